# Optimizing an MI355X kernel written in HIP

```python
import math
import jax, jax.numpy as jnp
from jax import lax
import numpy as np

D_MODEL = 1024
BATCH = 4
SEQ = 8192
DEPTH = 2

PLE_DIM = 256
NSA_HEADS = 8
NSA_HEAD_DIM = 64
NSA_GROUPS = 2
NSA_Q_PER_GROUP = NSA_HEADS // NSA_GROUPS
CMP_BLOCK = 32
CMP_STRIDE = 16
CMP_HIDDEN = 4 * NSA_HEAD_DIM
SLC_BLOCK = 64
N_SELECT = 16
WINDOW = 512
Q_BLOCK = 128
RET_HEADS = 4
RET_HEAD_DIM = 128
RET_CHUNK = 128
ROPE_BASE = 10000.0
D_FF = 4 * D_MODEL
EPS = 1e-6
MASK_VALUE = -1e30
FORCE_SCORE = 1e4

NSA_Q_W = NSA_HEADS * NSA_HEAD_DIM
NSA_KV_W = NSA_GROUPS * NSA_HEAD_DIM
NSA_GATE_W = 3 * NSA_HEADS
RET_W = RET_HEADS * RET_HEAD_DIM
IN_SPLITS = (NSA_Q_W, NSA_KV_W, NSA_KV_W, NSA_KV_W, NSA_KV_W, NSA_KV_W, NSA_KV_W, NSA_GATE_W,
             RET_W, RET_W, RET_W, RET_W, D_MODEL, D_MODEL)
D_IN = sum(IN_SPLITS)

kernel_name = "hybrid_nsa_retention_griffin_merge"


def split_cols(z, sizes):
    out = []
    off = 0
    for s in sizes:
        out.append(z[..., off:off + s])
        off += s
    return out


def rmsnorm(x, g):
    xf = x.astype(jnp.float32)
    y = xf * lax.rsqrt(jnp.mean(xf * xf, axis=-1, keepdims=True) + EPS)
    return (y * g.astype(jnp.float32)).astype(x.dtype)


def rms_noaffine(x):
    xf = x.astype(jnp.float32)
    return xf * lax.rsqrt(jnp.mean(xf * xf, axis=-1, keepdims=True) + EPS)


def masked_softmax(s, mask):
    s = jnp.where(mask, s, MASK_VALUE)
    m = jnp.max(s, axis=-1, keepdims=True)
    e = jnp.exp(s - m) * mask
    return e / jnp.maximum(jnp.sum(e, axis=-1, keepdims=True), 1e-30)


def rope(x, pos):
    half = x.shape[-1] // 2
    inv = ROPE_BASE ** (-jnp.arange(half, dtype=jnp.float32) / half)
    ang = pos[:, None] * inv[None, :]
    cos = jnp.cos(ang)[:, None, :]
    sin = jnp.sin(ang)[:, None, :]
    x1 = x[..., :half].astype(jnp.float32)
    x2 = x[..., half:].astype(jnp.float32)
    return jnp.concatenate([x1 * cos - x2 * sin, x1 * sin + x2 * cos], axis=-1)


def nsa_mixer(q_in, kc_in, vc_in, ks_in, vs_in, kw_in, vw_in, gate_logits,
              qn_g, kn_g, pos_k, pos_v, w1_k, w2_k, w1_v, w2_v):
    B, S = q_in.shape[:2]
    G, Hg, dh = NSA_GROUPS, NSA_Q_PER_GROUP, NSA_HEAD_DIM
    dtype = q_in.dtype
    scale = dh ** -0.5
    q = rmsnorm(q_in.reshape(B, S, G, Hg, dh).transpose(0, 2, 3, 1, 4), qn_g)

    def kv_heads(z):
        return z.reshape(B, S, G, dh).transpose(0, 2, 1, 3)

    k_c, v_c = kv_heads(kc_in), kv_heads(vc_in)
    k_s, v_s = rmsnorm(kv_heads(ks_in), kn_g), kv_heads(vs_in)
    k_w, v_w = rmsnorm(kv_heads(kw_in), kn_g), kv_heads(vw_in)
    gates = jax.nn.sigmoid(gate_logits.astype(jnp.float32)).reshape(B, S, 3, G, Hg).transpose(0, 3, 4, 1, 2)

    nc = S // CMP_STRIDE
    starts = jnp.arange(nc) * CMP_STRIDE
    idx = jnp.minimum(starts[:, None] + jnp.arange(CMP_BLOCK)[None, :], S - 1)
    cmp_end = starts + CMP_BLOCK - 1

    def compress(z, pos, w1, w2):
        zb = (z[:, :, idx] + pos).reshape(B, G, nc, CMP_BLOCK * dh)
        return jax.nn.gelu(zb @ w1) @ w2

    k_cmp = rmsnorm(compress(k_c, pos_k, w1_k, w2_k), kn_g)
    v_cmp = compress(v_c, pos_v, w1_v, w2_v)

    ns = S // SLC_BLOCK
    n_sel = min(N_SELECT, ns)
    ratio = SLC_BLOCK // CMP_STRIDE
    k_blk = k_s.reshape(B, G, ns, SLC_BLOCK, dh)
    v_blk = v_s.reshape(B, G, ns, SLC_BLOCK, dh)
    b_ix = jnp.arange(B)[:, None, None, None]
    g_ix = jnp.arange(G)[None, :, None, None]

    pad = ((0, 0), (0, 0), (WINDOW, 0), (0, 0))
    k_w_pad = jnp.pad(k_w, pad)
    v_w_pad = jnp.pad(v_w, pad)

    def query_block(c):
        q0 = c * Q_BLOCK
        qc = lax.dynamic_slice_in_dim(q, q0, Q_BLOCK, axis=3)
        gc = lax.dynamic_slice_in_dim(gates, q0, Q_BLOCK, axis=3)
        t = q0 + jnp.arange(Q_BLOCK)

        s = jnp.einsum('bghqd,bgnd->bghqn', qc, k_cmp).astype(jnp.float32) * scale
        p_cmp = masked_softmax(s, cmp_end[None, :] <= t[:, None])
        o_cmp = jnp.einsum('bghqn,bgnd->bghqd', p_cmp.astype(dtype), v_cmp)

        imp = jnp.sum(p_cmp, axis=2).reshape(B, G, Q_BLOCK, ns, ratio)
        imp_blk = jnp.sum(imp, axis=-1) + jnp.pad(imp[..., :-1, -1], ((0, 0), (0, 0), (0, 0), (1, 0)))
        blk = jnp.arange(ns)[None, :]
        cur = (t // SLC_BLOCK)[:, None]
        forced = (blk == 0) | (blk == cur) | (blk == cur - 1)
        score = jnp.where(forced, FORCE_SCORE, imp_blk)
        score = jnp.where(blk > cur, MASK_VALUE, score)
        _, sel = lax.top_k(score, n_sel)
        ks = k_blk[b_ix, g_ix, sel]
        vs = v_blk[b_ix, g_ix, sel]
        kpos = sel[..., None] * SLC_BLOCK + jnp.arange(SLC_BLOCK)
        smask = (kpos <= t[:, None, None]).reshape(B, G, Q_BLOCK, n_sel * SLC_BLOCK)[:, :, None]
        s = jnp.einsum('bghqd,bgqnkd->bghqnk', qc, ks).astype(jnp.float32) * scale
        p_slc = masked_softmax(s.reshape(B, G, Hg, Q_BLOCK, n_sel * SLC_BLOCK), smask)
        o_slc = jnp.einsum('bghqnk,bgqnkd->bghqd',
                           p_slc.reshape(B, G, Hg, Q_BLOCK, n_sel, SLC_BLOCK).astype(dtype), vs)

        kw = lax.dynamic_slice_in_dim(k_w_pad, q0, Q_BLOCK + WINDOW, axis=2)
        vw = lax.dynamic_slice_in_dim(v_w_pad, q0, Q_BLOCK + WINDOW, axis=2)
        wpos = q0 - WINDOW + jnp.arange(Q_BLOCK + WINDOW)
        dist = t[:, None] - wpos[None, :]
        wmask = (dist >= 0) & (dist < WINDOW) & (wpos[None, :] >= 0)
        s = jnp.einsum('bghqd,bgkd->bghqk', qc, kw).astype(jnp.float32) * scale
        p_win = masked_softmax(s, wmask)
        o_win = jnp.einsum('bghqk,bgkd->bghqd', p_win.astype(dtype), vw)

        return gc[..., 0:1] * o_cmp + gc[..., 1:2] * o_slc + gc[..., 2:3] * o_win

    out = lax.map(query_block, jnp.arange(S // Q_BLOCK))
    return out.transpose(1, 0, 4, 2, 3, 5).reshape(B, S, NSA_Q_W).astype(dtype)


def retention(q_in, k_in, v_in, g_in):
    B, S = q_in.shape[:2]
    H, dk, C = RET_HEADS, RET_HEAD_DIM, RET_CHUNK
    dtype = q_in.dtype
    pos = jnp.arange(S, dtype=jnp.float32)
    q = rope(q_in.reshape(B, S, H, dk), pos)
    k = rope(k_in.reshape(B, S, H, dk), pos) * (dk ** -0.5)
    v = v_in.reshape(B, S, H, dk).astype(jnp.float32)
    nch = S // C

    def chunks(z):
        return z.reshape(B, nch, C, H, dk).transpose(0, 3, 1, 2, 4)

    qc, kc, vc = chunks(q), chunks(k), chunks(v)
    gamma = 1.0 - 2.0 ** (-5.0 - jnp.arange(H, dtype=jnp.float32))
    lg = jnp.log(gamma)
    n = jnp.arange(C, dtype=jnp.float32)
    diff = n[:, None] - n[None, :]
    decay = jnp.where(diff >= 0, jnp.exp(lg[:, None, None] * jnp.maximum(diff, 0.0)), 0.0)
    xi = jnp.exp(lg[:, None] * (n + 1.0))[None, :, None, :, None]
    zeta = jnp.exp(lg[:, None] * (C - 1.0 - n))[None, :, None, :, None]
    g_chunk = jnp.exp(lg * C)[None, :, None, None]

    inner = jnp.einsum('bhcnd,bhcmd->bhcnm', qc, kc) * decay[None, :, None]
    inner = jnp.einsum('bhcnm,bhcme->bhcne', inner, vc)
    kv = jnp.einsum('bhcmd,bhcme->cbhde', kc * zeta, vc)

    def step(R, kv_c):
        return g_chunk * R + kv_c, R

    _, R_prev = lax.scan(step, jnp.zeros((B, H, dk, dk), jnp.float32), kv)
    cross = jnp.einsum('bhcnd,cbhde->bhcne', qc * xi, R_prev)
    y = rms_noaffine(inner + cross)
    y = y.transpose(0, 2, 3, 1, 4).reshape(B, S, RET_W)
    return (jax.nn.silu(g_in.astype(jnp.float32)) * y).astype(dtype)


def setup_inputs(seed: int = 0) -> dict:
    key = jax.random.key(seed)
    ks = jax.random.split(key, 21)
    f32 = jnp.float32

    def nrm(k, shape, scale):
        return jax.random.normal(k, shape, f32) * scale

    def gain(k, shape):
        return 1.0 + 0.1 * jax.random.normal(k, shape, f32)

    dh = NSA_HEAD_DIM
    return {
        "x": nrm(ks[0], (BATCH, SEQ, D_MODEL), 1.0),
        "p": nrm(ks[1], (DEPTH, BATCH, SEQ, PLE_DIM), 1.0),
        "norm_mix": gain(ks[2], (DEPTH, D_MODEL)),
        "w_in": nrm(ks[3], (DEPTH, D_MODEL, D_IN), D_MODEL ** -0.5),
        "nsa_q_norm": gain(ks[4], (DEPTH, dh)),
        "nsa_k_norm": gain(ks[5], (DEPTH, dh)),
        "cmp_pos_k": nrm(ks[6], (DEPTH, CMP_BLOCK, dh), 0.1),
        "cmp_pos_v": nrm(ks[7], (DEPTH, CMP_BLOCK, dh), 0.1),
        "cmp_w1_k": nrm(ks[8], (DEPTH, CMP_BLOCK * dh, CMP_HIDDEN), (CMP_BLOCK * dh) ** -0.5),
        "cmp_w2_k": nrm(ks[9], (DEPTH, CMP_HIDDEN, dh), CMP_HIDDEN ** -0.5),
        "cmp_w1_v": nrm(ks[10], (DEPTH, CMP_BLOCK * dh, CMP_HIDDEN), (CMP_BLOCK * dh) ** -0.5),
        "cmp_w2_v": nrm(ks[11], (DEPTH, CMP_HIDDEN, dh), CMP_HIDDEN ** -0.5),
        "w_up_nsa": nrm(ks[12], (DEPTH, NSA_Q_W, D_MODEL), NSA_Q_W ** -0.5),
        "w_up_ret": nrm(ks[13], (DEPTH, RET_W, D_MODEL), RET_W ** -0.5),
        "w_out": nrm(ks[14], (DEPTH, D_MODEL, D_MODEL), D_MODEL ** -0.5),
        "norm_mlp": gain(ks[15], (DEPTH, D_MODEL)),
        "w_ff1": nrm(ks[16], (DEPTH, D_MODEL, D_FF), D_MODEL ** -0.5),
        "w_ff2": nrm(ks[17], (DEPTH, D_FF, D_MODEL), D_FF ** -0.5),
        "norm_ple": gain(ks[18], (DEPTH, D_MODEL)),
        "w_ple": nrm(ks[19], (DEPTH, PLE_DIM, D_MODEL), PLE_DIM ** -0.5),
        "w_ple_gate": nrm(ks[20], (DEPTH, D_MODEL, D_MODEL), D_MODEL ** -0.5),
    }


def reference(x, p, norm_mix, w_in, nsa_q_norm, nsa_k_norm, cmp_pos_k, cmp_pos_v,
              cmp_w1_k, cmp_w2_k, cmp_w1_v, cmp_w2_v, w_up_nsa, w_up_ret, w_out,
              norm_mlp, w_ff1, w_ff2, norm_ple, w_ple, w_ple_gate):
    for i in range(DEPTH):
        h = rmsnorm(x, norm_mix[i])
        z = h @ w_in[i]
        (q_a, kc, vc, ks_, vs_, kw, vw, g_nsa, rq, rk, rv, rg, merge_a, merge_b) = split_cols(z, IN_SPLITS)
        y_a = nsa_mixer(q_a, kc, vc, ks_, vs_, kw, vw, g_nsa, nsa_q_norm[i], nsa_k_norm[i],
                        cmp_pos_k[i], cmp_pos_v[i], cmp_w1_k[i], cmp_w2_k[i], cmp_w1_v[i], cmp_w2_v[i]) @ w_up_nsa[i]
        y_b = retention(rq, rk, rv, rg) @ w_up_ret[i]
        mix = jax.nn.sigmoid(merge_a) * y_a + jax.nn.sigmoid(merge_b) * y_b
        x = x + mix @ w_out[i]
        h = rmsnorm(x, norm_mlp[i])
        x = x + jnp.square(jax.nn.relu(h @ w_ff1[i])) @ w_ff2[i]
        gate = jax.nn.sigmoid(rmsnorm(x, norm_ple[i]) @ w_ple_gate[i])
        x = x + gate * (p[i] @ w_ple[i])
    return x
```

```cpp
#include <hip/hip_runtime.h>
#include <hip/hip_cooperative_groups.h>
#include <cstdio>
#include <cstdint>
namespace cg = cooperative_groups;

typedef __attribute__((ext_vector_type(8))) short bf16x8;
typedef __attribute__((ext_vector_type(4))) float f32x4;
typedef unsigned short bf16_t;
#define DI __device__ __forceinline__

#define T_TOK 32768
#define SEQ 8192
#define DM 1024
#define ZS 5400
#define C_Q 0
#define C_KC 512
#define C_VC 640
#define C_KS 768
#define C_VS 896
#define C_KW 1024
#define C_VW 1152
#define C_GT 1280
#define C_RQ 1304
#define C_RK 1816
#define C_RV 2328
#define C_RG 2840
#define C_MA 3352
#define C_MB 4376
#define NPAD_IN 5504

#define W_IN 0
#define W_C1K 5636096
#define W_C1V 6160384
#define W_UPA 6684672
#define W_UPR 7208960
#define W_OUT 7733248
#define W_FF1 8781824
#define W_FF2 12976128
#define W_PLE 17170432
#define W_PG 17432576
#define W_LAYER 18481152

#define O_WT 0ull
#define O_ROPE 73924608ull
#define O_BIAS 78118912ull
#define O_HID 78123008ull
#define O_KCMP 82317312ull
#define O_VCMPT 82841600ull
#define O_VST 83365888ull
#define O_VWT 91754496ull
#define O_RVT 100143104ull
#define O_KZT 133697536ull
#define O_Z 167251968ull
#define WS_NEED 521146368ull

struct Params {
  const float* x; const float* p; const float* norm_mix; const float* w_in;
  const float* nsa_q_norm; const float* nsa_k_norm; const float* cmp_pos_k; const float* cmp_pos_v;
  const float* cmp_w1_k; const float* cmp_w2_k; const float* cmp_w1_v; const float* cmp_w2_v;
  const float* w_up_nsa; const float* w_up_ret; const float* w_out; const float* norm_mlp;
  const float* w_ff1; const float* w_ff2; const float* norm_ple; const float* w_ple; const float* w_ple_gate;
  float* out; char* ws;
};

DI unsigned pack2(float a, float b) {
  typedef __attribute__((ext_vector_type(2))) __bf16 bf2;
  typedef __attribute__((ext_vector_type(2))) float f2;
  f2 v = {a, b};
  bf2 r = __builtin_convertvector(v, bf2);
  return __builtin_bit_cast(unsigned, r);
}
DI bf16_t f2bf(float a) { return (bf16_t)(pack2(a, 0.f) & 0xffffu); }
DI float bf2f(bf16_t h) { return __uint_as_float(((unsigned)h) << 16); }
DI float bflo(unsigned u) { return __uint_as_float(u << 16); }
DI float bfhi(unsigned u) { return __uint_as_float(u & 0xffff0000u); }
DI float shx(float v, int mask, int lane) {
  return __int_as_float(__builtin_amdgcn_ds_bpermute((lane ^ mask) << 2, __float_as_int(v)));
}
DI uint32_t shxu(uint32_t v, int mask, int lane) {
  return (uint32_t)__builtin_amdgcn_ds_bpermute((lane ^ mask) << 2, (int)v);
}
DI float shfrom(float v, int srclane) {
  return __int_as_float(__builtin_amdgcn_ds_bpermute(srclane << 2, __float_as_int(v)));
}
DI float wave_sum(float v, int lane) {
#pragma unroll
  for (int o = 32; o > 0; o >>= 1) v += shx(v, o, lane);
  return v;
}
DI int TID() { int t = threadIdx.x; asm volatile("" : "+v"(t)); return t; }
DI float sigmoidf(float x) { return 1.f / (1.f + __expf(-x)); }
DI f32x4 mfma16(bf16x8 a, bf16x8 b, f32x4 c) { return __builtin_amdgcn_mfma_f32_16x16x32_bf16(a, b, c, 0, 0, 0); }
DI bf16x8 mk8(unsigned a, unsigned b, unsigned c, unsigned d) {
  uint4 u = make_uint4(a, b, c, d);
  return __builtin_bit_cast(bf16x8, u);
}

template <class AP, class BP>
DI void gemm_accum(f32x4 (&acc)[4][4], AP ap, BP bp, int nkb, bf16_t* lds) {
  const int tid = TID(), lane = tid & 63, w = tid >> 6;
  const int wm = w >> 1, wn = w & 1;
  const int lrow = tid >> 3, lch = tid & 7;
  bf16_t* As = lds;
  bf16_t* Bs = lds + 16384;
  uint4 ra[4], rb[4];
  __syncthreads();
#pragma unroll
  for (int i = 0; i < 4; ++i) {
    ra[i] = *(const uint4*)(ap(lrow + 32 * i, 0) + lch * 8);
    rb[i] = *(const uint4*)(bp(lrow + 32 * i, 0) + lch * 8);
  }
#pragma unroll
  for (int i = 0; i < 4; ++i) {
    int r = lrow + 32 * i;
    int off = r * 64 + ((lch ^ ((r >> 1) & 7)) << 3);
    *(uint4*)(As + off) = ra[i];
    *(uint4*)(Bs + off) = rb[i];
  }
  __syncthreads();
  for (int kb = 0; kb < nkb; ++kb) {
    const int cur = kb & 1;
    const bool more = (kb + 1 < nkb);
    if (more) {
#pragma unroll
      for (int i = 0; i < 4; ++i) {
        ra[i] = *(const uint4*)(ap(lrow + 32 * i, kb + 1) + lch * 8);
        rb[i] = *(const uint4*)(bp(lrow + 32 * i, kb + 1) + lch * 8);
      }
    }
    const bf16_t* a = As + cur * 8192;
    const bf16_t* b = Bs + cur * 8192;
#pragma unroll
    for (int ks = 0; ks < 2; ++ks) {
      bf16x8 af[4], bfr[4];
#pragma unroll
      for (int i = 0; i < 4; ++i) {
        int r = wm * 64 + i * 16 + (lane & 15);
        af[i] = *(const bf16x8*)(a + r * 64 + (((ks * 4 + (lane >> 4)) ^ ((r >> 1) & 7)) << 3));
        int r2 = wn * 64 + i * 16 + (lane & 15);
        bfr[i] = *(const bf16x8*)(b + r2 * 64 + (((ks * 4 + (lane >> 4)) ^ ((r2 >> 1) & 7)) << 3));
      }
#pragma unroll
      for (int i = 0; i < 4; ++i)
#pragma unroll
        for (int j = 0; j < 4; ++j) acc[i][j] = mfma16(bfr[j], af[i], acc[i][j]);
    }
    if (more) {
#pragma unroll
      for (int i = 0; i < 4; ++i) {
        int r = lrow + 32 * i;
        int off = (cur ^ 1) * 8192 + r * 64 + ((lch ^ ((r >> 1) & 7)) << 3);
        *(uint4*)(As + off) = ra[i];
        *(uint4*)(Bs + off) = rb[i];
      }
    }
    __syncthreads();
  }
}
template <class E>
DI void gemm_epi(f32x4 (&acc)[4][4], int m0, int n0, E e) {
  const int tid_ = TID();
  const int lane = tid_ & 63, w = tid_ >> 6;
  const int wm = w >> 1, wn = w & 1;
#pragma unroll
  for (int i = 0; i < 4; ++i)
#pragma unroll
    for (int j = 0; j < 4; ++j) {
      int m = m0 + wm * 64 + i * 16 + (lane & 15);
      int n = n0 + wn * 64 + j * 16 + (lane >> 4) * 4;
      e(m, n, acc[i][j]);
    }
}
DI void zero_acc(f32x4 (&acc)[4][4]) {
#pragma unroll
  for (int i = 0; i < 4; ++i)
#pragma unroll
    for (int j = 0; j < 4; ++j) acc[i][j] = f32x4{0.f, 0.f, 0.f, 0.f};
}
struct RowPtr {
  const bf16_t* base; size_t ld;
  DI const bf16_t* operator()(int r, int kb) const { return base + (size_t)r * ld + kb * 64; }
};

DI void convert_wt(const float* W, bf16_t* Wt, int K, int N, int Npad, int gtid, int gthreads) {
  const int k8n = K >> 3;
  const long total = (long)Npad * k8n;
  for (long idx = gtid; idx < total; idx += gthreads) {
    int n = (int)(idx % Npad);
    int k8 = (int)(idx / Npad);
    uint4 o = make_uint4(0, 0, 0, 0);
    if (n < N) {
      const float* s = W + (size_t)(k8 * 8) * N + n;
      float v0 = s[0], v1 = s[(size_t)N], v2 = s[(size_t)2 * N], v3 = s[(size_t)3 * N];
      float v4 = s[(size_t)4 * N], v5 = s[(size_t)5 * N], v6 = s[(size_t)6 * N], v7 = s[(size_t)7 * N];
      o = make_uint4(pack2(v0, v1), pack2(v2, v3), pack2(v4, v5), pack2(v6, v7));
    }
    *(uint4*)(Wt + (size_t)n * K + k8 * 8) = o;
  }
}

DI void phase0(const Params& p) {
  const int gtid = blockIdx.x * 256 + TID();
  const int gthreads = gridDim.x * 256;
  bf16_t* wt = (bf16_t*)(p.ws + O_WT);
  for (int L = 0; L < 2; ++L) {
    bf16_t* wl = wt + (size_t)L * W_LAYER;
    convert_wt(p.w_in + (size_t)L * 1024 * 5400, wl + W_IN, 1024, 5400, NPAD_IN, gtid, gthreads);
    convert_wt(p.cmp_w1_k + (size_t)L * 2048 * 256, wl + W_C1K, 2048, 256, 256, gtid, gthreads);
    convert_wt(p.cmp_w1_v + (size_t)L * 2048 * 256, wl + W_C1V, 2048, 256, 256, gtid, gthreads);
    convert_wt(p.w_up_nsa + (size_t)L * 512 * 1024, wl + W_UPA, 512, 1024, 1024, gtid, gthreads);
    convert_wt(p.w_up_ret + (size_t)L * 512 * 1024, wl + W_UPR, 512, 1024, 1024, gtid, gthreads);
    convert_wt(p.w_out + (size_t)L * 1024 * 1024, wl + W_OUT, 1024, 1024, 1024, gtid, gthreads);
    convert_wt(p.w_ff1 + (size_t)L * 1024 * 4096, wl + W_FF1, 1024, 4096, 4096, gtid, gthreads);
    convert_wt(p.w_ff2 + (size_t)L * 4096 * 1024, wl + W_FF2, 4096, 1024, 1024, gtid, gthreads);
    convert_wt(p.w_ple + (size_t)L * 256 * 1024, wl + W_PLE, 256, 1024, 1024, gtid, gthreads);
    convert_wt(p.w_ple_gate + (size_t)L * 1024 * 1024, wl + W_PG, 1024, 1024, 1024, gtid, gthreads);
  }
  float2* rope = (float2*)(p.ws + O_ROPE);
  for (int idx = gtid; idx < SEQ * 64; idx += gthreads) {
    int pos = idx >> 6, j = idx & 63;
    float inv = exp2f(-(float)j * (13.287712379549449f / 64.f));
    float ang = (float)pos * inv;
    double rev = (double)ang * 0.15915494309189535;
    rev -= rint(rev);
    float fr = (float)rev;
    rope[idx] = make_float2(__builtin_amdgcn_cosf(fr), __builtin_amdgcn_sinf(fr));
  }
  float* bias = (float*)(p.ws + O_BIAS);
  for (int idx = gtid; idx < 1024; idx += gthreads) {
    int n = idx & 255, kv = (idx >> 8) & 1, L = idx >> 9;
    const float* pos = (kv ? p.cmp_pos_v : p.cmp_pos_k) + L * 2048;
    const float* w1 = (kv ? p.cmp_w1_v : p.cmp_w1_k) + (size_t)L * 2048 * 256;
    float a = 0.f;
    for (int k = 0; k < 2048; ++k) a += pos[k] * w1[(size_t)k * 256 + n];
    bias[idx] = a;
  }
}

DI void norm_phase(const float* xin, const float* g, bf16_t* h) {
  const int tid_ = TID();
  const int lane = tid_ & 63;
  const int gw = (blockIdx.x * 256 + tid_) >> 6;
  const int nw = gridDim.x * 4;
  float4 gv[4];
#pragma unroll
  for (int i = 0; i < 4; ++i) gv[i] = ((const float4*)g)[i * 64 + lane];
  for (int row = gw; row < T_TOK; row += nw) {
    const float4* xr = (const float4*)(xin + (size_t)row * DM);
    float4 v[4];
    float ss = 0.f;
#pragma unroll
    for (int i = 0; i < 4; ++i) {
      v[i] = xr[i * 64 + lane];
      ss += v[i].x * v[i].x + v[i].y * v[i].y + v[i].z * v[i].z + v[i].w * v[i].w;
    }
    ss = wave_sum(ss, lane);
    float rs = rsqrtf(ss * (1.f / 1024.f) + 1e-6f);
    uint2* hr = (uint2*)(h + (size_t)row * DM);
#pragma unroll
    for (int i = 0; i < 4; ++i) {
      uint2 o;
      o.x = pack2(v[i].x * rs * gv[i].x, v[i].y * rs * gv[i].y);
      o.y = pack2(v[i].z * rs * gv[i].z, v[i].w * rs * gv[i].w);
      hr[i * 64 + lane] = o;
    }
  }
}

DI void post_z(const Params& p, int layer) {
  const int tid_ = TID();
  const int lane = tid_ & 63;
  const int gw = (blockIdx.x * 256 + tid_) >> 6;
  const int nw = gridDim.x * 4;
  bf16_t* z = (bf16_t*)(p.ws + O_Z);
  bf16_t* vsT = (bf16_t*)(p.ws + O_VST);
  bf16_t* vwT = (bf16_t*)(p.ws + O_VWT);
  bf16_t* rvT = (bf16_t*)(p.ws + O_RVT);
  bf16_t* kzT = (bf16_t*)(p.ws + O_KZT);
  const float2* rope = (const float2*)(p.ws + O_ROPE);
  const float* qn = p.nsa_q_norm + layer * 64;
  const float* kn = p.nsa_k_norm + layer * 64;
  for (int item = gw; item < 4096 * 32; item += nw) {
    const int slab = item & 31, tc = item >> 5;
    const int tok0 = tc * 8;
    const int b = tok0 >> 13, spos = tok0 & 8191;
    bf16_t* zr = z + (size_t)tok0 * ZS;
    if (slab < 12) {
      int colbase; const float* g; float sc;
      if (slab < 8) { colbase = C_Q + slab * 64; g = qn; sc = 0.125f; }
      else if (slab < 10) { colbase = C_KS + (slab - 8) * 64; g = kn; sc = 1.f; }
      else { colbase = C_KW + (slab - 10) * 64; g = kn; sc = 1.f; }
      const float gv = g[lane] * sc;
#pragma unroll
      for (int i = 0; i < 8; ++i) {
        bf16_t* ptr = zr + (size_t)i * ZS + colbase + lane;
        float v = bf2f(*ptr);
        float ss = wave_sum(v * v, lane);
        float rs = rsqrtf(ss * (1.f / 64.f) + 1e-6f);
        *ptr = f2bf(v * rs * gv);
      }
    } else if (slab < 16) {
      const int gi = slab & 1;
      const bool isw = slab >= 14;
      const int colbase = (isw ? C_VW : C_VS) + gi * 64;
      bf16_t* dst = (isw ? vwT : vsT) + ((size_t)((b * 2 + gi) * 64 + lane)) * SEQ + spos;
      unsigned u[8];
#pragma unroll
      for (int i = 0; i < 8; ++i) u[i] = zr[(size_t)i * ZS + colbase + lane];
      *(uint4*)dst = make_uint4(u[0] | (u[1] << 16), u[2] | (u[3] << 16), u[4] | (u[5] << 16), u[6] | (u[7] << 16));
    } else if (slab < 20) {
      const int h = slab - 16;
      const int colbase = C_RQ + h * 128;
#pragma unroll
      for (int i = 0; i < 8; ++i) {
        bf16_t* p1 = zr + (size_t)i * ZS + colbase + lane;
        float x1 = bf2f(p1[0]), x2 = bf2f(p1[64]);
        float2 cs = rope[(spos + i) * 64 + lane];
        p1[0] = f2bf(x1 * cs.x - x2 * cs.y);
        p1[64] = f2bf(x1 * cs.y + x2 * cs.x);
      }
    } else if (slab < 24) {
      const int h = slab - 20;
      const int colbase = C_RK + h * 128;
      const float lg2 = log2f(1.f - exp2f(-5.f - (float)h));
      unsigned u1[8], u2[8];
#pragma unroll
      for (int i = 0; i < 8; ++i) {
        bf16_t* p1 = zr + (size_t)i * ZS + colbase + lane;
        float x1 = bf2f(p1[0]), x2 = bf2f(p1[64]);
        float2 cs = rope[(spos + i) * 64 + lane];
        float o1 = (x1 * cs.x - x2 * cs.y) * 0.08838834764831845f;
        float o2 = (x1 * cs.y + x2 * cs.x) * 0.08838834764831845f;
        p1[0] = f2bf(o1);
        p1[64] = f2bf(o2);
        float zeta = exp2f(lg2 * (float)(127 - ((spos + i) & 127)));
        u1[i] = f2bf(o1 * zeta);
        u2[i] = f2bf(o2 * zeta);
      }
      bf16_t* d1 = kzT + ((size_t)((b * 4 + h) * 128 + lane)) * SEQ + spos;
      *(uint4*)d1 = make_uint4(u1[0] | (u1[1] << 16), u1[2] | (u1[3] << 16), u1[4] | (u1[5] << 16), u1[6] | (u1[7] << 16));
      *(uint4*)(d1 + (size_t)64 * SEQ) = make_uint4(u2[0] | (u2[1] << 16), u2[2] | (u2[3] << 16), u2[4] | (u2[5] << 16), u2[6] | (u2[7] << 16));
    } else {
      const int s8 = slab - 24;
      const int h = s8 >> 1, half = s8 & 1;
      const int colbase = C_RV + s8 * 64;
      bf16_t* dst = rvT + ((size_t)((b * 4 + h) * 128 + half * 64 + lane)) * SEQ + spos;
      unsigned u[8];
#pragma unroll
      for (int i = 0; i < 8; ++i) u[i] = zr[(size_t)i * ZS + colbase + lane];
      *(uint4*)dst = make_uint4(u[0] | (u[1] << 16), u[2] | (u[3] << 16), u[4] | (u[5] << 16), u[6] | (u[7] << 16));
    }
  }
}

DI void phase4b(const Params& p, int layer) {
  const int tid_ = TID();
  const int lane = tid_ & 63;
  const int gw = (blockIdx.x * 256 + tid_) >> 6;
  const int nw = gridDim.x * 4;
  bf16_t* z = (bf16_t*)(p.ws + O_Z);
  const bf16_t* hid = (const bf16_t*)(p.ws + O_HID);
  bf16_t* kcmp = (bf16_t*)(p.ws + O_KCMP);
  bf16_t* vcmpT = (bf16_t*)(p.ws + O_VCMPT);
  const float* kn = p.nsa_k_norm + layer * 64;
  for (int item = gw; item < 8192; item += nw) {
    const int kv = item >> 12, row = item & 4095;
    const bf16_t* hrow = hid + ((size_t)kv * 4096 + row) * 256;
    const float* w2 = (kv ? p.cmp_w2_v : p.cmp_w2_k) + (size_t)layer * 256 * 64;
    float acc = 0.f;
    for (int k8 = 0; k8 < 32; ++k8) {
      uint4 hv = *(const uint4*)(hrow + k8 * 8);
      const float* wr = w2 + (size_t)(k8 * 8) * 64 + lane;
      acc += bflo(hv.x) * wr[0];
      acc += bfhi(hv.x) * wr[64];
      acc += bflo(hv.y) * wr[128];
      acc += bfhi(hv.y) * wr[192];
      acc += bflo(hv.z) * wr[256];
      acc += bfhi(hv.z) * wr[320];
      acc += bflo(hv.w) * wr[384];
      acc += bfhi(hv.w) * wr[448];
    }
    if (kv == 0) {
      float ss = wave_sum(acc * acc, lane);
      float rs = rsqrtf(ss * (1.f / 64.f) + 1e-6f);
      kcmp[(size_t)row * 64 + lane] = f2bf(acc * rs * kn[lane]);
    } else {
      const int bg = row >> 9, c = row & 511;
      vcmpT[((size_t)(bg * 64 + lane)) * 512 + c] = f2bf(acc);
    }
  }
  const int gtid = blockIdx.x * 256 + tid_;
  const int gthreads = gridDim.x * 256;
  for (int idx = gtid; idx < 65536; idx += gthreads) {
    const int d4 = idx & 31, e = (idx >> 5) & 127, h = (idx >> 12) & 3, b = idx >> 14;
    const float lg2 = log2f(1.f - exp2f(-5.f - (float)h));
    const float gch = exp2f(lg2 * 128.f);
    float r0 = 0.f, r1 = 0.f, r2 = 0.f, r3 = 0.f;
    bf16_t* ptr = z + ((size_t)(b * SEQ + e)) * ZS + C_RV + h * 128 + d4 * 4;
    for (int c = 0; c < 64; ++c) {
      uint2* q = (uint2*)(ptr + (size_t)c * 128 * ZS);
      uint2 v = *q;
      uint2 o;
      o.x = pack2(r0, r1);
      o.y = pack2(r2, r3);
      *q = o;
      r0 = gch * r0 + bflo(v.x);
      r1 = gch * r1 + bfhi(v.x);
      r2 = gch * r2 + bflo(v.y);
      r3 = gch * r3 + bfhi(v.y);
    }
  }
}

struct AttnSt { f32x4 O[4][4]; float m[4]; float l[4]; };

DI void tile64_gload(int tid, uint4& r0, uint4& r1, const bf16_t* base, size_t stride) {
  {
    int idx = tid;
    int row = idx >> 3, ch = idx & 7;
    r0 = *(const uint4*)(base + (size_t)row * stride + ch * 8);
  }
  {
    int idx = tid + 256;
    int row = idx >> 3, ch = idx & 7;
    r1 = *(const uint4*)(base + (size_t)row * stride + ch * 8);
  }
}
DI void tile64_sstore(int tid, bf16_t* dst, const uint4& r0, const uint4& r1) {
  {
    int idx = tid;
    int row = idx >> 3, ch = idx & 7;
    *(uint4*)(dst + row * 64 + ((ch ^ ((row >> 1) & 7)) << 3)) = r0;
  }
  {
    int idx = tid + 256;
    int row = idx >> 3, ch = idx & 7;
    *(uint4*)(dst + row * 64 + ((ch ^ ((row >> 1) & 7)) << 3)) = r1;
  }
}

template <int MODE>
DI void attn_compute(const int lane, const bf16_t* Ks, const bf16_t* Vs, const bf16x8 (&qf)[4][2], AttnSt& st, const float (&invl)[4],
                     int lo, int hi, float (&impA)[4], float (&impE)[4]) {
  const int quad = lane >> 4, col = lane & 15;
#pragma unroll
  for (int hp = 0; hp < 2; ++hp) {
    f32x4 S[4][2];
#pragma unroll
    for (int kt = 0; kt < 4; ++kt)
#pragma unroll
      for (int hh = 0; hh < 2; ++hh) S[kt][hh] = f32x4{0.f, 0.f, 0.f, 0.f};
#pragma unroll
    for (int ks = 0; ks < 2; ++ks) {
#pragma unroll
      for (int kt = 0; kt < 4; ++kt) {
        int row = kt * 16 + col;
        bf16x8 kf = *(const bf16x8*)(Ks + row * 64 + (((ks * 4 + quad) ^ ((row >> 1) & 7)) << 3));
#pragma unroll
        for (int hh = 0; hh < 2; ++hh) S[kt][hh] = mfma16(kf, qf[hp * 2 + hh][ks], S[kt][hh]);
      }
    }
    bf16x8 pf[2][2];
#pragma unroll
    for (int hh = 0; hh < 2; ++hh) {
      const int h = hp * 2 + hh;
      float mx = -1e30f;
#pragma unroll
      for (int kt = 0; kt < 4; ++kt)
#pragma unroll
        for (int j = 0; j < 4; ++j) {
          int kl = kt * 16 + quad * 4 + j;
          bool v = (kl >= lo) && (kl <= hi);
          float sv = v ? S[kt][hh][j] : -1e30f;
          S[kt][hh][j] = sv;
          mx = fmaxf(mx, sv);
        }
      if (MODE != 1) {
        mx = fmaxf(mx, shx(mx, 16, lane));
        mx = fmaxf(mx, shx(mx, 32, lane));
        float m_new = fmaxf(st.m[h], mx);
        float alpha = __expf(st.m[h] - m_new);
        st.m[h] = m_new;
        float rs = 0.f;
#pragma unroll
        for (int kt = 0; kt < 4; ++kt)
#pragma unroll
          for (int j = 0; j < 4; ++j) {
            float sv = S[kt][hh][j];
            float pv = (sv > -1e29f) ? __expf(sv - m_new) : 0.f;
            rs += pv;
            S[kt][hh][j] = pv;
          }
        st.l[h] = st.l[h] * alpha + rs;
        if (MODE == 2) {
#pragma unroll
          for (int dt = 0; dt < 4; ++dt) st.O[h][dt] *= alpha;
        }
      } else {
        const float mh = st.m[h], il = invl[h];
#pragma unroll
        for (int kt = 0; kt < 4; ++kt) {
          float a = 0.f;
#pragma unroll
          for (int j = 0; j < 4; ++j) {
            float sv = S[kt][hh][j];
            float pv = (sv > -1e29f) ? __expf(sv - mh) * il : 0.f;
            S[kt][hh][j] = pv;
            a += pv;
          }
          impA[kt] += a;
          impE[kt] += S[kt][hh][3];
        }
      }
      if (MODE != 0) {
#pragma unroll
        for (int c = 0; c < 2; ++c)
          pf[hh][c] = mk8(pack2(S[2 * c][hh][0], S[2 * c][hh][1]), pack2(S[2 * c][hh][2], S[2 * c][hh][3]),
                          pack2(S[2 * c + 1][hh][0], S[2 * c + 1][hh][1]), pack2(S[2 * c + 1][hh][2], S[2 * c + 1][hh][3]));
      }
    }
    if (MODE != 0) {
#pragma unroll
      for (int dt = 0; dt < 4; ++dt) {
        const int row = dt * 16 + col;
        const int sw = (row >> 1) & 7;
#pragma unroll
        for (int c = 0; c < 2; ++c) {
          uint2 a = *(const uint2*)(Vs + row * 64 + (((4 * c + (quad >> 1)) ^ sw) << 3) + (quad & 1) * 4);
          uint2 b = *(const uint2*)(Vs + row * 64 + (((4 * c + 2 + (quad >> 1)) ^ sw) << 3) + (quad & 1) * 4);
          bf16x8 vf = mk8(a.x, a.y, b.x, b.y);
#pragma unroll
          for (int hh = 0; hh < 2; ++hh) st.O[hp * 2 + hh][dt] = mfma16(vf, pf[hh][c], st.O[hp * 2 + hh][dt]);
        }
      }
    }
  }
}

DI void st_reset(AttnSt& st) {
#pragma unroll
  for (int h = 0; h < 4; ++h) {
    st.m[h] = -1e30f;
    st.l[h] = 0.f;
#pragma unroll
    for (int dt = 0; dt < 4; ++dt) st.O[h][dt] = f32x4{0.f, 0.f, 0.f, 0.f};
  }
}

template <bool FIRST>
DI void nsa_flush(const int quad, bf16_t* z, const uint32_t ooff, const AttnSt& st, const float (&sc)[4]) {
#pragma unroll
  for (int h = 0; h < 4; ++h)
#pragma unroll
    for (int dt = 0; dt < 4; ++dt) {
      uint2* q = (uint2*)(z + (ooff + h * 64 + dt * 16 + quad * 4));
      f32x4 o = st.O[h][dt] * sc[h];
      if (!FIRST) {
        uint2 pv = *q;
        o[0] += bflo(pv.x); o[1] += bfhi(pv.x); o[2] += bflo(pv.y); o[3] += bfhi(pv.y);
      }
      uint2 u;
      u.x = pack2(o[0], o[1]);
      u.y = pack2(o[2], o[3]);
      *q = u;
    }
}

DI void nsa_tile(const Params& p, int b, int g, int tile, bf16_t* lds) {
  const int tid = TID(), lane = tid & 63, w = tid >> 6, quad = lane >> 4, col = lane & 15;
  const int cur = tile;
  const int tok = tile * 64 + w * 16 + col;
  bf16_t* z = (bf16_t*)(p.ws + O_Z);
  const bf16_t* kcmp = (const bf16_t*)(p.ws + O_KCMP) + (size_t)(b * 2 + g) * 512 * 64;
  const bf16_t* vcmpT = (const bf16_t*)(p.ws + O_VCMPT) + (size_t)(b * 2 + g) * 64 * 512;
  const bf16_t* vsT = (const bf16_t*)(p.ws + O_VST) + (size_t)(b * 2 + g) * 64 * SEQ;
  const bf16_t* vwT = (const bf16_t*)(p.ws + O_VWT) + (size_t)(b * 2 + g) * 64 * SEQ;
  const bf16_t* zb = z + (size_t)b * SEQ * ZS;
  const uint32_t tokoff = (uint32_t)(b * SEQ + tok) * ZS;
  const uint32_t ooff = tokoff + C_Q + g * 256;
  bf16_t* Ks = lds;
  bf16_t* Vs = lds + 4096;
  float* impl = (float*)(lds + 8192);

  bf16x8 qf[4][2];
#pragma unroll
  for (int h = 0; h < 4; ++h)
#pragma unroll
    for (int ks = 0; ks < 2; ++ks) qf[h][ks] = *(const bf16x8*)(z + (ooff + h * 64 + ks * 32 + quad * 8));

  AttnSt st;
  float invl[4] = {0.f, 0.f, 0.f, 0.f};
  float dA[4] = {0.f, 0.f, 0.f, 0.f}, dE[4] = {0.f, 0.f, 0.f, 0.f};
  uint4 rk0, rk1, rv0, rv1;

  const int ncs = (cur < 16) ? 1 : (cur >> 4) + 1;
  const int chi = (tok >= 31) ? ((tok - 31) >> 4) : -1;
  st_reset(st);
  for (int s = 0; s < ncs; ++s) {
    tile64_gload(tid, rk0, rk1, kcmp + (size_t)s * 4096, 64);
    __syncthreads();
    tile64_sstore(tid, Ks, rk0, rk1);
    __syncthreads();
    attn_compute<0>(lane, Ks, Vs, qf, st, invl, 0, chi - s * 64, dA, dE);
  }
#pragma unroll
  for (int h = 0; h < 4; ++h) {
    float l = st.l[h];
    l += shx(l, 16, lane);
    l += shx(l, 32, lane);
    invl[h] = (l > 0.f) ? 1.f / l : 0.f;
  }
  {
    float carry = 0.f;
    for (int s = 0; s < ncs; ++s) {
      float iA[4] = {0.f, 0.f, 0.f, 0.f}, iE[4] = {0.f, 0.f, 0.f, 0.f};
      tile64_gload(tid, rk0, rk1, kcmp + (size_t)s * 4096, 64);
      tile64_gload(tid, rv0, rv1, vcmpT + s * 64, 512);
      __syncthreads();
      tile64_sstore(tid, Ks, rk0, rk1);
      tile64_sstore(tid, Vs, rv0, rv1);
      __syncthreads();
      attn_compute<1>(lane, Ks, Vs, qf, st, invl, 0, chi - s * 64, iA, iE);
#pragma unroll
      for (int kt = 0; kt < 4; ++kt) {
        float recv = shfrom(iE[kt], (lane + 48) & 63);
        impl[(s * 4 + kt) * 256 + tid] = iA[kt] + ((quad == 0) ? carry : recv);
        carry = recv;
      }
    }
  }
  {
    float sc[4];
#pragma unroll
    for (int h = 0; h < 4; ++h) sc[h] = sigmoidf(bf2f(z[tokoff + C_GT + 0 * 8 + g * 4 + h]));
    nsa_flush<true>(quad, z, ooff, st, sc);
  }

  uint32_t sw0, sw1, sw2, sw3;
  {
    uint32_t key[32];
#pragma unroll
    for (int i = 0; i < 32; ++i) {
      int j = i * 4 + quad;
      float sc = (i < ncs * 4) ? impl[i * 256 + tid] : 0.f;
      if (j == 0 || j == cur || j == cur - 1) sc = 1e4f;
      uint32_t k = (__float_as_uint(sc) & ~127u) | (uint32_t)(127 - j);
      key[i] = (j > cur) ? 0u : k;
    }
    uint32_t prev = 0xFFFFFFFFu;
    for (int r = 0; r < 16; ++r) {
      uint32_t mx = 0u;
#pragma unroll
      for (int i = 0; i < 32; ++i) {
        uint32_t k = key[i];
        k = (k < prev) ? k : 0u;
        mx = (k > mx) ? k : mx;
      }
      uint32_t o = shxu(mx, 16, lane);
      mx = (o > mx) ? o : mx;
      o = shxu(mx, 32, lane);
      mx = (o > mx) ? o : mx;
      prev = mx;
    }
    sw0 = 0u; sw1 = 0u; sw2 = 0u; sw3 = 0u;
#pragma unroll
    for (int i = 0; i < 32; ++i) {
      bool sel = (key[i] != 0u) && (key[i] >= prev);
      uint32_t bit = sel ? (1u << ((i & 7) * 4 + quad)) : 0u;
      if ((i >> 3) == 0) sw0 |= bit;
      else if ((i >> 3) == 1) sw1 |= bit;
      else if ((i >> 3) == 2) sw2 |= bit;
      else sw3 |= bit;
    }
    sw0 |= shxu(sw0, 16, lane); sw0 |= shxu(sw0, 32, lane);
    sw1 |= shxu(sw1, 16, lane); sw1 |= shxu(sw1, 32, lane);
    sw2 |= shxu(sw2, 16, lane); sw2 |= shxu(sw2, 32, lane);
    sw3 |= shxu(sw3, 16, lane); sw3 |= shxu(sw3, 32, lane);
  }

  st_reset(st);
  {
    const bf16_t* kb = zb + C_KS + g * 64;
    for (int s = 0; s <= cur; ++s) {
      tile64_gload(tid, rk0, rk1, kb + (size_t)s * 64 * ZS, ZS);
      tile64_gload(tid, rv0, rv1, vsT + s * 64, SEQ);
      __syncthreads();
      tile64_sstore(tid, Ks, rk0, rk1);
      tile64_sstore(tid, Vs, rv0, rv1);
      __syncthreads();
      uint32_t wsel = (s < 32) ? sw0 : (s < 64) ? sw1 : (s < 96) ? sw2 : sw3;
      bool sel = (wsel >> (s & 31)) & 1u;
      int hi = sel ? (tok - s * 64) : -1;
      if (__any(hi >= 0)) attn_compute<2>(lane, Ks, Vs, qf, st, invl, 0, hi, dA, dE);
    }
  }
  {
    float sc[4];
#pragma unroll
    for (int h = 0; h < 4; ++h) {
      float l = st.l[h];
      l += shx(l, 16, lane);
      l += shx(l, 32, lane);
      sc[h] = (l > 0.f) ? sigmoidf(bf2f(z[tokoff + C_GT + 1 * 8 + g * 4 + h])) / l : 0.f;
    }
    nsa_flush<false>(quad, z, ooff, st, sc);
  }

  st_reset(st);
  {
    const bf16_t* kb = zb + C_KW + g * 64;
    const int s0 = (cur >= 8) ? cur - 8 : 0;
    for (int s = s0; s <= cur; ++s) {
      tile64_gload(tid, rk0, rk1, kb + (size_t)s * 64 * ZS, ZS);
      tile64_gload(tid, rv0, rv1, vwT + s * 64, SEQ);
      __syncthreads();
      tile64_sstore(tid, Ks, rk0, rk1);
      tile64_sstore(tid, Vs, rv0, rv1);
      __syncthreads();
      attn_compute<2>(lane, Ks, Vs, qf, st, invl, tok - 511 - s * 64, tok - s * 64, dA, dE);
    }
  }
  {
    float sc[4];
#pragma unroll
    for (int h = 0; h < 4; ++h) {
      float l = st.l[h];
      l += shx(l, 16, lane);
      l += shx(l, 32, lane);
      sc[h] = (l > 0.f) ? sigmoidf(bf2f(z[tokoff + C_GT + 2 * 8 + g * 4 + h])) / l : 0.f;
    }
    nsa_flush<false>(quad, z, ooff, st, sc);
  }
}

DI void load128(int tid, bf16_t* lds, const bf16_t* base, size_t stride) {
  uint4 r[8];
#pragma unroll
  for (int i = 0; i < 8; ++i) {
    int idx = tid + 256 * i;
    int row = idx >> 4, ch = idx & 15;
    r[i] = *(const uint4*)(base + (size_t)row * stride + ch * 8);
  }
#pragma unroll
  for (int i = 0; i < 8; ++i) {
    int idx = tid + 256 * i;
    int row = idx >> 4, ch = idx & 15;
    *(uint4*)(lds + row * 128 + ((ch ^ (row & 15)) << 3)) = r[i];
  }
}

DI void ret_tile(const Params& p, int b, int h, int c, bf16_t* lds) {
  const int tid = TID(), lane = tid & 63, w = tid >> 6, quad = lane >> 4, col = lane & 15;
  const float lg2 = log2f(1.f - exp2f(-5.f - (float)h));
  bf16_t* z = (bf16_t*)(p.ws + O_Z);
  const bf16_t* rvT = (const bf16_t*)(p.ws + O_RVT);
  bf16_t* zc = z + ((size_t)(b * SEQ + c * 128)) * ZS;
  bf16x8 qf[2][4];
#pragma unroll
  for (int nt = 0; nt < 2; ++nt)
#pragma unroll
    for (int ks = 0; ks < 4; ++ks) {
      int n = 32 * w + nt * 16 + col;
      qf[nt][ks] = *(const bf16x8*)(zc + (size_t)n * ZS + C_RQ + h * 128 + ks * 32 + quad * 8);
    }
  f32x4 acc[8][2];
#pragma unroll
  for (int et = 0; et < 8; ++et)
#pragma unroll
    for (int nt = 0; nt < 2; ++nt) acc[et][nt] = f32x4{0.f, 0.f, 0.f, 0.f};
  __syncthreads();
  load128(tid, lds, zc + C_RV + h * 128, ZS);
  __syncthreads();
#pragma unroll
  for (int ks = 0; ks < 4; ++ks)
#pragma unroll
    for (int et = 0; et < 8; ++et) {
      int row = et * 16 + col;
      bf16x8 af = *(const bf16x8*)(lds + row * 128 + (((ks * 4 + quad) ^ (row & 15)) << 3));
#pragma unroll
      for (int nt = 0; nt < 2; ++nt) acc[et][nt] = mfma16(af, qf[nt][ks], acc[et][nt]);
    }
#pragma unroll
  for (int nt = 0; nt < 2; ++nt) {
    int n = 32 * w + nt * 16 + col;
    float xi = exp2f(lg2 * (float)(n + 1));
#pragma unroll
    for (int et = 0; et < 8; ++et) acc[et][nt] *= xi;
  }
  __syncthreads();
  load128(tid, lds, zc + C_RK + h * 128, ZS);
  __syncthreads();
  bf16x8 pf[2][4];
  {
    f32x4 s[8][2];
#pragma unroll
    for (int mt = 0; mt < 8; ++mt)
#pragma unroll
      for (int nt = 0; nt < 2; ++nt) s[mt][nt] = f32x4{0.f, 0.f, 0.f, 0.f};
#pragma unroll
    for (int ks = 0; ks < 4; ++ks)
#pragma unroll
      for (int mt = 0; mt < 8; ++mt) {
        if (mt <= 2 * w + 1) {
          int row = mt * 16 + col;
          bf16x8 af = *(const bf16x8*)(lds + row * 128 + (((ks * 4 + quad) ^ (row & 15)) << 3));
#pragma unroll
          for (int nt = 0; nt < 2; ++nt) s[mt][nt] = mfma16(af, qf[nt][ks], s[mt][nt]);
        }
      }
#pragma unroll
    for (int nt = 0; nt < 2; ++nt) {
      const int n = 32 * w + nt * 16 + col;
#pragma unroll
      for (int c2 = 0; c2 < 4; ++c2) {
        float v[8];
#pragma unroll
        for (int i = 0; i < 8; ++i) {
          const int mt = 2 * c2 + (i >> 2), j = i & 3;
          const int m = mt * 16 + quad * 4 + j;
          v[i] = (n >= m) ? s[mt][nt][j] * exp2f(lg2 * (float)(n - m)) : 0.f;
        }
        pf[nt][c2] = mk8(pack2(v[0], v[1]), pack2(v[2], v[3]), pack2(v[4], v[5]), pack2(v[6], v[7]));
      }
    }
  }
  __syncthreads();
  load128(tid, lds, rvT + ((size_t)((b * 4 + h) * 128)) * SEQ + c * 128, SEQ);
  __syncthreads();
#pragma unroll
  for (int c2 = 0; c2 < 4; ++c2) {
    if (2 * c2 <= 2 * w + 1) {
#pragma unroll
      for (int et = 0; et < 8; ++et) {
        int row = et * 16 + col;
        int sw = row & 15;
        uint2 a = *(const uint2*)(lds + row * 128 + (((4 * c2 + (quad >> 1)) ^ sw) << 3) + (quad & 1) * 4);
        uint2 bb = *(const uint2*)(lds + row * 128 + (((4 * c2 + 2 + (quad >> 1)) ^ sw) << 3) + (quad & 1) * 4);
        bf16x8 vf = mk8(a.x, a.y, bb.x, bb.y);
#pragma unroll
        for (int nt = 0; nt < 2; ++nt) acc[et][nt] = mfma16(vf, pf[nt][c2], acc[et][nt]);
      }
    }
  }
#pragma unroll
  for (int nt = 0; nt < 2; ++nt) {
    float ss = 0.f;
#pragma unroll
    for (int et = 0; et < 8; ++et)
#pragma unroll
      for (int j = 0; j < 4; ++j) ss += acc[et][nt][j] * acc[et][nt][j];
    ss += shx(ss, 16, lane);
    ss += shx(ss, 32, lane);
    const float rs = rsqrtf(ss * (1.f / 128.f) + 1e-6f);
    const int n = 32 * w + nt * 16 + col;
    bf16_t* zr = zc + (size_t)n * ZS;
#pragma unroll
    for (int et = 0; et < 8; ++et) {
      const int e0 = et * 16 + quad * 4;
      uint2 gv = *(const uint2*)(zr + C_RG + h * 128 + e0);
      float g0 = bflo(gv.x), g1 = bfhi(gv.x), g2 = bflo(gv.y), g3 = bfhi(gv.y);
      uint2 o;
      o.x = pack2(acc[et][nt][0] * rs * g0 * sigmoidf(g0), acc[et][nt][1] * rs * g1 * sigmoidf(g1));
      o.y = pack2(acc[et][nt][2] * rs * g2 * sigmoidf(g2), acc[et][nt][3] * rs * g3 * sigmoidf(g3));
      *(uint2*)(zr + C_RQ + h * 128 + e0) = o;
    }
  }
}

__global__ void __launch_bounds__(256, 1) mega(Params p) {
  __shared__ __attribute__((aligned(16))) bf16_t lds[32768];
  cg::grid_group grid = cg::this_grid();
  const int nb = gridDim.x;
  bf16_t* wt = (bf16_t*)(p.ws + O_WT);
  bf16_t* z = (bf16_t*)(p.ws + O_Z);
  bf16_t* hbuf = (bf16_t*)(p.ws + O_VST);
  bf16_t* ubuf = z;
  bf16_t* p16 = z;
  bf16_t* hid = (bf16_t*)(p.ws + O_HID);
  const float* bias = (const float*)(p.ws + O_BIAS);

  phase0(p);
  grid.sync();

  for (int layer = 0; layer < 2; ++layer) {
    const bf16_t* wl = wt + (size_t)layer * W_LAYER;
    const float* xin = (layer == 0) ? p.x : p.out;

    norm_phase(xin, p.norm_mix + layer * DM, hbuf);
    grid.sync();

    for (int t = blockIdx.x; t < 256 * 43; t += nb) {
      const int mt = t / 43, ntile = t % 43;
      const int m0 = mt * 128, n0 = ntile * 128;
      f32x4 acc[4][4];
      zero_acc(acc);
      gemm_accum(acc, RowPtr{hbuf + (size_t)m0 * DM, DM}, RowPtr{wl + W_IN + (size_t)n0 * 1024, 1024}, 16, lds);
      gemm_epi(acc, m0, n0, [&](int m, int n, f32x4& a) {
        if (n < ZS) {
          uint2 u;
          u.x = pack2(a[0], a[1]);
          u.y = pack2(a[2], a[3]);
          *(uint2*)(z + (size_t)m * ZS + n) = u;
        }
      });
    }
    grid.sync();

    post_z(p, layer);
    grid.sync();

    for (int t = blockIdx.x; t < 128 + 1024; t += nb) {
      f32x4 acc[4][4];
      zero_acc(acc);
      if (t < 128) {
        const int kv = t >> 6, mt = (t >> 1) & 31, ntile = t & 1;
        const int m0 = mt * 128, n0 = ntile * 128;
        const int colbase = kv ? C_VC : C_KC;
        auto ap = [&](int r, int kb) -> const bf16_t* {
          int row = m0 + r;
          int bg = row >> 9, c = row & 511;
          int tk = 16 * c + kb;
          tk = tk > (SEQ - 1) ? (SEQ - 1) : tk;
          return z + ((size_t)((bg >> 1) * SEQ + tk)) * ZS + colbase + (bg & 1) * 64;
        };
        gemm_accum(acc, ap, RowPtr{wl + (kv ? W_C1V : W_C1K) + (size_t)n0 * 2048, 2048}, 32, lds);
        const float* bs = bias + layer * 512 + kv * 256;
        bf16_t* hd = hid + (size_t)kv * 4096 * 256;
        gemm_epi(acc, m0, n0, [&](int m, int n, f32x4& a) {
          float o[4];
#pragma unroll
          for (int j = 0; j < 4; ++j) {
            float xv = a[j] + bs[n + j];
            float y = 0.7978845608028654f * (xv + 0.044715f * xv * xv * xv);
            float th = 1.f - 2.f / (__expf(2.f * y) + 1.f);
            o[j] = 0.5f * xv * (1.f + th);
          }
          uint2 u;
          u.x = pack2(o[0], o[1]);
          u.y = pack2(o[2], o[3]);
          *(uint2*)(hd + (size_t)m * 256 + n) = u;
        });
      } else {
        const int idx = t - 128;
        const int c = idx & 63, bh = idx >> 6;
        const bf16_t* rvT = (const bf16_t*)(p.ws + O_RVT) + ((size_t)bh * 128) * SEQ + c * 128;
        const bf16_t* kzT = (const bf16_t*)(p.ws + O_KZT) + ((size_t)bh * 128) * SEQ + c * 128;
        gemm_accum(acc, RowPtr{rvT, SEQ}, RowPtr{kzT, SEQ}, 2, lds);
        bf16_t* dst = z + ((size_t)((bh >> 2) * SEQ + c * 128)) * ZS + C_RV + (bh & 3) * 128;
        gemm_epi(acc, 0, 0, [&](int m, int n, f32x4& a) {
          uint2 u;
          u.x = pack2(a[0], a[1]);
          u.y = pack2(a[2], a[3]);
          *(uint2*)(dst + (size_t)m * ZS + n) = u;
        });
      }
    }
    grid.sync();

    phase4b(p, layer);
    grid.sync();

    for (int t = blockIdx.x; t < 2048; t += nb) {
      if (t < 1024) {
        const int tile = 127 - (t >> 3), bg = t & 7;
        nsa_tile(p, bg >> 1, bg & 1, tile, lds);
      } else {
        const int idx = t - 1024;
        ret_tile(p, idx >> 8, (idx >> 6) & 3, idx & 63, lds);
      }
    }
    grid.sync();

    for (int t = blockIdx.x; t < 256 * 8; t += nb) {
      const int mt = t >> 3, ntile = t & 7;
      const int m0 = mt * 128, n0 = ntile * 128;
      f32x4 acc[4][4];
      zero_acc(acc);
      gemm_accum(acc, RowPtr{z + (size_t)m0 * ZS + C_Q, ZS}, RowPtr{wl + W_UPA + (size_t)n0 * 512, 512}, 8, lds);
      gemm_epi(acc, m0, n0, [&](int m, int n, f32x4& a) {
        uint2 ua = *(const uint2*)(z + (size_t)m * ZS + C_MA + n);
        uint2 ub = *(const uint2*)(z + (size_t)m * ZS + C_MB + n);
        a[0] *= sigmoidf(bflo(ua.x)) / sigmoidf(bflo(ub.x));
        a[1] *= sigmoidf(bfhi(ua.x)) / sigmoidf(bfhi(ub.x));
        a[2] *= sigmoidf(bflo(ua.y)) / sigmoidf(bflo(ub.y));
        a[3] *= sigmoidf(bfhi(ua.y)) / sigmoidf(bfhi(ub.y));
      });
      gemm_accum(acc, RowPtr{z + (size_t)m0 * ZS + C_RQ, ZS}, RowPtr{wl + W_UPR + (size_t)n0 * 512, 512}, 8, lds);
      gemm_epi(acc, m0, n0, [&](int m, int n, f32x4& a) {
        uint2 ub = *(const uint2*)(z + (size_t)m * ZS + C_MB + n);
        uint2 u;
        u.x = pack2(a[0] * sigmoidf(bflo(ub.x)), a[1] * sigmoidf(bfhi(ub.x)));
        u.y = pack2(a[2] * sigmoidf(bflo(ub.y)), a[3] * sigmoidf(bfhi(ub.y)));
        *(uint2*)(z + (size_t)m * ZS + C_RK + n) = u;
      });
    }
    grid.sync();

    for (int t = blockIdx.x; t < 256 * 8; t += nb) {
      const int mt = t >> 3, ntile = t & 7;
      const int m0 = mt * 128, n0 = ntile * 128;
      f32x4 acc[4][4];
      zero_acc(acc);
      gemm_accum(acc, RowPtr{z + (size_t)m0 * ZS + C_RK, ZS}, RowPtr{wl + W_OUT + (size_t)n0 * 1024, 1024}, 16, lds);
      gemm_epi(acc, m0, n0, [&](int m, int n, f32x4& a) {
        float4 xv = *(const float4*)(xin + (size_t)m * DM + n);
        *(float4*)(p.out + (size_t)m * DM + n) = make_float4(xv.x + a[0], xv.y + a[1], xv.z + a[2], xv.w + a[3]);
      });
    }
    grid.sync();

    norm_phase(p.out, p.norm_mlp + layer * DM, hbuf);
    grid.sync();

    for (int t = blockIdx.x; t < 256 * 32; t += nb) {
      const int mt = t >> 5, ntile = t & 31;
      const int m0 = mt * 128, n0 = ntile * 128;
      f32x4 acc[4][4];
      zero_acc(acc);
      gemm_accum(acc, RowPtr{hbuf + (size_t)m0 * DM, DM}, RowPtr{wl + W_FF1 + (size_t)n0 * 1024, 1024}, 16, lds);
      gemm_epi(acc, m0, n0, [&](int m, int n, f32x4& a) {
        float r0 = fmaxf(a[0], 0.f), r1 = fmaxf(a[1], 0.f), r2 = fmaxf(a[2], 0.f), r3 = fmaxf(a[3], 0.f);
        uint2 u;
        u.x = pack2(r0 * r0, r1 * r1);
        u.y = pack2(r2 * r2, r3 * r3);
        *(uint2*)(ubuf + (size_t)m * 4096 + n) = u;
      });
    }
    grid.sync();

    for (int t = blockIdx.x; t < 256 * 8; t += nb) {
      const int mt = t >> 3, ntile = t & 7;
      const int m0 = mt * 128, n0 = ntile * 128;
      f32x4 acc[4][4];
      zero_acc(acc);
      gemm_accum(acc, RowPtr{ubuf + (size_t)m0 * 4096, 4096}, RowPtr{wl + W_FF2 + (size_t)n0 * 4096, 4096}, 64, lds);
      gemm_epi(acc, m0, n0, [&](int m, int n, f32x4& a) {
        float4* o = (float4*)(p.out + (size_t)m * DM + n);
        float4 xv = *o;
        *o = make_float4(xv.x + a[0], xv.y + a[1], xv.z + a[2], xv.w + a[3]);
      });
    }
    grid.sync();

    norm_phase(p.out, p.norm_ple + layer * DM, hbuf);
    {
      const float* pl = p.p + (size_t)layer * T_TOK * 256;
      const int gtid = blockIdx.x * 256 + TID();
      const int gthreads = nb * 256;
      for (int i = gtid; i < T_TOK * 32; i += gthreads) {
        float4 a = ((const float4*)pl)[2 * i], b2 = ((const float4*)pl)[2 * i + 1];
        ((uint4*)p16)[i] = make_uint4(pack2(a.x, a.y), pack2(a.z, a.w), pack2(b2.x, b2.y), pack2(b2.z, b2.w));
      }
    }
    grid.sync();

    for (int t = blockIdx.x; t < 256 * 8; t += nb) {
      const int mt = t >> 3, ntile = t & 7;
      const int m0 = mt * 128, n0 = ntile * 128;
      f32x4 acc[4][4];
      zero_acc(acc);
      gemm_accum(acc, RowPtr{p16 + (size_t)m0 * 256, 256}, RowPtr{wl + W_PLE + (size_t)n0 * 256, 256}, 4, lds);
      uint2 pp[4][4];
#pragma unroll
      for (int i = 0; i < 4; ++i)
#pragma unroll
        for (int j = 0; j < 4; ++j) {
          pp[i][j].x = pack2(acc[i][j][0], acc[i][j][1]);
          pp[i][j].y = pack2(acc[i][j][2], acc[i][j][3]);
        }
      zero_acc(acc);
      gemm_accum(acc, RowPtr{hbuf + (size_t)m0 * DM, DM}, RowPtr{wl + W_PG + (size_t)n0 * 1024, 1024}, 16, lds);
      {
        const int tid_ = TID();
        const int lane = tid_ & 63, w = tid_ >> 6;
        const int wm = w >> 1, wn = w & 1;
#pragma unroll
        for (int i = 0; i < 4; ++i)
#pragma unroll
          for (int j = 0; j < 4; ++j) {
            int m = m0 + wm * 64 + i * 16 + (lane & 15);
            int n = n0 + wn * 64 + j * 16 + (lane >> 4) * 4;
            float4* o = (float4*)(p.out + (size_t)m * DM + n);
            float4 xv = *o;
            f32x4 a = acc[i][j];
            *o = make_float4(xv.x + sigmoidf(a[0]) * bflo(pp[i][j].x), xv.y + sigmoidf(a[1]) * bfhi(pp[i][j].x),
                             xv.z + sigmoidf(a[2]) * bflo(pp[i][j].y), xv.w + sigmoidf(a[3]) * bfhi(pp[i][j].y));
          }
      }
    }
    grid.sync();
  }
}

extern "C" void kernel_launch(void* const* d_in, const int* in_sizes, int n_in,
                              void* d_out, int out_size, void* d_ws, size_t ws_size,
                              hipStream_t stream) {
  static int grid_blocks = 0;
  if (!grid_blocks) {
    int dev = 0, cus = 0, per_cu = 0;
    hipGetDevice(&dev);
    hipDeviceGetAttribute(&cus, hipDeviceAttributeMultiprocessorCount, dev);
    hipOccupancyMaxActiveBlocksPerMultiprocessor(&per_cu, mega, 256, 0);
    if (per_cu > 1) per_cu = 1;
    if (per_cu < 1) per_cu = 1;
    grid_blocks = cus * per_cu;
  }
  if (ws_size < WS_NEED) {
    fprintf(stderr, "workspace too small: %zu < %llu\n", ws_size, (unsigned long long)WS_NEED);
    return;
  }
  Params p{};
  p.x = (const float*)d_in[0]; p.p = (const float*)d_in[1]; p.norm_mix = (const float*)d_in[2]; p.w_in = (const float*)d_in[3];
  p.nsa_q_norm = (const float*)d_in[4]; p.nsa_k_norm = (const float*)d_in[5]; p.cmp_pos_k = (const float*)d_in[6];
  p.cmp_pos_v = (const float*)d_in[7]; p.cmp_w1_k = (const float*)d_in[8]; p.cmp_w2_k = (const float*)d_in[9];
  p.cmp_w1_v = (const float*)d_in[10]; p.cmp_w2_v = (const float*)d_in[11]; p.w_up_nsa = (const float*)d_in[12];
  p.w_up_ret = (const float*)d_in[13]; p.w_out = (const float*)d_in[14]; p.norm_mlp = (const float*)d_in[15];
  p.w_ff1 = (const float*)d_in[16]; p.w_ff2 = (const float*)d_in[17]; p.norm_ple = (const float*)d_in[18];
  p.w_ple = (const float*)d_in[19]; p.w_ple_gate = (const float*)d_in[20];
  p.out = (float*)d_out; p.ws = (char*)d_ws;
  void* args[] = {&p};
  hipError_t e = hipLaunchCooperativeKernel((void*)mega, dim3(grid_blocks), dim3(256), args, 0, stream);
  if (e != hipSuccess) fprintf(stderr, "cooperative launch failed: %s (grid %d)\n", hipGetErrorString(e), grid_blocks);
}
```

```cpp
#include <hip/hip_runtime.h>
#include <hip/hip_cooperative_groups.h>
#include <cstdio>
#include <cstdint>
namespace cg = cooperative_groups;

typedef __attribute__((ext_vector_type(8))) short bf16x8;
typedef __attribute__((ext_vector_type(4))) float f32x4;
typedef unsigned short bf16_t;
typedef __attribute__((ext_vector_type(4))) unsigned u32x4;
#define DI __device__ __forceinline__

#define T_TOK 32768
#define SEQ 8192
#define DM 1024
#define ZS 5400
#define C_Q 0
#define C_KC 512
#define C_VC 640
#define C_KS 768
#define C_VS 896
#define C_KW 1024
#define C_VW 1152
#define C_GT 1280
#define C_RQ 1304
#define C_RK 1816
#define C_RV 2328
#define C_RG 2840
#define C_MA 3352
#define C_MB 4376
#define NPAD_IN 5504

#define W_IN 0
#define W_C1K 5636096
#define W_C1V 6160384
#define W_UPA 6684672
#define W_UPR 7208960
#define W_OUT 7733248
#define W_FF1 8781824
#define W_FF2 12976128
#define W_PLE 17170432
#define W_PG 17432576
#define W_LAYER 18481152

#define O_WT 0ull
#define O_ROPE 36962304ull
#define O_BIAS 41156608ull
#define O_HID 41160704ull
#define O_KCMP 45355008ull
#define O_VCMPT 45879296ull
#define O_VST 46403584ull
#define O_VWT 54792192ull
#define O_RVT 63180800ull
#define O_KZT 96735232ull
#define O_Z 130289664ull
#define O_ONSA 484184064ull
#define WS_NEED 517738496ull

struct Params {
  const float* x; const float* p; const float* norm_mix; const float* w_in;
  const float* nsa_q_norm; const float* nsa_k_norm; const float* cmp_pos_k; const float* cmp_pos_v;
  const float* cmp_w1_k; const float* cmp_w2_k; const float* cmp_w1_v; const float* cmp_w2_v;
  const float* w_up_nsa; const float* w_up_ret; const float* w_out; const float* norm_mlp;
  const float* w_ff1; const float* w_ff2; const float* norm_ple; const float* w_ple; const float* w_ple_gate;
  float* out; char* ws;
};

DI unsigned pack2(float a, float b) {
  typedef __attribute__((ext_vector_type(2))) __bf16 bf2;
  typedef __attribute__((ext_vector_type(2))) float f2;
  f2 v = {a, b};
  bf2 r = __builtin_convertvector(v, bf2);
  return __builtin_bit_cast(unsigned, r);
}
DI bf16_t f2bf(float a) { return (bf16_t)(pack2(a, 0.f) & 0xffffu); }
DI float bf2f(bf16_t h) { return __uint_as_float(((unsigned)h) << 16); }
DI float bflo(unsigned u) { return __uint_as_float(u << 16); }
DI float bfhi(unsigned u) { return __uint_as_float(u & 0xffff0000u); }
DI float shx(float v, int mask, int lane) {
  return __int_as_float(__builtin_amdgcn_ds_bpermute((lane ^ mask) << 2, __float_as_int(v)));
}
DI uint32_t shxu(uint32_t v, int mask, int lane) {
  return (uint32_t)__builtin_amdgcn_ds_bpermute((lane ^ mask) << 2, (int)v);
}
DI float shfrom(float v, int srclane) {
  return __int_as_float(__builtin_amdgcn_ds_bpermute(srclane << 2, __float_as_int(v)));
}
DI float wave_sum(float v, int lane) {
#pragma unroll
  for (int o = 32; o > 0; o >>= 1) v += shx(v, o, lane);
  return v;
}
DI int TID() { int t = threadIdx.x; asm volatile("" : "+v"(t)); return t; }
DI float sigmoidf(float x) { return 1.f / (1.f + __expf(-x)); }
DI f32x4 mfma16(bf16x8 a, bf16x8 b, f32x4 c) { return __builtin_amdgcn_mfma_f32_16x16x32_bf16(a, b, c, 0, 0, 0); }
DI bf16x8 mk8(unsigned a, unsigned b, unsigned c, unsigned d) {
  uint4 u = make_uint4(a, b, c, d);
  return __builtin_bit_cast(bf16x8, u);
}

template <class AP, class BP>
DI void g_load(u32x4 (&ra)[4], u32x4 (&rb)[4], const AP& ap, const BP& bp, int kb, int lrow, int lch) {
#pragma unroll
  for (int i = 0; i < 4; ++i) {
    ra[i] = *(const u32x4*)(ap(lrow + 32 * i, kb) + lch * 8);
    rb[i] = *(const u32x4*)(bp(lrow + 32 * i, kb) + lch * 8);
  }
}
DI void g_store(bf16_t* As, bf16_t* Bs, const u32x4 (&ra)[4], const u32x4 (&rb)[4], int buf, int lrow, int lch) {
#pragma unroll
  for (int i = 0; i < 4; ++i) {
    int r = lrow + 32 * i;
    int off = buf * 8192 + r * 64 + ((lch ^ ((r >> 1) & 7)) << 3);
    *(u32x4*)(As + off) = ra[i];
    *(u32x4*)(Bs + off) = rb[i];
  }
}
DI void g_compute(f32x4 (&acc)[4][4], const bf16_t* a, const bf16_t* b, int wm, int wn, int lane) {
#pragma unroll
  for (int ks = 0; ks < 2; ++ks) {
    bf16x8 af[4], bfr[4];
#pragma unroll
    for (int i = 0; i < 4; ++i) {
      int r = wm * 64 + i * 16 + (lane & 15);
      af[i] = *(const bf16x8*)(a + r * 64 + (((ks * 4 + (lane >> 4)) ^ ((r >> 1) & 7)) << 3));
      int r2 = wn * 64 + i * 16 + (lane & 15);
      bfr[i] = *(const bf16x8*)(b + r2 * 64 + (((ks * 4 + (lane >> 4)) ^ ((r2 >> 1) & 7)) << 3));
    }
#pragma unroll
    for (int i = 0; i < 4; ++i)
#pragma unroll
      for (int j = 0; j < 4; ++j) acc[i][j] = mfma16(bfr[j], af[i], acc[i][j]);
  }
}
template <class AP, class BP>
DI void gemm_accum(f32x4 (&acc)[4][4], AP ap, BP bp, int nkb, bf16_t* lds) {
  const int tid = TID(), lane = tid & 63, w = tid >> 6;
  const int wm = w >> 1, wn = w & 1;
  const int lrow = tid >> 3, lch = tid & 7;
  bf16_t* As = lds;
  bf16_t* Bs = lds + 16384;
  u32x4 ra0[4], rb0[4], ra1[4], rb1[4];
  __syncthreads();
  g_load(ra0, rb0, ap, bp, 0, lrow, lch);
  g_load(ra1, rb1, ap, bp, 1, lrow, lch);
  g_store(As, Bs, ra0, rb0, 0, lrow, lch);
  __syncthreads();
  for (int kb = 0; kb < nkb; kb += 2) {
    if (kb + 2 < nkb) g_load(ra0, rb0, ap, bp, kb + 2, lrow, lch);
    g_compute(acc, As, Bs, wm, wn, lane);
    g_store(As, Bs, ra1, rb1, 1, lrow, lch);
    __syncthreads();
    if (kb + 3 < nkb) g_load(ra1, rb1, ap, bp, kb + 3, lrow, lch);
    g_compute(acc, As + 8192, Bs + 8192, wm, wn, lane);
    if (kb + 2 < nkb) g_store(As, Bs, ra0, rb0, 0, lrow, lch);
    __syncthreads();
  }
}
template <class E>
DI void gemm_epi(f32x4 (&acc)[4][4], int m0, int n0, E e) {
  const int tid_ = TID();
  const int lane = tid_ & 63, w = tid_ >> 6;
  const int wm = w >> 1, wn = w & 1;
#pragma unroll
  for (int i = 0; i < 4; ++i)
#pragma unroll
    for (int j = 0; j < 4; ++j) {
      int m = m0 + wm * 64 + i * 16 + (lane & 15);
      int n = n0 + wn * 64 + j * 16 + (lane >> 4) * 4;
      e(m, n, acc[i][j]);
    }
}
DI void zero_acc(f32x4 (&acc)[4][4]) {
#pragma unroll
  for (int i = 0; i < 4; ++i)
#pragma unroll
    for (int j = 0; j < 4; ++j) acc[i][j] = f32x4{0.f, 0.f, 0.f, 0.f};
}
struct RowPtr {
  const bf16_t* base; size_t ld;
  DI const bf16_t* operator()(int r, int kb) const { return base + (size_t)r * ld + kb * 64; }
};

DI void convert_wt(const float* W, bf16_t* Wt, int K, int N, int Npad, int gtid, int gthreads) {
  const int k8n = K >> 3;
  const long total = (long)Npad * k8n;
  for (long idx = gtid; idx < total; idx += gthreads) {
    int n = (int)(idx % Npad);
    int k8 = (int)(idx / Npad);
    uint4 o = make_uint4(0, 0, 0, 0);
    if (n < N) {
      const float* s = W + (size_t)(k8 * 8) * N + n;
      float v0 = s[0], v1 = s[(size_t)N], v2 = s[(size_t)2 * N], v3 = s[(size_t)3 * N];
      float v4 = s[(size_t)4 * N], v5 = s[(size_t)5 * N], v6 = s[(size_t)6 * N], v7 = s[(size_t)7 * N];
      o = make_uint4(pack2(v0, v1), pack2(v2, v3), pack2(v4, v5), pack2(v6, v7));
    }
    *(uint4*)(Wt + (size_t)n * K + k8 * 8) = o;
  }
}

DI void phase0(const Params& p, const int L) {
  const int gtid = blockIdx.x * 256 + TID();
  const int gthreads = gridDim.x * 256;
  bf16_t* wl = (bf16_t*)(p.ws + O_WT);
  convert_wt(p.w_in + (size_t)L * 1024 * 5400, wl + W_IN, 1024, 5400, NPAD_IN, gtid, gthreads);
  convert_wt(p.cmp_w1_k + (size_t)L * 2048 * 256, wl + W_C1K, 2048, 256, 256, gtid, gthreads);
  convert_wt(p.cmp_w1_v + (size_t)L * 2048 * 256, wl + W_C1V, 2048, 256, 256, gtid, gthreads);
  convert_wt(p.w_up_nsa + (size_t)L * 512 * 1024, wl + W_UPA, 512, 1024, 1024, gtid, gthreads);
  convert_wt(p.w_up_ret + (size_t)L * 512 * 1024, wl + W_UPR, 512, 1024, 1024, gtid, gthreads);
  convert_wt(p.w_out + (size_t)L * 1024 * 1024, wl + W_OUT, 1024, 1024, 1024, gtid, gthreads);
  convert_wt(p.w_ff1 + (size_t)L * 1024 * 4096, wl + W_FF1, 1024, 4096, 4096, gtid, gthreads);
  convert_wt(p.w_ff2 + (size_t)L * 4096 * 1024, wl + W_FF2, 4096, 1024, 1024, gtid, gthreads);
  convert_wt(p.w_ple + (size_t)L * 256 * 1024, wl + W_PLE, 256, 1024, 1024, gtid, gthreads);
  convert_wt(p.w_ple_gate + (size_t)L * 1024 * 1024, wl + W_PG, 1024, 1024, 1024, gtid, gthreads);
  if (L == 0) {
    float2* rope = (float2*)(p.ws + O_ROPE);
    for (int idx = gtid; idx < SEQ * 64; idx += gthreads) {
      int pos = idx >> 6, j = idx & 63;
      float inv = exp2f(-(float)j * (13.287712379549449f / 64.f));
      float ang = (float)pos * inv;
      double rev = (double)ang * 0.15915494309189535;
      rev -= rint(rev);
      float fr = (float)rev;
      rope[idx] = make_float2(__builtin_amdgcn_cosf(fr), __builtin_amdgcn_sinf(fr));
    }
  }
  float* bias = (float*)(p.ws + O_BIAS);
  for (int idx = gtid; idx < 512; idx += gthreads) {
    int n = idx & 255, kv = idx >> 8;
    const float* pos = (kv ? p.cmp_pos_v : p.cmp_pos_k) + L * 2048;
    const float* w1 = (kv ? p.cmp_w1_v : p.cmp_w1_k) + (size_t)L * 2048 * 256;
    float a = 0.f;
    for (int k = 0; k < 2048; ++k) a += pos[k] * w1[(size_t)k * 256 + n];
    bias[idx] = a;
  }
}

DI void norm_phase(const float* xin, const float* g, bf16_t* h) {
  const int tid_ = TID();
  const int lane = tid_ & 63;
  const int gw = (blockIdx.x * 256 + tid_) >> 6;
  const int nw = gridDim.x * 4;
  float4 gv[4];
#pragma unroll
  for (int i = 0; i < 4; ++i) gv[i] = ((const float4*)g)[i * 64 + lane];
  for (int row = gw; row < T_TOK; row += nw) {
    const float4* xr = (const float4*)(xin + (size_t)row * DM);
    float4 v[4];
    float ss = 0.f;
#pragma unroll
    for (int i = 0; i < 4; ++i) {
      v[i] = xr[i * 64 + lane];
      ss += v[i].x * v[i].x + v[i].y * v[i].y + v[i].z * v[i].z + v[i].w * v[i].w;
    }
    ss = wave_sum(ss, lane);
    float rs = rsqrtf(ss * (1.f / 1024.f) + 1e-6f);
    uint2* hr = (uint2*)(h + (size_t)row * DM);
#pragma unroll
    for (int i = 0; i < 4; ++i) {
      uint2 o;
      o.x = pack2(v[i].x * rs * gv[i].x, v[i].y * rs * gv[i].y);
      o.y = pack2(v[i].z * rs * gv[i].z, v[i].w * rs * gv[i].w);
      hr[i * 64 + lane] = o;
    }
  }
}

DI void post_z(const Params& p, int layer) {
  const int tid_ = TID();
  const int lane = tid_ & 63;
  const int gw = (blockIdx.x * 256 + tid_) >> 6;
  const int nw = gridDim.x * 4;
  bf16_t* z = (bf16_t*)(p.ws + O_Z);
  bf16_t* vsT = (bf16_t*)(p.ws + O_VST);
  bf16_t* vwT = (bf16_t*)(p.ws + O_VWT);
  bf16_t* rvT = (bf16_t*)(p.ws + O_RVT);
  bf16_t* kzT = (bf16_t*)(p.ws + O_KZT);
  const float2* rope = (const float2*)(p.ws + O_ROPE);
  const float* qn = p.nsa_q_norm + layer * 64;
  const float* kn = p.nsa_k_norm + layer * 64;
  for (int item = gw; item < 4096 * 32; item += nw) {
    const int slab = item & 31, tc = item >> 5;
    const int tok0 = tc * 8;
    const int b = tok0 >> 13, spos = tok0 & 8191;
    bf16_t* zr = z + (size_t)tok0 * ZS;
    if (slab < 12) {
      int colbase; const float* g; float sc;
      if (slab < 8) { colbase = C_Q + slab * 64; g = qn; sc = 0.125f; }
      else if (slab < 10) { colbase = C_KS + (slab - 8) * 64; g = kn; sc = 1.f; }
      else { colbase = C_KW + (slab - 10) * 64; g = kn; sc = 1.f; }
      const float gv = g[lane] * sc;
#pragma unroll
      for (int i = 0; i < 8; ++i) {
        bf16_t* ptr = zr + (size_t)i * ZS + colbase + lane;
        float v = bf2f(*ptr);
        float ss = wave_sum(v * v, lane);
        float rs = rsqrtf(ss * (1.f / 64.f) + 1e-6f);
        *ptr = f2bf(v * rs * gv);
      }
    } else if (slab < 16) {
      const int gi = slab & 1;
      const bool isw = slab >= 14;
      const int colbase = (isw ? C_VW : C_VS) + gi * 64;
      bf16_t* dst = (isw ? vwT : vsT) + ((size_t)((b * 2 + gi) * 64 + lane)) * SEQ + spos;
      unsigned u[8];
#pragma unroll
      for (int i = 0; i < 8; ++i) u[i] = zr[(size_t)i * ZS + colbase + lane];
      *(uint4*)dst = make_uint4(u[0] | (u[1] << 16), u[2] | (u[3] << 16), u[4] | (u[5] << 16), u[6] | (u[7] << 16));
    } else if (slab < 20) {
      const int h = slab - 16;
      const int colbase = C_RQ + h * 128;
#pragma unroll
      for (int i = 0; i < 8; ++i) {
        bf16_t* p1 = zr + (size_t)i * ZS + colbase + lane;
        float x1 = bf2f(p1[0]), x2 = bf2f(p1[64]);
        float2 cs = rope[(spos + i) * 64 + lane];
        p1[0] = f2bf(x1 * cs.x - x2 * cs.y);
        p1[64] = f2bf(x1 * cs.y + x2 * cs.x);
      }
    } else if (slab < 24) {
      const int h = slab - 20;
      const int colbase = C_RK + h * 128;
      const float lg2 = log2f(1.f - exp2f(-5.f - (float)h));
      unsigned u1[8], u2[8];
#pragma unroll
      for (int i = 0; i < 8; ++i) {
        bf16_t* p1 = zr + (size_t)i * ZS + colbase + lane;
        float x1 = bf2f(p1[0]), x2 = bf2f(p1[64]);
        float2 cs = rope[(spos + i) * 64 + lane];
        float o1 = (x1 * cs.x - x2 * cs.y) * 0.08838834764831845f;
        float o2 = (x1 * cs.y + x2 * cs.x) * 0.08838834764831845f;
        p1[0] = f2bf(o1);
        p1[64] = f2bf(o2);
        float zeta = exp2f(lg2 * (float)(127 - ((spos + i) & 127)));
        u1[i] = f2bf(o1 * zeta);
        u2[i] = f2bf(o2 * zeta);
      }
      bf16_t* d1 = kzT + ((size_t)((b * 4 + h) * 128 + lane)) * SEQ + spos;
      *(uint4*)d1 = make_uint4(u1[0] | (u1[1] << 16), u1[2] | (u1[3] << 16), u1[4] | (u1[5] << 16), u1[6] | (u1[7] << 16));
      *(uint4*)(d1 + (size_t)64 * SEQ) = make_uint4(u2[0] | (u2[1] << 16), u2[2] | (u2[3] << 16), u2[4] | (u2[5] << 16), u2[6] | (u2[7] << 16));
    } else {
      const int s8 = slab - 24;
      const int h = s8 >> 1, half = s8 & 1;
      const int colbase = C_RV + s8 * 64;
      bf16_t* dst = rvT + ((size_t)((b * 4 + h) * 128 + half * 64 + lane)) * SEQ + spos;
      unsigned u[8];
#pragma unroll
      for (int i = 0; i < 8; ++i) u[i] = zr[(size_t)i * ZS + colbase + lane];
      *(uint4*)dst = make_uint4(u[0] | (u[1] << 16), u[2] | (u[3] << 16), u[4] | (u[5] << 16), u[6] | (u[7] << 16));
    }
  }
}

DI void phase4b(const Params& p, int layer) {
  const int tid_ = TID();
  const int lane = tid_ & 63;
  const int gw = (blockIdx.x * 256 + tid_) >> 6;
  const int nw = gridDim.x * 4;
  bf16_t* z = (bf16_t*)(p.ws + O_Z);
  const bf16_t* hid = (const bf16_t*)(p.ws + O_HID);
  bf16_t* kcmp = (bf16_t*)(p.ws + O_KCMP);
  bf16_t* vcmpT = (bf16_t*)(p.ws + O_VCMPT);
  const float* kn = p.nsa_k_norm + layer * 64;
  for (int item = gw; item < 8192; item += nw) {
    const int kv = item >> 12, row = item & 4095;
    const bf16_t* hrow = hid + ((size_t)kv * 4096 + row) * 256;
    const float* w2 = (kv ? p.cmp_w2_v : p.cmp_w2_k) + (size_t)layer * 256 * 64;
    float acc = 0.f;
    for (int k8 = 0; k8 < 32; ++k8) {
      uint4 hv = *(const uint4*)(hrow + k8 * 8);
      const float* wr = w2 + (size_t)(k8 * 8) * 64 + lane;
      acc += bflo(hv.x) * wr[0];
      acc += bfhi(hv.x) * wr[64];
      acc += bflo(hv.y) * wr[128];
      acc += bfhi(hv.y) * wr[192];
      acc += bflo(hv.z) * wr[256];
      acc += bfhi(hv.z) * wr[320];
      acc += bflo(hv.w) * wr[384];
      acc += bfhi(hv.w) * wr[448];
    }
    if (kv == 0) {
      float ss = wave_sum(acc * acc, lane);
      float rs = rsqrtf(ss * (1.f / 64.f) + 1e-6f);
      kcmp[(size_t)row * 64 + lane] = f2bf(acc * rs * kn[lane]);
    } else {
      const int bg = row >> 9, c = row & 511;
      vcmpT[((size_t)(bg * 64 + lane)) * 512 + c] = f2bf(acc);
    }
  }
  const int gtid = blockIdx.x * 256 + tid_;
  const int gthreads = gridDim.x * 256;
  for (int idx = gtid; idx < 65536; idx += gthreads) {
    const int d4 = idx & 31, e = (idx >> 5) & 127, h = (idx >> 12) & 3, b = idx >> 14;
    const float lg2 = log2f(1.f - exp2f(-5.f - (float)h));
    const float gch = exp2f(lg2 * 128.f);
    float r0 = 0.f, r1 = 0.f, r2 = 0.f, r3 = 0.f;
    bf16_t* ptr = z + ((size_t)(b * SEQ + e)) * ZS + C_RV + h * 128 + d4 * 4;
    for (int c = 0; c < 64; ++c) {
      uint2* q = (uint2*)(ptr + (size_t)c * 128 * ZS);
      uint2 v = *q;
      uint2 o;
      o.x = pack2(r0, r1);
      o.y = pack2(r2, r3);
      *q = o;
      r0 = gch * r0 + bflo(v.x);
      r1 = gch * r1 + bfhi(v.x);
      r2 = gch * r2 + bflo(v.y);
      r3 = gch * r3 + bfhi(v.y);
    }
  }
}


DI void tile64_gload(int tid, u32x4& r0, u32x4& r1, const bf16_t* base, size_t stride) {
  {
    int idx = tid;
    int row = idx >> 3, ch = idx & 7;
    r0 = *(const u32x4*)(base + (size_t)row * stride + ch * 8);
  }
  {
    int idx = tid + 256;
    int row = idx >> 3, ch = idx & 7;
    r1 = *(const u32x4*)(base + (size_t)row * stride + ch * 8);
  }
}
DI void tile64_sstore(int tid, bf16_t* dst, const u32x4& r0, const u32x4& r1) {
  {
    int idx = tid;
    int row = idx >> 3, ch = idx & 7;
    *(u32x4*)(dst + row * 64 + ((ch ^ ((row >> 1) & 7)) << 3)) = r0;
  }
  {
    int idx = tid + 256;
    int row = idx >> 3, ch = idx & 7;
    *(u32x4*)(dst + row * 64 + ((ch ^ ((row >> 1) & 7)) << 3)) = r1;
  }
}

struct AttnSt { f32x4 O[2][4]; float m[2]; float l[2]; };

template <int MODE>
DI void attn_compute(const int lane, const bf16_t* Ks, const bf16_t* Vs, const bf16x8 (&qf)[2][2], AttnSt& st, const float (&invl)[2],
                     int lo, int hi, float (&impA)[4], float (&impE)[4]) {
  const int quad = lane >> 4, col = lane & 15;
  f32x4 S[4][2];
#pragma unroll
  for (int kt = 0; kt < 4; ++kt)
#pragma unroll
    for (int hh = 0; hh < 2; ++hh) S[kt][hh] = f32x4{0.f, 0.f, 0.f, 0.f};
#pragma unroll
  for (int ks = 0; ks < 2; ++ks) {
#pragma unroll
    for (int kt = 0; kt < 4; ++kt) {
      int row = kt * 16 + col;
      bf16x8 kf = *(const bf16x8*)(Ks + row * 64 + (((ks * 4 + quad) ^ ((row >> 1) & 7)) << 3));
#pragma unroll
      for (int hh = 0; hh < 2; ++hh) S[kt][hh] = mfma16(kf, qf[hh][ks], S[kt][hh]);
    }
  }
  bf16x8 pf[2][2];
#pragma unroll
  for (int hh = 0; hh < 2; ++hh) {
    float mx = -1e30f;
#pragma unroll
    for (int kt = 0; kt < 4; ++kt)
#pragma unroll
      for (int j = 0; j < 4; ++j) {
        int kl = kt * 16 + quad * 4 + j;
        bool v = (kl >= lo) && (kl <= hi);
        float sv = v ? S[kt][hh][j] : -1e30f;
        S[kt][hh][j] = sv;
        mx = fmaxf(mx, sv);
      }
    if (MODE != 1) {
      mx = fmaxf(mx, shx(mx, 16, lane));
      mx = fmaxf(mx, shx(mx, 32, lane));
      float m_new = fmaxf(st.m[hh], mx);
      float alpha = __expf(st.m[hh] - m_new);
      st.m[hh] = m_new;
      float rs = 0.f;
#pragma unroll
      for (int kt = 0; kt < 4; ++kt)
#pragma unroll
        for (int j = 0; j < 4; ++j) {
          float sv = S[kt][hh][j];
          float pv = (sv > -1e29f) ? __expf(sv - m_new) : 0.f;
          rs += pv;
          S[kt][hh][j] = pv;
        }
      st.l[hh] = st.l[hh] * alpha + rs;
      if (MODE == 2) {
#pragma unroll
        for (int dt = 0; dt < 4; ++dt) st.O[hh][dt] *= alpha;
      }
    } else {
      const float mh = st.m[hh], il = invl[hh];
#pragma unroll
      for (int kt = 0; kt < 4; ++kt) {
        float a = 0.f;
#pragma unroll
        for (int j = 0; j < 4; ++j) {
          float sv = S[kt][hh][j];
          float pv = (sv > -1e29f) ? __expf(sv - mh) * il : 0.f;
          S[kt][hh][j] = pv;
          a += pv;
        }
        impA[kt] += a;
        impE[kt] += S[kt][hh][3];
      }
    }
    if (MODE != 0) {
#pragma unroll
      for (int c = 0; c < 2; ++c)
        pf[hh][c] = mk8(pack2(S[2 * c][hh][0], S[2 * c][hh][1]), pack2(S[2 * c][hh][2], S[2 * c][hh][3]),
                        pack2(S[2 * c + 1][hh][0], S[2 * c + 1][hh][1]), pack2(S[2 * c + 1][hh][2], S[2 * c + 1][hh][3]));
    }
  }
  if (MODE != 0) {
#pragma unroll
    for (int dt = 0; dt < 4; ++dt) {
      const int row = dt * 16 + col;
      const int sw = (row >> 1) & 7;
#pragma unroll
      for (int c = 0; c < 2; ++c) {
        uint2 a = *(const uint2*)(Vs + row * 64 + (((4 * c + (quad >> 1)) ^ sw) << 3) + (quad & 1) * 4);
        uint2 b = *(const uint2*)(Vs + row * 64 + (((4 * c + 2 + (quad >> 1)) ^ sw) << 3) + (quad & 1) * 4);
        bf16x8 vf = mk8(a.x, a.y, b.x, b.y);
#pragma unroll
        for (int hh = 0; hh < 2; ++hh) st.O[hh][dt] = mfma16(vf, pf[hh][c], st.O[hh][dt]);
      }
    }
  }
}

DI void st_reset(AttnSt& st) {
#pragma unroll
  for (int h = 0; h < 2; ++h) {
    st.m[h] = -1e30f;
    st.l[h] = 0.f;
#pragma unroll
    for (int dt = 0; dt < 4; ++dt) st.O[h][dt] = f32x4{0.f, 0.f, 0.f, 0.f};
  }
}

template <bool FIRST>
DI void nsa_flush(const int quad, bf16_t* optr, const AttnSt& st, const float (&sc)[2]) {
#pragma unroll
  for (int h = 0; h < 2; ++h)
#pragma unroll
    for (int dt = 0; dt < 4; ++dt) {
      uint2* q = (uint2*)(optr + h * 64 + dt * 16 + quad * 4);
      f32x4 o = st.O[h][dt] * sc[h];
      if (!FIRST) {
        uint2 pv = *q;
        o[0] += bflo(pv.x); o[1] += bfhi(pv.x); o[2] += bflo(pv.y); o[3] += bfhi(pv.y);
      }
      uint2 u;
      u.x = pack2(o[0], o[1]);
      u.y = pack2(o[2], o[3]);
      *q = u;
    }
}

DI void nsa_tile(const Params& p, int b, int g, int tile, bf16_t* lds) {
  const int tid = TID(), lane = tid & 63, w = tid >> 6, quad = lane >> 4, col = lane & 15;
  const int cur = tile;
  const int tok = tile * 64 + w * 16 + col;
  bf16_t* z = (bf16_t*)(p.ws + O_Z);
  const bf16_t* kcmp = (const bf16_t*)(p.ws + O_KCMP) + (size_t)(b * 2 + g) * 512 * 64;
  const bf16_t* vcmpT = (const bf16_t*)(p.ws + O_VCMPT) + (size_t)(b * 2 + g) * 64 * 512;
  const bf16_t* vsT = (const bf16_t*)(p.ws + O_VST) + (size_t)(b * 2 + g) * 64 * SEQ;
  const bf16_t* vwT = (const bf16_t*)(p.ws + O_VWT) + (size_t)(b * 2 + g) * 64 * SEQ;
  const bf16_t* zb = z + (size_t)b * SEQ * ZS;
  const bf16_t* ztok = z + ((size_t)(b * SEQ + tok)) * ZS;
  bf16_t* otok = (bf16_t*)(p.ws + O_ONSA) + ((size_t)(b * SEQ + tok)) * 512 + g * 256;
  bf16_t* Ks = lds;
  bf16_t* Vs = lds + 4096;
  float* impl = (float*)(lds + 8192);

  AttnSt st;
  float invl[2] = {0.f, 0.f};
  float dA[4] = {0.f, 0.f, 0.f, 0.f}, dE[4] = {0.f, 0.f, 0.f, 0.f};
  u32x4 rk0, rk1, rv0, rv1;
  bf16x8 qf[2][2];

  const int ncs = (cur < 16) ? 1 : (cur >> 4) + 1;
  const int chi = (tok >= 31) ? ((tok - 31) >> 4) : -1;

  for (int hp = 0; hp < 2; ++hp) {
#pragma unroll
    for (int hh = 0; hh < 2; ++hh)
#pragma unroll
      for (int ks = 0; ks < 2; ++ks) qf[hh][ks] = *(const bf16x8*)(ztok + C_Q + g * 256 + (hp * 2 + hh) * 64 + ks * 32 + quad * 8);
    st_reset(st);
    for (int s = 0; s < ncs; ++s) {
      tile64_gload(tid, rk0, rk1, kcmp + (size_t)s * 4096, 64);
      __syncthreads();
      tile64_sstore(tid, Ks, rk0, rk1);
      __syncthreads();
      attn_compute<0>(lane, Ks, Vs, qf, st, invl, 0, chi - s * 64, dA, dE);
    }
#pragma unroll
    for (int h = 0; h < 2; ++h) {
      float l = st.l[h];
      l += shx(l, 16, lane);
      l += shx(l, 32, lane);
      invl[h] = (l > 0.f) ? 1.f / l : 0.f;
    }
    {
      float carry = 0.f;
      for (int s = 0; s < ncs; ++s) {
        float iA[4] = {0.f, 0.f, 0.f, 0.f}, iE[4] = {0.f, 0.f, 0.f, 0.f};
        tile64_gload(tid, rk0, rk1, kcmp + (size_t)s * 4096, 64);
        tile64_gload(tid, rv0, rv1, vcmpT + s * 64, 512);
        __syncthreads();
        tile64_sstore(tid, Ks, rk0, rk1);
        tile64_sstore(tid, Vs, rv0, rv1);
        __syncthreads();
        attn_compute<1>(lane, Ks, Vs, qf, st, invl, 0, chi - s * 64, iA, iE);
#pragma unroll
        for (int kt = 0; kt < 4; ++kt) {
          float recv = shfrom(iE[kt], (lane + 48) & 63);
          float val = iA[kt] + ((quad == 0) ? carry : recv);
          carry = recv;
          float* slot = impl + (s * 4 + kt) * 256 + tid;
          if (hp == 0) *slot = val; else *slot += val;
        }
      }
    }
    {
      float sc[2];
#pragma unroll
      for (int h = 0; h < 2; ++h) sc[h] = sigmoidf(bf2f(ztok[C_GT + 0 * 8 + g * 4 + hp * 2 + h]));
      nsa_flush<true>(quad, otok + hp * 128, st, sc);
    }
  }

  uint32_t sw0, sw1, sw2, sw3;
  {
    uint32_t key[32];
#pragma unroll
    for (int i = 0; i < 32; ++i) {
      int j = i * 4 + quad;
      float sc = (i < ncs * 4) ? impl[i * 256 + tid] : 0.f;
      if (j == 0 || j == cur || j == cur - 1) sc = 1e4f;
      uint32_t k = (__float_as_uint(sc) & ~127u) | (uint32_t)(127 - j);
      key[i] = (j > cur) ? 0u : k;
    }
    uint32_t prev = 0xFFFFFFFFu;
    for (int r = 0; r < 16; ++r) {
      uint32_t mx = 0u;
#pragma unroll
      for (int i = 0; i < 32; ++i) {
        uint32_t k = key[i];
        k = (k < prev) ? k : 0u;
        mx = (k > mx) ? k : mx;
      }
      uint32_t o = shxu(mx, 16, lane);
      mx = (o > mx) ? o : mx;
      o = shxu(mx, 32, lane);
      mx = (o > mx) ? o : mx;
      prev = mx;
    }
    sw0 = 0u; sw1 = 0u; sw2 = 0u; sw3 = 0u;
#pragma unroll
    for (int i = 0; i < 32; ++i) {
      bool sel = (key[i] != 0u) && (key[i] >= prev);
      uint32_t bit = sel ? (1u << ((i & 7) * 4 + quad)) : 0u;
      if ((i >> 3) == 0) sw0 |= bit;
      else if ((i >> 3) == 1) sw1 |= bit;
      else if ((i >> 3) == 2) sw2 |= bit;
      else sw3 |= bit;
    }
    sw0 |= shxu(sw0, 16, lane); sw0 |= shxu(sw0, 32, lane);
    sw1 |= shxu(sw1, 16, lane); sw1 |= shxu(sw1, 32, lane);
    sw2 |= shxu(sw2, 16, lane); sw2 |= shxu(sw2, 32, lane);
    sw3 |= shxu(sw3, 16, lane); sw3 |= shxu(sw3, 32, lane);
  }

  for (int hp = 0; hp < 2; ++hp) {
#pragma unroll
    for (int hh = 0; hh < 2; ++hh)
#pragma unroll
      for (int ks = 0; ks < 2; ++ks) qf[hh][ks] = *(const bf16x8*)(ztok + C_Q + g * 256 + (hp * 2 + hh) * 64 + ks * 32 + quad * 8);
    st_reset(st);
    {
      const bf16_t* kb = zb + C_KS + g * 64;
      for (int s = 0; s <= cur; ++s) {
        tile64_gload(tid, rk0, rk1, kb + (size_t)s * 64 * ZS, ZS);
        tile64_gload(tid, rv0, rv1, vsT + s * 64, SEQ);
        __syncthreads();
        tile64_sstore(tid, Ks, rk0, rk1);
        tile64_sstore(tid, Vs, rv0, rv1);
        __syncthreads();
        uint32_t wsel = (s < 32) ? sw0 : (s < 64) ? sw1 : (s < 96) ? sw2 : sw3;
        bool sel = (wsel >> (s & 31)) & 1u;
        int hi = sel ? (tok - s * 64) : -1;
        if (__any(hi >= 0)) attn_compute<2>(lane, Ks, Vs, qf, st, invl, 0, hi, dA, dE);
      }
    }
    {
      float sc[2];
#pragma unroll
      for (int h = 0; h < 2; ++h) {
        float l = st.l[h];
        l += shx(l, 16, lane);
        l += shx(l, 32, lane);
        sc[h] = (l > 0.f) ? sigmoidf(bf2f(ztok[C_GT + 1 * 8 + g * 4 + hp * 2 + h])) / l : 0.f;
      }
      nsa_flush<false>(quad, otok + hp * 128, st, sc);
    }
    st_reset(st);
    {
      const bf16_t* kb = zb + C_KW + g * 64;
      const int s0 = (cur >= 8) ? cur - 8 : 0;
      for (int s = s0; s <= cur; ++s) {
        tile64_gload(tid, rk0, rk1, kb + (size_t)s * 64 * ZS, ZS);
        tile64_gload(tid, rv0, rv1, vwT + s * 64, SEQ);
        __syncthreads();
        tile64_sstore(tid, Ks, rk0, rk1);
        tile64_sstore(tid, Vs, rv0, rv1);
        __syncthreads();
        attn_compute<2>(lane, Ks, Vs, qf, st, invl, tok - 511 - s * 64, tok - s * 64, dA, dE);
      }
    }
    {
      float sc[2];
#pragma unroll
      for (int h = 0; h < 2; ++h) {
        float l = st.l[h];
        l += shx(l, 16, lane);
        l += shx(l, 32, lane);
        sc[h] = (l > 0.f) ? sigmoidf(bf2f(ztok[C_GT + 2 * 8 + g * 4 + hp * 2 + h])) / l : 0.f;
      }
      nsa_flush<false>(quad, otok + hp * 128, st, sc);
    }
  }
}

DI void load128(int tid, bf16_t* lds, const bf16_t* base, size_t stride) {
  u32x4 r[8];
#pragma unroll
  for (int i = 0; i < 8; ++i) {
    int idx = tid + 256 * i;
    int row = idx >> 4, ch = idx & 15;
    r[i] = *(const u32x4*)(base + (size_t)row * stride + ch * 8);
  }
#pragma unroll
  for (int i = 0; i < 8; ++i) {
    int idx = tid + 256 * i;
    int row = idx >> 4, ch = idx & 15;
    *(u32x4*)(lds + row * 128 + ((ch ^ (row & 15)) << 3)) = r[i];
  }
}

DI void ret_tile(const Params& p, int b, int h, int c, bf16_t* lds) {
  const int tid = TID(), lane = tid & 63, w = tid >> 6, quad = lane >> 4, col = lane & 15;
  const float lg2 = log2f(1.f - exp2f(-5.f - (float)h));
  bf16_t* z = (bf16_t*)(p.ws + O_Z);
  const bf16_t* rvT = (const bf16_t*)(p.ws + O_RVT);
  bf16_t* zc = z + ((size_t)(b * SEQ + c * 128)) * ZS;
  bf16x8 qf[2][4];
#pragma unroll
  for (int nt = 0; nt < 2; ++nt)
#pragma unroll
    for (int ks = 0; ks < 4; ++ks) {
      int n = 32 * w + nt * 16 + col;
      qf[nt][ks] = *(const bf16x8*)(zc + (size_t)n * ZS + C_RQ + h * 128 + ks * 32 + quad * 8);
    }
  f32x4 acc[8][2];
#pragma unroll
  for (int et = 0; et < 8; ++et)
#pragma unroll
    for (int nt = 0; nt < 2; ++nt) acc[et][nt] = f32x4{0.f, 0.f, 0.f, 0.f};
  __syncthreads();
  load128(tid, lds, zc + C_RV + h * 128, ZS);
  __syncthreads();
#pragma unroll
  for (int ks = 0; ks < 4; ++ks)
#pragma unroll
    for (int et = 0; et < 8; ++et) {
      int row = et * 16 + col;
      bf16x8 af = *(const bf16x8*)(lds + row * 128 + (((ks * 4 + quad) ^ (row & 15)) << 3));
#pragma unroll
      for (int nt = 0; nt < 2; ++nt) acc[et][nt] = mfma16(af, qf[nt][ks], acc[et][nt]);
    }
#pragma unroll
  for (int nt = 0; nt < 2; ++nt) {
    int n = 32 * w + nt * 16 + col;
    float xi = exp2f(lg2 * (float)(n + 1));
#pragma unroll
    for (int et = 0; et < 8; ++et) acc[et][nt] *= xi;
  }
  __syncthreads();
  load128(tid, lds, zc + C_RK + h * 128, ZS);
  __syncthreads();
  bf16x8 pf[2][4];
#pragma unroll
  for (int nt = 0; nt < 2; ++nt) {
    f32x4 s[8];
#pragma unroll
    for (int mt = 0; mt < 8; ++mt) s[mt] = f32x4{0.f, 0.f, 0.f, 0.f};
#pragma unroll
    for (int ks = 0; ks < 4; ++ks)
#pragma unroll
      for (int mt = 0; mt < 8; ++mt) {
        if (mt <= 2 * w + 1) {
          int row = mt * 16 + col;
          bf16x8 af = *(const bf16x8*)(lds + row * 128 + (((ks * 4 + quad) ^ (row & 15)) << 3));
          s[mt] = mfma16(af, qf[nt][ks], s[mt]);
        }
      }
    const int n = 32 * w + nt * 16 + col;
#pragma unroll
    for (int c2 = 0; c2 < 4; ++c2) {
      float v[8];
#pragma unroll
      for (int i = 0; i < 8; ++i) {
        const int mt = 2 * c2 + (i >> 2), j = i & 3;
        const int m = mt * 16 + quad * 4 + j;
        v[i] = (n >= m) ? s[mt][j] * exp2f(lg2 * (float)(n - m)) : 0.f;
      }
      pf[nt][c2] = mk8(pack2(v[0], v[1]), pack2(v[2], v[3]), pack2(v[4], v[5]), pack2(v[6], v[7]));
    }
  }
  __syncthreads();
  load128(tid, lds, rvT + ((size_t)((b * 4 + h) * 128)) * SEQ + c * 128, SEQ);
  __syncthreads();
#pragma unroll
  for (int c2 = 0; c2 < 4; ++c2) {
    if (2 * c2 <= 2 * w + 1) {
#pragma unroll
      for (int et = 0; et < 8; ++et) {
        int row = et * 16 + col;
        int sw = row & 15;
        uint2 a = *(const uint2*)(lds + row * 128 + (((4 * c2 + (quad >> 1)) ^ sw) << 3) + (quad & 1) * 4);
        uint2 bb = *(const uint2*)(lds + row * 128 + (((4 * c2 + 2 + (quad >> 1)) ^ sw) << 3) + (quad & 1) * 4);
        bf16x8 vf = mk8(a.x, a.y, bb.x, bb.y);
#pragma unroll
        for (int nt = 0; nt < 2; ++nt) acc[et][nt] = mfma16(vf, pf[nt][c2], acc[et][nt]);
      }
    }
  }
#pragma unroll
  for (int nt = 0; nt < 2; ++nt) {
    float ss = 0.f;
#pragma unroll
    for (int et = 0; et < 8; ++et)
#pragma unroll
      for (int j = 0; j < 4; ++j) ss += acc[et][nt][j] * acc[et][nt][j];
    ss += shx(ss, 16, lane);
    ss += shx(ss, 32, lane);
    const float rs = rsqrtf(ss * (1.f / 128.f) + 1e-6f);
    const int n = 32 * w + nt * 16 + col;
    bf16_t* zr = zc + (size_t)n * ZS;
#pragma unroll
    for (int et = 0; et < 8; ++et) {
      const int e0 = et * 16 + quad * 4;
      uint2 gv = *(const uint2*)(zr + C_RG + h * 128 + e0);
      float g0 = bflo(gv.x), g1 = bfhi(gv.x), g2 = bflo(gv.y), g3 = bfhi(gv.y);
      uint2 o;
      o.x = pack2(acc[et][nt][0] * rs * g0 * sigmoidf(g0), acc[et][nt][1] * rs * g1 * sigmoidf(g1));
      o.y = pack2(acc[et][nt][2] * rs * g2 * sigmoidf(g2), acc[et][nt][3] * rs * g3 * sigmoidf(g3));
      *(uint2*)(zr + C_RQ + h * 128 + e0) = o;
    }
  }
}

#define GEMM_TILE_LOOP(NT)                                                             \
  for (int q_ = (int)(blockIdx.x >> 3), per_ = (int)(gridDim.x >> 3), xcd_ = (int)(blockIdx.x & 7), mt = 0, ntile = 0; \
       q_ < 32 * (NT) && ((mt = (((xcd_ + 8 * (q_ / (8 * (NT)))) << 3) + ((q_ % (8 * (NT))) & 7)), ntile = ((q_ % (8 * (NT))) >> 3)), true); \
       q_ += per_)

__global__ void __launch_bounds__(256, 2) mega(Params p) {
  __shared__ __attribute__((aligned(16))) bf16_t lds[32768];
  cg::grid_group grid = cg::this_grid();
  const int nb = gridDim.x;
  bf16_t* wt = (bf16_t*)(p.ws + O_WT);
  bf16_t* z = (bf16_t*)(p.ws + O_Z);
  bf16_t* hbuf = (bf16_t*)(p.ws + O_VST);
  bf16_t* ubuf = z;
  bf16_t* p16 = z;
  bf16_t* hid = (bf16_t*)(p.ws + O_HID);
  const float* bias = (const float*)(p.ws + O_BIAS);

  for (int layer = 0; layer < 2; ++layer) {
    const bf16_t* wl = wt;
    const float* xin = (layer == 0) ? p.x : p.out;

    phase0(p, layer);
    norm_phase(xin, p.norm_mix + layer * DM, hbuf);
    grid.sync();

    GEMM_TILE_LOOP(43) {
      const int m0 = mt * 128, n0 = ntile * 128;
      f32x4 acc[4][4];
      zero_acc(acc);
      gemm_accum(acc, RowPtr{hbuf + (size_t)m0 * DM, DM}, RowPtr{wl + W_IN + (size_t)n0 * 1024, 1024}, 16, lds);
      gemm_epi(acc, m0, n0, [&](int m, int n, f32x4& a) {
        if (n < ZS) {
          uint2 u;
          u.x = pack2(a[0], a[1]);
          u.y = pack2(a[2], a[3]);
          *(uint2*)(z + (size_t)m * ZS + n) = u;
        }
      });
    }
    grid.sync();

    post_z(p, layer);
    grid.sync();

    for (int t = blockIdx.x; t < 128 + 1024; t += nb) {
      f32x4 acc[4][4];
      zero_acc(acc);
      if (t < 128) {
        const int kv = t >> 6, mt = (t >> 1) & 31, ntile = t & 1;
        const int m0 = mt * 128, n0 = ntile * 128;
        const int colbase = kv ? C_VC : C_KC;
        auto ap = [&](int r, int kb) -> const bf16_t* {
          int row = m0 + r;
          int bg = row >> 9, c = row & 511;
          int tk = 16 * c + kb;
          tk = tk > (SEQ - 1) ? (SEQ - 1) : tk;
          return z + ((size_t)((bg >> 1) * SEQ + tk)) * ZS + colbase + (bg & 1) * 64;
        };
        gemm_accum(acc, ap, RowPtr{wl + (kv ? W_C1V : W_C1K) + (size_t)n0 * 2048, 2048}, 32, lds);
        const float* bs = bias + kv * 256;
        bf16_t* hd = hid + (size_t)kv * 4096 * 256;
        gemm_epi(acc, m0, n0, [&](int m, int n, f32x4& a) {
          float o[4];
#pragma unroll
          for (int j = 0; j < 4; ++j) {
            float xv = a[j] + bs[n + j];
            float y = 0.7978845608028654f * (xv + 0.044715f * xv * xv * xv);
            float th = 1.f - 2.f / (__expf(2.f * y) + 1.f);
            o[j] = 0.5f * xv * (1.f + th);
          }
          uint2 u;
          u.x = pack2(o[0], o[1]);
          u.y = pack2(o[2], o[3]);
          *(uint2*)(hd + (size_t)m * 256 + n) = u;
        });
      } else {
        const int idx = t - 128;
        const int c = idx & 63, bh = idx >> 6;
        const bf16_t* rvT = (const bf16_t*)(p.ws + O_RVT) + ((size_t)bh * 128) * SEQ + c * 128;
        const bf16_t* kzT = (const bf16_t*)(p.ws + O_KZT) + ((size_t)bh * 128) * SEQ + c * 128;
        gemm_accum(acc, RowPtr{rvT, SEQ}, RowPtr{kzT, SEQ}, 2, lds);
        bf16_t* dst = z + ((size_t)((bh >> 2) * SEQ + c * 128)) * ZS + C_RV + (bh & 3) * 128;
        gemm_epi(acc, 0, 0, [&](int m, int n, f32x4& a) {
          uint2 u;
          u.x = pack2(a[0], a[1]);
          u.y = pack2(a[2], a[3]);
          *(uint2*)(dst + (size_t)m * ZS + n) = u;
        });
      }
    }
    grid.sync();

    phase4b(p, layer);
    grid.sync();

    for (int t = blockIdx.x; t < 2048; t += nb) {
      if (t < 1024) {
        const int tile = 127 - (t >> 3), bg = t & 7;
        nsa_tile(p, bg >> 1, bg & 1, tile, lds);
      } else {
        const int idx = t - 1024;
        ret_tile(p, idx >> 8, (idx >> 6) & 3, idx & 63, lds);
      }
    }
    grid.sync();

    GEMM_TILE_LOOP(8) {
      const int m0 = mt * 128, n0 = ntile * 128;
      f32x4 acc[4][4];
      zero_acc(acc);
      gemm_accum(acc, RowPtr{(const bf16_t*)(p.ws + O_ONSA) + (size_t)m0 * 512, 512}, RowPtr{wl + W_UPA + (size_t)n0 * 512, 512}, 8, lds);
      gemm_epi(acc, m0, n0, [&](int m, int n, f32x4& a) {
        uint2 ua = *(const uint2*)(z + (size_t)m * ZS + C_MA + n);
        uint2 ub = *(const uint2*)(z + (size_t)m * ZS + C_MB + n);
        a[0] *= sigmoidf(bflo(ua.x)) / sigmoidf(bflo(ub.x));
        a[1] *= sigmoidf(bfhi(ua.x)) / sigmoidf(bfhi(ub.x));
        a[2] *= sigmoidf(bflo(ua.y)) / sigmoidf(bflo(ub.y));
        a[3] *= sigmoidf(bfhi(ua.y)) / sigmoidf(bfhi(ub.y));
      });
      gemm_accum(acc, RowPtr{z + (size_t)m0 * ZS + C_RQ, ZS}, RowPtr{wl + W_UPR + (size_t)n0 * 512, 512}, 8, lds);
      gemm_epi(acc, m0, n0, [&](int m, int n, f32x4& a) {
        uint2 ub = *(const uint2*)(z + (size_t)m * ZS + C_MB + n);
        uint2 u;
        u.x = pack2(a[0] * sigmoidf(bflo(ub.x)), a[1] * sigmoidf(bfhi(ub.x)));
        u.y = pack2(a[2] * sigmoidf(bflo(ub.y)), a[3] * sigmoidf(bfhi(ub.y)));
        *(uint2*)(z + (size_t)m * ZS + C_RK + n) = u;
      });
    }
    grid.sync();

    GEMM_TILE_LOOP(8) {
      const int m0 = mt * 128, n0 = ntile * 128;
      f32x4 acc[4][4];
      zero_acc(acc);
      gemm_accum(acc, RowPtr{z + (size_t)m0 * ZS + C_RK, ZS}, RowPtr{wl + W_OUT + (size_t)n0 * 1024, 1024}, 16, lds);
      gemm_epi(acc, m0, n0, [&](int m, int n, f32x4& a) {
        float4 xv = *(const float4*)(xin + (size_t)m * DM + n);
        *(float4*)(p.out + (size_t)m * DM + n) = make_float4(xv.x + a[0], xv.y + a[1], xv.z + a[2], xv.w + a[3]);
      });
    }
    grid.sync();

    norm_phase(p.out, p.norm_mlp + layer * DM, hbuf);
    grid.sync();

    GEMM_TILE_LOOP(32) {
      const int m0 = mt * 128, n0 = ntile * 128;
      f32x4 acc[4][4];
      zero_acc(acc);
      gemm_accum(acc, RowPtr{hbuf + (size_t)m0 * DM, DM}, RowPtr{wl + W_FF1 + (size_t)n0 * 1024, 1024}, 16, lds);
      gemm_epi(acc, m0, n0, [&](int m, int n, f32x4& a) {
        float r0 = fmaxf(a[0], 0.f), r1 = fmaxf(a[1], 0.f), r2 = fmaxf(a[2], 0.f), r3 = fmaxf(a[3], 0.f);
        uint2 u;
        u.x = pack2(r0 * r0, r1 * r1);
        u.y = pack2(r2 * r2, r3 * r3);
        *(uint2*)(ubuf + (size_t)m * 4096 + n) = u;
      });
    }
    grid.sync();

    GEMM_TILE_LOOP(8) {
      const int m0 = mt * 128, n0 = ntile * 128;
      f32x4 acc[4][4];
      zero_acc(acc);
      gemm_accum(acc, RowPtr{ubuf + (size_t)m0 * 4096, 4096}, RowPtr{wl + W_FF2 + (size_t)n0 * 4096, 4096}, 64, lds);
      gemm_epi(acc, m0, n0, [&](int m, int n, f32x4& a) {
        float4* o = (float4*)(p.out + (size_t)m * DM + n);
        float4 xv = *o;
        *o = make_float4(xv.x + a[0], xv.y + a[1], xv.z + a[2], xv.w + a[3]);
      });
    }
    grid.sync();

    norm_phase(p.out, p.norm_ple + layer * DM, hbuf);
    {
      const float* pl = p.p + (size_t)layer * T_TOK * 256;
      const int gtid = blockIdx.x * 256 + TID();
      const int gthreads = nb * 256;
      for (int i = gtid; i < T_TOK * 32; i += gthreads) {
        float4 a = ((const float4*)pl)[2 * i], b2 = ((const float4*)pl)[2 * i + 1];
        ((uint4*)p16)[i] = make_uint4(pack2(a.x, a.y), pack2(a.z, a.w), pack2(b2.x, b2.y), pack2(b2.z, b2.w));
      }
    }
    grid.sync();

    GEMM_TILE_LOOP(8) {
      const int m0 = mt * 128, n0 = ntile * 128;
      f32x4 acc[4][4];
      zero_acc(acc);
      gemm_accum(acc, RowPtr{p16 + (size_t)m0 * 256, 256}, RowPtr{wl + W_PLE + (size_t)n0 * 256, 256}, 4, lds);
      uint2 pp[4][4];
#pragma unroll
      for (int i = 0; i < 4; ++i)
#pragma unroll
        for (int j = 0; j < 4; ++j) {
          pp[i][j].x = pack2(acc[i][j][0], acc[i][j][1]);
          pp[i][j].y = pack2(acc[i][j][2], acc[i][j][3]);
        }
      zero_acc(acc);
      gemm_accum(acc, RowPtr{hbuf + (size_t)m0 * DM, DM}, RowPtr{wl + W_PG + (size_t)n0 * 1024, 1024}, 16, lds);
      {
        const int tid_ = TID();
        const int lane = tid_ & 63, w = tid_ >> 6;
        const int wm = w >> 1, wn = w & 1;
#pragma unroll
        for (int i = 0; i < 4; ++i)
#pragma unroll
          for (int j = 0; j < 4; ++j) {
            int m = m0 + wm * 64 + i * 16 + (lane & 15);
            int n = n0 + wn * 64 + j * 16 + (lane >> 4) * 4;
            float4* o = (float4*)(p.out + (size_t)m * DM + n);
            float4 xv = *o;
            f32x4 a = acc[i][j];
            *o = make_float4(xv.x + sigmoidf(a[0]) * bflo(pp[i][j].x), xv.y + sigmoidf(a[1]) * bfhi(pp[i][j].x),
                             xv.z + sigmoidf(a[2]) * bflo(pp[i][j].y), xv.w + sigmoidf(a[3]) * bfhi(pp[i][j].y));
          }
      }
    }
    grid.sync();
  }
}

extern "C" void kernel_launch(void* const* d_in, const int* in_sizes, int n_in,
                              void* d_out, int out_size, void* d_ws, size_t ws_size,
                              hipStream_t stream) {
  static int grid_blocks = 0;
  if (!grid_blocks) {
    int dev = 0, cus = 0, per_cu = 0;
    hipGetDevice(&dev);
    hipDeviceGetAttribute(&cus, hipDeviceAttributeMultiprocessorCount, dev);
    hipOccupancyMaxActiveBlocksPerMultiprocessor(&per_cu, mega, 256, 0);
    if (per_cu > 2) per_cu = 2;
    if (per_cu < 1) per_cu = 1;
    grid_blocks = cus * per_cu;
  }
  if (ws_size < WS_NEED) {
    fprintf(stderr, "workspace too small: %zu < %llu\n", ws_size, (unsigned long long)WS_NEED);
    return;
  }
  Params p{};
  p.x = (const float*)d_in[0]; p.p = (const float*)d_in[1]; p.norm_mix = (const float*)d_in[2]; p.w_in = (const float*)d_in[3];
  p.nsa_q_norm = (const float*)d_in[4]; p.nsa_k_norm = (const float*)d_in[5]; p.cmp_pos_k = (const float*)d_in[6];
  p.cmp_pos_v = (const float*)d_in[7]; p.cmp_w1_k = (const float*)d_in[8]; p.cmp_w2_k = (const float*)d_in[9];
  p.cmp_w1_v = (const float*)d_in[10]; p.cmp_w2_v = (const float*)d_in[11]; p.w_up_nsa = (const float*)d_in[12];
  p.w_up_ret = (const float*)d_in[13]; p.w_out = (const float*)d_in[14]; p.norm_mlp = (const float*)d_in[15];
  p.w_ff1 = (const float*)d_in[16]; p.w_ff2 = (const float*)d_in[17]; p.norm_ple = (const float*)d_in[18];
  p.w_ple = (const float*)d_in[19]; p.w_ple_gate = (const float*)d_in[20];
  p.out = (float*)d_out; p.ws = (char*)d_ws;
  void* args[] = {&p};
  hipError_t e = hipLaunchCooperativeKernel((void*)mega, dim3(grid_blocks), dim3(256), args, 0, stream);
  if (e != hipSuccess) fprintf(stderr, "cooperative launch failed: %s (grid %d)\n", hipGetErrorString(e), grid_blocks);
}
```

```cpp
#include <hip/hip_runtime.h>
#include <hip/hip_cooperative_groups.h>
#include <cstdio>
#include <cstdint>
namespace cg = cooperative_groups;

typedef __attribute__((ext_vector_type(8))) short bf16x8;
typedef __attribute__((ext_vector_type(4))) float f32x4;
typedef unsigned short bf16_t;
typedef __attribute__((ext_vector_type(4))) unsigned u32x4;
#define DI __device__ __forceinline__

#define T_TOK 32768
#define SEQ 8192
#define DM 1024
#define ZS 5400
#define C_Q 0
#define C_KC 512
#define C_VC 640
#define C_KS 768
#define C_VS 896
#define C_KW 1024
#define C_VW 1152
#define C_GT 1280
#define C_RQ 1304
#define C_RK 1816
#define C_RV 2328
#define C_RG 2840
#define C_MA 3352
#define C_MB 4376
#define NPAD_IN 5504

#define W_IN 0
#define W_C1K 5636096
#define W_C1V 6160384
#define W_UPA 6684672
#define W_UPR 7208960
#define W_OUT 7733248
#define W_FF1 8781824
#define W_FF2 12976128
#define W_PLE 17170432
#define W_PG 17432576
#define W_LAYER 18481152

#define O_WT 0ull
#define O_ROPE 36962304ull
#define O_BIAS 41156608ull
#define O_HID 41160704ull
#define O_KCMP 45355008ull
#define O_VCMPT 45879296ull
#define O_VST 46403584ull
#define O_VWT 54792192ull
#define O_RVT 63180800ull
#define O_KZT 96735232ull
#define O_Z 130289664ull
#define O_ONSA 484184064ull
#define WS_NEED 517738496ull

struct Params {
  const float* x; const float* p; const float* norm_mix; const float* w_in;
  const float* nsa_q_norm; const float* nsa_k_norm; const float* cmp_pos_k; const float* cmp_pos_v;
  const float* cmp_w1_k; const float* cmp_w2_k; const float* cmp_w1_v; const float* cmp_w2_v;
  const float* w_up_nsa; const float* w_up_ret; const float* w_out; const float* norm_mlp;
  const float* w_ff1; const float* w_ff2; const float* norm_ple; const float* w_ple; const float* w_ple_gate;
  float* out; char* ws;
};

DI unsigned pack2(float a, float b) {
  typedef __attribute__((ext_vector_type(2))) __bf16 bf2;
  typedef __attribute__((ext_vector_type(2))) float f2;
  f2 v = {a, b};
  bf2 r = __builtin_convertvector(v, bf2);
  return __builtin_bit_cast(unsigned, r);
}
DI bf16_t f2bf(float a) { return (bf16_t)(pack2(a, 0.f) & 0xffffu); }
DI float bf2f(bf16_t h) { return __uint_as_float(((unsigned)h) << 16); }
DI float bflo(unsigned u) { return __uint_as_float(u << 16); }
DI float bfhi(unsigned u) { return __uint_as_float(u & 0xffff0000u); }
DI float shx(float v, int mask, int lane) {
  return __int_as_float(__builtin_amdgcn_ds_bpermute((lane ^ mask) << 2, __float_as_int(v)));
}
DI uint32_t shxu(uint32_t v, int mask, int lane) {
  return (uint32_t)__builtin_amdgcn_ds_bpermute((lane ^ mask) << 2, (int)v);
}
DI float shfrom(float v, int srclane) {
  return __int_as_float(__builtin_amdgcn_ds_bpermute(srclane << 2, __float_as_int(v)));
}
DI float wave_sum(float v, int lane) {
#pragma unroll
  for (int o = 32; o > 0; o >>= 1) v += shx(v, o, lane);
  return v;
}
DI int TID() { int t = threadIdx.x; asm volatile("" : "+v"(t)); return t; }
DI float sigmoidf(float x) { return 1.f / (1.f + __expf(-x)); }
DI f32x4 mfma16(bf16x8 a, bf16x8 b, f32x4 c) { return __builtin_amdgcn_mfma_f32_16x16x32_bf16(a, b, c, 0, 0, 0); }
DI bf16x8 mk8(unsigned a, unsigned b, unsigned c, unsigned d) {
  uint4 u = make_uint4(a, b, c, d);
  return __builtin_bit_cast(bf16x8, u);
}

template <class AP, class BP>
DI void g_load(u32x4 (&ra)[4], u32x4 (&rb)[4], const AP& ap, const BP& bp, int kb, int lrow, int lch) {
#pragma unroll
  for (int i = 0; i < 4; ++i) {
    ra[i] = *(const u32x4*)(ap(lrow + 32 * i, kb) + lch * 8);
    rb[i] = *(const u32x4*)(bp(lrow + 32 * i, kb) + lch * 8);
  }
}
DI void g_store(bf16_t* As, bf16_t* Bs, const u32x4 (&ra)[4], const u32x4 (&rb)[4], int buf, int lrow, int lch) {
#pragma unroll
  for (int i = 0; i < 4; ++i) {
    int r = lrow + 32 * i;
    int off = buf * 8192 + r * 64 + ((lch ^ ((r >> 1) & 7)) << 3);
    *(u32x4*)(As + off) = ra[i];
    *(u32x4*)(Bs + off) = rb[i];
  }
}
DI void g_compute(f32x4 (&acc)[4][4], const bf16_t* a, const bf16_t* b, int wm, int wn, int lane) {
#pragma unroll
  for (int ks = 0; ks < 2; ++ks) {
    bf16x8 af[4], bfr[4];
#pragma unroll
    for (int i = 0; i < 4; ++i) {
      int r = wm * 64 + i * 16 + (lane & 15);
      af[i] = *(const bf16x8*)(a + r * 64 + (((ks * 4 + (lane >> 4)) ^ ((r >> 1) & 7)) << 3));
      int r2 = wn * 64 + i * 16 + (lane & 15);
      bfr[i] = *(const bf16x8*)(b + r2 * 64 + (((ks * 4 + (lane >> 4)) ^ ((r2 >> 1) & 7)) << 3));
    }
#pragma unroll
    for (int i = 0; i < 4; ++i)
#pragma unroll
      for (int j = 0; j < 4; ++j) acc[i][j] = mfma16(bfr[j], af[i], acc[i][j]);
  }
}
template <class AP, class BP>
DI void gemm_accum(f32x4 (&acc)[4][4], AP ap, BP bp, int nkb, bf16_t* lds) {
  const int tid = TID(), lane = tid & 63, w = tid >> 6;
  const int wm = w >> 1, wn = w & 1;
  const int lrow = tid >> 3, lch = tid & 7;
  bf16_t* As = lds;
  bf16_t* Bs = lds + 16384;
  u32x4 ra0[4], rb0[4], ra1[4], rb1[4];
  __syncthreads();
  g_load(ra0, rb0, ap, bp, 0, lrow, lch);
  g_load(ra1, rb1, ap, bp, 1, lrow, lch);
  g_store(As, Bs, ra0, rb0, 0, lrow, lch);
  __syncthreads();
  for (int kb = 0; kb < nkb; kb += 2) {
    if (kb + 2 < nkb) g_load(ra0, rb0, ap, bp, kb + 2, lrow, lch);
    g_compute(acc, As, Bs, wm, wn, lane);
    g_store(As, Bs, ra1, rb1, 1, lrow, lch);
    __syncthreads();
    if (kb + 3 < nkb) g_load(ra1, rb1, ap, bp, kb + 3, lrow, lch);
    g_compute(acc, As + 8192, Bs + 8192, wm, wn, lane);
    if (kb + 2 < nkb) g_store(As, Bs, ra0, rb0, 0, lrow, lch);
    __syncthreads();
  }
}
template <class E>
DI void gemm_epi(f32x4 (&acc)[4][4], int m0, int n0, E e) {
  const int tid_ = TID();
  const int lane = tid_ & 63, w = tid_ >> 6;
  const int wm = w >> 1, wn = w & 1;
#pragma unroll
  for (int i = 0; i < 4; ++i)
#pragma unroll
    for (int j = 0; j < 4; ++j) {
      int m = m0 + wm * 64 + i * 16 + (lane & 15);
      int n = n0 + wn * 64 + j * 16 + (lane >> 4) * 4;
      e(m, n, acc[i][j]);
    }
}
DI void zero_acc(f32x4 (&acc)[4][4]) {
#pragma unroll
  for (int i = 0; i < 4; ++i)
#pragma unroll
    for (int j = 0; j < 4; ++j) acc[i][j] = f32x4{0.f, 0.f, 0.f, 0.f};
}
struct RowPtr {
  const bf16_t* base; size_t ld;
  DI const bf16_t* operator()(int r, int kb) const { return base + (size_t)r * ld + kb * 64; }
};

DI void convert_wt(const float* W, bf16_t* Wt, int K, int N, int Npad, int gtid, int gthreads) {
  const int k8n = K >> 3;
  const long total = (long)Npad * k8n;
  for (long idx = gtid; idx < total; idx += gthreads) {
    int n = (int)(idx % Npad);
    int k8 = (int)(idx / Npad);
    uint4 o = make_uint4(0, 0, 0, 0);
    if (n < N) {
      const float* s = W + (size_t)(k8 * 8) * N + n;
      float v0 = s[0], v1 = s[(size_t)N], v2 = s[(size_t)2 * N], v3 = s[(size_t)3 * N];
      float v4 = s[(size_t)4 * N], v5 = s[(size_t)5 * N], v6 = s[(size_t)6 * N], v7 = s[(size_t)7 * N];
      o = make_uint4(pack2(v0, v1), pack2(v2, v3), pack2(v4, v5), pack2(v6, v7));
    }
    *(uint4*)(Wt + (size_t)n * K + k8 * 8) = o;
  }
}

DI void phase0(const Params& p, const int L) {
  const int gtid = blockIdx.x * 256 + TID();
  const int gthreads = gridDim.x * 256;
  bf16_t* wl = (bf16_t*)(p.ws + O_WT);
  convert_wt(p.w_in + (size_t)L * 1024 * 5400, wl + W_IN, 1024, 5400, NPAD_IN, gtid, gthreads);
  convert_wt(p.cmp_w1_k + (size_t)L * 2048 * 256, wl + W_C1K, 2048, 256, 256, gtid, gthreads);
  convert_wt(p.cmp_w1_v + (size_t)L * 2048 * 256, wl + W_C1V, 2048, 256, 256, gtid, gthreads);
  convert_wt(p.w_up_nsa + (size_t)L * 512 * 1024, wl + W_UPA, 512, 1024, 1024, gtid, gthreads);
  convert_wt(p.w_up_ret + (size_t)L * 512 * 1024, wl + W_UPR, 512, 1024, 1024, gtid, gthreads);
  convert_wt(p.w_out + (size_t)L * 1024 * 1024, wl + W_OUT, 1024, 1024, 1024, gtid, gthreads);
  convert_wt(p.w_ff1 + (size_t)L * 1024 * 4096, wl + W_FF1, 1024, 4096, 4096, gtid, gthreads);
  convert_wt(p.w_ff2 + (size_t)L * 4096 * 1024, wl + W_FF2, 4096, 1024, 1024, gtid, gthreads);
  convert_wt(p.w_ple + (size_t)L * 256 * 1024, wl + W_PLE, 256, 1024, 1024, gtid, gthreads);
  convert_wt(p.w_ple_gate + (size_t)L * 1024 * 1024, wl + W_PG, 1024, 1024, 1024, gtid, gthreads);
  if (L == 0) {
    float2* rope = (float2*)(p.ws + O_ROPE);
    for (int idx = gtid; idx < SEQ * 64; idx += gthreads) {
      int pos = idx >> 6, j = idx & 63;
      float inv = exp2f(-(float)j * (13.287712379549449f / 64.f));
      float ang = (float)pos * inv;
      double rev = (double)ang * 0.15915494309189535;
      rev -= rint(rev);
      float fr = (float)rev;
      rope[idx] = make_float2(__builtin_amdgcn_cosf(fr), __builtin_amdgcn_sinf(fr));
    }
  }
  float* part = (float*)(p.ws + O_HID);
  {
    const int n = gtid & 255;
    for (int item = (int)blockIdx.x; item < 128; item += (int)gridDim.x) {
      const int kv = item >> 6, kc = item & 63;
      const float* pos = (kv ? p.cmp_pos_v : p.cmp_pos_k) + L * 2048 + kc * 32;
      const float* w1 = (kv ? p.cmp_w1_v : p.cmp_w1_k) + (size_t)L * 2048 * 256 + (size_t)kc * 32 * 256;
      float a = 0.f;
#pragma unroll 8
      for (int k = 0; k < 32; ++k) a += pos[k] * w1[(size_t)k * 256 + n];
      part[item * 256 + n] = a;
    }
  }
}

DI void norm_phase(const float* xin, const float* g, bf16_t* h) {
  const int tid_ = TID();
  const int lane = tid_ & 63;
  const int gw = (blockIdx.x * 256 + tid_) >> 6;
  const int nw = gridDim.x * 4;
  float4 gv[4];
#pragma unroll
  for (int i = 0; i < 4; ++i) gv[i] = ((const float4*)g)[i * 64 + lane];
  for (int row = gw; row < T_TOK; row += nw) {
    const float4* xr = (const float4*)(xin + (size_t)row * DM);
    float4 v[4];
    float ss = 0.f;
#pragma unroll
    for (int i = 0; i < 4; ++i) {
      v[i] = xr[i * 64 + lane];
      ss += v[i].x * v[i].x + v[i].y * v[i].y + v[i].z * v[i].z + v[i].w * v[i].w;
    }
    ss = wave_sum(ss, lane);
    float rs = rsqrtf(ss * (1.f / 1024.f) + 1e-6f);
    uint2* hr = (uint2*)(h + (size_t)row * DM);
#pragma unroll
    for (int i = 0; i < 4; ++i) {
      uint2 o;
      o.x = pack2(v[i].x * rs * gv[i].x, v[i].y * rs * gv[i].y);
      o.y = pack2(v[i].z * rs * gv[i].z, v[i].w * rs * gv[i].w);
      hr[i * 64 + lane] = o;
    }
  }
}

DI void post_z(const Params& p, int layer) {
  const int tid_ = TID();
  const int lane = tid_ & 63;
  const int gw = (blockIdx.x * 256 + tid_) >> 6;
  const int nw = gridDim.x * 4;
  bf16_t* z = (bf16_t*)(p.ws + O_Z);
  bf16_t* vsT = (bf16_t*)(p.ws + O_VST);
  bf16_t* vwT = (bf16_t*)(p.ws + O_VWT);
  bf16_t* rvT = (bf16_t*)(p.ws + O_RVT);
  bf16_t* kzT = (bf16_t*)(p.ws + O_KZT);
  const float2* rope = (const float2*)(p.ws + O_ROPE);
  const float* qn = p.nsa_q_norm + layer * 64;
  const float* kn = p.nsa_k_norm + layer * 64;
  {
    const float* part = (const float*)(p.ws + O_HID);
    float* bias = (float*)(p.ws + O_BIAS);
    const int idx = blockIdx.x * 256 + tid_;
    if (idx < 512) {
      const int kv = idx >> 8, n = idx & 255;
      float a = 0.f;
      for (int kc = 0; kc < 64; ++kc) a += part[(kv * 64 + kc) * 256 + n];
      bias[idx] = a;
    }
  }
  for (int item = gw; item < 4096 * 32; item += nw) {
    const int slab = item & 31, tc = item >> 5;
    const int tok0 = tc * 8;
    const int b = tok0 >> 13, spos = tok0 & 8191;
    bf16_t* zr = z + (size_t)tok0 * ZS;
    if (slab < 12) {
      int colbase; const float* g; float sc;
      if (slab < 8) { colbase = C_Q + slab * 64; g = qn; sc = 0.125f; }
      else if (slab < 10) { colbase = C_KS + (slab - 8) * 64; g = kn; sc = 1.f; }
      else { colbase = C_KW + (slab - 10) * 64; g = kn; sc = 1.f; }
      const float gv = g[lane] * sc;
#pragma unroll
      for (int i = 0; i < 8; ++i) {
        bf16_t* ptr = zr + (size_t)i * ZS + colbase + lane;
        float v = bf2f(*ptr);
        float ss = wave_sum(v * v, lane);
        float rs = rsqrtf(ss * (1.f / 64.f) + 1e-6f);
        *ptr = f2bf(v * rs * gv);
      }
    } else if (slab < 16) {
      const int gi = slab & 1;
      const bool isw = slab >= 14;
      const int colbase = (isw ? C_VW : C_VS) + gi * 64;
      bf16_t* dst = (isw ? vwT : vsT) + ((size_t)((b * 2 + gi) * 64 + lane)) * SEQ + spos;
      unsigned u[8];
#pragma unroll
      for (int i = 0; i < 8; ++i) u[i] = zr[(size_t)i * ZS + colbase + lane];
      *(uint4*)dst = make_uint4(u[0] | (u[1] << 16), u[2] | (u[3] << 16), u[4] | (u[5] << 16), u[6] | (u[7] << 16));
    } else if (slab < 20) {
      const int h = slab - 16;
      const int colbase = C_RQ + h * 128;
#pragma unroll
      for (int i = 0; i < 8; ++i) {
        bf16_t* p1 = zr + (size_t)i * ZS + colbase + lane;
        float x1 = bf2f(p1[0]), x2 = bf2f(p1[64]);
        float2 cs = rope[(spos + i) * 64 + lane];
        p1[0] = f2bf(x1 * cs.x - x2 * cs.y);
        p1[64] = f2bf(x1 * cs.y + x2 * cs.x);
      }
    } else if (slab < 24) {
      const int h = slab - 20;
      const int colbase = C_RK + h * 128;
      const float lg2 = log2f(1.f - exp2f(-5.f - (float)h));
      unsigned u1[8], u2[8];
#pragma unroll
      for (int i = 0; i < 8; ++i) {
        bf16_t* p1 = zr + (size_t)i * ZS + colbase + lane;
        float x1 = bf2f(p1[0]), x2 = bf2f(p1[64]);
        float2 cs = rope[(spos + i) * 64 + lane];
        float o1 = (x1 * cs.x - x2 * cs.y) * 0.08838834764831845f;
        float o2 = (x1 * cs.y + x2 * cs.x) * 0.08838834764831845f;
        p1[0] = f2bf(o1);
        p1[64] = f2bf(o2);
        float zeta = exp2f(lg2 * (float)(127 - ((spos + i) & 127)));
        u1[i] = f2bf(o1 * zeta);
        u2[i] = f2bf(o2 * zeta);
      }
      bf16_t* d1 = kzT + ((size_t)((b * 4 + h) * 128 + lane)) * SEQ + spos;
      *(uint4*)d1 = make_uint4(u1[0] | (u1[1] << 16), u1[2] | (u1[3] << 16), u1[4] | (u1[5] << 16), u1[6] | (u1[7] << 16));
      *(uint4*)(d1 + (size_t)64 * SEQ) = make_uint4(u2[0] | (u2[1] << 16), u2[2] | (u2[3] << 16), u2[4] | (u2[5] << 16), u2[6] | (u2[7] << 16));
    } else {
      const int s8 = slab - 24;
      const int h = s8 >> 1, half = s8 & 1;
      const int colbase = C_RV + s8 * 64;
      bf16_t* dst = rvT + ((size_t)((b * 4 + h) * 128 + half * 64 + lane)) * SEQ + spos;
      unsigned u[8];
#pragma unroll
      for (int i = 0; i < 8; ++i) u[i] = zr[(size_t)i * ZS + colbase + lane];
      *(uint4*)dst = make_uint4(u[0] | (u[1] << 16), u[2] | (u[3] << 16), u[4] | (u[5] << 16), u[6] | (u[7] << 16));
    }
  }
}

DI void phase4b(const Params& p, int layer) {
  const int tid_ = TID();
  const int lane = tid_ & 63;
  const int gw = (blockIdx.x * 256 + tid_) >> 6;
  const int nw = gridDim.x * 4;
  bf16_t* z = (bf16_t*)(p.ws + O_Z);
  const bf16_t* hid = (const bf16_t*)(p.ws + O_HID);
  bf16_t* kcmp = (bf16_t*)(p.ws + O_KCMP);
  bf16_t* vcmpT = (bf16_t*)(p.ws + O_VCMPT);
  const float* kn = p.nsa_k_norm + layer * 64;
  for (int item = gw; item < 8192; item += nw) {
    const int kv = item >> 12, row = item & 4095;
    const bf16_t* hrow = hid + ((size_t)kv * 4096 + row) * 256;
    const float* w2 = (kv ? p.cmp_w2_v : p.cmp_w2_k) + (size_t)layer * 256 * 64;
    float acc = 0.f;
    for (int k8 = 0; k8 < 32; ++k8) {
      uint4 hv = *(const uint4*)(hrow + k8 * 8);
      const float* wr = w2 + (size_t)(k8 * 8) * 64 + lane;
      acc += bflo(hv.x) * wr[0];
      acc += bfhi(hv.x) * wr[64];
      acc += bflo(hv.y) * wr[128];
      acc += bfhi(hv.y) * wr[192];
      acc += bflo(hv.z) * wr[256];
      acc += bfhi(hv.z) * wr[320];
      acc += bflo(hv.w) * wr[384];
      acc += bfhi(hv.w) * wr[448];
    }
    if (kv == 0) {
      float ss = wave_sum(acc * acc, lane);
      float rs = rsqrtf(ss * (1.f / 64.f) + 1e-6f);
      kcmp[(size_t)row * 64 + lane] = f2bf(acc * rs * kn[lane]);
    } else {
      const int bg = row >> 9, c = row & 511;
      vcmpT[((size_t)(bg * 64 + lane)) * 512 + c] = f2bf(acc);
    }
  }
  const int gtid = blockIdx.x * 256 + tid_;
  const int gthreads = gridDim.x * 256;
  for (int idx = gtid; idx < 65536; idx += gthreads) {
    const int d4 = idx & 31, e = (idx >> 5) & 127, h = (idx >> 12) & 3, b = idx >> 14;
    const float lg2 = log2f(1.f - exp2f(-5.f - (float)h));
    const float gch = exp2f(lg2 * 128.f);
    float r0 = 0.f, r1 = 0.f, r2 = 0.f, r3 = 0.f;
    bf16_t* ptr = z + ((size_t)(b * SEQ + e)) * ZS + C_RV + h * 128 + d4 * 4;
    for (int c0 = 0; c0 < 64; c0 += 16) {
      typedef __attribute__((ext_vector_type(2))) unsigned u32x2;
      u32x2 v[16];
#pragma unroll
      for (int i = 0; i < 16; ++i) v[i] = *(const u32x2*)(ptr + (size_t)(c0 + i) * 128 * ZS);
#pragma unroll
      for (int i = 0; i < 16; ++i) {
        u32x2 o;
        o.x = pack2(r0, r1);
        o.y = pack2(r2, r3);
        *(u32x2*)(ptr + (size_t)(c0 + i) * 128 * ZS) = o;
        r0 = gch * r0 + bflo(v[i].x);
        r1 = gch * r1 + bfhi(v[i].x);
        r2 = gch * r2 + bflo(v[i].y);
        r3 = gch * r3 + bfhi(v[i].y);
      }
    }
  }
}


DI void tile64_gload(int tid, u32x4& r0, u32x4& r1, const bf16_t* base, size_t stride) {
  {
    int idx = tid;
    int row = idx >> 3, ch = idx & 7;
    r0 = *(const u32x4*)(base + (size_t)row * stride + ch * 8);
  }
  {
    int idx = tid + 256;
    int row = idx >> 3, ch = idx & 7;
    r1 = *(const u32x4*)(base + (size_t)row * stride + ch * 8);
  }
}
DI void tile64_sstore(int tid, bf16_t* dst, const u32x4& r0, const u32x4& r1) {
  {
    int idx = tid;
    int row = idx >> 3, ch = idx & 7;
    *(u32x4*)(dst + row * 64 + ((ch ^ ((row >> 1) & 7)) << 3)) = r0;
  }
  {
    int idx = tid + 256;
    int row = idx >> 3, ch = idx & 7;
    *(u32x4*)(dst + row * 64 + ((ch ^ ((row >> 1) & 7)) << 3)) = r1;
  }
}

struct AttnSt { f32x4 O[2][4]; float m[2]; float l[2]; };

template <int MODE>
DI void attn_compute(const int lane, const bf16_t* Ks, const bf16_t* Vs, const bf16x8 (&qf)[2][2], AttnSt& st, const float (&invl)[2],
                     int lo, int hi, float (&impA)[4], float (&impE)[4]) {
  const int quad = lane >> 4, col = lane & 15;
  f32x4 S[4][2];
#pragma unroll
  for (int kt = 0; kt < 4; ++kt)
#pragma unroll
    for (int hh = 0; hh < 2; ++hh) S[kt][hh] = f32x4{0.f, 0.f, 0.f, 0.f};
#pragma unroll
  for (int ks = 0; ks < 2; ++ks) {
#pragma unroll
    for (int kt = 0; kt < 4; ++kt) {
      int row = kt * 16 + col;
      bf16x8 kf = *(const bf16x8*)(Ks + row * 64 + (((ks * 4 + quad) ^ ((row >> 1) & 7)) << 3));
#pragma unroll
      for (int hh = 0; hh < 2; ++hh) S[kt][hh] = mfma16(kf, qf[hh][ks], S[kt][hh]);
    }
  }
  bf16x8 pf[2][2];
#pragma unroll
  for (int hh = 0; hh < 2; ++hh) {
    float mx = -1e30f;
#pragma unroll
    for (int kt = 0; kt < 4; ++kt)
#pragma unroll
      for (int j = 0; j < 4; ++j) {
        int kl = kt * 16 + quad * 4 + j;
        bool v = (kl >= lo) && (kl <= hi);
        float sv = v ? S[kt][hh][j] : -1e30f;
        S[kt][hh][j] = sv;
        mx = fmaxf(mx, sv);
      }
    if (MODE != 1) {
      mx = fmaxf(mx, shx(mx, 16, lane));
      mx = fmaxf(mx, shx(mx, 32, lane));
      float m_new = fmaxf(st.m[hh], mx);
      float alpha = __expf(st.m[hh] - m_new);
      st.m[hh] = m_new;
      float rs = 0.f;
#pragma unroll
      for (int kt = 0; kt < 4; ++kt)
#pragma unroll
        for (int j = 0; j < 4; ++j) {
          float sv = S[kt][hh][j];
          float pv = (sv > -1e29f) ? __expf(sv - m_new) : 0.f;
          rs += pv;
          S[kt][hh][j] = pv;
        }
      st.l[hh] = st.l[hh] * alpha + rs;
      if (MODE == 2) {
#pragma unroll
        for (int dt = 0; dt < 4; ++dt) st.O[hh][dt] *= alpha;
      }
    } else {
      const float mh = st.m[hh], il = invl[hh];
#pragma unroll
      for (int kt = 0; kt < 4; ++kt) {
        float a = 0.f;
#pragma unroll
        for (int j = 0; j < 4; ++j) {
          float sv = S[kt][hh][j];
          float pv = (sv > -1e29f) ? __expf(sv - mh) * il : 0.f;
          S[kt][hh][j] = pv;
          a += pv;
        }
        impA[kt] += a;
        impE[kt] += S[kt][hh][3];
      }
    }
    if (MODE != 0) {
#pragma unroll
      for (int c = 0; c < 2; ++c)
        pf[hh][c] = mk8(pack2(S[2 * c][hh][0], S[2 * c][hh][1]), pack2(S[2 * c][hh][2], S[2 * c][hh][3]),
                        pack2(S[2 * c + 1][hh][0], S[2 * c + 1][hh][1]), pack2(S[2 * c + 1][hh][2], S[2 * c + 1][hh][3]));
    }
  }
  if (MODE != 0) {
#pragma unroll
    for (int dt = 0; dt < 4; ++dt) {
      const int row = dt * 16 + col;
      const int sw = (row >> 1) & 7;
#pragma unroll
      for (int c = 0; c < 2; ++c) {
        uint2 a = *(const uint2*)(Vs + row * 64 + (((4 * c + (quad >> 1)) ^ sw) << 3) + (quad & 1) * 4);
        uint2 b = *(const uint2*)(Vs + row * 64 + (((4 * c + 2 + (quad >> 1)) ^ sw) << 3) + (quad & 1) * 4);
        bf16x8 vf = mk8(a.x, a.y, b.x, b.y);
#pragma unroll
        for (int hh = 0; hh < 2; ++hh) st.O[hh][dt] = mfma16(vf, pf[hh][c], st.O[hh][dt]);
      }
    }
  }
}

DI void st_reset(AttnSt& st) {
#pragma unroll
  for (int h = 0; h < 2; ++h) {
    st.m[h] = -1e30f;
    st.l[h] = 0.f;
#pragma unroll
    for (int dt = 0; dt < 4; ++dt) st.O[h][dt] = f32x4{0.f, 0.f, 0.f, 0.f};
  }
}

template <bool FIRST>
DI void nsa_flush(const int quad, bf16_t* optr, const AttnSt& st, const float (&sc)[2]) {
#pragma unroll
  for (int h = 0; h < 2; ++h)
#pragma unroll
    for (int dt = 0; dt < 4; ++dt) {
      uint2* q = (uint2*)(optr + h * 64 + dt * 16 + quad * 4);
      f32x4 o = st.O[h][dt] * sc[h];
      if (!FIRST) {
        uint2 pv = *q;
        o[0] += bflo(pv.x); o[1] += bfhi(pv.x); o[2] += bflo(pv.y); o[3] += bfhi(pv.y);
      }
      uint2 u;
      u.x = pack2(o[0], o[1]);
      u.y = pack2(o[2], o[3]);
      *q = u;
    }
}

DI void nsa_tile(const Params& p, int b, int g, int tile, bf16_t* lds) {
  const int tid = TID(), lane = tid & 63, w = tid >> 6, quad = lane >> 4, col = lane & 15;
  const int cur = tile;
  const int tok = tile * 64 + w * 16 + col;
  bf16_t* z = (bf16_t*)(p.ws + O_Z);
  const bf16_t* kcmp = (const bf16_t*)(p.ws + O_KCMP) + (size_t)(b * 2 + g) * 512 * 64;
  const bf16_t* vcmpT = (const bf16_t*)(p.ws + O_VCMPT) + (size_t)(b * 2 + g) * 64 * 512;
  const bf16_t* vsT = (const bf16_t*)(p.ws + O_VST) + (size_t)(b * 2 + g) * 64 * SEQ;
  const bf16_t* vwT = (const bf16_t*)(p.ws + O_VWT) + (size_t)(b * 2 + g) * 64 * SEQ;
  const bf16_t* zb = z + (size_t)b * SEQ * ZS;
  const bf16_t* ztok = z + ((size_t)(b * SEQ + tok)) * ZS;
  bf16_t* otok = (bf16_t*)(p.ws + O_ONSA) + ((size_t)(b * SEQ + tok)) * 512 + g * 256;
  bf16_t* Ks = lds;
  bf16_t* Vs = lds + 4096;
  float* impl = (float*)(lds + 8192);

  AttnSt st;
  float invl[2] = {0.f, 0.f};
  float dA[4] = {0.f, 0.f, 0.f, 0.f}, dE[4] = {0.f, 0.f, 0.f, 0.f};
  u32x4 rk0, rk1, rv0, rv1;
  bf16x8 qf[2][2];

  const int ncs = (cur < 16) ? 1 : (cur >> 4) + 1;
  const int chi = (tok >= 31) ? ((tok - 31) >> 4) : -1;

  for (int hp = 0; hp < 2; ++hp) {
#pragma unroll
    for (int hh = 0; hh < 2; ++hh)
#pragma unroll
      for (int ks = 0; ks < 2; ++ks) qf[hh][ks] = *(const bf16x8*)(ztok + C_Q + g * 256 + (hp * 2 + hh) * 64 + ks * 32 + quad * 8);
    st_reset(st);
    for (int s = 0; s < ncs; ++s) {
      tile64_gload(tid, rk0, rk1, kcmp + (size_t)s * 4096, 64);
      __syncthreads();
      tile64_sstore(tid, Ks, rk0, rk1);
      __syncthreads();
      attn_compute<0>(lane, Ks, Vs, qf, st, invl, 0, chi - s * 64, dA, dE);
    }
#pragma unroll
    for (int h = 0; h < 2; ++h) {
      float l = st.l[h];
      l += shx(l, 16, lane);
      l += shx(l, 32, lane);
      invl[h] = (l > 0.f) ? 1.f / l : 0.f;
    }
    {
      float carry = 0.f;
      for (int s = 0; s < ncs; ++s) {
        float iA[4] = {0.f, 0.f, 0.f, 0.f}, iE[4] = {0.f, 0.f, 0.f, 0.f};
        tile64_gload(tid, rk0, rk1, kcmp + (size_t)s * 4096, 64);
        tile64_gload(tid, rv0, rv1, vcmpT + s * 64, 512);
        __syncthreads();
        tile64_sstore(tid, Ks, rk0, rk1);
        tile64_sstore(tid, Vs, rv0, rv1);
        __syncthreads();
        attn_compute<1>(lane, Ks, Vs, qf, st, invl, 0, chi - s * 64, iA, iE);
#pragma unroll
        for (int kt = 0; kt < 4; ++kt) {
          float recv = shfrom(iE[kt], (lane + 48) & 63);
          float val = iA[kt] + ((quad == 0) ? carry : recv);
          carry = recv;
          float* slot = impl + (s * 4 + kt) * 256 + tid;
          if (hp == 0) *slot = val; else *slot += val;
        }
      }
    }
    {
      float sc[2];
#pragma unroll
      for (int h = 0; h < 2; ++h) sc[h] = sigmoidf(bf2f(ztok[C_GT + 0 * 8 + g * 4 + hp * 2 + h]));
      nsa_flush<true>(quad, otok + hp * 128, st, sc);
    }
  }

  uint32_t sw0, sw1, sw2, sw3;
  {
    uint32_t key[32];
#pragma unroll
    for (int i = 0; i < 32; ++i) {
      int j = i * 4 + quad;
      float sc = (i < ncs * 4) ? impl[i * 256 + tid] : 0.f;
      if (j == 0 || j == cur || j == cur - 1) sc = 1e4f;
      uint32_t k = (__float_as_uint(sc) & ~127u) | (uint32_t)(127 - j);
      key[i] = (j > cur) ? 0u : k;
    }
    uint32_t prev = 0xFFFFFFFFu;
    for (int r = 0; r < 16; ++r) {
      uint32_t mx = 0u;
#pragma unroll
      for (int i = 0; i < 32; ++i) {
        uint32_t k = key[i];
        k = (k < prev) ? k : 0u;
        mx = (k > mx) ? k : mx;
      }
      uint32_t o = shxu(mx, 16, lane);
      mx = (o > mx) ? o : mx;
      o = shxu(mx, 32, lane);
      mx = (o > mx) ? o : mx;
      prev = mx;
    }
    sw0 = 0u; sw1 = 0u; sw2 = 0u; sw3 = 0u;
#pragma unroll
    for (int i = 0; i < 32; ++i) {
      bool sel = (key[i] != 0u) && (key[i] >= prev);
      uint32_t bit = sel ? (1u << ((i & 7) * 4 + quad)) : 0u;
      if ((i >> 3) == 0) sw0 |= bit;
      else if ((i >> 3) == 1) sw1 |= bit;
      else if ((i >> 3) == 2) sw2 |= bit;
      else sw3 |= bit;
    }
    sw0 |= shxu(sw0, 16, lane); sw0 |= shxu(sw0, 32, lane);
    sw1 |= shxu(sw1, 16, lane); sw1 |= shxu(sw1, 32, lane);
    sw2 |= shxu(sw2, 16, lane); sw2 |= shxu(sw2, 32, lane);
    sw3 |= shxu(sw3, 16, lane); sw3 |= shxu(sw3, 32, lane);
  }

  for (int hp = 0; hp < 2; ++hp) {
#pragma unroll
    for (int hh = 0; hh < 2; ++hh)
#pragma unroll
      for (int ks = 0; ks < 2; ++ks) qf[hh][ks] = *(const bf16x8*)(ztok + C_Q + g * 256 + (hp * 2 + hh) * 64 + ks * 32 + quad * 8);
    st_reset(st);
    {
      const bf16_t* kb = zb + C_KS + g * 64;
      for (int s = 0; s <= cur; ++s) {
        tile64_gload(tid, rk0, rk1, kb + (size_t)s * 64 * ZS, ZS);
        tile64_gload(tid, rv0, rv1, vsT + s * 64, SEQ);
        __syncthreads();
        tile64_sstore(tid, Ks, rk0, rk1);
        tile64_sstore(tid, Vs, rv0, rv1);
        __syncthreads();
        uint32_t wsel = (s < 32) ? sw0 : (s < 64) ? sw1 : (s < 96) ? sw2 : sw3;
        bool sel = (wsel >> (s & 31)) & 1u;
        int hi = sel ? (tok - s * 64) : -1;
        if (__any(hi >= 0)) attn_compute<2>(lane, Ks, Vs, qf, st, invl, 0, hi, dA, dE);
      }
    }
    {
      float sc[2];
#pragma unroll
      for (int h = 0; h < 2; ++h) {
        float l = st.l[h];
        l += shx(l, 16, lane);
        l += shx(l, 32, lane);
        sc[h] = (l > 0.f) ? sigmoidf(bf2f(ztok[C_GT + 1 * 8 + g * 4 + hp * 2 + h])) / l : 0.f;
      }
      nsa_flush<false>(quad, otok + hp * 128, st, sc);
    }
    st_reset(st);
    {
      const bf16_t* kb = zb + C_KW + g * 64;
      const int s0 = (cur >= 8) ? cur - 8 : 0;
      for (int s = s0; s <= cur; ++s) {
        tile64_gload(tid, rk0, rk1, kb + (size_t)s * 64 * ZS, ZS);
        tile64_gload(tid, rv0, rv1, vwT + s * 64, SEQ);
        __syncthreads();
        tile64_sstore(tid, Ks, rk0, rk1);
        tile64_sstore(tid, Vs, rv0, rv1);
        __syncthreads();
        attn_compute<2>(lane, Ks, Vs, qf, st, invl, tok - 511 - s * 64, tok - s * 64, dA, dE);
      }
    }
    {
      float sc[2];
#pragma unroll
      for (int h = 0; h < 2; ++h) {
        float l = st.l[h];
        l += shx(l, 16, lane);
        l += shx(l, 32, lane);
        sc[h] = (l > 0.f) ? sigmoidf(bf2f(ztok[C_GT + 2 * 8 + g * 4 + hp * 2 + h])) / l : 0.f;
      }
      nsa_flush<false>(quad, otok + hp * 128, st, sc);
    }
  }
}

DI void load128(int tid, bf16_t* lds, const bf16_t* base, size_t stride) {
  u32x4 r[8];
#pragma unroll
  for (int i = 0; i < 8; ++i) {
    int idx = tid + 256 * i;
    int row = idx >> 4, ch = idx & 15;
    r[i] = *(const u32x4*)(base + (size_t)row * stride + ch * 8);
  }
#pragma unroll
  for (int i = 0; i < 8; ++i) {
    int idx = tid + 256 * i;
    int row = idx >> 4, ch = idx & 15;
    *(u32x4*)(lds + row * 128 + ((ch ^ (row & 15)) << 3)) = r[i];
  }
}

DI void ret_tile(const Params& p, int b, int h, int c, bf16_t* lds) {
  const int tid = TID(), lane = tid & 63, w = tid >> 6, quad = lane >> 4, col = lane & 15;
  const float lg2 = log2f(1.f - exp2f(-5.f - (float)h));
  bf16_t* z = (bf16_t*)(p.ws + O_Z);
  const bf16_t* rvT = (const bf16_t*)(p.ws + O_RVT);
  bf16_t* zc = z + ((size_t)(b * SEQ + c * 128)) * ZS;
  bf16x8 qf[2][4];
#pragma unroll
  for (int nt = 0; nt < 2; ++nt)
#pragma unroll
    for (int ks = 0; ks < 4; ++ks) {
      int n = 32 * w + nt * 16 + col;
      qf[nt][ks] = *(const bf16x8*)(zc + (size_t)n * ZS + C_RQ + h * 128 + ks * 32 + quad * 8);
    }
  f32x4 acc[8][2];
#pragma unroll
  for (int et = 0; et < 8; ++et)
#pragma unroll
    for (int nt = 0; nt < 2; ++nt) acc[et][nt] = f32x4{0.f, 0.f, 0.f, 0.f};
  __syncthreads();
  load128(tid, lds, zc + C_RV + h * 128, ZS);
  __syncthreads();
#pragma unroll
  for (int ks = 0; ks < 4; ++ks)
#pragma unroll
    for (int et = 0; et < 8; ++et) {
      int row = et * 16 + col;
      bf16x8 af = *(const bf16x8*)(lds + row * 128 + (((ks * 4 + quad) ^ (row & 15)) << 3));
#pragma unroll
      for (int nt = 0; nt < 2; ++nt) acc[et][nt] = mfma16(af, qf[nt][ks], acc[et][nt]);
    }
#pragma unroll
  for (int nt = 0; nt < 2; ++nt) {
    int n = 32 * w + nt * 16 + col;
    float xi = exp2f(lg2 * (float)(n + 1));
#pragma unroll
    for (int et = 0; et < 8; ++et) acc[et][nt] *= xi;
  }
  __syncthreads();
  load128(tid, lds, zc + C_RK + h * 128, ZS);
  __syncthreads();
  bf16x8 pf[2][4];
#pragma unroll
  for (int nt = 0; nt < 2; ++nt) {
    f32x4 s[8];
#pragma unroll
    for (int mt = 0; mt < 8; ++mt) s[mt] = f32x4{0.f, 0.f, 0.f, 0.f};
#pragma unroll
    for (int ks = 0; ks < 4; ++ks)
#pragma unroll
      for (int mt = 0; mt < 8; ++mt) {
        if (mt <= 2 * w + 1) {
          int row = mt * 16 + col;
          bf16x8 af = *(const bf16x8*)(lds + row * 128 + (((ks * 4 + quad) ^ (row & 15)) << 3));
          s[mt] = mfma16(af, qf[nt][ks], s[mt]);
        }
      }
    const int n = 32 * w + nt * 16 + col;
#pragma unroll
    for (int c2 = 0; c2 < 4; ++c2) {
      float v[8];
#pragma unroll
      for (int i = 0; i < 8; ++i) {
        const int mt = 2 * c2 + (i >> 2), j = i & 3;
        const int m = mt * 16 + quad * 4 + j;
        v[i] = (n >= m) ? s[mt][j] * exp2f(lg2 * (float)(n - m)) : 0.f;
      }
      pf[nt][c2] = mk8(pack2(v[0], v[1]), pack2(v[2], v[3]), pack2(v[4], v[5]), pack2(v[6], v[7]));
    }
  }
  __syncthreads();
  load128(tid, lds, rvT + ((size_t)((b * 4 + h) * 128)) * SEQ + c * 128, SEQ);
  __syncthreads();
#pragma unroll
  for (int c2 = 0; c2 < 4; ++c2) {
    if (2 * c2 <= 2 * w + 1) {
#pragma unroll
      for (int et = 0; et < 8; ++et) {
        int row = et * 16 + col;
        int sw = row & 15;
        uint2 a = *(const uint2*)(lds + row * 128 + (((4 * c2 + (quad >> 1)) ^ sw) << 3) + (quad & 1) * 4);
        uint2 bb = *(const uint2*)(lds + row * 128 + (((4 * c2 + 2 + (quad >> 1)) ^ sw) << 3) + (quad & 1) * 4);
        bf16x8 vf = mk8(a.x, a.y, bb.x, bb.y);
#pragma unroll
        for (int nt = 0; nt < 2; ++nt) acc[et][nt] = mfma16(vf, pf[nt][c2], acc[et][nt]);
      }
    }
  }
#pragma unroll
  for (int nt = 0; nt < 2; ++nt) {
    float ss = 0.f;
#pragma unroll
    for (int et = 0; et < 8; ++et)
#pragma unroll
      for (int j = 0; j < 4; ++j) ss += acc[et][nt][j] * acc[et][nt][j];
    ss += shx(ss, 16, lane);
    ss += shx(ss, 32, lane);
    const float rs = rsqrtf(ss * (1.f / 128.f) + 1e-6f);
    const int n = 32 * w + nt * 16 + col;
    bf16_t* zr = zc + (size_t)n * ZS;
#pragma unroll
    for (int et = 0; et < 8; ++et) {
      const int e0 = et * 16 + quad * 4;
      uint2 gv = *(const uint2*)(zr + C_RG + h * 128 + e0);
      float g0 = bflo(gv.x), g1 = bfhi(gv.x), g2 = bflo(gv.y), g3 = bfhi(gv.y);
      uint2 o;
      o.x = pack2(acc[et][nt][0] * rs * g0 * sigmoidf(g0), acc[et][nt][1] * rs * g1 * sigmoidf(g1));
      o.y = pack2(acc[et][nt][2] * rs * g2 * sigmoidf(g2), acc[et][nt][3] * rs * g3 * sigmoidf(g3));
      *(uint2*)(zr + C_RQ + h * 128 + e0) = o;
    }
  }
}

#define GEMM_TILE_LOOP(NT)                                                             \
  for (int q_ = (int)(blockIdx.x >> 3), per_ = (int)(gridDim.x >> 3), xcd_ = (int)(blockIdx.x & 7), mt = 0, ntile = 0; \
       q_ < 32 * (NT) && ((mt = (((xcd_ + 8 * (q_ / (8 * (NT)))) << 3) + ((q_ % (8 * (NT))) & 7)), ntile = ((q_ % (8 * (NT))) >> 3)), true); \
       q_ += per_)

__global__ void __launch_bounds__(256, 2) mega(Params p) {
  __shared__ __attribute__((aligned(16))) bf16_t lds[32768];
  cg::grid_group grid = cg::this_grid();
  const int nb = gridDim.x;
  bf16_t* wt = (bf16_t*)(p.ws + O_WT);
  bf16_t* z = (bf16_t*)(p.ws + O_Z);
  bf16_t* hbuf = (bf16_t*)(p.ws + O_VST);
  bf16_t* ubuf = z;
  bf16_t* p16 = z;
  bf16_t* hid = (bf16_t*)(p.ws + O_HID);
  const float* bias = (const float*)(p.ws + O_BIAS);

  for (int layer = 0; layer < 2; ++layer) {
    const bf16_t* wl = wt;
    const float* xin = (layer == 0) ? p.x : p.out;

    phase0(p, layer);
    norm_phase(xin, p.norm_mix + layer * DM, hbuf);
    grid.sync();

    GEMM_TILE_LOOP(43) {
      const int m0 = mt * 128, n0 = ntile * 128;
      f32x4 acc[4][4];
      zero_acc(acc);
      gemm_accum(acc, RowPtr{hbuf + (size_t)m0 * DM, DM}, RowPtr{wl + W_IN + (size_t)n0 * 1024, 1024}, 16, lds);
      gemm_epi(acc, m0, n0, [&](int m, int n, f32x4& a) {
        if (n < ZS) {
          uint2 u;
          u.x = pack2(a[0], a[1]);
          u.y = pack2(a[2], a[3]);
          *(uint2*)(z + (size_t)m * ZS + n) = u;
        }
      });
    }
    grid.sync();

    post_z(p, layer);
    grid.sync();

    for (int t = blockIdx.x; t < 128 + 1024; t += nb) {
      f32x4 acc[4][4];
      zero_acc(acc);
      if (t < 128) {
        const int kv = t >> 6, mt = (t >> 1) & 31, ntile = t & 1;
        const int m0 = mt * 128, n0 = ntile * 128;
        const int colbase = kv ? C_VC : C_KC;
        auto ap = [&](int r, int kb) -> const bf16_t* {
          int row = m0 + r;
          int bg = row >> 9, c = row & 511;
          int tk = 16 * c + kb;
          tk = tk > (SEQ - 1) ? (SEQ - 1) : tk;
          return z + ((size_t)((bg >> 1) * SEQ + tk)) * ZS + colbase + (bg & 1) * 64;
        };
        gemm_accum(acc, ap, RowPtr{wl + (kv ? W_C1V : W_C1K) + (size_t)n0 * 2048, 2048}, 32, lds);
        const float* bs = bias + kv * 256;
        bf16_t* hd = hid + (size_t)kv * 4096 * 256;
        gemm_epi(acc, m0, n0, [&](int m, int n, f32x4& a) {
          float o[4];
#pragma unroll
          for (int j = 0; j < 4; ++j) {
            float xv = a[j] + bs[n + j];
            float y = 0.7978845608028654f * (xv + 0.044715f * xv * xv * xv);
            float th = 1.f - 2.f / (__expf(2.f * y) + 1.f);
            o[j] = 0.5f * xv * (1.f + th);
          }
          uint2 u;
          u.x = pack2(o[0], o[1]);
          u.y = pack2(o[2], o[3]);
          *(uint2*)(hd + (size_t)m * 256 + n) = u;
        });
      } else {
        const int idx = t - 128;
        const int c = idx & 63, bh = idx >> 6;
        const bf16_t* rvT = (const bf16_t*)(p.ws + O_RVT) + ((size_t)bh * 128) * SEQ + c * 128;
        const bf16_t* kzT = (const bf16_t*)(p.ws + O_KZT) + ((size_t)bh * 128) * SEQ + c * 128;
        gemm_accum(acc, RowPtr{rvT, SEQ}, RowPtr{kzT, SEQ}, 2, lds);
        bf16_t* dst = z + ((size_t)((bh >> 2) * SEQ + c * 128)) * ZS + C_RV + (bh & 3) * 128;
        gemm_epi(acc, 0, 0, [&](int m, int n, f32x4& a) {
          uint2 u;
          u.x = pack2(a[0], a[1]);
          u.y = pack2(a[2], a[3]);
          *(uint2*)(dst + (size_t)m * ZS + n) = u;
        });
      }
    }
    grid.sync();

    phase4b(p, layer);
    grid.sync();

    for (int t = blockIdx.x; t < 2048; t += nb) {
      if (t < 1024) {
        const int tile = (t < 512) ? 127 - (t >> 3) : ((t - 512) >> 3), bg = t & 7;
        nsa_tile(p, bg >> 1, bg & 1, tile, lds);
      } else {
        const int idx = t - 1024;
        ret_tile(p, idx >> 8, (idx >> 6) & 3, idx & 63, lds);
      }
    }
    grid.sync();

    GEMM_TILE_LOOP(8) {
      const int m0 = mt * 128, n0 = ntile * 128;
      f32x4 acc[4][4];
      zero_acc(acc);
      gemm_accum(acc, RowPtr{(const bf16_t*)(p.ws + O_ONSA) + (size_t)m0 * 512, 512}, RowPtr{wl + W_UPA + (size_t)n0 * 512, 512}, 8, lds);
      gemm_epi(acc, m0, n0, [&](int m, int n, f32x4& a) {
        uint2 ua = *(const uint2*)(z + (size_t)m * ZS + C_MA + n);
        uint2 ub = *(const uint2*)(z + (size_t)m * ZS + C_MB + n);
        a[0] *= sigmoidf(bflo(ua.x)) / sigmoidf(bflo(ub.x));
        a[1] *= sigmoidf(bfhi(ua.x)) / sigmoidf(bfhi(ub.x));
        a[2] *= sigmoidf(bflo(ua.y)) / sigmoidf(bflo(ub.y));
        a[3] *= sigmoidf(bfhi(ua.y)) / sigmoidf(bfhi(ub.y));
      });
      gemm_accum(acc, RowPtr{z + (size_t)m0 * ZS + C_RQ, ZS}, RowPtr{wl + W_UPR + (size_t)n0 * 512, 512}, 8, lds);
      gemm_epi(acc, m0, n0, [&](int m, int n, f32x4& a) {
        uint2 ub = *(const uint2*)(z + (size_t)m * ZS + C_MB + n);
        uint2 u;
        u.x = pack2(a[0] * sigmoidf(bflo(ub.x)), a[1] * sigmoidf(bfhi(ub.x)));
        u.y = pack2(a[2] * sigmoidf(bflo(ub.y)), a[3] * sigmoidf(bfhi(ub.y)));
        *(uint2*)(z + (size_t)m * ZS + C_RK + n) = u;
      });
    }
    grid.sync();

    GEMM_TILE_LOOP(8) {
      const int m0 = mt * 128, n0 = ntile * 128;
      f32x4 acc[4][4];
      zero_acc(acc);
      gemm_accum(acc, RowPtr{z + (size_t)m0 * ZS + C_RK, ZS}, RowPtr{wl + W_OUT + (size_t)n0 * 1024, 1024}, 16, lds);
      gemm_epi(acc, m0, n0, [&](int m, int n, f32x4& a) {
        float4 xv = *(const float4*)(xin + (size_t)m * DM + n);
        *(float4*)(p.out + (size_t)m * DM + n) = make_float4(xv.x + a[0], xv.y + a[1], xv.z + a[2], xv.w + a[3]);
      });
    }
    grid.sync();

    norm_phase(p.out, p.norm_mlp + layer * DM, hbuf);
    grid.sync();

    GEMM_TILE_LOOP(32) {
      const int m0 = mt * 128, n0 = ntile * 128;
      f32x4 acc[4][4];
      zero_acc(acc);
      gemm_accum(acc, RowPtr{hbuf + (size_t)m0 * DM, DM}, RowPtr{wl + W_FF1 + (size_t)n0 * 1024, 1024}, 16, lds);
      gemm_epi(acc, m0, n0, [&](int m, int n, f32x4& a) {
        float r0 = fmaxf(a[0], 0.f), r1 = fmaxf(a[1], 0.f), r2 = fmaxf(a[2], 0.f), r3 = fmaxf(a[3], 0.f);
        uint2 u;
        u.x = pack2(r0 * r0, r1 * r1);
        u.y = pack2(r2 * r2, r3 * r3);
        *(uint2*)(ubuf + (size_t)m * 4096 + n) = u;
      });
    }
    grid.sync();

    GEMM_TILE_LOOP(8) {
      const int m0 = mt * 128, n0 = ntile * 128;
      f32x4 acc[4][4];
      zero_acc(acc);
      gemm_accum(acc, RowPtr{ubuf + (size_t)m0 * 4096, 4096}, RowPtr{wl + W_FF2 + (size_t)n0 * 4096, 4096}, 64, lds);
      gemm_epi(acc, m0, n0, [&](int m, int n, f32x4& a) {
        float4* o = (float4*)(p.out + (size_t)m * DM + n);
        float4 xv = *o;
        *o = make_float4(xv.x + a[0], xv.y + a[1], xv.z + a[2], xv.w + a[3]);
      });
    }
    grid.sync();

    norm_phase(p.out, p.norm_ple + layer * DM, hbuf);
    {
      const float* pl = p.p + (size_t)layer * T_TOK * 256;
      const int gtid = blockIdx.x * 256 + TID();
      const int gthreads = nb * 256;
      for (int i = gtid; i < T_TOK * 32; i += gthreads) {
        float4 a = ((const float4*)pl)[2 * i], b2 = ((const float4*)pl)[2 * i + 1];
        ((uint4*)p16)[i] = make_uint4(pack2(a.x, a.y), pack2(a.z, a.w), pack2(b2.x, b2.y), pack2(b2.z, b2.w));
      }
    }
    grid.sync();

    GEMM_TILE_LOOP(8) {
      const int m0 = mt * 128, n0 = ntile * 128;
      f32x4 acc[4][4];
      zero_acc(acc);
      gemm_accum(acc, RowPtr{p16 + (size_t)m0 * 256, 256}, RowPtr{wl + W_PLE + (size_t)n0 * 256, 256}, 4, lds);
      uint2 pp[4][4];
#pragma unroll
      for (int i = 0; i < 4; ++i)
#pragma unroll
        for (int j = 0; j < 4; ++j) {
          pp[i][j].x = pack2(acc[i][j][0], acc[i][j][1]);
          pp[i][j].y = pack2(acc[i][j][2], acc[i][j][3]);
        }
      zero_acc(acc);
      gemm_accum(acc, RowPtr{hbuf + (size_t)m0 * DM, DM}, RowPtr{wl + W_PG + (size_t)n0 * 1024, 1024}, 16, lds);
      {
        const int tid_ = TID();
        const int lane = tid_ & 63, w = tid_ >> 6;
        const int wm = w >> 1, wn = w & 1;
#pragma unroll
        for (int i = 0; i < 4; ++i)
#pragma unroll
          for (int j = 0; j < 4; ++j) {
            int m = m0 + wm * 64 + i * 16 + (lane & 15);
            int n = n0 + wn * 64 + j * 16 + (lane >> 4) * 4;
            float4* o = (float4*)(p.out + (size_t)m * DM + n);
            float4 xv = *o;
            f32x4 a = acc[i][j];
            *o = make_float4(xv.x + sigmoidf(a[0]) * bflo(pp[i][j].x), xv.y + sigmoidf(a[1]) * bfhi(pp[i][j].x),
                             xv.z + sigmoidf(a[2]) * bflo(pp[i][j].y), xv.w + sigmoidf(a[3]) * bfhi(pp[i][j].y));
          }
      }
    }
    grid.sync();
  }
}

extern "C" void kernel_launch(void* const* d_in, const int* in_sizes, int n_in,
                              void* d_out, int out_size, void* d_ws, size_t ws_size,
                              hipStream_t stream) {
  static int grid_blocks = 0;
  if (!grid_blocks) {
    int dev = 0, cus = 0, per_cu = 0;
    hipGetDevice(&dev);
    hipDeviceGetAttribute(&cus, hipDeviceAttributeMultiprocessorCount, dev);
    hipOccupancyMaxActiveBlocksPerMultiprocessor(&per_cu, mega, 256, 0);
    if (per_cu > 2) per_cu = 2;
    if (per_cu < 1) per_cu = 1;
    grid_blocks = cus * per_cu;
  }
  if (ws_size < WS_NEED) {
    fprintf(stderr, "workspace too small: %zu < %llu\n", ws_size, (unsigned long long)WS_NEED);
    return;
  }
  Params p{};
  p.x = (const float*)d_in[0]; p.p = (const float*)d_in[1]; p.norm_mix = (const float*)d_in[2]; p.w_in = (const float*)d_in[3];
  p.nsa_q_norm = (const float*)d_in[4]; p.nsa_k_norm = (const float*)d_in[5]; p.cmp_pos_k = (const float*)d_in[6];
  p.cmp_pos_v = (const float*)d_in[7]; p.cmp_w1_k = (const float*)d_in[8]; p.cmp_w2_k = (const float*)d_in[9];
  p.cmp_w1_v = (const float*)d_in[10]; p.cmp_w2_v = (const float*)d_in[11]; p.w_up_nsa = (const float*)d_in[12];
  p.w_up_ret = (const float*)d_in[13]; p.w_out = (const float*)d_in[14]; p.norm_mlp = (const float*)d_in[15];
  p.w_ff1 = (const float*)d_in[16]; p.w_ff2 = (const float*)d_in[17]; p.norm_ple = (const float*)d_in[18];
  p.w_ple = (const float*)d_in[19]; p.w_ple_gate = (const float*)d_in[20];
  p.out = (float*)d_out; p.ws = (char*)d_ws;
  void* args[] = {&p};
  hipError_t e = hipLaunchCooperativeKernel((void*)mega, dim3(grid_blocks), dim3(256), args, 0, stream);
  if (e != hipSuccess) fprintf(stderr, "cooperative launch failed: %s (grid %d)\n", hipGetErrorString(e), grid_blocks);
}
```

```cpp
#include <hip/hip_runtime.h>
#include <hip/hip_cooperative_groups.h>
#include <cstdio>
#include <cstdint>
namespace cg = cooperative_groups;

typedef __attribute__((ext_vector_type(8))) short bf16x8;
typedef __attribute__((ext_vector_type(4))) float f32x4;
typedef unsigned short bf16_t;
typedef __attribute__((ext_vector_type(4))) unsigned u32x4;
#define DI __device__ __forceinline__

#define T_TOK 32768
#define SEQ 8192
#define DM 1024
#define ZS 5400
#define C_Q 0
#define C_KC 512
#define C_VC 640
#define C_KS 768
#define C_VS 896
#define C_KW 1024
#define C_VW 1152
#define C_GT 1280
#define C_RQ 1304
#define C_RK 1816
#define C_RV 2328
#define C_RG 2840
#define C_MA 3352
#define C_MB 4376
#define NPAD_IN 5504

#define W_IN 0
#define W_C1K 5636096
#define W_C1V 6160384
#define W_UPA 6684672
#define W_UPR 7208960
#define W_OUT 7733248
#define W_FF1 8781824
#define W_FF2 12976128
#define W_PLE 17170432
#define W_PG 17432576
#define W_LAYER 18481152

#define O_WT 0ull
#define O_ROPE 36962304ull
#define O_BIAS 41156608ull
#define O_HID 41160704ull
#define O_KCMP 45355008ull
#define O_VCMPT 45879296ull
#define O_VST 46403584ull
#define O_VWT 54792192ull
#define O_RVT 63180800ull
#define O_KZT 96735232ull
#define O_Z 130289664ull
#define O_ONSA 484184064ull
#define O_BAR 517738496ull
#define BAR_BYTES 13824
#define WS_NEED 517752320ull

struct Params {
  const float* x; const float* p; const float* norm_mix; const float* w_in;
  const float* nsa_q_norm; const float* nsa_k_norm; const float* cmp_pos_k; const float* cmp_pos_v;
  const float* cmp_w1_k; const float* cmp_w2_k; const float* cmp_w1_v; const float* cmp_w2_v;
  const float* w_up_nsa; const float* w_up_ret; const float* w_out; const float* norm_mlp;
  const float* w_ff1; const float* w_ff2; const float* norm_ple; const float* w_ple; const float* w_ple_gate;
  float* out; char* ws;
};

DI unsigned pack2(float a, float b) {
  typedef __attribute__((ext_vector_type(2))) __bf16 bf2;
  typedef __attribute__((ext_vector_type(2))) float f2;
  f2 v = {a, b};
  bf2 r = __builtin_convertvector(v, bf2);
  return __builtin_bit_cast(unsigned, r);
}
DI bf16_t f2bf(float a) { return (bf16_t)(pack2(a, 0.f) & 0xffffu); }
DI float bf2f(bf16_t h) { return __uint_as_float(((unsigned)h) << 16); }
DI float bflo(unsigned u) { return __uint_as_float(u << 16); }
DI float bfhi(unsigned u) { return __uint_as_float(u & 0xffff0000u); }
DI float shx(float v, int mask, int lane) {
  return __int_as_float(__builtin_amdgcn_ds_bpermute((lane ^ mask) << 2, __float_as_int(v)));
}
DI uint32_t shxu(uint32_t v, int mask, int lane) {
  return (uint32_t)__builtin_amdgcn_ds_bpermute((lane ^ mask) << 2, (int)v);
}
DI float shfrom(float v, int srclane) {
  return __int_as_float(__builtin_amdgcn_ds_bpermute(srclane << 2, __float_as_int(v)));
}
DI float wave_sum(float v, int lane) {
#pragma unroll
  for (int o = 32; o > 0; o >>= 1) v += shx(v, o, lane);
  return v;
}
DI int TID() { int t = threadIdx.x; asm volatile("" : "+v"(t)); return t; }
DI float sigmoidf(float x) { return 1.f / (1.f + __expf(-x)); }
DI f32x4 mfma16(bf16x8 a, bf16x8 b, f32x4 c) { return __builtin_amdgcn_mfma_f32_16x16x32_bf16(a, b, c, 0, 0, 0); }
DI bf16x8 mk8(unsigned a, unsigned b, unsigned c, unsigned d) {
  uint4 u = make_uint4(a, b, c, d);
  return __builtin_bit_cast(bf16x8, u);
}

template <class AP, class BP>
DI void g_load(u32x4 (&ra)[4], u32x4 (&rb)[4], const AP& ap, const BP& bp, int kb, int lrow, int lch) {
#pragma unroll
  for (int i = 0; i < 4; ++i) {
    ra[i] = *(const u32x4*)(ap(lrow + 32 * i, kb) + lch * 8);
    rb[i] = *(const u32x4*)(bp(lrow + 32 * i, kb) + lch * 8);
  }
}
DI void g_store(bf16_t* As, bf16_t* Bs, const u32x4 (&ra)[4], const u32x4 (&rb)[4], int buf, int lrow, int lch) {
#pragma unroll
  for (int i = 0; i < 4; ++i) {
    int r = lrow + 32 * i;
    int off = buf * 8192 + r * 64 + ((lch ^ ((r >> 1) & 7)) << 3);
    *(u32x4*)(As + off) = ra[i];
    *(u32x4*)(Bs + off) = rb[i];
  }
}
DI void g_compute(f32x4 (&acc)[4][4], const bf16_t* a, const bf16_t* b, int wm, int wn, int lane) {
#pragma unroll
  for (int ks = 0; ks < 2; ++ks) {
    bf16x8 af[4], bfr[4];
#pragma unroll
    for (int i = 0; i < 4; ++i) {
      int r = wm * 64 + i * 16 + (lane & 15);
      af[i] = *(const bf16x8*)(a + r * 64 + (((ks * 4 + (lane >> 4)) ^ ((r >> 1) & 7)) << 3));
      int r2 = wn * 64 + i * 16 + (lane & 15);
      bfr[i] = *(const bf16x8*)(b + r2 * 64 + (((ks * 4 + (lane >> 4)) ^ ((r2 >> 1) & 7)) << 3));
    }
#pragma unroll
    for (int i = 0; i < 4; ++i)
#pragma unroll
      for (int j = 0; j < 4; ++j) acc[i][j] = mfma16(bfr[j], af[i], acc[i][j]);
  }
}
template <class AP, class BP>
DI void gemm_accum(f32x4 (&acc)[4][4], AP ap, BP bp, int nkb, bf16_t* lds) {
  const int tid = TID(), lane = tid & 63, w = tid >> 6;
  const int wm = w >> 1, wn = w & 1;
  const int lrow = tid >> 3, lch = tid & 7;
  bf16_t* As = lds;
  bf16_t* Bs = lds + 16384;
  u32x4 ra0[4], rb0[4], ra1[4], rb1[4];
  __syncthreads();
  g_load(ra0, rb0, ap, bp, 0, lrow, lch);
  g_load(ra1, rb1, ap, bp, 1, lrow, lch);
  g_store(As, Bs, ra0, rb0, 0, lrow, lch);
  __syncthreads();
  for (int kb = 0; kb < nkb; kb += 2) {
    if (kb + 2 < nkb) g_load(ra0, rb0, ap, bp, kb + 2, lrow, lch);
    g_compute(acc, As, Bs, wm, wn, lane);
    g_store(As, Bs, ra1, rb1, 1, lrow, lch);
    __syncthreads();
    if (kb + 3 < nkb) g_load(ra1, rb1, ap, bp, kb + 3, lrow, lch);
    g_compute(acc, As + 8192, Bs + 8192, wm, wn, lane);
    if (kb + 2 < nkb) g_store(As, Bs, ra0, rb0, 0, lrow, lch);
    __syncthreads();
  }
}
template <class E>
DI void gemm_epi(f32x4 (&acc)[4][4], int m0, int n0, E e) {
  const int tid_ = TID();
  const int lane = tid_ & 63, w = tid_ >> 6;
  const int wm = w >> 1, wn = w & 1;
#pragma unroll
  for (int i = 0; i < 4; ++i)
#pragma unroll
    for (int j = 0; j < 4; ++j) {
      int m = m0 + wm * 64 + i * 16 + (lane & 15);
      int n = n0 + wn * 64 + j * 16 + (lane >> 4) * 4;
      e(m, n, acc[i][j]);
    }
}
DI void zero_acc(f32x4 (&acc)[4][4]) {
#pragma unroll
  for (int i = 0; i < 4; ++i)
#pragma unroll
    for (int j = 0; j < 4; ++j) acc[i][j] = f32x4{0.f, 0.f, 0.f, 0.f};
}
struct RowPtr {
  const bf16_t* base; size_t ld;
  DI const bf16_t* operator()(int r, int kb) const { return base + (size_t)r * ld + kb * 64; }
};

DI void convert_wt(const float* W, bf16_t* Wt, int K, int N, int Npad, int gtid, int gthreads) {
  const int k8n = K >> 3;
  const long total = (long)Npad * k8n;
  for (long idx = gtid; idx < total; idx += gthreads) {
    int n = (int)(idx % Npad);
    int k8 = (int)(idx / Npad);
    uint4 o = make_uint4(0, 0, 0, 0);
    if (n < N) {
      const float* s = W + (size_t)(k8 * 8) * N + n;
      float v0 = s[0], v1 = s[(size_t)N], v2 = s[(size_t)2 * N], v3 = s[(size_t)3 * N];
      float v4 = s[(size_t)4 * N], v5 = s[(size_t)5 * N], v6 = s[(size_t)6 * N], v7 = s[(size_t)7 * N];
      o = make_uint4(pack2(v0, v1), pack2(v2, v3), pack2(v4, v5), pack2(v6, v7));
    }
    *(uint4*)(Wt + (size_t)n * K + k8 * 8) = o;
  }
}

DI void phase0(const Params& p, const int L) {
  const int gtid = blockIdx.x * 256 + TID();
  const int gthreads = gridDim.x * 256;
  bf16_t* wl = (bf16_t*)(p.ws + O_WT);
  convert_wt(p.w_in + (size_t)L * 1024 * 5400, wl + W_IN, 1024, 5400, NPAD_IN, gtid, gthreads);
  convert_wt(p.cmp_w1_k + (size_t)L * 2048 * 256, wl + W_C1K, 2048, 256, 256, gtid, gthreads);
  convert_wt(p.cmp_w1_v + (size_t)L * 2048 * 256, wl + W_C1V, 2048, 256, 256, gtid, gthreads);
  convert_wt(p.w_up_nsa + (size_t)L * 512 * 1024, wl + W_UPA, 512, 1024, 1024, gtid, gthreads);
  convert_wt(p.w_up_ret + (size_t)L * 512 * 1024, wl + W_UPR, 512, 1024, 1024, gtid, gthreads);
  convert_wt(p.w_out + (size_t)L * 1024 * 1024, wl + W_OUT, 1024, 1024, 1024, gtid, gthreads);
  convert_wt(p.w_ff1 + (size_t)L * 1024 * 4096, wl + W_FF1, 1024, 4096, 4096, gtid, gthreads);
  convert_wt(p.w_ff2 + (size_t)L * 4096 * 1024, wl + W_FF2, 4096, 1024, 1024, gtid, gthreads);
  convert_wt(p.w_ple + (size_t)L * 256 * 1024, wl + W_PLE, 256, 1024, 1024, gtid, gthreads);
  convert_wt(p.w_ple_gate + (size_t)L * 1024 * 1024, wl + W_PG, 1024, 1024, 1024, gtid, gthreads);
  if (L == 0) {
    float2* rope = (float2*)(p.ws + O_ROPE);
    for (int idx = gtid; idx < SEQ * 64; idx += gthreads) {
      int pos = idx >> 6, j = idx & 63;
      float inv = exp2f(-(float)j * (13.287712379549449f / 64.f));
      float ang = (float)pos * inv;
      double rev = (double)ang * 0.15915494309189535;
      rev -= rint(rev);
      float fr = (float)rev;
      rope[idx] = make_float2(__builtin_amdgcn_cosf(fr), __builtin_amdgcn_sinf(fr));
    }
  }
  float* part = (float*)(p.ws + O_HID);
  {
    const int n = gtid & 255;
    for (int item = (int)blockIdx.x; item < 128; item += (int)gridDim.x) {
      const int kv = item >> 6, kc = item & 63;
      const float* pos = (kv ? p.cmp_pos_v : p.cmp_pos_k) + L * 2048 + kc * 32;
      const float* w1 = (kv ? p.cmp_w1_v : p.cmp_w1_k) + (size_t)L * 2048 * 256 + (size_t)kc * 32 * 256;
      float a = 0.f;
#pragma unroll 8
      for (int k = 0; k < 32; ++k) a += pos[k] * w1[(size_t)k * 256 + n];
      part[item * 256 + n] = a;
    }
  }
}

DI void norm_phase(const float* xin, const float* g, bf16_t* h) {
  const int tid_ = TID();
  const int lane = tid_ & 63;
  const int gw = (blockIdx.x * 256 + tid_) >> 6;
  const int nw = gridDim.x * 4;
  float4 gv[4];
#pragma unroll
  for (int i = 0; i < 4; ++i) gv[i] = ((const float4*)g)[i * 64 + lane];
  for (int row = gw; row < T_TOK; row += nw) {
    const float4* xr = (const float4*)(xin + (size_t)row * DM);
    float4 v[4];
    float ss = 0.f;
#pragma unroll
    for (int i = 0; i < 4; ++i) {
      v[i] = xr[i * 64 + lane];
      ss += v[i].x * v[i].x + v[i].y * v[i].y + v[i].z * v[i].z + v[i].w * v[i].w;
    }
    ss = wave_sum(ss, lane);
    float rs = rsqrtf(ss * (1.f / 1024.f) + 1e-6f);
    uint2* hr = (uint2*)(h + (size_t)row * DM);
#pragma unroll
    for (int i = 0; i < 4; ++i) {
      uint2 o;
      o.x = pack2(v[i].x * rs * gv[i].x, v[i].y * rs * gv[i].y);
      o.y = pack2(v[i].z * rs * gv[i].z, v[i].w * rs * gv[i].w);
      hr[i * 64 + lane] = o;
    }
  }
}

DI void post_z(const Params& p, int layer) {
  const int tid_ = TID();
  const int lane = tid_ & 63;
  const int gw = (blockIdx.x * 256 + tid_) >> 6;
  const int nw = gridDim.x * 4;
  bf16_t* z = (bf16_t*)(p.ws + O_Z);
  bf16_t* vsT = (bf16_t*)(p.ws + O_VST);
  bf16_t* vwT = (bf16_t*)(p.ws + O_VWT);
  bf16_t* rvT = (bf16_t*)(p.ws + O_RVT);
  bf16_t* kzT = (bf16_t*)(p.ws + O_KZT);
  const float2* rope = (const float2*)(p.ws + O_ROPE);
  const float* qn = p.nsa_q_norm + layer * 64;
  const float* kn = p.nsa_k_norm + layer * 64;
  {
    const float* part = (const float*)(p.ws + O_HID);
    float* bias = (float*)(p.ws + O_BIAS);
    const int idx = blockIdx.x * 256 + tid_;
    if (idx < 512) {
      const int kv = idx >> 8, n = idx & 255;
      float a = 0.f;
      for (int kc = 0; kc < 64; ++kc) a += part[(kv * 64 + kc) * 256 + n];
      bias[idx] = a;
    }
  }
  for (int item = gw; item < 4096 * 32; item += nw) {
    const int slab = item & 31, tc = item >> 5;
    const int tok0 = tc * 8;
    const int b = tok0 >> 13, spos = tok0 & 8191;
    bf16_t* zr = z + (size_t)tok0 * ZS;
    if (slab < 12) {
      int colbase; const float* g; float sc;
      if (slab < 8) { colbase = C_Q + slab * 64; g = qn; sc = 0.125f; }
      else if (slab < 10) { colbase = C_KS + (slab - 8) * 64; g = kn; sc = 1.f; }
      else { colbase = C_KW + (slab - 10) * 64; g = kn; sc = 1.f; }
      const float gv = g[lane] * sc;
#pragma unroll
      for (int i = 0; i < 8; ++i) {
        bf16_t* ptr = zr + (size_t)i * ZS + colbase + lane;
        float v = bf2f(*ptr);
        float ss = wave_sum(v * v, lane);
        float rs = rsqrtf(ss * (1.f / 64.f) + 1e-6f);
        *ptr = f2bf(v * rs * gv);
      }
    } else if (slab < 16) {
      const int gi = slab & 1;
      const bool isw = slab >= 14;
      const int colbase = (isw ? C_VW : C_VS) + gi * 64;
      bf16_t* dst = (isw ? vwT : vsT) + ((size_t)((b * 2 + gi) * 64 + lane)) * SEQ + spos;
      unsigned u[8];
#pragma unroll
      for (int i = 0; i < 8; ++i) u[i] = zr[(size_t)i * ZS + colbase + lane];
      *(uint4*)dst = make_uint4(u[0] | (u[1] << 16), u[2] | (u[3] << 16), u[4] | (u[5] << 16), u[6] | (u[7] << 16));
    } else if (slab < 20) {
      const int h = slab - 16;
      const int colbase = C_RQ + h * 128;
#pragma unroll
      for (int i = 0; i < 8; ++i) {
        bf16_t* p1 = zr + (size_t)i * ZS + colbase + lane;
        float x1 = bf2f(p1[0]), x2 = bf2f(p1[64]);
        float2 cs = rope[(spos + i) * 64 + lane];
        p1[0] = f2bf(x1 * cs.x - x2 * cs.y);
        p1[64] = f2bf(x1 * cs.y + x2 * cs.x);
      }
    } else if (slab < 24) {
      const int h = slab - 20;
      const int colbase = C_RK + h * 128;
      const float lg2 = log2f(1.f - exp2f(-5.f - (float)h));
      unsigned u1[8], u2[8];
#pragma unroll
      for (int i = 0; i < 8; ++i) {
        bf16_t* p1 = zr + (size_t)i * ZS + colbase + lane;
        float x1 = bf2f(p1[0]), x2 = bf2f(p1[64]);
        float2 cs = rope[(spos + i) * 64 + lane];
        float o1 = (x1 * cs.x - x2 * cs.y) * 0.08838834764831845f;
        float o2 = (x1 * cs.y + x2 * cs.x) * 0.08838834764831845f;
        p1[0] = f2bf(o1);
        p1[64] = f2bf(o2);
        float zeta = exp2f(lg2 * (float)(127 - ((spos + i) & 127)));
        u1[i] = f2bf(o1 * zeta);
        u2[i] = f2bf(o2 * zeta);
      }
      bf16_t* d1 = kzT + ((size_t)((b * 4 + h) * 128 + lane)) * SEQ + spos;
      *(uint4*)d1 = make_uint4(u1[0] | (u1[1] << 16), u1[2] | (u1[3] << 16), u1[4] | (u1[5] << 16), u1[6] | (u1[7] << 16));
      *(uint4*)(d1 + (size_t)64 * SEQ) = make_uint4(u2[0] | (u2[1] << 16), u2[2] | (u2[3] << 16), u2[4] | (u2[5] << 16), u2[6] | (u2[7] << 16));
    } else {
      const int s8 = slab - 24;
      const int h = s8 >> 1, half = s8 & 1;
      const int colbase = C_RV + s8 * 64;
      bf16_t* dst = rvT + ((size_t)((b * 4 + h) * 128 + half * 64 + lane)) * SEQ + spos;
      unsigned u[8];
#pragma unroll
      for (int i = 0; i < 8; ++i) u[i] = zr[(size_t)i * ZS + colbase + lane];
      *(uint4*)dst = make_uint4(u[0] | (u[1] << 16), u[2] | (u[3] << 16), u[4] | (u[5] << 16), u[6] | (u[7] << 16));
    }
  }
}

DI void phase4b(const Params& p, int layer) {
  const int tid_ = TID();
  const int lane = tid_ & 63;
  const int gw = (blockIdx.x * 256 + tid_) >> 6;
  const int nw = gridDim.x * 4;
  bf16_t* z = (bf16_t*)(p.ws + O_Z);
  const bf16_t* hid = (const bf16_t*)(p.ws + O_HID);
  bf16_t* kcmp = (bf16_t*)(p.ws + O_KCMP);
  bf16_t* vcmpT = (bf16_t*)(p.ws + O_VCMPT);
  const float* kn = p.nsa_k_norm + layer * 64;
  for (int item = gw; item < 8192; item += nw) {
    const int kv = item >> 12, row = item & 4095;
    const bf16_t* hrow = hid + ((size_t)kv * 4096 + row) * 256;
    const float* w2 = (kv ? p.cmp_w2_v : p.cmp_w2_k) + (size_t)layer * 256 * 64;
    float acc = 0.f;
    for (int k8 = 0; k8 < 32; ++k8) {
      uint4 hv = *(const uint4*)(hrow + k8 * 8);
      const float* wr = w2 + (size_t)(k8 * 8) * 64 + lane;
      acc += bflo(hv.x) * wr[0];
      acc += bfhi(hv.x) * wr[64];
      acc += bflo(hv.y) * wr[128];
      acc += bfhi(hv.y) * wr[192];
      acc += bflo(hv.z) * wr[256];
      acc += bfhi(hv.z) * wr[320];
      acc += bflo(hv.w) * wr[384];
      acc += bfhi(hv.w) * wr[448];
    }
    if (kv == 0) {
      float ss = wave_sum(acc * acc, lane);
      float rs = rsqrtf(ss * (1.f / 64.f) + 1e-6f);
      kcmp[(size_t)row * 64 + lane] = f2bf(acc * rs * kn[lane]);
    } else {
      const int bg = row >> 9, c = row & 511;
      vcmpT[((size_t)(bg * 64 + lane)) * 512 + c] = f2bf(acc);
    }
  }
  const int gtid = blockIdx.x * 256 + tid_;
  const int gthreads = gridDim.x * 256;
  for (int idx = gtid; idx < 65536; idx += gthreads) {
    const int d4 = idx & 31, e = (idx >> 5) & 127, h = (idx >> 12) & 3, b = idx >> 14;
    const float lg2 = log2f(1.f - exp2f(-5.f - (float)h));
    const float gch = exp2f(lg2 * 128.f);
    float r0 = 0.f, r1 = 0.f, r2 = 0.f, r3 = 0.f;
    bf16_t* ptr = z + ((size_t)(b * SEQ + e)) * ZS + C_RV + h * 128 + d4 * 4;
    for (int c0 = 0; c0 < 64; c0 += 16) {
      typedef __attribute__((ext_vector_type(2))) unsigned u32x2;
      u32x2 v[16];
#pragma unroll
      for (int i = 0; i < 16; ++i) v[i] = *(const u32x2*)(ptr + (size_t)(c0 + i) * 128 * ZS);
#pragma unroll
      for (int i = 0; i < 16; ++i) {
        u32x2 o;
        o.x = pack2(r0, r1);
        o.y = pack2(r2, r3);
        *(u32x2*)(ptr + (size_t)(c0 + i) * 128 * ZS) = o;
        r0 = gch * r0 + bflo(v[i].x);
        r1 = gch * r1 + bfhi(v[i].x);
        r2 = gch * r2 + bflo(v[i].y);
        r3 = gch * r3 + bfhi(v[i].y);
      }
    }
  }
}


DI void tile64_gload(int tid, u32x4& r0, u32x4& r1, const bf16_t* base, size_t stride) {
  {
    int idx = tid;
    int row = idx >> 3, ch = idx & 7;
    r0 = *(const u32x4*)(base + (size_t)row * stride + ch * 8);
  }
  {
    int idx = tid + 256;
    int row = idx >> 3, ch = idx & 7;
    r1 = *(const u32x4*)(base + (size_t)row * stride + ch * 8);
  }
}
DI void tile64_sstore(int tid, bf16_t* dst, const u32x4& r0, const u32x4& r1) {
  {
    int idx = tid;
    int row = idx >> 3, ch = idx & 7;
    *(u32x4*)(dst + row * 64 + ((ch ^ ((row >> 1) & 7)) << 3)) = r0;
  }
  {
    int idx = tid + 256;
    int row = idx >> 3, ch = idx & 7;
    *(u32x4*)(dst + row * 64 + ((ch ^ ((row >> 1) & 7)) << 3)) = r1;
  }
}

struct AttnSt { f32x4 O[2][4]; float m[2]; float l[2]; };

template <int MODE>
DI void attn_compute(const int lane, const bf16_t* Ks, const bf16_t* Vs, const bf16x8 (&qf)[2][2], AttnSt& st, const float (&invl)[2],
                     int lo, int hi, float (&impA)[4], float (&impE)[4]) {
  const int quad = lane >> 4, col = lane & 15;
  f32x4 S[4][2];
#pragma unroll
  for (int kt = 0; kt < 4; ++kt)
#pragma unroll
    for (int hh = 0; hh < 2; ++hh) S[kt][hh] = f32x4{0.f, 0.f, 0.f, 0.f};
#pragma unroll
  for (int ks = 0; ks < 2; ++ks) {
#pragma unroll
    for (int kt = 0; kt < 4; ++kt) {
      int row = kt * 16 + col;
      bf16x8 kf = *(const bf16x8*)(Ks + row * 64 + (((ks * 4 + quad) ^ ((row >> 1) & 7)) << 3));
#pragma unroll
      for (int hh = 0; hh < 2; ++hh) S[kt][hh] = mfma16(kf, qf[hh][ks], S[kt][hh]);
    }
  }
  bf16x8 pf[2][2];
#pragma unroll
  for (int hh = 0; hh < 2; ++hh) {
    float mx = -1e30f;
#pragma unroll
    for (int kt = 0; kt < 4; ++kt)
#pragma unroll
      for (int j = 0; j < 4; ++j) {
        int kl = kt * 16 + quad * 4 + j;
        bool v = (kl >= lo) && (kl <= hi);
        float sv = v ? S[kt][hh][j] : -1e30f;
        S[kt][hh][j] = sv;
        mx = fmaxf(mx, sv);
      }
    if (MODE != 1) {
      mx = fmaxf(mx, shx(mx, 16, lane));
      mx = fmaxf(mx, shx(mx, 32, lane));
      float m_new = fmaxf(st.m[hh], mx);
      float alpha = __expf(st.m[hh] - m_new);
      st.m[hh] = m_new;
      float rs = 0.f;
#pragma unroll
      for (int kt = 0; kt < 4; ++kt)
#pragma unroll
        for (int j = 0; j < 4; ++j) {
          float sv = S[kt][hh][j];
          float pv = (sv > -1e29f) ? __expf(sv - m_new) : 0.f;
          rs += pv;
          S[kt][hh][j] = pv;
        }
      st.l[hh] = st.l[hh] * alpha + rs;
      if (MODE == 2) {
#pragma unroll
        for (int dt = 0; dt < 4; ++dt) st.O[hh][dt] *= alpha;
      }
    } else {
      const float mh = st.m[hh], il = invl[hh];
#pragma unroll
      for (int kt = 0; kt < 4; ++kt) {
        float a = 0.f;
#pragma unroll
        for (int j = 0; j < 4; ++j) {
          float sv = S[kt][hh][j];
          float pv = (sv > -1e29f) ? __expf(sv - mh) * il : 0.f;
          S[kt][hh][j] = pv;
          a += pv;
        }
        impA[kt] += a;
        impE[kt] += S[kt][hh][3];
      }
    }
    if (MODE != 0) {
#pragma unroll
      for (int c = 0; c < 2; ++c)
        pf[hh][c] = mk8(pack2(S[2 * c][hh][0], S[2 * c][hh][1]), pack2(S[2 * c][hh][2], S[2 * c][hh][3]),
                        pack2(S[2 * c + 1][hh][0], S[2 * c + 1][hh][1]), pack2(S[2 * c + 1][hh][2], S[2 * c + 1][hh][3]));
    }
  }
  if (MODE != 0) {
#pragma unroll
    for (int dt = 0; dt < 4; ++dt) {
      const int row = dt * 16 + col;
      const int sw = (row >> 1) & 7;
#pragma unroll
      for (int c = 0; c < 2; ++c) {
        uint2 a = *(const uint2*)(Vs + row * 64 + (((4 * c + (quad >> 1)) ^ sw) << 3) + (quad & 1) * 4);
        uint2 b = *(const uint2*)(Vs + row * 64 + (((4 * c + 2 + (quad >> 1)) ^ sw) << 3) + (quad & 1) * 4);
        bf16x8 vf = mk8(a.x, a.y, b.x, b.y);
#pragma unroll
        for (int hh = 0; hh < 2; ++hh) st.O[hh][dt] = mfma16(vf, pf[hh][c], st.O[hh][dt]);
      }
    }
  }
}

DI void st_reset(AttnSt& st) {
#pragma unroll
  for (int h = 0; h < 2; ++h) {
    st.m[h] = -1e30f;
    st.l[h] = 0.f;
#pragma unroll
    for (int dt = 0; dt < 4; ++dt) st.O[h][dt] = f32x4{0.f, 0.f, 0.f, 0.f};
  }
}

template <bool FIRST>
DI void nsa_flush(const int quad, bf16_t* optr, const AttnSt& st, const float (&sc)[2]) {
#pragma unroll
  for (int h = 0; h < 2; ++h)
#pragma unroll
    for (int dt = 0; dt < 4; ++dt) {
      uint2* q = (uint2*)(optr + h * 64 + dt * 16 + quad * 4);
      f32x4 o = st.O[h][dt] * sc[h];
      if (!FIRST) {
        uint2 pv = *q;
        o[0] += bflo(pv.x); o[1] += bfhi(pv.x); o[2] += bflo(pv.y); o[3] += bfhi(pv.y);
      }
      uint2 u;
      u.x = pack2(o[0], o[1]);
      u.y = pack2(o[2], o[3]);
      *q = u;
    }
}

DI void nsa_tile(const Params& p, int b, int g, int tile, bf16_t* lds) {
  const int tid = TID(), lane = tid & 63, w = tid >> 6, quad = lane >> 4, col = lane & 15;
  const int cur = tile;
  const int tok = tile * 64 + w * 16 + col;
  bf16_t* z = (bf16_t*)(p.ws + O_Z);
  const bf16_t* kcmp = (const bf16_t*)(p.ws + O_KCMP) + (size_t)(b * 2 + g) * 512 * 64;
  const bf16_t* vcmpT = (const bf16_t*)(p.ws + O_VCMPT) + (size_t)(b * 2 + g) * 64 * 512;
  const bf16_t* vsT = (const bf16_t*)(p.ws + O_VST) + (size_t)(b * 2 + g) * 64 * SEQ;
  const bf16_t* vwT = (const bf16_t*)(p.ws + O_VWT) + (size_t)(b * 2 + g) * 64 * SEQ;
  const bf16_t* zb = z + (size_t)b * SEQ * ZS;
  const bf16_t* ztok = z + ((size_t)(b * SEQ + tok)) * ZS;
  bf16_t* otok = (bf16_t*)(p.ws + O_ONSA) + ((size_t)(b * SEQ + tok)) * 512 + g * 256;
  bf16_t* Ks = lds;
  bf16_t* Vs = lds + 4096;
  float* impl = (float*)(lds + 8192);

  AttnSt st;
  float invl[2] = {0.f, 0.f};
  float dA[4] = {0.f, 0.f, 0.f, 0.f}, dE[4] = {0.f, 0.f, 0.f, 0.f};
  u32x4 rk0, rk1, rv0, rv1;
  bf16x8 qf[2][2];

  const int ncs = (cur < 16) ? 1 : (cur >> 4) + 1;
  const int chi = (tok >= 31) ? ((tok - 31) >> 4) : -1;

  for (int hp = 0; hp < 2; ++hp) {
#pragma unroll
    for (int hh = 0; hh < 2; ++hh)
#pragma unroll
      for (int ks = 0; ks < 2; ++ks) qf[hh][ks] = *(const bf16x8*)(ztok + C_Q + g * 256 + (hp * 2 + hh) * 64 + ks * 32 + quad * 8);
    st_reset(st);
    for (int s = 0; s < ncs; ++s) {
      tile64_gload(tid, rk0, rk1, kcmp + (size_t)s * 4096, 64);
      __syncthreads();
      tile64_sstore(tid, Ks, rk0, rk1);
      __syncthreads();
      attn_compute<0>(lane, Ks, Vs, qf, st, invl, 0, chi - s * 64, dA, dE);
    }
#pragma unroll
    for (int h = 0; h < 2; ++h) {
      float l = st.l[h];
      l += shx(l, 16, lane);
      l += shx(l, 32, lane);
      invl[h] = (l > 0.f) ? 1.f / l : 0.f;
    }
    {
      float carry = 0.f;
      for (int s = 0; s < ncs; ++s) {
        float iA[4] = {0.f, 0.f, 0.f, 0.f}, iE[4] = {0.f, 0.f, 0.f, 0.f};
        tile64_gload(tid, rk0, rk1, kcmp + (size_t)s * 4096, 64);
        tile64_gload(tid, rv0, rv1, vcmpT + s * 64, 512);
        __syncthreads();
        tile64_sstore(tid, Ks, rk0, rk1);
        tile64_sstore(tid, Vs, rv0, rv1);
        __syncthreads();
        attn_compute<1>(lane, Ks, Vs, qf, st, invl, 0, chi - s * 64, iA, iE);
#pragma unroll
        for (int kt = 0; kt < 4; ++kt) {
          float recv = shfrom(iE[kt], (lane + 48) & 63);
          float val = iA[kt] + ((quad == 0) ? carry : recv);
          carry = recv;
          float* slot = impl + (s * 4 + kt) * 256 + tid;
          if (hp == 0) *slot = val; else *slot += val;
        }
      }
    }
    {
      float sc[2];
#pragma unroll
      for (int h = 0; h < 2; ++h) sc[h] = sigmoidf(bf2f(ztok[C_GT + 0 * 8 + g * 4 + hp * 2 + h]));
      nsa_flush<true>(quad, otok + hp * 128, st, sc);
    }
  }

  uint32_t sw0, sw1, sw2, sw3;
  {
    uint32_t key[32];
#pragma unroll
    for (int i = 0; i < 32; ++i) {
      int j = i * 4 + quad;
      float sc = (i < ncs * 4) ? impl[i * 256 + tid] : 0.f;
      if (j == 0 || j == cur || j == cur - 1) sc = 1e4f;
      uint32_t k = (__float_as_uint(sc) & ~127u) | (uint32_t)(127 - j);
      key[i] = (j > cur) ? 0u : k;
    }
    uint32_t prev = 0xFFFFFFFFu;
    for (int r = 0; r < 16; ++r) {
      uint32_t mx = 0u;
#pragma unroll
      for (int i = 0; i < 32; ++i) {
        uint32_t k = key[i];
        k = (k < prev) ? k : 0u;
        mx = (k > mx) ? k : mx;
      }
      uint32_t o = shxu(mx, 16, lane);
      mx = (o > mx) ? o : mx;
      o = shxu(mx, 32, lane);
      mx = (o > mx) ? o : mx;
      prev = mx;
    }
    sw0 = 0u; sw1 = 0u; sw2 = 0u; sw3 = 0u;
#pragma unroll
    for (int i = 0; i < 32; ++i) {
      bool sel = (key[i] != 0u) && (key[i] >= prev);
      uint32_t bit = sel ? (1u << ((i & 7) * 4 + quad)) : 0u;
      if ((i >> 3) == 0) sw0 |= bit;
      else if ((i >> 3) == 1) sw1 |= bit;
      else if ((i >> 3) == 2) sw2 |= bit;
      else sw3 |= bit;
    }
    sw0 |= shxu(sw0, 16, lane); sw0 |= shxu(sw0, 32, lane);
    sw1 |= shxu(sw1, 16, lane); sw1 |= shxu(sw1, 32, lane);
    sw2 |= shxu(sw2, 16, lane); sw2 |= shxu(sw2, 32, lane);
    sw3 |= shxu(sw3, 16, lane); sw3 |= shxu(sw3, 32, lane);
  }

  for (int hp = 0; hp < 2; ++hp) {
#pragma unroll
    for (int hh = 0; hh < 2; ++hh)
#pragma unroll
      for (int ks = 0; ks < 2; ++ks) qf[hh][ks] = *(const bf16x8*)(ztok + C_Q + g * 256 + (hp * 2 + hh) * 64 + ks * 32 + quad * 8);
    st_reset(st);
    {
      const bf16_t* kb = zb + C_KS + g * 64;
      for (int s = 0; s <= cur; ++s) {
        tile64_gload(tid, rk0, rk1, kb + (size_t)s * 64 * ZS, ZS);
        tile64_gload(tid, rv0, rv1, vsT + s * 64, SEQ);
        __syncthreads();
        tile64_sstore(tid, Ks, rk0, rk1);
        tile64_sstore(tid, Vs, rv0, rv1);
        __syncthreads();
        uint32_t wsel = (s < 32) ? sw0 : (s < 64) ? sw1 : (s < 96) ? sw2 : sw3;
        bool sel = (wsel >> (s & 31)) & 1u;
        int hi = sel ? (tok - s * 64) : -1;
        if (__any(hi >= 0)) attn_compute<2>(lane, Ks, Vs, qf, st, invl, 0, hi, dA, dE);
      }
    }
    {
      float sc[2];
#pragma unroll
      for (int h = 0; h < 2; ++h) {
        float l = st.l[h];
        l += shx(l, 16, lane);
        l += shx(l, 32, lane);
        sc[h] = (l > 0.f) ? sigmoidf(bf2f(ztok[C_GT + 1 * 8 + g * 4 + hp * 2 + h])) / l : 0.f;
      }
      nsa_flush<false>(quad, otok + hp * 128, st, sc);
    }
    st_reset(st);
    {
      const bf16_t* kb = zb + C_KW + g * 64;
      const int s0 = (cur >= 8) ? cur - 8 : 0;
      for (int s = s0; s <= cur; ++s) {
        tile64_gload(tid, rk0, rk1, kb + (size_t)s * 64 * ZS, ZS);
        tile64_gload(tid, rv0, rv1, vwT + s * 64, SEQ);
        __syncthreads();
        tile64_sstore(tid, Ks, rk0, rk1);
        tile64_sstore(tid, Vs, rv0, rv1);
        __syncthreads();
        attn_compute<2>(lane, Ks, Vs, qf, st, invl, tok - 511 - s * 64, tok - s * 64, dA, dE);
      }
    }
    {
      float sc[2];
#pragma unroll
      for (int h = 0; h < 2; ++h) {
        float l = st.l[h];
        l += shx(l, 16, lane);
        l += shx(l, 32, lane);
        sc[h] = (l > 0.f) ? sigmoidf(bf2f(ztok[C_GT + 2 * 8 + g * 4 + hp * 2 + h])) / l : 0.f;
      }
      nsa_flush<false>(quad, otok + hp * 128, st, sc);
    }
  }
}

DI void load128(int tid, bf16_t* lds, const bf16_t* base, size_t stride) {
  u32x4 r[8];
#pragma unroll
  for (int i = 0; i < 8; ++i) {
    int idx = tid + 256 * i;
    int row = idx >> 4, ch = idx & 15;
    r[i] = *(const u32x4*)(base + (size_t)row * stride + ch * 8);
  }
#pragma unroll
  for (int i = 0; i < 8; ++i) {
    int idx = tid + 256 * i;
    int row = idx >> 4, ch = idx & 15;
    *(u32x4*)(lds + row * 128 + ((ch ^ (row & 15)) << 3)) = r[i];
  }
}

DI void ret_tile(const Params& p, int b, int h, int c, bf16_t* lds) {
  const int tid = TID(), lane = tid & 63, w = tid >> 6, quad = lane >> 4, col = lane & 15;
  const float lg2 = log2f(1.f - exp2f(-5.f - (float)h));
  bf16_t* z = (bf16_t*)(p.ws + O_Z);
  const bf16_t* rvT = (const bf16_t*)(p.ws + O_RVT);
  bf16_t* zc = z + ((size_t)(b * SEQ + c * 128)) * ZS;
  bf16x8 qf[2][4];
#pragma unroll
  for (int nt = 0; nt < 2; ++nt)
#pragma unroll
    for (int ks = 0; ks < 4; ++ks) {
      int n = 32 * w + nt * 16 + col;
      qf[nt][ks] = *(const bf16x8*)(zc + (size_t)n * ZS + C_RQ + h * 128 + ks * 32 + quad * 8);
    }
  f32x4 acc[8][2];
#pragma unroll
  for (int et = 0; et < 8; ++et)
#pragma unroll
    for (int nt = 0; nt < 2; ++nt) acc[et][nt] = f32x4{0.f, 0.f, 0.f, 0.f};
  __syncthreads();
  load128(tid, lds, zc + C_RV + h * 128, ZS);
  __syncthreads();
#pragma unroll
  for (int ks = 0; ks < 4; ++ks)
#pragma unroll
    for (int et = 0; et < 8; ++et) {
      int row = et * 16 + col;
      bf16x8 af = *(const bf16x8*)(lds + row * 128 + (((ks * 4 + quad) ^ (row & 15)) << 3));
#pragma unroll
      for (int nt = 0; nt < 2; ++nt) acc[et][nt] = mfma16(af, qf[nt][ks], acc[et][nt]);
    }
#pragma unroll
  for (int nt = 0; nt < 2; ++nt) {
    int n = 32 * w + nt * 16 + col;
    float xi = exp2f(lg2 * (float)(n + 1));
#pragma unroll
    for (int et = 0; et < 8; ++et) acc[et][nt] *= xi;
  }
  __syncthreads();
  load128(tid, lds, zc + C_RK + h * 128, ZS);
  __syncthreads();
  bf16x8 pf[2][4];
#pragma unroll
  for (int nt = 0; nt < 2; ++nt) {
    f32x4 s[8];
#pragma unroll
    for (int mt = 0; mt < 8; ++mt) s[mt] = f32x4{0.f, 0.f, 0.f, 0.f};
#pragma unroll
    for (int ks = 0; ks < 4; ++ks)
#pragma unroll
      for (int mt = 0; mt < 8; ++mt) {
        if (mt <= 2 * w + 1) {
          int row = mt * 16 + col;
          bf16x8 af = *(const bf16x8*)(lds + row * 128 + (((ks * 4 + quad) ^ (row & 15)) << 3));
          s[mt] = mfma16(af, qf[nt][ks], s[mt]);
        }
      }
    const int n = 32 * w + nt * 16 + col;
#pragma unroll
    for (int c2 = 0; c2 < 4; ++c2) {
      float v[8];
#pragma unroll
      for (int i = 0; i < 8; ++i) {
        const int mt = 2 * c2 + (i >> 2), j = i & 3;
        const int m = mt * 16 + quad * 4 + j;
        v[i] = (n >= m) ? s[mt][j] * exp2f(lg2 * (float)(n - m)) : 0.f;
      }
      pf[nt][c2] = mk8(pack2(v[0], v[1]), pack2(v[2], v[3]), pack2(v[4], v[5]), pack2(v[6], v[7]));
    }
  }
  __syncthreads();
  load128(tid, lds, rvT + ((size_t)((b * 4 + h) * 128)) * SEQ + c * 128, SEQ);
  __syncthreads();
#pragma unroll
  for (int c2 = 0; c2 < 4; ++c2) {
    if (2 * c2 <= 2 * w + 1) {
#pragma unroll
      for (int et = 0; et < 8; ++et) {
        int row = et * 16 + col;
        int sw = row & 15;
        uint2 a = *(const uint2*)(lds + row * 128 + (((4 * c2 + (quad >> 1)) ^ sw) << 3) + (quad & 1) * 4);
        uint2 bb = *(const uint2*)(lds + row * 128 + (((4 * c2 + 2 + (quad >> 1)) ^ sw) << 3) + (quad & 1) * 4);
        bf16x8 vf = mk8(a.x, a.y, bb.x, bb.y);
#pragma unroll
        for (int nt = 0; nt < 2; ++nt) acc[et][nt] = mfma16(vf, pf[nt][c2], acc[et][nt]);
      }
    }
  }
#pragma unroll
  for (int nt = 0; nt < 2; ++nt) {
    float ss = 0.f;
#pragma unroll
    for (int et = 0; et < 8; ++et)
#pragma unroll
      for (int j = 0; j < 4; ++j) ss += acc[et][nt][j] * acc[et][nt][j];
    ss += shx(ss, 16, lane);
    ss += shx(ss, 32, lane);
    const float rs = rsqrtf(ss * (1.f / 128.f) + 1e-6f);
    const int n = 32 * w + nt * 16 + col;
    bf16_t* zr = zc + (size_t)n * ZS;
#pragma unroll
    for (int et = 0; et < 8; ++et) {
      const int e0 = et * 16 + quad * 4;
      uint2 gv = *(const uint2*)(zr + C_RG + h * 128 + e0);
      float g0 = bflo(gv.x), g1 = bfhi(gv.x), g2 = bflo(gv.y), g3 = bfhi(gv.y);
      uint2 o;
      o.x = pack2(acc[et][nt][0] * rs * g0 * sigmoidf(g0), acc[et][nt][1] * rs * g1 * sigmoidf(g1));
      o.y = pack2(acc[et][nt][2] * rs * g2 * sigmoidf(g2), acc[et][nt][3] * rs * g3 * sigmoidf(g3));
      *(uint2*)(zr + C_RQ + h * 128 + e0) = o;
    }
  }
}

#define GEMM_TILE_LOOP(NT)                                                             \
  for (int q_ = (int)(blockIdx.x >> 3), per_ = (int)(gridDim.x >> 3), xcd_ = (int)(blockIdx.x & 7), mt = 0, ntile = 0; \
       q_ < 32 * (NT) && ((mt = (((xcd_ + 8 * (q_ / (8 * (NT)))) << 3) + ((q_ % (8 * (NT))) & 7)), ntile = ((q_ % (8 * (NT))) >> 3)), true); \
       q_ += per_)

#define XB_TMO      128
#define XB_XCNT(j)  (256  + 64 * (j))
#define XB_XSUB(j)  (1280 + 64 * (j))
#define XB_XGEN(j)  (2304 + 64 * (j))
#define XB_TOP      3328
#define XB_TOPGEN   3392
#define XB_SPIN_CAP (1u << 20)
DI unsigned xb_ld(unsigned* p) { return __hip_atomic_load(p, __ATOMIC_RELAXED, __HIP_MEMORY_SCOPE_AGENT); }
DI unsigned xb_add(unsigned* p, unsigned v) { return __hip_atomic_fetch_add(p, v, __ATOMIC_RELAXED, __HIP_MEMORY_SCOPE_AGENT); }
DI unsigned xb_xcc_id() { return (unsigned)__builtin_amdgcn_s_getreg((3 << 11) | 20) & 0xFu; }
#define XB_SPIN(cond, bar) do { unsigned _sp = 0; while (cond) { __builtin_amdgcn_s_sleep(1); \
    if ((++_sp & 255u) == 0u) { if (xb_ld(&(bar)[XB_TMO])) break; if (_sp > XB_SPIN_CAP) { atomicAdd(&(bar)[XB_TMO], 1u); break; } } } } while (0)

DI void xcd_barrier(unsigned* bar, const unsigned x, const unsigned nloc, const unsigned nx) {
  asm volatile("s_waitcnt vmcnt(0)" ::: "memory");
  __syncthreads();
  if (TID() == 0) {
    __builtin_amdgcn_s_waitcnt(0);
    const unsigned old = xb_add(&bar[XB_XSUB(x)], 1u);
    const unsigned gen = old / nloc;
    if (old + 1u == (gen + 1u) * nloc) {
      __builtin_amdgcn_fence(__ATOMIC_RELEASE, "agent");
      asm volatile("s_waitcnt vmcnt(0)" ::: "memory");
      const unsigned og = xb_add(&bar[XB_TOP], 1u);
      const unsigned tg = og / nx;
      if (og + 1u == (tg + 1u) * nx) xb_add(&bar[XB_TOPGEN], 1u);
      else XB_SPIN(xb_ld(&bar[XB_TOPGEN]) == tg, bar);
      __builtin_amdgcn_fence(__ATOMIC_ACQUIRE, "agent");
      xb_add(&bar[XB_XGEN(x)], 1u);
      asm volatile("s_waitcnt vmcnt(0)" ::: "memory");
    } else {
      XB_SPIN(xb_ld(&bar[XB_XGEN(x)]) == gen, bar);
      __builtin_amdgcn_fence(__ATOMIC_ACQUIRE, "agent");
      asm volatile("s_waitcnt vmcnt(0)" ::: "memory");
    }
  }
  __syncthreads();
}

__global__ void __launch_bounds__(256, 2) mega(Params p) {
  __shared__ __attribute__((aligned(16))) bf16_t lds[32768];
  cg::grid_group grid = cg::this_grid();
  const int nb = gridDim.x;
  bf16_t* wt = (bf16_t*)(p.ws + O_WT);
  bf16_t* z = (bf16_t*)(p.ws + O_Z);
  bf16_t* hbuf = (bf16_t*)(p.ws + O_VST);
  bf16_t* ubuf = z;
  bf16_t* p16 = z;
  bf16_t* hid = (bf16_t*)(p.ws + O_HID);
  const float* bias = (const float*)(p.ws + O_BIAS);

  unsigned* bar = (unsigned*)(p.ws + O_BAR);
  const unsigned xb_x = xb_xcc_id();
  if (TID() == 0) (void)xb_add(&bar[XB_XCNT(xb_x)], 1u);
  unsigned xb_nloc = 1u, xb_nx = 1u;

  for (int layer = 0; layer < 2; ++layer) {
    const bf16_t* wl = wt;
    const float* xin = (layer == 0) ? p.x : p.out;

    phase0(p, layer);
    norm_phase(xin, p.norm_mix + layer * DM, hbuf);
    if (layer == 0) {
      grid.sync();
      unsigned mine = 0u, cnt = 0u;
#pragma unroll
      for (unsigned j = 0; j < 16; ++j) {
        const unsigned c = xb_ld(&bar[XB_XCNT(j)]);
        cnt += (c > 0u) ? 1u : 0u;
        mine = (j == xb_x) ? c : mine;
      }
      xb_nloc = __builtin_amdgcn_readfirstlane(mine > 0u ? mine : 1u);
      xb_nx = __builtin_amdgcn_readfirstlane(cnt > 0u ? cnt : 1u);
    } else {
      xcd_barrier(bar, xb_x, xb_nloc, xb_nx);
    }

    GEMM_TILE_LOOP(43) {
      const int m0 = mt * 128, n0 = ntile * 128;
      f32x4 acc[4][4];
      zero_acc(acc);
      gemm_accum(acc, RowPtr{hbuf + (size_t)m0 * DM, DM}, RowPtr{wl + W_IN + (size_t)n0 * 1024, 1024}, 16, lds);
      gemm_epi(acc, m0, n0, [&](int m, int n, f32x4& a) {
        if (n < ZS) {
          uint2 u;
          u.x = pack2(a[0], a[1]);
          u.y = pack2(a[2], a[3]);
          *(uint2*)(z + (size_t)m * ZS + n) = u;
        }
      });
    }
    xcd_barrier(bar, xb_x, xb_nloc, xb_nx);

    post_z(p, layer);
    xcd_barrier(bar, xb_x, xb_nloc, xb_nx);

    for (int t = blockIdx.x; t < 128 + 1024; t += nb) {
      f32x4 acc[4][4];
      zero_acc(acc);
      if (t < 128) {
        const int kv = t >> 6, mt = (t >> 1) & 31, ntile = t & 1;
        const int m0 = mt * 128, n0 = ntile * 128;
        const int colbase = kv ? C_VC : C_KC;
        auto ap = [&](int r, int kb) -> const bf16_t* {
          int row = m0 + r;
          int bg = row >> 9, c = row & 511;
          int tk = 16 * c + kb;
          tk = tk > (SEQ - 1) ? (SEQ - 1) : tk;
          return z + ((size_t)((bg >> 1) * SEQ + tk)) * ZS + colbase + (bg & 1) * 64;
        };
        gemm_accum(acc, ap, RowPtr{wl + (kv ? W_C1V : W_C1K) + (size_t)n0 * 2048, 2048}, 32, lds);
        const float* bs = bias + kv * 256;
        bf16_t* hd = hid + (size_t)kv * 4096 * 256;
        gemm_epi(acc, m0, n0, [&](int m, int n, f32x4& a) {
          float o[4];
#pragma unroll
          for (int j = 0; j < 4; ++j) {
            float xv = a[j] + bs[n + j];
            float y = 0.7978845608028654f * (xv + 0.044715f * xv * xv * xv);
            float th = 1.f - 2.f / (__expf(2.f * y) + 1.f);
            o[j] = 0.5f * xv * (1.f + th);
          }
          uint2 u;
          u.x = pack2(o[0], o[1]);
          u.y = pack2(o[2], o[3]);
          *(uint2*)(hd + (size_t)m * 256 + n) = u;
        });
      } else {
        const int idx = t - 128;
        const int c = idx & 63, bh = idx >> 6;
        const bf16_t* rvT = (const bf16_t*)(p.ws + O_RVT) + ((size_t)bh * 128) * SEQ + c * 128;
        const bf16_t* kzT = (const bf16_t*)(p.ws + O_KZT) + ((size_t)bh * 128) * SEQ + c * 128;
        gemm_accum(acc, RowPtr{rvT, SEQ}, RowPtr{kzT, SEQ}, 2, lds);
        bf16_t* dst = z + ((size_t)((bh >> 2) * SEQ + c * 128)) * ZS + C_RV + (bh & 3) * 128;
        gemm_epi(acc, 0, 0, [&](int m, int n, f32x4& a) {
          uint2 u;
          u.x = pack2(a[0], a[1]);
          u.y = pack2(a[2], a[3]);
          *(uint2*)(dst + (size_t)m * ZS + n) = u;
        });
      }
    }
    xcd_barrier(bar, xb_x, xb_nloc, xb_nx);

    phase4b(p, layer);
    xcd_barrier(bar, xb_x, xb_nloc, xb_nx);

    for (int t = blockIdx.x; t < 2048; t += nb) {
      if (t < 1024) {
        const int tile = (t < 512) ? 127 - (t >> 3) : ((t - 512) >> 3), bg = t & 7;
        nsa_tile(p, bg >> 1, bg & 1, tile, lds);
      } else {
        const int idx = t - 1024;
        ret_tile(p, idx >> 8, (idx >> 6) & 3, idx & 63, lds);
      }
    }
    xcd_barrier(bar, xb_x, xb_nloc, xb_nx);

    GEMM_TILE_LOOP(8) {
      const int m0 = mt * 128, n0 = ntile * 128;
      f32x4 acc[4][4];
      zero_acc(acc);
      gemm_accum(acc, RowPtr{(const bf16_t*)(p.ws + O_ONSA) + (size_t)m0 * 512, 512}, RowPtr{wl + W_UPA + (size_t)n0 * 512, 512}, 8, lds);
      gemm_epi(acc, m0, n0, [&](int m, int n, f32x4& a) {
        uint2 ua = *(const uint2*)(z + (size_t)m * ZS + C_MA + n);
        uint2 ub = *(const uint2*)(z + (size_t)m * ZS + C_MB + n);
        a[0] *= sigmoidf(bflo(ua.x)) / sigmoidf(bflo(ub.x));
        a[1] *= sigmoidf(bfhi(ua.x)) / sigmoidf(bfhi(ub.x));
        a[2] *= sigmoidf(bflo(ua.y)) / sigmoidf(bflo(ub.y));
        a[3] *= sigmoidf(bfhi(ua.y)) / sigmoidf(bfhi(ub.y));
      });
      gemm_accum(acc, RowPtr{z + (size_t)m0 * ZS + C_RQ, ZS}, RowPtr{wl + W_UPR + (size_t)n0 * 512, 512}, 8, lds);
      gemm_epi(acc, m0, n0, [&](int m, int n, f32x4& a) {
        uint2 ub = *(const uint2*)(z + (size_t)m * ZS + C_MB + n);
        uint2 u;
        u.x = pack2(a[0] * sigmoidf(bflo(ub.x)), a[1] * sigmoidf(bfhi(ub.x)));
        u.y = pack2(a[2] * sigmoidf(bflo(ub.y)), a[3] * sigmoidf(bfhi(ub.y)));
        *(uint2*)(z + (size_t)m * ZS + C_RK + n) = u;
      });
    }
    xcd_barrier(bar, xb_x, xb_nloc, xb_nx);

    GEMM_TILE_LOOP(8) {
      const int m0 = mt * 128, n0 = ntile * 128;
      f32x4 acc[4][4];
      zero_acc(acc);
      gemm_accum(acc, RowPtr{z + (size_t)m0 * ZS + C_RK, ZS}, RowPtr{wl + W_OUT + (size_t)n0 * 1024, 1024}, 16, lds);
      gemm_epi(acc, m0, n0, [&](int m, int n, f32x4& a) {
        float4 xv = *(const float4*)(xin + (size_t)m * DM + n);
        *(float4*)(p.out + (size_t)m * DM + n) = make_float4(xv.x + a[0], xv.y + a[1], xv.z + a[2], xv.w + a[3]);
      });
    }
    xcd_barrier(bar, xb_x, xb_nloc, xb_nx);

    norm_phase(p.out, p.norm_mlp + layer * DM, hbuf);
    xcd_barrier(bar, xb_x, xb_nloc, xb_nx);

    GEMM_TILE_LOOP(32) {
      const int m0 = mt * 128, n0 = ntile * 128;
      f32x4 acc[4][4];
      zero_acc(acc);
      gemm_accum(acc, RowPtr{hbuf + (size_t)m0 * DM, DM}, RowPtr{wl + W_FF1 + (size_t)n0 * 1024, 1024}, 16, lds);
      gemm_epi(acc, m0, n0, [&](int m, int n, f32x4& a) {
        float r0 = fmaxf(a[0], 0.f), r1 = fmaxf(a[1], 0.f), r2 = fmaxf(a[2], 0.f), r3 = fmaxf(a[3], 0.f);
        uint2 u;
        u.x = pack2(r0 * r0, r1 * r1);
        u.y = pack2(r2 * r2, r3 * r3);
        *(uint2*)(ubuf + (size_t)m * 4096 + n) = u;
      });
    }
    xcd_barrier(bar, xb_x, xb_nloc, xb_nx);

    GEMM_TILE_LOOP(8) {
      const int m0 = mt * 128, n0 = ntile * 128;
      f32x4 acc[4][4];
      zero_acc(acc);
      gemm_accum(acc, RowPtr{ubuf + (size_t)m0 * 4096, 4096}, RowPtr{wl + W_FF2 + (size_t)n0 * 4096, 4096}, 64, lds);
      gemm_epi(acc, m0, n0, [&](int m, int n, f32x4& a) {
        float4* o = (float4*)(p.out + (size_t)m * DM + n);
        float4 xv = *o;
        *o = make_float4(xv.x + a[0], xv.y + a[1], xv.z + a[2], xv.w + a[3]);
      });
    }
    xcd_barrier(bar, xb_x, xb_nloc, xb_nx);

    norm_phase(p.out, p.norm_ple + layer * DM, hbuf);
    {
      const float* pl = p.p + (size_t)layer * T_TOK * 256;
      const int gtid = blockIdx.x * 256 + TID();
      const int gthreads = nb * 256;
      for (int i = gtid; i < T_TOK * 32; i += gthreads) {
        float4 a = ((const float4*)pl)[2 * i], b2 = ((const float4*)pl)[2 * i + 1];
        ((uint4*)p16)[i] = make_uint4(pack2(a.x, a.y), pack2(a.z, a.w), pack2(b2.x, b2.y), pack2(b2.z, b2.w));
      }
    }
    xcd_barrier(bar, xb_x, xb_nloc, xb_nx);

    GEMM_TILE_LOOP(8) {
      const int m0 = mt * 128, n0 = ntile * 128;
      f32x4 acc[4][4];
      zero_acc(acc);
      gemm_accum(acc, RowPtr{p16 + (size_t)m0 * 256, 256}, RowPtr{wl + W_PLE + (size_t)n0 * 256, 256}, 4, lds);
      bf16_t* ppb = z + (size_t)T_TOK * 256;
      gemm_epi(acc, m0, n0, [&](int m, int n, f32x4& a) {
        uint2 u;
        u.x = pack2(a[0], a[1]);
        u.y = pack2(a[2], a[3]);
        *(uint2*)(ppb + (size_t)m * DM + n) = u;
      });
      zero_acc(acc);
      gemm_accum(acc, RowPtr{hbuf + (size_t)m0 * DM, DM}, RowPtr{wl + W_PG + (size_t)n0 * 1024, 1024}, 16, lds);
      gemm_epi(acc, m0, n0, [&](int m, int n, f32x4& a) {
        uint2 pv = *(const uint2*)(ppb + (size_t)m * DM + n);
        float4* o = (float4*)(p.out + (size_t)m * DM + n);
        float4 xv = *o;
        *o = make_float4(xv.x + sigmoidf(a[0]) * bflo(pv.x), xv.y + sigmoidf(a[1]) * bfhi(pv.x),
                         xv.z + sigmoidf(a[2]) * bflo(pv.y), xv.w + sigmoidf(a[3]) * bfhi(pv.y));
      });
    }
    xcd_barrier(bar, xb_x, xb_nloc, xb_nx);
  }
}

extern "C" void kernel_launch(void* const* d_in, const int* in_sizes, int n_in,
                              void* d_out, int out_size, void* d_ws, size_t ws_size,
                              hipStream_t stream) {
  static int grid_blocks = 0;
  if (!grid_blocks) {
    int dev = 0, cus = 0, per_cu = 0;
    hipGetDevice(&dev);
    hipDeviceGetAttribute(&cus, hipDeviceAttributeMultiprocessorCount, dev);
    hipOccupancyMaxActiveBlocksPerMultiprocessor(&per_cu, mega, 256, 0);
    if (per_cu > 2) per_cu = 2;
    if (per_cu < 1) per_cu = 1;
    grid_blocks = cus * per_cu;
  }
  if (ws_size < WS_NEED) {
    fprintf(stderr, "workspace too small: %zu < %llu\n", ws_size, (unsigned long long)WS_NEED);
    return;
  }
  Params p{};
  p.x = (const float*)d_in[0]; p.p = (const float*)d_in[1]; p.norm_mix = (const float*)d_in[2]; p.w_in = (const float*)d_in[3];
  p.nsa_q_norm = (const float*)d_in[4]; p.nsa_k_norm = (const float*)d_in[5]; p.cmp_pos_k = (const float*)d_in[6];
  p.cmp_pos_v = (const float*)d_in[7]; p.cmp_w1_k = (const float*)d_in[8]; p.cmp_w2_k = (const float*)d_in[9];
  p.cmp_w1_v = (const float*)d_in[10]; p.cmp_w2_v = (const float*)d_in[11]; p.w_up_nsa = (const float*)d_in[12];
  p.w_up_ret = (const float*)d_in[13]; p.w_out = (const float*)d_in[14]; p.norm_mlp = (const float*)d_in[15];
  p.w_ff1 = (const float*)d_in[16]; p.w_ff2 = (const float*)d_in[17]; p.norm_ple = (const float*)d_in[18];
  p.w_ple = (const float*)d_in[19]; p.w_ple_gate = (const float*)d_in[20];
  p.out = (float*)d_out; p.ws = (char*)d_ws;
  hipMemsetAsync((char*)d_ws + O_BAR, 0, BAR_BYTES, stream);
  void* args[] = {&p};
  hipError_t e = hipLaunchCooperativeKernel((void*)mega, dim3(grid_blocks), dim3(256), args, 0, stream);
  if (e != hipSuccess) fprintf(stderr, "cooperative launch failed: %s (grid %d)\n", hipGetErrorString(e), grid_blocks);
}
```

```cpp
#include <hip/hip_runtime.h>
#include <hip/hip_cooperative_groups.h>
#include <cstdio>
#include <cstdint>
namespace cg = cooperative_groups;

typedef __attribute__((ext_vector_type(8))) short bf16x8;
typedef __attribute__((ext_vector_type(4))) float f32x4;
typedef unsigned short bf16_t;
typedef __attribute__((ext_vector_type(4))) unsigned u32x4;
#define DI __device__ __forceinline__

#define T_TOK 32768
#define SEQ 8192
#define DM 1024
#define ZS 5400
#define C_Q 0
#define C_KC 512
#define C_VC 640
#define C_KS 768
#define C_VS 896
#define C_KW 1024
#define C_VW 1152
#define C_GT 1280
#define C_RQ 1304
#define C_RK 1816
#define C_RV 2328
#define C_RG 2840
#define C_MA 3352
#define C_MB 4376
#define NPAD_IN 5504
#define TS 8256

#define W_IN 0
#define W_C1K 5636096
#define W_C1V 6160384
#define W_UPA 6684672
#define W_UPR 7208960
#define W_OUT 7733248
#define W_FF1 8781824
#define W_FF2 12976128
#define W_PLE 17170432
#define W_PG 17432576
#define W_LAYER 18481152

#define O_WT 0ull
#define O_ROPE 36962304ull
#define O_BIAS 41156608ull
#define O_HID 41160704ull
#define O_KCMP 45355008ull
#define O_VCMPT 45879296ull
#define O_VST 46403584ull
#define O_VWT 54857728ull
#define O_RVT 63311872ull
#define O_KZT 97128448ull
#define O_Z 130945024ull
#define O_ONSA 484839424ull
#define O_BAR 518393856ull
#define BAR_BYTES 13824
#define WS_NEED 518407680ull

struct Params {
  const float* x; const float* p; const float* norm_mix; const float* w_in;
  const float* nsa_q_norm; const float* nsa_k_norm; const float* cmp_pos_k; const float* cmp_pos_v;
  const float* cmp_w1_k; const float* cmp_w2_k; const float* cmp_w1_v; const float* cmp_w2_v;
  const float* w_up_nsa; const float* w_up_ret; const float* w_out; const float* norm_mlp;
  const float* w_ff1; const float* w_ff2; const float* norm_ple; const float* w_ple; const float* w_ple_gate;
  float* out; char* ws;
};

DI unsigned pack2(float a, float b) {
  typedef __attribute__((ext_vector_type(2))) __bf16 bf2;
  typedef __attribute__((ext_vector_type(2))) float f2;
  f2 v = {a, b};
  bf2 r = __builtin_convertvector(v, bf2);
  return __builtin_bit_cast(unsigned, r);
}
DI bf16_t f2bf(float a) { return (bf16_t)(pack2(a, 0.f) & 0xffffu); }
DI float bf2f(bf16_t h) { return __uint_as_float(((unsigned)h) << 16); }
DI float bflo(unsigned u) { return __uint_as_float(u << 16); }
DI float bfhi(unsigned u) { return __uint_as_float(u & 0xffff0000u); }
DI float shx(float v, int mask, int lane) {
  return __int_as_float(__builtin_amdgcn_ds_bpermute((lane ^ mask) << 2, __float_as_int(v)));
}
DI uint32_t shxu(uint32_t v, int mask, int lane) {
  return (uint32_t)__builtin_amdgcn_ds_bpermute((lane ^ mask) << 2, (int)v);
}
DI float shfrom(float v, int srclane) {
  return __int_as_float(__builtin_amdgcn_ds_bpermute(srclane << 2, __float_as_int(v)));
}
DI float wave_sum(float v, int lane) {
#pragma unroll
  for (int o = 32; o > 0; o >>= 1) v += shx(v, o, lane);
  return v;
}
DI int TID() { int t = threadIdx.x; asm volatile("" : "+v"(t)); return t; }
DI float sigmoidf(float x) { return 1.f / (1.f + __expf(-x)); }
DI f32x4 mfma16(bf16x8 a, bf16x8 b, f32x4 c) { return __builtin_amdgcn_mfma_f32_16x16x32_bf16(a, b, c, 0, 0, 0); }
DI bf16x8 mk8(unsigned a, unsigned b, unsigned c, unsigned d) {
  uint4 u = make_uint4(a, b, c, d);
  return __builtin_bit_cast(bf16x8, u);
}

template <class AP, class BP>
DI void g_load(u32x4 (&ra)[4], u32x4 (&rb)[4], const AP& ap, const BP& bp, int kb, int lrow, int lch) {
#pragma unroll
  for (int i = 0; i < 4; ++i) {
    ra[i] = *(const u32x4*)(ap(lrow + 32 * i, kb) + lch * 8);
    rb[i] = *(const u32x4*)(bp(lrow + 32 * i, kb) + lch * 8);
  }
}
DI void g_store(bf16_t* As, bf16_t* Bs, const u32x4 (&ra)[4], const u32x4 (&rb)[4], int buf, int lrow, int lch) {
#pragma unroll
  for (int i = 0; i < 4; ++i) {
    int r = lrow + 32 * i;
    int off = buf * 8192 + r * 64 + ((lch ^ ((r >> 1) & 7)) << 3);
    *(u32x4*)(As + off) = ra[i];
    *(u32x4*)(Bs + off) = rb[i];
  }
}
DI void g_compute(f32x4 (&acc)[4][4], const bf16_t* a, const bf16_t* b, int wm, int wn, int lane) {
#pragma unroll
  for (int ks = 0; ks < 2; ++ks) {
    bf16x8 af[4], bfr[4];
#pragma unroll
    for (int i = 0; i < 4; ++i) {
      int r = wm * 64 + i * 16 + (lane & 15);
      af[i] = *(const bf16x8*)(a + r * 64 + (((ks * 4 + (lane >> 4)) ^ ((r >> 1) & 7)) << 3));
      int r2 = wn * 64 + i * 16 + (lane & 15);
      bfr[i] = *(const bf16x8*)(b + r2 * 64 + (((ks * 4 + (lane >> 4)) ^ ((r2 >> 1) & 7)) << 3));
    }
#pragma unroll
    for (int i = 0; i < 4; ++i)
#pragma unroll
      for (int j = 0; j < 4; ++j) acc[i][j] = mfma16(bfr[j], af[i], acc[i][j]);
  }
}
template <class AP, class BP>
DI void gemm_accum(f32x4 (&acc)[4][4], AP ap, BP bp, int nkb, bf16_t* lds) {
  const int tid = TID(), lane = tid & 63, w = tid >> 6;
  const int wm = w >> 1, wn = w & 1;
  const int lrow = tid >> 3, lch = tid & 7;
  bf16_t* As = lds;
  bf16_t* Bs = lds + 16384;
  u32x4 ra0[4], rb0[4], ra1[4], rb1[4];
  __syncthreads();
  g_load(ra0, rb0, ap, bp, 0, lrow, lch);
  g_load(ra1, rb1, ap, bp, 1, lrow, lch);
  g_store(As, Bs, ra0, rb0, 0, lrow, lch);
  __syncthreads();
  for (int kb = 0; kb < nkb; kb += 2) {
    const int k2 = (kb + 2 < nkb) ? kb + 2 : nkb - 2;
    g_load(ra0, rb0, ap, bp, k2, lrow, lch);
    __builtin_amdgcn_sched_barrier(0);
    g_compute(acc, As, Bs, wm, wn, lane);
    g_store(As, Bs, ra1, rb1, 1, lrow, lch);
    __syncthreads();
    g_load(ra1, rb1, ap, bp, k2 + 1, lrow, lch);
    __builtin_amdgcn_sched_barrier(0);
    g_compute(acc, As + 8192, Bs + 8192, wm, wn, lane);
    g_store(As, Bs, ra0, rb0, 0, lrow, lch);
    __syncthreads();
  }
}
template <class E>
DI void gemm_epi(f32x4 (&acc)[4][4], int m0, int n0, E e) {
  const int tid_ = TID();
  const int lane = tid_ & 63, w = tid_ >> 6;
  const int wm = w >> 1, wn = w & 1;
#pragma unroll
  for (int i = 0; i < 4; ++i)
#pragma unroll
    for (int j = 0; j < 4; ++j) {
      int m = m0 + wm * 64 + i * 16 + (lane & 15);
      int n = n0 + wn * 64 + j * 16 + (lane >> 4) * 4;
      e(m, n, acc[i][j]);
    }
}
DI void zero_acc(f32x4 (&acc)[4][4]) {
#pragma unroll
  for (int i = 0; i < 4; ++i)
#pragma unroll
    for (int j = 0; j < 4; ++j) acc[i][j] = f32x4{0.f, 0.f, 0.f, 0.f};
}
struct RowPtr {
  const bf16_t* base; size_t ld;
  DI const bf16_t* operator()(int r, int kb) const { return base + (size_t)r * ld + kb * 64; }
};

DI void convert_wt(const float* W, bf16_t* Wt, int K, int N, int Npad, int gtid, int gthreads) {
  const int k8n = K >> 3;
  const long total = (long)Npad * k8n;
  for (long idx = gtid; idx < total; idx += gthreads) {
    int n = (int)(idx % Npad);
    int k8 = (int)(idx / Npad);
    uint4 o = make_uint4(0, 0, 0, 0);
    if (n < N) {
      const float* s = W + (size_t)(k8 * 8) * N + n;
      float v0 = s[0], v1 = s[(size_t)N], v2 = s[(size_t)2 * N], v3 = s[(size_t)3 * N];
      float v4 = s[(size_t)4 * N], v5 = s[(size_t)5 * N], v6 = s[(size_t)6 * N], v7 = s[(size_t)7 * N];
      o = make_uint4(pack2(v0, v1), pack2(v2, v3), pack2(v4, v5), pack2(v6, v7));
    }
    *(uint4*)(Wt + (size_t)n * K + k8 * 8) = o;
  }
}

DI void phase0(const Params& p, const int L) {
  const int gtid = blockIdx.x * 256 + TID();
  const int gthreads = gridDim.x * 256;
  bf16_t* wl = (bf16_t*)(p.ws + O_WT);
  convert_wt(p.w_in + (size_t)L * 1024 * 5400, wl + W_IN, 1024, 5400, NPAD_IN, gtid, gthreads);
  convert_wt(p.cmp_w1_k + (size_t)L * 2048 * 256, wl + W_C1K, 2048, 256, 256, gtid, gthreads);
  convert_wt(p.cmp_w1_v + (size_t)L * 2048 * 256, wl + W_C1V, 2048, 256, 256, gtid, gthreads);
  convert_wt(p.w_up_nsa + (size_t)L * 512 * 1024, wl + W_UPA, 512, 1024, 1024, gtid, gthreads);
  convert_wt(p.w_up_ret + (size_t)L * 512 * 1024, wl + W_UPR, 512, 1024, 1024, gtid, gthreads);
  convert_wt(p.w_out + (size_t)L * 1024 * 1024, wl + W_OUT, 1024, 1024, 1024, gtid, gthreads);
  convert_wt(p.w_ff1 + (size_t)L * 1024 * 4096, wl + W_FF1, 1024, 4096, 4096, gtid, gthreads);
  convert_wt(p.w_ff2 + (size_t)L * 4096 * 1024, wl + W_FF2, 4096, 1024, 1024, gtid, gthreads);
  convert_wt(p.w_ple + (size_t)L * 256 * 1024, wl + W_PLE, 256, 1024, 1024, gtid, gthreads);
  convert_wt(p.w_ple_gate + (size_t)L * 1024 * 1024, wl + W_PG, 1024, 1024, 1024, gtid, gthreads);
  if (L == 0) {
    float2* rope = (float2*)(p.ws + O_ROPE);
    for (int idx = gtid; idx < SEQ * 64; idx += gthreads) {
      int pos = idx >> 6, j = idx & 63;
      float inv = exp2f(-(float)j * (13.287712379549449f / 64.f));
      float ang = (float)pos * inv;
      double rev = (double)ang * 0.15915494309189535;
      rev -= rint(rev);
      float fr = (float)rev;
      rope[idx] = make_float2(__builtin_amdgcn_cosf(fr), __builtin_amdgcn_sinf(fr));
    }
  }
  float* part = (float*)(p.ws + O_HID);
  {
    const int n = gtid & 255;
    for (int item = (int)blockIdx.x; item < 128; item += (int)gridDim.x) {
      const int kv = item >> 6, kc = item & 63;
      const float* pos = (kv ? p.cmp_pos_v : p.cmp_pos_k) + L * 2048 + kc * 32;
      const float* w1 = (kv ? p.cmp_w1_v : p.cmp_w1_k) + (size_t)L * 2048 * 256 + (size_t)kc * 32 * 256;
      float a = 0.f;
#pragma unroll 8
      for (int k = 0; k < 32; ++k) a += pos[k] * w1[(size_t)k * 256 + n];
      part[item * 256 + n] = a;
    }
  }
}

DI void norm_phase(const float* xin, const float* g, bf16_t* h) {
  const int tid_ = TID();
  const int lane = tid_ & 63;
  const int gw = (blockIdx.x * 256 + tid_) >> 6;
  const int nw = gridDim.x * 4;
  float4 gv[4];
#pragma unroll
  for (int i = 0; i < 4; ++i) gv[i] = ((const float4*)g)[i * 64 + lane];
  for (int row = gw; row < T_TOK; row += nw) {
    const float4* xr = (const float4*)(xin + (size_t)row * DM);
    float4 v[4];
    float ss = 0.f;
#pragma unroll
    for (int i = 0; i < 4; ++i) {
      v[i] = xr[i * 64 + lane];
      ss += v[i].x * v[i].x + v[i].y * v[i].y + v[i].z * v[i].z + v[i].w * v[i].w;
    }
    ss = wave_sum(ss, lane);
    float rs = rsqrtf(ss * (1.f / 1024.f) + 1e-6f);
    uint2* hr = (uint2*)(h + (size_t)row * DM);
#pragma unroll
    for (int i = 0; i < 4; ++i) {
      uint2 o;
      o.x = pack2(v[i].x * rs * gv[i].x, v[i].y * rs * gv[i].y);
      o.y = pack2(v[i].z * rs * gv[i].z, v[i].w * rs * gv[i].w);
      hr[i * 64 + lane] = o;
    }
  }
}

DI void post_z(const Params& p, int layer) {
  const int tid_ = TID();
  const int lane = tid_ & 63;
  const int gw = (blockIdx.x * 256 + tid_) >> 6;
  const int nw = gridDim.x * 4;
  bf16_t* z = (bf16_t*)(p.ws + O_Z);
  bf16_t* vsT = (bf16_t*)(p.ws + O_VST);
  bf16_t* vwT = (bf16_t*)(p.ws + O_VWT);
  bf16_t* rvT = (bf16_t*)(p.ws + O_RVT);
  bf16_t* kzT = (bf16_t*)(p.ws + O_KZT);
  const float2* rope = (const float2*)(p.ws + O_ROPE);
  const float* qn = p.nsa_q_norm + layer * 64;
  const float* kn = p.nsa_k_norm + layer * 64;
  {
    const float* part = (const float*)(p.ws + O_HID);
    float* bias = (float*)(p.ws + O_BIAS);
    const int idx = blockIdx.x * 256 + tid_;
    if (idx < 512) {
      const int kv = idx >> 8, n = idx & 255;
      float a = 0.f;
      for (int kc = 0; kc < 64; ++kc) a += part[(kv * 64 + kc) * 256 + n];
      bias[idx] = a;
    }
  }
  for (int item = gw; item < 1024 * 32; item += nw) {
    const int slab = item & 31, tc = item >> 5;
    const int tok0 = tc * 32;
    const int b = tok0 >> 13, spos = tok0 & 8191;
    bf16_t* zr = z + (size_t)tok0 * ZS;
    if (slab < 12) {
      int colbase; const float* g; float sc;
      if (slab < 8) { colbase = C_Q + slab * 64; g = qn; sc = 0.125f; }
      else if (slab < 10) { colbase = C_KS + (slab - 8) * 64; g = kn; sc = 1.f; }
      else { colbase = C_KW + (slab - 10) * 64; g = kn; sc = 1.f; }
      const float gv = g[lane] * sc;
      float v[32];
#pragma unroll
      for (int i = 0; i < 32; ++i) v[i] = bf2f(zr[(size_t)i * ZS + colbase + lane]);
#pragma unroll
      for (int i = 0; i < 32; ++i) {
        float ss = wave_sum(v[i] * v[i], lane);
        float rs = rsqrtf(ss * (1.f / 64.f) + 1e-6f);
        zr[(size_t)i * ZS + colbase + lane] = f2bf(v[i] * rs * gv);
      }
    } else if (slab < 16 || slab >= 24) {
      int colbase; bf16_t* dst;
      if (slab < 16) {
        const int gi = slab & 1;
        const bool isw = slab >= 14;
        colbase = (isw ? C_VW : C_VS) + gi * 64;
        dst = (isw ? vwT : vsT) + ((size_t)((b * 2 + gi) * 64 + lane)) * TS + spos;
      } else {
        const int s8 = slab - 24;
        const int h = s8 >> 1, half = s8 & 1;
        colbase = C_RV + s8 * 64;
        dst = rvT + ((size_t)((b * 4 + h) * 128 + half * 64 + lane)) * TS + spos;
      }
      unsigned u[32];
#pragma unroll
      for (int i = 0; i < 32; ++i) u[i] = zr[(size_t)i * ZS + colbase + lane];
#pragma unroll
      for (int q4 = 0; q4 < 4; ++q4)
        *(uint4*)(dst + q4 * 8) = make_uint4(u[q4 * 8 + 0] | (u[q4 * 8 + 1] << 16), u[q4 * 8 + 2] | (u[q4 * 8 + 3] << 16),
                                             u[q4 * 8 + 4] | (u[q4 * 8 + 5] << 16), u[q4 * 8 + 6] | (u[q4 * 8 + 7] << 16));
    } else if (slab < 20) {
      const int h = slab - 16;
      const int colbase = C_RQ + h * 128;
      float x1[32], x2[32];
#pragma unroll
      for (int i = 0; i < 32; ++i) {
        const bf16_t* p1 = zr + (size_t)i * ZS + colbase + lane;
        x1[i] = bf2f(p1[0]);
        x2[i] = bf2f(p1[64]);
      }
#pragma unroll
      for (int i = 0; i < 32; ++i) {
        bf16_t* p1 = zr + (size_t)i * ZS + colbase + lane;
        float2 cs = rope[(spos + i) * 64 + lane];
        p1[0] = f2bf(x1[i] * cs.x - x2[i] * cs.y);
        p1[64] = f2bf(x1[i] * cs.y + x2[i] * cs.x);
      }
    } else {
      const int h = slab - 20;
      const int colbase = C_RK + h * 128;
      const float lg2 = log2f(1.f - exp2f(-5.f - (float)h));
      float x1[32], x2[32];
#pragma unroll
      for (int i = 0; i < 32; ++i) {
        const bf16_t* p1 = zr + (size_t)i * ZS + colbase + lane;
        x1[i] = bf2f(p1[0]);
        x2[i] = bf2f(p1[64]);
      }
      unsigned u1[32], u2[32];
#pragma unroll
      for (int i = 0; i < 32; ++i) {
        bf16_t* p1 = zr + (size_t)i * ZS + colbase + lane;
        float2 cs = rope[(spos + i) * 64 + lane];
        float o1 = (x1[i] * cs.x - x2[i] * cs.y) * 0.08838834764831845f;
        float o2 = (x1[i] * cs.y + x2[i] * cs.x) * 0.08838834764831845f;
        p1[0] = f2bf(o1);
        p1[64] = f2bf(o2);
        float zeta = exp2f(lg2 * (float)(127 - ((spos + i) & 127)));
        u1[i] = f2bf(o1 * zeta);
        u2[i] = f2bf(o2 * zeta);
      }
      bf16_t* d1 = kzT + ((size_t)((b * 4 + h) * 128 + lane)) * TS + spos;
#pragma unroll
      for (int q4 = 0; q4 < 4; ++q4) {
        *(uint4*)(d1 + q4 * 8) = make_uint4(u1[q4 * 8 + 0] | (u1[q4 * 8 + 1] << 16), u1[q4 * 8 + 2] | (u1[q4 * 8 + 3] << 16),
                                            u1[q4 * 8 + 4] | (u1[q4 * 8 + 5] << 16), u1[q4 * 8 + 6] | (u1[q4 * 8 + 7] << 16));
        *(uint4*)(d1 + (size_t)64 * TS + q4 * 8) = make_uint4(u2[q4 * 8 + 0] | (u2[q4 * 8 + 1] << 16), u2[q4 * 8 + 2] | (u2[q4 * 8 + 3] << 16),
                                                              u2[q4 * 8 + 4] | (u2[q4 * 8 + 5] << 16), u2[q4 * 8 + 6] | (u2[q4 * 8 + 7] << 16));
      }
    }
  }
}

DI void phase4b(const Params& p, int layer) {
  const int tid_ = TID();
  const int lane = tid_ & 63;
  const int gw = (blockIdx.x * 256 + tid_) >> 6;
  const int nw = gridDim.x * 4;
  bf16_t* z = (bf16_t*)(p.ws + O_Z);
  const bf16_t* hid = (const bf16_t*)(p.ws + O_HID);
  bf16_t* kcmp = (bf16_t*)(p.ws + O_KCMP);
  bf16_t* vcmpT = (bf16_t*)(p.ws + O_VCMPT);
  const float* kn = p.nsa_k_norm + layer * 64;
  for (int item = gw; item < 8192; item += nw) {
    const int kv = item >> 12, row = item & 4095;
    const bf16_t* hrow = hid + ((size_t)kv * 4096 + row) * 256;
    const float* w2 = (kv ? p.cmp_w2_v : p.cmp_w2_k) + (size_t)layer * 256 * 64;
    float acc = 0.f;
    for (int k8 = 0; k8 < 32; ++k8) {
      uint4 hv = *(const uint4*)(hrow + k8 * 8);
      const float* wr = w2 + (size_t)(k8 * 8) * 64 + lane;
      acc += bflo(hv.x) * wr[0];
      acc += bfhi(hv.x) * wr[64];
      acc += bflo(hv.y) * wr[128];
      acc += bfhi(hv.y) * wr[192];
      acc += bflo(hv.z) * wr[256];
      acc += bfhi(hv.z) * wr[320];
      acc += bflo(hv.w) * wr[384];
      acc += bfhi(hv.w) * wr[448];
    }
    if (kv == 0) {
      float ss = wave_sum(acc * acc, lane);
      float rs = rsqrtf(ss * (1.f / 64.f) + 1e-6f);
      kcmp[(size_t)row * 64 + lane] = f2bf(acc * rs * kn[lane]);
    } else {
      const int bg = row >> 9, c = row & 511;
      vcmpT[((size_t)(bg * 64 + lane)) * 512 + c] = f2bf(acc);
    }
  }
  const int gtid = blockIdx.x * 256 + tid_;
  const int gthreads = gridDim.x * 256;
  for (int idx = gtid; idx < 65536; idx += gthreads) {
    const int d4 = idx & 31, e = (idx >> 5) & 127, h = (idx >> 12) & 3, b = idx >> 14;
    const float lg2 = log2f(1.f - exp2f(-5.f - (float)h));
    const float gch = exp2f(lg2 * 128.f);
    float r0 = 0.f, r1 = 0.f, r2 = 0.f, r3 = 0.f;
    bf16_t* ptr = z + ((size_t)(b * SEQ + e)) * ZS + C_RV + h * 128 + d4 * 4;
    for (int c0 = 0; c0 < 64; c0 += 16) {
      typedef __attribute__((ext_vector_type(2))) unsigned u32x2;
      u32x2 v[16];
#pragma unroll
      for (int i = 0; i < 16; ++i) v[i] = *(const u32x2*)(ptr + (size_t)(c0 + i) * 128 * ZS);
#pragma unroll
      for (int i = 0; i < 16; ++i) {
        u32x2 o;
        o.x = pack2(r0, r1);
        o.y = pack2(r2, r3);
        *(u32x2*)(ptr + (size_t)(c0 + i) * 128 * ZS) = o;
        r0 = gch * r0 + bflo(v[i].x);
        r1 = gch * r1 + bfhi(v[i].x);
        r2 = gch * r2 + bflo(v[i].y);
        r3 = gch * r3 + bfhi(v[i].y);
      }
    }
  }
}


DI void tile64_gload(int tid, u32x4& r0, u32x4& r1, const bf16_t* base, size_t stride) {
  {
    int idx = tid;
    int row = idx >> 3, ch = idx & 7;
    r0 = *(const u32x4*)(base + (size_t)row * stride + ch * 8);
  }
  {
    int idx = tid + 256;
    int row = idx >> 3, ch = idx & 7;
    r1 = *(const u32x4*)(base + (size_t)row * stride + ch * 8);
  }
}
DI void tile64_sstore(int tid, bf16_t* dst, const u32x4& r0, const u32x4& r1) {
  {
    int idx = tid;
    int row = idx >> 3, ch = idx & 7;
    *(u32x4*)(dst + row * 64 + ((ch ^ ((row >> 1) & 7)) << 3)) = r0;
  }
  {
    int idx = tid + 256;
    int row = idx >> 3, ch = idx & 7;
    *(u32x4*)(dst + row * 64 + ((ch ^ ((row >> 1) & 7)) << 3)) = r1;
  }
}

struct AttnSt { f32x4 O[2][4]; float m[2]; float l[2]; };

template <int MODE>
DI void attn_compute(const int lane, const bf16_t* Ks, const bf16_t* Vs, const bf16x8 (&qf)[2][2], AttnSt& st, const float (&invl)[2],
                     int lo, int hi, float (&impA)[4], float (&impE)[4]) {
  const int quad = lane >> 4, col = lane & 15;
  f32x4 S[4][2];
#pragma unroll
  for (int kt = 0; kt < 4; ++kt)
#pragma unroll
    for (int hh = 0; hh < 2; ++hh) S[kt][hh] = f32x4{0.f, 0.f, 0.f, 0.f};
#pragma unroll
  for (int ks = 0; ks < 2; ++ks) {
#pragma unroll
    for (int kt = 0; kt < 4; ++kt) {
      int row = kt * 16 + col;
      bf16x8 kf = *(const bf16x8*)(Ks + row * 64 + (((ks * 4 + quad) ^ ((row >> 1) & 7)) << 3));
#pragma unroll
      for (int hh = 0; hh < 2; ++hh) S[kt][hh] = mfma16(kf, qf[hh][ks], S[kt][hh]);
    }
  }
  bf16x8 pf[2][2];
  const bool full = (lo <= 0) && (hi >= 63);
  const bool none = (hi < 0) || (lo > 63) || (hi < lo);
  if (__all(full || none)) {
    constexpr float L2E = 1.4426950408889634f;
#pragma unroll
    for (int hh = 0; hh < 2; ++hh) {
      float mL;
      float il = 1.f;
      if (MODE != 1) {
        float mx = -1e30f;
#pragma unroll
        for (int kt = 0; kt < 4; ++kt)
#pragma unroll
          for (int j = 0; j < 4; ++j) mx = fmaxf(mx, S[kt][hh][j]);
        mx = full ? mx : -1e30f;
        mx = fmaxf(mx, shx(mx, 16, lane));
        mx = fmaxf(mx, shx(mx, 32, lane));
        const float m_new = fmaxf(st.m[hh], mx);
        const float alpha = __expf(st.m[hh] - m_new);
        st.m[hh] = m_new;
        st.l[hh] *= alpha;
        if (MODE == 2) {
#pragma unroll
          for (int dt = 0; dt < 4; ++dt) st.O[hh][dt] *= alpha;
        }
        mL = full ? m_new * L2E : 1e30f;
      } else {
        mL = full ? st.m[hh] * L2E : 1e30f;
        il = invl[hh];
      }
      float rs = 0.f;
#pragma unroll
      for (int kt = 0; kt < 4; ++kt) {
        float a = 0.f;
#pragma unroll
        for (int j = 0; j < 4; ++j) {
          float pv = __builtin_amdgcn_exp2f(fmaf(S[kt][hh][j], L2E, -mL));
          if (MODE == 1) pv *= il;
          S[kt][hh][j] = pv;
          a += pv;
        }
        rs += a;
        if (MODE == 1) {
          impA[kt] += a;
          impE[kt] += S[kt][hh][3];
        }
      }
      if (MODE != 1) st.l[hh] += rs;
      if (MODE != 0) {
#pragma unroll
        for (int c = 0; c < 2; ++c)
          pf[hh][c] = mk8(pack2(S[2 * c][hh][0], S[2 * c][hh][1]), pack2(S[2 * c][hh][2], S[2 * c][hh][3]),
                          pack2(S[2 * c + 1][hh][0], S[2 * c + 1][hh][1]), pack2(S[2 * c + 1][hh][2], S[2 * c + 1][hh][3]));
      }
    }
  } else {
#pragma unroll
  for (int hh = 0; hh < 2; ++hh) {
    float mx = -1e30f;
#pragma unroll
    for (int kt = 0; kt < 4; ++kt)
#pragma unroll
      for (int j = 0; j < 4; ++j) {
        int kl = kt * 16 + quad * 4 + j;
        bool v = (kl >= lo) && (kl <= hi);
        float sv = v ? S[kt][hh][j] : -1e30f;
        S[kt][hh][j] = sv;
        mx = fmaxf(mx, sv);
      }
    if (MODE != 1) {
      mx = fmaxf(mx, shx(mx, 16, lane));
      mx = fmaxf(mx, shx(mx, 32, lane));
      float m_new = fmaxf(st.m[hh], mx);
      float alpha = __expf(st.m[hh] - m_new);
      st.m[hh] = m_new;
      float rs = 0.f;
#pragma unroll
      for (int kt = 0; kt < 4; ++kt)
#pragma unroll
        for (int j = 0; j < 4; ++j) {
          float sv = S[kt][hh][j];
          float pv = (sv > -1e29f) ? __expf(sv - m_new) : 0.f;
          rs += pv;
          S[kt][hh][j] = pv;
        }
      st.l[hh] = st.l[hh] * alpha + rs;
      if (MODE == 2) {
#pragma unroll
        for (int dt = 0; dt < 4; ++dt) st.O[hh][dt] *= alpha;
      }
    } else {
      const float mh = st.m[hh], il = invl[hh];
#pragma unroll
      for (int kt = 0; kt < 4; ++kt) {
        float a = 0.f;
#pragma unroll
        for (int j = 0; j < 4; ++j) {
          float sv = S[kt][hh][j];
          float pv = (sv > -1e29f) ? __expf(sv - mh) * il : 0.f;
          S[kt][hh][j] = pv;
          a += pv;
        }
        impA[kt] += a;
        impE[kt] += S[kt][hh][3];
      }
    }
    if (MODE != 0) {
#pragma unroll
      for (int c = 0; c < 2; ++c)
        pf[hh][c] = mk8(pack2(S[2 * c][hh][0], S[2 * c][hh][1]), pack2(S[2 * c][hh][2], S[2 * c][hh][3]),
                        pack2(S[2 * c + 1][hh][0], S[2 * c + 1][hh][1]), pack2(S[2 * c + 1][hh][2], S[2 * c + 1][hh][3]));
    }
  }
  }
  if (MODE != 0) {
#pragma unroll
    for (int dt = 0; dt < 4; ++dt) {
      const int row = dt * 16 + col;
      const int sw = (row >> 1) & 7;
#pragma unroll
      for (int c = 0; c < 2; ++c) {
        uint2 a = *(const uint2*)(Vs + row * 64 + (((4 * c + (quad >> 1)) ^ sw) << 3) + (quad & 1) * 4);
        uint2 b = *(const uint2*)(Vs + row * 64 + (((4 * c + 2 + (quad >> 1)) ^ sw) << 3) + (quad & 1) * 4);
        bf16x8 vf = mk8(a.x, a.y, b.x, b.y);
#pragma unroll
        for (int hh = 0; hh < 2; ++hh) st.O[hh][dt] = mfma16(vf, pf[hh][c], st.O[hh][dt]);
      }
    }
  }
}

DI void st_reset(AttnSt& st) {
#pragma unroll
  for (int h = 0; h < 2; ++h) {
    st.m[h] = -1e30f;
    st.l[h] = 0.f;
#pragma unroll
    for (int dt = 0; dt < 4; ++dt) st.O[h][dt] = f32x4{0.f, 0.f, 0.f, 0.f};
  }
}

template <bool FIRST>
DI void nsa_flush(const int quad, bf16_t* optr, const AttnSt& st, const float (&sc)[2]) {
#pragma unroll
  for (int h = 0; h < 2; ++h)
#pragma unroll
    for (int dt = 0; dt < 4; ++dt) {
      uint2* q = (uint2*)(optr + h * 64 + dt * 16 + quad * 4);
      f32x4 o = st.O[h][dt] * sc[h];
      if (!FIRST) {
        uint2 pv = *q;
        o[0] += bflo(pv.x); o[1] += bfhi(pv.x); o[2] += bflo(pv.y); o[3] += bfhi(pv.y);
      }
      uint2 u;
      u.x = pack2(o[0], o[1]);
      u.y = pack2(o[2], o[3]);
      *q = u;
    }
}

DI void nsa_tile(const Params& p, int b, int g, int tile, bf16_t* lds) {
  const int tid = TID(), lane = tid & 63, w = tid >> 6, quad = lane >> 4, col = lane & 15;
  const int cur = tile;
  const int tok = tile * 64 + w * 16 + col;
  bf16_t* z = (bf16_t*)(p.ws + O_Z);
  const bf16_t* kcmp = (const bf16_t*)(p.ws + O_KCMP) + (size_t)(b * 2 + g) * 512 * 64;
  const bf16_t* vcmpT = (const bf16_t*)(p.ws + O_VCMPT) + (size_t)(b * 2 + g) * 64 * 512;
  const bf16_t* vsT = (const bf16_t*)(p.ws + O_VST) + (size_t)(b * 2 + g) * 64 * TS;
  const bf16_t* vwT = (const bf16_t*)(p.ws + O_VWT) + (size_t)(b * 2 + g) * 64 * TS;
  const bf16_t* zb = z + (size_t)b * SEQ * ZS;
  const bf16_t* ztok = z + ((size_t)(b * SEQ + tok)) * ZS;
  bf16_t* otok = (bf16_t*)(p.ws + O_ONSA) + ((size_t)(b * SEQ + tok)) * 512 + g * 256;
  bf16_t* Ks = lds;
  bf16_t* Vs = lds + 4096;
  float* impl = (float*)(lds + 8192);

  AttnSt st;
  float invl[2] = {0.f, 0.f};
  float dA[4] = {0.f, 0.f, 0.f, 0.f}, dE[4] = {0.f, 0.f, 0.f, 0.f};
  u32x4 rk0, rk1, rv0, rv1;
  bf16x8 qf[2][2];

  const int ncs = (cur < 16) ? 1 : (cur >> 4) + 1;
  const int chi = (tok >= 31) ? ((tok - 31) >> 4) : -1;

  for (int hp = 0; hp < 2; ++hp) {
#pragma unroll
    for (int hh = 0; hh < 2; ++hh)
#pragma unroll
      for (int ks = 0; ks < 2; ++ks) qf[hh][ks] = *(const bf16x8*)(ztok + C_Q + g * 256 + (hp * 2 + hh) * 64 + ks * 32 + quad * 8);
    st_reset(st);
    tile64_gload(tid, rk0, rk1, kcmp, 64);
    for (int s = 0; s < ncs; ++s) {
      __syncthreads();
      tile64_sstore(tid, Ks, rk0, rk1);
      __syncthreads();
      if (s + 1 < ncs) tile64_gload(tid, rk0, rk1, kcmp + (size_t)(s + 1) * 4096, 64);
      attn_compute<0>(lane, Ks, Vs, qf, st, invl, 0, chi - s * 64, dA, dE);
    }
#pragma unroll
    for (int h = 0; h < 2; ++h) {
      float l = st.l[h];
      l += shx(l, 16, lane);
      l += shx(l, 32, lane);
      invl[h] = (l > 0.f) ? 1.f / l : 0.f;
    }
    {
      float carry = 0.f;
      tile64_gload(tid, rk0, rk1, kcmp, 64);
      tile64_gload(tid, rv0, rv1, vcmpT, 512);
      for (int s = 0; s < ncs; ++s) {
        float iA[4] = {0.f, 0.f, 0.f, 0.f}, iE[4] = {0.f, 0.f, 0.f, 0.f};
        __syncthreads();
        tile64_sstore(tid, Ks, rk0, rk1);
        tile64_sstore(tid, Vs, rv0, rv1);
        __syncthreads();
        if (s + 1 < ncs) {
          tile64_gload(tid, rk0, rk1, kcmp + (size_t)(s + 1) * 4096, 64);
          tile64_gload(tid, rv0, rv1, vcmpT + (s + 1) * 64, 512);
        }
        attn_compute<1>(lane, Ks, Vs, qf, st, invl, 0, chi - s * 64, iA, iE);
#pragma unroll
        for (int kt = 0; kt < 4; ++kt) {
          float recv = shfrom(iE[kt], (lane + 48) & 63);
          float val = iA[kt] + ((quad == 0) ? carry : recv);
          carry = recv;
          float* slot = impl + (s * 4 + kt) * 256 + tid;
          if (hp == 0) *slot = val; else *slot += val;
        }
      }
    }
    {
      float sc[2];
#pragma unroll
      for (int h = 0; h < 2; ++h) sc[h] = sigmoidf(bf2f(ztok[C_GT + 0 * 8 + g * 4 + hp * 2 + h]));
      nsa_flush<true>(quad, otok + hp * 128, st, sc);
    }
  }

  uint32_t sw0, sw1, sw2, sw3;
  {
    uint32_t key[32];
#pragma unroll
    for (int i = 0; i < 32; ++i) {
      int j = i * 4 + quad;
      float sc = (i < ncs * 4) ? impl[i * 256 + tid] : 0.f;
      if (j == 0 || j == cur || j == cur - 1) sc = 1e4f;
      uint32_t k = (__float_as_uint(sc) & ~127u) | (uint32_t)(127 - j);
      key[i] = (j > cur) ? 0u : k;
    }
    uint32_t prev = 0xFFFFFFFFu;
    for (int r = 0; r < 16; ++r) {
      uint32_t mx = 0u;
#pragma unroll
      for (int i = 0; i < 32; ++i) {
        uint32_t k = key[i];
        k = (k < prev) ? k : 0u;
        mx = (k > mx) ? k : mx;
      }
      uint32_t o = shxu(mx, 16, lane);
      mx = (o > mx) ? o : mx;
      o = shxu(mx, 32, lane);
      mx = (o > mx) ? o : mx;
      prev = mx;
    }
    sw0 = 0u; sw1 = 0u; sw2 = 0u; sw3 = 0u;
#pragma unroll
    for (int i = 0; i < 32; ++i) {
      bool sel = (key[i] != 0u) && (key[i] >= prev);
      uint32_t bit = sel ? (1u << ((i & 7) * 4 + quad)) : 0u;
      if ((i >> 3) == 0) sw0 |= bit;
      else if ((i >> 3) == 1) sw1 |= bit;
      else if ((i >> 3) == 2) sw2 |= bit;
      else sw3 |= bit;
    }
    sw0 |= shxu(sw0, 16, lane); sw0 |= shxu(sw0, 32, lane);
    sw1 |= shxu(sw1, 16, lane); sw1 |= shxu(sw1, 32, lane);
    sw2 |= shxu(sw2, 16, lane); sw2 |= shxu(sw2, 32, lane);
    sw3 |= shxu(sw3, 16, lane); sw3 |= shxu(sw3, 32, lane);
  }

  for (int hp = 0; hp < 2; ++hp) {
#pragma unroll
    for (int hh = 0; hh < 2; ++hh)
#pragma unroll
      for (int ks = 0; ks < 2; ++ks) qf[hh][ks] = *(const bf16x8*)(ztok + C_Q + g * 256 + (hp * 2 + hh) * 64 + ks * 32 + quad * 8);
    st_reset(st);
    {
      const bf16_t* kb = zb + C_KS + g * 64;
      tile64_gload(tid, rk0, rk1, kb, ZS);
      tile64_gload(tid, rv0, rv1, vsT, TS);
      for (int s = 0; s <= cur; ++s) {
        __syncthreads();
        tile64_sstore(tid, Ks, rk0, rk1);
        tile64_sstore(tid, Vs, rv0, rv1);
        __syncthreads();
        if (s < cur) {
          tile64_gload(tid, rk0, rk1, kb + (size_t)(s + 1) * 64 * ZS, ZS);
          tile64_gload(tid, rv0, rv1, vsT + (s + 1) * 64, TS);
        }
        uint32_t wsel = (s < 32) ? sw0 : (s < 64) ? sw1 : (s < 96) ? sw2 : sw3;
        bool sel = (wsel >> (s & 31)) & 1u;
        int hi = sel ? (tok - s * 64) : -1;
        if (__any(hi >= 0)) attn_compute<2>(lane, Ks, Vs, qf, st, invl, 0, hi, dA, dE);
      }
    }
    {
      float sc[2];
#pragma unroll
      for (int h = 0; h < 2; ++h) {
        float l = st.l[h];
        l += shx(l, 16, lane);
        l += shx(l, 32, lane);
        sc[h] = (l > 0.f) ? sigmoidf(bf2f(ztok[C_GT + 1 * 8 + g * 4 + hp * 2 + h])) / l : 0.f;
      }
      nsa_flush<false>(quad, otok + hp * 128, st, sc);
    }
    st_reset(st);
    {
      const bf16_t* kb = zb + C_KW + g * 64;
      const int s0 = (cur >= 8) ? cur - 8 : 0;
      tile64_gload(tid, rk0, rk1, kb + (size_t)s0 * 64 * ZS, ZS);
      tile64_gload(tid, rv0, rv1, vwT + s0 * 64, TS);
      for (int s = s0; s <= cur; ++s) {
        __syncthreads();
        tile64_sstore(tid, Ks, rk0, rk1);
        tile64_sstore(tid, Vs, rv0, rv1);
        __syncthreads();
        if (s < cur) {
          tile64_gload(tid, rk0, rk1, kb + (size_t)(s + 1) * 64 * ZS, ZS);
          tile64_gload(tid, rv0, rv1, vwT + (s + 1) * 64, TS);
        }
        attn_compute<2>(lane, Ks, Vs, qf, st, invl, tok - 511 - s * 64, tok - s * 64, dA, dE);
      }
    }
    {
      float sc[2];
#pragma unroll
      for (int h = 0; h < 2; ++h) {
        float l = st.l[h];
        l += shx(l, 16, lane);
        l += shx(l, 32, lane);
        sc[h] = (l > 0.f) ? sigmoidf(bf2f(ztok[C_GT + 2 * 8 + g * 4 + hp * 2 + h])) / l : 0.f;
      }
      nsa_flush<false>(quad, otok + hp * 128, st, sc);
    }
  }
}

DI void load128(int tid, bf16_t* lds, const bf16_t* base, size_t stride) {
  u32x4 r[8];
#pragma unroll
  for (int i = 0; i < 8; ++i) {
    int idx = tid + 256 * i;
    int row = idx >> 4, ch = idx & 15;
    r[i] = *(const u32x4*)(base + (size_t)row * stride + ch * 8);
  }
#pragma unroll
  for (int i = 0; i < 8; ++i) {
    int idx = tid + 256 * i;
    int row = idx >> 4, ch = idx & 15;
    *(u32x4*)(lds + row * 128 + ((ch ^ (row & 15)) << 3)) = r[i];
  }
}

DI void ret_tile(const Params& p, int b, int h, int c, bf16_t* lds) {
  const int tid = TID(), lane = tid & 63, w = tid >> 6, quad = lane >> 4, col = lane & 15;
  const float lg2 = log2f(1.f - exp2f(-5.f - (float)h));
  bf16_t* z = (bf16_t*)(p.ws + O_Z);
  const bf16_t* rvT = (const bf16_t*)(p.ws + O_RVT);
  bf16_t* zc = z + ((size_t)(b * SEQ + c * 128)) * ZS;
  bf16x8 qf[2][4];
#pragma unroll
  for (int nt = 0; nt < 2; ++nt)
#pragma unroll
    for (int ks = 0; ks < 4; ++ks) {
      int n = 32 * w + nt * 16 + col;
      qf[nt][ks] = *(const bf16x8*)(zc + (size_t)n * ZS + C_RQ + h * 128 + ks * 32 + quad * 8);
    }
  f32x4 acc[8][2];
#pragma unroll
  for (int et = 0; et < 8; ++et)
#pragma unroll
    for (int nt = 0; nt < 2; ++nt) acc[et][nt] = f32x4{0.f, 0.f, 0.f, 0.f};
  __syncthreads();
  load128(tid, lds, zc + C_RV + h * 128, ZS);
  __syncthreads();
#pragma unroll
  for (int ks = 0; ks < 4; ++ks)
#pragma unroll
    for (int et = 0; et < 8; ++et) {
      int row = et * 16 + col;
      bf16x8 af = *(const bf16x8*)(lds + row * 128 + (((ks * 4 + quad) ^ (row & 15)) << 3));
#pragma unroll
      for (int nt = 0; nt < 2; ++nt) acc[et][nt] = mfma16(af, qf[nt][ks], acc[et][nt]);
    }
#pragma unroll
  for (int nt = 0; nt < 2; ++nt) {
    int n = 32 * w + nt * 16 + col;
    float xi = exp2f(lg2 * (float)(n + 1));
#pragma unroll
    for (int et = 0; et < 8; ++et) acc[et][nt] *= xi;
  }
  __syncthreads();
  load128(tid, lds, zc + C_RK + h * 128, ZS);
  __syncthreads();
  bf16x8 pf[2][4];
#pragma unroll
  for (int nt = 0; nt < 2; ++nt) {
    f32x4 s[8];
#pragma unroll
    for (int mt = 0; mt < 8; ++mt) s[mt] = f32x4{0.f, 0.f, 0.f, 0.f};
#pragma unroll
    for (int ks = 0; ks < 4; ++ks)
#pragma unroll
      for (int mt = 0; mt < 8; ++mt) {
        if (mt <= 2 * w + 1) {
          int row = mt * 16 + col;
          bf16x8 af = *(const bf16x8*)(lds + row * 128 + (((ks * 4 + quad) ^ (row & 15)) << 3));
          s[mt] = mfma16(af, qf[nt][ks], s[mt]);
        }
      }
    const int n = 32 * w + nt * 16 + col;
#pragma unroll
    for (int c2 = 0; c2 < 4; ++c2) {
      float v[8];
#pragma unroll
      for (int i = 0; i < 8; ++i) {
        const int mt = 2 * c2 + (i >> 2), j = i & 3;
        const int m = mt * 16 + quad * 4 + j;
        v[i] = (n >= m) ? s[mt][j] * exp2f(lg2 * (float)(n - m)) : 0.f;
      }
      pf[nt][c2] = mk8(pack2(v[0], v[1]), pack2(v[2], v[3]), pack2(v[4], v[5]), pack2(v[6], v[7]));
    }
  }
  __syncthreads();
  load128(tid, lds, rvT + ((size_t)((b * 4 + h) * 128)) * TS + c * 128, TS);
  __syncthreads();
#pragma unroll
  for (int c2 = 0; c2 < 4; ++c2) {
    if (2 * c2 <= 2 * w + 1) {
#pragma unroll
      for (int et = 0; et < 8; ++et) {
        int row = et * 16 + col;
        int sw = row & 15;
        uint2 a = *(const uint2*)(lds + row * 128 + (((4 * c2 + (quad >> 1)) ^ sw) << 3) + (quad & 1) * 4);
        uint2 bb = *(const uint2*)(lds + row * 128 + (((4 * c2 + 2 + (quad >> 1)) ^ sw) << 3) + (quad & 1) * 4);
        bf16x8 vf = mk8(a.x, a.y, bb.x, bb.y);
#pragma unroll
        for (int nt = 0; nt < 2; ++nt) acc[et][nt] = mfma16(vf, pf[nt][c2], acc[et][nt]);
      }
    }
  }
#pragma unroll
  for (int nt = 0; nt < 2; ++nt) {
    float ss = 0.f;
#pragma unroll
    for (int et = 0; et < 8; ++et)
#pragma unroll
      for (int j = 0; j < 4; ++j) ss += acc[et][nt][j] * acc[et][nt][j];
    ss += shx(ss, 16, lane);
    ss += shx(ss, 32, lane);
    const float rs = rsqrtf(ss * (1.f / 128.f) + 1e-6f);
    const int n = 32 * w + nt * 16 + col;
    bf16_t* zr = zc + (size_t)n * ZS;
#pragma unroll
    for (int et = 0; et < 8; ++et) {
      const int e0 = et * 16 + quad * 4;
      uint2 gv = *(const uint2*)(zr + C_RG + h * 128 + e0);
      float g0 = bflo(gv.x), g1 = bfhi(gv.x), g2 = bflo(gv.y), g3 = bfhi(gv.y);
      uint2 o;
      o.x = pack2(acc[et][nt][0] * rs * g0 * sigmoidf(g0), acc[et][nt][1] * rs * g1 * sigmoidf(g1));
      o.y = pack2(acc[et][nt][2] * rs * g2 * sigmoidf(g2), acc[et][nt][3] * rs * g3 * sigmoidf(g3));
      *(uint2*)(zr + C_RQ + h * 128 + e0) = o;
    }
  }
}

#define GEMM_TILE_LOOP(NT)                                                             \
  for (int q_ = (int)(blockIdx.x >> 3), per_ = (int)(gridDim.x >> 3), xcd_ = (int)(blockIdx.x & 7), mt = 0, ntile = 0; \
       q_ < 32 * (NT) && ((mt = (((xcd_ + 8 * (q_ / (8 * (NT)))) << 3) + ((q_ % (8 * (NT))) & 7)), ntile = ((q_ % (8 * (NT))) >> 3)), true); \
       q_ += per_)

#define XB_TMO      128
#define XB_XCNT(j)  (256  + 64 * (j))
#define XB_XSUB(j)  (1280 + 64 * (j))
#define XB_XGEN(j)  (2304 + 64 * (j))
#define XB_TOP      3328
#define XB_TOPGEN   3392
#define XB_SPIN_CAP (1u << 20)
DI unsigned xb_ld(unsigned* p) { return __hip_atomic_load(p, __ATOMIC_RELAXED, __HIP_MEMORY_SCOPE_AGENT); }
DI unsigned xb_add(unsigned* p, unsigned v) { return __hip_atomic_fetch_add(p, v, __ATOMIC_RELAXED, __HIP_MEMORY_SCOPE_AGENT); }
DI unsigned xb_xcc_id() { return (unsigned)__builtin_amdgcn_s_getreg((3 << 11) | 20) & 0xFu; }
#define XB_SPIN(cond, bar) do { unsigned _sp = 0; while (cond) { __builtin_amdgcn_s_sleep(1); \
    if ((++_sp & 255u) == 0u) { if (xb_ld(&(bar)[XB_TMO])) break; if (_sp > XB_SPIN_CAP) { atomicAdd(&(bar)[XB_TMO], 1u); break; } } } } while (0)

DI void xcd_barrier(unsigned* bar, const unsigned x, const unsigned nloc, const unsigned nx) {
  asm volatile("s_waitcnt vmcnt(0)" ::: "memory");
  __syncthreads();
  if (TID() == 0) {
    __builtin_amdgcn_s_waitcnt(0);
    const unsigned old = xb_add(&bar[XB_XSUB(x)], 1u);
    const unsigned gen = old / nloc;
    if (old + 1u == (gen + 1u) * nloc) {
      __builtin_amdgcn_fence(__ATOMIC_RELEASE, "agent");
      asm volatile("s_waitcnt vmcnt(0)" ::: "memory");
      const unsigned og = xb_add(&bar[XB_TOP], 1u);
      const unsigned tg = og / nx;
      if (og + 1u == (tg + 1u) * nx) xb_add(&bar[XB_TOPGEN], 1u);
      else XB_SPIN(xb_ld(&bar[XB_TOPGEN]) == tg, bar);
      __builtin_amdgcn_fence(__ATOMIC_ACQUIRE, "agent");
      xb_add(&bar[XB_XGEN(x)], 1u);
      asm volatile("s_waitcnt vmcnt(0)" ::: "memory");
    } else {
      XB_SPIN(xb_ld(&bar[XB_XGEN(x)]) == gen, bar);
      __builtin_amdgcn_fence(__ATOMIC_ACQUIRE, "agent");
      asm volatile("s_waitcnt vmcnt(0)" ::: "memory");
    }
  }
  __syncthreads();
}

__global__ void __launch_bounds__(256, 2) mega(Params p) {
  __shared__ __attribute__((aligned(16))) bf16_t lds[32768];
  cg::grid_group grid = cg::this_grid();
  const int nb = gridDim.x;
  bf16_t* wt = (bf16_t*)(p.ws + O_WT);
  bf16_t* z = (bf16_t*)(p.ws + O_Z);
  bf16_t* hbuf = (bf16_t*)(p.ws + O_VST);
  bf16_t* ubuf = z;
  bf16_t* p16 = z;
  bf16_t* hid = (bf16_t*)(p.ws + O_HID);
  const float* bias = (const float*)(p.ws + O_BIAS);

  unsigned* bar = (unsigned*)(p.ws + O_BAR);
  const unsigned xb_x = xb_xcc_id();
  if (TID() == 0) (void)xb_add(&bar[XB_XCNT(xb_x)], 1u);
  unsigned xb_nloc = 1u, xb_nx = 1u;

  for (int layer = 0; layer < 2; ++layer) {
    const bf16_t* wl = wt;
    const float* xin = (layer == 0) ? p.x : p.out;

    phase0(p, layer);
    norm_phase(xin, p.norm_mix + layer * DM, hbuf);
    if (layer == 0) {
      grid.sync();
      unsigned mine = 0u, cnt = 0u;
#pragma unroll
      for (unsigned j = 0; j < 16; ++j) {
        const unsigned c = xb_ld(&bar[XB_XCNT(j)]);
        cnt += (c > 0u) ? 1u : 0u;
        mine = (j == xb_x) ? c : mine;
      }
      xb_nloc = __builtin_amdgcn_readfirstlane(mine > 0u ? mine : 1u);
      xb_nx = __builtin_amdgcn_readfirstlane(cnt > 0u ? cnt : 1u);
    } else {
      xcd_barrier(bar, xb_x, xb_nloc, xb_nx);
    }

    GEMM_TILE_LOOP(43) {
      const int m0 = mt * 128, n0 = ntile * 128;
      f32x4 acc[4][4];
      zero_acc(acc);
      gemm_accum(acc, RowPtr{hbuf + (size_t)m0 * DM, DM}, RowPtr{wl + W_IN + (size_t)n0 * 1024, 1024}, 16, lds);
      gemm_epi(acc, m0, n0, [&](int m, int n, f32x4& a) {
        if (n < ZS) {
          uint2 u;
          u.x = pack2(a[0], a[1]);
          u.y = pack2(a[2], a[3]);
          *(uint2*)(z + (size_t)m * ZS + n) = u;
        }
      });
    }
    xcd_barrier(bar, xb_x, xb_nloc, xb_nx);

    post_z(p, layer);
    xcd_barrier(bar, xb_x, xb_nloc, xb_nx);

    for (int t = blockIdx.x; t < 128 + 1024; t += nb) {
      f32x4 acc[4][4];
      zero_acc(acc);
      if (t < 128) {
        const int kv = t >> 6, mt = (t >> 1) & 31, ntile = t & 1;
        const int m0 = mt * 128, n0 = ntile * 128;
        const int colbase = kv ? C_VC : C_KC;
        auto ap = [&](int r, int kb) -> const bf16_t* {
          int row = m0 + r;
          int bg = row >> 9, c = row & 511;
          int tk = 16 * c + kb;
          tk = tk > (SEQ - 1) ? (SEQ - 1) : tk;
          return z + ((size_t)((bg >> 1) * SEQ + tk)) * ZS + colbase + (bg & 1) * 64;
        };
        gemm_accum(acc, ap, RowPtr{wl + (kv ? W_C1V : W_C1K) + (size_t)n0 * 2048, 2048}, 32, lds);
        const float* bs = bias + kv * 256;
        bf16_t* hd = hid + (size_t)kv * 4096 * 256;
        gemm_epi(acc, m0, n0, [&](int m, int n, f32x4& a) {
          float o[4];
#pragma unroll
          for (int j = 0; j < 4; ++j) {
            float xv = a[j] + bs[n + j];
            float y = 0.7978845608028654f * (xv + 0.044715f * xv * xv * xv);
            float th = 1.f - 2.f / (__expf(2.f * y) + 1.f);
            o[j] = 0.5f * xv * (1.f + th);
          }
          uint2 u;
          u.x = pack2(o[0], o[1]);
          u.y = pack2(o[2], o[3]);
          *(uint2*)(hd + (size_t)m * 256 + n) = u;
        });
      } else {
        const int idx = t - 128;
        const int c = idx & 63, bh = idx >> 6;
        const bf16_t* rvT = (const bf16_t*)(p.ws + O_RVT) + ((size_t)bh * 128) * TS + c * 128;
        const bf16_t* kzT = (const bf16_t*)(p.ws + O_KZT) + ((size_t)bh * 128) * TS + c * 128;
        gemm_accum(acc, RowPtr{rvT, TS}, RowPtr{kzT, TS}, 2, lds);
        bf16_t* dst = z + ((size_t)((bh >> 2) * SEQ + c * 128)) * ZS + C_RV + (bh & 3) * 128;
        gemm_epi(acc, 0, 0, [&](int m, int n, f32x4& a) {
          uint2 u;
          u.x = pack2(a[0], a[1]);
          u.y = pack2(a[2], a[3]);
          *(uint2*)(dst + (size_t)m * ZS + n) = u;
        });
      }
    }
    xcd_barrier(bar, xb_x, xb_nloc, xb_nx);

    phase4b(p, layer);
    xcd_barrier(bar, xb_x, xb_nloc, xb_nx);

    for (int t = blockIdx.x; t < 2048; t += nb) {
      if (t < 1024) {
        const int tile = (t < 512) ? 127 - (t >> 3) : ((t - 512) >> 3), bg = t & 7;
        nsa_tile(p, bg >> 1, bg & 1, tile, lds);
      } else {
        const int idx = t - 1024;
        ret_tile(p, idx >> 8, (idx >> 6) & 3, idx & 63, lds);
      }
    }
    xcd_barrier(bar, xb_x, xb_nloc, xb_nx);

    GEMM_TILE_LOOP(8) {
      const int m0 = mt * 128, n0 = ntile * 128;
      f32x4 acc[4][4];
      zero_acc(acc);
      gemm_accum(acc, RowPtr{(const bf16_t*)(p.ws + O_ONSA) + (size_t)m0 * 512, 512}, RowPtr{wl + W_UPA + (size_t)n0 * 512, 512}, 8, lds);
      gemm_epi(acc, m0, n0, [&](int m, int n, f32x4& a) {
        uint2 ua = *(const uint2*)(z + (size_t)m * ZS + C_MA + n);
        uint2 ub = *(const uint2*)(z + (size_t)m * ZS + C_MB + n);
        a[0] *= sigmoidf(bflo(ua.x)) / sigmoidf(bflo(ub.x));
        a[1] *= sigmoidf(bfhi(ua.x)) / sigmoidf(bfhi(ub.x));
        a[2] *= sigmoidf(bflo(ua.y)) / sigmoidf(bflo(ub.y));
        a[3] *= sigmoidf(bfhi(ua.y)) / sigmoidf(bfhi(ub.y));
      });
      gemm_accum(acc, RowPtr{z + (size_t)m0 * ZS + C_RQ, ZS}, RowPtr{wl + W_UPR + (size_t)n0 * 512, 512}, 8, lds);
      gemm_epi(acc, m0, n0, [&](int m, int n, f32x4& a) {
        uint2 ub = *(const uint2*)(z + (size_t)m * ZS + C_MB + n);
        uint2 u;
        u.x = pack2(a[0] * sigmoidf(bflo(ub.x)), a[1] * sigmoidf(bfhi(ub.x)));
        u.y = pack2(a[2] * sigmoidf(bflo(ub.y)), a[3] * sigmoidf(bfhi(ub.y)));
        *(uint2*)(z + (size_t)m * ZS + C_RK + n) = u;
      });
    }
    xcd_barrier(bar, xb_x, xb_nloc, xb_nx);

    GEMM_TILE_LOOP(8) {
      const int m0 = mt * 128, n0 = ntile * 128;
      f32x4 acc[4][4];
      zero_acc(acc);
      gemm_accum(acc, RowPtr{z + (size_t)m0 * ZS + C_RK, ZS}, RowPtr{wl + W_OUT + (size_t)n0 * 1024, 1024}, 16, lds);
      gemm_epi(acc, m0, n0, [&](int m, int n, f32x4& a) {
        float4 xv = *(const float4*)(xin + (size_t)m * DM + n);
        *(float4*)(p.out + (size_t)m * DM + n) = make_float4(xv.x + a[0], xv.y + a[1], xv.z + a[2], xv.w + a[3]);
      });
    }
    xcd_barrier(bar, xb_x, xb_nloc, xb_nx);

    norm_phase(p.out, p.norm_mlp + layer * DM, hbuf);
    xcd_barrier(bar, xb_x, xb_nloc, xb_nx);

    GEMM_TILE_LOOP(32) {
      const int m0 = mt * 128, n0 = ntile * 128;
      f32x4 acc[4][4];
      zero_acc(acc);
      gemm_accum(acc, RowPtr{hbuf + (size_t)m0 * DM, DM}, RowPtr{wl + W_FF1 + (size_t)n0 * 1024, 1024}, 16, lds);
      gemm_epi(acc, m0, n0, [&](int m, int n, f32x4& a) {
        float r0 = fmaxf(a[0], 0.f), r1 = fmaxf(a[1], 0.f), r2 = fmaxf(a[2], 0.f), r3 = fmaxf(a[3], 0.f);
        uint2 u;
        u.x = pack2(r0 * r0, r1 * r1);
        u.y = pack2(r2 * r2, r3 * r3);
        *(uint2*)(ubuf + (size_t)m * 4096 + n) = u;
      });
    }
    xcd_barrier(bar, xb_x, xb_nloc, xb_nx);

    GEMM_TILE_LOOP(8) {
      const int m0 = mt * 128, n0 = ntile * 128;
      f32x4 acc[4][4];
      zero_acc(acc);
      gemm_accum(acc, RowPtr{ubuf + (size_t)m0 * 4096, 4096}, RowPtr{wl + W_FF2 + (size_t)n0 * 4096, 4096}, 64, lds);
      gemm_epi(acc, m0, n0, [&](int m, int n, f32x4& a) {
        float4* o = (float4*)(p.out + (size_t)m * DM + n);
        float4 xv = *o;
        *o = make_float4(xv.x + a[0], xv.y + a[1], xv.z + a[2], xv.w + a[3]);
      });
    }
    xcd_barrier(bar, xb_x, xb_nloc, xb_nx);

    norm_phase(p.out, p.norm_ple + layer * DM, hbuf);
    {
      const float* pl = p.p + (size_t)layer * T_TOK * 256;
      const int gtid = blockIdx.x * 256 + TID();
      const int gthreads = nb * 256;
      for (int i = gtid; i < T_TOK * 32; i += gthreads) {
        float4 a = ((const float4*)pl)[2 * i], b2 = ((const float4*)pl)[2 * i + 1];
        ((uint4*)p16)[i] = make_uint4(pack2(a.x, a.y), pack2(a.z, a.w), pack2(b2.x, b2.y), pack2(b2.z, b2.w));
      }
    }
    xcd_barrier(bar, xb_x, xb_nloc, xb_nx);

    GEMM_TILE_LOOP(8) {
      const int m0 = mt * 128, n0 = ntile * 128;
      f32x4 acc[4][4];
      zero_acc(acc);
      gemm_accum(acc, RowPtr{p16 + (size_t)m0 * 256, 256}, RowPtr{wl + W_PLE + (size_t)n0 * 256, 256}, 4, lds);
      bf16_t* ppb = z + (size_t)T_TOK * 256;
      gemm_epi(acc, m0, n0, [&](int m, int n, f32x4& a) {
        uint2 u;
        u.x = pack2(a[0], a[1]);
        u.y = pack2(a[2], a[3]);
        *(uint2*)(ppb + (size_t)m * DM + n) = u;
      });
      zero_acc(acc);
      gemm_accum(acc, RowPtr{hbuf + (size_t)m0 * DM, DM}, RowPtr{wl + W_PG + (size_t)n0 * 1024, 1024}, 16, lds);
      gemm_epi(acc, m0, n0, [&](int m, int n, f32x4& a) {
        uint2 pv = *(const uint2*)(ppb + (size_t)m * DM + n);
        float4* o = (float4*)(p.out + (size_t)m * DM + n);
        float4 xv = *o;
        *o = make_float4(xv.x + sigmoidf(a[0]) * bflo(pv.x), xv.y + sigmoidf(a[1]) * bfhi(pv.x),
                         xv.z + sigmoidf(a[2]) * bflo(pv.y), xv.w + sigmoidf(a[3]) * bfhi(pv.y));
      });
    }
    xcd_barrier(bar, xb_x, xb_nloc, xb_nx);
  }
}

extern "C" void kernel_launch(void* const* d_in, const int* in_sizes, int n_in,
                              void* d_out, int out_size, void* d_ws, size_t ws_size,
                              hipStream_t stream) {
  static int grid_blocks = 0;
  if (!grid_blocks) {
    int dev = 0, cus = 0, per_cu = 0;
    hipGetDevice(&dev);
    hipDeviceGetAttribute(&cus, hipDeviceAttributeMultiprocessorCount, dev);
    hipOccupancyMaxActiveBlocksPerMultiprocessor(&per_cu, mega, 256, 0);
    if (per_cu > 2) per_cu = 2;
    if (per_cu < 1) per_cu = 1;
    grid_blocks = cus * per_cu;
  }
  if (ws_size < WS_NEED) {
    fprintf(stderr, "workspace too small: %zu < %llu\n", ws_size, (unsigned long long)WS_NEED);
    return;
  }
  Params p{};
  p.x = (const float*)d_in[0]; p.p = (const float*)d_in[1]; p.norm_mix = (const float*)d_in[2]; p.w_in = (const float*)d_in[3];
  p.nsa_q_norm = (const float*)d_in[4]; p.nsa_k_norm = (const float*)d_in[5]; p.cmp_pos_k = (const float*)d_in[6];
  p.cmp_pos_v = (const float*)d_in[7]; p.cmp_w1_k = (const float*)d_in[8]; p.cmp_w2_k = (const float*)d_in[9];
  p.cmp_w1_v = (const float*)d_in[10]; p.cmp_w2_v = (const float*)d_in[11]; p.w_up_nsa = (const float*)d_in[12];
  p.w_up_ret = (const float*)d_in[13]; p.w_out = (const float*)d_in[14]; p.norm_mlp = (const float*)d_in[15];
  p.w_ff1 = (const float*)d_in[16]; p.w_ff2 = (const float*)d_in[17]; p.norm_ple = (const float*)d_in[18];
  p.w_ple = (const float*)d_in[19]; p.w_ple_gate = (const float*)d_in[20];
  p.out = (float*)d_out; p.ws = (char*)d_ws;
  hipMemsetAsync((char*)d_ws + O_BAR, 0, BAR_BYTES, stream);
  void* args[] = {&p};
  hipError_t e = hipLaunchCooperativeKernel((void*)mega, dim3(grid_blocks), dim3(256), args, 0, stream);
  if (e != hipSuccess) fprintf(stderr, "cooperative launch failed: %s (grid %d)\n", hipGetErrorString(e), grid_blocks);
}
```

```cpp
#include <hip/hip_runtime.h>
#include <hip/hip_cooperative_groups.h>
#include <cstdio>
#include <cstdint>
namespace cg = cooperative_groups;

typedef __attribute__((ext_vector_type(8))) short bf16x8;
typedef __attribute__((ext_vector_type(4))) float f32x4;
typedef unsigned short bf16_t;
typedef __attribute__((ext_vector_type(4))) unsigned u32x4;
#define DI __device__ __forceinline__

#define T_TOK 32768
#define SEQ 8192
#define DM 1024
#define ZS 5400
#define C_Q 0
#define C_KC 512
#define C_VC 640
#define C_KS 768
#define C_VS 896
#define C_KW 1024
#define C_VW 1152
#define C_GT 1280
#define C_RQ 1304
#define C_RK 1816
#define C_RV 2328
#define C_RG 2840
#define C_MA 3352
#define C_MB 4376
#define NPAD_IN 5504
#define TS 8256

#define W_IN 0
#define W_C1K 5636096
#define W_C1V 6160384
#define W_UPA 6684672
#define W_UPR 7208960
#define W_OUT 7733248
#define W_FF1 8781824
#define W_FF2 12976128
#define W_PLE 17170432
#define W_PG 17432576
#define W_LAYER 18481152

#define O_WT 0ull
#define O_ROPE 36962304ull
#define O_BIAS 41156608ull
#define O_HID 41160704ull
#define O_KCMP 45355008ull
#define O_VCMPT 45879296ull
#define O_VST 46403584ull
#define O_VWT 54857728ull
#define O_RVT 63311872ull
#define O_KZT 97128448ull
#define O_Z 130945024ull
#define O_ONSA 484839424ull
#define O_BAR 518393856ull
#define BAR_BYTES 13824
#define O_KVD 518407680ull
#define WS_NEED 535184896ull

struct Params {
  const float* x; const float* p; const float* norm_mix; const float* w_in;
  const float* nsa_q_norm; const float* nsa_k_norm; const float* cmp_pos_k; const float* cmp_pos_v;
  const float* cmp_w1_k; const float* cmp_w2_k; const float* cmp_w1_v; const float* cmp_w2_v;
  const float* w_up_nsa; const float* w_up_ret; const float* w_out; const float* norm_mlp;
  const float* w_ff1; const float* w_ff2; const float* norm_ple; const float* w_ple; const float* w_ple_gate;
  float* out; char* ws;
};

DI unsigned pack2(float a, float b) {
  typedef __attribute__((ext_vector_type(2))) __bf16 bf2;
  typedef __attribute__((ext_vector_type(2))) float f2;
  f2 v = {a, b};
  bf2 r = __builtin_convertvector(v, bf2);
  return __builtin_bit_cast(unsigned, r);
}
DI bf16_t f2bf(float a) { return (bf16_t)(pack2(a, 0.f) & 0xffffu); }
DI float bf2f(bf16_t h) { return __uint_as_float(((unsigned)h) << 16); }
DI float bflo(unsigned u) { return __uint_as_float(u << 16); }
DI float bfhi(unsigned u) { return __uint_as_float(u & 0xffff0000u); }
DI float shx(float v, int mask, int lane) {
  return __int_as_float(__builtin_amdgcn_ds_bpermute((lane ^ mask) << 2, __float_as_int(v)));
}
DI uint32_t shxu(uint32_t v, int mask, int lane) {
  return (uint32_t)__builtin_amdgcn_ds_bpermute((lane ^ mask) << 2, (int)v);
}
DI float shfrom(float v, int srclane) {
  return __int_as_float(__builtin_amdgcn_ds_bpermute(srclane << 2, __float_as_int(v)));
}
DI float wave_sum(float v, int lane) {
#pragma unroll
  for (int o = 32; o > 0; o >>= 1) v += shx(v, o, lane);
  return v;
}
DI int TID() { int t = threadIdx.x; asm volatile("" : "+v"(t)); return t; }
DI float sigmoidf(float x) { return 1.f / (1.f + __expf(-x)); }
DI f32x4 mfma16(bf16x8 a, bf16x8 b, f32x4 c) { return __builtin_amdgcn_mfma_f32_16x16x32_bf16(a, b, c, 0, 0, 0); }
DI bf16x8 mk8(unsigned a, unsigned b, unsigned c, unsigned d) {
  uint4 u = make_uint4(a, b, c, d);
  return __builtin_bit_cast(bf16x8, u);
}

template <class AP, class BP>
DI void g_load(u32x4 (&ra)[4], u32x4 (&rb)[4], const AP& ap, const BP& bp, int kb, int lrow, int lch) {
#pragma unroll
  for (int i = 0; i < 4; ++i) {
    ra[i] = *(const u32x4*)(ap(lrow + 32 * i, kb) + lch * 8);
    rb[i] = *(const u32x4*)(bp(lrow + 32 * i, kb) + lch * 8);
  }
}
DI void g_store(bf16_t* As, bf16_t* Bs, const u32x4 (&ra)[4], const u32x4 (&rb)[4], int buf, int lrow, int lch) {
#pragma unroll
  for (int i = 0; i < 4; ++i) {
    int r = lrow + 32 * i;
    int off = buf * 8192 + r * 64 + ((lch ^ ((r >> 1) & 7)) << 3);
    *(u32x4*)(As + off) = ra[i];
    *(u32x4*)(Bs + off) = rb[i];
  }
}
DI void g_compute(f32x4 (&acc)[4][4], const bf16_t* a, const bf16_t* b, int wm, int wn, int lane) {
  bf16x8 af[2][4], bfr[2][4];
#pragma unroll
  for (int ks = 0; ks < 2; ++ks)
#pragma unroll
    for (int i = 0; i < 4; ++i) {
      int r = wm * 64 + i * 16 + (lane & 15);
      af[ks][i] = *(const bf16x8*)(a + r * 64 + (((ks * 4 + (lane >> 4)) ^ ((r >> 1) & 7)) << 3));
      int r2 = wn * 64 + i * 16 + (lane & 15);
      bfr[ks][i] = *(const bf16x8*)(b + r2 * 64 + (((ks * 4 + (lane >> 4)) ^ ((r2 >> 1) & 7)) << 3));
    }
  __builtin_amdgcn_s_setprio(1);
#pragma unroll
  for (int ks = 0; ks < 2; ++ks)
#pragma unroll
    for (int i = 0; i < 4; ++i)
#pragma unroll
      for (int j = 0; j < 4; ++j) acc[i][j] = mfma16(bfr[ks][j], af[ks][i], acc[i][j]);
  __builtin_amdgcn_s_setprio(0);
}
template <class AP, class BP>
DI void gemm_accum(f32x4 (&acc)[4][4], AP ap, BP bp, int nkb, bf16_t* lds) {
  const int tid = TID(), lane = tid & 63, w = tid >> 6;
  const int wm = w >> 1, wn = w & 1;
  const int lrow = tid >> 3, lch = tid & 7;
  bf16_t* As = lds;
  bf16_t* Bs = lds + 16384;
  u32x4 ra0[4], rb0[4], ra1[4], rb1[4];
  __syncthreads();
  g_load(ra0, rb0, ap, bp, 0, lrow, lch);
  g_load(ra1, rb1, ap, bp, 1, lrow, lch);
  g_store(As, Bs, ra0, rb0, 0, lrow, lch);
  __syncthreads();
  for (int kb = 0; kb < nkb; kb += 2) {
    const int k2 = (kb + 2 < nkb) ? kb + 2 : nkb - 2;
    g_load(ra0, rb0, ap, bp, k2, lrow, lch);
    __builtin_amdgcn_sched_barrier(0);
    g_compute(acc, As, Bs, wm, wn, lane);
    g_store(As, Bs, ra1, rb1, 1, lrow, lch);
    __syncthreads();
    g_load(ra1, rb1, ap, bp, k2 + 1, lrow, lch);
    __builtin_amdgcn_sched_barrier(0);
    g_compute(acc, As + 8192, Bs + 8192, wm, wn, lane);
    g_store(As, Bs, ra0, rb0, 0, lrow, lch);
    __syncthreads();
  }
}
template <class E>
DI void gemm_epi(f32x4 (&acc)[4][4], int m0, int n0, E e) {
  const int tid_ = TID();
  const int lane = tid_ & 63, w = tid_ >> 6;
  const int wm = w >> 1, wn = w & 1;
#pragma unroll
  for (int i = 0; i < 4; ++i)
#pragma unroll
    for (int j = 0; j < 4; ++j) {
      int m = m0 + wm * 64 + i * 16 + (lane & 15);
      int n = n0 + wn * 64 + j * 16 + (lane >> 4) * 4;
      e(m, n, acc[i][j]);
    }
}
DI void zero_acc(f32x4 (&acc)[4][4]) {
#pragma unroll
  for (int i = 0; i < 4; ++i)
#pragma unroll
    for (int j = 0; j < 4; ++j) acc[i][j] = f32x4{0.f, 0.f, 0.f, 0.f};
}
struct RowPtr {
  const bf16_t* base; size_t ld;
  DI const bf16_t* operator()(int r, int kb) const { return base + (size_t)r * ld + kb * 64; }
};

DI void convert_wt(const float* W, bf16_t* Wt, int K, int N, int Npad, int gtid, int gthreads) {
  const int k8n = K >> 3;
  const long total = (long)Npad * k8n;
  for (long idx = gtid; idx < total; idx += gthreads) {
    int n = (int)(idx % Npad);
    int k8 = (int)(idx / Npad);
    uint4 o = make_uint4(0, 0, 0, 0);
    if (n < N) {
      const float* s = W + (size_t)(k8 * 8) * N + n;
      float v0 = s[0], v1 = s[(size_t)N], v2 = s[(size_t)2 * N], v3 = s[(size_t)3 * N];
      float v4 = s[(size_t)4 * N], v5 = s[(size_t)5 * N], v6 = s[(size_t)6 * N], v7 = s[(size_t)7 * N];
      o = make_uint4(pack2(v0, v1), pack2(v2, v3), pack2(v4, v5), pack2(v6, v7));
    }
    *(uint4*)(Wt + (size_t)n * K + k8 * 8) = o;
  }
}

DI void phase0(const Params& p, const int L) {
  const int gtid = blockIdx.x * 256 + TID();
  const int gthreads = gridDim.x * 256;
  bf16_t* wl = (bf16_t*)(p.ws + O_WT);
  convert_wt(p.w_in + (size_t)L * 1024 * 5400, wl + W_IN, 1024, 5400, NPAD_IN, gtid, gthreads);
  convert_wt(p.cmp_w1_k + (size_t)L * 2048 * 256, wl + W_C1K, 2048, 256, 256, gtid, gthreads);
  convert_wt(p.cmp_w1_v + (size_t)L * 2048 * 256, wl + W_C1V, 2048, 256, 256, gtid, gthreads);
  convert_wt(p.w_up_nsa + (size_t)L * 512 * 1024, wl + W_UPA, 512, 1024, 1024, gtid, gthreads);
  convert_wt(p.w_up_ret + (size_t)L * 512 * 1024, wl + W_UPR, 512, 1024, 1024, gtid, gthreads);
  convert_wt(p.w_out + (size_t)L * 1024 * 1024, wl + W_OUT, 1024, 1024, 1024, gtid, gthreads);
  convert_wt(p.w_ff1 + (size_t)L * 1024 * 4096, wl + W_FF1, 1024, 4096, 4096, gtid, gthreads);
  convert_wt(p.w_ff2 + (size_t)L * 4096 * 1024, wl + W_FF2, 4096, 1024, 1024, gtid, gthreads);
  convert_wt(p.w_ple + (size_t)L * 256 * 1024, wl + W_PLE, 256, 1024, 1024, gtid, gthreads);
  convert_wt(p.w_ple_gate + (size_t)L * 1024 * 1024, wl + W_PG, 1024, 1024, 1024, gtid, gthreads);
  if (L == 0) {
    float2* rope = (float2*)(p.ws + O_ROPE);
    for (int idx = gtid; idx < SEQ * 64; idx += gthreads) {
      int pos = idx >> 6, j = idx & 63;
      float inv = exp2f(-(float)j * (13.287712379549449f / 64.f));
      float ang = (float)pos * inv;
      double rev = (double)ang * 0.15915494309189535;
      rev -= rint(rev);
      float fr = (float)rev;
      rope[idx] = make_float2(__builtin_amdgcn_cosf(fr), __builtin_amdgcn_sinf(fr));
    }
  }
  float* part = (float*)(p.ws + O_HID);
  {
    const int n = gtid & 255;
    for (int item = (int)blockIdx.x; item < 128; item += (int)gridDim.x) {
      const int kv = item >> 6, kc = item & 63;
      const float* pos = (kv ? p.cmp_pos_v : p.cmp_pos_k) + L * 2048 + kc * 32;
      const float* w1 = (kv ? p.cmp_w1_v : p.cmp_w1_k) + (size_t)L * 2048 * 256 + (size_t)kc * 32 * 256;
      float a = 0.f;
#pragma unroll 8
      for (int k = 0; k < 32; ++k) a += pos[k] * w1[(size_t)k * 256 + n];
      part[item * 256 + n] = a;
    }
  }
}

DI void norm_phase(const float* xin, const float* g, bf16_t* h) {
  const int tid_ = TID();
  const int lane = tid_ & 63;
  const int gw = (blockIdx.x * 256 + tid_) >> 6;
  const int nw = gridDim.x * 4;
  float4 gv[4];
#pragma unroll
  for (int i = 0; i < 4; ++i) gv[i] = ((const float4*)g)[i * 64 + lane];
  for (int row = gw; row < T_TOK; row += nw) {
    const float4* xr = (const float4*)(xin + (size_t)row * DM);
    float4 v[4];
    float ss = 0.f;
#pragma unroll
    for (int i = 0; i < 4; ++i) {
      v[i] = xr[i * 64 + lane];
      ss += v[i].x * v[i].x + v[i].y * v[i].y + v[i].z * v[i].z + v[i].w * v[i].w;
    }
    ss = wave_sum(ss, lane);
    float rs = rsqrtf(ss * (1.f / 1024.f) + 1e-6f);
    uint2* hr = (uint2*)(h + (size_t)row * DM);
#pragma unroll
    for (int i = 0; i < 4; ++i) {
      uint2 o;
      o.x = pack2(v[i].x * rs * gv[i].x, v[i].y * rs * gv[i].y);
      o.y = pack2(v[i].z * rs * gv[i].z, v[i].w * rs * gv[i].w);
      hr[i * 64 + lane] = o;
    }
  }
}

DI void post_z(const Params& p, int layer) {
  const int tid_ = TID();
  const int lane = tid_ & 63;
  const int gw = (blockIdx.x * 256 + tid_) >> 6;
  const int nw = gridDim.x * 4;
  bf16_t* z = (bf16_t*)(p.ws + O_Z);
  bf16_t* vsT = (bf16_t*)(p.ws + O_VST);
  bf16_t* vwT = (bf16_t*)(p.ws + O_VWT);
  bf16_t* rvT = (bf16_t*)(p.ws + O_RVT);
  bf16_t* kzT = (bf16_t*)(p.ws + O_KZT);
  const float2* rope = (const float2*)(p.ws + O_ROPE);
  const float* qn = p.nsa_q_norm + layer * 64;
  const float* kn = p.nsa_k_norm + layer * 64;
  {
    const float* part = (const float*)(p.ws + O_HID);
    float* bias = (float*)(p.ws + O_BIAS);
    const int idx = blockIdx.x * 256 + tid_;
    if (idx < 512) {
      const int kv = idx >> 8, n = idx & 255;
      float a = 0.f;
      for (int kc = 0; kc < 64; ++kc) a += part[(kv * 64 + kc) * 256 + n];
      bias[idx] = a;
    }
  }
  for (int item = gw; item < 1024 * 36; item += nw) {
    const int tc = item / 36, slab = item - tc * 36;
    const int tok0 = tc * 32;
    const int b = tok0 >> 13, spos = tok0 & 8191;
    bf16_t* zr = z + (size_t)tok0 * ZS;
    if (slab >= 32) {
      const int s4 = slab - 32, kv = s4 >> 1, gi = s4 & 1;
      const int colbase = (kv ? C_VC : C_KC) + gi * 64;
      bf16_t* dst = (bf16_t*)(p.ws + O_KVD) + ((size_t)((kv * 8 + b * 2 + gi) * SEQ + spos)) * 64 + lane;
      bf16_t u[32];
#pragma unroll
      for (int i = 0; i < 32; ++i) u[i] = zr[(size_t)i * ZS + colbase + lane];
#pragma unroll
      for (int i = 0; i < 32; ++i) dst[i * 64] = u[i];
    } else if (slab < 12) {
      int colbase; const float* g; float sc;
      if (slab < 8) { colbase = C_Q + slab * 64; g = qn; sc = 0.125f; }
      else if (slab < 10) { colbase = C_KS + (slab - 8) * 64; g = kn; sc = 1.f; }
      else { colbase = C_KW + (slab - 10) * 64; g = kn; sc = 1.f; }
      const float gv = g[lane] * sc;
      float v[32];
#pragma unroll
      for (int i = 0; i < 32; ++i) v[i] = bf2f(zr[(size_t)i * ZS + colbase + lane]);
#pragma unroll
      for (int i = 0; i < 32; ++i) {
        float ss = wave_sum(v[i] * v[i], lane);
        float rs = rsqrtf(ss * (1.f / 64.f) + 1e-6f);
        zr[(size_t)i * ZS + colbase + lane] = f2bf(v[i] * rs * gv);
      }
    } else if (slab < 16 || slab >= 24) {
      int colbase; bf16_t* dst;
      if (slab < 16) {
        const int gi = slab & 1;
        const bool isw = slab >= 14;
        colbase = (isw ? C_VW : C_VS) + gi * 64;
        dst = (isw ? vwT : vsT) + ((size_t)((b * 2 + gi) * 64 + lane)) * TS + spos;
      } else {
        const int s8 = slab - 24;
        const int h = s8 >> 1, half = s8 & 1;
        colbase = C_RV + s8 * 64;
        dst = rvT + ((size_t)((b * 4 + h) * 128 + half * 64 + lane)) * TS + spos;
      }
      unsigned u[32];
#pragma unroll
      for (int i = 0; i < 32; ++i) u[i] = zr[(size_t)i * ZS + colbase + lane];
#pragma unroll
      for (int q4 = 0; q4 < 4; ++q4)
        *(uint4*)(dst + q4 * 8) = make_uint4(u[q4 * 8 + 0] | (u[q4 * 8 + 1] << 16), u[q4 * 8 + 2] | (u[q4 * 8 + 3] << 16),
                                             u[q4 * 8 + 4] | (u[q4 * 8 + 5] << 16), u[q4 * 8 + 6] | (u[q4 * 8 + 7] << 16));
    } else if (slab < 20) {
      const int h = slab - 16;
      const int colbase = C_RQ + h * 128;
      float x1[32], x2[32];
#pragma unroll
      for (int i = 0; i < 32; ++i) {
        const bf16_t* p1 = zr + (size_t)i * ZS + colbase + lane;
        x1[i] = bf2f(p1[0]);
        x2[i] = bf2f(p1[64]);
      }
#pragma unroll
      for (int i = 0; i < 32; ++i) {
        bf16_t* p1 = zr + (size_t)i * ZS + colbase + lane;
        float2 cs = rope[(spos + i) * 64 + lane];
        p1[0] = f2bf(x1[i] * cs.x - x2[i] * cs.y);
        p1[64] = f2bf(x1[i] * cs.y + x2[i] * cs.x);
      }
    } else {
      const int h = slab - 20;
      const int colbase = C_RK + h * 128;
      const float lg2 = log2f(1.f - exp2f(-5.f - (float)h));
      float x1[32], x2[32];
#pragma unroll
      for (int i = 0; i < 32; ++i) {
        const bf16_t* p1 = zr + (size_t)i * ZS + colbase + lane;
        x1[i] = bf2f(p1[0]);
        x2[i] = bf2f(p1[64]);
      }
      unsigned u1[32], u2[32];
#pragma unroll
      for (int i = 0; i < 32; ++i) {
        bf16_t* p1 = zr + (size_t)i * ZS + colbase + lane;
        float2 cs = rope[(spos + i) * 64 + lane];
        float o1 = (x1[i] * cs.x - x2[i] * cs.y) * 0.08838834764831845f;
        float o2 = (x1[i] * cs.y + x2[i] * cs.x) * 0.08838834764831845f;
        p1[0] = f2bf(o1);
        p1[64] = f2bf(o2);
        float zeta = exp2f(lg2 * (float)(127 - ((spos + i) & 127)));
        u1[i] = f2bf(o1 * zeta);
        u2[i] = f2bf(o2 * zeta);
      }
      bf16_t* d1 = kzT + ((size_t)((b * 4 + h) * 128 + lane)) * TS + spos;
#pragma unroll
      for (int q4 = 0; q4 < 4; ++q4) {
        *(uint4*)(d1 + q4 * 8) = make_uint4(u1[q4 * 8 + 0] | (u1[q4 * 8 + 1] << 16), u1[q4 * 8 + 2] | (u1[q4 * 8 + 3] << 16),
                                            u1[q4 * 8 + 4] | (u1[q4 * 8 + 5] << 16), u1[q4 * 8 + 6] | (u1[q4 * 8 + 7] << 16));
        *(uint4*)(d1 + (size_t)64 * TS + q4 * 8) = make_uint4(u2[q4 * 8 + 0] | (u2[q4 * 8 + 1] << 16), u2[q4 * 8 + 2] | (u2[q4 * 8 + 3] << 16),
                                                              u2[q4 * 8 + 4] | (u2[q4 * 8 + 5] << 16), u2[q4 * 8 + 6] | (u2[q4 * 8 + 7] << 16));
      }
    }
  }
}

DI void phase4b(const Params& p, int layer) {
  const int tid_ = TID();
  const int lane = tid_ & 63;
  const int gw = (blockIdx.x * 256 + tid_) >> 6;
  const int nw = gridDim.x * 4;
  bf16_t* z = (bf16_t*)(p.ws + O_Z);
  const bf16_t* hid = (const bf16_t*)(p.ws + O_HID);
  bf16_t* kcmp = (bf16_t*)(p.ws + O_KCMP);
  bf16_t* vcmpT = (bf16_t*)(p.ws + O_VCMPT);
  const float* kn = p.nsa_k_norm + layer * 64;
  for (int item = gw; item < 8192; item += nw) {
    const int kv = item >> 12, row = item & 4095;
    const bf16_t* hrow = hid + ((size_t)kv * 4096 + row) * 256;
    const float* w2 = (kv ? p.cmp_w2_v : p.cmp_w2_k) + (size_t)layer * 256 * 64;
    float acc = 0.f;
    for (int k8 = 0; k8 < 32; ++k8) {
      uint4 hv = *(const uint4*)(hrow + k8 * 8);
      const float* wr = w2 + (size_t)(k8 * 8) * 64 + lane;
      acc += bflo(hv.x) * wr[0];
      acc += bfhi(hv.x) * wr[64];
      acc += bflo(hv.y) * wr[128];
      acc += bfhi(hv.y) * wr[192];
      acc += bflo(hv.z) * wr[256];
      acc += bfhi(hv.z) * wr[320];
      acc += bflo(hv.w) * wr[384];
      acc += bfhi(hv.w) * wr[448];
    }
    if (kv == 0) {
      float ss = wave_sum(acc * acc, lane);
      float rs = rsqrtf(ss * (1.f / 64.f) + 1e-6f);
      kcmp[(size_t)row * 64 + lane] = f2bf(acc * rs * kn[lane]);
    } else {
      const int bg = row >> 9, c = row & 511;
      vcmpT[((size_t)(bg * 64 + lane)) * 512 + c] = f2bf(acc);
    }
  }
  const int gtid = blockIdx.x * 256 + tid_;
  const int gthreads = gridDim.x * 256;
  for (int idx = gtid; idx < 65536; idx += gthreads) {
    const int d4 = idx & 31, e = (idx >> 5) & 127, h = (idx >> 12) & 3, b = idx >> 14;
    const float lg2 = log2f(1.f - exp2f(-5.f - (float)h));
    const float gch = exp2f(lg2 * 128.f);
    float r0 = 0.f, r1 = 0.f, r2 = 0.f, r3 = 0.f;
    bf16_t* ptr = z + ((size_t)(b * SEQ + e)) * ZS + C_RV + h * 128 + d4 * 4;
    for (int c0 = 0; c0 < 64; c0 += 16) {
      typedef __attribute__((ext_vector_type(2))) unsigned u32x2;
      u32x2 v[16];
#pragma unroll
      for (int i = 0; i < 16; ++i) v[i] = *(const u32x2*)(ptr + (size_t)(c0 + i) * 128 * ZS);
#pragma unroll
      for (int i = 0; i < 16; ++i) {
        u32x2 o;
        o.x = pack2(r0, r1);
        o.y = pack2(r2, r3);
        *(u32x2*)(ptr + (size_t)(c0 + i) * 128 * ZS) = o;
        r0 = gch * r0 + bflo(v[i].x);
        r1 = gch * r1 + bfhi(v[i].x);
        r2 = gch * r2 + bflo(v[i].y);
        r3 = gch * r3 + bfhi(v[i].y);
      }
    }
  }
}


DI void tile64_gload(int tid, u32x4& r0, u32x4& r1, const bf16_t* base, size_t stride) {
  {
    int idx = tid;
    int row = idx >> 3, ch = idx & 7;
    r0 = *(const u32x4*)(base + (size_t)row * stride + ch * 8);
  }
  {
    int idx = tid + 256;
    int row = idx >> 3, ch = idx & 7;
    r1 = *(const u32x4*)(base + (size_t)row * stride + ch * 8);
  }
}
DI void tile64_sstore(int tid, bf16_t* dst, const u32x4& r0, const u32x4& r1) {
  {
    int idx = tid;
    int row = idx >> 3, ch = idx & 7;
    *(u32x4*)(dst + row * 64 + ((ch ^ ((row >> 1) & 7)) << 3)) = r0;
  }
  {
    int idx = tid + 256;
    int row = idx >> 3, ch = idx & 7;
    *(u32x4*)(dst + row * 64 + ((ch ^ ((row >> 1) & 7)) << 3)) = r1;
  }
}

struct AttnSt { f32x4 O[2][4]; float m[2]; float l[2]; };

template <int MODE>
DI void attn_compute(const int lane, const bf16_t* Ks, const bf16_t* Vs, const bf16x8 (&qf)[2][2], AttnSt& st, const float (&invl)[2],
                     int lo, int hi, float (&impA)[4], float (&impE)[4]) {
  const int quad = lane >> 4, col = lane & 15;
  f32x4 S[4][2];
#pragma unroll
  for (int kt = 0; kt < 4; ++kt)
#pragma unroll
    for (int hh = 0; hh < 2; ++hh) S[kt][hh] = f32x4{0.f, 0.f, 0.f, 0.f};
#pragma unroll
  for (int ks = 0; ks < 2; ++ks) {
#pragma unroll
    for (int kt = 0; kt < 4; ++kt) {
      int row = kt * 16 + col;
      bf16x8 kf = *(const bf16x8*)(Ks + row * 64 + (((ks * 4 + quad) ^ ((row >> 1) & 7)) << 3));
#pragma unroll
      for (int hh = 0; hh < 2; ++hh) S[kt][hh] = mfma16(kf, qf[hh][ks], S[kt][hh]);
    }
  }
  bf16x8 pf[2][2];
  const bool full = (lo <= 0) && (hi >= 63);
  const bool none = (hi < 0) || (lo > 63) || (hi < lo);
  if (__all(full || none)) {
    constexpr float L2E = 1.4426950408889634f;
#pragma unroll
    for (int hh = 0; hh < 2; ++hh) {
      float mL;
      float il = 1.f;
      if (MODE != 1) {
        float mx = -1e30f;
#pragma unroll
        for (int kt = 0; kt < 4; ++kt)
#pragma unroll
          for (int j = 0; j < 4; ++j) mx = fmaxf(mx, S[kt][hh][j]);
        mx = full ? mx : -1e30f;
        mx = fmaxf(mx, shx(mx, 16, lane));
        mx = fmaxf(mx, shx(mx, 32, lane));
        const float m_new = fmaxf(st.m[hh], mx);
        const float alpha = __expf(st.m[hh] - m_new);
        st.m[hh] = m_new;
        st.l[hh] *= alpha;
        if (MODE == 2) {
#pragma unroll
          for (int dt = 0; dt < 4; ++dt) st.O[hh][dt] *= alpha;
        }
        mL = full ? m_new * L2E : 1e30f;
      } else {
        mL = full ? st.m[hh] * L2E : 1e30f;
        il = invl[hh];
      }
      float rs = 0.f;
#pragma unroll
      for (int kt = 0; kt < 4; ++kt) {
        float a = 0.f;
#pragma unroll
        for (int j = 0; j < 4; ++j) {
          float pv = __builtin_amdgcn_exp2f(fmaf(S[kt][hh][j], L2E, -mL));
          if (MODE == 1) pv *= il;
          S[kt][hh][j] = pv;
          a += pv;
        }
        rs += a;
        if (MODE == 1) {
          impA[kt] += a;
          impE[kt] += S[kt][hh][3];
        }
      }
      if (MODE != 1) st.l[hh] += rs;
      if (MODE != 0) {
#pragma unroll
        for (int c = 0; c < 2; ++c)
          pf[hh][c] = mk8(pack2(S[2 * c][hh][0], S[2 * c][hh][1]), pack2(S[2 * c][hh][2], S[2 * c][hh][3]),
                          pack2(S[2 * c + 1][hh][0], S[2 * c + 1][hh][1]), pack2(S[2 * c + 1][hh][2], S[2 * c + 1][hh][3]));
      }
    }
  } else {
#pragma unroll
  for (int hh = 0; hh < 2; ++hh) {
    float mx = -1e30f;
#pragma unroll
    for (int kt = 0; kt < 4; ++kt)
#pragma unroll
      for (int j = 0; j < 4; ++j) {
        int kl = kt * 16 + quad * 4 + j;
        bool v = (kl >= lo) && (kl <= hi);
        float sv = v ? S[kt][hh][j] : -1e30f;
        S[kt][hh][j] = sv;
        mx = fmaxf(mx, sv);
      }
    if (MODE != 1) {
      mx = fmaxf(mx, shx(mx, 16, lane));
      mx = fmaxf(mx, shx(mx, 32, lane));
      float m_new = fmaxf(st.m[hh], mx);
      float alpha = __expf(st.m[hh] - m_new);
      st.m[hh] = m_new;
      float rs = 0.f;
#pragma unroll
      for (int kt = 0; kt < 4; ++kt)
#pragma unroll
        for (int j = 0; j < 4; ++j) {
          float sv = S[kt][hh][j];
          float pv = (sv > -1e29f) ? __expf(sv - m_new) : 0.f;
          rs += pv;
          S[kt][hh][j] = pv;
        }
      st.l[hh] = st.l[hh] * alpha + rs;
      if (MODE == 2) {
#pragma unroll
        for (int dt = 0; dt < 4; ++dt) st.O[hh][dt] *= alpha;
      }
    } else {
      const float mh = st.m[hh], il = invl[hh];
#pragma unroll
      for (int kt = 0; kt < 4; ++kt) {
        float a = 0.f;
#pragma unroll
        for (int j = 0; j < 4; ++j) {
          float sv = S[kt][hh][j];
          float pv = (sv > -1e29f) ? __expf(sv - mh) * il : 0.f;
          S[kt][hh][j] = pv;
          a += pv;
        }
        impA[kt] += a;
        impE[kt] += S[kt][hh][3];
      }
    }
    if (MODE != 0) {
#pragma unroll
      for (int c = 0; c < 2; ++c)
        pf[hh][c] = mk8(pack2(S[2 * c][hh][0], S[2 * c][hh][1]), pack2(S[2 * c][hh][2], S[2 * c][hh][3]),
                        pack2(S[2 * c + 1][hh][0], S[2 * c + 1][hh][1]), pack2(S[2 * c + 1][hh][2], S[2 * c + 1][hh][3]));
    }
  }
  }
  if (MODE != 0) {
#pragma unroll
    for (int dt = 0; dt < 4; ++dt) {
      const int row = dt * 16 + col;
      const int sw = (row >> 1) & 7;
#pragma unroll
      for (int c = 0; c < 2; ++c) {
        uint2 a = *(const uint2*)(Vs + row * 64 + (((4 * c + (quad >> 1)) ^ sw) << 3) + (quad & 1) * 4);
        uint2 b = *(const uint2*)(Vs + row * 64 + (((4 * c + 2 + (quad >> 1)) ^ sw) << 3) + (quad & 1) * 4);
        bf16x8 vf = mk8(a.x, a.y, b.x, b.y);
#pragma unroll
        for (int hh = 0; hh < 2; ++hh) st.O[hh][dt] = mfma16(vf, pf[hh][c], st.O[hh][dt]);
      }
    }
  }
}

DI void st_reset(AttnSt& st) {
#pragma unroll
  for (int h = 0; h < 2; ++h) {
    st.m[h] = -1e30f;
    st.l[h] = 0.f;
#pragma unroll
    for (int dt = 0; dt < 4; ++dt) st.O[h][dt] = f32x4{0.f, 0.f, 0.f, 0.f};
  }
}

template <bool FIRST>
DI void nsa_flush(const int quad, bf16_t* optr, const AttnSt& st, const float (&sc)[2]) {
#pragma unroll
  for (int h = 0; h < 2; ++h)
#pragma unroll
    for (int dt = 0; dt < 4; ++dt) {
      uint2* q = (uint2*)(optr + h * 64 + dt * 16 + quad * 4);
      f32x4 o = st.O[h][dt] * sc[h];
      if (!FIRST) {
        uint2 pv = *q;
        o[0] += bflo(pv.x); o[1] += bfhi(pv.x); o[2] += bflo(pv.y); o[3] += bfhi(pv.y);
      }
      uint2 u;
      u.x = pack2(o[0], o[1]);
      u.y = pack2(o[2], o[3]);
      *q = u;
    }
}

DI void nsa_tile(const Params& p, int b, int g, int tile, bf16_t* lds) {
  const int tid = TID(), lane = tid & 63, w = tid >> 6, quad = lane >> 4, col = lane & 15;
  const int cur = tile;
  const int tok = tile * 64 + w * 16 + col;
  bf16_t* z = (bf16_t*)(p.ws + O_Z);
  const bf16_t* kcmp = (const bf16_t*)(p.ws + O_KCMP) + (size_t)(b * 2 + g) * 512 * 64;
  const bf16_t* vcmpT = (const bf16_t*)(p.ws + O_VCMPT) + (size_t)(b * 2 + g) * 64 * 512;
  const bf16_t* vsT = (const bf16_t*)(p.ws + O_VST) + (size_t)(b * 2 + g) * 64 * TS;
  const bf16_t* vwT = (const bf16_t*)(p.ws + O_VWT) + (size_t)(b * 2 + g) * 64 * TS;
  const bf16_t* zb = z + (size_t)b * SEQ * ZS;
  const bf16_t* ztok = z + ((size_t)(b * SEQ + tok)) * ZS;
  bf16_t* otok = (bf16_t*)(p.ws + O_ONSA) + ((size_t)(b * SEQ + tok)) * 512 + g * 256;
  bf16_t* Ks = lds;
  bf16_t* Vs = lds + 4096;
  float* impl = (float*)(lds + 8192);

  AttnSt st;
  float invl[2] = {0.f, 0.f};
  float dA[4] = {0.f, 0.f, 0.f, 0.f}, dE[4] = {0.f, 0.f, 0.f, 0.f};
  u32x4 rk0, rk1, rv0, rv1;
  bf16x8 qf[2][2];

  const int ncs = (cur < 16) ? 1 : (cur >> 4) + 1;
  const int chi = (tok >= 31) ? ((tok - 31) >> 4) : -1;

  for (int hp = 0; hp < 2; ++hp) {
#pragma unroll
    for (int hh = 0; hh < 2; ++hh)
#pragma unroll
      for (int ks = 0; ks < 2; ++ks) qf[hh][ks] = *(const bf16x8*)(ztok + C_Q + g * 256 + (hp * 2 + hh) * 64 + ks * 32 + quad * 8);
    st_reset(st);
    tile64_gload(tid, rk0, rk1, kcmp, 64);
    for (int s = 0; s < ncs; ++s) {
      __syncthreads();
      tile64_sstore(tid, Ks, rk0, rk1);
      __syncthreads();
      if (s + 1 < ncs) tile64_gload(tid, rk0, rk1, kcmp + (size_t)(s + 1) * 4096, 64);
      attn_compute<0>(lane, Ks, Vs, qf, st, invl, 0, chi - s * 64, dA, dE);
    }
#pragma unroll
    for (int h = 0; h < 2; ++h) {
      float l = st.l[h];
      l += shx(l, 16, lane);
      l += shx(l, 32, lane);
      invl[h] = (l > 0.f) ? 1.f / l : 0.f;
    }
    {
      float carry = 0.f;
      tile64_gload(tid, rk0, rk1, kcmp, 64);
      tile64_gload(tid, rv0, rv1, vcmpT, 512);
      for (int s = 0; s < ncs; ++s) {
        float iA[4] = {0.f, 0.f, 0.f, 0.f}, iE[4] = {0.f, 0.f, 0.f, 0.f};
        __syncthreads();
        tile64_sstore(tid, Ks, rk0, rk1);
        tile64_sstore(tid, Vs, rv0, rv1);
        __syncthreads();
        if (s + 1 < ncs) {
          tile64_gload(tid, rk0, rk1, kcmp + (size_t)(s + 1) * 4096, 64);
          tile64_gload(tid, rv0, rv1, vcmpT + (s + 1) * 64, 512);
        }
        attn_compute<1>(lane, Ks, Vs, qf, st, invl, 0, chi - s * 64, iA, iE);
#pragma unroll
        for (int kt = 0; kt < 4; ++kt) {
          float recv = shfrom(iE[kt], (lane + 48) & 63);
          float val = iA[kt] + ((quad == 0) ? carry : recv);
          carry = recv;
          float* slot = impl + (s * 4 + kt) * 256 + tid;
          if (hp == 0) *slot = val; else *slot += val;
        }
      }
    }
    {
      float sc[2];
#pragma unroll
      for (int h = 0; h < 2; ++h) sc[h] = sigmoidf(bf2f(ztok[C_GT + 0 * 8 + g * 4 + hp * 2 + h]));
      nsa_flush<true>(quad, otok + hp * 128, st, sc);
    }
  }

  uint32_t sw0, sw1, sw2, sw3;
  {
    uint32_t key[32];
#pragma unroll
    for (int i = 0; i < 32; ++i) {
      int j = i * 4 + quad;
      float sc = (i < ncs * 4) ? impl[i * 256 + tid] : 0.f;
      if (j == 0 || j == cur || j == cur - 1) sc = 1e4f;
      uint32_t k = (__float_as_uint(sc) & ~127u) | (uint32_t)(127 - j);
      key[i] = (j > cur) ? 0u : k;
    }
    uint32_t prev = 0xFFFFFFFFu;
    for (int r = 0; r < 16; ++r) {
      uint32_t mx = 0u;
#pragma unroll
      for (int i = 0; i < 32; ++i) {
        uint32_t k = key[i];
        k = (k < prev) ? k : 0u;
        mx = (k > mx) ? k : mx;
      }
      uint32_t o = shxu(mx, 16, lane);
      mx = (o > mx) ? o : mx;
      o = shxu(mx, 32, lane);
      mx = (o > mx) ? o : mx;
      prev = mx;
    }
    sw0 = 0u; sw1 = 0u; sw2 = 0u; sw3 = 0u;
#pragma unroll
    for (int i = 0; i < 32; ++i) {
      bool sel = (key[i] != 0u) && (key[i] >= prev);
      uint32_t bit = sel ? (1u << ((i & 7) * 4 + quad)) : 0u;
      if ((i >> 3) == 0) sw0 |= bit;
      else if ((i >> 3) == 1) sw1 |= bit;
      else if ((i >> 3) == 2) sw2 |= bit;
      else sw3 |= bit;
    }
    sw0 |= shxu(sw0, 16, lane); sw0 |= shxu(sw0, 32, lane);
    sw1 |= shxu(sw1, 16, lane); sw1 |= shxu(sw1, 32, lane);
    sw2 |= shxu(sw2, 16, lane); sw2 |= shxu(sw2, 32, lane);
    sw3 |= shxu(sw3, 16, lane); sw3 |= shxu(sw3, 32, lane);
  }

  for (int hp = 0; hp < 2; ++hp) {
#pragma unroll
    for (int hh = 0; hh < 2; ++hh)
#pragma unroll
      for (int ks = 0; ks < 2; ++ks) qf[hh][ks] = *(const bf16x8*)(ztok + C_Q + g * 256 + (hp * 2 + hh) * 64 + ks * 32 + quad * 8);
    st_reset(st);
    {
      const bf16_t* kb = zb + C_KS + g * 64;
      tile64_gload(tid, rk0, rk1, kb, ZS);
      tile64_gload(tid, rv0, rv1, vsT, TS);
      for (int s = 0; s <= cur; ++s) {
        __syncthreads();
        tile64_sstore(tid, Ks, rk0, rk1);
        tile64_sstore(tid, Vs, rv0, rv1);
        __syncthreads();
        if (s < cur) {
          tile64_gload(tid, rk0, rk1, kb + (size_t)(s + 1) * 64 * ZS, ZS);
          tile64_gload(tid, rv0, rv1, vsT + (s + 1) * 64, TS);
        }
        uint32_t wsel = (s < 32) ? sw0 : (s < 64) ? sw1 : (s < 96) ? sw2 : sw3;
        bool sel = (wsel >> (s & 31)) & 1u;
        int hi = sel ? (tok - s * 64) : -1;
        if (__any(hi >= 0)) attn_compute<2>(lane, Ks, Vs, qf, st, invl, 0, hi, dA, dE);
      }
    }
    {
      float sc[2];
#pragma unroll
      for (int h = 0; h < 2; ++h) {
        float l = st.l[h];
        l += shx(l, 16, lane);
        l += shx(l, 32, lane);
        sc[h] = (l > 0.f) ? sigmoidf(bf2f(ztok[C_GT + 1 * 8 + g * 4 + hp * 2 + h])) / l : 0.f;
      }
      nsa_flush<false>(quad, otok + hp * 128, st, sc);
    }
    st_reset(st);
    {
      const bf16_t* kb = zb + C_KW + g * 64;
      const int s0 = (cur >= 8) ? cur - 8 : 0;
      tile64_gload(tid, rk0, rk1, kb + (size_t)s0 * 64 * ZS, ZS);
      tile64_gload(tid, rv0, rv1, vwT + s0 * 64, TS);
      for (int s = s0; s <= cur; ++s) {
        __syncthreads();
        tile64_sstore(tid, Ks, rk0, rk1);
        tile64_sstore(tid, Vs, rv0, rv1);
        __syncthreads();
        if (s < cur) {
          tile64_gload(tid, rk0, rk1, kb + (size_t)(s + 1) * 64 * ZS, ZS);
          tile64_gload(tid, rv0, rv1, vwT + (s + 1) * 64, TS);
        }
        attn_compute<2>(lane, Ks, Vs, qf, st, invl, tok - 511 - s * 64, tok - s * 64, dA, dE);
      }
    }
    {
      float sc[2];
#pragma unroll
      for (int h = 0; h < 2; ++h) {
        float l = st.l[h];
        l += shx(l, 16, lane);
        l += shx(l, 32, lane);
        sc[h] = (l > 0.f) ? sigmoidf(bf2f(ztok[C_GT + 2 * 8 + g * 4 + hp * 2 + h])) / l : 0.f;
      }
      nsa_flush<false>(quad, otok + hp * 128, st, sc);
    }
  }
}

DI void load128(int tid, bf16_t* lds, const bf16_t* base, size_t stride) {
  u32x4 r[8];
#pragma unroll
  for (int i = 0; i < 8; ++i) {
    int idx = tid + 256 * i;
    int row = idx >> 4, ch = idx & 15;
    r[i] = *(const u32x4*)(base + (size_t)row * stride + ch * 8);
  }
#pragma unroll
  for (int i = 0; i < 8; ++i) {
    int idx = tid + 256 * i;
    int row = idx >> 4, ch = idx & 15;
    *(u32x4*)(lds + row * 128 + ((ch ^ (row & 15)) << 3)) = r[i];
  }
}

DI void ret_tile(const Params& p, int b, int h, int c, bf16_t* lds) {
  const int tid = TID(), lane = tid & 63, w = tid >> 6, quad = lane >> 4, col = lane & 15;
  const float lg2 = log2f(1.f - exp2f(-5.f - (float)h));
  bf16_t* z = (bf16_t*)(p.ws + O_Z);
  const bf16_t* rvT = (const bf16_t*)(p.ws + O_RVT);
  bf16_t* zc = z + ((size_t)(b * SEQ + c * 128)) * ZS;
  bf16x8 qf[2][4];
#pragma unroll
  for (int nt = 0; nt < 2; ++nt)
#pragma unroll
    for (int ks = 0; ks < 4; ++ks) {
      int n = 32 * w + nt * 16 + col;
      qf[nt][ks] = *(const bf16x8*)(zc + (size_t)n * ZS + C_RQ + h * 128 + ks * 32 + quad * 8);
    }
  f32x4 acc[8][2];
#pragma unroll
  for (int et = 0; et < 8; ++et)
#pragma unroll
    for (int nt = 0; nt < 2; ++nt) acc[et][nt] = f32x4{0.f, 0.f, 0.f, 0.f};
  __syncthreads();
  load128(tid, lds, zc + C_RV + h * 128, ZS);
  __syncthreads();
#pragma unroll
  for (int ks = 0; ks < 4; ++ks)
#pragma unroll
    for (int et = 0; et < 8; ++et) {
      int row = et * 16 + col;
      bf16x8 af = *(const bf16x8*)(lds + row * 128 + (((ks * 4 + quad) ^ (row & 15)) << 3));
#pragma unroll
      for (int nt = 0; nt < 2; ++nt) acc[et][nt] = mfma16(af, qf[nt][ks], acc[et][nt]);
    }
#pragma unroll
  for (int nt = 0; nt < 2; ++nt) {
    int n = 32 * w + nt * 16 + col;
    float xi = exp2f(lg2 * (float)(n + 1));
#pragma unroll
    for (int et = 0; et < 8; ++et) acc[et][nt] *= xi;
  }
  __syncthreads();
  load128(tid, lds, zc + C_RK + h * 128, ZS);
  __syncthreads();
  bf16x8 pf[2][4];
#pragma unroll
  for (int nt = 0; nt < 2; ++nt) {
    f32x4 s[8];
#pragma unroll
    for (int mt = 0; mt < 8; ++mt) s[mt] = f32x4{0.f, 0.f, 0.f, 0.f};
#pragma unroll
    for (int ks = 0; ks < 4; ++ks)
#pragma unroll
      for (int mt = 0; mt < 8; ++mt) {
        if (mt <= 2 * w + 1) {
          int row = mt * 16 + col;
          bf16x8 af = *(const bf16x8*)(lds + row * 128 + (((ks * 4 + quad) ^ (row & 15)) << 3));
          s[mt] = mfma16(af, qf[nt][ks], s[mt]);
        }
      }
    const int n = 32 * w + nt * 16 + col;
#pragma unroll
    for (int c2 = 0; c2 < 4; ++c2) {
      float v[8];
#pragma unroll
      for (int i = 0; i < 8; ++i) {
        const int mt = 2 * c2 + (i >> 2), j = i & 3;
        const int m = mt * 16 + quad * 4 + j;
        v[i] = (n >= m) ? s[mt][j] * exp2f(lg2 * (float)(n - m)) : 0.f;
      }
      pf[nt][c2] = mk8(pack2(v[0], v[1]), pack2(v[2], v[3]), pack2(v[4], v[5]), pack2(v[6], v[7]));
    }
  }
  __syncthreads();
  load128(tid, lds, rvT + ((size_t)((b * 4 + h) * 128)) * TS + c * 128, TS);
  __syncthreads();
#pragma unroll
  for (int c2 = 0; c2 < 4; ++c2) {
    if (2 * c2 <= 2 * w + 1) {
#pragma unroll
      for (int et = 0; et < 8; ++et) {
        int row = et * 16 + col;
        int sw = row & 15;
        uint2 a = *(const uint2*)(lds + row * 128 + (((4 * c2 + (quad >> 1)) ^ sw) << 3) + (quad & 1) * 4);
        uint2 bb = *(const uint2*)(lds + row * 128 + (((4 * c2 + 2 + (quad >> 1)) ^ sw) << 3) + (quad & 1) * 4);
        bf16x8 vf = mk8(a.x, a.y, bb.x, bb.y);
#pragma unroll
        for (int nt = 0; nt < 2; ++nt) acc[et][nt] = mfma16(vf, pf[nt][c2], acc[et][nt]);
      }
    }
  }
#pragma unroll
  for (int nt = 0; nt < 2; ++nt) {
    float ss = 0.f;
#pragma unroll
    for (int et = 0; et < 8; ++et)
#pragma unroll
      for (int j = 0; j < 4; ++j) ss += acc[et][nt][j] * acc[et][nt][j];
    ss += shx(ss, 16, lane);
    ss += shx(ss, 32, lane);
    const float rs = rsqrtf(ss * (1.f / 128.f) + 1e-6f);
    const int n = 32 * w + nt * 16 + col;
    bf16_t* zr = zc + (size_t)n * ZS;
#pragma unroll
    for (int et = 0; et < 8; ++et) {
      const int e0 = et * 16 + quad * 4;
      uint2 gv = *(const uint2*)(zr + C_RG + h * 128 + e0);
      float g0 = bflo(gv.x), g1 = bfhi(gv.x), g2 = bflo(gv.y), g3 = bfhi(gv.y);
      uint2 o;
      o.x = pack2(acc[et][nt][0] * rs * g0 * sigmoidf(g0), acc[et][nt][1] * rs * g1 * sigmoidf(g1));
      o.y = pack2(acc[et][nt][2] * rs * g2 * sigmoidf(g2), acc[et][nt][3] * rs * g3 * sigmoidf(g3));
      *(uint2*)(zr + C_RQ + h * 128 + e0) = o;
    }
  }
}

#define GEMM_TILE_LOOP(NT)                                                             \
  for (int q_ = (int)(blockIdx.x >> 3), per_ = (int)(gridDim.x >> 3), xcd_ = (int)(blockIdx.x & 7), mt = 0, ntile = 0; \
       q_ < 32 * (NT) && ((mt = (((xcd_ + 8 * (q_ / (8 * (NT)))) << 3) + ((q_ % (8 * (NT))) & 7)), ntile = ((q_ % (8 * (NT))) >> 3)), true); \
       q_ += per_)

#define XB_TMO      128
#define XB_XCNT(j)  (256  + 64 * (j))
#define XB_XSUB(j)  (1280 + 64 * (j))
#define XB_XGEN(j)  (2304 + 64 * (j))
#define XB_TOP      3328
#define XB_TOPGEN   3392
#define XB_SPIN_CAP (1u << 20)
DI unsigned xb_ld(unsigned* p) { return __hip_atomic_load(p, __ATOMIC_RELAXED, __HIP_MEMORY_SCOPE_AGENT); }
DI unsigned xb_add(unsigned* p, unsigned v) { return __hip_atomic_fetch_add(p, v, __ATOMIC_RELAXED, __HIP_MEMORY_SCOPE_AGENT); }
DI unsigned xb_xcc_id() { return (unsigned)__builtin_amdgcn_s_getreg((3 << 11) | 20) & 0xFu; }
#define XB_SPIN(cond, bar) do { unsigned _sp = 0; while (cond) { __builtin_amdgcn_s_sleep(1); \
    if ((++_sp & 255u) == 0u) { if (xb_ld(&(bar)[XB_TMO])) break; if (_sp > XB_SPIN_CAP) { atomicAdd(&(bar)[XB_TMO], 1u); break; } } } } while (0)

DI void xcd_barrier(unsigned* bar, const unsigned x, const unsigned nloc, const unsigned nx) {
  asm volatile("s_waitcnt vmcnt(0)" ::: "memory");
  __syncthreads();
  if (TID() == 0) {
    __builtin_amdgcn_s_waitcnt(0);
    const unsigned old = xb_add(&bar[XB_XSUB(x)], 1u);
    const unsigned gen = old / nloc;
    if (old + 1u == (gen + 1u) * nloc) {
      __builtin_amdgcn_fence(__ATOMIC_RELEASE, "agent");
      asm volatile("s_waitcnt vmcnt(0)" ::: "memory");
      const unsigned og = xb_add(&bar[XB_TOP], 1u);
      const unsigned tg = og / nx;
      if (og + 1u == (tg + 1u) * nx) xb_add(&bar[XB_TOPGEN], 1u);
      else XB_SPIN(xb_ld(&bar[XB_TOPGEN]) == tg, bar);
      __builtin_amdgcn_fence(__ATOMIC_ACQUIRE, "agent");
      xb_add(&bar[XB_XGEN(x)], 1u);
      asm volatile("s_waitcnt vmcnt(0)" ::: "memory");
    } else {
      XB_SPIN(xb_ld(&bar[XB_XGEN(x)]) == gen, bar);
      __builtin_amdgcn_fence(__ATOMIC_ACQUIRE, "agent");
      asm volatile("s_waitcnt vmcnt(0)" ::: "memory");
    }
  }
  __syncthreads();
}

__global__ void __launch_bounds__(256, 2) mega(Params p) {
  __shared__ __attribute__((aligned(16))) bf16_t lds[32768];
  cg::grid_group grid = cg::this_grid();
  const int nb = gridDim.x;
  bf16_t* wt = (bf16_t*)(p.ws + O_WT);
  bf16_t* z = (bf16_t*)(p.ws + O_Z);
  bf16_t* hbuf = (bf16_t*)(p.ws + O_VST);
  bf16_t* ubuf = z;
  bf16_t* p16 = z;
  bf16_t* hid = (bf16_t*)(p.ws + O_HID);
  const float* bias = (const float*)(p.ws + O_BIAS);

  unsigned* bar = (unsigned*)(p.ws + O_BAR);
  const unsigned xb_x = xb_xcc_id();
  if (TID() == 0) (void)xb_add(&bar[XB_XCNT(xb_x)], 1u);
  unsigned xb_nloc = 1u, xb_nx = 1u;

  for (int layer = 0; layer < 2; ++layer) {
    const bf16_t* wl = wt;
    const float* xin = (layer == 0) ? p.x : p.out;

    phase0(p, layer);
    norm_phase(xin, p.norm_mix + layer * DM, hbuf);
    if (layer == 0) {
      grid.sync();
      unsigned mine = 0u, cnt = 0u;
#pragma unroll
      for (unsigned j = 0; j < 16; ++j) {
        const unsigned c = xb_ld(&bar[XB_XCNT(j)]);
        cnt += (c > 0u) ? 1u : 0u;
        mine = (j == xb_x) ? c : mine;
      }
      xb_nloc = __builtin_amdgcn_readfirstlane(mine > 0u ? mine : 1u);
      xb_nx = __builtin_amdgcn_readfirstlane(cnt > 0u ? cnt : 1u);
    } else {
      xcd_barrier(bar, xb_x, xb_nloc, xb_nx);
    }

    GEMM_TILE_LOOP(43) {
      const int m0 = mt * 128, n0 = ntile * 128;
      f32x4 acc[4][4];
      zero_acc(acc);
      gemm_accum(acc, RowPtr{hbuf + (size_t)m0 * DM, DM}, RowPtr{wl + W_IN + (size_t)n0 * 1024, 1024}, 16, lds);
      gemm_epi(acc, m0, n0, [&](int m, int n, f32x4& a) {
        if (n < ZS) {
          uint2 u;
          u.x = pack2(a[0], a[1]);
          u.y = pack2(a[2], a[3]);
          *(uint2*)(z + (size_t)m * ZS + n) = u;
        }
      });
    }
    xcd_barrier(bar, xb_x, xb_nloc, xb_nx);

    post_z(p, layer);
    xcd_barrier(bar, xb_x, xb_nloc, xb_nx);

    for (int t = (blockIdx.x < 128) ? (int)blockIdx.x : (int)blockIdx.x; t < 128 + 1024; t += (t < 128) ? 2048 : (nb - 128)) {
      f32x4 acc[4][4];
      zero_acc(acc);
      if (t < 128) {
        const int kv = t >> 6, mt = (t >> 1) & 31, ntile = t & 1;
        const int m0 = mt * 128, n0 = ntile * 128;
        const bf16_t* kvd = (const bf16_t*)(p.ws + O_KVD) + (size_t)kv * 8 * SEQ * 64;
        auto ap = [&](int r, int kb) -> const bf16_t* {
          int row = m0 + r;
          int bg = row >> 9, c = row & 511;
          int tk = 16 * c + kb;
          tk = tk > (SEQ - 1) ? (SEQ - 1) : tk;
          return kvd + ((size_t)(bg * SEQ + tk)) * 64;
        };
        gemm_accum(acc, ap, RowPtr{wl + (kv ? W_C1V : W_C1K) + (size_t)n0 * 2048, 2048}, 32, lds);
        const float* bs = bias + kv * 256;
        bf16_t* hd = hid + (size_t)kv * 4096 * 256;
        gemm_epi(acc, m0, n0, [&](int m, int n, f32x4& a) {
          float o[4];
#pragma unroll
          for (int j = 0; j < 4; ++j) {
            float xv = a[j] + bs[n + j];
            float y = 0.7978845608028654f * (xv + 0.044715f * xv * xv * xv);
            float th = 1.f - 2.f / (__expf(2.f * y) + 1.f);
            o[j] = 0.5f * xv * (1.f + th);
          }
          uint2 u;
          u.x = pack2(o[0], o[1]);
          u.y = pack2(o[2], o[3]);
          *(uint2*)(hd + (size_t)m * 256 + n) = u;
        });
      } else {
        const int idx = t - 128;
        const int c = idx & 63, bh = idx >> 6;
        const bf16_t* rvT = (const bf16_t*)(p.ws + O_RVT) + ((size_t)bh * 128) * TS + c * 128;
        const bf16_t* kzT = (const bf16_t*)(p.ws + O_KZT) + ((size_t)bh * 128) * TS + c * 128;
        gemm_accum(acc, RowPtr{rvT, TS}, RowPtr{kzT, TS}, 2, lds);
        bf16_t* dst = z + ((size_t)((bh >> 2) * SEQ + c * 128)) * ZS + C_RV + (bh & 3) * 128;
        gemm_epi(acc, 0, 0, [&](int m, int n, f32x4& a) {
          uint2 u;
          u.x = pack2(a[0], a[1]);
          u.y = pack2(a[2], a[3]);
          *(uint2*)(dst + (size_t)m * ZS + n) = u;
        });
      }
    }
    xcd_barrier(bar, xb_x, xb_nloc, xb_nx);

    phase4b(p, layer);
    xcd_barrier(bar, xb_x, xb_nloc, xb_nx);

    for (int t = blockIdx.x; t < 2048; t += nb) {
      if (t < 1024) {
        const int tile = (t < 512) ? 127 - (t >> 3) : ((t - 512) >> 3), bg = t & 7;
        nsa_tile(p, bg >> 1, bg & 1, tile, lds);
      } else {
        const int idx = t - 1024;
        ret_tile(p, idx >> 8, (idx >> 6) & 3, idx & 63, lds);
      }
    }
    xcd_barrier(bar, xb_x, xb_nloc, xb_nx);

    GEMM_TILE_LOOP(8) {
      const int m0 = mt * 128, n0 = ntile * 128;
      f32x4 acc[4][4];
      zero_acc(acc);
      gemm_accum(acc, RowPtr{(const bf16_t*)(p.ws + O_ONSA) + (size_t)m0 * 512, 512}, RowPtr{wl + W_UPA + (size_t)n0 * 512, 512}, 8, lds);
      gemm_epi(acc, m0, n0, [&](int m, int n, f32x4& a) {
        uint2 ua = *(const uint2*)(z + (size_t)m * ZS + C_MA + n);
        uint2 ub = *(const uint2*)(z + (size_t)m * ZS + C_MB + n);
        a[0] *= sigmoidf(bflo(ua.x)) / sigmoidf(bflo(ub.x));
        a[1] *= sigmoidf(bfhi(ua.x)) / sigmoidf(bfhi(ub.x));
        a[2] *= sigmoidf(bflo(ua.y)) / sigmoidf(bflo(ub.y));
        a[3] *= sigmoidf(bfhi(ua.y)) / sigmoidf(bfhi(ub.y));
      });
      gemm_accum(acc, RowPtr{z + (size_t)m0 * ZS + C_RQ, ZS}, RowPtr{wl + W_UPR + (size_t)n0 * 512, 512}, 8, lds);
      gemm_epi(acc, m0, n0, [&](int m, int n, f32x4& a) {
        uint2 ub = *(const uint2*)(z + (size_t)m * ZS + C_MB + n);
        uint2 u;
        u.x = pack2(a[0] * sigmoidf(bflo(ub.x)), a[1] * sigmoidf(bfhi(ub.x)));
        u.y = pack2(a[2] * sigmoidf(bflo(ub.y)), a[3] * sigmoidf(bfhi(ub.y)));
        *(uint2*)(z + (size_t)m * ZS + C_RK + n) = u;
      });
    }
    xcd_barrier(bar, xb_x, xb_nloc, xb_nx);

    GEMM_TILE_LOOP(8) {
      const int m0 = mt * 128, n0 = ntile * 128;
      f32x4 acc[4][4];
      zero_acc(acc);
      gemm_accum(acc, RowPtr{z + (size_t)m0 * ZS + C_RK, ZS}, RowPtr{wl + W_OUT + (size_t)n0 * 1024, 1024}, 16, lds);
      gemm_epi(acc, m0, n0, [&](int m, int n, f32x4& a) {
        float4 xv = *(const float4*)(xin + (size_t)m * DM + n);
        *(float4*)(p.out + (size_t)m * DM + n) = make_float4(xv.x + a[0], xv.y + a[1], xv.z + a[2], xv.w + a[3]);
      });
    }
    xcd_barrier(bar, xb_x, xb_nloc, xb_nx);

    norm_phase(p.out, p.norm_mlp + layer * DM, hbuf);
    xcd_barrier(bar, xb_x, xb_nloc, xb_nx);

    GEMM_TILE_LOOP(32) {
      const int m0 = mt * 128, n0 = ntile * 128;
      f32x4 acc[4][4];
      zero_acc(acc);
      gemm_accum(acc, RowPtr{hbuf + (size_t)m0 * DM, DM}, RowPtr{wl + W_FF1 + (size_t)n0 * 1024, 1024}, 16, lds);
      gemm_epi(acc, m0, n0, [&](int m, int n, f32x4& a) {
        float r0 = fmaxf(a[0], 0.f), r1 = fmaxf(a[1], 0.f), r2 = fmaxf(a[2], 0.f), r3 = fmaxf(a[3], 0.f);
        uint2 u;
        u.x = pack2(r0 * r0, r1 * r1);
        u.y = pack2(r2 * r2, r3 * r3);
        *(uint2*)(ubuf + (size_t)m * 4096 + n) = u;
      });
    }
    xcd_barrier(bar, xb_x, xb_nloc, xb_nx);

    GEMM_TILE_LOOP(8) {
      const int m0 = mt * 128, n0 = ntile * 128;
      f32x4 acc[4][4];
      zero_acc(acc);
      gemm_accum(acc, RowPtr{ubuf + (size_t)m0 * 4096, 4096}, RowPtr{wl + W_FF2 + (size_t)n0 * 4096, 4096}, 64, lds);
      gemm_epi(acc, m0, n0, [&](int m, int n, f32x4& a) {
        float4* o = (float4*)(p.out + (size_t)m * DM + n);
        float4 xv = *o;
        *o = make_float4(xv.x + a[0], xv.y + a[1], xv.z + a[2], xv.w + a[3]);
      });
    }
    xcd_barrier(bar, xb_x, xb_nloc, xb_nx);

    norm_phase(p.out, p.norm_ple + layer * DM, hbuf);
    {
      const float* pl = p.p + (size_t)layer * T_TOK * 256;
      const int gtid = blockIdx.x * 256 + TID();
      const int gthreads = nb * 256;
      for (int i = gtid; i < T_TOK * 32; i += gthreads) {
        float4 a = ((const float4*)pl)[2 * i], b2 = ((const float4*)pl)[2 * i + 1];
        ((uint4*)p16)[i] = make_uint4(pack2(a.x, a.y), pack2(a.z, a.w), pack2(b2.x, b2.y), pack2(b2.z, b2.w));
      }
    }
    xcd_barrier(bar, xb_x, xb_nloc, xb_nx);

    GEMM_TILE_LOOP(8) {
      const int m0 = mt * 128, n0 = ntile * 128;
      f32x4 acc[4][4];
      zero_acc(acc);
      gemm_accum(acc, RowPtr{p16 + (size_t)m0 * 256, 256}, RowPtr{wl + W_PLE + (size_t)n0 * 256, 256}, 4, lds);
      bf16_t* ppb = z + (size_t)T_TOK * 256;
      gemm_epi(acc, m0, n0, [&](int m, int n, f32x4& a) {
        uint2 u;
        u.x = pack2(a[0], a[1]);
        u.y = pack2(a[2], a[3]);
        *(uint2*)(ppb + (size_t)m * DM + n) = u;
      });
      zero_acc(acc);
      gemm_accum(acc, RowPtr{hbuf + (size_t)m0 * DM, DM}, RowPtr{wl + W_PG + (size_t)n0 * 1024, 1024}, 16, lds);
      gemm_epi(acc, m0, n0, [&](int m, int n, f32x4& a) {
        uint2 pv = *(const uint2*)(ppb + (size_t)m * DM + n);
        float4* o = (float4*)(p.out + (size_t)m * DM + n);
        float4 xv = *o;
        *o = make_float4(xv.x + sigmoidf(a[0]) * bflo(pv.x), xv.y + sigmoidf(a[1]) * bfhi(pv.x),
                         xv.z + sigmoidf(a[2]) * bflo(pv.y), xv.w + sigmoidf(a[3]) * bfhi(pv.y));
      });
    }
    xcd_barrier(bar, xb_x, xb_nloc, xb_nx);
  }
}

extern "C" void kernel_launch(void* const* d_in, const int* in_sizes, int n_in,
                              void* d_out, int out_size, void* d_ws, size_t ws_size,
                              hipStream_t stream) {
  static int grid_blocks = 0;
  if (!grid_blocks) {
    int dev = 0, cus = 0, per_cu = 0;
    hipGetDevice(&dev);
    hipDeviceGetAttribute(&cus, hipDeviceAttributeMultiprocessorCount, dev);
    hipOccupancyMaxActiveBlocksPerMultiprocessor(&per_cu, mega, 256, 0);
    if (per_cu > 2) per_cu = 2;
    if (per_cu < 1) per_cu = 1;
    grid_blocks = cus * per_cu;
  }
  if (ws_size < WS_NEED) {
    fprintf(stderr, "workspace too small: %zu < %llu\n", ws_size, (unsigned long long)WS_NEED);
    return;
  }
  Params p{};
  p.x = (const float*)d_in[0]; p.p = (const float*)d_in[1]; p.norm_mix = (const float*)d_in[2]; p.w_in = (const float*)d_in[3];
  p.nsa_q_norm = (const float*)d_in[4]; p.nsa_k_norm = (const float*)d_in[5]; p.cmp_pos_k = (const float*)d_in[6];
  p.cmp_pos_v = (const float*)d_in[7]; p.cmp_w1_k = (const float*)d_in[8]; p.cmp_w2_k = (const float*)d_in[9];
  p.cmp_w1_v = (const float*)d_in[10]; p.cmp_w2_v = (const float*)d_in[11]; p.w_up_nsa = (const float*)d_in[12];
  p.w_up_ret = (const float*)d_in[13]; p.w_out = (const float*)d_in[14]; p.norm_mlp = (const float*)d_in[15];
  p.w_ff1 = (const float*)d_in[16]; p.w_ff2 = (const float*)d_in[17]; p.norm_ple = (const float*)d_in[18];
  p.w_ple = (const float*)d_in[19]; p.w_ple_gate = (const float*)d_in[20];
  p.out = (float*)d_out; p.ws = (char*)d_ws;
  hipMemsetAsync((char*)d_ws + O_BAR, 0, BAR_BYTES, stream);
  void* args[] = {&p};
  hipError_t e = hipLaunchCooperativeKernel((void*)mega, dim3(grid_blocks), dim3(256), args, 0, stream);
  if (e != hipSuccess) fprintf(stderr, "cooperative launch failed: %s (grid %d)\n", hipGetErrorString(e), grid_blocks);
}
```

```cpp
#include <hip/hip_runtime.h>
#include <hip/hip_cooperative_groups.h>
#include <cstdio>
#include <cstdint>
namespace cg = cooperative_groups;

typedef __attribute__((ext_vector_type(8))) short bf16x8;
typedef __attribute__((ext_vector_type(4))) float f32x4;
typedef unsigned short bf16_t;
typedef __attribute__((ext_vector_type(4))) unsigned u32x4;
#define DI __device__ __forceinline__

#define T_TOK 32768
#define SEQ 8192
#define DM 1024
#define ZS 5400
#define C_Q 0
#define C_KC 512
#define C_VC 640
#define C_KS 768
#define C_VS 896
#define C_KW 1024
#define C_VW 1152
#define C_GT 1280
#define C_RQ 1304
#define C_RK 1816
#define C_RV 2328
#define C_RG 2840
#define C_MA 3352
#define C_MB 4376
#define NPAD_IN 5504
#define TS 8256

#define W_IN 0
#define W_C1K 5636096
#define W_C1V 6160384
#define W_UPA 6684672
#define W_UPR 7208960
#define W_OUT 7733248
#define W_FF1 8781824
#define W_FF2 12976128
#define W_PLE 17170432
#define W_PG 17432576
#define W_LAYER 18481152

#define O_WT 0ull
#define O_ROPE 36962304ull
#define O_BIAS 41156608ull
#define O_HID 41160704ull
#define O_KCMP 45355008ull
#define O_VCMPT 45879296ull
#define O_VST 46403584ull
#define O_VWT 54857728ull
#define O_RVT 63311872ull
#define O_KZT 97128448ull
#define O_Z 130945024ull
#define O_ONSA 484839424ull
#define O_BAR 518393856ull
#define BAR_BYTES 13824
#define O_KVD 518407680ull
#define O_RP 535184896ull
#define WS_NEED 536233472ull

struct Params {
  const float* x; const float* p; const float* norm_mix; const float* w_in;
  const float* nsa_q_norm; const float* nsa_k_norm; const float* cmp_pos_k; const float* cmp_pos_v;
  const float* cmp_w1_k; const float* cmp_w2_k; const float* cmp_w1_v; const float* cmp_w2_v;
  const float* w_up_nsa; const float* w_up_ret; const float* w_out; const float* norm_mlp;
  const float* w_ff1; const float* w_ff2; const float* norm_ple; const float* w_ple; const float* w_ple_gate;
  float* out; char* ws;
};

DI unsigned pack2(float a, float b) {
  typedef __attribute__((ext_vector_type(2))) __bf16 bf2;
  typedef __attribute__((ext_vector_type(2))) float f2;
  f2 v = {a, b};
  bf2 r = __builtin_convertvector(v, bf2);
  return __builtin_bit_cast(unsigned, r);
}
DI bf16_t f2bf(float a) { return (bf16_t)(pack2(a, 0.f) & 0xffffu); }
DI float bf2f(bf16_t h) { return __uint_as_float(((unsigned)h) << 16); }
DI float bflo(unsigned u) { return __uint_as_float(u << 16); }
DI float bfhi(unsigned u) { return __uint_as_float(u & 0xffff0000u); }
DI float shx(float v, int mask, int lane) {
  return __int_as_float(__builtin_amdgcn_ds_bpermute((lane ^ mask) << 2, __float_as_int(v)));
}
DI uint32_t shxu(uint32_t v, int mask, int lane) {
  return (uint32_t)__builtin_amdgcn_ds_bpermute((lane ^ mask) << 2, (int)v);
}
DI float shfrom(float v, int srclane) {
  return __int_as_float(__builtin_amdgcn_ds_bpermute(srclane << 2, __float_as_int(v)));
}
DI float wave_sum(float v, int lane) {
#pragma unroll
  for (int o = 32; o > 0; o >>= 1) v += shx(v, o, lane);
  return v;
}
DI int TID() { int t = threadIdx.x; asm volatile("" : "+v"(t)); return t; }
DI float sigmoidf(float x) { return 1.f / (1.f + __expf(-x)); }
DI f32x4 mfma16(bf16x8 a, bf16x8 b, f32x4 c) { return __builtin_amdgcn_mfma_f32_16x16x32_bf16(a, b, c, 0, 0, 0); }
DI bf16x8 mk8(unsigned a, unsigned b, unsigned c, unsigned d) {
  uint4 u = make_uint4(a, b, c, d);
  return __builtin_bit_cast(bf16x8, u);
}

template <class AP, class BP>
DI void g_load(u32x4 (&ra)[4], u32x4 (&rb)[4], const AP& ap, const BP& bp, int kb, int lrow, int lch) {
#pragma unroll
  for (int i = 0; i < 4; ++i) {
    ra[i] = *(const u32x4*)(ap(lrow + 32 * i, kb) + lch * 8);
    rb[i] = *(const u32x4*)(bp(lrow + 32 * i, kb) + lch * 8);
  }
}
DI void g_store(bf16_t* As, bf16_t* Bs, const u32x4 (&ra)[4], const u32x4 (&rb)[4], int buf, int lrow, int lch) {
#pragma unroll
  for (int i = 0; i < 4; ++i) {
    int r = lrow + 32 * i;
    int off = buf * 8192 + r * 64 + ((lch ^ ((r >> 1) & 7)) << 3);
    *(u32x4*)(As + off) = ra[i];
    *(u32x4*)(Bs + off) = rb[i];
  }
}
DI void g_compute(f32x4 (&acc)[4][4], const bf16_t* a, const bf16_t* b, int wm, int wn, int lane) {
  bf16x8 af[2][4], bfr[2][4];
#pragma unroll
  for (int ks = 0; ks < 2; ++ks)
#pragma unroll
    for (int i = 0; i < 4; ++i) {
      int r = wm * 64 + i * 16 + (lane & 15);
      af[ks][i] = *(const bf16x8*)(a + r * 64 + (((ks * 4 + (lane >> 4)) ^ ((r >> 1) & 7)) << 3));
      int r2 = wn * 64 + i * 16 + (lane & 15);
      bfr[ks][i] = *(const bf16x8*)(b + r2 * 64 + (((ks * 4 + (lane >> 4)) ^ ((r2 >> 1) & 7)) << 3));
    }
  __builtin_amdgcn_s_setprio(1);
#pragma unroll
  for (int ks = 0; ks < 2; ++ks)
#pragma unroll
    for (int i = 0; i < 4; ++i)
#pragma unroll
      for (int j = 0; j < 4; ++j) acc[i][j] = mfma16(bfr[ks][j], af[ks][i], acc[i][j]);
  __builtin_amdgcn_s_setprio(0);
}
template <class AP, class BP>
DI void gemm_accum(f32x4 (&acc)[4][4], AP ap, BP bp, int nkb, bf16_t* lds) {
  const int tid = TID(), lane = tid & 63, w = tid >> 6;
  const int wm = w >> 1, wn = w & 1;
  const int lrow = tid >> 3, lch = tid & 7;
  bf16_t* As = lds;
  bf16_t* Bs = lds + 16384;
  u32x4 ra0[4], rb0[4], ra1[4], rb1[4];
  __syncthreads();
  g_load(ra0, rb0, ap, bp, 0, lrow, lch);
  g_load(ra1, rb1, ap, bp, 1, lrow, lch);
  g_store(As, Bs, ra0, rb0, 0, lrow, lch);
  __syncthreads();
  for (int kb = 0; kb < nkb; kb += 2) {
    const int k2 = (kb + 2 < nkb) ? kb + 2 : nkb - 2;
    g_load(ra0, rb0, ap, bp, k2, lrow, lch);
    __builtin_amdgcn_sched_barrier(0);
    g_compute(acc, As, Bs, wm, wn, lane);
    g_store(As, Bs, ra1, rb1, 1, lrow, lch);
    __syncthreads();
    g_load(ra1, rb1, ap, bp, k2 + 1, lrow, lch);
    __builtin_amdgcn_sched_barrier(0);
    g_compute(acc, As + 8192, Bs + 8192, wm, wn, lane);
    g_store(As, Bs, ra0, rb0, 0, lrow, lch);
    __syncthreads();
  }
}
template <class E>
DI void gemm_epi(f32x4 (&acc)[4][4], int m0, int n0, E e) {
  const int tid_ = TID();
  const int lane = tid_ & 63, w = tid_ >> 6;
  const int wm = w >> 1, wn = w & 1;
#pragma unroll
  for (int i = 0; i < 4; ++i)
#pragma unroll
    for (int j = 0; j < 4; ++j) {
      int m = m0 + wm * 64 + i * 16 + (lane & 15);
      int n = n0 + wn * 64 + j * 16 + (lane >> 4) * 4;
      e(m, n, acc[i][j]);
    }
}
template <class F>
DI void gemm_epi_staged(f32x4 (&acc)[4][4], int m0, int n0, bf16_t* lds, F f, bf16_t* dst, size_t ld, int nmax) {
  const int tid_ = TID();
  const int lane = tid_ & 63, w = tid_ >> 6;
  const int wm = w >> 1, wn = w & 1;
#pragma unroll
  for (int i = 0; i < 4; ++i)
#pragma unroll
    for (int j = 0; j < 4; ++j) {
      const int ml = wm * 64 + i * 16 + (lane & 15);
      const int nl = wn * 64 + j * 16 + (lane >> 4) * 4;
      f32x4 a = acc[i][j];
      f(m0 + ml, n0 + nl, a);
      uint2 u;
      u.x = pack2(a[0], a[1]);
      u.y = pack2(a[2], a[3]);
      *(uint2*)(lds + ml * 136 + nl) = u;
    }
  __syncthreads();
#pragma unroll
  for (int it = 0; it < 8; ++it) {
    const int idx = tid_ + 256 * it;
    const int row = idx >> 4, ch = idx & 15;
    const u32x4 v = *(const u32x4*)(lds + row * 136 + ch * 8);
    const int n = n0 + ch * 8;
    if (n < nmax) *(u32x4*)(dst + (size_t)(m0 + row) * ld + n) = v;
  }
}
DI void gemm_epi_resid(f32x4 (&acc)[4][4], int m0, int n0, int ntile, bf16_t* lds, const float* xin, float* out, bf16_t* xb, float* rowpart) {
  const int tid_ = TID();
  const int lane = tid_ & 63, w = tid_ >> 6;
  const int wm = w >> 1, wn = w & 1;
  float* red = (float*)lds;
#pragma unroll
  for (int i = 0; i < 4; ++i) {
    const int ml = wm * 64 + i * 16 + (lane & 15);
    const size_t rowoff = (size_t)(m0 + ml) * DM;
    float ss = 0.f;
#pragma unroll
    for (int j = 0; j < 4; ++j) {
      const int n = n0 + wn * 64 + j * 16 + (lane >> 4) * 4;
      const float4 xv = *(const float4*)(xin + rowoff + n);
      const float o0 = xv.x + acc[i][j][0], o1 = xv.y + acc[i][j][1], o2 = xv.z + acc[i][j][2], o3 = xv.w + acc[i][j][3];
      *(float4*)(out + rowoff + n) = make_float4(o0, o1, o2, o3);
      ss += o0 * o0 + o1 * o1 + o2 * o2 + o3 * o3;
      uint2 u;
      u.x = pack2(o0, o1);
      u.y = pack2(o2, o3);
      *(uint2*)(xb + rowoff + n) = u;
    }
    ss += shx(ss, 16, lane);
    ss += shx(ss, 32, lane);
    if ((lane >> 4) == 0) red[wn * 128 + ml] = ss;
  }
  __syncthreads();
  if (tid_ < 128) rowpart[(size_t)ntile * T_TOK + m0 + tid_] = red[tid_] + red[128 + tid_];
}
DI void row_rs(float (&rsv)[4], const float* rowpart, int m0) {
  const int tid_ = TID();
  const int lane = tid_ & 63, wm = tid_ >> 7;
#pragma unroll
  for (int i = 0; i < 4; ++i) {
    const int m = m0 + wm * 64 + i * 16 + (lane & 15);
    float s = 0.f;
#pragma unroll
    for (int t = 0; t < 8; ++t) s += rowpart[(size_t)t * T_TOK + m];
    rsv[i] = rsqrtf(s * (1.f / 1024.f) + 1e-6f);
  }
}
DI void scale_rows(f32x4 (&acc)[4][4], const float (&rsv)[4]) {
#pragma unroll
  for (int i = 0; i < 4; ++i)
#pragma unroll
    for (int j = 0; j < 4; ++j) acc[i][j] *= rsv[i];
}
DI void zero_acc(f32x4 (&acc)[4][4]) {
#pragma unroll
  for (int i = 0; i < 4; ++i)
#pragma unroll
    for (int j = 0; j < 4; ++j) acc[i][j] = f32x4{0.f, 0.f, 0.f, 0.f};
}
struct RowPtr {
  const bf16_t* base; size_t ld;
  DI const bf16_t* operator()(int r, int kb) const { return base + (size_t)r * ld + kb * 64; }
};

DI void convert_wt(const float* W, bf16_t* Wt, int K, int N, int Npad, int gtid, int gthreads, const float* gk = nullptr) {
  const int k8n = K >> 3;
  const long total = (long)Npad * k8n;
  for (long idx = gtid; idx < total; idx += gthreads) {
    int n = (int)(idx % Npad);
    int k8 = (int)(idx / Npad);
    uint4 o = make_uint4(0, 0, 0, 0);
    if (n < N) {
      const float* s = W + (size_t)(k8 * 8) * N + n;
      float v0 = s[0], v1 = s[(size_t)N], v2 = s[(size_t)2 * N], v3 = s[(size_t)3 * N];
      float v4 = s[(size_t)4 * N], v5 = s[(size_t)5 * N], v6 = s[(size_t)6 * N], v7 = s[(size_t)7 * N];
      if (gk) {
        const float* gp = gk + k8 * 8;
        v0 *= gp[0]; v1 *= gp[1]; v2 *= gp[2]; v3 *= gp[3]; v4 *= gp[4]; v5 *= gp[5]; v6 *= gp[6]; v7 *= gp[7];
      }
      o = make_uint4(pack2(v0, v1), pack2(v2, v3), pack2(v4, v5), pack2(v6, v7));
    }
    *(uint4*)(Wt + (size_t)n * K + k8 * 8) = o;
  }
}

DI void phase0(const Params& p, const int L) {
  const int gtid = blockIdx.x * 256 + TID();
  const int gthreads = gridDim.x * 256;
  bf16_t* wl = (bf16_t*)(p.ws + O_WT);
  convert_wt(p.w_in + (size_t)L * 1024 * 5400, wl + W_IN, 1024, 5400, NPAD_IN, gtid, gthreads);
  convert_wt(p.cmp_w1_k + (size_t)L * 2048 * 256, wl + W_C1K, 2048, 256, 256, gtid, gthreads);
  convert_wt(p.cmp_w1_v + (size_t)L * 2048 * 256, wl + W_C1V, 2048, 256, 256, gtid, gthreads);
  convert_wt(p.w_up_nsa + (size_t)L * 512 * 1024, wl + W_UPA, 512, 1024, 1024, gtid, gthreads);
  convert_wt(p.w_up_ret + (size_t)L * 512 * 1024, wl + W_UPR, 512, 1024, 1024, gtid, gthreads);
  convert_wt(p.w_out + (size_t)L * 1024 * 1024, wl + W_OUT, 1024, 1024, 1024, gtid, gthreads);
  convert_wt(p.w_ff1 + (size_t)L * 1024 * 4096, wl + W_FF1, 1024, 4096, 4096, gtid, gthreads, p.norm_mlp + L * DM);
  convert_wt(p.w_ff2 + (size_t)L * 4096 * 1024, wl + W_FF2, 4096, 1024, 1024, gtid, gthreads);
  convert_wt(p.w_ple + (size_t)L * 256 * 1024, wl + W_PLE, 256, 1024, 1024, gtid, gthreads);
  convert_wt(p.w_ple_gate + (size_t)L * 1024 * 1024, wl + W_PG, 1024, 1024, 1024, gtid, gthreads, p.norm_ple + L * DM);
  if (L == 0) {
    float2* rope = (float2*)(p.ws + O_ROPE);
    for (int idx = gtid; idx < SEQ * 64; idx += gthreads) {
      int pos = idx >> 6, j = idx & 63;
      float inv = exp2f(-(float)j * (13.287712379549449f / 64.f));
      float ang = (float)pos * inv;
      double rev = (double)ang * 0.15915494309189535;
      rev -= rint(rev);
      float fr = (float)rev;
      rope[idx] = make_float2(__builtin_amdgcn_cosf(fr), __builtin_amdgcn_sinf(fr));
    }
  }
  float* part = (float*)(p.ws + O_HID);
  {
    const int n = gtid & 255;
    for (int item = (int)blockIdx.x; item < 128; item += (int)gridDim.x) {
      const int kv = item >> 6, kc = item & 63;
      const float* pos = (kv ? p.cmp_pos_v : p.cmp_pos_k) + L * 2048 + kc * 32;
      const float* w1 = (kv ? p.cmp_w1_v : p.cmp_w1_k) + (size_t)L * 2048 * 256 + (size_t)kc * 32 * 256;
      float a = 0.f;
#pragma unroll 8
      for (int k = 0; k < 32; ++k) a += pos[k] * w1[(size_t)k * 256 + n];
      part[item * 256 + n] = a;
    }
  }
}

DI void norm_phase(const float* xin, const float* g, bf16_t* h) {
  const int tid_ = TID();
  const int lane = tid_ & 63;
  const int gw = (blockIdx.x * 256 + tid_) >> 6;
  const int nw = gridDim.x * 4;
  float4 gv[4];
#pragma unroll
  for (int i = 0; i < 4; ++i) gv[i] = ((const float4*)g)[i * 64 + lane];
  for (int row = gw; row < T_TOK; row += nw) {
    const float4* xr = (const float4*)(xin + (size_t)row * DM);
    float4 v[4];
    float ss = 0.f;
#pragma unroll
    for (int i = 0; i < 4; ++i) {
      v[i] = xr[i * 64 + lane];
      ss += v[i].x * v[i].x + v[i].y * v[i].y + v[i].z * v[i].z + v[i].w * v[i].w;
    }
    ss = wave_sum(ss, lane);
    float rs = rsqrtf(ss * (1.f / 1024.f) + 1e-6f);
    uint2* hr = (uint2*)(h + (size_t)row * DM);
#pragma unroll
    for (int i = 0; i < 4; ++i) {
      uint2 o;
      o.x = pack2(v[i].x * rs * gv[i].x, v[i].y * rs * gv[i].y);
      o.y = pack2(v[i].z * rs * gv[i].z, v[i].w * rs * gv[i].w);
      hr[i * 64 + lane] = o;
    }
  }
}

DI void post_z(const Params& p, int layer) {
  const int tid_ = TID();
  const int lane = tid_ & 63;
  const int gw = (blockIdx.x * 256 + tid_) >> 6;
  const int nw = gridDim.x * 4;
  bf16_t* z = (bf16_t*)(p.ws + O_Z);
  bf16_t* vsT = (bf16_t*)(p.ws + O_VST);
  bf16_t* vwT = (bf16_t*)(p.ws + O_VWT);
  bf16_t* rvT = (bf16_t*)(p.ws + O_RVT);
  bf16_t* kzT = (bf16_t*)(p.ws + O_KZT);
  const float2* rope = (const float2*)(p.ws + O_ROPE);
  const float* qn = p.nsa_q_norm + layer * 64;
  const float* kn = p.nsa_k_norm + layer * 64;
  {
    const float* part = (const float*)(p.ws + O_HID);
    float* bias = (float*)(p.ws + O_BIAS);
    const int idx = blockIdx.x * 256 + tid_;
    if (idx < 512) {
      const int kv = idx >> 8, n = idx & 255;
      float a = 0.f;
      for (int kc = 0; kc < 64; ++kc) a += part[(kv * 64 + kc) * 256 + n];
      bias[idx] = a;
    }
  }
  for (int item = gw; item < 1024 * 36; item += nw) {
    const int tc = item / 36, slab = item - tc * 36;
    const int tok0 = tc * 32;
    const int b = tok0 >> 13, spos = tok0 & 8191;
    bf16_t* zr = z + (size_t)tok0 * ZS;
    if (slab >= 32) {
      const int s4 = slab - 32, kv = s4 >> 1, gi = s4 & 1;
      const int colbase = (kv ? C_VC : C_KC) + gi * 64;
      bf16_t* dst = (bf16_t*)(p.ws + O_KVD) + ((size_t)((kv * 8 + b * 2 + gi) * SEQ + spos)) * 64 + lane;
      bf16_t u[32];
#pragma unroll
      for (int i = 0; i < 32; ++i) u[i] = zr[(size_t)i * ZS + colbase + lane];
#pragma unroll
      for (int i = 0; i < 32; ++i) dst[i * 64] = u[i];
    } else if (slab < 12) {
      int colbase; const float* g; float sc;
      if (slab < 8) { colbase = C_Q + slab * 64; g = qn; sc = 0.125f; }
      else if (slab < 10) { colbase = C_KS + (slab - 8) * 64; g = kn; sc = 1.f; }
      else { colbase = C_KW + (slab - 10) * 64; g = kn; sc = 1.f; }
      const float gv = g[lane] * sc;
      float v[32];
#pragma unroll
      for (int i = 0; i < 32; ++i) v[i] = bf2f(zr[(size_t)i * ZS + colbase + lane]);
#pragma unroll
      for (int i = 0; i < 32; ++i) {
        float ss = wave_sum(v[i] * v[i], lane);
        float rs = rsqrtf(ss * (1.f / 64.f) + 1e-6f);
        zr[(size_t)i * ZS + colbase + lane] = f2bf(v[i] * rs * gv);
      }
    } else if (slab < 16 || slab >= 24) {
      int colbase; bf16_t* dst;
      if (slab < 16) {
        const int gi = slab & 1;
        const bool isw = slab >= 14;
        colbase = (isw ? C_VW : C_VS) + gi * 64;
        dst = (isw ? vwT : vsT) + ((size_t)((b * 2 + gi) * 64 + lane)) * TS + spos;
      } else {
        const int s8 = slab - 24;
        const int h = s8 >> 1, half = s8 & 1;
        colbase = C_RV + s8 * 64;
        dst = rvT + ((size_t)((b * 4 + h) * 128 + half * 64 + lane)) * TS + spos;
      }
      unsigned u[32];
#pragma unroll
      for (int i = 0; i < 32; ++i) u[i] = zr[(size_t)i * ZS + colbase + lane];
#pragma unroll
      for (int q4 = 0; q4 < 4; ++q4)
        *(uint4*)(dst + q4 * 8) = make_uint4(u[q4 * 8 + 0] | (u[q4 * 8 + 1] << 16), u[q4 * 8 + 2] | (u[q4 * 8 + 3] << 16),
                                             u[q4 * 8 + 4] | (u[q4 * 8 + 5] << 16), u[q4 * 8 + 6] | (u[q4 * 8 + 7] << 16));
    } else if (slab < 20) {
      const int h = slab - 16;
      const int colbase = C_RQ + h * 128;
      float x1[32], x2[32];
#pragma unroll
      for (int i = 0; i < 32; ++i) {
        const bf16_t* p1 = zr + (size_t)i * ZS + colbase + lane;
        x1[i] = bf2f(p1[0]);
        x2[i] = bf2f(p1[64]);
      }
#pragma unroll
      for (int i = 0; i < 32; ++i) {
        bf16_t* p1 = zr + (size_t)i * ZS + colbase + lane;
        float2 cs = rope[(spos + i) * 64 + lane];
        p1[0] = f2bf(x1[i] * cs.x - x2[i] * cs.y);
        p1[64] = f2bf(x1[i] * cs.y + x2[i] * cs.x);
      }
    } else {
      const int h = slab - 20;
      const int colbase = C_RK + h * 128;
      const float lg2 = log2f(1.f - exp2f(-5.f - (float)h));
      float x1[32], x2[32];
#pragma unroll
      for (int i = 0; i < 32; ++i) {
        const bf16_t* p1 = zr + (size_t)i * ZS + colbase + lane;
        x1[i] = bf2f(p1[0]);
        x2[i] = bf2f(p1[64]);
      }
      unsigned u1[32], u2[32];
#pragma unroll
      for (int i = 0; i < 32; ++i) {
        bf16_t* p1 = zr + (size_t)i * ZS + colbase + lane;
        float2 cs = rope[(spos + i) * 64 + lane];
        float o1 = (x1[i] * cs.x - x2[i] * cs.y) * 0.08838834764831845f;
        float o2 = (x1[i] * cs.y + x2[i] * cs.x) * 0.08838834764831845f;
        p1[0] = f2bf(o1);
        p1[64] = f2bf(o2);
        float zeta = exp2f(lg2 * (float)(127 - ((spos + i) & 127)));
        u1[i] = f2bf(o1 * zeta);
        u2[i] = f2bf(o2 * zeta);
      }
      bf16_t* d1 = kzT + ((size_t)((b * 4 + h) * 128 + lane)) * TS + spos;
#pragma unroll
      for (int q4 = 0; q4 < 4; ++q4) {
        *(uint4*)(d1 + q4 * 8) = make_uint4(u1[q4 * 8 + 0] | (u1[q4 * 8 + 1] << 16), u1[q4 * 8 + 2] | (u1[q4 * 8 + 3] << 16),
                                            u1[q4 * 8 + 4] | (u1[q4 * 8 + 5] << 16), u1[q4 * 8 + 6] | (u1[q4 * 8 + 7] << 16));
        *(uint4*)(d1 + (size_t)64 * TS + q4 * 8) = make_uint4(u2[q4 * 8 + 0] | (u2[q4 * 8 + 1] << 16), u2[q4 * 8 + 2] | (u2[q4 * 8 + 3] << 16),
                                                              u2[q4 * 8 + 4] | (u2[q4 * 8 + 5] << 16), u2[q4 * 8 + 6] | (u2[q4 * 8 + 7] << 16));
      }
    }
  }
}

DI void phase4b(const Params& p, int layer) {
  const int tid_ = TID();
  const int lane = tid_ & 63;
  const int gw = (blockIdx.x * 256 + tid_) >> 6;
  const int nw = gridDim.x * 4;
  bf16_t* z = (bf16_t*)(p.ws + O_Z);
  const bf16_t* hid = (const bf16_t*)(p.ws + O_HID);
  bf16_t* kcmp = (bf16_t*)(p.ws + O_KCMP);
  bf16_t* vcmpT = (bf16_t*)(p.ws + O_VCMPT);
  const float* kn = p.nsa_k_norm + layer * 64;
  for (int item = gw; item < 8192; item += nw) {
    const int kv = item >> 12, row = item & 4095;
    const bf16_t* hrow = hid + ((size_t)kv * 4096 + row) * 256;
    const float* w2 = (kv ? p.cmp_w2_v : p.cmp_w2_k) + (size_t)layer * 256 * 64;
    float acc = 0.f;
    for (int k8 = 0; k8 < 32; ++k8) {
      uint4 hv = *(const uint4*)(hrow + k8 * 8);
      const float* wr = w2 + (size_t)(k8 * 8) * 64 + lane;
      acc += bflo(hv.x) * wr[0];
      acc += bfhi(hv.x) * wr[64];
      acc += bflo(hv.y) * wr[128];
      acc += bfhi(hv.y) * wr[192];
      acc += bflo(hv.z) * wr[256];
      acc += bfhi(hv.z) * wr[320];
      acc += bflo(hv.w) * wr[384];
      acc += bfhi(hv.w) * wr[448];
    }
    if (kv == 0) {
      float ss = wave_sum(acc * acc, lane);
      float rs = rsqrtf(ss * (1.f / 64.f) + 1e-6f);
      kcmp[(size_t)row * 64 + lane] = f2bf(acc * rs * kn[lane]);
    } else {
      const int bg = row >> 9, c = row & 511;
      vcmpT[((size_t)(bg * 64 + lane)) * 512 + c] = f2bf(acc);
    }
  }
  const int gtid = blockIdx.x * 256 + tid_;
  const int gthreads = gridDim.x * 256;
  for (int idx = gtid; idx < 65536; idx += gthreads) {
    const int d4 = idx & 31, e = (idx >> 5) & 127, h = (idx >> 12) & 3, b = idx >> 14;
    const float lg2 = log2f(1.f - exp2f(-5.f - (float)h));
    const float gch = exp2f(lg2 * 128.f);
    float r0 = 0.f, r1 = 0.f, r2 = 0.f, r3 = 0.f;
    bf16_t* ptr = z + ((size_t)(b * SEQ + e)) * ZS + C_RV + h * 128 + d4 * 4;
    for (int c0 = 0; c0 < 64; c0 += 16) {
      typedef __attribute__((ext_vector_type(2))) unsigned u32x2;
      u32x2 v[16];
#pragma unroll
      for (int i = 0; i < 16; ++i) v[i] = *(const u32x2*)(ptr + (size_t)(c0 + i) * 128 * ZS);
#pragma unroll
      for (int i = 0; i < 16; ++i) {
        u32x2 o;
        o.x = pack2(r0, r1);
        o.y = pack2(r2, r3);
        *(u32x2*)(ptr + (size_t)(c0 + i) * 128 * ZS) = o;
        r0 = gch * r0 + bflo(v[i].x);
        r1 = gch * r1 + bfhi(v[i].x);
        r2 = gch * r2 + bflo(v[i].y);
        r3 = gch * r3 + bfhi(v[i].y);
      }
    }
  }
}


DI void tile64_gload(int tid, u32x4& r0, u32x4& r1, const bf16_t* base, size_t stride) {
  {
    int idx = tid;
    int row = idx >> 3, ch = idx & 7;
    r0 = *(const u32x4*)(base + (size_t)row * stride + ch * 8);
  }
  {
    int idx = tid + 256;
    int row = idx >> 3, ch = idx & 7;
    r1 = *(const u32x4*)(base + (size_t)row * stride + ch * 8);
  }
}
DI void tile64_sstore(int tid, bf16_t* dst, const u32x4& r0, const u32x4& r1) {
  {
    int idx = tid;
    int row = idx >> 3, ch = idx & 7;
    *(u32x4*)(dst + row * 64 + ((ch ^ ((row >> 1) & 7)) << 3)) = r0;
  }
  {
    int idx = tid + 256;
    int row = idx >> 3, ch = idx & 7;
    *(u32x4*)(dst + row * 64 + ((ch ^ ((row >> 1) & 7)) << 3)) = r1;
  }
}

struct AttnSt { f32x4 O[2][4]; float m[2]; float l[2]; };

template <int MODE, bool FX>
DI void attn_compute(const int lane, const bf16_t* Ks, const bf16_t* Vs, const bf16x8 (&qf)[2][2], AttnSt& st, const float (&invl)[2],
                     int lo, int hi, float (&impA)[4], float (&impE)[4], const float CL) {
  const int quad = lane >> 4, col = lane & 15;
  f32x4 S[4][2];
#pragma unroll
  for (int kt = 0; kt < 4; ++kt)
#pragma unroll
    for (int hh = 0; hh < 2; ++hh) S[kt][hh] = f32x4{0.f, 0.f, 0.f, 0.f};
#pragma unroll
  for (int ks = 0; ks < 2; ++ks) {
#pragma unroll
    for (int kt = 0; kt < 4; ++kt) {
      int row = kt * 16 + col;
      bf16x8 kf = *(const bf16x8*)(Ks + row * 64 + (((ks * 4 + quad) ^ ((row >> 1) & 7)) << 3));
#pragma unroll
      for (int hh = 0; hh < 2; ++hh) S[kt][hh] = mfma16(kf, qf[hh][ks], S[kt][hh]);
    }
  }
  bf16x8 pf[2][2];
  const bool full = (lo <= 0) && (hi >= 63);
  const bool none = (hi < 0) || (lo > 63) || (hi < lo);
  if (__all(full || none)) {
    constexpr float L2E = 1.4426950408889634f;
#pragma unroll
    for (int hh = 0; hh < 2; ++hh) {
      float mL;
      float il = 1.f;
      if (FX) {
        mL = full ? CL : 1e30f;
        if (MODE == 1) il = invl[hh];
      } else if (MODE != 1) {
        float mx = -1e30f;
#pragma unroll
        for (int kt = 0; kt < 4; ++kt)
#pragma unroll
          for (int j = 0; j < 4; ++j) mx = fmaxf(mx, S[kt][hh][j]);
        mx = full ? mx : -1e30f;
        mx = fmaxf(mx, shx(mx, 16, lane));
        mx = fmaxf(mx, shx(mx, 32, lane));
        const float m_new = fmaxf(st.m[hh], mx);
        const float alpha = __expf(st.m[hh] - m_new);
        st.m[hh] = m_new;
        st.l[hh] *= alpha;
        if (MODE == 2) {
#pragma unroll
          for (int dt = 0; dt < 4; ++dt) st.O[hh][dt] *= alpha;
        }
        mL = full ? m_new * L2E : 1e30f;
      } else {
        mL = full ? st.m[hh] * L2E : 1e30f;
        il = invl[hh];
      }
      float rs = 0.f;
#pragma unroll
      for (int kt = 0; kt < 4; ++kt) {
        float a = 0.f;
#pragma unroll
        for (int j = 0; j < 4; ++j) {
          float pv = __builtin_amdgcn_exp2f(fmaf(S[kt][hh][j], L2E, -mL));
          if (MODE == 1) pv *= il;
          S[kt][hh][j] = pv;
          a += pv;
        }
        rs += a;
        if (MODE == 1) {
          impA[kt] += a;
          impE[kt] += S[kt][hh][3];
        }
      }
      if (MODE != 1) st.l[hh] += rs;
      if (MODE != 0) {
#pragma unroll
        for (int c = 0; c < 2; ++c)
          pf[hh][c] = mk8(pack2(S[2 * c][hh][0], S[2 * c][hh][1]), pack2(S[2 * c][hh][2], S[2 * c][hh][3]),
                          pack2(S[2 * c + 1][hh][0], S[2 * c + 1][hh][1]), pack2(S[2 * c + 1][hh][2], S[2 * c + 1][hh][3]));
      }
    }
  } else {
#pragma unroll
  for (int hh = 0; hh < 2; ++hh) {
    if (FX) {
      constexpr float L2E = 1.4426950408889634f;
      const float il = (MODE == 1) ? invl[hh] : 1.f;
      float rs = 0.f;
#pragma unroll
      for (int kt = 0; kt < 4; ++kt) {
        float a = 0.f;
#pragma unroll
        for (int j = 0; j < 4; ++j) {
          const int kl = kt * 16 + quad * 4 + j;
          const bool v = (kl >= lo) && (kl <= hi);
          float pv = v ? __builtin_amdgcn_exp2f(fmaf(S[kt][hh][j], L2E, -CL)) : 0.f;
          if (MODE == 1) pv *= il;
          S[kt][hh][j] = pv;
          a += pv;
        }
        rs += a;
        if (MODE == 1) {
          impA[kt] += a;
          impE[kt] += S[kt][hh][3];
        }
      }
      if (MODE != 1) st.l[hh] += rs;
      if (MODE != 0) {
#pragma unroll
        for (int c = 0; c < 2; ++c)
          pf[hh][c] = mk8(pack2(S[2 * c][hh][0], S[2 * c][hh][1]), pack2(S[2 * c][hh][2], S[2 * c][hh][3]),
                          pack2(S[2 * c + 1][hh][0], S[2 * c + 1][hh][1]), pack2(S[2 * c + 1][hh][2], S[2 * c + 1][hh][3]));
      }
      continue;
    }
    float mx = -1e30f;
#pragma unroll
    for (int kt = 0; kt < 4; ++kt)
#pragma unroll
      for (int j = 0; j < 4; ++j) {
        int kl = kt * 16 + quad * 4 + j;
        bool v = (kl >= lo) && (kl <= hi);
        float sv = v ? S[kt][hh][j] : -1e30f;
        S[kt][hh][j] = sv;
        mx = fmaxf(mx, sv);
      }
    if (MODE != 1) {
      mx = fmaxf(mx, shx(mx, 16, lane));
      mx = fmaxf(mx, shx(mx, 32, lane));
      float m_new = fmaxf(st.m[hh], mx);
      float alpha = __expf(st.m[hh] - m_new);
      st.m[hh] = m_new;
      float rs = 0.f;
#pragma unroll
      for (int kt = 0; kt < 4; ++kt)
#pragma unroll
        for (int j = 0; j < 4; ++j) {
          float sv = S[kt][hh][j];
          float pv = (sv > -1e29f) ? __expf(sv - m_new) : 0.f;
          rs += pv;
          S[kt][hh][j] = pv;
        }
      st.l[hh] = st.l[hh] * alpha + rs;
      if (MODE == 2) {
#pragma unroll
        for (int dt = 0; dt < 4; ++dt) st.O[hh][dt] *= alpha;
      }
    } else {
      const float mh = st.m[hh], il = invl[hh];
#pragma unroll
      for (int kt = 0; kt < 4; ++kt) {
        float a = 0.f;
#pragma unroll
        for (int j = 0; j < 4; ++j) {
          float sv = S[kt][hh][j];
          float pv = (sv > -1e29f) ? __expf(sv - mh) * il : 0.f;
          S[kt][hh][j] = pv;
          a += pv;
        }
        impA[kt] += a;
        impE[kt] += S[kt][hh][3];
      }
    }
    if (MODE != 0) {
#pragma unroll
      for (int c = 0; c < 2; ++c)
        pf[hh][c] = mk8(pack2(S[2 * c][hh][0], S[2 * c][hh][1]), pack2(S[2 * c][hh][2], S[2 * c][hh][3]),
                        pack2(S[2 * c + 1][hh][0], S[2 * c + 1][hh][1]), pack2(S[2 * c + 1][hh][2], S[2 * c + 1][hh][3]));
    }
  }
  }
  if (MODE != 0) {
#pragma unroll
    for (int dt = 0; dt < 4; ++dt) {
      const int row = dt * 16 + col;
      const int sw = (row >> 1) & 7;
#pragma unroll
      for (int c = 0; c < 2; ++c) {
        uint2 a = *(const uint2*)(Vs + row * 64 + (((4 * c + (quad >> 1)) ^ sw) << 3) + (quad & 1) * 4);
        uint2 b = *(const uint2*)(Vs + row * 64 + (((4 * c + 2 + (quad >> 1)) ^ sw) << 3) + (quad & 1) * 4);
        bf16x8 vf = mk8(a.x, a.y, b.x, b.y);
#pragma unroll
        for (int hh = 0; hh < 2; ++hh) st.O[hh][dt] = mfma16(vf, pf[hh][c], st.O[hh][dt]);
      }
    }
  }
}

DI void st_reset(AttnSt& st) {
#pragma unroll
  for (int h = 0; h < 2; ++h) {
    st.m[h] = -1e30f;
    st.l[h] = 0.f;
#pragma unroll
    for (int dt = 0; dt < 4; ++dt) st.O[h][dt] = f32x4{0.f, 0.f, 0.f, 0.f};
  }
}

template <bool FIRST>
DI void nsa_flush(const int quad, bf16_t* optr, const AttnSt& st, const float (&sc)[2]) {
#pragma unroll
  for (int h = 0; h < 2; ++h)
#pragma unroll
    for (int dt = 0; dt < 4; ++dt) {
      uint2* q = (uint2*)(optr + h * 64 + dt * 16 + quad * 4);
      f32x4 o = st.O[h][dt] * sc[h];
      if (!FIRST) {
        uint2 pv = *q;
        o[0] += bflo(pv.x); o[1] += bfhi(pv.x); o[2] += bflo(pv.y); o[3] += bfhi(pv.y);
      }
      uint2 u;
      u.x = pack2(o[0], o[1]);
      u.y = pack2(o[2], o[3]);
      *q = u;
    }
}

template <bool FX>
DI void nsa_tile(const Params& p, int b, int g, int tile, bf16_t* lds, const float CL) {
  const int tid = TID(), lane = tid & 63, w = tid >> 6, quad = lane >> 4, col = lane & 15;
  const int cur = tile;
  const int tok = tile * 64 + w * 16 + col;
  bf16_t* z = (bf16_t*)(p.ws + O_Z);
  const bf16_t* kcmp = (const bf16_t*)(p.ws + O_KCMP) + (size_t)(b * 2 + g) * 512 * 64;
  const bf16_t* vcmpT = (const bf16_t*)(p.ws + O_VCMPT) + (size_t)(b * 2 + g) * 64 * 512;
  const bf16_t* vsT = (const bf16_t*)(p.ws + O_VST) + (size_t)(b * 2 + g) * 64 * TS;
  const bf16_t* vwT = (const bf16_t*)(p.ws + O_VWT) + (size_t)(b * 2 + g) * 64 * TS;
  const bf16_t* zb = z + (size_t)b * SEQ * ZS;
  const bf16_t* ztok = z + ((size_t)(b * SEQ + tok)) * ZS;
  bf16_t* otok = (bf16_t*)(p.ws + O_ONSA) + ((size_t)(b * SEQ + tok)) * 512 + g * 256;
  bf16_t* Ks = lds;
  bf16_t* Vs = lds + 4096;
  float* impl = (float*)(lds + 8192);

  AttnSt st;
  float invl[2] = {0.f, 0.f};
  float dA[4] = {0.f, 0.f, 0.f, 0.f}, dE[4] = {0.f, 0.f, 0.f, 0.f};
  u32x4 rk0, rk1, rv0, rv1;
  bf16x8 qf[2][2];

  const int ncs = (cur < 16) ? 1 : (cur >> 4) + 1;
  const int chi = (tok >= 31) ? ((tok - 31) >> 4) : -1;

  for (int hp = 0; hp < 2; ++hp) {
#pragma unroll
    for (int hh = 0; hh < 2; ++hh)
#pragma unroll
      for (int ks = 0; ks < 2; ++ks) qf[hh][ks] = *(const bf16x8*)(ztok + C_Q + g * 256 + (hp * 2 + hh) * 64 + ks * 32 + quad * 8);
    st_reset(st);
    tile64_gload(tid, rk0, rk1, kcmp, 64);
    for (int s = 0; s < ncs; ++s) {
      __syncthreads();
      tile64_sstore(tid, Ks, rk0, rk1);
      __syncthreads();
      if (s + 1 < ncs) tile64_gload(tid, rk0, rk1, kcmp + (size_t)(s + 1) * 4096, 64);
      attn_compute<0, FX>(lane, Ks, Vs, qf, st, invl, 0, chi - s * 64, dA, dE, CL);
    }
#pragma unroll
    for (int h = 0; h < 2; ++h) {
      float l = st.l[h];
      l += shx(l, 16, lane);
      l += shx(l, 32, lane);
      invl[h] = (l > 0.f) ? 1.f / l : 0.f;
    }
    {
      float carry = 0.f;
      tile64_gload(tid, rk0, rk1, kcmp, 64);
      tile64_gload(tid, rv0, rv1, vcmpT, 512);
      for (int s = 0; s < ncs; ++s) {
        float iA[4] = {0.f, 0.f, 0.f, 0.f}, iE[4] = {0.f, 0.f, 0.f, 0.f};
        __syncthreads();
        tile64_sstore(tid, Ks, rk0, rk1);
        tile64_sstore(tid, Vs, rv0, rv1);
        __syncthreads();
        if (s + 1 < ncs) {
          tile64_gload(tid, rk0, rk1, kcmp + (size_t)(s + 1) * 4096, 64);
          tile64_gload(tid, rv0, rv1, vcmpT + (s + 1) * 64, 512);
        }
        attn_compute<1, FX>(lane, Ks, Vs, qf, st, invl, 0, chi - s * 64, iA, iE, CL);
#pragma unroll
        for (int kt = 0; kt < 4; ++kt) {
          float recv = shfrom(iE[kt], (lane + 48) & 63);
          float val = iA[kt] + ((quad == 0) ? carry : recv);
          carry = recv;
          float* slot = impl + (s * 4 + kt) * 256 + tid;
          if (hp == 0) *slot = val; else *slot += val;
        }
      }
    }
    {
      float sc[2];
#pragma unroll
      for (int h = 0; h < 2; ++h) sc[h] = sigmoidf(bf2f(ztok[C_GT + 0 * 8 + g * 4 + hp * 2 + h]));
      nsa_flush<true>(quad, otok + hp * 128, st, sc);
    }
  }

  uint32_t sw0, sw1, sw2, sw3;
  {
    uint32_t key[32];
#pragma unroll
    for (int i = 0; i < 32; ++i) {
      int j = i * 4 + quad;
      float sc = (i < ncs * 4) ? impl[i * 256 + tid] : 0.f;
      if (j == 0 || j == cur || j == cur - 1) sc = 1e4f;
      uint32_t k = (__float_as_uint(sc) & ~127u) | (uint32_t)(127 - j);
      key[i] = (j > cur) ? 0u : k;
    }
    uint32_t prev = 0xFFFFFFFFu;
    for (int r = 0; r < 16; ++r) {
      uint32_t mx = 0u;
#pragma unroll
      for (int i = 0; i < 32; ++i) {
        uint32_t k = key[i];
        k = (k < prev) ? k : 0u;
        mx = (k > mx) ? k : mx;
      }
      uint32_t o = shxu(mx, 16, lane);
      mx = (o > mx) ? o : mx;
      o = shxu(mx, 32, lane);
      mx = (o > mx) ? o : mx;
      prev = mx;
    }
    sw0 = 0u; sw1 = 0u; sw2 = 0u; sw3 = 0u;
#pragma unroll
    for (int i = 0; i < 32; ++i) {
      bool sel = (key[i] != 0u) && (key[i] >= prev);
      uint32_t bit = sel ? (1u << ((i & 7) * 4 + quad)) : 0u;
      if ((i >> 3) == 0) sw0 |= bit;
      else if ((i >> 3) == 1) sw1 |= bit;
      else if ((i >> 3) == 2) sw2 |= bit;
      else sw3 |= bit;
    }
    sw0 |= shxu(sw0, 16, lane); sw0 |= shxu(sw0, 32, lane);
    sw1 |= shxu(sw1, 16, lane); sw1 |= shxu(sw1, 32, lane);
    sw2 |= shxu(sw2, 16, lane); sw2 |= shxu(sw2, 32, lane);
    sw3 |= shxu(sw3, 16, lane); sw3 |= shxu(sw3, 32, lane);
  }

  for (int hp = 0; hp < 2; ++hp) {
#pragma unroll
    for (int hh = 0; hh < 2; ++hh)
#pragma unroll
      for (int ks = 0; ks < 2; ++ks) qf[hh][ks] = *(const bf16x8*)(ztok + C_Q + g * 256 + (hp * 2 + hh) * 64 + ks * 32 + quad * 8);
    st_reset(st);
    {
      const bf16_t* kb = zb + C_KS + g * 64;
      tile64_gload(tid, rk0, rk1, kb, ZS);
      tile64_gload(tid, rv0, rv1, vsT, TS);
      for (int s = 0; s <= cur; ++s) {
        __syncthreads();
        tile64_sstore(tid, Ks, rk0, rk1);
        tile64_sstore(tid, Vs, rv0, rv1);
        __syncthreads();
        if (s < cur) {
          tile64_gload(tid, rk0, rk1, kb + (size_t)(s + 1) * 64 * ZS, ZS);
          tile64_gload(tid, rv0, rv1, vsT + (s + 1) * 64, TS);
        }
        uint32_t wsel = (s < 32) ? sw0 : (s < 64) ? sw1 : (s < 96) ? sw2 : sw3;
        bool sel = (wsel >> (s & 31)) & 1u;
        int hi = sel ? (tok - s * 64) : -1;
        if (__any(hi >= 0)) attn_compute<2, FX>(lane, Ks, Vs, qf, st, invl, 0, hi, dA, dE, CL);
      }
    }
    {
      float sc[2];
#pragma unroll
      for (int h = 0; h < 2; ++h) {
        float l = st.l[h];
        l += shx(l, 16, lane);
        l += shx(l, 32, lane);
        sc[h] = (l > 0.f) ? sigmoidf(bf2f(ztok[C_GT + 1 * 8 + g * 4 + hp * 2 + h])) / l : 0.f;
      }
      nsa_flush<false>(quad, otok + hp * 128, st, sc);
    }
    st_reset(st);
    {
      const bf16_t* kb = zb + C_KW + g * 64;
      const int s0 = (cur >= 8) ? cur - 8 : 0;
      tile64_gload(tid, rk0, rk1, kb + (size_t)s0 * 64 * ZS, ZS);
      tile64_gload(tid, rv0, rv1, vwT + s0 * 64, TS);
      for (int s = s0; s <= cur; ++s) {
        __syncthreads();
        tile64_sstore(tid, Ks, rk0, rk1);
        tile64_sstore(tid, Vs, rv0, rv1);
        __syncthreads();
        if (s < cur) {
          tile64_gload(tid, rk0, rk1, kb + (size_t)(s + 1) * 64 * ZS, ZS);
          tile64_gload(tid, rv0, rv1, vwT + (s + 1) * 64, TS);
        }
        attn_compute<2, FX>(lane, Ks, Vs, qf, st, invl, tok - 511 - s * 64, tok - s * 64, dA, dE, CL);
      }
    }
    {
      float sc[2];
#pragma unroll
      for (int h = 0; h < 2; ++h) {
        float l = st.l[h];
        l += shx(l, 16, lane);
        l += shx(l, 32, lane);
        sc[h] = (l > 0.f) ? sigmoidf(bf2f(ztok[C_GT + 2 * 8 + g * 4 + hp * 2 + h])) / l : 0.f;
      }
      nsa_flush<false>(quad, otok + hp * 128, st, sc);
    }
  }
}

DI void load128(int tid, bf16_t* lds, const bf16_t* base, size_t stride) {
  u32x4 r[8];
#pragma unroll
  for (int i = 0; i < 8; ++i) {
    int idx = tid + 256 * i;
    int row = idx >> 4, ch = idx & 15;
    r[i] = *(const u32x4*)(base + (size_t)row * stride + ch * 8);
  }
#pragma unroll
  for (int i = 0; i < 8; ++i) {
    int idx = tid + 256 * i;
    int row = idx >> 4, ch = idx & 15;
    *(u32x4*)(lds + row * 128 + ((ch ^ (row & 15)) << 3)) = r[i];
  }
}

DI void ret_tile(const Params& p, int b, int h, int c, bf16_t* lds) {
  const int tid = TID(), lane = tid & 63, w = tid >> 6, quad = lane >> 4, col = lane & 15;
  const float lg2 = log2f(1.f - exp2f(-5.f - (float)h));
  bf16_t* z = (bf16_t*)(p.ws + O_Z);
  const bf16_t* rvT = (const bf16_t*)(p.ws + O_RVT);
  bf16_t* zc = z + ((size_t)(b * SEQ + c * 128)) * ZS;
  bf16x8 qf[2][4];
#pragma unroll
  for (int nt = 0; nt < 2; ++nt)
#pragma unroll
    for (int ks = 0; ks < 4; ++ks) {
      int n = 32 * w + nt * 16 + col;
      qf[nt][ks] = *(const bf16x8*)(zc + (size_t)n * ZS + C_RQ + h * 128 + ks * 32 + quad * 8);
    }
  f32x4 acc[8][2];
#pragma unroll
  for (int et = 0; et < 8; ++et)
#pragma unroll
    for (int nt = 0; nt < 2; ++nt) acc[et][nt] = f32x4{0.f, 0.f, 0.f, 0.f};
  __syncthreads();
  load128(tid, lds, zc + C_RV + h * 128, ZS);
  __syncthreads();
#pragma unroll
  for (int ks = 0; ks < 4; ++ks)
#pragma unroll
    for (int et = 0; et < 8; ++et) {
      int row = et * 16 + col;
      bf16x8 af = *(const bf16x8*)(lds + row * 128 + (((ks * 4 + quad) ^ (row & 15)) << 3));
#pragma unroll
      for (int nt = 0; nt < 2; ++nt) acc[et][nt] = mfma16(af, qf[nt][ks], acc[et][nt]);
    }
#pragma unroll
  for (int nt = 0; nt < 2; ++nt) {
    int n = 32 * w + nt * 16 + col;
    float xi = exp2f(lg2 * (float)(n + 1));
#pragma unroll
    for (int et = 0; et < 8; ++et) acc[et][nt] *= xi;
  }
  __syncthreads();
  load128(tid, lds, zc + C_RK + h * 128, ZS);
  __syncthreads();
  bf16x8 pf[2][4];
#pragma unroll
  for (int nt = 0; nt < 2; ++nt) {
    f32x4 s[8];
#pragma unroll
    for (int mt = 0; mt < 8; ++mt) s[mt] = f32x4{0.f, 0.f, 0.f, 0.f};
#pragma unroll
    for (int ks = 0; ks < 4; ++ks)
#pragma unroll
      for (int mt = 0; mt < 8; ++mt) {
        if (mt <= 2 * w + 1) {
          int row = mt * 16 + col;
          bf16x8 af = *(const bf16x8*)(lds + row * 128 + (((ks * 4 + quad) ^ (row & 15)) << 3));
          s[mt] = mfma16(af, qf[nt][ks], s[mt]);
        }
      }
    const int n = 32 * w + nt * 16 + col;
#pragma unroll
    for (int c2 = 0; c2 < 4; ++c2) {
      float v[8];
#pragma unroll
      for (int i = 0; i < 8; ++i) {
        const int mt = 2 * c2 + (i >> 2), j = i & 3;
        const int m = mt * 16 + quad * 4 + j;
        v[i] = (n >= m) ? s[mt][j] * exp2f(lg2 * (float)(n - m)) : 0.f;
      }
      pf[nt][c2] = mk8(pack2(v[0], v[1]), pack2(v[2], v[3]), pack2(v[4], v[5]), pack2(v[6], v[7]));
    }
  }
  __syncthreads();
  load128(tid, lds, rvT + ((size_t)((b * 4 + h) * 128)) * TS + c * 128, TS);
  __syncthreads();
#pragma unroll
  for (int c2 = 0; c2 < 4; ++c2) {
    if (2 * c2 <= 2 * w + 1) {
#pragma unroll
      for (int et = 0; et < 8; ++et) {
        int row = et * 16 + col;
        int sw = row & 15;
        uint2 a = *(const uint2*)(lds + row * 128 + (((4 * c2 + (quad >> 1)) ^ sw) << 3) + (quad & 1) * 4);
        uint2 bb = *(const uint2*)(lds + row * 128 + (((4 * c2 + 2 + (quad >> 1)) ^ sw) << 3) + (quad & 1) * 4);
        bf16x8 vf = mk8(a.x, a.y, bb.x, bb.y);
#pragma unroll
        for (int nt = 0; nt < 2; ++nt) acc[et][nt] = mfma16(vf, pf[nt][c2], acc[et][nt]);
      }
    }
  }
#pragma unroll
  for (int nt = 0; nt < 2; ++nt) {
    float ss = 0.f;
#pragma unroll
    for (int et = 0; et < 8; ++et)
#pragma unroll
      for (int j = 0; j < 4; ++j) ss += acc[et][nt][j] * acc[et][nt][j];
    ss += shx(ss, 16, lane);
    ss += shx(ss, 32, lane);
    const float rs = rsqrtf(ss * (1.f / 128.f) + 1e-6f);
    const int n = 32 * w + nt * 16 + col;
    bf16_t* zr = zc + (size_t)n * ZS;
#pragma unroll
    for (int et = 0; et < 8; ++et) {
      const int e0 = et * 16 + quad * 4;
      uint2 gv = *(const uint2*)(zr + C_RG + h * 128 + e0);
      float g0 = bflo(gv.x), g1 = bfhi(gv.x), g2 = bflo(gv.y), g3 = bfhi(gv.y);
      uint2 o;
      o.x = pack2(acc[et][nt][0] * rs * g0 * sigmoidf(g0), acc[et][nt][1] * rs * g1 * sigmoidf(g1));
      o.y = pack2(acc[et][nt][2] * rs * g2 * sigmoidf(g2), acc[et][nt][3] * rs * g3 * sigmoidf(g3));
      *(uint2*)(zr + C_RQ + h * 128 + e0) = o;
    }
  }
}

#define GEMM_TILE_LOOP(NT)                                                             \
  for (int q_ = (int)(blockIdx.x >> 3), per_ = (int)(gridDim.x >> 3), xcd_ = (int)(blockIdx.x & 7), mt = 0, ntile = 0; \
       q_ < 32 * (NT) && ((mt = (((xcd_ + 8 * (q_ / (8 * (NT)))) << 3) + ((q_ % (8 * (NT))) & 7)), ntile = ((q_ % (8 * (NT))) >> 3)), true); \
       q_ += per_)

#define XB_TMO      128
#define XB_XCNT(j)  (256  + 64 * (j))
#define XB_XSUB(j)  (1280 + 64 * (j))
#define XB_XGEN(j)  (2304 + 64 * (j))
#define XB_TOP      3328
#define XB_TOPGEN   3392
#define XB_SPIN_CAP (1u << 20)
DI unsigned xb_ld(unsigned* p) { return __hip_atomic_load(p, __ATOMIC_RELAXED, __HIP_MEMORY_SCOPE_AGENT); }
DI unsigned xb_add(unsigned* p, unsigned v) { return __hip_atomic_fetch_add(p, v, __ATOMIC_RELAXED, __HIP_MEMORY_SCOPE_AGENT); }
DI unsigned xb_xcc_id() { return (unsigned)__builtin_amdgcn_s_getreg((3 << 11) | 20) & 0xFu; }
#define XB_SPIN(cond, bar) do { unsigned _sp = 0; while (cond) { __builtin_amdgcn_s_sleep(1); \
    if ((++_sp & 255u) == 0u) { if (xb_ld(&(bar)[XB_TMO])) break; if (_sp > XB_SPIN_CAP) { atomicAdd(&(bar)[XB_TMO], 1u); break; } } } } while (0)

DI void xcd_barrier(unsigned* bar, const unsigned x, const unsigned nloc, const unsigned nx) {
  asm volatile("s_waitcnt vmcnt(0)" ::: "memory");
  __syncthreads();
  if (TID() == 0) {
    __builtin_amdgcn_s_waitcnt(0);
    const unsigned old = xb_add(&bar[XB_XSUB(x)], 1u);
    const unsigned gen = old / nloc;
    if (old + 1u == (gen + 1u) * nloc) {
      __builtin_amdgcn_fence(__ATOMIC_RELEASE, "agent");
      asm volatile("s_waitcnt vmcnt(0)" ::: "memory");
      const unsigned og = xb_add(&bar[XB_TOP], 1u);
      const unsigned tg = og / nx;
      if (og + 1u == (tg + 1u) * nx) xb_add(&bar[XB_TOPGEN], 1u);
      else XB_SPIN(xb_ld(&bar[XB_TOPGEN]) == tg, bar);
      __builtin_amdgcn_fence(__ATOMIC_ACQUIRE, "agent");
      xb_add(&bar[XB_XGEN(x)], 1u);
      asm volatile("s_waitcnt vmcnt(0)" ::: "memory");
    } else {
      XB_SPIN(xb_ld(&bar[XB_XGEN(x)]) == gen, bar);
      __builtin_amdgcn_fence(__ATOMIC_ACQUIRE, "agent");
      asm volatile("s_waitcnt vmcnt(0)" ::: "memory");
    }
  }
  __syncthreads();
}

__global__ void __launch_bounds__(256, 2) mega(Params p) {
  __shared__ __attribute__((aligned(16))) bf16_t lds[32768];
  cg::grid_group grid = cg::this_grid();
  const int nb = gridDim.x;
  bf16_t* wt = (bf16_t*)(p.ws + O_WT);
  bf16_t* z = (bf16_t*)(p.ws + O_Z);
  bf16_t* hbuf = (bf16_t*)(p.ws + O_VST);
  bf16_t* ubuf = z;
  bf16_t* p16 = (bf16_t*)(p.ws + O_KVD);
  float* rowpart = (float*)(p.ws + O_RP);
  bf16_t* hid = (bf16_t*)(p.ws + O_HID);
  const float* bias = (const float*)(p.ws + O_BIAS);

  unsigned* bar = (unsigned*)(p.ws + O_BAR);
  const unsigned xb_x = xb_xcc_id();
  if (TID() == 0) (void)xb_add(&bar[XB_XCNT(xb_x)], 1u);
  unsigned xb_nloc = 1u, xb_nx = 1u;

  for (int layer = 0; layer < 2; ++layer) {
    const bf16_t* wl = wt;
    const float* xin = (layer == 0) ? p.x : p.out;

    phase0(p, layer);
    norm_phase(xin, p.norm_mix + layer * DM, hbuf);
    if (layer == 0) {
      grid.sync();
      unsigned mine = 0u, cnt = 0u;
#pragma unroll
      for (unsigned j = 0; j < 16; ++j) {
        const unsigned c = xb_ld(&bar[XB_XCNT(j)]);
        cnt += (c > 0u) ? 1u : 0u;
        mine = (j == xb_x) ? c : mine;
      }
      xb_nloc = __builtin_amdgcn_readfirstlane(mine > 0u ? mine : 1u);
      xb_nx = __builtin_amdgcn_readfirstlane(cnt > 0u ? cnt : 1u);
    } else {
      xcd_barrier(bar, xb_x, xb_nloc, xb_nx);
    }

    GEMM_TILE_LOOP(43) {
      const int m0 = mt * 128, n0 = ntile * 128;
      f32x4 acc[4][4];
      zero_acc(acc);
      gemm_accum(acc, RowPtr{hbuf + (size_t)m0 * DM, DM}, RowPtr{wl + W_IN + (size_t)n0 * 1024, 1024}, 16, lds);
      gemm_epi_staged(acc, m0, n0, lds, [&](int, int, f32x4&) {}, z, ZS, ZS);
    }
    xcd_barrier(bar, xb_x, xb_nloc, xb_nx);

    post_z(p, layer);
    xcd_barrier(bar, xb_x, xb_nloc, xb_nx);

    for (int t = (blockIdx.x < 128) ? (int)blockIdx.x : (int)blockIdx.x; t < 128 + 1024; t += (t < 128) ? 2048 : (nb - 128)) {
      f32x4 acc[4][4];
      zero_acc(acc);
      if (t < 128) {
        const int kv = t >> 6, mt = (t >> 1) & 31, ntile = t & 1;
        const int m0 = mt * 128, n0 = ntile * 128;
        const bf16_t* kvd = (const bf16_t*)(p.ws + O_KVD) + (size_t)kv * 8 * SEQ * 64;
        auto ap = [&](int r, int kb) -> const bf16_t* {
          int row = m0 + r;
          int bg = row >> 9, c = row & 511;
          int tk = 16 * c + kb;
          tk = tk > (SEQ - 1) ? (SEQ - 1) : tk;
          return kvd + ((size_t)(bg * SEQ + tk)) * 64;
        };
        gemm_accum(acc, ap, RowPtr{wl + (kv ? W_C1V : W_C1K) + (size_t)n0 * 2048, 2048}, 32, lds);
        const float* bs = bias + kv * 256;
        bf16_t* hd = hid + (size_t)kv * 4096 * 256;
        gemm_epi(acc, m0, n0, [&](int m, int n, f32x4& a) {
          float o[4];
#pragma unroll
          for (int j = 0; j < 4; ++j) {
            float xv = a[j] + bs[n + j];
            float y = 0.7978845608028654f * (xv + 0.044715f * xv * xv * xv);
            float th = 1.f - 2.f / (__expf(2.f * y) + 1.f);
            o[j] = 0.5f * xv * (1.f + th);
          }
          uint2 u;
          u.x = pack2(o[0], o[1]);
          u.y = pack2(o[2], o[3]);
          *(uint2*)(hd + (size_t)m * 256 + n) = u;
        });
      } else {
        const int idx = t - 128;
        const int c = idx & 63, bh = idx >> 6;
        const bf16_t* rvT = (const bf16_t*)(p.ws + O_RVT) + ((size_t)bh * 128) * TS + c * 128;
        const bf16_t* kzT = (const bf16_t*)(p.ws + O_KZT) + ((size_t)bh * 128) * TS + c * 128;
        gemm_accum(acc, RowPtr{rvT, TS}, RowPtr{kzT, TS}, 2, lds);
        bf16_t* dst = z + ((size_t)((bh >> 2) * SEQ + c * 128)) * ZS + C_RV + (bh & 3) * 128;
        gemm_epi_staged(acc, 0, 0, lds, [&](int, int, f32x4&) {}, dst, ZS, 128);
      }
    }
    xcd_barrier(bar, xb_x, xb_nloc, xb_nx);

    phase4b(p, layer);
    {
      const float* pl = p.p + (size_t)layer * T_TOK * 256;
      const int gtid = blockIdx.x * 256 + TID();
      const int gthreads = nb * 256;
      for (int i = gtid; i < T_TOK * 32; i += gthreads) {
        float4 a = ((const float4*)pl)[2 * i], b2 = ((const float4*)pl)[2 * i + 1];
        ((uint4*)p16)[i] = make_uint4(pack2(a.x, a.y), pack2(a.z, a.w), pack2(b2.x, b2.y), pack2(b2.z, b2.w));
      }
    }
    xcd_barrier(bar, xb_x, xb_nloc, xb_nx);

    float nsa_c;
    {
      const int ln = TID() & 63;
      float gq = fabsf(p.nsa_q_norm[layer * 64 + ln]), gk = fabsf(p.nsa_k_norm[layer * 64 + ln]);
#pragma unroll
      for (int o = 32; o > 0; o >>= 1) {
        gq = fmaxf(gq, shx(gq, o, ln));
        gk = fmaxf(gk, shx(gk, o, ln));
      }
      nsa_c = 8.f * gq * gk;
    }
    const bool nsa_fx = nsa_c < 30.f;
    const float nsa_cl = nsa_c * 1.4426950408889634f;
    for (int t = blockIdx.x; t < 2048; t += nb) {
      if (t < 1024) {
        const int tile = (t < 512) ? 127 - (t >> 3) : ((t - 512) >> 3), bg = t & 7;
        if (nsa_fx) nsa_tile<true>(p, bg >> 1, bg & 1, tile, lds, nsa_cl);
        else nsa_tile<false>(p, bg >> 1, bg & 1, tile, lds, 0.f);
      } else {
        const int idx = t - 1024;
        ret_tile(p, idx >> 8, (idx >> 6) & 3, idx & 63, lds);
      }
    }
    xcd_barrier(bar, xb_x, xb_nloc, xb_nx);

    GEMM_TILE_LOOP(8) {
      const int m0 = mt * 128, n0 = ntile * 128;
      f32x4 acc[4][4];
      zero_acc(acc);
      gemm_accum(acc, RowPtr{(const bf16_t*)(p.ws + O_ONSA) + (size_t)m0 * 512, 512}, RowPtr{wl + W_UPA + (size_t)n0 * 512, 512}, 8, lds);
      gemm_epi(acc, m0, n0, [&](int m, int n, f32x4& a) {
        uint2 ua = *(const uint2*)(z + (size_t)m * ZS + C_MA + n);
        uint2 ub = *(const uint2*)(z + (size_t)m * ZS + C_MB + n);
        a[0] *= sigmoidf(bflo(ua.x)) / sigmoidf(bflo(ub.x));
        a[1] *= sigmoidf(bfhi(ua.x)) / sigmoidf(bfhi(ub.x));
        a[2] *= sigmoidf(bflo(ua.y)) / sigmoidf(bflo(ub.y));
        a[3] *= sigmoidf(bfhi(ua.y)) / sigmoidf(bfhi(ub.y));
      });
      gemm_accum(acc, RowPtr{z + (size_t)m0 * ZS + C_RQ, ZS}, RowPtr{wl + W_UPR + (size_t)n0 * 512, 512}, 8, lds);
      gemm_epi_staged(acc, m0, n0, lds, [&](int m, int n, f32x4& a) {
        uint2 ub = *(const uint2*)(z + (size_t)m * ZS + C_MB + n);
        a[0] *= sigmoidf(bflo(ub.x)); a[1] *= sigmoidf(bfhi(ub.x));
        a[2] *= sigmoidf(bflo(ub.y)); a[3] *= sigmoidf(bfhi(ub.y));
      }, z + C_RK, ZS, 1024);
    }
    xcd_barrier(bar, xb_x, xb_nloc, xb_nx);

    GEMM_TILE_LOOP(8) {
      const int m0 = mt * 128, n0 = ntile * 128;
      f32x4 acc[4][4];
      zero_acc(acc);
      gemm_accum(acc, RowPtr{z + (size_t)m0 * ZS + C_RK, ZS}, RowPtr{wl + W_OUT + (size_t)n0 * 1024, 1024}, 16, lds);
      gemm_epi_resid(acc, m0, n0, ntile, lds, xin, p.out, hbuf, rowpart);
    }
    xcd_barrier(bar, xb_x, xb_nloc, xb_nx);

    GEMM_TILE_LOOP(32) {
      const int m0 = mt * 128, n0 = ntile * 128;
      f32x4 acc[4][4];
      zero_acc(acc);
      float rsv[4];
      row_rs(rsv, rowpart, m0);
      gemm_accum(acc, RowPtr{hbuf + (size_t)m0 * DM, DM}, RowPtr{wl + W_FF1 + (size_t)n0 * 1024, 1024}, 16, lds);
      scale_rows(acc, rsv);
      gemm_epi_staged(acc, m0, n0, lds, [&](int, int, f32x4& a) {
        float r0 = fmaxf(a[0], 0.f), r1 = fmaxf(a[1], 0.f), r2 = fmaxf(a[2], 0.f), r3 = fmaxf(a[3], 0.f);
        a[0] = r0 * r0; a[1] = r1 * r1; a[2] = r2 * r2; a[3] = r3 * r3;
      }, ubuf, 4096, 4096);
    }
    xcd_barrier(bar, xb_x, xb_nloc, xb_nx);

    GEMM_TILE_LOOP(8) {
      const int m0 = mt * 128, n0 = ntile * 128;
      f32x4 acc[4][4];
      zero_acc(acc);
      gemm_accum(acc, RowPtr{ubuf + (size_t)m0 * 4096, 4096}, RowPtr{wl + W_FF2 + (size_t)n0 * 4096, 4096}, 64, lds);
      gemm_epi_resid(acc, m0, n0, ntile, lds, p.out, p.out, hbuf, rowpart);
    }
    xcd_barrier(bar, xb_x, xb_nloc, xb_nx);

    GEMM_TILE_LOOP(8) {
      const int m0 = mt * 128, n0 = ntile * 128;
      f32x4 acc[4][4];
      zero_acc(acc);
      gemm_accum(acc, RowPtr{p16 + (size_t)m0 * 256, 256}, RowPtr{wl + W_PLE + (size_t)n0 * 256, 256}, 4, lds);
      bf16_t* ppb = z + (size_t)T_TOK * 256;
      gemm_epi_staged(acc, m0, n0, lds, [&](int, int, f32x4&) {}, ppb, DM, 1024);
      zero_acc(acc);
      float rsv[4];
      row_rs(rsv, rowpart, m0);
      gemm_accum(acc, RowPtr{hbuf + (size_t)m0 * DM, DM}, RowPtr{wl + W_PG + (size_t)n0 * 1024, 1024}, 16, lds);
      scale_rows(acc, rsv);
      gemm_epi(acc, m0, n0, [&](int m, int n, f32x4& a) {
        uint2 pv = *(const uint2*)(ppb + (size_t)m * DM + n);
        float4* o = (float4*)(p.out + (size_t)m * DM + n);
        float4 xv = *o;
        *o = make_float4(xv.x + sigmoidf(a[0]) * bflo(pv.x), xv.y + sigmoidf(a[1]) * bfhi(pv.x),
                         xv.z + sigmoidf(a[2]) * bflo(pv.y), xv.w + sigmoidf(a[3]) * bfhi(pv.y));
      });
    }
    xcd_barrier(bar, xb_x, xb_nloc, xb_nx);
  }
}

extern "C" void kernel_launch(void* const* d_in, const int* in_sizes, int n_in,
                              void* d_out, int out_size, void* d_ws, size_t ws_size,
                              hipStream_t stream) {
  static int grid_blocks = 0;
  if (!grid_blocks) {
    int dev = 0, cus = 0, per_cu = 0;
    hipGetDevice(&dev);
    hipDeviceGetAttribute(&cus, hipDeviceAttributeMultiprocessorCount, dev);
    hipOccupancyMaxActiveBlocksPerMultiprocessor(&per_cu, mega, 256, 0);
    if (per_cu > 2) per_cu = 2;
    if (per_cu < 1) per_cu = 1;
    grid_blocks = cus * per_cu;
  }
  if (ws_size < WS_NEED) {
    fprintf(stderr, "workspace too small: %zu < %llu\n", ws_size, (unsigned long long)WS_NEED);
    return;
  }
  Params p{};
  p.x = (const float*)d_in[0]; p.p = (const float*)d_in[1]; p.norm_mix = (const float*)d_in[2]; p.w_in = (const float*)d_in[3];
  p.nsa_q_norm = (const float*)d_in[4]; p.nsa_k_norm = (const float*)d_in[5]; p.cmp_pos_k = (const float*)d_in[6];
  p.cmp_pos_v = (const float*)d_in[7]; p.cmp_w1_k = (const float*)d_in[8]; p.cmp_w2_k = (const float*)d_in[9];
  p.cmp_w1_v = (const float*)d_in[10]; p.cmp_w2_v = (const float*)d_in[11]; p.w_up_nsa = (const float*)d_in[12];
  p.w_up_ret = (const float*)d_in[13]; p.w_out = (const float*)d_in[14]; p.norm_mlp = (const float*)d_in[15];
  p.w_ff1 = (const float*)d_in[16]; p.w_ff2 = (const float*)d_in[17]; p.norm_ple = (const float*)d_in[18];
  p.w_ple = (const float*)d_in[19]; p.w_ple_gate = (const float*)d_in[20];
  p.out = (float*)d_out; p.ws = (char*)d_ws;
  hipMemsetAsync((char*)d_ws + O_BAR, 0, BAR_BYTES, stream);
  void* args[] = {&p};
  hipError_t e = hipLaunchCooperativeKernel((void*)mega, dim3(grid_blocks), dim3(256), args, 0, stream);
  if (e != hipSuccess) fprintf(stderr, "cooperative launch failed: %s (grid %d)\n", hipGetErrorString(e), grid_blocks);
}
```

```cpp
#include <hip/hip_runtime.h>
#include <hip/hip_cooperative_groups.h>
#include <cstdio>
#include <cstdint>
namespace cg = cooperative_groups;

typedef __attribute__((ext_vector_type(8))) short bf16x8;
typedef __attribute__((ext_vector_type(4))) float f32x4;
typedef unsigned short bf16_t;
typedef __attribute__((ext_vector_type(4))) unsigned u32x4;
#define DI __device__ __forceinline__

#define T_TOK 32768
#define SEQ 8192
#define DM 1024
#define ZS 5400
#define C_Q 0
#define C_KC 512
#define C_VC 640
#define C_KS 768
#define C_VS 896
#define C_KW 1024
#define C_VW 1152
#define C_GT 1280
#define C_RQ 1304
#define C_RK 1816
#define C_RV 2328
#define C_RG 2840
#define C_MA 3352
#define C_MB 4376
#define NPAD_IN 5504
#define TS 8256

#define W_IN 0
#define W_C1K 5636096
#define W_C1V 6160384
#define W_UPA 6684672
#define W_UPR 7208960
#define W_OUT 7733248
#define W_FF1 8781824
#define W_FF2 12976128
#define W_PLE 17170432
#define W_PG 17432576
#define W_LAYER 18481152

#define O_WT 0ull
#define O_ROPE 36962304ull
#define O_BIAS 41156608ull
#define O_HID 41160704ull
#define O_KCMP 45355008ull
#define O_VCMPT 45879296ull
#define O_VST 46403584ull
#define O_VWT 54857728ull
#define O_RVT 63311872ull
#define O_KZT 97128448ull
#define O_Z 130945024ull
#define O_ONSA 484839424ull
#define O_BAR 518393856ull
#define BAR_BYTES 13824
#define O_KVD 518407680ull
#define O_RP 535184896ull
#define WS_NEED 536233472ull
#define DYN_LDS 131072

struct Params {
  const float* x; const float* p; const float* norm_mix; const float* w_in;
  const float* nsa_q_norm; const float* nsa_k_norm; const float* cmp_pos_k; const float* cmp_pos_v;
  const float* cmp_w1_k; const float* cmp_w2_k; const float* cmp_w1_v; const float* cmp_w2_v;
  const float* w_up_nsa; const float* w_up_ret; const float* w_out; const float* norm_mlp;
  const float* w_ff1; const float* w_ff2; const float* norm_ple; const float* w_ple; const float* w_ple_gate;
  float* out; char* ws;
};

DI unsigned pack2(float a, float b) {
  typedef __attribute__((ext_vector_type(2))) __bf16 bf2;
  typedef __attribute__((ext_vector_type(2))) float f2;
  f2 v = {a, b};
  bf2 r = __builtin_convertvector(v, bf2);
  return __builtin_bit_cast(unsigned, r);
}
DI bf16_t f2bf(float a) { return (bf16_t)(pack2(a, 0.f) & 0xffffu); }
DI float bf2f(bf16_t h) { return __uint_as_float(((unsigned)h) << 16); }
DI float bflo(unsigned u) { return __uint_as_float(u << 16); }
DI float bfhi(unsigned u) { return __uint_as_float(u & 0xffff0000u); }
DI float shx(float v, int mask, int lane) {
  return __int_as_float(__builtin_amdgcn_ds_bpermute((lane ^ mask) << 2, __float_as_int(v)));
}
DI uint32_t shxu(uint32_t v, int mask, int lane) {
  return (uint32_t)__builtin_amdgcn_ds_bpermute((lane ^ mask) << 2, (int)v);
}
DI float shfrom(float v, int srclane) {
  return __int_as_float(__builtin_amdgcn_ds_bpermute(srclane << 2, __float_as_int(v)));
}
DI float wave_sum(float v, int lane) {
#pragma unroll
  for (int o = 32; o > 0; o >>= 1) v += shx(v, o, lane);
  return v;
}
DI int TID() { int t = threadIdx.x & 255; asm volatile("" : "+v"(t)); return t; }
DI int HALF() { return __builtin_amdgcn_readfirstlane((int)(threadIdx.x >> 8)); }
#define VBID ((int)(blockIdx.x * 2) + HALF())
#define NVB ((int)(gridDim.x * 2))
DI float sigmoidf(float x) { return 1.f / (1.f + __expf(-x)); }
DI f32x4 mfma16(bf16x8 a, bf16x8 b, f32x4 c) { return __builtin_amdgcn_mfma_f32_16x16x32_bf16(a, b, c, 0, 0, 0); }
DI bf16x8 mk8(unsigned a, unsigned b, unsigned c, unsigned d) {
  uint4 u = make_uint4(a, b, c, d);
  return __builtin_bit_cast(bf16x8, u);
}

template <class AP, class BP>
DI void g_load(u32x4 (&ra)[4], u32x4 (&rb)[4], const AP& ap, const BP& bp, int kb, int lrow, int lch) {
#pragma unroll
  for (int i = 0; i < 4; ++i) {
    ra[i] = *(const u32x4*)(ap(lrow + 32 * i, kb) + lch * 8);
    rb[i] = *(const u32x4*)(bp(lrow + 32 * i, kb) + lch * 8);
  }
}
DI void g_store(bf16_t* As, bf16_t* Bs, const u32x4 (&ra)[4], const u32x4 (&rb)[4], int buf, int lrow, int lch) {
#pragma unroll
  for (int i = 0; i < 4; ++i) {
    int r = lrow + 32 * i;
    int off = buf * 8192 + r * 64 + ((lch ^ ((r >> 1) & 7)) << 3);
    *(u32x4*)(As + off) = ra[i];
    *(u32x4*)(Bs + off) = rb[i];
  }
}
DI void g_compute(f32x4 (&acc)[4][4], const bf16_t* a, const bf16_t* b, int wm, int wn, int lane) {
  bf16x8 af[2][4], bfr[2][4];
#pragma unroll
  for (int ks = 0; ks < 2; ++ks)
#pragma unroll
    for (int i = 0; i < 4; ++i) {
      int r = wm * 64 + i * 16 + (lane & 15);
      af[ks][i] = *(const bf16x8*)(a + r * 64 + (((ks * 4 + (lane >> 4)) ^ ((r >> 1) & 7)) << 3));
      int r2 = wn * 64 + i * 16 + (lane & 15);
      bfr[ks][i] = *(const bf16x8*)(b + r2 * 64 + (((ks * 4 + (lane >> 4)) ^ ((r2 >> 1) & 7)) << 3));
    }
  __builtin_amdgcn_s_setprio(1);
#pragma unroll
  for (int ks = 0; ks < 2; ++ks)
#pragma unroll
    for (int i = 0; i < 4; ++i)
#pragma unroll
      for (int j = 0; j < 4; ++j) acc[i][j] = mfma16(bfr[ks][j], af[ks][i], acc[i][j]);
  __builtin_amdgcn_s_setprio(0);
}
template <class AP, class BP>
DI void gemm_accum(f32x4 (&acc)[4][4], AP ap, BP bp, int nkb, bf16_t* lds) {
  const int tid = TID(), lane = tid & 63, w = tid >> 6;
  const int wm = w >> 1, wn = w & 1;
  const int lrow = tid >> 3, lch = tid & 7;
  bf16_t* As = lds;
  bf16_t* Bs = lds + 16384;
  u32x4 ra0[4], rb0[4], ra1[4], rb1[4];
  __syncthreads();
  g_load(ra0, rb0, ap, bp, 0, lrow, lch);
  g_load(ra1, rb1, ap, bp, 1, lrow, lch);
  g_store(As, Bs, ra0, rb0, 0, lrow, lch);
  __syncthreads();
  for (int kb = 0; kb < nkb; kb += 2) {
    const int k2 = (kb + 2 < nkb) ? kb + 2 : nkb - 2;
    g_load(ra0, rb0, ap, bp, k2, lrow, lch);
    __builtin_amdgcn_sched_barrier(0);
    g_compute(acc, As, Bs, wm, wn, lane);
    g_store(As, Bs, ra1, rb1, 1, lrow, lch);
    __syncthreads();
    g_load(ra1, rb1, ap, bp, k2 + 1, lrow, lch);
    __builtin_amdgcn_sched_barrier(0);
    g_compute(acc, As + 8192, Bs + 8192, wm, wn, lane);
    g_store(As, Bs, ra0, rb0, 0, lrow, lch);
    __syncthreads();
  }
}
template <class E>
DI void gemm_epi(f32x4 (&acc)[4][4], int m0, int n0, E e) {
  const int tid_ = TID();
  const int lane = tid_ & 63, w = tid_ >> 6;
  const int wm = w >> 1, wn = w & 1;
#pragma unroll
  for (int i = 0; i < 4; ++i)
#pragma unroll
    for (int j = 0; j < 4; ++j) {
      int m = m0 + wm * 64 + i * 16 + (lane & 15);
      int n = n0 + wn * 64 + j * 16 + (lane >> 4) * 4;
      e(m, n, acc[i][j]);
    }
}
template <class F>
DI void gemm_epi_staged(f32x4 (&acc)[4][4], int m0, int n0, bf16_t* lds, F f, bf16_t* dst, size_t ld, int nmax) {
  const int tid_ = TID();
  const int lane = tid_ & 63, w = tid_ >> 6;
  const int wm = w >> 1, wn = w & 1;
#pragma unroll
  for (int i = 0; i < 4; ++i)
#pragma unroll
    for (int j = 0; j < 4; ++j) {
      const int ml = wm * 64 + i * 16 + (lane & 15);
      const int nl = wn * 64 + j * 16 + (lane >> 4) * 4;
      f32x4 a = acc[i][j];
      f(m0 + ml, n0 + nl, a);
      uint2 u;
      u.x = pack2(a[0], a[1]);
      u.y = pack2(a[2], a[3]);
      *(uint2*)(lds + ml * 136 + nl) = u;
    }
  __syncthreads();
#pragma unroll
  for (int it = 0; it < 8; ++it) {
    const int idx = tid_ + 256 * it;
    const int row = idx >> 4, ch = idx & 15;
    const u32x4 v = *(const u32x4*)(lds + row * 136 + ch * 8);
    const int n = n0 + ch * 8;
    if (n < nmax) *(u32x4*)(dst + (size_t)(m0 + row) * ld + n) = v;
  }
}
DI void gemm_epi_resid(f32x4 (&acc)[4][4], int m0, int n0, int ntile, bf16_t* lds, const float* xin, float* out, bf16_t* xb, float* rowpart) {
  const int tid_ = TID();
  const int lane = tid_ & 63, w = tid_ >> 6;
  const int wm = w >> 1, wn = w & 1;
  float* red = (float*)lds;
#pragma unroll
  for (int i = 0; i < 4; ++i) {
    const int ml = wm * 64 + i * 16 + (lane & 15);
    const size_t rowoff = (size_t)(m0 + ml) * DM;
    float ss = 0.f;
#pragma unroll
    for (int j = 0; j < 4; ++j) {
      const int n = n0 + wn * 64 + j * 16 + (lane >> 4) * 4;
      const float4 xv = *(const float4*)(xin + rowoff + n);
      const float o0 = xv.x + acc[i][j][0], o1 = xv.y + acc[i][j][1], o2 = xv.z + acc[i][j][2], o3 = xv.w + acc[i][j][3];
      *(float4*)(out + rowoff + n) = make_float4(o0, o1, o2, o3);
      ss += o0 * o0 + o1 * o1 + o2 * o2 + o3 * o3;
      uint2 u;
      u.x = pack2(o0, o1);
      u.y = pack2(o2, o3);
      *(uint2*)(xb + rowoff + n) = u;
    }
    ss += shx(ss, 16, lane);
    ss += shx(ss, 32, lane);
    if ((lane >> 4) == 0) red[wn * 128 + ml] = ss;
  }
  __syncthreads();
  if (tid_ < 128) rowpart[(size_t)ntile * T_TOK + m0 + tid_] = red[tid_] + red[128 + tid_];
}
DI void row_rs(float (&rsv)[4], const float* rowpart, int m0) {
  const int tid_ = TID();
  const int lane = tid_ & 63, wm = tid_ >> 7;
#pragma unroll
  for (int i = 0; i < 4; ++i) {
    const int m = m0 + wm * 64 + i * 16 + (lane & 15);
    float s = 0.f;
#pragma unroll
    for (int t = 0; t < 8; ++t) s += rowpart[(size_t)t * T_TOK + m];
    rsv[i] = rsqrtf(s * (1.f / 1024.f) + 1e-6f);
  }
}
DI void scale_rows(f32x4 (&acc)[4][4], const float (&rsv)[4]) {
#pragma unroll
  for (int i = 0; i < 4; ++i)
#pragma unroll
    for (int j = 0; j < 4; ++j) acc[i][j] *= rsv[i];
}
DI void zero_acc(f32x4 (&acc)[4][4]) {
#pragma unroll
  for (int i = 0; i < 4; ++i)
#pragma unroll
    for (int j = 0; j < 4; ++j) acc[i][j] = f32x4{0.f, 0.f, 0.f, 0.f};
}
struct RowPtr {
  const bf16_t* base; size_t ld;
  DI const bf16_t* operator()(int r, int kb) const { return base + (size_t)r * ld + kb * 64; }
};

DI void convert_wt(const float* W, bf16_t* Wt, int K, int N, int Npad, int gtid, int gthreads, const float* gk = nullptr) {
  const int k8n = K >> 3;
  const long total = (long)Npad * k8n;
  for (long idx = gtid; idx < total; idx += gthreads) {
    int n = (int)(idx % Npad);
    int k8 = (int)(idx / Npad);
    uint4 o = make_uint4(0, 0, 0, 0);
    if (n < N) {
      const float* s = W + (size_t)(k8 * 8) * N + n;
      float v0 = s[0], v1 = s[(size_t)N], v2 = s[(size_t)2 * N], v3 = s[(size_t)3 * N];
      float v4 = s[(size_t)4 * N], v5 = s[(size_t)5 * N], v6 = s[(size_t)6 * N], v7 = s[(size_t)7 * N];
      if (gk) {
        const float* gp = gk + k8 * 8;
        v0 *= gp[0]; v1 *= gp[1]; v2 *= gp[2]; v3 *= gp[3]; v4 *= gp[4]; v5 *= gp[5]; v6 *= gp[6]; v7 *= gp[7];
      }
      o = make_uint4(pack2(v0, v1), pack2(v2, v3), pack2(v4, v5), pack2(v6, v7));
    }
    *(uint4*)(Wt + (size_t)n * K + k8 * 8) = o;
  }
}

DI void phase0(const Params& p, const int L) {
  const int gtid = VBID * 256 + TID();
  const int gthreads = NVB * 256;
  bf16_t* wl = (bf16_t*)(p.ws + O_WT);
  convert_wt(p.w_in + (size_t)L * 1024 * 5400, wl + W_IN, 1024, 5400, NPAD_IN, gtid, gthreads);
  convert_wt(p.cmp_w1_k + (size_t)L * 2048 * 256, wl + W_C1K, 2048, 256, 256, gtid, gthreads);
  convert_wt(p.cmp_w1_v + (size_t)L * 2048 * 256, wl + W_C1V, 2048, 256, 256, gtid, gthreads);
  convert_wt(p.w_up_nsa + (size_t)L * 512 * 1024, wl + W_UPA, 512, 1024, 1024, gtid, gthreads);
  convert_wt(p.w_up_ret + (size_t)L * 512 * 1024, wl + W_UPR, 512, 1024, 1024, gtid, gthreads);
  convert_wt(p.w_out + (size_t)L * 1024 * 1024, wl + W_OUT, 1024, 1024, 1024, gtid, gthreads);
  convert_wt(p.w_ff1 + (size_t)L * 1024 * 4096, wl + W_FF1, 1024, 4096, 4096, gtid, gthreads, p.norm_mlp + L * DM);
  convert_wt(p.w_ff2 + (size_t)L * 4096 * 1024, wl + W_FF2, 4096, 1024, 1024, gtid, gthreads);
  convert_wt(p.w_ple + (size_t)L * 256 * 1024, wl + W_PLE, 256, 1024, 1024, gtid, gthreads);
  convert_wt(p.w_ple_gate + (size_t)L * 1024 * 1024, wl + W_PG, 1024, 1024, 1024, gtid, gthreads, p.norm_ple + L * DM);
  if (L == 0) {
    float2* rope = (float2*)(p.ws + O_ROPE);
    for (int idx = gtid; idx < SEQ * 64; idx += gthreads) {
      int pos = idx >> 6, j = idx & 63;
      float inv = exp2f(-(float)j * (13.287712379549449f / 64.f));
      float ang = (float)pos * inv;
      double rev = (double)ang * 0.15915494309189535;
      rev -= rint(rev);
      float fr = (float)rev;
      rope[idx] = make_float2(__builtin_amdgcn_cosf(fr), __builtin_amdgcn_sinf(fr));
    }
  }
  float* part = (float*)(p.ws + O_HID);
  {
    const int n = gtid & 255;
    for (int item = VBID; item < 128; item += NVB) {
      const int kv = item >> 6, kc = item & 63;
      const float* pos = (kv ? p.cmp_pos_v : p.cmp_pos_k) + L * 2048 + kc * 32;
      const float* w1 = (kv ? p.cmp_w1_v : p.cmp_w1_k) + (size_t)L * 2048 * 256 + (size_t)kc * 32 * 256;
      float a = 0.f;
#pragma unroll 8
      for (int k = 0; k < 32; ++k) a += pos[k] * w1[(size_t)k * 256 + n];
      part[item * 256 + n] = a;
    }
  }
}

DI void norm_phase(const float* xin, const float* g, bf16_t* h) {
  const int tid_ = TID();
  const int lane = tid_ & 63;
  const int gw = (VBID * 256 + tid_) >> 6;
  const int nw = NVB * 4;
  float4 gv[4];
#pragma unroll
  for (int i = 0; i < 4; ++i) gv[i] = ((const float4*)g)[i * 64 + lane];
  for (int row = gw; row < T_TOK; row += nw) {
    const float4* xr = (const float4*)(xin + (size_t)row * DM);
    float4 v[4];
    float ss = 0.f;
#pragma unroll
    for (int i = 0; i < 4; ++i) {
      v[i] = xr[i * 64 + lane];
      ss += v[i].x * v[i].x + v[i].y * v[i].y + v[i].z * v[i].z + v[i].w * v[i].w;
    }
    ss = wave_sum(ss, lane);
    float rs = rsqrtf(ss * (1.f / 1024.f) + 1e-6f);
    uint2* hr = (uint2*)(h + (size_t)row * DM);
#pragma unroll
    for (int i = 0; i < 4; ++i) {
      uint2 o;
      o.x = pack2(v[i].x * rs * gv[i].x, v[i].y * rs * gv[i].y);
      o.y = pack2(v[i].z * rs * gv[i].z, v[i].w * rs * gv[i].w);
      hr[i * 64 + lane] = o;
    }
  }
}

DI void post_z(const Params& p, int layer) {
  const int tid_ = TID();
  const int lane = tid_ & 63;
  const int gw = (VBID * 256 + tid_) >> 6;
  const int nw = NVB * 4;
  bf16_t* z = (bf16_t*)(p.ws + O_Z);
  bf16_t* vsT = (bf16_t*)(p.ws + O_VST);
  bf16_t* vwT = (bf16_t*)(p.ws + O_VWT);
  bf16_t* rvT = (bf16_t*)(p.ws + O_RVT);
  bf16_t* kzT = (bf16_t*)(p.ws + O_KZT);
  const float2* rope = (const float2*)(p.ws + O_ROPE);
  const float* qn = p.nsa_q_norm + layer * 64;
  const float* kn = p.nsa_k_norm + layer * 64;
  {
    const float* part = (const float*)(p.ws + O_HID);
    float* bias = (float*)(p.ws + O_BIAS);
    const int idx = VBID * 256 + tid_;
    if (idx < 512) {
      const int kv = idx >> 8, n = idx & 255;
      float a = 0.f;
      for (int kc = 0; kc < 64; ++kc) a += part[(kv * 64 + kc) * 256 + n];
      bias[idx] = a;
    }
  }
  for (int item = gw; item < 1024 * 36; item += nw) {
    const int tc = item / 36, slab = item - tc * 36;
    const int tok0 = tc * 32;
    const int b = tok0 >> 13, spos = tok0 & 8191;
    bf16_t* zr = z + (size_t)tok0 * ZS;
    if (slab >= 32) {
      const int s4 = slab - 32, kv = s4 >> 1, gi = s4 & 1;
      const int colbase = (kv ? C_VC : C_KC) + gi * 64;
      bf16_t* dst = (bf16_t*)(p.ws + O_KVD) + ((size_t)((kv * 8 + b * 2 + gi) * SEQ + spos)) * 64 + lane;
      bf16_t u[32];
#pragma unroll
      for (int i = 0; i < 32; ++i) u[i] = zr[(size_t)i * ZS + colbase + lane];
#pragma unroll
      for (int i = 0; i < 32; ++i) dst[i * 64] = u[i];
    } else if (slab < 12) {
      int colbase; const float* g; float sc;
      if (slab < 8) { colbase = C_Q + slab * 64; g = qn; sc = 0.125f; }
      else if (slab < 10) { colbase = C_KS + (slab - 8) * 64; g = kn; sc = 1.f; }
      else { colbase = C_KW + (slab - 10) * 64; g = kn; sc = 1.f; }
      const float gv = g[lane] * sc;
      float v[32];
#pragma unroll
      for (int i = 0; i < 32; ++i) v[i] = bf2f(zr[(size_t)i * ZS + colbase + lane]);
#pragma unroll
      for (int i = 0; i < 32; ++i) {
        float ss = wave_sum(v[i] * v[i], lane);
        float rs = rsqrtf(ss * (1.f / 64.f) + 1e-6f);
        zr[(size_t)i * ZS + colbase + lane] = f2bf(v[i] * rs * gv);
      }
    } else if (slab < 16 || slab >= 24) {
      int colbase; bf16_t* dst;
      if (slab < 16) {
        const int gi = slab & 1;
        const bool isw = slab >= 14;
        colbase = (isw ? C_VW : C_VS) + gi * 64;
        dst = (isw ? vwT : vsT) + ((size_t)((b * 2 + gi) * 64 + lane)) * TS + spos;
      } else {
        const int s8 = slab - 24;
        const int h = s8 >> 1, half = s8 & 1;
        colbase = C_RV + s8 * 64;
        dst = rvT + ((size_t)((b * 4 + h) * 128 + half * 64 + lane)) * TS + spos;
      }
      unsigned u[32];
#pragma unroll
      for (int i = 0; i < 32; ++i) u[i] = zr[(size_t)i * ZS + colbase + lane];
#pragma unroll
      for (int q4 = 0; q4 < 4; ++q4)
        *(uint4*)(dst + q4 * 8) = make_uint4(u[q4 * 8 + 0] | (u[q4 * 8 + 1] << 16), u[q4 * 8 + 2] | (u[q4 * 8 + 3] << 16),
                                             u[q4 * 8 + 4] | (u[q4 * 8 + 5] << 16), u[q4 * 8 + 6] | (u[q4 * 8 + 7] << 16));
    } else if (slab < 20) {
      const int h = slab - 16;
      const int colbase = C_RQ + h * 128;
      float x1[32], x2[32];
#pragma unroll
      for (int i = 0; i < 32; ++i) {
        const bf16_t* p1 = zr + (size_t)i * ZS + colbase + lane;
        x1[i] = bf2f(p1[0]);
        x2[i] = bf2f(p1[64]);
      }
#pragma unroll
      for (int i = 0; i < 32; ++i) {
        bf16_t* p1 = zr + (size_t)i * ZS + colbase + lane;
        float2 cs = rope[(spos + i) * 64 + lane];
        p1[0] = f2bf(x1[i] * cs.x - x2[i] * cs.y);
        p1[64] = f2bf(x1[i] * cs.y + x2[i] * cs.x);
      }
    } else {
      const int h = slab - 20;
      const int colbase = C_RK + h * 128;
      const float lg2 = log2f(1.f - exp2f(-5.f - (float)h));
      float x1[32], x2[32];
#pragma unroll
      for (int i = 0; i < 32; ++i) {
        const bf16_t* p1 = zr + (size_t)i * ZS + colbase + lane;
        x1[i] = bf2f(p1[0]);
        x2[i] = bf2f(p1[64]);
      }
      unsigned u1[32], u2[32];
#pragma unroll
      for (int i = 0; i < 32; ++i) {
        bf16_t* p1 = zr + (size_t)i * ZS + colbase + lane;
        float2 cs = rope[(spos + i) * 64 + lane];
        float o1 = (x1[i] * cs.x - x2[i] * cs.y) * 0.08838834764831845f;
        float o2 = (x1[i] * cs.y + x2[i] * cs.x) * 0.08838834764831845f;
        p1[0] = f2bf(o1);
        p1[64] = f2bf(o2);
        float zeta = exp2f(lg2 * (float)(127 - ((spos + i) & 127)));
        u1[i] = f2bf(o1 * zeta);
        u2[i] = f2bf(o2 * zeta);
      }
      bf16_t* d1 = kzT + ((size_t)((b * 4 + h) * 128 + lane)) * TS + spos;
#pragma unroll
      for (int q4 = 0; q4 < 4; ++q4) {
        *(uint4*)(d1 + q4 * 8) = make_uint4(u1[q4 * 8 + 0] | (u1[q4 * 8 + 1] << 16), u1[q4 * 8 + 2] | (u1[q4 * 8 + 3] << 16),
                                            u1[q4 * 8 + 4] | (u1[q4 * 8 + 5] << 16), u1[q4 * 8 + 6] | (u1[q4 * 8 + 7] << 16));
        *(uint4*)(d1 + (size_t)64 * TS + q4 * 8) = make_uint4(u2[q4 * 8 + 0] | (u2[q4 * 8 + 1] << 16), u2[q4 * 8 + 2] | (u2[q4 * 8 + 3] << 16),
                                                              u2[q4 * 8 + 4] | (u2[q4 * 8 + 5] << 16), u2[q4 * 8 + 6] | (u2[q4 * 8 + 7] << 16));
      }
    }
  }
}

DI void phase4b(const Params& p, int layer) {
  const int tid_ = TID();
  const int lane = tid_ & 63;
  const int gw = (VBID * 256 + tid_) >> 6;
  const int nw = NVB * 4;
  bf16_t* z = (bf16_t*)(p.ws + O_Z);
  const bf16_t* hid = (const bf16_t*)(p.ws + O_HID);
  bf16_t* kcmp = (bf16_t*)(p.ws + O_KCMP);
  bf16_t* vcmpT = (bf16_t*)(p.ws + O_VCMPT);
  const float* kn = p.nsa_k_norm + layer * 64;
  for (int item = gw; item < 8192; item += nw) {
    const int kv = item >> 12, row = item & 4095;
    const bf16_t* hrow = hid + ((size_t)kv * 4096 + row) * 256;
    const float* w2 = (kv ? p.cmp_w2_v : p.cmp_w2_k) + (size_t)layer * 256 * 64;
    float acc = 0.f;
    for (int k8 = 0; k8 < 32; ++k8) {
      uint4 hv = *(const uint4*)(hrow + k8 * 8);
      const float* wr = w2 + (size_t)(k8 * 8) * 64 + lane;
      acc += bflo(hv.x) * wr[0];
      acc += bfhi(hv.x) * wr[64];
      acc += bflo(hv.y) * wr[128];
      acc += bfhi(hv.y) * wr[192];
      acc += bflo(hv.z) * wr[256];
      acc += bfhi(hv.z) * wr[320];
      acc += bflo(hv.w) * wr[384];
      acc += bfhi(hv.w) * wr[448];
    }
    if (kv == 0) {
      float ss = wave_sum(acc * acc, lane);
      float rs = rsqrtf(ss * (1.f / 64.f) + 1e-6f);
      kcmp[(size_t)row * 64 + lane] = f2bf(acc * rs * kn[lane]);
    } else {
      const int bg = row >> 9, c = row & 511;
      vcmpT[((size_t)(bg * 64 + lane)) * 512 + c] = f2bf(acc);
    }
  }
  const int gtid = VBID * 256 + tid_;
  const int gthreads = NVB * 256;
  for (int idx = gtid; idx < 65536; idx += gthreads) {
    const int d4 = idx & 31, e = (idx >> 5) & 127, h = (idx >> 12) & 3, b = idx >> 14;
    const float lg2 = log2f(1.f - exp2f(-5.f - (float)h));
    const float gch = exp2f(lg2 * 128.f);
    float r0 = 0.f, r1 = 0.f, r2 = 0.f, r3 = 0.f;
    bf16_t* ptr = z + ((size_t)(b * SEQ + e)) * ZS + C_RV + h * 128 + d4 * 4;
    for (int c0 = 0; c0 < 64; c0 += 16) {
      typedef __attribute__((ext_vector_type(2))) unsigned u32x2;
      u32x2 v[16];
#pragma unroll
      for (int i = 0; i < 16; ++i) v[i] = *(const u32x2*)(ptr + (size_t)(c0 + i) * 128 * ZS);
#pragma unroll
      for (int i = 0; i < 16; ++i) {
        u32x2 o;
        o.x = pack2(r0, r1);
        o.y = pack2(r2, r3);
        *(u32x2*)(ptr + (size_t)(c0 + i) * 128 * ZS) = o;
        r0 = gch * r0 + bflo(v[i].x);
        r1 = gch * r1 + bfhi(v[i].x);
        r2 = gch * r2 + bflo(v[i].y);
        r3 = gch * r3 + bfhi(v[i].y);
      }
    }
  }
}


DI void tile64_gload(int tid, u32x4& r0, u32x4& r1, const bf16_t* base, size_t stride) {
  {
    int idx = tid;
    int row = idx >> 3, ch = idx & 7;
    r0 = *(const u32x4*)(base + (size_t)row * stride + ch * 8);
  }
  {
    int idx = tid + 256;
    int row = idx >> 3, ch = idx & 7;
    r1 = *(const u32x4*)(base + (size_t)row * stride + ch * 8);
  }
}
DI void tile64_sstore(int tid, bf16_t* dst, const u32x4& r0, const u32x4& r1) {
  {
    int idx = tid;
    int row = idx >> 3, ch = idx & 7;
    *(u32x4*)(dst + row * 64 + ((ch ^ ((row >> 1) & 7)) << 3)) = r0;
  }
  {
    int idx = tid + 256;
    int row = idx >> 3, ch = idx & 7;
    *(u32x4*)(dst + row * 64 + ((ch ^ ((row >> 1) & 7)) << 3)) = r1;
  }
}

struct AttnSt { f32x4 O[2][4]; float m[2]; float l[2]; };

template <int MODE, bool FX>
DI void attn_compute(const int lane, const bf16_t* Ks, const bf16_t* Vs, const bf16x8 (&qf)[2][2], AttnSt& st, const float (&invl)[2],
                     int lo, int hi, float (&impA)[4], float (&impE)[4], const float CL) {
  const int quad = lane >> 4, col = lane & 15;
  f32x4 S[4][2];
#pragma unroll
  for (int kt = 0; kt < 4; ++kt)
#pragma unroll
    for (int hh = 0; hh < 2; ++hh) S[kt][hh] = f32x4{0.f, 0.f, 0.f, 0.f};
#pragma unroll
  for (int ks = 0; ks < 2; ++ks) {
#pragma unroll
    for (int kt = 0; kt < 4; ++kt) {
      int row = kt * 16 + col;
      bf16x8 kf = *(const bf16x8*)(Ks + row * 64 + (((ks * 4 + quad) ^ ((row >> 1) & 7)) << 3));
#pragma unroll
      for (int hh = 0; hh < 2; ++hh) S[kt][hh] = mfma16(kf, qf[hh][ks], S[kt][hh]);
    }
  }
  bf16x8 pf[2][2];
  const bool full = (lo <= 0) && (hi >= 63);
  const bool none = (hi < 0) || (lo > 63) || (hi < lo);
  if (__all(full || none)) {
    constexpr float L2E = 1.4426950408889634f;
#pragma unroll
    for (int hh = 0; hh < 2; ++hh) {
      float mL;
      float il = 1.f;
      if (FX) {
        mL = full ? CL : 1e30f;
        if (MODE == 1) il = invl[hh];
      } else if (MODE != 1) {
        float mx = -1e30f;
#pragma unroll
        for (int kt = 0; kt < 4; ++kt)
#pragma unroll
          for (int j = 0; j < 4; ++j) mx = fmaxf(mx, S[kt][hh][j]);
        mx = full ? mx : -1e30f;
        mx = fmaxf(mx, shx(mx, 16, lane));
        mx = fmaxf(mx, shx(mx, 32, lane));
        const float m_new = fmaxf(st.m[hh], mx);
        const float alpha = __expf(st.m[hh] - m_new);
        st.m[hh] = m_new;
        st.l[hh] *= alpha;
        if (MODE == 2) {
#pragma unroll
          for (int dt = 0; dt < 4; ++dt) st.O[hh][dt] *= alpha;
        }
        mL = full ? m_new * L2E : 1e30f;
      } else {
        mL = full ? st.m[hh] * L2E : 1e30f;
        il = invl[hh];
      }
      float rs = 0.f;
#pragma unroll
      for (int kt = 0; kt < 4; ++kt) {
        float a = 0.f;
#pragma unroll
        for (int j = 0; j < 4; ++j) {
          float pv = __builtin_amdgcn_exp2f(fmaf(S[kt][hh][j], L2E, -mL));
          if (MODE == 1) pv *= il;
          S[kt][hh][j] = pv;
          a += pv;
        }
        rs += a;
        if (MODE == 1) {
          impA[kt] += a;
          impE[kt] += S[kt][hh][3];
        }
      }
      if (MODE != 1) st.l[hh] += rs;
      if (MODE != 0) {
#pragma unroll
        for (int c = 0; c < 2; ++c)
          pf[hh][c] = mk8(pack2(S[2 * c][hh][0], S[2 * c][hh][1]), pack2(S[2 * c][hh][2], S[2 * c][hh][3]),
                          pack2(S[2 * c + 1][hh][0], S[2 * c + 1][hh][1]), pack2(S[2 * c + 1][hh][2], S[2 * c + 1][hh][3]));
      }
    }
  } else {
#pragma unroll
  for (int hh = 0; hh < 2; ++hh) {
    if (FX) {
      constexpr float L2E = 1.4426950408889634f;
      const float il = (MODE == 1) ? invl[hh] : 1.f;
      float rs = 0.f;
#pragma unroll
      for (int kt = 0; kt < 4; ++kt) {
        float a = 0.f;
#pragma unroll
        for (int j = 0; j < 4; ++j) {
          const int kl = kt * 16 + quad * 4 + j;
          const bool v = (kl >= lo) && (kl <= hi);
          float pv = v ? __builtin_amdgcn_exp2f(fmaf(S[kt][hh][j], L2E, -CL)) : 0.f;
          if (MODE == 1) pv *= il;
          S[kt][hh][j] = pv;
          a += pv;
        }
        rs += a;
        if (MODE == 1) {
          impA[kt] += a;
          impE[kt] += S[kt][hh][3];
        }
      }
      if (MODE != 1) st.l[hh] += rs;
      if (MODE != 0) {
#pragma unroll
        for (int c = 0; c < 2; ++c)
          pf[hh][c] = mk8(pack2(S[2 * c][hh][0], S[2 * c][hh][1]), pack2(S[2 * c][hh][2], S[2 * c][hh][3]),
                          pack2(S[2 * c + 1][hh][0], S[2 * c + 1][hh][1]), pack2(S[2 * c + 1][hh][2], S[2 * c + 1][hh][3]));
      }
      continue;
    }
    float mx = -1e30f;
#pragma unroll
    for (int kt = 0; kt < 4; ++kt)
#pragma unroll
      for (int j = 0; j < 4; ++j) {
        int kl = kt * 16 + quad * 4 + j;
        bool v = (kl >= lo) && (kl <= hi);
        float sv = v ? S[kt][hh][j] : -1e30f;
        S[kt][hh][j] = sv;
        mx = fmaxf(mx, sv);
      }
    if (MODE != 1) {
      mx = fmaxf(mx, shx(mx, 16, lane));
      mx = fmaxf(mx, shx(mx, 32, lane));
      float m_new = fmaxf(st.m[hh], mx);
      float alpha = __expf(st.m[hh] - m_new);
      st.m[hh] = m_new;
      float rs = 0.f;
#pragma unroll
      for (int kt = 0; kt < 4; ++kt)
#pragma unroll
        for (int j = 0; j < 4; ++j) {
          float sv = S[kt][hh][j];
          float pv = (sv > -1e29f) ? __expf(sv - m_new) : 0.f;
          rs += pv;
          S[kt][hh][j] = pv;
        }
      st.l[hh] = st.l[hh] * alpha + rs;
      if (MODE == 2) {
#pragma unroll
        for (int dt = 0; dt < 4; ++dt) st.O[hh][dt] *= alpha;
      }
    } else {
      const float mh = st.m[hh], il = invl[hh];
#pragma unroll
      for (int kt = 0; kt < 4; ++kt) {
        float a = 0.f;
#pragma unroll
        for (int j = 0; j < 4; ++j) {
          float sv = S[kt][hh][j];
          float pv = (sv > -1e29f) ? __expf(sv - mh) * il : 0.f;
          S[kt][hh][j] = pv;
          a += pv;
        }
        impA[kt] += a;
        impE[kt] += S[kt][hh][3];
      }
    }
    if (MODE != 0) {
#pragma unroll
      for (int c = 0; c < 2; ++c)
        pf[hh][c] = mk8(pack2(S[2 * c][hh][0], S[2 * c][hh][1]), pack2(S[2 * c][hh][2], S[2 * c][hh][3]),
                        pack2(S[2 * c + 1][hh][0], S[2 * c + 1][hh][1]), pack2(S[2 * c + 1][hh][2], S[2 * c + 1][hh][3]));
    }
  }
  }
  if (MODE != 0) {
#pragma unroll
    for (int dt = 0; dt < 4; ++dt) {
      const int row = dt * 16 + col;
      const int sw = (row >> 1) & 7;
#pragma unroll
      for (int c = 0; c < 2; ++c) {
        uint2 a = *(const uint2*)(Vs + row * 64 + (((4 * c + (quad >> 1)) ^ sw) << 3) + (quad & 1) * 4);
        uint2 b = *(const uint2*)(Vs + row * 64 + (((4 * c + 2 + (quad >> 1)) ^ sw) << 3) + (quad & 1) * 4);
        bf16x8 vf = mk8(a.x, a.y, b.x, b.y);
#pragma unroll
        for (int hh = 0; hh < 2; ++hh) st.O[hh][dt] = mfma16(vf, pf[hh][c], st.O[hh][dt]);
      }
    }
  }
}

DI void st_reset(AttnSt& st) {
#pragma unroll
  for (int h = 0; h < 2; ++h) {
    st.m[h] = -1e30f;
    st.l[h] = 0.f;
#pragma unroll
    for (int dt = 0; dt < 4; ++dt) st.O[h][dt] = f32x4{0.f, 0.f, 0.f, 0.f};
  }
}

template <bool FIRST>
DI void nsa_flush(const int quad, bf16_t* optr, const AttnSt& st, const float (&sc)[2]) {
#pragma unroll
  for (int h = 0; h < 2; ++h)
#pragma unroll
    for (int dt = 0; dt < 4; ++dt) {
      uint2* q = (uint2*)(optr + h * 64 + dt * 16 + quad * 4);
      f32x4 o = st.O[h][dt] * sc[h];
      if (!FIRST) {
        uint2 pv = *q;
        o[0] += bflo(pv.x); o[1] += bfhi(pv.x); o[2] += bflo(pv.y); o[3] += bfhi(pv.y);
      }
      uint2 u;
      u.x = pack2(o[0], o[1]);
      u.y = pack2(o[2], o[3]);
      *q = u;
    }
}

template <bool FX>
DI void nsa_tile(const Params& p, int b, int g, int tile, bf16_t* lds, const float CL) {
  const int tid = TID(), lane = tid & 63, w = tid >> 6, quad = lane >> 4, col = lane & 15;
  const int cur = tile;
  const int tok = tile * 64 + w * 16 + col;
  bf16_t* z = (bf16_t*)(p.ws + O_Z);
  const bf16_t* kcmp = (const bf16_t*)(p.ws + O_KCMP) + (size_t)(b * 2 + g) * 512 * 64;
  const bf16_t* vcmpT = (const bf16_t*)(p.ws + O_VCMPT) + (size_t)(b * 2 + g) * 64 * 512;
  const bf16_t* vsT = (const bf16_t*)(p.ws + O_VST) + (size_t)(b * 2 + g) * 64 * TS;
  const bf16_t* vwT = (const bf16_t*)(p.ws + O_VWT) + (size_t)(b * 2 + g) * 64 * TS;
  const bf16_t* zb = z + (size_t)b * SEQ * ZS;
  const bf16_t* ztok = z + ((size_t)(b * SEQ + tok)) * ZS;
  bf16_t* otok = (bf16_t*)(p.ws + O_ONSA) + ((size_t)(b * SEQ + tok)) * 512 + g * 256;
  bf16_t* Ks = lds;
  bf16_t* Vs = lds + 4096;
  float* impl = (float*)(lds + 8192);

  AttnSt st;
  float invl[2] = {0.f, 0.f};
  float dA[4] = {0.f, 0.f, 0.f, 0.f}, dE[4] = {0.f, 0.f, 0.f, 0.f};
  u32x4 rk0, rk1, rv0, rv1;
  bf16x8 qf[2][2];

  const int ncs = (cur < 16) ? 1 : (cur >> 4) + 1;
  const int chi = (tok >= 31) ? ((tok - 31) >> 4) : -1;

  for (int hp = 0; hp < 2; ++hp) {
#pragma unroll
    for (int hh = 0; hh < 2; ++hh)
#pragma unroll
      for (int ks = 0; ks < 2; ++ks) qf[hh][ks] = *(const bf16x8*)(ztok + C_Q + g * 256 + (hp * 2 + hh) * 64 + ks * 32 + quad * 8);
    st_reset(st);
    tile64_gload(tid, rk0, rk1, kcmp, 64);
    for (int s = 0; s < ncs; ++s) {
      __syncthreads();
      tile64_sstore(tid, Ks, rk0, rk1);
      __syncthreads();
      if (s + 1 < ncs) tile64_gload(tid, rk0, rk1, kcmp + (size_t)(s + 1) * 4096, 64);
      attn_compute<0, FX>(lane, Ks, Vs, qf, st, invl, 0, chi - s * 64, dA, dE, CL);
    }
#pragma unroll
    for (int h = 0; h < 2; ++h) {
      float l = st.l[h];
      l += shx(l, 16, lane);
      l += shx(l, 32, lane);
      invl[h] = (l > 0.f) ? 1.f / l : 0.f;
    }
    {
      float carry = 0.f;
      tile64_gload(tid, rk0, rk1, kcmp, 64);
      tile64_gload(tid, rv0, rv1, vcmpT, 512);
      for (int s = 0; s < ncs; ++s) {
        float iA[4] = {0.f, 0.f, 0.f, 0.f}, iE[4] = {0.f, 0.f, 0.f, 0.f};
        __syncthreads();
        tile64_sstore(tid, Ks, rk0, rk1);
        tile64_sstore(tid, Vs, rv0, rv1);
        __syncthreads();
        if (s + 1 < ncs) {
          tile64_gload(tid, rk0, rk1, kcmp + (size_t)(s + 1) * 4096, 64);
          tile64_gload(tid, rv0, rv1, vcmpT + (s + 1) * 64, 512);
        }
        attn_compute<1, FX>(lane, Ks, Vs, qf, st, invl, 0, chi - s * 64, iA, iE, CL);
#pragma unroll
        for (int kt = 0; kt < 4; ++kt) {
          float recv = shfrom(iE[kt], (lane + 48) & 63);
          float val = iA[kt] + ((quad == 0) ? carry : recv);
          carry = recv;
          float* slot = impl + (s * 4 + kt) * 256 + tid;
          if (hp == 0) *slot = val; else *slot += val;
        }
      }
    }
    {
      float sc[2];
#pragma unroll
      for (int h = 0; h < 2; ++h) sc[h] = sigmoidf(bf2f(ztok[C_GT + 0 * 8 + g * 4 + hp * 2 + h]));
      nsa_flush<true>(quad, otok + hp * 128, st, sc);
    }
  }

  uint32_t sw0, sw1, sw2, sw3;
  {
    uint32_t key[32];
#pragma unroll
    for (int i = 0; i < 32; ++i) {
      int j = i * 4 + quad;
      float sc = (i < ncs * 4) ? impl[i * 256 + tid] : 0.f;
      if (j == 0 || j == cur || j == cur - 1) sc = 1e4f;
      uint32_t k = (__float_as_uint(sc) & ~127u) | (uint32_t)(127 - j);
      key[i] = (j > cur) ? 0u : k;
    }
    uint32_t prev = 0xFFFFFFFFu;
    for (int r = 0; r < 16; ++r) {
      uint32_t mx = 0u;
#pragma unroll
      for (int i = 0; i < 32; ++i) {
        uint32_t k = key[i];
        k = (k < prev) ? k : 0u;
        mx = (k > mx) ? k : mx;
      }
      uint32_t o = shxu(mx, 16, lane);
      mx = (o > mx) ? o : mx;
      o = shxu(mx, 32, lane);
      mx = (o > mx) ? o : mx;
      prev = mx;
    }
    sw0 = 0u; sw1 = 0u; sw2 = 0u; sw3 = 0u;
#pragma unroll
    for (int i = 0; i < 32; ++i) {
      bool sel = (key[i] != 0u) && (key[i] >= prev);
      uint32_t bit = sel ? (1u << ((i & 7) * 4 + quad)) : 0u;
      if ((i >> 3) == 0) sw0 |= bit;
      else if ((i >> 3) == 1) sw1 |= bit;
      else if ((i >> 3) == 2) sw2 |= bit;
      else sw3 |= bit;
    }
    sw0 |= shxu(sw0, 16, lane); sw0 |= shxu(sw0, 32, lane);
    sw1 |= shxu(sw1, 16, lane); sw1 |= shxu(sw1, 32, lane);
    sw2 |= shxu(sw2, 16, lane); sw2 |= shxu(sw2, 32, lane);
    sw3 |= shxu(sw3, 16, lane); sw3 |= shxu(sw3, 32, lane);
  }

  for (int hp = 0; hp < 2; ++hp) {
#pragma unroll
    for (int hh = 0; hh < 2; ++hh)
#pragma unroll
      for (int ks = 0; ks < 2; ++ks) qf[hh][ks] = *(const bf16x8*)(ztok + C_Q + g * 256 + (hp * 2 + hh) * 64 + ks * 32 + quad * 8);
    st_reset(st);
    {
      const bf16_t* kb = zb + C_KS + g * 64;
      tile64_gload(tid, rk0, rk1, kb, ZS);
      tile64_gload(tid, rv0, rv1, vsT, TS);
      for (int s = 0; s <= cur; ++s) {
        __syncthreads();
        tile64_sstore(tid, Ks, rk0, rk1);
        tile64_sstore(tid, Vs, rv0, rv1);
        __syncthreads();
        if (s < cur) {
          tile64_gload(tid, rk0, rk1, kb + (size_t)(s + 1) * 64 * ZS, ZS);
          tile64_gload(tid, rv0, rv1, vsT + (s + 1) * 64, TS);
        }
        uint32_t wsel = (s < 32) ? sw0 : (s < 64) ? sw1 : (s < 96) ? sw2 : sw3;
        bool sel = (wsel >> (s & 31)) & 1u;
        int hi = sel ? (tok - s * 64) : -1;
        if (__any(hi >= 0)) attn_compute<2, FX>(lane, Ks, Vs, qf, st, invl, 0, hi, dA, dE, CL);
      }
    }
    {
      float sc[2];
#pragma unroll
      for (int h = 0; h < 2; ++h) {
        float l = st.l[h];
        l += shx(l, 16, lane);
        l += shx(l, 32, lane);
        sc[h] = (l > 0.f) ? sigmoidf(bf2f(ztok[C_GT + 1 * 8 + g * 4 + hp * 2 + h])) / l : 0.f;
      }
      nsa_flush<false>(quad, otok + hp * 128, st, sc);
    }
    st_reset(st);
    {
      const bf16_t* kb = zb + C_KW + g * 64;
      const int s0 = (cur >= 8) ? cur - 8 : 0;
      tile64_gload(tid, rk0, rk1, kb + (size_t)s0 * 64 * ZS, ZS);
      tile64_gload(tid, rv0, rv1, vwT + s0 * 64, TS);
      for (int s = s0; s <= cur; ++s) {
        __syncthreads();
        tile64_sstore(tid, Ks, rk0, rk1);
        tile64_sstore(tid, Vs, rv0, rv1);
        __syncthreads();
        if (s < cur) {
          tile64_gload(tid, rk0, rk1, kb + (size_t)(s + 1) * 64 * ZS, ZS);
          tile64_gload(tid, rv0, rv1, vwT + (s + 1) * 64, TS);
        }
        attn_compute<2, FX>(lane, Ks, Vs, qf, st, invl, tok - 511 - s * 64, tok - s * 64, dA, dE, CL);
      }
    }
    {
      float sc[2];
#pragma unroll
      for (int h = 0; h < 2; ++h) {
        float l = st.l[h];
        l += shx(l, 16, lane);
        l += shx(l, 32, lane);
        sc[h] = (l > 0.f) ? sigmoidf(bf2f(ztok[C_GT + 2 * 8 + g * 4 + hp * 2 + h])) / l : 0.f;
      }
      nsa_flush<false>(quad, otok + hp * 128, st, sc);
    }
  }
}

DI void load128(int tid, bf16_t* lds, const bf16_t* base, size_t stride) {
  u32x4 r[8];
#pragma unroll
  for (int i = 0; i < 8; ++i) {
    int idx = tid + 256 * i;
    int row = idx >> 4, ch = idx & 15;
    r[i] = *(const u32x4*)(base + (size_t)row * stride + ch * 8);
  }
#pragma unroll
  for (int i = 0; i < 8; ++i) {
    int idx = tid + 256 * i;
    int row = idx >> 4, ch = idx & 15;
    *(u32x4*)(lds + row * 128 + ((ch ^ (row & 15)) << 3)) = r[i];
  }
}

DI void ret_tile(const Params& p, int b, int h, int c, bf16_t* lds) {
  const int tid = TID(), lane = tid & 63, w = tid >> 6, quad = lane >> 4, col = lane & 15;
  const float lg2 = log2f(1.f - exp2f(-5.f - (float)h));
  bf16_t* z = (bf16_t*)(p.ws + O_Z);
  const bf16_t* rvT = (const bf16_t*)(p.ws + O_RVT);
  bf16_t* zc = z + ((size_t)(b * SEQ + c * 128)) * ZS;
  bf16x8 qf[2][4];
#pragma unroll
  for (int nt = 0; nt < 2; ++nt)
#pragma unroll
    for (int ks = 0; ks < 4; ++ks) {
      int n = 32 * w + nt * 16 + col;
      qf[nt][ks] = *(const bf16x8*)(zc + (size_t)n * ZS + C_RQ + h * 128 + ks * 32 + quad * 8);
    }
  f32x4 acc[8][2];
#pragma unroll
  for (int et = 0; et < 8; ++et)
#pragma unroll
    for (int nt = 0; nt < 2; ++nt) acc[et][nt] = f32x4{0.f, 0.f, 0.f, 0.f};
  __syncthreads();
  load128(tid, lds, zc + C_RV + h * 128, ZS);
  __syncthreads();
#pragma unroll
  for (int ks = 0; ks < 4; ++ks)
#pragma unroll
    for (int et = 0; et < 8; ++et) {
      int row = et * 16 + col;
      bf16x8 af = *(const bf16x8*)(lds + row * 128 + (((ks * 4 + quad) ^ (row & 15)) << 3));
#pragma unroll
      for (int nt = 0; nt < 2; ++nt) acc[et][nt] = mfma16(af, qf[nt][ks], acc[et][nt]);
    }
#pragma unroll
  for (int nt = 0; nt < 2; ++nt) {
    int n = 32 * w + nt * 16 + col;
    float xi = exp2f(lg2 * (float)(n + 1));
#pragma unroll
    for (int et = 0; et < 8; ++et) acc[et][nt] *= xi;
  }
  __syncthreads();
  load128(tid, lds, zc + C_RK + h * 128, ZS);
  __syncthreads();
  bf16x8 pf[2][4];
#pragma unroll
  for (int nt = 0; nt < 2; ++nt) {
    f32x4 s[8];
#pragma unroll
    for (int mt = 0; mt < 8; ++mt) s[mt] = f32x4{0.f, 0.f, 0.f, 0.f};
#pragma unroll
    for (int ks = 0; ks < 4; ++ks)
#pragma unroll
      for (int mt = 0; mt < 8; ++mt) {
        if (mt <= 2 * w + 1) {
          int row = mt * 16 + col;
          bf16x8 af = *(const bf16x8*)(lds + row * 128 + (((ks * 4 + quad) ^ (row & 15)) << 3));
          s[mt] = mfma16(af, qf[nt][ks], s[mt]);
        }
      }
    const int n = 32 * w + nt * 16 + col;
#pragma unroll
    for (int c2 = 0; c2 < 4; ++c2) {
      float v[8];
#pragma unroll
      for (int i = 0; i < 8; ++i) {
        const int mt = 2 * c2 + (i >> 2), j = i & 3;
        const int m = mt * 16 + quad * 4 + j;
        v[i] = (n >= m) ? s[mt][j] * exp2f(lg2 * (float)(n - m)) : 0.f;
      }
      pf[nt][c2] = mk8(pack2(v[0], v[1]), pack2(v[2], v[3]), pack2(v[4], v[5]), pack2(v[6], v[7]));
    }
  }
  __syncthreads();
  load128(tid, lds, rvT + ((size_t)((b * 4 + h) * 128)) * TS + c * 128, TS);
  __syncthreads();
#pragma unroll
  for (int c2 = 0; c2 < 4; ++c2) {
    if (2 * c2 <= 2 * w + 1) {
#pragma unroll
      for (int et = 0; et < 8; ++et) {
        int row = et * 16 + col;
        int sw = row & 15;
        uint2 a = *(const uint2*)(lds + row * 128 + (((4 * c2 + (quad >> 1)) ^ sw) << 3) + (quad & 1) * 4);
        uint2 bb = *(const uint2*)(lds + row * 128 + (((4 * c2 + 2 + (quad >> 1)) ^ sw) << 3) + (quad & 1) * 4);
        bf16x8 vf = mk8(a.x, a.y, bb.x, bb.y);
#pragma unroll
        for (int nt = 0; nt < 2; ++nt) acc[et][nt] = mfma16(vf, pf[nt][c2], acc[et][nt]);
      }
    }
  }
#pragma unroll
  for (int nt = 0; nt < 2; ++nt) {
    float ss = 0.f;
#pragma unroll
    for (int et = 0; et < 8; ++et)
#pragma unroll
      for (int j = 0; j < 4; ++j) ss += acc[et][nt][j] * acc[et][nt][j];
    ss += shx(ss, 16, lane);
    ss += shx(ss, 32, lane);
    const float rs = rsqrtf(ss * (1.f / 128.f) + 1e-6f);
    const int n = 32 * w + nt * 16 + col;
    bf16_t* zr = zc + (size_t)n * ZS;
#pragma unroll
    for (int et = 0; et < 8; ++et) {
      const int e0 = et * 16 + quad * 4;
      uint2 gv = *(const uint2*)(zr + C_RG + h * 128 + e0);
      float g0 = bflo(gv.x), g1 = bfhi(gv.x), g2 = bflo(gv.y), g3 = bfhi(gv.y);
      uint2 o;
      o.x = pack2(acc[et][nt][0] * rs * g0 * sigmoidf(g0), acc[et][nt][1] * rs * g1 * sigmoidf(g1));
      o.y = pack2(acc[et][nt][2] * rs * g2 * sigmoidf(g2), acc[et][nt][3] * rs * g3 * sigmoidf(g3));
      *(uint2*)(zr + C_RQ + h * 128 + e0) = o;
    }
  }
}

#define GEMM_TILE_LOOP(NT)                                                             \
  for (int qp_ = (int)(blockIdx.x >> 3), per_ = (int)(gridDim.x >> 3), xcd_ = (int)(blockIdx.x & 7), q_ = 0, mt = 0, ntile = 0; \
       2 * qp_ < 32 * (NT) && ((q_ = 2 * qp_ + HALF()), (mt = (((xcd_ + 8 * (q_ / (8 * (NT)))) << 3) + ((q_ % (8 * (NT))) & 7)), ntile = ((q_ % (8 * (NT))) >> 3)), true); \
       qp_ += per_)


DI int TID8() { int t = threadIdx.x; asm volatile("" : "+v"(t)); return t; }
DI void g8_load(u32x4 (&ra)[4], u32x4 (&rb)[4], const bf16_t* a, size_t lda, const bf16_t* b, size_t ldb, int kb, int lrow, int lch) {
#pragma unroll
  for (int i = 0; i < 4; ++i) {
    ra[i] = *(const u32x4*)(a + (size_t)(lrow + 64 * i) * lda + kb * 64 + lch * 8);
    rb[i] = *(const u32x4*)(b + (size_t)(lrow + 64 * i) * ldb + kb * 64 + lch * 8);
  }
}
DI void g8_store(bf16_t* S, const u32x4 (&ra)[4], const u32x4 (&rb)[4], int lrow, int lch) {
#pragma unroll
  for (int i = 0; i < 4; ++i) {
    const int r = lrow + 64 * i;
    const int off = r * 64 + ((lch ^ ((r >> 1) & 7)) << 3);
    *(u32x4*)(S + off) = ra[i];
    *(u32x4*)(S + 16384 + off) = rb[i];
  }
}
DI void g8_compute(f32x4 (&acc)[8][4], const bf16_t* S, int wm, int wn, int lane) {
#pragma unroll
  for (int ks = 0; ks < 2; ++ks) {
    bf16x8 af[8], bfr[4];
#pragma unroll
    for (int i = 0; i < 8; ++i) {
      const int r = wm * 128 + i * 16 + (lane & 15);
      af[i] = *(const bf16x8*)(S + r * 64 + (((ks * 4 + (lane >> 4)) ^ ((r >> 1) & 7)) << 3));
    }
#pragma unroll
    for (int j = 0; j < 4; ++j) {
      const int r = wn * 64 + j * 16 + (lane & 15);
      bfr[j] = *(const bf16x8*)(S + 16384 + r * 64 + (((ks * 4 + (lane >> 4)) ^ ((r >> 1) & 7)) << 3));
    }
    __builtin_amdgcn_s_setprio(1);
#pragma unroll
    for (int i = 0; i < 8; ++i)
#pragma unroll
      for (int j = 0; j < 4; ++j) acc[i][j] = mfma16(bfr[j], af[i], acc[i][j]);
    __builtin_amdgcn_s_setprio(0);
  }
}
DI void gemm8_accum(f32x4 (&acc)[8][4], const bf16_t* a, size_t lda, const bf16_t* b, size_t ldb, int nkb, bf16_t* L) {
  const int tid = TID8(), lane = tid & 63, w = tid >> 6;
  const int wm = w >> 2, wn = w & 3;
  const int lrow = tid >> 3, lch = tid & 7;
  u32x4 ra[4], rb[4];
  __syncthreads();
  g8_load(ra, rb, a, lda, b, ldb, 0, lrow, lch);
  g8_store(L, ra, rb, lrow, lch);
  __syncthreads();
  for (int kb = 0; kb < nkb; ++kb) {
    const int s = kb & 1;
    const int k1 = (kb + 1 < nkb) ? kb + 1 : kb;
    g8_load(ra, rb, a, lda, b, ldb, k1, lrow, lch);
    __builtin_amdgcn_sched_barrier(0);
    g8_compute(acc, L + s * 32768, wm, wn, lane);
    g8_store(L + (s ^ 1) * 32768, ra, rb, lrow, lch);
    __syncthreads();
  }
}
DI void zero_acc8(f32x4 (&acc)[8][4]) {
#pragma unroll
  for (int i = 0; i < 8; ++i)
#pragma unroll
    for (int j = 0; j < 4; ++j) acc[i][j] = f32x4{0.f, 0.f, 0.f, 0.f};
}
template <class F>
DI void gemm8_epi_staged(f32x4 (&acc)[8][4], int m0, int n0, bf16_t* L, F f, bf16_t* dst, size_t ld, int nmax) {
  const int tid = TID8(), lane = tid & 63, w = tid >> 6;
  const int wm = w >> 2, wn = w & 3;
#pragma unroll
  for (int half = 0; half < 2; ++half) {
    if (wm == half) {
#pragma unroll
      for (int i = 0; i < 8; ++i)
#pragma unroll
        for (int j = 0; j < 4; ++j) {
          const int ml = i * 16 + (lane & 15);
          const int nl = wn * 64 + j * 16 + (lane >> 4) * 4;
          f32x4 a = acc[i][j];
          f(m0 + half * 128 + ml, n0 + nl, a);
          uint2 u;
          u.x = pack2(a[0], a[1]);
          u.y = pack2(a[2], a[3]);
          *(uint2*)(L + ml * 264 + nl) = u;
        }
    }
    __syncthreads();
#pragma unroll
    for (int it = 0; it < 8; ++it) {
      const int idx = tid + 512 * it;
      const int row = idx >> 5, ch = idx & 31;
      const u32x4 v = *(const u32x4*)(L + row * 264 + ch * 8);
      const int n = n0 + ch * 8;
      if (n < nmax) *(u32x4*)(dst + (size_t)(m0 + half * 128 + row) * ld + n) = v;
    }
    __syncthreads();
  }
}
DI void gemm8_epi_resid(f32x4 (&acc)[8][4], int m0, int n0, int ntile8, bf16_t* L, const float* xin, float* out, bf16_t* xb, float* rowpart) {
  const int tid = TID8(), lane = tid & 63, w = tid >> 6;
  const int wm = w >> 2, wn = w & 3;
  float* red = (float*)L;
#pragma unroll
  for (int i = 0; i < 8; ++i) {
    const int ml = wm * 128 + i * 16 + (lane & 15);
    const size_t rowoff = (size_t)(m0 + ml) * DM;
    float ss = 0.f;
#pragma unroll
    for (int j = 0; j < 4; ++j) {
      const int n = n0 + wn * 64 + j * 16 + (lane >> 4) * 4;
      const float4 xv = *(const float4*)(xin + rowoff + n);
      const float o0 = xv.x + acc[i][j][0], o1 = xv.y + acc[i][j][1], o2 = xv.z + acc[i][j][2], o3 = xv.w + acc[i][j][3];
      *(float4*)(out + rowoff + n) = make_float4(o0, o1, o2, o3);
      ss += o0 * o0 + o1 * o1 + o2 * o2 + o3 * o3;
      uint2 u;
      u.x = pack2(o0, o1);
      u.y = pack2(o2, o3);
      *(uint2*)(xb + rowoff + n) = u;
    }
    ss += shx(ss, 16, lane);
    ss += shx(ss, 32, lane);
    if ((lane >> 4) == 0) red[wn * 256 + ml] = ss;
  }
  __syncthreads();
  {
    const int row = tid & 255, h = tid >> 8;
    rowpart[(size_t)(ntile8 * 2 + h) * T_TOK + m0 + row] = red[(2 * h) * 256 + row] + red[(2 * h + 1) * 256 + row];
  }
}
DI void row_rs8(float (&rsv)[8], const float* rowpart, int m0) {
  const int tid = TID8(), lane = tid & 63, wm = tid >> 8;
#pragma unroll
  for (int i = 0; i < 8; ++i) {
    const int m = m0 + wm * 128 + i * 16 + (lane & 15);
    float s = 0.f;
#pragma unroll
    for (int t = 0; t < 8; ++t) s += rowpart[(size_t)t * T_TOK + m];
    rsv[i] = rsqrtf(s * (1.f / 1024.f) + 1e-6f);
  }
}
DI void scale_rows8(f32x4 (&acc)[8][4], const float (&rsv)[8]) {
#pragma unroll
  for (int i = 0; i < 8; ++i)
#pragma unroll
    for (int j = 0; j < 4; ++j) acc[i][j] *= rsv[i];
}
#define GEMM8_TILE_LOOP(NT8)                                                            \
  for (int q_ = (int)(blockIdx.x >> 3), per_ = (int)(gridDim.x >> 3), xcd_ = (int)(blockIdx.x & 7), mt = 0, ntile = 0; \
       q_ < 16 * (NT8) && ((mt = (((xcd_ + 8 * (q_ / (4 * (NT8)))) << 2) + ((q_ % (4 * (NT8))) & 3)), ntile = ((q_ % (4 * (NT8))) >> 2)), true); \
       q_ += per_)

#define XB_TMO      128
#define XB_XCNT(j)  (256  + 64 * (j))
#define XB_XSUB(j)  (1280 + 64 * (j))
#define XB_XGEN(j)  (2304 + 64 * (j))
#define XB_TOP      3328
#define XB_TOPGEN   3392
#define XB_SPIN_CAP (1u << 20)
DI unsigned xb_ld(unsigned* p) { return __hip_atomic_load(p, __ATOMIC_RELAXED, __HIP_MEMORY_SCOPE_AGENT); }
DI unsigned xb_add(unsigned* p, unsigned v) { return __hip_atomic_fetch_add(p, v, __ATOMIC_RELAXED, __HIP_MEMORY_SCOPE_AGENT); }
DI unsigned xb_xcc_id() { return (unsigned)__builtin_amdgcn_s_getreg((3 << 11) | 20) & 0xFu; }
#define XB_SPIN(cond, bar) do { unsigned _sp = 0; while (cond) { __builtin_amdgcn_s_sleep(1); \
    if ((++_sp & 255u) == 0u) { if (xb_ld(&(bar)[XB_TMO])) break; if (_sp > XB_SPIN_CAP) { atomicAdd(&(bar)[XB_TMO], 1u); break; } } } } while (0)

DI void xcd_barrier(unsigned* bar, const unsigned x, const unsigned nloc, const unsigned nx) {
  asm volatile("s_waitcnt vmcnt(0)" ::: "memory");
  __syncthreads();
  if (threadIdx.x == 0) {
    __builtin_amdgcn_s_waitcnt(0);
    const unsigned old = xb_add(&bar[XB_XSUB(x)], 1u);
    const unsigned gen = old / nloc;
    if (old + 1u == (gen + 1u) * nloc) {
      __builtin_amdgcn_fence(__ATOMIC_RELEASE, "agent");
      asm volatile("s_waitcnt vmcnt(0)" ::: "memory");
      const unsigned og = xb_add(&bar[XB_TOP], 1u);
      const unsigned tg = og / nx;
      if (og + 1u == (tg + 1u) * nx) xb_add(&bar[XB_TOPGEN], 1u);
      else XB_SPIN(xb_ld(&bar[XB_TOPGEN]) == tg, bar);
      __builtin_amdgcn_fence(__ATOMIC_ACQUIRE, "agent");
      xb_add(&bar[XB_XGEN(x)], 1u);
      asm volatile("s_waitcnt vmcnt(0)" ::: "memory");
    } else {
      XB_SPIN(xb_ld(&bar[XB_XGEN(x)]) == gen, bar);
      __builtin_amdgcn_fence(__ATOMIC_ACQUIRE, "agent");
      asm volatile("s_waitcnt vmcnt(0)" ::: "memory");
    }
  }
  __syncthreads();
}

__global__ void __launch_bounds__(512, 2) mega(Params p) {
  extern __shared__ __attribute__((aligned(16))) bf16_t lds_all[];
  bf16_t* lds = lds_all + HALF() * 32768;
  cg::grid_group grid = cg::this_grid();
  const int nb = NVB;
  bf16_t* wt = (bf16_t*)(p.ws + O_WT);
  bf16_t* z = (bf16_t*)(p.ws + O_Z);
  bf16_t* hbuf = (bf16_t*)(p.ws + O_VST);
  bf16_t* ubuf = z;
  bf16_t* p16 = (bf16_t*)(p.ws + O_KVD);
  float* rowpart = (float*)(p.ws + O_RP);
  bf16_t* hid = (bf16_t*)(p.ws + O_HID);
  const float* bias = (const float*)(p.ws + O_BIAS);

  unsigned* bar = (unsigned*)(p.ws + O_BAR);
  const unsigned xb_x = xb_xcc_id();
  if (threadIdx.x == 0) (void)xb_add(&bar[XB_XCNT(xb_x)], 1u);
  unsigned xb_nloc = 1u, xb_nx = 1u;

  for (int layer = 0; layer < 2; ++layer) {
    const bf16_t* wl = wt;
    const float* xin = (layer == 0) ? p.x : p.out;

    phase0(p, layer);
    norm_phase(xin, p.norm_mix + layer * DM, hbuf);
    if (layer == 0) {
      grid.sync();
      unsigned mine = 0u, cnt = 0u;
#pragma unroll
      for (unsigned j = 0; j < 16; ++j) {
        const unsigned c = xb_ld(&bar[XB_XCNT(j)]);
        cnt += (c > 0u) ? 1u : 0u;
        mine = (j == xb_x) ? c : mine;
      }
      xb_nloc = __builtin_amdgcn_readfirstlane(mine > 0u ? mine : 1u);
      xb_nx = __builtin_amdgcn_readfirstlane(cnt > 0u ? cnt : 1u);
    } else {
      xcd_barrier(bar, xb_x, xb_nloc, xb_nx);
    }

    GEMM8_TILE_LOOP(22) {
      const int m0 = mt * 256, n0 = ntile * 256;
      f32x4 acc8[8][4];
      zero_acc8(acc8);
      gemm8_accum(acc8, hbuf + (size_t)m0 * DM, DM, wl + W_IN + (size_t)n0 * 1024, 1024, 16, lds_all);
      gemm8_epi_staged(acc8, m0, n0, lds_all, [&](int, int, f32x4&) {}, z, ZS, ZS);
    }
    xcd_barrier(bar, xb_x, xb_nloc, xb_nx);

    post_z(p, layer);
    xcd_barrier(bar, xb_x, xb_nloc, xb_nx);

    for (int u_ = (int)blockIdx.x, t = 0; (u_ < 64 || u_ - 64 < 512) && ((t = (u_ < 64) ? 2 * u_ + HALF() : 128 + 2 * (u_ - 64) + HALF()), true); u_ = (u_ < 64) ? 1 << 20 : u_ + (int)gridDim.x - 64) {
      f32x4 acc[4][4];
      zero_acc(acc);
      if (t < 128) {
        const int kv = t >> 6, mt = (t >> 1) & 31, ntile = t & 1;
        const int m0 = mt * 128, n0 = ntile * 128;
        const bf16_t* kvd = (const bf16_t*)(p.ws + O_KVD) + (size_t)kv * 8 * SEQ * 64;
        auto ap = [&](int r, int kb) -> const bf16_t* {
          int row = m0 + r;
          int bg = row >> 9, c = row & 511;
          int tk = 16 * c + kb;
          tk = tk > (SEQ - 1) ? (SEQ - 1) : tk;
          return kvd + ((size_t)(bg * SEQ + tk)) * 64;
        };
        gemm_accum(acc, ap, RowPtr{wl + (kv ? W_C1V : W_C1K) + (size_t)n0 * 2048, 2048}, 32, lds);
        const float* bs = bias + kv * 256;
        bf16_t* hd = hid + (size_t)kv * 4096 * 256;
        gemm_epi(acc, m0, n0, [&](int m, int n, f32x4& a) {
          float o[4];
#pragma unroll
          for (int j = 0; j < 4; ++j) {
            float xv = a[j] + bs[n + j];
            float y = 0.7978845608028654f * (xv + 0.044715f * xv * xv * xv);
            float th = 1.f - 2.f / (__expf(2.f * y) + 1.f);
            o[j] = 0.5f * xv * (1.f + th);
          }
          uint2 u;
          u.x = pack2(o[0], o[1]);
          u.y = pack2(o[2], o[3]);
          *(uint2*)(hd + (size_t)m * 256 + n) = u;
        });
      } else {
        const int idx = t - 128;
        const int c = idx & 63, bh = idx >> 6;
        const bf16_t* rvT = (const bf16_t*)(p.ws + O_RVT) + ((size_t)bh * 128) * TS + c * 128;
        const bf16_t* kzT = (const bf16_t*)(p.ws + O_KZT) + ((size_t)bh * 128) * TS + c * 128;
        gemm_accum(acc, RowPtr{rvT, TS}, RowPtr{kzT, TS}, 2, lds);
        bf16_t* dst = z + ((size_t)((bh >> 2) * SEQ + c * 128)) * ZS + C_RV + (bh & 3) * 128;
        gemm_epi_staged(acc, 0, 0, lds, [&](int, int, f32x4&) {}, dst, ZS, 128);
      }
    }
    xcd_barrier(bar, xb_x, xb_nloc, xb_nx);

    phase4b(p, layer);
    {
      const float* pl = p.p + (size_t)layer * T_TOK * 256;
      const int gtid = VBID * 256 + TID();
      const int gthreads = nb * 256;
      for (int i = gtid; i < T_TOK * 32; i += gthreads) {
        float4 a = ((const float4*)pl)[2 * i], b2 = ((const float4*)pl)[2 * i + 1];
        ((uint4*)p16)[i] = make_uint4(pack2(a.x, a.y), pack2(a.z, a.w), pack2(b2.x, b2.y), pack2(b2.z, b2.w));
      }
    }
    xcd_barrier(bar, xb_x, xb_nloc, xb_nx);

    float nsa_c;
    {
      const int ln = TID() & 63;
      float gq = fabsf(p.nsa_q_norm[layer * 64 + ln]), gk = fabsf(p.nsa_k_norm[layer * 64 + ln]);
#pragma unroll
      for (int o = 32; o > 0; o >>= 1) {
        gq = fmaxf(gq, shx(gq, o, ln));
        gk = fmaxf(gk, shx(gk, o, ln));
      }
      nsa_c = 8.f * gq * gk;
    }
    const bool nsa_fx = nsa_c < 30.f;
    const float nsa_cl = nsa_c * 1.4426950408889634f;
    for (int t = VBID; t < 2048; t += nb) {
      if (t < 1024) {
        const int tile = (t < 512) ? 127 - (t >> 3) : ((t - 512) >> 3), bg = t & 7;
        if (nsa_fx) nsa_tile<true>(p, bg >> 1, bg & 1, tile, lds, nsa_cl);
        else nsa_tile<false>(p, bg >> 1, bg & 1, tile, lds, 0.f);
      } else {
        const int idx = t - 1024;
        ret_tile(p, idx >> 8, (idx >> 6) & 3, idx & 63, lds);
      }
    }
    xcd_barrier(bar, xb_x, xb_nloc, xb_nx);

    GEMM_TILE_LOOP(8) {
      const int m0 = mt * 128, n0 = ntile * 128;
      f32x4 acc[4][4];
      zero_acc(acc);
      gemm_accum(acc, RowPtr{(const bf16_t*)(p.ws + O_ONSA) + (size_t)m0 * 512, 512}, RowPtr{wl + W_UPA + (size_t)n0 * 512, 512}, 8, lds);
      gemm_epi(acc, m0, n0, [&](int m, int n, f32x4& a) {
        uint2 ua = *(const uint2*)(z + (size_t)m * ZS + C_MA + n);
        uint2 ub = *(const uint2*)(z + (size_t)m * ZS + C_MB + n);
        a[0] *= sigmoidf(bflo(ua.x)) / sigmoidf(bflo(ub.x));
        a[1] *= sigmoidf(bfhi(ua.x)) / sigmoidf(bfhi(ub.x));
        a[2] *= sigmoidf(bflo(ua.y)) / sigmoidf(bflo(ub.y));
        a[3] *= sigmoidf(bfhi(ua.y)) / sigmoidf(bfhi(ub.y));
      });
      gemm_accum(acc, RowPtr{z + (size_t)m0 * ZS + C_RQ, ZS}, RowPtr{wl + W_UPR + (size_t)n0 * 512, 512}, 8, lds);
      gemm_epi_staged(acc, m0, n0, lds, [&](int m, int n, f32x4& a) {
        uint2 ub = *(const uint2*)(z + (size_t)m * ZS + C_MB + n);
        a[0] *= sigmoidf(bflo(ub.x)); a[1] *= sigmoidf(bfhi(ub.x));
        a[2] *= sigmoidf(bflo(ub.y)); a[3] *= sigmoidf(bfhi(ub.y));
      }, z + C_RK, ZS, 1024);
    }
    xcd_barrier(bar, xb_x, xb_nloc, xb_nx);

    GEMM8_TILE_LOOP(4) {
      const int m0 = mt * 256, n0 = ntile * 256;
      f32x4 acc8[8][4];
      zero_acc8(acc8);
      gemm8_accum(acc8, z + (size_t)m0 * ZS + C_RK, ZS, wl + W_OUT + (size_t)n0 * 1024, 1024, 16, lds_all);
      gemm8_epi_resid(acc8, m0, n0, ntile, lds_all, xin, p.out, hbuf, rowpart);
    }
    xcd_barrier(bar, xb_x, xb_nloc, xb_nx);

    GEMM8_TILE_LOOP(16) {
      const int m0 = mt * 256, n0 = ntile * 256;
      f32x4 acc8[8][4];
      zero_acc8(acc8);
      float rsv[8];
      row_rs8(rsv, rowpart, m0);
      gemm8_accum(acc8, hbuf + (size_t)m0 * DM, DM, wl + W_FF1 + (size_t)n0 * 1024, 1024, 16, lds_all);
      scale_rows8(acc8, rsv);
      gemm8_epi_staged(acc8, m0, n0, lds_all, [&](int, int, f32x4& a) {
        float r0 = fmaxf(a[0], 0.f), r1 = fmaxf(a[1], 0.f), r2 = fmaxf(a[2], 0.f), r3 = fmaxf(a[3], 0.f);
        a[0] = r0 * r0; a[1] = r1 * r1; a[2] = r2 * r2; a[3] = r3 * r3;
      }, ubuf, 4096, 4096);
    }
    xcd_barrier(bar, xb_x, xb_nloc, xb_nx);

    GEMM8_TILE_LOOP(4) {
      const int m0 = mt * 256, n0 = ntile * 256;
      f32x4 acc8[8][4];
      zero_acc8(acc8);
      gemm8_accum(acc8, ubuf + (size_t)m0 * 4096, 4096, wl + W_FF2 + (size_t)n0 * 4096, 4096, 64, lds_all);
      gemm8_epi_resid(acc8, m0, n0, ntile, lds_all, p.out, p.out, hbuf, rowpart);
    }
    xcd_barrier(bar, xb_x, xb_nloc, xb_nx);

    GEMM_TILE_LOOP(8) {
      const int m0 = mt * 128, n0 = ntile * 128;
      f32x4 acc[4][4];
      zero_acc(acc);
      gemm_accum(acc, RowPtr{p16 + (size_t)m0 * 256, 256}, RowPtr{wl + W_PLE + (size_t)n0 * 256, 256}, 4, lds);
      bf16_t* ppb = z + (size_t)T_TOK * 256;
      gemm_epi_staged(acc, m0, n0, lds, [&](int, int, f32x4&) {}, ppb, DM, 1024);
      zero_acc(acc);
      float rsv[4];
      row_rs(rsv, rowpart, m0);
      gemm_accum(acc, RowPtr{hbuf + (size_t)m0 * DM, DM}, RowPtr{wl + W_PG + (size_t)n0 * 1024, 1024}, 16, lds);
      scale_rows(acc, rsv);
      gemm_epi(acc, m0, n0, [&](int m, int n, f32x4& a) {
        uint2 pv = *(const uint2*)(ppb + (size_t)m * DM + n);
        float4* o = (float4*)(p.out + (size_t)m * DM + n);
        float4 xv = *o;
        *o = make_float4(xv.x + sigmoidf(a[0]) * bflo(pv.x), xv.y + sigmoidf(a[1]) * bfhi(pv.x),
                         xv.z + sigmoidf(a[2]) * bflo(pv.y), xv.w + sigmoidf(a[3]) * bfhi(pv.y));
      });
    }
    xcd_barrier(bar, xb_x, xb_nloc, xb_nx);
  }
}

extern "C" void kernel_launch(void* const* d_in, const int* in_sizes, int n_in,
                              void* d_out, int out_size, void* d_ws, size_t ws_size,
                              hipStream_t stream) {
  static int grid_blocks = 0;
  if (!grid_blocks) {
    int dev = 0, cus = 0, per_cu = 0;
    hipGetDevice(&dev);
    hipDeviceGetAttribute(&cus, hipDeviceAttributeMultiprocessorCount, dev);
    hipFuncSetAttribute((const void*)mega, hipFuncAttributeMaxDynamicSharedMemorySize, DYN_LDS);
    hipOccupancyMaxActiveBlocksPerMultiprocessor(&per_cu, mega, 512, DYN_LDS);
    if (per_cu > 1) per_cu = 1;
    if (per_cu < 1) per_cu = 1;
    grid_blocks = cus * per_cu;
  }
  if (ws_size < WS_NEED) {
    fprintf(stderr, "workspace too small: %zu < %llu\n", ws_size, (unsigned long long)WS_NEED);
    return;
  }
  Params p{};
  p.x = (const float*)d_in[0]; p.p = (const float*)d_in[1]; p.norm_mix = (const float*)d_in[2]; p.w_in = (const float*)d_in[3];
  p.nsa_q_norm = (const float*)d_in[4]; p.nsa_k_norm = (const float*)d_in[5]; p.cmp_pos_k = (const float*)d_in[6];
  p.cmp_pos_v = (const float*)d_in[7]; p.cmp_w1_k = (const float*)d_in[8]; p.cmp_w2_k = (const float*)d_in[9];
  p.cmp_w1_v = (const float*)d_in[10]; p.cmp_w2_v = (const float*)d_in[11]; p.w_up_nsa = (const float*)d_in[12];
  p.w_up_ret = (const float*)d_in[13]; p.w_out = (const float*)d_in[14]; p.norm_mlp = (const float*)d_in[15];
  p.w_ff1 = (const float*)d_in[16]; p.w_ff2 = (const float*)d_in[17]; p.norm_ple = (const float*)d_in[18];
  p.w_ple = (const float*)d_in[19]; p.w_ple_gate = (const float*)d_in[20];
  p.out = (float*)d_out; p.ws = (char*)d_ws;
  hipMemsetAsync((char*)d_ws + O_BAR, 0, BAR_BYTES, stream);
  void* args[] = {&p};
  hipError_t e = hipLaunchCooperativeKernel((void*)mega, dim3(grid_blocks), dim3(512), args, DYN_LDS, stream);
  if (e != hipSuccess) fprintf(stderr, "cooperative launch failed: %s (grid %d)\n", hipGetErrorString(e), grid_blocks);
}
```

```cpp
#include <hip/hip_runtime.h>
#include <hip/hip_cooperative_groups.h>
#include <cstdio>
#include <cstdint>
namespace cg = cooperative_groups;

typedef __attribute__((ext_vector_type(8))) short bf16x8;
typedef __attribute__((ext_vector_type(4))) float f32x4;
typedef unsigned short bf16_t;
typedef __attribute__((ext_vector_type(4))) unsigned u32x4;
#define DI __device__ __forceinline__

#define T_TOK 32768
#define SEQ 8192
#define DM 1024
#define ZS 5400
#define C_Q 0
#define C_KC 512
#define C_VC 640
#define C_KS 768
#define C_VS 896
#define C_KW 1024
#define C_VW 1152
#define C_GT 1280
#define C_RQ 1304
#define C_RK 1816
#define C_RV 2328
#define C_RG 2840
#define C_MA 3352
#define C_MB 4376
#define NPAD_IN 5504
#define TS 8256

#define W_IN 0
#define W_C1K 5636096
#define W_C1V 6160384
#define W_UPA 6684672
#define W_UPR 7208960
#define W_OUT 7733248
#define W_FF1 8781824
#define W_FF2 12976128
#define W_PLE 17170432
#define W_PG 17432576
#define W_LAYER 18481152

#define O_WT 0ull
#define O_ROPE 36962304ull
#define O_BIAS 41156608ull
#define O_HID 41160704ull
#define O_KCMP 45355008ull
#define O_VCMPT 45879296ull
#define O_VST 46403584ull
#define O_VWT 54857728ull
#define O_RVT 63311872ull
#define O_KZT 97128448ull
#define O_Z 130945024ull
#define O_ONSA 484839424ull
#define O_BAR 518393856ull
#define BAR_BYTES 13824
#define O_KVD 518407680ull
#define O_RP 535184896ull
#define WS_NEED 536233472ull
#define DYN_LDS 131072

struct Params {
  const float* x; const float* p; const float* norm_mix; const float* w_in;
  const float* nsa_q_norm; const float* nsa_k_norm; const float* cmp_pos_k; const float* cmp_pos_v;
  const float* cmp_w1_k; const float* cmp_w2_k; const float* cmp_w1_v; const float* cmp_w2_v;
  const float* w_up_nsa; const float* w_up_ret; const float* w_out; const float* norm_mlp;
  const float* w_ff1; const float* w_ff2; const float* norm_ple; const float* w_ple; const float* w_ple_gate;
  float* out; char* ws;
};

DI unsigned pack2(float a, float b) {
  typedef __attribute__((ext_vector_type(2))) __bf16 bf2;
  typedef __attribute__((ext_vector_type(2))) float f2;
  f2 v = {a, b};
  bf2 r = __builtin_convertvector(v, bf2);
  return __builtin_bit_cast(unsigned, r);
}
DI bf16_t f2bf(float a) { return (bf16_t)(pack2(a, 0.f) & 0xffffu); }
DI float bf2f(bf16_t h) { return __uint_as_float(((unsigned)h) << 16); }
DI float bflo(unsigned u) { return __uint_as_float(u << 16); }
DI float bfhi(unsigned u) { return __uint_as_float(u & 0xffff0000u); }
DI float shx(float v, int mask, int lane) {
  return __int_as_float(__builtin_amdgcn_ds_bpermute((lane ^ mask) << 2, __float_as_int(v)));
}
DI uint32_t shxu(uint32_t v, int mask, int lane) {
  return (uint32_t)__builtin_amdgcn_ds_bpermute((lane ^ mask) << 2, (int)v);
}
DI float shfrom(float v, int srclane) {
  return __int_as_float(__builtin_amdgcn_ds_bpermute(srclane << 2, __float_as_int(v)));
}
DI float wave_sum(float v, int lane) {
#pragma unroll
  for (int o = 32; o > 0; o >>= 1) v += shx(v, o, lane);
  return v;
}
DI int TID() { int t = threadIdx.x & 255; asm volatile("" : "+v"(t)); return t; }
DI int HALF() { return __builtin_amdgcn_readfirstlane((int)(threadIdx.x >> 8)); }
#define VBID ((int)(blockIdx.x * 2) + HALF())
#define NVB ((int)(gridDim.x * 2))
DI float sigmoidf(float x) { return 1.f / (1.f + __expf(-x)); }
DI f32x4 mfma16(bf16x8 a, bf16x8 b, f32x4 c) { return __builtin_amdgcn_mfma_f32_16x16x32_bf16(a, b, c, 0, 0, 0); }
DI bf16x8 mk8(unsigned a, unsigned b, unsigned c, unsigned d) {
  uint4 u = make_uint4(a, b, c, d);
  return __builtin_bit_cast(bf16x8, u);
}

template <class AP, class BP>
DI void g_load(u32x4 (&ra)[4], u32x4 (&rb)[4], const AP& ap, const BP& bp, int kb, int lrow, int lch) {
#pragma unroll
  for (int i = 0; i < 4; ++i) {
    ra[i] = *(const u32x4*)(ap(lrow + 32 * i, kb) + lch * 8);
    rb[i] = *(const u32x4*)(bp(lrow + 32 * i, kb) + lch * 8);
  }
}
DI void g_store(bf16_t* As, bf16_t* Bs, const u32x4 (&ra)[4], const u32x4 (&rb)[4], int buf, int lrow, int lch) {
#pragma unroll
  for (int i = 0; i < 4; ++i) {
    int r = lrow + 32 * i;
    int off = buf * 8192 + r * 64 + ((lch ^ ((r >> 1) & 7)) << 3);
    *(u32x4*)(As + off) = ra[i];
    *(u32x4*)(Bs + off) = rb[i];
  }
}
DI void g_compute(f32x4 (&acc)[4][4], const bf16_t* a, const bf16_t* b, int wm, int wn, int lane) {
  bf16x8 af[2][4], bfr[2][4];
#pragma unroll
  for (int ks = 0; ks < 2; ++ks)
#pragma unroll
    for (int i = 0; i < 4; ++i) {
      int r = wm * 64 + i * 16 + (lane & 15);
      af[ks][i] = *(const bf16x8*)(a + r * 64 + (((ks * 4 + (lane >> 4)) ^ ((r >> 1) & 7)) << 3));
      int r2 = wn * 64 + i * 16 + (lane & 15);
      bfr[ks][i] = *(const bf16x8*)(b + r2 * 64 + (((ks * 4 + (lane >> 4)) ^ ((r2 >> 1) & 7)) << 3));
    }
  __builtin_amdgcn_s_setprio(1);
#pragma unroll
  for (int ks = 0; ks < 2; ++ks)
#pragma unroll
    for (int i = 0; i < 4; ++i)
#pragma unroll
      for (int j = 0; j < 4; ++j) acc[i][j] = mfma16(bfr[ks][j], af[ks][i], acc[i][j]);
  __builtin_amdgcn_s_setprio(0);
}
template <class AP, class BP>
DI void gemm_accum(f32x4 (&acc)[4][4], AP ap, BP bp, int nkb, bf16_t* lds) {
  const int tid = TID(), lane = tid & 63, w = tid >> 6;
  const int wm = w >> 1, wn = w & 1;
  const int lrow = tid >> 3, lch = tid & 7;
  bf16_t* As = lds;
  bf16_t* Bs = lds + 16384;
  u32x4 ra0[4], rb0[4], ra1[4], rb1[4];
  __syncthreads();
  g_load(ra0, rb0, ap, bp, 0, lrow, lch);
  g_load(ra1, rb1, ap, bp, 1, lrow, lch);
  g_store(As, Bs, ra0, rb0, 0, lrow, lch);
  __syncthreads();
  for (int kb = 0; kb < nkb; kb += 2) {
    const int k2 = (kb + 2 < nkb) ? kb + 2 : nkb - 2;
    g_load(ra0, rb0, ap, bp, k2, lrow, lch);
    __builtin_amdgcn_sched_barrier(0);
    g_compute(acc, As, Bs, wm, wn, lane);
    g_store(As, Bs, ra1, rb1, 1, lrow, lch);
    __syncthreads();
    g_load(ra1, rb1, ap, bp, k2 + 1, lrow, lch);
    __builtin_amdgcn_sched_barrier(0);
    g_compute(acc, As + 8192, Bs + 8192, wm, wn, lane);
    g_store(As, Bs, ra0, rb0, 0, lrow, lch);
    __syncthreads();
  }
}
template <class E>
DI void gemm_epi(f32x4 (&acc)[4][4], int m0, int n0, E e) {
  const int tid_ = TID();
  const int lane = tid_ & 63, w = tid_ >> 6;
  const int wm = w >> 1, wn = w & 1;
#pragma unroll
  for (int i = 0; i < 4; ++i)
#pragma unroll
    for (int j = 0; j < 4; ++j) {
      int m = m0 + wm * 64 + i * 16 + (lane & 15);
      int n = n0 + wn * 64 + j * 16 + (lane >> 4) * 4;
      e(m, n, acc[i][j]);
    }
}
template <class F>
DI void gemm_epi_staged(f32x4 (&acc)[4][4], int m0, int n0, bf16_t* lds, F f, bf16_t* dst, size_t ld, int nmax) {
  const int tid_ = TID();
  const int lane = tid_ & 63, w = tid_ >> 6;
  const int wm = w >> 1, wn = w & 1;
#pragma unroll
  for (int i = 0; i < 4; ++i)
#pragma unroll
    for (int j = 0; j < 4; ++j) {
      const int ml = wm * 64 + i * 16 + (lane & 15);
      const int nl = wn * 64 + j * 16 + (lane >> 4) * 4;
      f32x4 a = acc[i][j];
      f(m0 + ml, n0 + nl, a);
      uint2 u;
      u.x = pack2(a[0], a[1]);
      u.y = pack2(a[2], a[3]);
      *(uint2*)(lds + ml * 136 + nl) = u;
    }
  __syncthreads();
#pragma unroll
  for (int it = 0; it < 8; ++it) {
    const int idx = tid_ + 256 * it;
    const int row = idx >> 4, ch = idx & 15;
    const u32x4 v = *(const u32x4*)(lds + row * 136 + ch * 8);
    const int n = n0 + ch * 8;
    if (n < nmax) *(u32x4*)(dst + (size_t)(m0 + row) * ld + n) = v;
  }
}
DI void gemm_epi_resid(f32x4 (&acc)[4][4], int m0, int n0, int ntile, bf16_t* lds, const float* xin, float* out, bf16_t* xb, float* rowpart) {
  const int tid_ = TID();
  const int lane = tid_ & 63, w = tid_ >> 6;
  const int wm = w >> 1, wn = w & 1;
  float* red = (float*)lds;
#pragma unroll
  for (int i = 0; i < 4; ++i) {
    const int ml = wm * 64 + i * 16 + (lane & 15);
    const size_t rowoff = (size_t)(m0 + ml) * DM;
    float ss = 0.f;
#pragma unroll
    for (int j = 0; j < 4; ++j) {
      const int n = n0 + wn * 64 + j * 16 + (lane >> 4) * 4;
      const float4 xv = *(const float4*)(xin + rowoff + n);
      const float o0 = xv.x + acc[i][j][0], o1 = xv.y + acc[i][j][1], o2 = xv.z + acc[i][j][2], o3 = xv.w + acc[i][j][3];
      *(float4*)(out + rowoff + n) = make_float4(o0, o1, o2, o3);
      ss += o0 * o0 + o1 * o1 + o2 * o2 + o3 * o3;
      uint2 u;
      u.x = pack2(o0, o1);
      u.y = pack2(o2, o3);
      *(uint2*)(xb + rowoff + n) = u;
    }
    ss += shx(ss, 16, lane);
    ss += shx(ss, 32, lane);
    if ((lane >> 4) == 0) red[wn * 128 + ml] = ss;
  }
  __syncthreads();
  if (tid_ < 128) rowpart[(size_t)ntile * T_TOK + m0 + tid_] = red[tid_] + red[128 + tid_];
}
DI void row_rs(float (&rsv)[4], const float* rowpart, int m0) {
  const int tid_ = TID();
  const int lane = tid_ & 63, wm = tid_ >> 7;
#pragma unroll
  for (int i = 0; i < 4; ++i) {
    const int m = m0 + wm * 64 + i * 16 + (lane & 15);
    float s = 0.f;
#pragma unroll
    for (int t = 0; t < 8; ++t) s += rowpart[(size_t)t * T_TOK + m];
    rsv[i] = rsqrtf(s * (1.f / 1024.f) + 1e-6f);
  }
}
DI void scale_rows(f32x4 (&acc)[4][4], const float (&rsv)[4]) {
#pragma unroll
  for (int i = 0; i < 4; ++i)
#pragma unroll
    for (int j = 0; j < 4; ++j) acc[i][j] *= rsv[i];
}
DI void zero_acc(f32x4 (&acc)[4][4]) {
#pragma unroll
  for (int i = 0; i < 4; ++i)
#pragma unroll
    for (int j = 0; j < 4; ++j) acc[i][j] = f32x4{0.f, 0.f, 0.f, 0.f};
}
struct RowPtr {
  const bf16_t* base; size_t ld;
  DI const bf16_t* operator()(int r, int kb) const { return base + (size_t)r * ld + kb * 64; }
};

DI void convert_wt(const float* W, bf16_t* Wt, int K, int N, int Npad, int gtid, int gthreads, const float* gk = nullptr) {
  const int k8n = K >> 3;
  const long total = (long)Npad * k8n;
  for (long idx = gtid; idx < total; idx += gthreads) {
    int n = (int)(idx % Npad);
    int k8 = (int)(idx / Npad);
    uint4 o = make_uint4(0, 0, 0, 0);
    if (n < N) {
      const float* s = W + (size_t)(k8 * 8) * N + n;
      float v0 = s[0], v1 = s[(size_t)N], v2 = s[(size_t)2 * N], v3 = s[(size_t)3 * N];
      float v4 = s[(size_t)4 * N], v5 = s[(size_t)5 * N], v6 = s[(size_t)6 * N], v7 = s[(size_t)7 * N];
      if (gk) {
        const float* gp = gk + k8 * 8;
        v0 *= gp[0]; v1 *= gp[1]; v2 *= gp[2]; v3 *= gp[3]; v4 *= gp[4]; v5 *= gp[5]; v6 *= gp[6]; v7 *= gp[7];
      }
      o = make_uint4(pack2(v0, v1), pack2(v2, v3), pack2(v4, v5), pack2(v6, v7));
    }
    *(uint4*)(Wt + (size_t)n * K + k8 * 8) = o;
  }
}

DI void phase0(const Params& p, const int L) {
  const int gtid = VBID * 256 + TID();
  const int gthreads = NVB * 256;
  bf16_t* wl = (bf16_t*)(p.ws + O_WT);
  convert_wt(p.w_in + (size_t)L * 1024 * 5400, wl + W_IN, 1024, 5400, NPAD_IN, gtid, gthreads);
  convert_wt(p.cmp_w1_k + (size_t)L * 2048 * 256, wl + W_C1K, 2048, 256, 256, gtid, gthreads);
  convert_wt(p.cmp_w1_v + (size_t)L * 2048 * 256, wl + W_C1V, 2048, 256, 256, gtid, gthreads);
  convert_wt(p.w_up_nsa + (size_t)L * 512 * 1024, wl + W_UPA, 512, 1024, 1024, gtid, gthreads);
  convert_wt(p.w_up_ret + (size_t)L * 512 * 1024, wl + W_UPR, 512, 1024, 1024, gtid, gthreads);
  convert_wt(p.w_out + (size_t)L * 1024 * 1024, wl + W_OUT, 1024, 1024, 1024, gtid, gthreads);
  convert_wt(p.w_ff1 + (size_t)L * 1024 * 4096, wl + W_FF1, 1024, 4096, 4096, gtid, gthreads, p.norm_mlp + L * DM);
  convert_wt(p.w_ff2 + (size_t)L * 4096 * 1024, wl + W_FF2, 4096, 1024, 1024, gtid, gthreads);
  convert_wt(p.w_ple + (size_t)L * 256 * 1024, wl + W_PLE, 256, 1024, 1024, gtid, gthreads);
  convert_wt(p.w_ple_gate + (size_t)L * 1024 * 1024, wl + W_PG, 1024, 1024, 1024, gtid, gthreads, p.norm_ple + L * DM);
  if (L == 0) {
    float2* rope = (float2*)(p.ws + O_ROPE);
    for (int idx = gtid; idx < SEQ * 64; idx += gthreads) {
      int pos = idx >> 6, j = idx & 63;
      float inv = exp2f(-(float)j * (13.287712379549449f / 64.f));
      float ang = (float)pos * inv;
      double rev = (double)ang * 0.15915494309189535;
      rev -= rint(rev);
      float fr = (float)rev;
      rope[idx] = make_float2(__builtin_amdgcn_cosf(fr), __builtin_amdgcn_sinf(fr));
    }
  }
  float* part = (float*)(p.ws + O_HID);
  {
    const int n = gtid & 255;
    for (int item = VBID; item < 128; item += NVB) {
      const int kv = item >> 6, kc = item & 63;
      const float* pos = (kv ? p.cmp_pos_v : p.cmp_pos_k) + L * 2048 + kc * 32;
      const float* w1 = (kv ? p.cmp_w1_v : p.cmp_w1_k) + (size_t)L * 2048 * 256 + (size_t)kc * 32 * 256;
      float a = 0.f;
#pragma unroll 8
      for (int k = 0; k < 32; ++k) a += pos[k] * w1[(size_t)k * 256 + n];
      part[item * 256 + n] = a;
    }
  }
}

DI void norm_phase(const float* xin, const float* g, bf16_t* h) {
  const int tid_ = TID();
  const int lane = tid_ & 63;
  const int gw = (VBID * 256 + tid_) >> 6;
  const int nw = NVB * 4;
  float4 gv[4];
#pragma unroll
  for (int i = 0; i < 4; ++i) gv[i] = ((const float4*)g)[i * 64 + lane];
  for (int row = gw; row < T_TOK; row += nw) {
    const float4* xr = (const float4*)(xin + (size_t)row * DM);
    float4 v[4];
    float ss = 0.f;
#pragma unroll
    for (int i = 0; i < 4; ++i) {
      v[i] = xr[i * 64 + lane];
      ss += v[i].x * v[i].x + v[i].y * v[i].y + v[i].z * v[i].z + v[i].w * v[i].w;
    }
    ss = wave_sum(ss, lane);
    float rs = rsqrtf(ss * (1.f / 1024.f) + 1e-6f);
    uint2* hr = (uint2*)(h + (size_t)row * DM);
#pragma unroll
    for (int i = 0; i < 4; ++i) {
      uint2 o;
      o.x = pack2(v[i].x * rs * gv[i].x, v[i].y * rs * gv[i].y);
      o.y = pack2(v[i].z * rs * gv[i].z, v[i].w * rs * gv[i].w);
      hr[i * 64 + lane] = o;
    }
  }
}

DI void post_z(const Params& p, int layer) {
  const int tid_ = TID();
  const int lane = tid_ & 63;
  const int gw = (VBID * 256 + tid_) >> 6;
  const int nw = NVB * 4;
  bf16_t* z = (bf16_t*)(p.ws + O_Z);
  bf16_t* vsT = (bf16_t*)(p.ws + O_VST);
  bf16_t* vwT = (bf16_t*)(p.ws + O_VWT);
  bf16_t* rvT = (bf16_t*)(p.ws + O_RVT);
  bf16_t* kzT = (bf16_t*)(p.ws + O_KZT);
  const float2* rope = (const float2*)(p.ws + O_ROPE);
  const float* qn = p.nsa_q_norm + layer * 64;
  const float* kn = p.nsa_k_norm + layer * 64;
  {
    const float* part = (const float*)(p.ws + O_HID);
    float* bias = (float*)(p.ws + O_BIAS);
    const int idx = VBID * 256 + tid_;
    if (idx < 512) {
      const int kv = idx >> 8, n = idx & 255;
      float a = 0.f;
      for (int kc = 0; kc < 64; ++kc) a += part[(kv * 64 + kc) * 256 + n];
      bias[idx] = a;
    }
  }
  for (int item = gw; item < 1024 * 36; item += nw) {
    const int tc = item / 36, slab = item - tc * 36;
    const int tok0 = tc * 32;
    const int b = tok0 >> 13, spos = tok0 & 8191;
    bf16_t* zr = z + (size_t)tok0 * ZS;
    if (slab >= 32) {
      const int s4 = slab - 32, kv = s4 >> 1, gi = s4 & 1;
      const int colbase = (kv ? C_VC : C_KC) + gi * 64;
      bf16_t* dst = (bf16_t*)(p.ws + O_KVD) + ((size_t)((kv * 8 + b * 2 + gi) * SEQ + spos)) * 64 + lane;
      bf16_t u[32];
#pragma unroll
      for (int i = 0; i < 32; ++i) u[i] = zr[(size_t)i * ZS + colbase + lane];
#pragma unroll
      for (int i = 0; i < 32; ++i) dst[i * 64] = u[i];
    } else if (slab < 12) {
      int colbase; const float* g; float sc;
      if (slab < 8) { colbase = C_Q + slab * 64; g = qn; sc = 0.125f; }
      else if (slab < 10) { colbase = C_KS + (slab - 8) * 64; g = kn; sc = 1.f; }
      else { colbase = C_KW + (slab - 10) * 64; g = kn; sc = 1.f; }
      const float gv = g[lane] * sc;
      float v[32];
#pragma unroll
      for (int i = 0; i < 32; ++i) v[i] = bf2f(zr[(size_t)i * ZS + colbase + lane]);
#pragma unroll
      for (int i = 0; i < 32; ++i) {
        float ss = wave_sum(v[i] * v[i], lane);
        float rs = rsqrtf(ss * (1.f / 64.f) + 1e-6f);
        zr[(size_t)i * ZS + colbase + lane] = f2bf(v[i] * rs * gv);
      }
    } else if (slab < 16 || slab >= 24) {
      int colbase; bf16_t* dst;
      if (slab < 16) {
        const int gi = slab & 1;
        const bool isw = slab >= 14;
        colbase = (isw ? C_VW : C_VS) + gi * 64;
        dst = (isw ? vwT : vsT) + ((size_t)((b * 2 + gi) * 64 + lane)) * TS + spos;
      } else {
        const int s8 = slab - 24;
        const int h = s8 >> 1, half = s8 & 1;
        colbase = C_RV + s8 * 64;
        dst = rvT + ((size_t)((b * 4 + h) * 128 + half * 64 + lane)) * TS + spos;
      }
      unsigned u[32];
#pragma unroll
      for (int i = 0; i < 32; ++i) u[i] = zr[(size_t)i * ZS + colbase + lane];
#pragma unroll
      for (int q4 = 0; q4 < 4; ++q4)
        *(uint4*)(dst + q4 * 8) = make_uint4(u[q4 * 8 + 0] | (u[q4 * 8 + 1] << 16), u[q4 * 8 + 2] | (u[q4 * 8 + 3] << 16),
                                             u[q4 * 8 + 4] | (u[q4 * 8 + 5] << 16), u[q4 * 8 + 6] | (u[q4 * 8 + 7] << 16));
    } else if (slab < 20) {
      const int h = slab - 16;
      const int colbase = C_RQ + h * 128;
      float x1[32], x2[32];
#pragma unroll
      for (int i = 0; i < 32; ++i) {
        const bf16_t* p1 = zr + (size_t)i * ZS + colbase + lane;
        x1[i] = bf2f(p1[0]);
        x2[i] = bf2f(p1[64]);
      }
#pragma unroll
      for (int i = 0; i < 32; ++i) {
        bf16_t* p1 = zr + (size_t)i * ZS + colbase + lane;
        float2 cs = rope[(spos + i) * 64 + lane];
        p1[0] = f2bf(x1[i] * cs.x - x2[i] * cs.y);
        p1[64] = f2bf(x1[i] * cs.y + x2[i] * cs.x);
      }
    } else {
      const int h = slab - 20;
      const int colbase = C_RK + h * 128;
      const float lg2 = log2f(1.f - exp2f(-5.f - (float)h));
      float x1[32], x2[32];
#pragma unroll
      for (int i = 0; i < 32; ++i) {
        const bf16_t* p1 = zr + (size_t)i * ZS + colbase + lane;
        x1[i] = bf2f(p1[0]);
        x2[i] = bf2f(p1[64]);
      }
      unsigned u1[32], u2[32];
#pragma unroll
      for (int i = 0; i < 32; ++i) {
        bf16_t* p1 = zr + (size_t)i * ZS + colbase + lane;
        float2 cs = rope[(spos + i) * 64 + lane];
        float o1 = (x1[i] * cs.x - x2[i] * cs.y) * 0.08838834764831845f;
        float o2 = (x1[i] * cs.y + x2[i] * cs.x) * 0.08838834764831845f;
        p1[0] = f2bf(o1);
        p1[64] = f2bf(o2);
        float zeta = exp2f(lg2 * (float)(127 - ((spos + i) & 127)));
        u1[i] = f2bf(o1 * zeta);
        u2[i] = f2bf(o2 * zeta);
      }
      bf16_t* d1 = kzT + ((size_t)((b * 4 + h) * 128 + lane)) * TS + spos;
#pragma unroll
      for (int q4 = 0; q4 < 4; ++q4) {
        *(uint4*)(d1 + q4 * 8) = make_uint4(u1[q4 * 8 + 0] | (u1[q4 * 8 + 1] << 16), u1[q4 * 8 + 2] | (u1[q4 * 8 + 3] << 16),
                                            u1[q4 * 8 + 4] | (u1[q4 * 8 + 5] << 16), u1[q4 * 8 + 6] | (u1[q4 * 8 + 7] << 16));
        *(uint4*)(d1 + (size_t)64 * TS + q4 * 8) = make_uint4(u2[q4 * 8 + 0] | (u2[q4 * 8 + 1] << 16), u2[q4 * 8 + 2] | (u2[q4 * 8 + 3] << 16),
                                                              u2[q4 * 8 + 4] | (u2[q4 * 8 + 5] << 16), u2[q4 * 8 + 6] | (u2[q4 * 8 + 7] << 16));
      }
    }
  }
}

DI void phase4b(const Params& p, int layer) {
  const int tid_ = TID();
  const int lane = tid_ & 63;
  const int gw = (VBID * 256 + tid_) >> 6;
  const int nw = NVB * 4;
  bf16_t* z = (bf16_t*)(p.ws + O_Z);
  const bf16_t* hid = (const bf16_t*)(p.ws + O_HID);
  bf16_t* kcmp = (bf16_t*)(p.ws + O_KCMP);
  bf16_t* vcmpT = (bf16_t*)(p.ws + O_VCMPT);
  const float* kn = p.nsa_k_norm + layer * 64;
  for (int item = gw; item < 8192; item += nw) {
    const int kv = item >> 12, row = item & 4095;
    const bf16_t* hrow = hid + ((size_t)kv * 4096 + row) * 256;
    const float* w2 = (kv ? p.cmp_w2_v : p.cmp_w2_k) + (size_t)layer * 256 * 64;
    float acc = 0.f;
    for (int k8 = 0; k8 < 32; ++k8) {
      uint4 hv = *(const uint4*)(hrow + k8 * 8);
      const float* wr = w2 + (size_t)(k8 * 8) * 64 + lane;
      acc += bflo(hv.x) * wr[0];
      acc += bfhi(hv.x) * wr[64];
      acc += bflo(hv.y) * wr[128];
      acc += bfhi(hv.y) * wr[192];
      acc += bflo(hv.z) * wr[256];
      acc += bfhi(hv.z) * wr[320];
      acc += bflo(hv.w) * wr[384];
      acc += bfhi(hv.w) * wr[448];
    }
    if (kv == 0) {
      float ss = wave_sum(acc * acc, lane);
      float rs = rsqrtf(ss * (1.f / 64.f) + 1e-6f);
      kcmp[(size_t)row * 64 + lane] = f2bf(acc * rs * kn[lane]);
    } else {
      const int bg = row >> 9, c = row & 511;
      vcmpT[((size_t)(bg * 64 + lane)) * 512 + c] = f2bf(acc);
    }
  }
  const int gtid = VBID * 256 + tid_;
  const int gthreads = NVB * 256;
  for (int idx = gtid; idx < 65536; idx += gthreads) {
    const int d4 = idx & 31, e = (idx >> 5) & 127, h = (idx >> 12) & 3, b = idx >> 14;
    const float lg2 = log2f(1.f - exp2f(-5.f - (float)h));
    const float gch = exp2f(lg2 * 128.f);
    float r0 = 0.f, r1 = 0.f, r2 = 0.f, r3 = 0.f;
    bf16_t* ptr = z + ((size_t)(b * SEQ + e)) * ZS + C_RV + h * 128 + d4 * 4;
    for (int c0 = 0; c0 < 64; c0 += 16) {
      typedef __attribute__((ext_vector_type(2))) unsigned u32x2;
      u32x2 v[16];
#pragma unroll
      for (int i = 0; i < 16; ++i) v[i] = *(const u32x2*)(ptr + (size_t)(c0 + i) * 128 * ZS);
#pragma unroll
      for (int i = 0; i < 16; ++i) {
        u32x2 o;
        o.x = pack2(r0, r1);
        o.y = pack2(r2, r3);
        *(u32x2*)(ptr + (size_t)(c0 + i) * 128 * ZS) = o;
        r0 = gch * r0 + bflo(v[i].x);
        r1 = gch * r1 + bfhi(v[i].x);
        r2 = gch * r2 + bflo(v[i].y);
        r3 = gch * r3 + bfhi(v[i].y);
      }
    }
  }
}


DI void tile64_gload(int tid, u32x4& r0, u32x4& r1, const bf16_t* base, size_t stride) {
  {
    int idx = tid;
    int row = idx >> 3, ch = idx & 7;
    r0 = *(const u32x4*)(base + (size_t)row * stride + ch * 8);
  }
  {
    int idx = tid + 256;
    int row = idx >> 3, ch = idx & 7;
    r1 = *(const u32x4*)(base + (size_t)row * stride + ch * 8);
  }
}
DI void tile64_sstore(int tid, bf16_t* dst, const u32x4& r0, const u32x4& r1) {
  {
    int idx = tid;
    int row = idx >> 3, ch = idx & 7;
    *(u32x4*)(dst + row * 64 + ((ch ^ ((row >> 1) & 7)) << 3)) = r0;
  }
  {
    int idx = tid + 256;
    int row = idx >> 3, ch = idx & 7;
    *(u32x4*)(dst + row * 64 + ((ch ^ ((row >> 1) & 7)) << 3)) = r1;
  }
}

struct AttnSt { f32x4 O[2][4]; f32x4 L[2]; float m[2]; float l[2]; };

template <int MODE, bool FX>
DI void attn_compute(const int lane, const bf16_t* Ks, const bf16_t* Vs, const bf16x8 (&qf)[2][2], AttnSt& st, const float (&invl)[2],
                     int lo, int hi, float (&impA)[4], float (&impE)[4], const float CL) {
  const int quad = lane >> 4, col = lane & 15;
  f32x4 S[4][2];
#pragma unroll
  for (int kt = 0; kt < 4; ++kt)
#pragma unroll
    for (int hh = 0; hh < 2; ++hh) S[kt][hh] = f32x4{0.f, 0.f, 0.f, 0.f};
#pragma unroll
  for (int ks = 0; ks < 2; ++ks) {
#pragma unroll
    for (int kt = 0; kt < 4; ++kt) {
      int row = kt * 16 + col;
      bf16x8 kf = *(const bf16x8*)(Ks + row * 64 + (((ks * 4 + quad) ^ ((row >> 1) & 7)) << 3));
#pragma unroll
      for (int hh = 0; hh < 2; ++hh) S[kt][hh] = mfma16(kf, qf[hh][ks], S[kt][hh]);
    }
  }
  bf16x8 pf[2][2];
  const bool full = (lo <= 0) && (hi >= 63);
  const bool none = (hi < 0) || (lo > 63) || (hi < lo);
  if (__all(full || none)) {
    constexpr float L2E = 1.4426950408889634f;
#pragma unroll
    for (int hh = 0; hh < 2; ++hh) {
      float mL;
      float il = 1.f;
      if (FX) {
        mL = full ? CL : 1e30f;
        if (MODE == 1) il = invl[hh];
      } else if (MODE != 1) {
        float mx = -1e30f;
#pragma unroll
        for (int kt = 0; kt < 4; ++kt)
#pragma unroll
          for (int j = 0; j < 4; ++j) mx = fmaxf(mx, S[kt][hh][j]);
        mx = full ? mx : -1e30f;
        mx = fmaxf(mx, shx(mx, 16, lane));
        mx = fmaxf(mx, shx(mx, 32, lane));
        const float m_new = fmaxf(st.m[hh], mx);
        const float alpha = __expf(st.m[hh] - m_new);
        st.m[hh] = m_new;
        st.l[hh] *= alpha;
        if (MODE == 2) {
#pragma unroll
          for (int dt = 0; dt < 4; ++dt) st.O[hh][dt] *= alpha;
        }
        mL = full ? m_new * L2E : 1e30f;
      } else {
        mL = full ? st.m[hh] * L2E : 1e30f;
        il = invl[hh];
      }
      float rs = 0.f;
#pragma unroll
      for (int kt = 0; kt < 4; ++kt) {
        float a = 0.f;
#pragma unroll
        for (int j = 0; j < 4; ++j) {
          float pv = __builtin_amdgcn_exp2f(fmaf(S[kt][hh][j], L2E, -mL));
          if (MODE == 1) pv *= il;
          S[kt][hh][j] = pv;
          a += pv;
        }
        rs += a;
        if (MODE == 1) {
          impA[kt] += a;
          impE[kt] += S[kt][hh][3];
        }
      }
      if (MODE != 1 && !(FX && MODE == 2)) st.l[hh] += rs;
      if (MODE != 0) {
#pragma unroll
        for (int c = 0; c < 2; ++c)
          pf[hh][c] = mk8(pack2(S[2 * c][hh][0], S[2 * c][hh][1]), pack2(S[2 * c][hh][2], S[2 * c][hh][3]),
                          pack2(S[2 * c + 1][hh][0], S[2 * c + 1][hh][1]), pack2(S[2 * c + 1][hh][2], S[2 * c + 1][hh][3]));
      }
    }
  } else {
#pragma unroll
  for (int hh = 0; hh < 2; ++hh) {
    if (FX) {
      constexpr float L2E = 1.4426950408889634f;
      const float il = (MODE == 1) ? invl[hh] : 1.f;
      float rs = 0.f;
#pragma unroll
      for (int kt = 0; kt < 4; ++kt) {
        float a = 0.f;
#pragma unroll
        for (int j = 0; j < 4; ++j) {
          const int kl = kt * 16 + quad * 4 + j;
          const bool v = (kl >= lo) && (kl <= hi);
          float pv = v ? __builtin_amdgcn_exp2f(fmaf(S[kt][hh][j], L2E, -CL)) : 0.f;
          if (MODE == 1) pv *= il;
          S[kt][hh][j] = pv;
          a += pv;
        }
        rs += a;
        if (MODE == 1) {
          impA[kt] += a;
          impE[kt] += S[kt][hh][3];
        }
      }
      if (MODE != 1 && !(FX && MODE == 2)) st.l[hh] += rs;
      if (MODE != 0) {
#pragma unroll
        for (int c = 0; c < 2; ++c)
          pf[hh][c] = mk8(pack2(S[2 * c][hh][0], S[2 * c][hh][1]), pack2(S[2 * c][hh][2], S[2 * c][hh][3]),
                          pack2(S[2 * c + 1][hh][0], S[2 * c + 1][hh][1]), pack2(S[2 * c + 1][hh][2], S[2 * c + 1][hh][3]));
      }
      continue;
    }
    float mx = -1e30f;
#pragma unroll
    for (int kt = 0; kt < 4; ++kt)
#pragma unroll
      for (int j = 0; j < 4; ++j) {
        int kl = kt * 16 + quad * 4 + j;
        bool v = (kl >= lo) && (kl <= hi);
        float sv = v ? S[kt][hh][j] : -1e30f;
        S[kt][hh][j] = sv;
        mx = fmaxf(mx, sv);
      }
    if (MODE != 1) {
      mx = fmaxf(mx, shx(mx, 16, lane));
      mx = fmaxf(mx, shx(mx, 32, lane));
      float m_new = fmaxf(st.m[hh], mx);
      float alpha = __expf(st.m[hh] - m_new);
      st.m[hh] = m_new;
      float rs = 0.f;
#pragma unroll
      for (int kt = 0; kt < 4; ++kt)
#pragma unroll
        for (int j = 0; j < 4; ++j) {
          float sv = S[kt][hh][j];
          float pv = (sv > -1e29f) ? __expf(sv - m_new) : 0.f;
          rs += pv;
          S[kt][hh][j] = pv;
        }
      st.l[hh] = st.l[hh] * alpha + rs;
      if (MODE == 2) {
#pragma unroll
        for (int dt = 0; dt < 4; ++dt) st.O[hh][dt] *= alpha;
      }
    } else {
      const float mh = st.m[hh], il = invl[hh];
#pragma unroll
      for (int kt = 0; kt < 4; ++kt) {
        float a = 0.f;
#pragma unroll
        for (int j = 0; j < 4; ++j) {
          float sv = S[kt][hh][j];
          float pv = (sv > -1e29f) ? __expf(sv - mh) * il : 0.f;
          S[kt][hh][j] = pv;
          a += pv;
        }
        impA[kt] += a;
        impE[kt] += S[kt][hh][3];
      }
    }
    if (MODE != 0) {
#pragma unroll
      for (int c = 0; c < 2; ++c)
        pf[hh][c] = mk8(pack2(S[2 * c][hh][0], S[2 * c][hh][1]), pack2(S[2 * c][hh][2], S[2 * c][hh][3]),
                        pack2(S[2 * c + 1][hh][0], S[2 * c + 1][hh][1]), pack2(S[2 * c + 1][hh][2], S[2 * c + 1][hh][3]));
    }
  }
  }
  if (MODE != 0) {
#pragma unroll
    for (int dt = 0; dt < 4; ++dt) {
      const int row = dt * 16 + col;
      const int sw = (row >> 1) & 7;
#pragma unroll
      for (int c = 0; c < 2; ++c) {
        uint2 a = *(const uint2*)(Vs + row * 64 + (((4 * c + (quad >> 1)) ^ sw) << 3) + (quad & 1) * 4);
        uint2 b = *(const uint2*)(Vs + row * 64 + (((4 * c + 2 + (quad >> 1)) ^ sw) << 3) + (quad & 1) * 4);
        bf16x8 vf = mk8(a.x, a.y, b.x, b.y);
#pragma unroll
        for (int hh = 0; hh < 2; ++hh) st.O[hh][dt] = mfma16(vf, pf[hh][c], st.O[hh][dt]);
      }
    }
    if (FX && MODE == 2) {
      const bf16x8 ones = mk8(0x3F803F80u, 0x3F803F80u, 0x3F803F80u, 0x3F803F80u);
#pragma unroll
      for (int c = 0; c < 2; ++c)
#pragma unroll
        for (int hh = 0; hh < 2; ++hh) st.L[hh] = mfma16(ones, pf[hh][c], st.L[hh]);
    }
  }
}

DI void st_reset(AttnSt& st) {
#pragma unroll
  for (int h = 0; h < 2; ++h) {
    st.m[h] = -1e30f;
    st.l[h] = 0.f;
    st.L[h] = f32x4{0.f, 0.f, 0.f, 0.f};
#pragma unroll
    for (int dt = 0; dt < 4; ++dt) st.O[h][dt] = f32x4{0.f, 0.f, 0.f, 0.f};
  }
}

template <bool FIRST>
DI void nsa_flush(const int quad, bf16_t* optr, const AttnSt& st, const float (&sc)[2]) {
#pragma unroll
  for (int h = 0; h < 2; ++h)
#pragma unroll
    for (int dt = 0; dt < 4; ++dt) {
      uint2* q = (uint2*)(optr + h * 64 + dt * 16 + quad * 4);
      f32x4 o = st.O[h][dt] * sc[h];
      if (!FIRST) {
        uint2 pv = *q;
        o[0] += bflo(pv.x); o[1] += bfhi(pv.x); o[2] += bflo(pv.y); o[3] += bfhi(pv.y);
      }
      uint2 u;
      u.x = pack2(o[0], o[1]);
      u.y = pack2(o[2], o[3]);
      *q = u;
    }
}

template <bool FX>
DI void nsa_tile(const Params& p, int b, int g, int tile, bf16_t* lds, const float CL) {
  const int tid = TID(), lane = tid & 63, w = tid >> 6, quad = lane >> 4, col = lane & 15;
  const int cur = tile;
  const int tok = tile * 64 + w * 16 + col;
  bf16_t* z = (bf16_t*)(p.ws + O_Z);
  const bf16_t* kcmp = (const bf16_t*)(p.ws + O_KCMP) + (size_t)(b * 2 + g) * 512 * 64;
  const bf16_t* vcmpT = (const bf16_t*)(p.ws + O_VCMPT) + (size_t)(b * 2 + g) * 64 * 512;
  const bf16_t* vsT = (const bf16_t*)(p.ws + O_VST) + (size_t)(b * 2 + g) * 64 * TS;
  const bf16_t* vwT = (const bf16_t*)(p.ws + O_VWT) + (size_t)(b * 2 + g) * 64 * TS;
  const bf16_t* zb = z + (size_t)b * SEQ * ZS;
  const bf16_t* ztok = z + ((size_t)(b * SEQ + tok)) * ZS;
  bf16_t* otok = (bf16_t*)(p.ws + O_ONSA) + ((size_t)(b * SEQ + tok)) * 512 + g * 256;
  bf16_t* Ks = lds;
  bf16_t* Vs = lds + 4096;
  float* impl = (float*)(lds + 8192);

  AttnSt st;
  float invl[2] = {0.f, 0.f};
  float dA[4] = {0.f, 0.f, 0.f, 0.f}, dE[4] = {0.f, 0.f, 0.f, 0.f};
  u32x4 rk0, rk1, rv0, rv1;
  bf16x8 qf[2][2];

  const int ncs = (cur < 16) ? 1 : (cur >> 4) + 1;
  const int chi = (tok >= 31) ? ((tok - 31) >> 4) : -1;

  for (int hp = 0; hp < 2; ++hp) {
#pragma unroll
    for (int hh = 0; hh < 2; ++hh)
#pragma unroll
      for (int ks = 0; ks < 2; ++ks) qf[hh][ks] = *(const bf16x8*)(ztok + C_Q + g * 256 + (hp * 2 + hh) * 64 + ks * 32 + quad * 8);
    st_reset(st);
    tile64_gload(tid, rk0, rk1, kcmp, 64);
    for (int s = 0; s < ncs; ++s) {
      __syncthreads();
      tile64_sstore(tid, Ks, rk0, rk1);
      __syncthreads();
      if (s + 1 < ncs) tile64_gload(tid, rk0, rk1, kcmp + (size_t)(s + 1) * 4096, 64);
      attn_compute<0, FX>(lane, Ks, Vs, qf, st, invl, 0, chi - s * 64, dA, dE, CL);
    }
#pragma unroll
    for (int h = 0; h < 2; ++h) {
      float l = st.l[h];
      l += shx(l, 16, lane);
      l += shx(l, 32, lane);
      invl[h] = (l > 0.f) ? 1.f / l : 0.f;
    }
    {
      float carry = 0.f;
      tile64_gload(tid, rk0, rk1, kcmp, 64);
      tile64_gload(tid, rv0, rv1, vcmpT, 512);
      for (int s = 0; s < ncs; ++s) {
        float iA[4] = {0.f, 0.f, 0.f, 0.f}, iE[4] = {0.f, 0.f, 0.f, 0.f};
        __syncthreads();
        tile64_sstore(tid, Ks, rk0, rk1);
        tile64_sstore(tid, Vs, rv0, rv1);
        __syncthreads();
        if (s + 1 < ncs) {
          tile64_gload(tid, rk0, rk1, kcmp + (size_t)(s + 1) * 4096, 64);
          tile64_gload(tid, rv0, rv1, vcmpT + (s + 1) * 64, 512);
        }
        attn_compute<1, FX>(lane, Ks, Vs, qf, st, invl, 0, chi - s * 64, iA, iE, CL);
#pragma unroll
        for (int kt = 0; kt < 4; ++kt) {
          float recv = shfrom(iE[kt], (lane + 48) & 63);
          float val = iA[kt] + ((quad == 0) ? carry : recv);
          carry = recv;
          float* slot = impl + (s * 4 + kt) * 256 + tid;
          if (hp == 0) *slot = val; else *slot += val;
        }
      }
    }
    {
      float sc[2];
#pragma unroll
      for (int h = 0; h < 2; ++h) sc[h] = sigmoidf(bf2f(ztok[C_GT + 0 * 8 + g * 4 + hp * 2 + h]));
      nsa_flush<true>(quad, otok + hp * 128, st, sc);
    }
  }

  uint32_t sw0, sw1, sw2, sw3;
  {
    uint32_t key[32];
#pragma unroll
    for (int i = 0; i < 32; ++i) {
      int j = i * 4 + quad;
      float sc = (i < ncs * 4) ? impl[i * 256 + tid] : 0.f;
      if (j == 0 || j == cur || j == cur - 1) sc = 1e4f;
      uint32_t k = (__float_as_uint(sc) & ~127u) | (uint32_t)(127 - j);
      key[i] = (j > cur) ? 0u : k;
    }
    uint32_t prev = 0xFFFFFFFFu;
    for (int r = 0; r < 16; ++r) {
      uint32_t mx = 0u;
#pragma unroll
      for (int i = 0; i < 32; ++i) {
        uint32_t k = key[i];
        k = (k < prev) ? k : 0u;
        mx = (k > mx) ? k : mx;
      }
      uint32_t o = shxu(mx, 16, lane);
      mx = (o > mx) ? o : mx;
      o = shxu(mx, 32, lane);
      mx = (o > mx) ? o : mx;
      prev = mx;
    }
    sw0 = 0u; sw1 = 0u; sw2 = 0u; sw3 = 0u;
#pragma unroll
    for (int i = 0; i < 32; ++i) {
      bool sel = (key[i] != 0u) && (key[i] >= prev);
      uint32_t bit = sel ? (1u << ((i & 7) * 4 + quad)) : 0u;
      if ((i >> 3) == 0) sw0 |= bit;
      else if ((i >> 3) == 1) sw1 |= bit;
      else if ((i >> 3) == 2) sw2 |= bit;
      else sw3 |= bit;
    }
    sw0 |= shxu(sw0, 16, lane); sw0 |= shxu(sw0, 32, lane);
    sw1 |= shxu(sw1, 16, lane); sw1 |= shxu(sw1, 32, lane);
    sw2 |= shxu(sw2, 16, lane); sw2 |= shxu(sw2, 32, lane);
    sw3 |= shxu(sw3, 16, lane); sw3 |= shxu(sw3, 32, lane);
  }

  for (int hp = 0; hp < 2; ++hp) {
#pragma unroll
    for (int hh = 0; hh < 2; ++hh)
#pragma unroll
      for (int ks = 0; ks < 2; ++ks) qf[hh][ks] = *(const bf16x8*)(ztok + C_Q + g * 256 + (hp * 2 + hh) * 64 + ks * 32 + quad * 8);
    st_reset(st);
    {
      const bf16_t* kb = zb + C_KS + g * 64;
      tile64_gload(tid, rk0, rk1, kb, ZS);
      tile64_gload(tid, rv0, rv1, vsT, TS);
      for (int s = 0; s <= cur; ++s) {
        __syncthreads();
        tile64_sstore(tid, Ks, rk0, rk1);
        tile64_sstore(tid, Vs, rv0, rv1);
        __syncthreads();
        if (s < cur) {
          tile64_gload(tid, rk0, rk1, kb + (size_t)(s + 1) * 64 * ZS, ZS);
          tile64_gload(tid, rv0, rv1, vsT + (s + 1) * 64, TS);
        }
        uint32_t wsel = (s < 32) ? sw0 : (s < 64) ? sw1 : (s < 96) ? sw2 : sw3;
        bool sel = (wsel >> (s & 31)) & 1u;
        int hi = sel ? (tok - s * 64) : -1;
        if (__any(hi >= 0)) attn_compute<2, FX>(lane, Ks, Vs, qf, st, invl, 0, hi, dA, dE, CL);
      }
    }
    {
      float sc[2];
#pragma unroll
      for (int h = 0; h < 2; ++h) {
        float l;
        if (FX) {
          l = st.L[h][0];
        } else {
          l = st.l[h];
          l += shx(l, 16, lane);
          l += shx(l, 32, lane);
        }
        sc[h] = (l > 0.f) ? sigmoidf(bf2f(ztok[C_GT + 1 * 8 + g * 4 + hp * 2 + h])) / l : 0.f;
      }
      nsa_flush<false>(quad, otok + hp * 128, st, sc);
    }
    st_reset(st);
    {
      const bf16_t* kb = zb + C_KW + g * 64;
      const int s0 = (cur >= 8) ? cur - 8 : 0;
      tile64_gload(tid, rk0, rk1, kb + (size_t)s0 * 64 * ZS, ZS);
      tile64_gload(tid, rv0, rv1, vwT + s0 * 64, TS);
      for (int s = s0; s <= cur; ++s) {
        __syncthreads();
        tile64_sstore(tid, Ks, rk0, rk1);
        tile64_sstore(tid, Vs, rv0, rv1);
        __syncthreads();
        if (s < cur) {
          tile64_gload(tid, rk0, rk1, kb + (size_t)(s + 1) * 64 * ZS, ZS);
          tile64_gload(tid, rv0, rv1, vwT + (s + 1) * 64, TS);
        }
        attn_compute<2, FX>(lane, Ks, Vs, qf, st, invl, tok - 511 - s * 64, tok - s * 64, dA, dE, CL);
      }
    }
    {
      float sc[2];
#pragma unroll
      for (int h = 0; h < 2; ++h) {
        float l;
        if (FX) {
          l = st.L[h][0];
        } else {
          l = st.l[h];
          l += shx(l, 16, lane);
          l += shx(l, 32, lane);
        }
        sc[h] = (l > 0.f) ? sigmoidf(bf2f(ztok[C_GT + 2 * 8 + g * 4 + hp * 2 + h])) / l : 0.f;
      }
      nsa_flush<false>(quad, otok + hp * 128, st, sc);
    }
  }
}

DI void load128(int tid, bf16_t* lds, const bf16_t* base, size_t stride) {
  u32x4 r[8];
#pragma unroll
  for (int i = 0; i < 8; ++i) {
    int idx = tid + 256 * i;
    int row = idx >> 4, ch = idx & 15;
    r[i] = *(const u32x4*)(base + (size_t)row * stride + ch * 8);
  }
#pragma unroll
  for (int i = 0; i < 8; ++i) {
    int idx = tid + 256 * i;
    int row = idx >> 4, ch = idx & 15;
    *(u32x4*)(lds + row * 128 + ((ch ^ (row & 15)) << 3)) = r[i];
  }
}

DI void ret_tile(const Params& p, int b, int h, int c, bf16_t* lds) {
  const int tid = TID(), lane = tid & 63, w = tid >> 6, quad = lane >> 4, col = lane & 15;
  const float lg2 = log2f(1.f - exp2f(-5.f - (float)h));
  bf16_t* z = (bf16_t*)(p.ws + O_Z);
  const bf16_t* rvT = (const bf16_t*)(p.ws + O_RVT);
  bf16_t* zc = z + ((size_t)(b * SEQ + c * 128)) * ZS;
  bf16x8 qf[2][4];
#pragma unroll
  for (int nt = 0; nt < 2; ++nt)
#pragma unroll
    for (int ks = 0; ks < 4; ++ks) {
      int n = 32 * w + nt * 16 + col;
      qf[nt][ks] = *(const bf16x8*)(zc + (size_t)n * ZS + C_RQ + h * 128 + ks * 32 + quad * 8);
    }
  f32x4 acc[8][2];
#pragma unroll
  for (int et = 0; et < 8; ++et)
#pragma unroll
    for (int nt = 0; nt < 2; ++nt) acc[et][nt] = f32x4{0.f, 0.f, 0.f, 0.f};
  __syncthreads();
  load128(tid, lds, zc + C_RV + h * 128, ZS);
  __syncthreads();
#pragma unroll
  for (int ks = 0; ks < 4; ++ks)
#pragma unroll
    for (int et = 0; et < 8; ++et) {
      int row = et * 16 + col;
      bf16x8 af = *(const bf16x8*)(lds + row * 128 + (((ks * 4 + quad) ^ (row & 15)) << 3));
#pragma unroll
      for (int nt = 0; nt < 2; ++nt) acc[et][nt] = mfma16(af, qf[nt][ks], acc[et][nt]);
    }
#pragma unroll
  for (int nt = 0; nt < 2; ++nt) {
    int n = 32 * w + nt * 16 + col;
    float xi = exp2f(lg2 * (float)(n + 1));
#pragma unroll
    for (int et = 0; et < 8; ++et) acc[et][nt] *= xi;
  }
  __syncthreads();
  load128(tid, lds, zc + C_RK + h * 128, ZS);
  __syncthreads();
  bf16x8 pf[2][4];
#pragma unroll
  for (int nt = 0; nt < 2; ++nt) {
    f32x4 s[8];
#pragma unroll
    for (int mt = 0; mt < 8; ++mt) s[mt] = f32x4{0.f, 0.f, 0.f, 0.f};
#pragma unroll
    for (int ks = 0; ks < 4; ++ks)
#pragma unroll
      for (int mt = 0; mt < 8; ++mt) {
        if (mt <= 2 * w + 1) {
          int row = mt * 16 + col;
          bf16x8 af = *(const bf16x8*)(lds + row * 128 + (((ks * 4 + quad) ^ (row & 15)) << 3));
          s[mt] = mfma16(af, qf[nt][ks], s[mt]);
        }
      }
    const int n = 32 * w + nt * 16 + col;
#pragma unroll
    for (int c2 = 0; c2 < 4; ++c2) {
      float v[8];
#pragma unroll
      for (int i = 0; i < 8; ++i) {
        const int mt = 2 * c2 + (i >> 2), j = i & 3;
        const int m = mt * 16 + quad * 4 + j;
        v[i] = (n >= m) ? s[mt][j] * exp2f(lg2 * (float)(n - m)) : 0.f;
      }
      pf[nt][c2] = mk8(pack2(v[0], v[1]), pack2(v[2], v[3]), pack2(v[4], v[5]), pack2(v[6], v[7]));
    }
  }
  __syncthreads();
  load128(tid, lds, rvT + ((size_t)((b * 4 + h) * 128)) * TS + c * 128, TS);
  __syncthreads();
#pragma unroll
  for (int c2 = 0; c2 < 4; ++c2) {
    if (2 * c2 <= 2 * w + 1) {
#pragma unroll
      for (int et = 0; et < 8; ++et) {
        int row = et * 16 + col;
        int sw = row & 15;
        uint2 a = *(const uint2*)(lds + row * 128 + (((4 * c2 + (quad >> 1)) ^ sw) << 3) + (quad & 1) * 4);
        uint2 bb = *(const uint2*)(lds + row * 128 + (((4 * c2 + 2 + (quad >> 1)) ^ sw) << 3) + (quad & 1) * 4);
        bf16x8 vf = mk8(a.x, a.y, bb.x, bb.y);
#pragma unroll
        for (int nt = 0; nt < 2; ++nt) acc[et][nt] = mfma16(vf, pf[nt][c2], acc[et][nt]);
      }
    }
  }
#pragma unroll
  for (int nt = 0; nt < 2; ++nt) {
    float ss = 0.f;
#pragma unroll
    for (int et = 0; et < 8; ++et)
#pragma unroll
      for (int j = 0; j < 4; ++j) ss += acc[et][nt][j] * acc[et][nt][j];
    ss += shx(ss, 16, lane);
    ss += shx(ss, 32, lane);
    const float rs = rsqrtf(ss * (1.f / 128.f) + 1e-6f);
    const int n = 32 * w + nt * 16 + col;
    bf16_t* zr = zc + (size_t)n * ZS;
#pragma unroll
    for (int et = 0; et < 8; ++et) {
      const int e0 = et * 16 + quad * 4;
      uint2 gv = *(const uint2*)(zr + C_RG + h * 128 + e0);
      float g0 = bflo(gv.x), g1 = bfhi(gv.x), g2 = bflo(gv.y), g3 = bfhi(gv.y);
      uint2 o;
      o.x = pack2(acc[et][nt][0] * rs * g0 * sigmoidf(g0), acc[et][nt][1] * rs * g1 * sigmoidf(g1));
      o.y = pack2(acc[et][nt][2] * rs * g2 * sigmoidf(g2), acc[et][nt][3] * rs * g3 * sigmoidf(g3));
      *(uint2*)(zr + C_RQ + h * 128 + e0) = o;
    }
  }
}

#define GEMM_TILE_LOOP(NT)                                                             \
  for (int qp_ = (int)(blockIdx.x >> 3), per_ = (int)(gridDim.x >> 3), xcd_ = (int)(blockIdx.x & 7), q_ = 0, mt = 0, ntile = 0; \
       2 * qp_ < 32 * (NT) && ((q_ = 2 * qp_ + HALF()), (mt = (((xcd_ + 8 * (q_ / (8 * (NT)))) << 3) + ((q_ % (8 * (NT))) & 7)), ntile = ((q_ % (8 * (NT))) >> 3)), true); \
       qp_ += per_)


DI int TID8() { int t = threadIdx.x; asm volatile("" : "+v"(t)); return t; }
DI void g8_load(u32x4 (&ra)[4], u32x4 (&rb)[4], const bf16_t* a, size_t lda, const bf16_t* b, size_t ldb, int kb, int lrow, int lch) {
#pragma unroll
  for (int i = 0; i < 4; ++i) {
    ra[i] = *(const u32x4*)(a + (size_t)(lrow + 64 * i) * lda + kb * 64 + lch * 8);
    rb[i] = *(const u32x4*)(b + (size_t)(lrow + 64 * i) * ldb + kb * 64 + lch * 8);
  }
}
DI void g8_store(bf16_t* S, const u32x4 (&ra)[4], const u32x4 (&rb)[4], int lrow, int lch) {
#pragma unroll
  for (int i = 0; i < 4; ++i) {
    const int r = lrow + 64 * i;
    const int off = r * 64 + ((lch ^ ((r >> 1) & 7)) << 3);
    *(u32x4*)(S + off) = ra[i];
    *(u32x4*)(S + 16384 + off) = rb[i];
  }
}
DI void g8_compute(f32x4 (&acc)[8][4], const bf16_t* S, int wm, int wn, int lane) {
#pragma unroll
  for (int ks = 0; ks < 2; ++ks) {
    bf16x8 af[8], bfr[4];
#pragma unroll
    for (int i = 0; i < 8; ++i) {
      const int r = wm * 128 + i * 16 + (lane & 15);
      af[i] = *(const bf16x8*)(S + r * 64 + (((ks * 4 + (lane >> 4)) ^ ((r >> 1) & 7)) << 3));
    }
#pragma unroll
    for (int j = 0; j < 4; ++j) {
      const int r = wn * 64 + j * 16 + (lane & 15);
      bfr[j] = *(const bf16x8*)(S + 16384 + r * 64 + (((ks * 4 + (lane >> 4)) ^ ((r >> 1) & 7)) << 3));
    }
    __builtin_amdgcn_s_setprio(1);
#pragma unroll
    for (int i = 0; i < 8; ++i)
#pragma unroll
      for (int j = 0; j < 4; ++j) acc[i][j] = mfma16(bfr[j], af[i], acc[i][j]);
    __builtin_amdgcn_s_setprio(0);
  }
}
DI void gemm8_accum(f32x4 (&acc)[8][4], const bf16_t* a, size_t lda, const bf16_t* b, size_t ldb, int nkb, bf16_t* L) {
  const int tid = TID8(), lane = tid & 63, w = tid >> 6;
  const int wm = w >> 2, wn = w & 3;
  const int lrow = tid >> 3, lch = tid & 7;
  u32x4 ra[4], rb[4];
  __syncthreads();
  g8_load(ra, rb, a, lda, b, ldb, 0, lrow, lch);
  g8_store(L, ra, rb, lrow, lch);
  __syncthreads();
  for (int kb = 0; kb < nkb; ++kb) {
    const int s = kb & 1;
    const int k1 = (kb + 1 < nkb) ? kb + 1 : kb;
    g8_load(ra, rb, a, lda, b, ldb, k1, lrow, lch);
    __builtin_amdgcn_sched_barrier(0);
    g8_compute(acc, L + s * 32768, wm, wn, lane);
    g8_store(L + (s ^ 1) * 32768, ra, rb, lrow, lch);
    __syncthreads();
  }
}
DI void zero_acc8(f32x4 (&acc)[8][4]) {
#pragma unroll
  for (int i = 0; i < 8; ++i)
#pragma unroll
    for (int j = 0; j < 4; ++j) acc[i][j] = f32x4{0.f, 0.f, 0.f, 0.f};
}
template <class F>
DI void gemm8_epi_staged(f32x4 (&acc)[8][4], int m0, int n0, bf16_t* L, F f, bf16_t* dst, size_t ld, int nmax) {
  const int tid = TID8(), lane = tid & 63, w = tid >> 6;
  const int wm = w >> 2, wn = w & 3;
#pragma unroll
  for (int half = 0; half < 2; ++half) {
    if (wm == half) {
#pragma unroll
      for (int i = 0; i < 8; ++i)
#pragma unroll
        for (int j = 0; j < 4; ++j) {
          const int ml = i * 16 + (lane & 15);
          const int nl = wn * 64 + j * 16 + (lane >> 4) * 4;
          f32x4 a = acc[i][j];
          f(m0 + half * 128 + ml, n0 + nl, a);
          uint2 u;
          u.x = pack2(a[0], a[1]);
          u.y = pack2(a[2], a[3]);
          *(uint2*)(L + ml * 264 + nl) = u;
        }
    }
    __syncthreads();
#pragma unroll
    for (int it = 0; it < 8; ++it) {
      const int idx = tid + 512 * it;
      const int row = idx >> 5, ch = idx & 31;
      const u32x4 v = *(const u32x4*)(L + row * 264 + ch * 8);
      const int n = n0 + ch * 8;
      if (n < nmax) *(u32x4*)(dst + (size_t)(m0 + half * 128 + row) * ld + n) = v;
    }
    __syncthreads();
  }
}
DI void gemm8_epi_resid(f32x4 (&acc)[8][4], int m0, int n0, int ntile8, bf16_t* L, const float* xin, float* out, bf16_t* xb, float* rowpart) {
  const int tid = TID8(), lane = tid & 63, w = tid >> 6;
  const int wm = w >> 2, wn = w & 3;
  float* red = (float*)L;
#pragma unroll
  for (int i = 0; i < 8; ++i) {
    const int ml = wm * 128 + i * 16 + (lane & 15);
    const size_t rowoff = (size_t)(m0 + ml) * DM;
    float ss = 0.f;
#pragma unroll
    for (int j = 0; j < 4; ++j) {
      const int n = n0 + wn * 64 + j * 16 + (lane >> 4) * 4;
      const float4 xv = *(const float4*)(xin + rowoff + n);
      const float o0 = xv.x + acc[i][j][0], o1 = xv.y + acc[i][j][1], o2 = xv.z + acc[i][j][2], o3 = xv.w + acc[i][j][3];
      *(float4*)(out + rowoff + n) = make_float4(o0, o1, o2, o3);
      ss += o0 * o0 + o1 * o1 + o2 * o2 + o3 * o3;
      uint2 u;
      u.x = pack2(o0, o1);
      u.y = pack2(o2, o3);
      *(uint2*)(xb + rowoff + n) = u;
    }
    ss += shx(ss, 16, lane);
    ss += shx(ss, 32, lane);
    if ((lane >> 4) == 0) red[wn * 256 + ml] = ss;
  }
  __syncthreads();
  {
    const int row = tid & 255, h = tid >> 8;
    rowpart[(size_t)(ntile8 * 2 + h) * T_TOK + m0 + row] = red[(2 * h) * 256 + row] + red[(2 * h + 1) * 256 + row];
  }
}
template <class E>
DI void gemm8_epi(f32x4 (&acc)[8][4], int m0, int n0, E e) {
  const int tid = TID8(), lane = tid & 63, w = tid >> 6;
  const int wm = w >> 2, wn = w & 3;
#pragma unroll
  for (int i = 0; i < 8; ++i)
#pragma unroll
    for (int j = 0; j < 4; ++j) {
      const int m = m0 + wm * 128 + i * 16 + (lane & 15);
      const int n = n0 + wn * 64 + j * 16 + (lane >> 4) * 4;
      e(m, n, acc[i][j]);
    }
}
DI void row_rs8(float (&rsv)[8], const float* rowpart, int m0) {
  const int tid = TID8(), lane = tid & 63, wm = tid >> 8;
#pragma unroll
  for (int i = 0; i < 8; ++i) {
    const int m = m0 + wm * 128 + i * 16 + (lane & 15);
    float s = 0.f;
#pragma unroll
    for (int t = 0; t < 8; ++t) s += rowpart[(size_t)t * T_TOK + m];
    rsv[i] = rsqrtf(s * (1.f / 1024.f) + 1e-6f);
  }
}
DI void scale_rows8(f32x4 (&acc)[8][4], const float (&rsv)[8]) {
#pragma unroll
  for (int i = 0; i < 8; ++i)
#pragma unroll
    for (int j = 0; j < 4; ++j) acc[i][j] *= rsv[i];
}
#define GEMM8_TILE_LOOP(NT8)                                                            \
  for (int q_ = (int)(blockIdx.x >> 3), per_ = (int)(gridDim.x >> 3), xcd_ = (int)(blockIdx.x & 7), mt = 0, ntile = 0; \
       q_ < 16 * (NT8) && ((mt = (((xcd_ + 8 * (q_ / (4 * (NT8)))) << 2) + ((q_ % (4 * (NT8))) & 3)), ntile = ((q_ % (4 * (NT8))) >> 2)), true); \
       q_ += per_)

#define XB_TMO      128
#define XB_XCNT(j)  (256  + 64 * (j))
#define XB_XSUB(j)  (1280 + 64 * (j))
#define XB_XGEN(j)  (2304 + 64 * (j))
#define XB_TOP      3328
#define XB_TOPGEN   3392
#define XB_SPIN_CAP (1u << 20)
DI unsigned xb_ld(unsigned* p) { return __hip_atomic_load(p, __ATOMIC_RELAXED, __HIP_MEMORY_SCOPE_AGENT); }
DI unsigned xb_add(unsigned* p, unsigned v) { return __hip_atomic_fetch_add(p, v, __ATOMIC_RELAXED, __HIP_MEMORY_SCOPE_AGENT); }
DI unsigned xb_xcc_id() { return (unsigned)__builtin_amdgcn_s_getreg((3 << 11) | 20) & 0xFu; }
#define XB_SPIN(cond, bar) do { unsigned _sp = 0; while (cond) { __builtin_amdgcn_s_sleep(1); \
    if ((++_sp & 255u) == 0u) { if (xb_ld(&(bar)[XB_TMO])) break; if (_sp > XB_SPIN_CAP) { atomicAdd(&(bar)[XB_TMO], 1u); break; } } } } while (0)

DI void xcd_barrier(unsigned* bar, const unsigned x, const unsigned nloc, const unsigned nx) {
  asm volatile("s_waitcnt vmcnt(0)" ::: "memory");
  __syncthreads();
  if (threadIdx.x == 0) {
    __builtin_amdgcn_s_waitcnt(0);
    const unsigned old = xb_add(&bar[XB_XSUB(x)], 1u);
    const unsigned gen = old / nloc;
    if (old + 1u == (gen + 1u) * nloc) {
      __builtin_amdgcn_fence(__ATOMIC_RELEASE, "agent");
      asm volatile("s_waitcnt vmcnt(0)" ::: "memory");
      const unsigned og = xb_add(&bar[XB_TOP], 1u);
      const unsigned tg = og / nx;
      if (og + 1u == (tg + 1u) * nx) xb_add(&bar[XB_TOPGEN], 1u);
      else XB_SPIN(xb_ld(&bar[XB_TOPGEN]) == tg, bar);
      __builtin_amdgcn_fence(__ATOMIC_ACQUIRE, "agent");
      xb_add(&bar[XB_XGEN(x)], 1u);
      asm volatile("s_waitcnt vmcnt(0)" ::: "memory");
    } else {
      XB_SPIN(xb_ld(&bar[XB_XGEN(x)]) == gen, bar);
      __builtin_amdgcn_fence(__ATOMIC_ACQUIRE, "agent");
      asm volatile("s_waitcnt vmcnt(0)" ::: "memory");
    }
  }
  __syncthreads();
}

__global__ void __launch_bounds__(512, 2) mega(Params p) {
  extern __shared__ __attribute__((aligned(16))) bf16_t lds_all[];
  bf16_t* lds = lds_all + HALF() * 32768;
  cg::grid_group grid = cg::this_grid();
  const int nb = NVB;
  bf16_t* wt = (bf16_t*)(p.ws + O_WT);
  bf16_t* z = (bf16_t*)(p.ws + O_Z);
  bf16_t* hbuf = (bf16_t*)(p.ws + O_VST);
  bf16_t* ubuf = z;
  bf16_t* p16 = (bf16_t*)(p.ws + O_KVD);
  float* rowpart = (float*)(p.ws + O_RP);
  bf16_t* hid = (bf16_t*)(p.ws + O_HID);
  const float* bias = (const float*)(p.ws + O_BIAS);

  unsigned* bar = (unsigned*)(p.ws + O_BAR);
  const unsigned xb_x = xb_xcc_id();
  if (threadIdx.x == 0) (void)xb_add(&bar[XB_XCNT(xb_x)], 1u);
  unsigned xb_nloc = 1u, xb_nx = 1u;

  for (int layer = 0; layer < 2; ++layer) {
    const bf16_t* wl = wt;
    const float* xin = (layer == 0) ? p.x : p.out;

    phase0(p, layer);
    norm_phase(xin, p.norm_mix + layer * DM, hbuf);
    if (layer == 0) {
      grid.sync();
      unsigned mine = 0u, cnt = 0u;
#pragma unroll
      for (unsigned j = 0; j < 16; ++j) {
        const unsigned c = xb_ld(&bar[XB_XCNT(j)]);
        cnt += (c > 0u) ? 1u : 0u;
        mine = (j == xb_x) ? c : mine;
      }
      xb_nloc = __builtin_amdgcn_readfirstlane(mine > 0u ? mine : 1u);
      xb_nx = __builtin_amdgcn_readfirstlane(cnt > 0u ? cnt : 1u);
    } else {
      xcd_barrier(bar, xb_x, xb_nloc, xb_nx);
    }

    GEMM8_TILE_LOOP(22) {
      const int m0 = mt * 256, n0 = ntile * 256;
      f32x4 acc8[8][4];
      zero_acc8(acc8);
      gemm8_accum(acc8, hbuf + (size_t)m0 * DM, DM, wl + W_IN + (size_t)n0 * 1024, 1024, 16, lds_all);
      gemm8_epi_staged(acc8, m0, n0, lds_all, [&](int, int, f32x4&) {}, z, ZS, ZS);
    }
    xcd_barrier(bar, xb_x, xb_nloc, xb_nx);

    post_z(p, layer);
    xcd_barrier(bar, xb_x, xb_nloc, xb_nx);

    for (int u_ = (int)blockIdx.x, t = 0; (u_ < 64 || u_ - 64 < 512) && ((t = (u_ < 64) ? 2 * u_ + HALF() : 128 + 2 * (u_ - 64) + HALF()), true); u_ = (u_ < 64) ? 1 << 20 : u_ + (int)gridDim.x - 64) {
      f32x4 acc[4][4];
      zero_acc(acc);
      if (t < 128) {
        const int kv = t >> 6, mt = (t >> 1) & 31, ntile = t & 1;
        const int m0 = mt * 128, n0 = ntile * 128;
        const bf16_t* kvd = (const bf16_t*)(p.ws + O_KVD) + (size_t)kv * 8 * SEQ * 64;
        auto ap = [&](int r, int kb) -> const bf16_t* {
          int row = m0 + r;
          int bg = row >> 9, c = row & 511;
          int tk = 16 * c + kb;
          tk = tk > (SEQ - 1) ? (SEQ - 1) : tk;
          return kvd + ((size_t)(bg * SEQ + tk)) * 64;
        };
        gemm_accum(acc, ap, RowPtr{wl + (kv ? W_C1V : W_C1K) + (size_t)n0 * 2048, 2048}, 32, lds);
        const float* bs = bias + kv * 256;
        bf16_t* hd = hid + (size_t)kv * 4096 * 256;
        gemm_epi(acc, m0, n0, [&](int m, int n, f32x4& a) {
          float o[4];
#pragma unroll
          for (int j = 0; j < 4; ++j) {
            float xv = a[j] + bs[n + j];
            float y = 0.7978845608028654f * (xv + 0.044715f * xv * xv * xv);
            float th = 1.f - 2.f / (__expf(2.f * y) + 1.f);
            o[j] = 0.5f * xv * (1.f + th);
          }
          uint2 u;
          u.x = pack2(o[0], o[1]);
          u.y = pack2(o[2], o[3]);
          *(uint2*)(hd + (size_t)m * 256 + n) = u;
        });
      } else {
        const int idx = t - 128;
        const int c = idx & 63, bh = idx >> 6;
        const bf16_t* rvT = (const bf16_t*)(p.ws + O_RVT) + ((size_t)bh * 128) * TS + c * 128;
        const bf16_t* kzT = (const bf16_t*)(p.ws + O_KZT) + ((size_t)bh * 128) * TS + c * 128;
        gemm_accum(acc, RowPtr{rvT, TS}, RowPtr{kzT, TS}, 2, lds);
        bf16_t* dst = z + ((size_t)((bh >> 2) * SEQ + c * 128)) * ZS + C_RV + (bh & 3) * 128;
        gemm_epi_staged(acc, 0, 0, lds, [&](int, int, f32x4&) {}, dst, ZS, 128);
      }
    }
    xcd_barrier(bar, xb_x, xb_nloc, xb_nx);

    phase4b(p, layer);
    {
      const float* pl = p.p + (size_t)layer * T_TOK * 256;
      const int gtid = VBID * 256 + TID();
      const int gthreads = nb * 256;
      for (int i = gtid; i < T_TOK * 32; i += gthreads) {
        float4 a = ((const float4*)pl)[2 * i], b2 = ((const float4*)pl)[2 * i + 1];
        ((uint4*)p16)[i] = make_uint4(pack2(a.x, a.y), pack2(a.z, a.w), pack2(b2.x, b2.y), pack2(b2.z, b2.w));
      }
    }
    xcd_barrier(bar, xb_x, xb_nloc, xb_nx);

    float nsa_c;
    {
      const int ln = TID() & 63;
      float gq = fabsf(p.nsa_q_norm[layer * 64 + ln]), gk = fabsf(p.nsa_k_norm[layer * 64 + ln]);
#pragma unroll
      for (int o = 32; o > 0; o >>= 1) {
        gq = fmaxf(gq, shx(gq, o, ln));
        gk = fmaxf(gk, shx(gk, o, ln));
      }
      nsa_c = 8.f * gq * gk;
    }
    const bool nsa_fx = nsa_c < 30.f;
    const float nsa_cl = nsa_c * 1.4426950408889634f;
    for (int t = VBID; t < 2048; t += nb) {
      if (t < 1024) {
        const int tile = (t < 512) ? 127 - (t >> 3) : ((t - 512) >> 3), bg = t & 7;
        if (nsa_fx) nsa_tile<true>(p, bg >> 1, bg & 1, tile, lds, nsa_cl);
        else nsa_tile<false>(p, bg >> 1, bg & 1, tile, lds, 0.f);
      } else {
        const int idx = t - 1024;
        ret_tile(p, idx >> 8, (idx >> 6) & 3, idx & 63, lds);
      }
    }
    xcd_barrier(bar, xb_x, xb_nloc, xb_nx);

    GEMM8_TILE_LOOP(4) {
      const int m0 = mt * 256, n0 = ntile * 256;
      f32x4 acc8[8][4];
      zero_acc8(acc8);
      gemm8_accum(acc8, (const bf16_t*)(p.ws + O_ONSA) + (size_t)m0 * 512, 512, wl + W_UPA + (size_t)n0 * 512, 512, 8, lds_all);
      gemm8_epi(acc8, m0, n0, [&](int m, int n, f32x4& a) {
        uint2 ua = *(const uint2*)(z + (size_t)m * ZS + C_MA + n);
        uint2 ub = *(const uint2*)(z + (size_t)m * ZS + C_MB + n);
        a[0] *= sigmoidf(bflo(ua.x)) / sigmoidf(bflo(ub.x));
        a[1] *= sigmoidf(bfhi(ua.x)) / sigmoidf(bfhi(ub.x));
        a[2] *= sigmoidf(bflo(ua.y)) / sigmoidf(bflo(ub.y));
        a[3] *= sigmoidf(bfhi(ua.y)) / sigmoidf(bfhi(ub.y));
      });
      gemm8_accum(acc8, z + (size_t)m0 * ZS + C_RQ, ZS, wl + W_UPR + (size_t)n0 * 512, 512, 8, lds_all);
      gemm8_epi_staged(acc8, m0, n0, lds_all, [&](int m, int n, f32x4& a) {
        uint2 ub = *(const uint2*)(z + (size_t)m * ZS + C_MB + n);
        a[0] *= sigmoidf(bflo(ub.x)); a[1] *= sigmoidf(bfhi(ub.x));
        a[2] *= sigmoidf(bflo(ub.y)); a[3] *= sigmoidf(bfhi(ub.y));
      }, z + C_RK, ZS, 1024);
    }
    xcd_barrier(bar, xb_x, xb_nloc, xb_nx);

    GEMM8_TILE_LOOP(4) {
      const int m0 = mt * 256, n0 = ntile * 256;
      f32x4 acc8[8][4];
      zero_acc8(acc8);
      gemm8_accum(acc8, z + (size_t)m0 * ZS + C_RK, ZS, wl + W_OUT + (size_t)n0 * 1024, 1024, 16, lds_all);
      gemm8_epi_resid(acc8, m0, n0, ntile, lds_all, xin, p.out, hbuf, rowpart);
    }
    xcd_barrier(bar, xb_x, xb_nloc, xb_nx);

    GEMM8_TILE_LOOP(16) {
      const int m0 = mt * 256, n0 = ntile * 256;
      f32x4 acc8[8][4];
      zero_acc8(acc8);
      float rsv[8];
      row_rs8(rsv, rowpart, m0);
      gemm8_accum(acc8, hbuf + (size_t)m0 * DM, DM, wl + W_FF1 + (size_t)n0 * 1024, 1024, 16, lds_all);
      scale_rows8(acc8, rsv);
      gemm8_epi_staged(acc8, m0, n0, lds_all, [&](int, int, f32x4& a) {
        float r0 = fmaxf(a[0], 0.f), r1 = fmaxf(a[1], 0.f), r2 = fmaxf(a[2], 0.f), r3 = fmaxf(a[3], 0.f);
        a[0] = r0 * r0; a[1] = r1 * r1; a[2] = r2 * r2; a[3] = r3 * r3;
      }, ubuf, 4096, 4096);
    }
    xcd_barrier(bar, xb_x, xb_nloc, xb_nx);

    GEMM8_TILE_LOOP(4) {
      const int m0 = mt * 256, n0 = ntile * 256;
      f32x4 acc8[8][4];
      zero_acc8(acc8);
      gemm8_accum(acc8, ubuf + (size_t)m0 * 4096, 4096, wl + W_FF2 + (size_t)n0 * 4096, 4096, 64, lds_all);
      gemm8_epi_resid(acc8, m0, n0, ntile, lds_all, p.out, p.out, hbuf, rowpart);
    }
    xcd_barrier(bar, xb_x, xb_nloc, xb_nx);

    GEMM8_TILE_LOOP(4) {
      const int m0 = mt * 256, n0 = ntile * 256;
      f32x4 acc8[8][4];
      zero_acc8(acc8);
      gemm8_accum(acc8, p16 + (size_t)m0 * 256, 256, wl + W_PLE + (size_t)n0 * 256, 256, 4, lds_all);
      bf16_t* ppb = z + (size_t)T_TOK * 256;
      gemm8_epi_staged(acc8, m0, n0, lds_all, [&](int, int, f32x4&) {}, ppb, DM, 1024);
      zero_acc8(acc8);
      float rsv[8];
      row_rs8(rsv, rowpart, m0);
      gemm8_accum(acc8, hbuf + (size_t)m0 * DM, DM, wl + W_PG + (size_t)n0 * 1024, 1024, 16, lds_all);
      scale_rows8(acc8, rsv);
      gemm8_epi(acc8, m0, n0, [&](int m, int n, f32x4& a) {
        uint2 pv = *(const uint2*)(ppb + (size_t)m * DM + n);
        float4* o = (float4*)(p.out + (size_t)m * DM + n);
        float4 xv = *o;
        *o = make_float4(xv.x + sigmoidf(a[0]) * bflo(pv.x), xv.y + sigmoidf(a[1]) * bfhi(pv.x),
                         xv.z + sigmoidf(a[2]) * bflo(pv.y), xv.w + sigmoidf(a[3]) * bfhi(pv.y));
      });
    }
    xcd_barrier(bar, xb_x, xb_nloc, xb_nx);
  }
}

extern "C" void kernel_launch(void* const* d_in, const int* in_sizes, int n_in,
                              void* d_out, int out_size, void* d_ws, size_t ws_size,
                              hipStream_t stream) {
  static int grid_blocks = 0;
  if (!grid_blocks) {
    int dev = 0, cus = 0, per_cu = 0;
    hipGetDevice(&dev);
    hipDeviceGetAttribute(&cus, hipDeviceAttributeMultiprocessorCount, dev);
    hipFuncSetAttribute((const void*)mega, hipFuncAttributeMaxDynamicSharedMemorySize, DYN_LDS);
    hipOccupancyMaxActiveBlocksPerMultiprocessor(&per_cu, mega, 512, DYN_LDS);
    if (per_cu > 1) per_cu = 1;
    if (per_cu < 1) per_cu = 1;
    grid_blocks = cus * per_cu;
  }
  if (ws_size < WS_NEED) {
    fprintf(stderr, "workspace too small: %zu < %llu\n", ws_size, (unsigned long long)WS_NEED);
    return;
  }
  Params p{};
  p.x = (const float*)d_in[0]; p.p = (const float*)d_in[1]; p.norm_mix = (const float*)d_in[2]; p.w_in = (const float*)d_in[3];
  p.nsa_q_norm = (const float*)d_in[4]; p.nsa_k_norm = (const float*)d_in[5]; p.cmp_pos_k = (const float*)d_in[6];
  p.cmp_pos_v = (const float*)d_in[7]; p.cmp_w1_k = (const float*)d_in[8]; p.cmp_w2_k = (const float*)d_in[9];
  p.cmp_w1_v = (const float*)d_in[10]; p.cmp_w2_v = (const float*)d_in[11]; p.w_up_nsa = (const float*)d_in[12];
  p.w_up_ret = (const float*)d_in[13]; p.w_out = (const float*)d_in[14]; p.norm_mlp = (const float*)d_in[15];
  p.w_ff1 = (const float*)d_in[16]; p.w_ff2 = (const float*)d_in[17]; p.norm_ple = (const float*)d_in[18];
  p.w_ple = (const float*)d_in[19]; p.w_ple_gate = (const float*)d_in[20];
  p.out = (float*)d_out; p.ws = (char*)d_ws;
  hipMemsetAsync((char*)d_ws + O_BAR, 0, BAR_BYTES, stream);
  void* args[] = {&p};
  hipError_t e = hipLaunchCooperativeKernel((void*)mega, dim3(grid_blocks), dim3(512), args, DYN_LDS, stream);
  if (e != hipSuccess) fprintf(stderr, "cooperative launch failed: %s (grid %d)\n", hipGetErrorString(e), grid_blocks);
}
```

```cpp
#include <hip/hip_runtime.h>
#include <hip/hip_cooperative_groups.h>
#include <cstdio>
#include <cstdint>
namespace cg = cooperative_groups;

typedef __attribute__((ext_vector_type(8))) short bf16x8;
typedef __attribute__((ext_vector_type(4))) float f32x4;
typedef unsigned short bf16_t;
typedef __attribute__((ext_vector_type(4))) unsigned u32x4;
#define DI __device__ __forceinline__

#define T_TOK 32768
#define SEQ 8192
#define DM 1024
#define ZS 5400
#define C_Q 0
#define C_KC 512
#define C_VC 640
#define C_KS 768
#define C_VS 896
#define C_KW 1024
#define C_VW 1152
#define C_GT 1280
#define C_RQ 1304
#define C_RK 1816
#define C_RV 2328
#define C_RG 2840
#define C_MA 3352
#define C_MB 4376
#define NPAD_IN 5504
#define TS 8256

#define W_IN 0
#define W_C1K 5636096
#define W_C1V 6160384
#define W_UPA 6684672
#define W_UPR 7208960
#define W_OUT 7733248
#define W_FF1 8781824
#define W_FF2 12976128
#define W_PLE 17170432
#define W_PG 17432576
#define W_LAYER 18481152

#define O_WT 0ull
#define O_ROPE 36962304ull
#define O_BIAS 41156608ull
#define O_HID 41160704ull
#define O_KCMP 45355008ull
#define O_VCMPT 45879296ull
#define O_VST 46403584ull
#define O_VWT 54857728ull
#define O_RVT 63311872ull
#define O_KZT 97128448ull
#define O_Z 130945024ull
#define O_ONSA 484839424ull
#define O_BAR 518393856ull
#define BAR_BYTES 13824
#define O_KVD 518407680ull
#define O_RP 535184896ull
#define WS_NEED 536233472ull
#define DYN_LDS 131072

struct Params {
  const float* x; const float* p; const float* norm_mix; const float* w_in;
  const float* nsa_q_norm; const float* nsa_k_norm; const float* cmp_pos_k; const float* cmp_pos_v;
  const float* cmp_w1_k; const float* cmp_w2_k; const float* cmp_w1_v; const float* cmp_w2_v;
  const float* w_up_nsa; const float* w_up_ret; const float* w_out; const float* norm_mlp;
  const float* w_ff1; const float* w_ff2; const float* norm_ple; const float* w_ple; const float* w_ple_gate;
  float* out; char* ws;
};

DI unsigned pack2(float a, float b) {
  typedef __attribute__((ext_vector_type(2))) __bf16 bf2;
  typedef __attribute__((ext_vector_type(2))) float f2;
  f2 v = {a, b};
  bf2 r = __builtin_convertvector(v, bf2);
  return __builtin_bit_cast(unsigned, r);
}
DI bf16_t f2bf(float a) { return (bf16_t)(pack2(a, 0.f) & 0xffffu); }
DI float bf2f(bf16_t h) { return __uint_as_float(((unsigned)h) << 16); }
DI float bflo(unsigned u) { return __uint_as_float(u << 16); }
DI float bfhi(unsigned u) { return __uint_as_float(u & 0xffff0000u); }
DI float shx(float v, int mask, int lane) {
  return __int_as_float(__builtin_amdgcn_ds_bpermute((lane ^ mask) << 2, __float_as_int(v)));
}
DI uint32_t shxu(uint32_t v, int mask, int lane) {
  return (uint32_t)__builtin_amdgcn_ds_bpermute((lane ^ mask) << 2, (int)v);
}
DI float shfrom(float v, int srclane) {
  return __int_as_float(__builtin_amdgcn_ds_bpermute(srclane << 2, __float_as_int(v)));
}
DI float wave_sum(float v, int lane) {
#pragma unroll
  for (int o = 32; o > 0; o >>= 1) v += shx(v, o, lane);
  return v;
}
DI int TID() { int t = threadIdx.x & 255; asm volatile("" : "+v"(t)); return t; }
DI int HALF() { return __builtin_amdgcn_readfirstlane((int)(threadIdx.x >> 8)); }
#define VBID ((int)(blockIdx.x * 2) + HALF())
#define NVB ((int)(gridDim.x * 2))
DI float sigmoidf(float x) { return 1.f / (1.f + __expf(-x)); }
DI f32x4 mfma16(bf16x8 a, bf16x8 b, f32x4 c) { return __builtin_amdgcn_mfma_f32_16x16x32_bf16(a, b, c, 0, 0, 0); }
DI bf16x8 mk8(unsigned a, unsigned b, unsigned c, unsigned d) {
  uint4 u = make_uint4(a, b, c, d);
  return __builtin_bit_cast(bf16x8, u);
}

template <class AP, class BP>
DI void g_load(u32x4 (&ra)[4], u32x4 (&rb)[4], const AP& ap, const BP& bp, int kb, int lrow, int lch) {
#pragma unroll
  for (int i = 0; i < 4; ++i) {
    ra[i] = *(const u32x4*)(ap(lrow + 32 * i, kb) + lch * 8);
    rb[i] = *(const u32x4*)(bp(lrow + 32 * i, kb) + lch * 8);
  }
}
DI void g_store(bf16_t* As, bf16_t* Bs, const u32x4 (&ra)[4], const u32x4 (&rb)[4], int buf, int lrow, int lch) {
#pragma unroll
  for (int i = 0; i < 4; ++i) {
    int r = lrow + 32 * i;
    int off = buf * 8192 + r * 64 + ((lch ^ ((r >> 1) & 7)) << 3);
    *(u32x4*)(As + off) = ra[i];
    *(u32x4*)(Bs + off) = rb[i];
  }
}
DI void g_compute(f32x4 (&acc)[4][4], const bf16_t* a, const bf16_t* b, int wm, int wn, int lane) {
  bf16x8 af[2][4], bfr[2][4];
#pragma unroll
  for (int ks = 0; ks < 2; ++ks)
#pragma unroll
    for (int i = 0; i < 4; ++i) {
      int r = wm * 64 + i * 16 + (lane & 15);
      af[ks][i] = *(const bf16x8*)(a + r * 64 + (((ks * 4 + (lane >> 4)) ^ ((r >> 1) & 7)) << 3));
      int r2 = wn * 64 + i * 16 + (lane & 15);
      bfr[ks][i] = *(const bf16x8*)(b + r2 * 64 + (((ks * 4 + (lane >> 4)) ^ ((r2 >> 1) & 7)) << 3));
    }
  __builtin_amdgcn_s_setprio(1);
#pragma unroll
  for (int ks = 0; ks < 2; ++ks)
#pragma unroll
    for (int i = 0; i < 4; ++i)
#pragma unroll
      for (int j = 0; j < 4; ++j) acc[i][j] = mfma16(bfr[ks][j], af[ks][i], acc[i][j]);
  __builtin_amdgcn_s_setprio(0);
}
template <class AP, class BP>
DI void gemm_accum(f32x4 (&acc)[4][4], AP ap, BP bp, int nkb, bf16_t* lds) {
  const int tid = TID(), lane = tid & 63, w = tid >> 6;
  const int wm = w >> 1, wn = w & 1;
  const int lrow = tid >> 3, lch = tid & 7;
  bf16_t* As = lds;
  bf16_t* Bs = lds + 16384;
  u32x4 ra0[4], rb0[4], ra1[4], rb1[4];
  __syncthreads();
  g_load(ra0, rb0, ap, bp, 0, lrow, lch);
  g_load(ra1, rb1, ap, bp, 1, lrow, lch);
  g_store(As, Bs, ra0, rb0, 0, lrow, lch);
  __syncthreads();
  for (int kb = 0; kb < nkb; kb += 2) {
    const int k2 = (kb + 2 < nkb) ? kb + 2 : nkb - 2;
    g_load(ra0, rb0, ap, bp, k2, lrow, lch);
    __builtin_amdgcn_sched_barrier(0);
    g_compute(acc, As, Bs, wm, wn, lane);
    g_store(As, Bs, ra1, rb1, 1, lrow, lch);
    __syncthreads();
    g_load(ra1, rb1, ap, bp, k2 + 1, lrow, lch);
    __builtin_amdgcn_sched_barrier(0);
    g_compute(acc, As + 8192, Bs + 8192, wm, wn, lane);
    g_store(As, Bs, ra0, rb0, 0, lrow, lch);
    __syncthreads();
  }
}
template <class E>
DI void gemm_epi(f32x4 (&acc)[4][4], int m0, int n0, E e) {
  const int tid_ = TID();
  const int lane = tid_ & 63, w = tid_ >> 6;
  const int wm = w >> 1, wn = w & 1;
#pragma unroll
  for (int i = 0; i < 4; ++i)
#pragma unroll
    for (int j = 0; j < 4; ++j) {
      int m = m0 + wm * 64 + i * 16 + (lane & 15);
      int n = n0 + wn * 64 + j * 16 + (lane >> 4) * 4;
      e(m, n, acc[i][j]);
    }
}
template <class F>
DI void gemm_epi_staged(f32x4 (&acc)[4][4], int m0, int n0, bf16_t* lds, F f, bf16_t* dst, size_t ld, int nmax) {
  const int tid_ = TID();
  const int lane = tid_ & 63, w = tid_ >> 6;
  const int wm = w >> 1, wn = w & 1;
#pragma unroll
  for (int i = 0; i < 4; ++i)
#pragma unroll
    for (int j = 0; j < 4; ++j) {
      const int ml = wm * 64 + i * 16 + (lane & 15);
      const int nl = wn * 64 + j * 16 + (lane >> 4) * 4;
      f32x4 a = acc[i][j];
      f(m0 + ml, n0 + nl, a);
      uint2 u;
      u.x = pack2(a[0], a[1]);
      u.y = pack2(a[2], a[3]);
      *(uint2*)(lds + ml * 136 + nl) = u;
    }
  __syncthreads();
#pragma unroll
  for (int it = 0; it < 8; ++it) {
    const int idx = tid_ + 256 * it;
    const int row = idx >> 4, ch = idx & 15;
    const u32x4 v = *(const u32x4*)(lds + row * 136 + ch * 8);
    const int n = n0 + ch * 8;
    if (n < nmax) *(u32x4*)(dst + (size_t)(m0 + row) * ld + n) = v;
  }
}
DI void gemm_epi_resid(f32x4 (&acc)[4][4], int m0, int n0, int ntile, bf16_t* lds, const float* xin, float* out, bf16_t* xb, float* rowpart) {
  const int tid_ = TID();
  const int lane = tid_ & 63, w = tid_ >> 6;
  const int wm = w >> 1, wn = w & 1;
  float* red = (float*)lds;
#pragma unroll
  for (int i = 0; i < 4; ++i) {
    const int ml = wm * 64 + i * 16 + (lane & 15);
    const size_t rowoff = (size_t)(m0 + ml) * DM;
    float ss = 0.f;
#pragma unroll
    for (int j = 0; j < 4; ++j) {
      const int n = n0 + wn * 64 + j * 16 + (lane >> 4) * 4;
      const float4 xv = *(const float4*)(xin + rowoff + n);
      const float o0 = xv.x + acc[i][j][0], o1 = xv.y + acc[i][j][1], o2 = xv.z + acc[i][j][2], o3 = xv.w + acc[i][j][3];
      *(float4*)(out + rowoff + n) = make_float4(o0, o1, o2, o3);
      ss += o0 * o0 + o1 * o1 + o2 * o2 + o3 * o3;
      uint2 u;
      u.x = pack2(o0, o1);
      u.y = pack2(o2, o3);
      *(uint2*)(xb + rowoff + n) = u;
    }
    ss += shx(ss, 16, lane);
    ss += shx(ss, 32, lane);
    if ((lane >> 4) == 0) red[wn * 128 + ml] = ss;
  }
  __syncthreads();
  if (tid_ < 128) rowpart[(size_t)ntile * T_TOK + m0 + tid_] = red[tid_] + red[128 + tid_];
}
DI void row_rs(float (&rsv)[4], const float* rowpart, int m0) {
  const int tid_ = TID();
  const int lane = tid_ & 63, wm = tid_ >> 7;
#pragma unroll
  for (int i = 0; i < 4; ++i) {
    const int m = m0 + wm * 64 + i * 16 + (lane & 15);
    float s = 0.f;
#pragma unroll
    for (int t = 0; t < 8; ++t) s += rowpart[(size_t)t * T_TOK + m];
    rsv[i] = rsqrtf(s * (1.f / 1024.f) + 1e-6f);
  }
}
DI void scale_rows(f32x4 (&acc)[4][4], const float (&rsv)[4]) {
#pragma unroll
  for (int i = 0; i < 4; ++i)
#pragma unroll
    for (int j = 0; j < 4; ++j) acc[i][j] *= rsv[i];
}
DI void zero_acc(f32x4 (&acc)[4][4]) {
#pragma unroll
  for (int i = 0; i < 4; ++i)
#pragma unroll
    for (int j = 0; j < 4; ++j) acc[i][j] = f32x4{0.f, 0.f, 0.f, 0.f};
}
struct RowPtr {
  const bf16_t* base; size_t ld;
  DI const bf16_t* operator()(int r, int kb) const { return base + (size_t)r * ld + kb * 64; }
};

DI void convert_wt(const float* W, bf16_t* Wt, int K, int N, int Npad, int gtid, int gthreads, const float* gk = nullptr) {
  const int k8n = K >> 3;
  const long total = (long)Npad * k8n;
  for (long idx = gtid; idx < total; idx += gthreads) {
    int n = (int)(idx % Npad);
    int k8 = (int)(idx / Npad);
    uint4 o = make_uint4(0, 0, 0, 0);
    if (n < N) {
      const float* s = W + (size_t)(k8 * 8) * N + n;
      float v0 = s[0], v1 = s[(size_t)N], v2 = s[(size_t)2 * N], v3 = s[(size_t)3 * N];
      float v4 = s[(size_t)4 * N], v5 = s[(size_t)5 * N], v6 = s[(size_t)6 * N], v7 = s[(size_t)7 * N];
      if (gk) {
        const float* gp = gk + k8 * 8;
        v0 *= gp[0]; v1 *= gp[1]; v2 *= gp[2]; v3 *= gp[3]; v4 *= gp[4]; v5 *= gp[5]; v6 *= gp[6]; v7 *= gp[7];
      }
      o = make_uint4(pack2(v0, v1), pack2(v2, v3), pack2(v4, v5), pack2(v6, v7));
    }
    *(uint4*)(Wt + (size_t)n * K + k8 * 8) = o;
  }
}

DI void phase0(const Params& p, const int L) {
  const int gtid = VBID * 256 + TID();
  const int gthreads = NVB * 256;
  bf16_t* wl = (bf16_t*)(p.ws + O_WT);
  convert_wt(p.w_in + (size_t)L * 1024 * 5400, wl + W_IN, 1024, 5400, NPAD_IN, gtid, gthreads);
  convert_wt(p.cmp_w1_k + (size_t)L * 2048 * 256, wl + W_C1K, 2048, 256, 256, gtid, gthreads);
  convert_wt(p.cmp_w1_v + (size_t)L * 2048 * 256, wl + W_C1V, 2048, 256, 256, gtid, gthreads);
  convert_wt(p.w_up_nsa + (size_t)L * 512 * 1024, wl + W_UPA, 512, 1024, 1024, gtid, gthreads);
  convert_wt(p.w_up_ret + (size_t)L * 512 * 1024, wl + W_UPR, 512, 1024, 1024, gtid, gthreads);
  convert_wt(p.w_out + (size_t)L * 1024 * 1024, wl + W_OUT, 1024, 1024, 1024, gtid, gthreads);
  convert_wt(p.w_ff1 + (size_t)L * 1024 * 4096, wl + W_FF1, 1024, 4096, 4096, gtid, gthreads, p.norm_mlp + L * DM);
  convert_wt(p.w_ff2 + (size_t)L * 4096 * 1024, wl + W_FF2, 4096, 1024, 1024, gtid, gthreads);
  convert_wt(p.w_ple + (size_t)L * 256 * 1024, wl + W_PLE, 256, 1024, 1024, gtid, gthreads);
  convert_wt(p.w_ple_gate + (size_t)L * 1024 * 1024, wl + W_PG, 1024, 1024, 1024, gtid, gthreads, p.norm_ple + L * DM);
  if (L == 0) {
    float2* rope = (float2*)(p.ws + O_ROPE);
    for (int idx = gtid; idx < SEQ * 64; idx += gthreads) {
      int pos = idx >> 6, j = idx & 63;
      float inv = exp2f(-(float)j * (13.287712379549449f / 64.f));
      float ang = (float)pos * inv;
      double rev = (double)ang * 0.15915494309189535;
      rev -= rint(rev);
      float fr = (float)rev;
      rope[idx] = make_float2(__builtin_amdgcn_cosf(fr), __builtin_amdgcn_sinf(fr));
    }
  }
  float* part = (float*)(p.ws + O_HID);
  {
    const int n = gtid & 255;
    for (int item = VBID; item < 128; item += NVB) {
      const int kv = item >> 6, kc = item & 63;
      const float* pos = (kv ? p.cmp_pos_v : p.cmp_pos_k) + L * 2048 + kc * 32;
      const float* w1 = (kv ? p.cmp_w1_v : p.cmp_w1_k) + (size_t)L * 2048 * 256 + (size_t)kc * 32 * 256;
      float a = 0.f;
#pragma unroll 8
      for (int k = 0; k < 32; ++k) a += pos[k] * w1[(size_t)k * 256 + n];
      part[item * 256 + n] = a;
    }
  }
}

DI void norm_phase(const float* xin, const float* g, bf16_t* h) {
  const int tid_ = TID();
  const int lane = tid_ & 63;
  const int gw = (VBID * 256 + tid_) >> 6;
  const int nw = NVB * 4;
  float4 gv[4];
#pragma unroll
  for (int i = 0; i < 4; ++i) gv[i] = ((const float4*)g)[i * 64 + lane];
  for (int row = gw; row < T_TOK; row += nw) {
    const float4* xr = (const float4*)(xin + (size_t)row * DM);
    float4 v[4];
    float ss = 0.f;
#pragma unroll
    for (int i = 0; i < 4; ++i) {
      v[i] = xr[i * 64 + lane];
      ss += v[i].x * v[i].x + v[i].y * v[i].y + v[i].z * v[i].z + v[i].w * v[i].w;
    }
    ss = wave_sum(ss, lane);
    float rs = rsqrtf(ss * (1.f / 1024.f) + 1e-6f);
    uint2* hr = (uint2*)(h + (size_t)row * DM);
#pragma unroll
    for (int i = 0; i < 4; ++i) {
      uint2 o;
      o.x = pack2(v[i].x * rs * gv[i].x, v[i].y * rs * gv[i].y);
      o.y = pack2(v[i].z * rs * gv[i].z, v[i].w * rs * gv[i].w);
      hr[i * 64 + lane] = o;
    }
  }
}

DI void post_z(const Params& p, int layer) {
  const int tid_ = TID();
  const int lane = tid_ & 63;
  const int gw = (VBID * 256 + tid_) >> 6;
  const int nw = NVB * 4;
  bf16_t* z = (bf16_t*)(p.ws + O_Z);
  bf16_t* vsT = (bf16_t*)(p.ws + O_VST);
  bf16_t* vwT = (bf16_t*)(p.ws + O_VWT);
  bf16_t* rvT = (bf16_t*)(p.ws + O_RVT);
  bf16_t* kzT = (bf16_t*)(p.ws + O_KZT);
  const float2* rope = (const float2*)(p.ws + O_ROPE);
  const float* qn = p.nsa_q_norm + layer * 64;
  const float* kn = p.nsa_k_norm + layer * 64;
  {
    const float* part = (const float*)(p.ws + O_HID);
    float* bias = (float*)(p.ws + O_BIAS);
    const int idx = VBID * 256 + tid_;
    if (idx < 512) {
      const int kv = idx >> 8, n = idx & 255;
      float a = 0.f;
      for (int kc = 0; kc < 64; ++kc) a += part[(kv * 64 + kc) * 256 + n];
      bias[idx] = a;
    }
  }
  for (int item = gw; item < 1024 * 36; item += nw) {
    const int tc = item / 36, slab = item - tc * 36;
    const int tok0 = tc * 32;
    const int b = tok0 >> 13, spos = tok0 & 8191;
    bf16_t* zr = z + (size_t)tok0 * ZS;
    if (slab >= 32) {
      const int s4 = slab - 32, kv = s4 >> 1, gi = s4 & 1;
      const int colbase = (kv ? C_VC : C_KC) + gi * 64;
      bf16_t* dst = (bf16_t*)(p.ws + O_KVD) + ((size_t)((kv * 8 + b * 2 + gi) * SEQ + spos)) * 64 + lane;
      bf16_t u[32];
#pragma unroll
      for (int i = 0; i < 32; ++i) u[i] = zr[(size_t)i * ZS + colbase + lane];
#pragma unroll
      for (int i = 0; i < 32; ++i) dst[i * 64] = u[i];
    } else if (slab < 12) {
      int colbase; const float* g; float sc;
      if (slab < 8) { colbase = C_Q + slab * 64; g = qn; sc = 0.125f; }
      else if (slab < 10) { colbase = C_KS + (slab - 8) * 64; g = kn; sc = 1.f; }
      else { colbase = C_KW + (slab - 10) * 64; g = kn; sc = 1.f; }
      const float gv = g[lane] * sc;
      float v[32];
#pragma unroll
      for (int i = 0; i < 32; ++i) v[i] = bf2f(zr[(size_t)i * ZS + colbase + lane]);
#pragma unroll
      for (int i = 0; i < 32; ++i) {
        float ss = wave_sum(v[i] * v[i], lane);
        float rs = rsqrtf(ss * (1.f / 64.f) + 1e-6f);
        zr[(size_t)i * ZS + colbase + lane] = f2bf(v[i] * rs * gv);
      }
    } else if (slab < 16 || slab >= 24) {
      int colbase; bf16_t* dst;
      if (slab < 16) {
        const int gi = slab & 1;
        const bool isw = slab >= 14;
        colbase = (isw ? C_VW : C_VS) + gi * 64;
        dst = (isw ? vwT : vsT) + ((size_t)((b * 2 + gi) * 64 + lane)) * TS + spos;
      } else {
        const int s8 = slab - 24;
        const int h = s8 >> 1, half = s8 & 1;
        colbase = C_RV + s8 * 64;
        dst = rvT + ((size_t)((b * 4 + h) * 128 + half * 64 + lane)) * TS + spos;
      }
      unsigned u[32];
#pragma unroll
      for (int i = 0; i < 32; ++i) u[i] = zr[(size_t)i * ZS + colbase + lane];
#pragma unroll
      for (int q4 = 0; q4 < 4; ++q4)
        *(uint4*)(dst + q4 * 8) = make_uint4(u[q4 * 8 + 0] | (u[q4 * 8 + 1] << 16), u[q4 * 8 + 2] | (u[q4 * 8 + 3] << 16),
                                             u[q4 * 8 + 4] | (u[q4 * 8 + 5] << 16), u[q4 * 8 + 6] | (u[q4 * 8 + 7] << 16));
    } else if (slab < 20) {
      const int h = slab - 16;
      const int colbase = C_RQ + h * 128;
      float x1[32], x2[32];
#pragma unroll
      for (int i = 0; i < 32; ++i) {
        const bf16_t* p1 = zr + (size_t)i * ZS + colbase + lane;
        x1[i] = bf2f(p1[0]);
        x2[i] = bf2f(p1[64]);
      }
#pragma unroll
      for (int i = 0; i < 32; ++i) {
        bf16_t* p1 = zr + (size_t)i * ZS + colbase + lane;
        float2 cs = rope[(spos + i) * 64 + lane];
        p1[0] = f2bf(x1[i] * cs.x - x2[i] * cs.y);
        p1[64] = f2bf(x1[i] * cs.y + x2[i] * cs.x);
      }
    } else {
      const int h = slab - 20;
      const int colbase = C_RK + h * 128;
      const float lg2 = log2f(1.f - exp2f(-5.f - (float)h));
      float x1[32], x2[32];
#pragma unroll
      for (int i = 0; i < 32; ++i) {
        const bf16_t* p1 = zr + (size_t)i * ZS + colbase + lane;
        x1[i] = bf2f(p1[0]);
        x2[i] = bf2f(p1[64]);
      }
      unsigned u1[32], u2[32];
#pragma unroll
      for (int i = 0; i < 32; ++i) {
        bf16_t* p1 = zr + (size_t)i * ZS + colbase + lane;
        float2 cs = rope[(spos + i) * 64 + lane];
        float o1 = (x1[i] * cs.x - x2[i] * cs.y) * 0.08838834764831845f;
        float o2 = (x1[i] * cs.y + x2[i] * cs.x) * 0.08838834764831845f;
        p1[0] = f2bf(o1);
        p1[64] = f2bf(o2);
        float zeta = exp2f(lg2 * (float)(127 - ((spos + i) & 127)));
        u1[i] = f2bf(o1 * zeta);
        u2[i] = f2bf(o2 * zeta);
      }
      bf16_t* d1 = kzT + ((size_t)((b * 4 + h) * 128 + lane)) * TS + spos;
#pragma unroll
      for (int q4 = 0; q4 < 4; ++q4) {
        *(uint4*)(d1 + q4 * 8) = make_uint4(u1[q4 * 8 + 0] | (u1[q4 * 8 + 1] << 16), u1[q4 * 8 + 2] | (u1[q4 * 8 + 3] << 16),
                                            u1[q4 * 8 + 4] | (u1[q4 * 8 + 5] << 16), u1[q4 * 8 + 6] | (u1[q4 * 8 + 7] << 16));
        *(uint4*)(d1 + (size_t)64 * TS + q4 * 8) = make_uint4(u2[q4 * 8 + 0] | (u2[q4 * 8 + 1] << 16), u2[q4 * 8 + 2] | (u2[q4 * 8 + 3] << 16),
                                                              u2[q4 * 8 + 4] | (u2[q4 * 8 + 5] << 16), u2[q4 * 8 + 6] | (u2[q4 * 8 + 7] << 16));
      }
    }
  }
}

DI void phase4b(const Params& p, int layer) {
  const int tid_ = TID();
  const int lane = tid_ & 63;
  const int gw = (VBID * 256 + tid_) >> 6;
  const int nw = NVB * 4;
  bf16_t* z = (bf16_t*)(p.ws + O_Z);
  const bf16_t* hid = (const bf16_t*)(p.ws + O_HID);
  bf16_t* kcmp = (bf16_t*)(p.ws + O_KCMP);
  bf16_t* vcmpT = (bf16_t*)(p.ws + O_VCMPT);
  const float* kn = p.nsa_k_norm + layer * 64;
  for (int item = gw; item < 8192; item += nw) {
    const int kv = item >> 12, row = item & 4095;
    const bf16_t* hrow = hid + ((size_t)kv * 4096 + row) * 256;
    const float* w2 = (kv ? p.cmp_w2_v : p.cmp_w2_k) + (size_t)layer * 256 * 64;
    float acc = 0.f;
    for (int k8 = 0; k8 < 32; ++k8) {
      uint4 hv = *(const uint4*)(hrow + k8 * 8);
      const float* wr = w2 + (size_t)(k8 * 8) * 64 + lane;
      acc += bflo(hv.x) * wr[0];
      acc += bfhi(hv.x) * wr[64];
      acc += bflo(hv.y) * wr[128];
      acc += bfhi(hv.y) * wr[192];
      acc += bflo(hv.z) * wr[256];
      acc += bfhi(hv.z) * wr[320];
      acc += bflo(hv.w) * wr[384];
      acc += bfhi(hv.w) * wr[448];
    }
    if (kv == 0) {
      float ss = wave_sum(acc * acc, lane);
      float rs = rsqrtf(ss * (1.f / 64.f) + 1e-6f);
      kcmp[(size_t)row * 64 + lane] = f2bf(acc * rs * kn[lane]);
    } else {
      const int bg = row >> 9, c = row & 511;
      vcmpT[((size_t)(bg * 64 + lane)) * 512 + c] = f2bf(acc);
    }
  }
  const int gtid = VBID * 256 + tid_;
  const int gthreads = NVB * 256;
  for (int idx = gtid; idx < 65536; idx += gthreads) {
    const int d4 = idx & 31, e = (idx >> 5) & 127, h = (idx >> 12) & 3, b = idx >> 14;
    const float lg2 = log2f(1.f - exp2f(-5.f - (float)h));
    const float gch = exp2f(lg2 * 128.f);
    float r0 = 0.f, r1 = 0.f, r2 = 0.f, r3 = 0.f;
    bf16_t* ptr = z + ((size_t)(b * SEQ + e)) * ZS + C_RV + h * 128 + d4 * 4;
    for (int c0 = 0; c0 < 64; c0 += 16) {
      typedef __attribute__((ext_vector_type(2))) unsigned u32x2;
      u32x2 v[16];
#pragma unroll
      for (int i = 0; i < 16; ++i) v[i] = *(const u32x2*)(ptr + (size_t)(c0 + i) * 128 * ZS);
#pragma unroll
      for (int i = 0; i < 16; ++i) {
        u32x2 o;
        o.x = pack2(r0, r1);
        o.y = pack2(r2, r3);
        *(u32x2*)(ptr + (size_t)(c0 + i) * 128 * ZS) = o;
        r0 = gch * r0 + bflo(v[i].x);
        r1 = gch * r1 + bfhi(v[i].x);
        r2 = gch * r2 + bflo(v[i].y);
        r3 = gch * r3 + bfhi(v[i].y);
      }
    }
  }
}


DI void tile64_gload(int tid, u32x4& r0, u32x4& r1, const bf16_t* base, size_t stride) {
  {
    int idx = tid;
    int row = idx >> 3, ch = idx & 7;
    r0 = *(const u32x4*)(base + (size_t)row * stride + ch * 8);
  }
  {
    int idx = tid + 256;
    int row = idx >> 3, ch = idx & 7;
    r1 = *(const u32x4*)(base + (size_t)row * stride + ch * 8);
  }
}
DI void tile64_sstore(int tid, bf16_t* dst, const u32x4& r0, const u32x4& r1) {
  {
    int idx = tid;
    int row = idx >> 3, ch = idx & 7;
    *(u32x4*)(dst + row * 64 + ((ch ^ ((row >> 1) & 7)) << 3)) = r0;
  }
  {
    int idx = tid + 256;
    int row = idx >> 3, ch = idx & 7;
    *(u32x4*)(dst + row * 64 + ((ch ^ ((row >> 1) & 7)) << 3)) = r1;
  }
}

struct AttnSt { f32x4 O[2][4]; f32x4 L[2]; float m[2]; float l[2]; };

template <int MODE, bool FX>
DI void attn_compute(const int lane, const bf16_t* Ks, const bf16_t* Vs, const bf16x8 (&qf)[2][2], AttnSt& st, const float (&invl)[2],
                     int lo, int hi, float (&impA)[4], float (&impE)[4], const float CL) {
  const int quad = lane >> 4, col = lane & 15;
  f32x4 S[4][2];
#pragma unroll
  for (int kt = 0; kt < 4; ++kt)
#pragma unroll
    for (int hh = 0; hh < 2; ++hh) S[kt][hh] = f32x4{0.f, 0.f, 0.f, 0.f};
#pragma unroll
  for (int ks = 0; ks < 2; ++ks) {
#pragma unroll
    for (int kt = 0; kt < 4; ++kt) {
      int row = kt * 16 + col;
      bf16x8 kf = *(const bf16x8*)(Ks + row * 64 + (((ks * 4 + quad) ^ ((row >> 1) & 7)) << 3));
#pragma unroll
      for (int hh = 0; hh < 2; ++hh) S[kt][hh] = mfma16(kf, qf[hh][ks], S[kt][hh]);
    }
  }
  bf16x8 pf[2][2];
  const bool full = (lo <= 0) && (hi >= 63);
  const bool none = (hi < 0) || (lo > 63) || (hi < lo);
  if (__all(full || none)) {
    constexpr float L2E = 1.4426950408889634f;
#pragma unroll
    for (int hh = 0; hh < 2; ++hh) {
      float mL;
      float il = 1.f;
      if (FX) {
        mL = full ? CL : 1e30f;
        if (MODE == 1) il = invl[hh];
      } else if (MODE != 1) {
        float mx = -1e30f;
#pragma unroll
        for (int kt = 0; kt < 4; ++kt)
#pragma unroll
          for (int j = 0; j < 4; ++j) mx = fmaxf(mx, S[kt][hh][j]);
        mx = full ? mx : -1e30f;
        mx = fmaxf(mx, shx(mx, 16, lane));
        mx = fmaxf(mx, shx(mx, 32, lane));
        const float m_new = fmaxf(st.m[hh], mx);
        const float alpha = __expf(st.m[hh] - m_new);
        st.m[hh] = m_new;
        st.l[hh] *= alpha;
        if (MODE == 2) {
#pragma unroll
          for (int dt = 0; dt < 4; ++dt) st.O[hh][dt] *= alpha;
        }
        mL = full ? m_new * L2E : 1e30f;
      } else {
        mL = full ? st.m[hh] * L2E : 1e30f;
        il = invl[hh];
      }
      float rs = 0.f;
#pragma unroll
      for (int kt = 0; kt < 4; ++kt) {
        float a = 0.f;
#pragma unroll
        for (int j = 0; j < 4; ++j) {
          float pv = __builtin_amdgcn_exp2f(fmaf(S[kt][hh][j], L2E, -mL));
          if (MODE == 1) pv *= il;
          S[kt][hh][j] = pv;
          a += pv;
        }
        rs += a;
        if (MODE == 1) {
          impA[kt] += a;
          impE[kt] += S[kt][hh][3];
        }
      }
      if (MODE != 1 && !(FX && MODE == 2)) st.l[hh] += rs;
      if (MODE != 0) {
#pragma unroll
        for (int c = 0; c < 2; ++c)
          pf[hh][c] = mk8(pack2(S[2 * c][hh][0], S[2 * c][hh][1]), pack2(S[2 * c][hh][2], S[2 * c][hh][3]),
                          pack2(S[2 * c + 1][hh][0], S[2 * c + 1][hh][1]), pack2(S[2 * c + 1][hh][2], S[2 * c + 1][hh][3]));
      }
    }
  } else {
#pragma unroll
  for (int hh = 0; hh < 2; ++hh) {
    if (FX) {
      constexpr float L2E = 1.4426950408889634f;
      const float il = (MODE == 1) ? invl[hh] : 1.f;
      float rs = 0.f;
#pragma unroll
      for (int kt = 0; kt < 4; ++kt) {
        float a = 0.f;
#pragma unroll
        for (int j = 0; j < 4; ++j) {
          const int kl = kt * 16 + quad * 4 + j;
          const bool v = (kl >= lo) && (kl <= hi);
          float pv = v ? __builtin_amdgcn_exp2f(fmaf(S[kt][hh][j], L2E, -CL)) : 0.f;
          if (MODE == 1) pv *= il;
          S[kt][hh][j] = pv;
          a += pv;
        }
        rs += a;
        if (MODE == 1) {
          impA[kt] += a;
          impE[kt] += S[kt][hh][3];
        }
      }
      if (MODE != 1 && !(FX && MODE == 2)) st.l[hh] += rs;
      if (MODE != 0) {
#pragma unroll
        for (int c = 0; c < 2; ++c)
          pf[hh][c] = mk8(pack2(S[2 * c][hh][0], S[2 * c][hh][1]), pack2(S[2 * c][hh][2], S[2 * c][hh][3]),
                          pack2(S[2 * c + 1][hh][0], S[2 * c + 1][hh][1]), pack2(S[2 * c + 1][hh][2], S[2 * c + 1][hh][3]));
      }
      continue;
    }
    float mx = -1e30f;
#pragma unroll
    for (int kt = 0; kt < 4; ++kt)
#pragma unroll
      for (int j = 0; j < 4; ++j) {
        int kl = kt * 16 + quad * 4 + j;
        bool v = (kl >= lo) && (kl <= hi);
        float sv = v ? S[kt][hh][j] : -1e30f;
        S[kt][hh][j] = sv;
        mx = fmaxf(mx, sv);
      }
    if (MODE != 1) {
      mx = fmaxf(mx, shx(mx, 16, lane));
      mx = fmaxf(mx, shx(mx, 32, lane));
      float m_new = fmaxf(st.m[hh], mx);
      float alpha = __expf(st.m[hh] - m_new);
      st.m[hh] = m_new;
      float rs = 0.f;
#pragma unroll
      for (int kt = 0; kt < 4; ++kt)
#pragma unroll
        for (int j = 0; j < 4; ++j) {
          float sv = S[kt][hh][j];
          float pv = (sv > -1e29f) ? __expf(sv - m_new) : 0.f;
          rs += pv;
          S[kt][hh][j] = pv;
        }
      st.l[hh] = st.l[hh] * alpha + rs;
      if (MODE == 2) {
#pragma unroll
        for (int dt = 0; dt < 4; ++dt) st.O[hh][dt] *= alpha;
      }
    } else {
      const float mh = st.m[hh], il = invl[hh];
#pragma unroll
      for (int kt = 0; kt < 4; ++kt) {
        float a = 0.f;
#pragma unroll
        for (int j = 0; j < 4; ++j) {
          float sv = S[kt][hh][j];
          float pv = (sv > -1e29f) ? __expf(sv - mh) * il : 0.f;
          S[kt][hh][j] = pv;
          a += pv;
        }
        impA[kt] += a;
        impE[kt] += S[kt][hh][3];
      }
    }
    if (MODE != 0) {
#pragma unroll
      for (int c = 0; c < 2; ++c)
        pf[hh][c] = mk8(pack2(S[2 * c][hh][0], S[2 * c][hh][1]), pack2(S[2 * c][hh][2], S[2 * c][hh][3]),
                        pack2(S[2 * c + 1][hh][0], S[2 * c + 1][hh][1]), pack2(S[2 * c + 1][hh][2], S[2 * c + 1][hh][3]));
    }
  }
  }
  if (MODE != 0) {
#pragma unroll
    for (int dt = 0; dt < 4; ++dt) {
      const int row = dt * 16 + col;
      const int sw = (row >> 1) & 7;
#pragma unroll
      for (int c = 0; c < 2; ++c) {
        uint2 a = *(const uint2*)(Vs + row * 64 + (((4 * c + (quad >> 1)) ^ sw) << 3) + (quad & 1) * 4);
        uint2 b = *(const uint2*)(Vs + row * 64 + (((4 * c + 2 + (quad >> 1)) ^ sw) << 3) + (quad & 1) * 4);
        bf16x8 vf = mk8(a.x, a.y, b.x, b.y);
#pragma unroll
        for (int hh = 0; hh < 2; ++hh) st.O[hh][dt] = mfma16(vf, pf[hh][c], st.O[hh][dt]);
      }
    }
    if (FX && MODE == 2) {
      const bf16x8 ones = mk8(0x3F803F80u, 0x3F803F80u, 0x3F803F80u, 0x3F803F80u);
#pragma unroll
      for (int c = 0; c < 2; ++c)
#pragma unroll
        for (int hh = 0; hh < 2; ++hh) st.L[hh] = mfma16(ones, pf[hh][c], st.L[hh]);
    }
  }
}

DI void st_reset(AttnSt& st) {
#pragma unroll
  for (int h = 0; h < 2; ++h) {
    st.m[h] = -1e30f;
    st.l[h] = 0.f;
    st.L[h] = f32x4{0.f, 0.f, 0.f, 0.f};
#pragma unroll
    for (int dt = 0; dt < 4; ++dt) st.O[h][dt] = f32x4{0.f, 0.f, 0.f, 0.f};
  }
}

template <bool FIRST>
DI void nsa_flush(const int quad, bf16_t* optr, const AttnSt& st, const float (&sc)[2]) {
#pragma unroll
  for (int h = 0; h < 2; ++h)
#pragma unroll
    for (int dt = 0; dt < 4; ++dt) {
      uint2* q = (uint2*)(optr + h * 64 + dt * 16 + quad * 4);
      f32x4 o = st.O[h][dt] * sc[h];
      if (!FIRST) {
        uint2 pv = *q;
        o[0] += bflo(pv.x); o[1] += bfhi(pv.x); o[2] += bflo(pv.y); o[3] += bfhi(pv.y);
      }
      uint2 u;
      u.x = pack2(o[0], o[1]);
      u.y = pack2(o[2], o[3]);
      *q = u;
    }
}

template <bool FX>
DI void nsa_tile(const Params& p, int b, int g, int tile, bf16_t* lds, const float CL) {
  const int tid = TID(), lane = tid & 63, w = tid >> 6, quad = lane >> 4, col = lane & 15;
  const int cur = tile;
  const int tok = tile * 64 + w * 16 + col;
  bf16_t* z = (bf16_t*)(p.ws + O_Z);
  const bf16_t* kcmp = (const bf16_t*)(p.ws + O_KCMP) + (size_t)(b * 2 + g) * 512 * 64;
  const bf16_t* vcmpT = (const bf16_t*)(p.ws + O_VCMPT) + (size_t)(b * 2 + g) * 64 * 512;
  const bf16_t* vsT = (const bf16_t*)(p.ws + O_VST) + (size_t)(b * 2 + g) * 64 * TS;
  const bf16_t* vwT = (const bf16_t*)(p.ws + O_VWT) + (size_t)(b * 2 + g) * 64 * TS;
  const bf16_t* zb = z + (size_t)b * SEQ * ZS;
  const bf16_t* ztok = z + ((size_t)(b * SEQ + tok)) * ZS;
  bf16_t* otok = (bf16_t*)(p.ws + O_ONSA) + ((size_t)(b * SEQ + tok)) * 512 + g * 256;
  bf16_t* Ks = lds;
  bf16_t* Vs = lds + 4096;
  float* impl = (float*)(lds + 8192);

  AttnSt st;
  float invl[2] = {0.f, 0.f};
  float dA[4] = {0.f, 0.f, 0.f, 0.f}, dE[4] = {0.f, 0.f, 0.f, 0.f};
  u32x4 rk0, rk1, rv0, rv1;
  bf16x8 qf[2][2];

  const int ncs = (cur < 16) ? 1 : (cur >> 4) + 1;
  const int chi = (tok >= 31) ? ((tok - 31) >> 4) : -1;

  for (int hp = 0; hp < 2; ++hp) {
#pragma unroll
    for (int hh = 0; hh < 2; ++hh)
#pragma unroll
      for (int ks = 0; ks < 2; ++ks) qf[hh][ks] = *(const bf16x8*)(ztok + C_Q + g * 256 + (hp * 2 + hh) * 64 + ks * 32 + quad * 8);
    st_reset(st);
    tile64_gload(tid, rk0, rk1, kcmp, 64);
    for (int s = 0; s < ncs; ++s) {
      __syncthreads();
      tile64_sstore(tid, Ks, rk0, rk1);
      __syncthreads();
      if (s + 1 < ncs) tile64_gload(tid, rk0, rk1, kcmp + (size_t)(s + 1) * 4096, 64);
      attn_compute<0, FX>(lane, Ks, Vs, qf, st, invl, 0, chi - s * 64, dA, dE, CL);
    }
#pragma unroll
    for (int h = 0; h < 2; ++h) {
      float l = st.l[h];
      l += shx(l, 16, lane);
      l += shx(l, 32, lane);
      invl[h] = (l > 0.f) ? 1.f / l : 0.f;
    }
    {
      float carry = 0.f;
      tile64_gload(tid, rk0, rk1, kcmp, 64);
      tile64_gload(tid, rv0, rv1, vcmpT, 512);
      for (int s = 0; s < ncs; ++s) {
        float iA[4] = {0.f, 0.f, 0.f, 0.f}, iE[4] = {0.f, 0.f, 0.f, 0.f};
        __syncthreads();
        tile64_sstore(tid, Ks, rk0, rk1);
        tile64_sstore(tid, Vs, rv0, rv1);
        __syncthreads();
        if (s + 1 < ncs) {
          tile64_gload(tid, rk0, rk1, kcmp + (size_t)(s + 1) * 4096, 64);
          tile64_gload(tid, rv0, rv1, vcmpT + (s + 1) * 64, 512);
        }
        attn_compute<1, FX>(lane, Ks, Vs, qf, st, invl, 0, chi - s * 64, iA, iE, CL);
#pragma unroll
        for (int kt = 0; kt < 4; ++kt) {
          float recv = shfrom(iE[kt], (lane + 48) & 63);
          float val = iA[kt] + ((quad == 0) ? carry : recv);
          carry = recv;
          float* slot = impl + (s * 4 + kt) * 256 + tid;
          if (hp == 0) *slot = val; else *slot += val;
        }
      }
    }
    {
      float sc[2];
#pragma unroll
      for (int h = 0; h < 2; ++h) sc[h] = sigmoidf(bf2f(ztok[C_GT + 0 * 8 + g * 4 + hp * 2 + h]));
      nsa_flush<true>(quad, otok + hp * 128, st, sc);
    }
  }

  uint32_t sw0, sw1, sw2, sw3;
  {
    uint32_t key[32];
#pragma unroll
    for (int i = 0; i < 32; ++i) {
      int j = i * 4 + quad;
      float sc = (i < ncs * 4) ? impl[i * 256 + tid] : 0.f;
      if (j == 0 || j == cur || j == cur - 1) sc = 1e4f;
      uint32_t k = (__float_as_uint(sc) & ~127u) | (uint32_t)(127 - j);
      key[i] = (j > cur) ? 0u : k;
    }
    uint32_t prev = 0xFFFFFFFFu;
    for (int r = 0; r < 16; ++r) {
      uint32_t mx = 0u;
#pragma unroll
      for (int i = 0; i < 32; ++i) {
        uint32_t k = key[i];
        k = (k < prev) ? k : 0u;
        mx = (k > mx) ? k : mx;
      }
      uint32_t o = shxu(mx, 16, lane);
      mx = (o > mx) ? o : mx;
      o = shxu(mx, 32, lane);
      mx = (o > mx) ? o : mx;
      prev = mx;
    }
    sw0 = 0u; sw1 = 0u; sw2 = 0u; sw3 = 0u;
#pragma unroll
    for (int i = 0; i < 32; ++i) {
      bool sel = (key[i] != 0u) && (key[i] >= prev);
      uint32_t bit = sel ? (1u << ((i & 7) * 4 + quad)) : 0u;
      if ((i >> 3) == 0) sw0 |= bit;
      else if ((i >> 3) == 1) sw1 |= bit;
      else if ((i >> 3) == 2) sw2 |= bit;
      else sw3 |= bit;
    }
    sw0 |= shxu(sw0, 16, lane); sw0 |= shxu(sw0, 32, lane);
    sw1 |= shxu(sw1, 16, lane); sw1 |= shxu(sw1, 32, lane);
    sw2 |= shxu(sw2, 16, lane); sw2 |= shxu(sw2, 32, lane);
    sw3 |= shxu(sw3, 16, lane); sw3 |= shxu(sw3, 32, lane);
  }

  for (int hp = 0; hp < 2; ++hp) {
#pragma unroll
    for (int hh = 0; hh < 2; ++hh)
#pragma unroll
      for (int ks = 0; ks < 2; ++ks) qf[hh][ks] = *(const bf16x8*)(ztok + C_Q + g * 256 + (hp * 2 + hh) * 64 + ks * 32 + quad * 8);
    st_reset(st);
    {
      const bf16_t* kb = zb + C_KS + g * 64;
      tile64_gload(tid, rk0, rk1, kb, ZS);
      tile64_gload(tid, rv0, rv1, vsT, TS);
      for (int s = 0; s <= cur; ++s) {
        __syncthreads();
        tile64_sstore(tid, Ks, rk0, rk1);
        tile64_sstore(tid, Vs, rv0, rv1);
        __syncthreads();
        if (s < cur) {
          tile64_gload(tid, rk0, rk1, kb + (size_t)(s + 1) * 64 * ZS, ZS);
          tile64_gload(tid, rv0, rv1, vsT + (s + 1) * 64, TS);
        }
        uint32_t wsel = (s < 32) ? sw0 : (s < 64) ? sw1 : (s < 96) ? sw2 : sw3;
        bool sel = (wsel >> (s & 31)) & 1u;
        int hi = sel ? (tok - s * 64) : -1;
        if (__any(hi >= 0)) attn_compute<2, FX>(lane, Ks, Vs, qf, st, invl, 0, hi, dA, dE, CL);
      }
    }
    {
      float sc[2];
#pragma unroll
      for (int h = 0; h < 2; ++h) {
        float l;
        if (FX) {
          l = st.L[h][0];
        } else {
          l = st.l[h];
          l += shx(l, 16, lane);
          l += shx(l, 32, lane);
        }
        sc[h] = (l > 0.f) ? sigmoidf(bf2f(ztok[C_GT + 1 * 8 + g * 4 + hp * 2 + h])) / l : 0.f;
      }
      nsa_flush<false>(quad, otok + hp * 128, st, sc);
    }
    st_reset(st);
    {
      const bf16_t* kb = zb + C_KW + g * 64;
      const int s0 = (cur >= 8) ? cur - 8 : 0;
      tile64_gload(tid, rk0, rk1, kb + (size_t)s0 * 64 * ZS, ZS);
      tile64_gload(tid, rv0, rv1, vwT + s0 * 64, TS);
      for (int s = s0; s <= cur; ++s) {
        __syncthreads();
        tile64_sstore(tid, Ks, rk0, rk1);
        tile64_sstore(tid, Vs, rv0, rv1);
        __syncthreads();
        if (s < cur) {
          tile64_gload(tid, rk0, rk1, kb + (size_t)(s + 1) * 64 * ZS, ZS);
          tile64_gload(tid, rv0, rv1, vwT + (s + 1) * 64, TS);
        }
        attn_compute<2, FX>(lane, Ks, Vs, qf, st, invl, tok - 511 - s * 64, tok - s * 64, dA, dE, CL);
      }
    }
    {
      float sc[2];
#pragma unroll
      for (int h = 0; h < 2; ++h) {
        float l;
        if (FX) {
          l = st.L[h][0];
        } else {
          l = st.l[h];
          l += shx(l, 16, lane);
          l += shx(l, 32, lane);
        }
        sc[h] = (l > 0.f) ? sigmoidf(bf2f(ztok[C_GT + 2 * 8 + g * 4 + hp * 2 + h])) / l : 0.f;
      }
      nsa_flush<false>(quad, otok + hp * 128, st, sc);
    }
  }
}

DI void load128(int tid, bf16_t* lds, const bf16_t* base, size_t stride) {
  u32x4 r[8];
#pragma unroll
  for (int i = 0; i < 8; ++i) {
    int idx = tid + 256 * i;
    int row = idx >> 4, ch = idx & 15;
    r[i] = *(const u32x4*)(base + (size_t)row * stride + ch * 8);
  }
#pragma unroll
  for (int i = 0; i < 8; ++i) {
    int idx = tid + 256 * i;
    int row = idx >> 4, ch = idx & 15;
    *(u32x4*)(lds + row * 128 + ((ch ^ (row & 15)) << 3)) = r[i];
  }
}

DI void ret_tile(const Params& p, int b, int h, int c, bf16_t* lds) {
  const int tid = TID(), lane = tid & 63, w = tid >> 6, quad = lane >> 4, col = lane & 15;
  const float lg2 = log2f(1.f - exp2f(-5.f - (float)h));
  bf16_t* z = (bf16_t*)(p.ws + O_Z);
  const bf16_t* rvT = (const bf16_t*)(p.ws + O_RVT);
  bf16_t* zc = z + ((size_t)(b * SEQ + c * 128)) * ZS;
  bf16x8 qf[2][4];
#pragma unroll
  for (int nt = 0; nt < 2; ++nt)
#pragma unroll
    for (int ks = 0; ks < 4; ++ks) {
      int n = 32 * w + nt * 16 + col;
      qf[nt][ks] = *(const bf16x8*)(zc + (size_t)n * ZS + C_RQ + h * 128 + ks * 32 + quad * 8);
    }
  f32x4 acc[8][2];
#pragma unroll
  for (int et = 0; et < 8; ++et)
#pragma unroll
    for (int nt = 0; nt < 2; ++nt) acc[et][nt] = f32x4{0.f, 0.f, 0.f, 0.f};
  __syncthreads();
  load128(tid, lds, zc + C_RV + h * 128, ZS);
  __syncthreads();
#pragma unroll
  for (int ks = 0; ks < 4; ++ks)
#pragma unroll
    for (int et = 0; et < 8; ++et) {
      int row = et * 16 + col;
      bf16x8 af = *(const bf16x8*)(lds + row * 128 + (((ks * 4 + quad) ^ (row & 15)) << 3));
#pragma unroll
      for (int nt = 0; nt < 2; ++nt) acc[et][nt] = mfma16(af, qf[nt][ks], acc[et][nt]);
    }
#pragma unroll
  for (int nt = 0; nt < 2; ++nt) {
    int n = 32 * w + nt * 16 + col;
    float xi = exp2f(lg2 * (float)(n + 1));
#pragma unroll
    for (int et = 0; et < 8; ++et) acc[et][nt] *= xi;
  }
  __syncthreads();
  load128(tid, lds, zc + C_RK + h * 128, ZS);
  __syncthreads();
  bf16x8 pf[2][4];
#pragma unroll
  for (int nt = 0; nt < 2; ++nt) {
    f32x4 s[8];
#pragma unroll
    for (int mt = 0; mt < 8; ++mt) s[mt] = f32x4{0.f, 0.f, 0.f, 0.f};
#pragma unroll
    for (int ks = 0; ks < 4; ++ks)
#pragma unroll
      for (int mt = 0; mt < 8; ++mt) {
        if (mt <= 2 * w + 1) {
          int row = mt * 16 + col;
          bf16x8 af = *(const bf16x8*)(lds + row * 128 + (((ks * 4 + quad) ^ (row & 15)) << 3));
          s[mt] = mfma16(af, qf[nt][ks], s[mt]);
        }
      }
    const int n = 32 * w + nt * 16 + col;
#pragma unroll
    for (int c2 = 0; c2 < 4; ++c2) {
      float v[8];
#pragma unroll
      for (int i = 0; i < 8; ++i) {
        const int mt = 2 * c2 + (i >> 2), j = i & 3;
        const int m = mt * 16 + quad * 4 + j;
        v[i] = (n >= m) ? s[mt][j] * exp2f(lg2 * (float)(n - m)) : 0.f;
      }
      pf[nt][c2] = mk8(pack2(v[0], v[1]), pack2(v[2], v[3]), pack2(v[4], v[5]), pack2(v[6], v[7]));
    }
  }
  __syncthreads();
  load128(tid, lds, rvT + ((size_t)((b * 4 + h) * 128)) * TS + c * 128, TS);
  __syncthreads();
#pragma unroll
  for (int c2 = 0; c2 < 4; ++c2) {
    if (2 * c2 <= 2 * w + 1) {
#pragma unroll
      for (int et = 0; et < 8; ++et) {
        int row = et * 16 + col;
        int sw = row & 15;
        uint2 a = *(const uint2*)(lds + row * 128 + (((4 * c2 + (quad >> 1)) ^ sw) << 3) + (quad & 1) * 4);
        uint2 bb = *(const uint2*)(lds + row * 128 + (((4 * c2 + 2 + (quad >> 1)) ^ sw) << 3) + (quad & 1) * 4);
        bf16x8 vf = mk8(a.x, a.y, bb.x, bb.y);
#pragma unroll
        for (int nt = 0; nt < 2; ++nt) acc[et][nt] = mfma16(vf, pf[nt][c2], acc[et][nt]);
      }
    }
  }
#pragma unroll
  for (int nt = 0; nt < 2; ++nt) {
    float ss = 0.f;
#pragma unroll
    for (int et = 0; et < 8; ++et)
#pragma unroll
      for (int j = 0; j < 4; ++j) ss += acc[et][nt][j] * acc[et][nt][j];
    ss += shx(ss, 16, lane);
    ss += shx(ss, 32, lane);
    const float rs = rsqrtf(ss * (1.f / 128.f) + 1e-6f);
    const int n = 32 * w + nt * 16 + col;
    bf16_t* zr = zc + (size_t)n * ZS;
#pragma unroll
    for (int et = 0; et < 8; ++et) {
      const int e0 = et * 16 + quad * 4;
      uint2 gv = *(const uint2*)(zr + C_RG + h * 128 + e0);
      float g0 = bflo(gv.x), g1 = bfhi(gv.x), g2 = bflo(gv.y), g3 = bfhi(gv.y);
      uint2 o;
      o.x = pack2(acc[et][nt][0] * rs * g0 * sigmoidf(g0), acc[et][nt][1] * rs * g1 * sigmoidf(g1));
      o.y = pack2(acc[et][nt][2] * rs * g2 * sigmoidf(g2), acc[et][nt][3] * rs * g3 * sigmoidf(g3));
      *(uint2*)(zr + C_RQ + h * 128 + e0) = o;
    }
  }
}

#define GEMM_TILE_LOOP(NT)                                                             \
  for (int qp_ = (int)(blockIdx.x >> 3), per_ = (int)(gridDim.x >> 3), xcd_ = (int)(blockIdx.x & 7), q_ = 0, mt = 0, ntile = 0; \
       2 * qp_ < 32 * (NT) && ((q_ = 2 * qp_ + HALF()), (mt = (((xcd_ + 8 * (q_ / (8 * (NT)))) << 3) + ((q_ % (8 * (NT))) & 7)), ntile = ((q_ % (8 * (NT))) >> 3)), true); \
       qp_ += per_)


DI int TID8() { int t = threadIdx.x; asm volatile("" : "+v"(t)); return t; }
DI void g8_load(u32x4 (&ra)[4], u32x4 (&rb)[4], const bf16_t* a, size_t lda, const bf16_t* b, size_t ldb, int kb, int lrow, int lch) {
#pragma unroll
  for (int i = 0; i < 4; ++i) {
    ra[i] = *(const u32x4*)(a + (size_t)(lrow + 64 * i) * lda + kb * 64 + lch * 8);
    rb[i] = *(const u32x4*)(b + (size_t)(lrow + 64 * i) * ldb + kb * 64 + lch * 8);
  }
}
DI void g8_store(bf16_t* S, const u32x4 (&ra)[4], const u32x4 (&rb)[4], int lrow, int lch) {
#pragma unroll
  for (int i = 0; i < 4; ++i) {
    const int r = lrow + 64 * i;
    const int off = r * 64 + ((lch ^ ((r >> 1) & 7)) << 3);
    *(u32x4*)(S + off) = ra[i];
    *(u32x4*)(S + 16384 + off) = rb[i];
  }
}
DI void g8_compute(f32x4 (&acc)[8][4], const bf16_t* S, int wm, int wn, int lane) {
#pragma unroll
  for (int ks = 0; ks < 2; ++ks) {
    bf16x8 af[8], bfr[4];
#pragma unroll
    for (int i = 0; i < 8; ++i) {
      const int r = wm * 128 + i * 16 + (lane & 15);
      af[i] = *(const bf16x8*)(S + r * 64 + (((ks * 4 + (lane >> 4)) ^ ((r >> 1) & 7)) << 3));
    }
#pragma unroll
    for (int j = 0; j < 4; ++j) {
      const int r = wn * 64 + j * 16 + (lane & 15);
      bfr[j] = *(const bf16x8*)(S + 16384 + r * 64 + (((ks * 4 + (lane >> 4)) ^ ((r >> 1) & 7)) << 3));
    }
    __builtin_amdgcn_s_setprio(1);
#pragma unroll
    for (int i = 0; i < 8; ++i)
#pragma unroll
      for (int j = 0; j < 4; ++j) acc[i][j] = mfma16(bfr[j], af[i], acc[i][j]);
    __builtin_amdgcn_s_setprio(0);
  }
}
DI void gemm8_accum(f32x4 (&acc)[8][4], const bf16_t* a, size_t lda, const bf16_t* b, size_t ldb, int nkb, bf16_t* L) {
  const int tid = TID8(), lane = tid & 63, w = tid >> 6;
  const int wm = w >> 2, wn = w & 3;
  const int lrow = tid >> 3, lch = tid & 7;
  u32x4 ra[4], rb[4];
  g8_load(ra, rb, a, lda, b, ldb, 0, lrow, lch);
  __syncthreads();
  g8_store(L, ra, rb, lrow, lch);
  g8_load(ra, rb, a, lda, b, ldb, 1, lrow, lch);
  for (int kb = 0; kb + 1 < nkb; ++kb) {
    __syncthreads();
    g8_store(L + ((kb + 1) & 1) * 32768, ra, rb, lrow, lch);
    g8_load(ra, rb, a, lda, b, ldb, (kb + 2 < nkb) ? kb + 2 : kb + 1, lrow, lch);
    __builtin_amdgcn_sched_barrier(0);
    g8_compute(acc, L + (kb & 1) * 32768, wm, wn, lane);
  }
  __syncthreads();
  g8_compute(acc, L + ((nkb - 1) & 1) * 32768, wm, wn, lane);
  __syncthreads();
}
DI void zero_acc8(f32x4 (&acc)[8][4]) {
#pragma unroll
  for (int i = 0; i < 8; ++i)
#pragma unroll
    for (int j = 0; j < 4; ++j) acc[i][j] = f32x4{0.f, 0.f, 0.f, 0.f};
}
template <class F>
DI void gemm8_epi_staged(f32x4 (&acc)[8][4], int m0, int n0, bf16_t* L, F f, bf16_t* dst, size_t ld, int nmax) {
  const int tid = TID8(), lane = tid & 63, w = tid >> 6;
  const int wm = w >> 2, wn = w & 3;
#pragma unroll
  for (int half = 0; half < 2; ++half) {
    if (wm == half) {
#pragma unroll
      for (int i = 0; i < 8; ++i)
#pragma unroll
        for (int j = 0; j < 4; ++j) {
          const int ml = i * 16 + (lane & 15);
          const int nl = wn * 64 + j * 16 + (lane >> 4) * 4;
          f32x4 a = acc[i][j];
          f(m0 + half * 128 + ml, n0 + nl, a);
          uint2 u;
          u.x = pack2(a[0], a[1]);
          u.y = pack2(a[2], a[3]);
          *(uint2*)(L + ml * 264 + nl) = u;
        }
    }
    __syncthreads();
#pragma unroll
    for (int it = 0; it < 8; ++it) {
      const int idx = tid + 512 * it;
      const int row = idx >> 5, ch = idx & 31;
      const u32x4 v = *(const u32x4*)(L + row * 264 + ch * 8);
      const int n = n0 + ch * 8;
      if (n < nmax) *(u32x4*)(dst + (size_t)(m0 + half * 128 + row) * ld + n) = v;
    }
    __syncthreads();
  }
}
DI void gemm8_epi_resid(f32x4 (&acc)[8][4], int m0, int n0, int ntile8, bf16_t* L, const float* xin, float* out, bf16_t* xb, float* rowpart) {
  const int tid = TID8(), lane = tid & 63, w = tid >> 6;
  const int wm = w >> 2, wn = w & 3;
  float* red = (float*)L;
#pragma unroll
  for (int i = 0; i < 8; ++i) {
    const int ml = wm * 128 + i * 16 + (lane & 15);
    const size_t rowoff = (size_t)(m0 + ml) * DM;
    float ss = 0.f;
#pragma unroll
    for (int j = 0; j < 4; ++j) {
      const int n = n0 + wn * 64 + j * 16 + (lane >> 4) * 4;
      const float4 xv = *(const float4*)(xin + rowoff + n);
      const float o0 = xv.x + acc[i][j][0], o1 = xv.y + acc[i][j][1], o2 = xv.z + acc[i][j][2], o3 = xv.w + acc[i][j][3];
      *(float4*)(out + rowoff + n) = make_float4(o0, o1, o2, o3);
      ss += o0 * o0 + o1 * o1 + o2 * o2 + o3 * o3;
      uint2 u;
      u.x = pack2(o0, o1);
      u.y = pack2(o2, o3);
      *(uint2*)(xb + rowoff + n) = u;
    }
    ss += shx(ss, 16, lane);
    ss += shx(ss, 32, lane);
    if ((lane >> 4) == 0) red[wn * 256 + ml] = ss;
  }
  __syncthreads();
  {
    const int row = tid & 255, h = tid >> 8;
    rowpart[(size_t)(ntile8 * 2 + h) * T_TOK + m0 + row] = red[(2 * h) * 256 + row] + red[(2 * h + 1) * 256 + row];
  }
}
template <class E>
DI void gemm8_epi(f32x4 (&acc)[8][4], int m0, int n0, E e) {
  const int tid = TID8(), lane = tid & 63, w = tid >> 6;
  const int wm = w >> 2, wn = w & 3;
#pragma unroll
  for (int i = 0; i < 8; ++i)
#pragma unroll
    for (int j = 0; j < 4; ++j) {
      const int m = m0 + wm * 128 + i * 16 + (lane & 15);
      const int n = n0 + wn * 64 + j * 16 + (lane >> 4) * 4;
      e(m, n, acc[i][j]);
    }
}
DI void row_rs8(float (&rsv)[8], const float* rowpart, int m0) {
  const int tid = TID8(), lane = tid & 63, wm = tid >> 8;
#pragma unroll
  for (int i = 0; i < 8; ++i) {
    const int m = m0 + wm * 128 + i * 16 + (lane & 15);
    float s = 0.f;
#pragma unroll
    for (int t = 0; t < 8; ++t) s += rowpart[(size_t)t * T_TOK + m];
    rsv[i] = rsqrtf(s * (1.f / 1024.f) + 1e-6f);
  }
}
DI void scale_rows8(f32x4 (&acc)[8][4], const float (&rsv)[8]) {
#pragma unroll
  for (int i = 0; i < 8; ++i)
#pragma unroll
    for (int j = 0; j < 4; ++j) acc[i][j] *= rsv[i];
}
#define GEMM8_TILE_LOOP(NT8)                                                            \
  for (int q_ = (int)(blockIdx.x >> 3), per_ = (int)(gridDim.x >> 3), xcd_ = (int)(blockIdx.x & 7), mt = 0, ntile = 0; \
       q_ < 16 * (NT8) && ((mt = (((xcd_ + 8 * (q_ / (4 * (NT8)))) << 2) + ((q_ % (4 * (NT8))) & 3)), ntile = ((q_ % (4 * (NT8))) >> 2)), true); \
       q_ += per_)

#define XB_TMO      128
#define XB_XCNT(j)  (256  + 64 * (j))
#define XB_XSUB(j)  (1280 + 64 * (j))
#define XB_XGEN(j)  (2304 + 64 * (j))
#define XB_TOP      3328
#define XB_TOPGEN   3392
#define XB_SPIN_CAP (1u << 20)
DI unsigned xb_ld(unsigned* p) { return __hip_atomic_load(p, __ATOMIC_RELAXED, __HIP_MEMORY_SCOPE_AGENT); }
DI unsigned xb_add(unsigned* p, unsigned v) { return __hip_atomic_fetch_add(p, v, __ATOMIC_RELAXED, __HIP_MEMORY_SCOPE_AGENT); }
DI unsigned xb_xcc_id() { return (unsigned)__builtin_amdgcn_s_getreg((3 << 11) | 20) & 0xFu; }
#define XB_SPIN(cond, bar) do { unsigned _sp = 0; while (cond) { __builtin_amdgcn_s_sleep(1); \
    if ((++_sp & 255u) == 0u) { if (xb_ld(&(bar)[XB_TMO])) break; if (_sp > XB_SPIN_CAP) { atomicAdd(&(bar)[XB_TMO], 1u); break; } } } } while (0)

DI void xcd_barrier(unsigned* bar, const unsigned x, const unsigned nloc, const unsigned nx) {
  asm volatile("s_waitcnt vmcnt(0)" ::: "memory");
  __syncthreads();
  if (threadIdx.x == 0) {
    __builtin_amdgcn_s_waitcnt(0);
    const unsigned old = xb_add(&bar[XB_XSUB(x)], 1u);
    const unsigned gen = old / nloc;
    if (old + 1u == (gen + 1u) * nloc) {
      __builtin_amdgcn_fence(__ATOMIC_RELEASE, "agent");
      asm volatile("s_waitcnt vmcnt(0)" ::: "memory");
      const unsigned og = xb_add(&bar[XB_TOP], 1u);
      const unsigned tg = og / nx;
      if (og + 1u == (tg + 1u) * nx) xb_add(&bar[XB_TOPGEN], 1u);
      else XB_SPIN(xb_ld(&bar[XB_TOPGEN]) == tg, bar);
      __builtin_amdgcn_fence(__ATOMIC_ACQUIRE, "agent");
      xb_add(&bar[XB_XGEN(x)], 1u);
      asm volatile("s_waitcnt vmcnt(0)" ::: "memory");
    } else {
      XB_SPIN(xb_ld(&bar[XB_XGEN(x)]) == gen, bar);
      __builtin_amdgcn_fence(__ATOMIC_ACQUIRE, "agent");
      asm volatile("s_waitcnt vmcnt(0)" ::: "memory");
    }
  }
  __syncthreads();
}

__global__ void __launch_bounds__(512, 2) mega(Params p) {
  extern __shared__ __attribute__((aligned(16))) bf16_t lds_all[];
  bf16_t* lds = lds_all + HALF() * 32768;
  cg::grid_group grid = cg::this_grid();
  const int nb = NVB;
  bf16_t* wt = (bf16_t*)(p.ws + O_WT);
  bf16_t* z = (bf16_t*)(p.ws + O_Z);
  bf16_t* hbuf = (bf16_t*)(p.ws + O_VST);
  bf16_t* ubuf = z;
  bf16_t* p16 = (bf16_t*)(p.ws + O_KVD);
  float* rowpart = (float*)(p.ws + O_RP);
  bf16_t* hid = (bf16_t*)(p.ws + O_HID);
  const float* bias = (const float*)(p.ws + O_BIAS);

  unsigned* bar = (unsigned*)(p.ws + O_BAR);
  const unsigned xb_x = xb_xcc_id();
  if (threadIdx.x == 0) (void)xb_add(&bar[XB_XCNT(xb_x)], 1u);
  unsigned xb_nloc = 1u, xb_nx = 1u;

  for (int layer = 0; layer < 2; ++layer) {
    const bf16_t* wl = wt;
    const float* xin = (layer == 0) ? p.x : p.out;

    phase0(p, layer);
    norm_phase(xin, p.norm_mix + layer * DM, hbuf);
    if (layer == 0) {
      grid.sync();
      unsigned mine = 0u, cnt = 0u;
#pragma unroll
      for (unsigned j = 0; j < 16; ++j) {
        const unsigned c = xb_ld(&bar[XB_XCNT(j)]);
        cnt += (c > 0u) ? 1u : 0u;
        mine = (j == xb_x) ? c : mine;
      }
      xb_nloc = __builtin_amdgcn_readfirstlane(mine > 0u ? mine : 1u);
      xb_nx = __builtin_amdgcn_readfirstlane(cnt > 0u ? cnt : 1u);
    } else {
      xcd_barrier(bar, xb_x, xb_nloc, xb_nx);
    }

    GEMM8_TILE_LOOP(22) {
      const int m0 = mt * 256, n0 = ntile * 256;
      f32x4 acc8[8][4];
      zero_acc8(acc8);
      gemm8_accum(acc8, hbuf + (size_t)m0 * DM, DM, wl + W_IN + (size_t)n0 * 1024, 1024, 16, lds_all);
      gemm8_epi_staged(acc8, m0, n0, lds_all, [&](int, int, f32x4&) {}, z, ZS, ZS);
    }
    xcd_barrier(bar, xb_x, xb_nloc, xb_nx);

    post_z(p, layer);
    xcd_barrier(bar, xb_x, xb_nloc, xb_nx);

    for (int u_ = (int)blockIdx.x, t = 0; (u_ < 64 || u_ - 64 < 512) && ((t = (u_ < 64) ? 2 * u_ + HALF() : 128 + 2 * (u_ - 64) + HALF()), true); u_ = (u_ < 64) ? 1 << 20 : u_ + (int)gridDim.x - 64) {
      f32x4 acc[4][4];
      zero_acc(acc);
      if (t < 128) {
        const int kv = t >> 6, mt = (t >> 1) & 31, ntile = t & 1;
        const int m0 = mt * 128, n0 = ntile * 128;
        const bf16_t* kvd = (const bf16_t*)(p.ws + O_KVD) + (size_t)kv * 8 * SEQ * 64;
        auto ap = [&](int r, int kb) -> const bf16_t* {
          int row = m0 + r;
          int bg = row >> 9, c = row & 511;
          int tk = 16 * c + kb;
          tk = tk > (SEQ - 1) ? (SEQ - 1) : tk;
          return kvd + ((size_t)(bg * SEQ + tk)) * 64;
        };
        gemm_accum(acc, ap, RowPtr{wl + (kv ? W_C1V : W_C1K) + (size_t)n0 * 2048, 2048}, 32, lds);
        const float* bs = bias + kv * 256;
        bf16_t* hd = hid + (size_t)kv * 4096 * 256;
        gemm_epi(acc, m0, n0, [&](int m, int n, f32x4& a) {
          float o[4];
#pragma unroll
          for (int j = 0; j < 4; ++j) {
            float xv = a[j] + bs[n + j];
            float y = 0.7978845608028654f * (xv + 0.044715f * xv * xv * xv);
            float th = 1.f - 2.f / (__expf(2.f * y) + 1.f);
            o[j] = 0.5f * xv * (1.f + th);
          }
          uint2 u;
          u.x = pack2(o[0], o[1]);
          u.y = pack2(o[2], o[3]);
          *(uint2*)(hd + (size_t)m * 256 + n) = u;
        });
      } else {
        const int idx = t - 128;
        const int c = idx & 63, bh = idx >> 6;
        const bf16_t* rvT = (const bf16_t*)(p.ws + O_RVT) + ((size_t)bh * 128) * TS + c * 128;
        const bf16_t* kzT = (const bf16_t*)(p.ws + O_KZT) + ((size_t)bh * 128) * TS + c * 128;
        gemm_accum(acc, RowPtr{rvT, TS}, RowPtr{kzT, TS}, 2, lds);
        bf16_t* dst = z + ((size_t)((bh >> 2) * SEQ + c * 128)) * ZS + C_RV + (bh & 3) * 128;
        gemm_epi_staged(acc, 0, 0, lds, [&](int, int, f32x4&) {}, dst, ZS, 128);
      }
    }
    xcd_barrier(bar, xb_x, xb_nloc, xb_nx);

    phase4b(p, layer);
    {
      const float* pl = p.p + (size_t)layer * T_TOK * 256;
      const int gtid = VBID * 256 + TID();
      const int gthreads = nb * 256;
      for (int i = gtid; i < T_TOK * 32; i += gthreads) {
        float4 a = ((const float4*)pl)[2 * i], b2 = ((const float4*)pl)[2 * i + 1];
        ((uint4*)p16)[i] = make_uint4(pack2(a.x, a.y), pack2(a.z, a.w), pack2(b2.x, b2.y), pack2(b2.z, b2.w));
      }
    }
    xcd_barrier(bar, xb_x, xb_nloc, xb_nx);

    float nsa_c;
    {
      const int ln = TID() & 63;
      float gq = fabsf(p.nsa_q_norm[layer * 64 + ln]), gk = fabsf(p.nsa_k_norm[layer * 64 + ln]);
#pragma unroll
      for (int o = 32; o > 0; o >>= 1) {
        gq = fmaxf(gq, shx(gq, o, ln));
        gk = fmaxf(gk, shx(gk, o, ln));
      }
      nsa_c = 8.f * gq * gk;
    }
    const bool nsa_fx = nsa_c < 30.f;
    const float nsa_cl = nsa_c * 1.4426950408889634f;
    for (int t = VBID; t < 2048; t += nb) {
      if (t < 1024) {
        const int tile = (t < 512) ? 127 - (t >> 3) : ((t - 512) >> 3), bg = t & 7;
        if (nsa_fx) nsa_tile<true>(p, bg >> 1, bg & 1, tile, lds, nsa_cl);
        else nsa_tile<false>(p, bg >> 1, bg & 1, tile, lds, 0.f);
      } else {
        const int idx = t - 1024;
        ret_tile(p, idx >> 8, (idx >> 6) & 3, idx & 63, lds);
      }
    }
    xcd_barrier(bar, xb_x, xb_nloc, xb_nx);

    GEMM8_TILE_LOOP(4) {
      const int m0 = mt * 256, n0 = ntile * 256;
      f32x4 acc8[8][4];
      zero_acc8(acc8);
      gemm8_accum(acc8, (const bf16_t*)(p.ws + O_ONSA) + (size_t)m0 * 512, 512, wl + W_UPA + (size_t)n0 * 512, 512, 8, lds_all);
      gemm8_epi(acc8, m0, n0, [&](int m, int n, f32x4& a) {
        uint2 ua = *(const uint2*)(z + (size_t)m * ZS + C_MA + n);
        uint2 ub = *(const uint2*)(z + (size_t)m * ZS + C_MB + n);
        a[0] *= sigmoidf(bflo(ua.x)) / sigmoidf(bflo(ub.x));
        a[1] *= sigmoidf(bfhi(ua.x)) / sigmoidf(bfhi(ub.x));
        a[2] *= sigmoidf(bflo(ua.y)) / sigmoidf(bflo(ub.y));
        a[3] *= sigmoidf(bfhi(ua.y)) / sigmoidf(bfhi(ub.y));
      });
      gemm8_accum(acc8, z + (size_t)m0 * ZS + C_RQ, ZS, wl + W_UPR + (size_t)n0 * 512, 512, 8, lds_all);
      gemm8_epi_staged(acc8, m0, n0, lds_all, [&](int m, int n, f32x4& a) {
        uint2 ub = *(const uint2*)(z + (size_t)m * ZS + C_MB + n);
        a[0] *= sigmoidf(bflo(ub.x)); a[1] *= sigmoidf(bfhi(ub.x));
        a[2] *= sigmoidf(bflo(ub.y)); a[3] *= sigmoidf(bfhi(ub.y));
      }, z + C_RK, ZS, 1024);
    }
    xcd_barrier(bar, xb_x, xb_nloc, xb_nx);

    GEMM8_TILE_LOOP(4) {
      const int m0 = mt * 256, n0 = ntile * 256;
      f32x4 acc8[8][4];
      zero_acc8(acc8);
      gemm8_accum(acc8, z + (size_t)m0 * ZS + C_RK, ZS, wl + W_OUT + (size_t)n0 * 1024, 1024, 16, lds_all);
      gemm8_epi_resid(acc8, m0, n0, ntile, lds_all, xin, p.out, hbuf, rowpart);
    }
    xcd_barrier(bar, xb_x, xb_nloc, xb_nx);

    GEMM8_TILE_LOOP(16) {
      const int m0 = mt * 256, n0 = ntile * 256;
      f32x4 acc8[8][4];
      zero_acc8(acc8);
      float rsv[8];
      row_rs8(rsv, rowpart, m0);
      gemm8_accum(acc8, hbuf + (size_t)m0 * DM, DM, wl + W_FF1 + (size_t)n0 * 1024, 1024, 16, lds_all);
      scale_rows8(acc8, rsv);
      gemm8_epi_staged(acc8, m0, n0, lds_all, [&](int, int, f32x4& a) {
        float r0 = fmaxf(a[0], 0.f), r1 = fmaxf(a[1], 0.f), r2 = fmaxf(a[2], 0.f), r3 = fmaxf(a[3], 0.f);
        a[0] = r0 * r0; a[1] = r1 * r1; a[2] = r2 * r2; a[3] = r3 * r3;
      }, ubuf, 4096, 4096);
    }
    xcd_barrier(bar, xb_x, xb_nloc, xb_nx);

    GEMM8_TILE_LOOP(4) {
      const int m0 = mt * 256, n0 = ntile * 256;
      f32x4 acc8[8][4];
      zero_acc8(acc8);
      gemm8_accum(acc8, ubuf + (size_t)m0 * 4096, 4096, wl + W_FF2 + (size_t)n0 * 4096, 4096, 64, lds_all);
      gemm8_epi_resid(acc8, m0, n0, ntile, lds_all, p.out, p.out, hbuf, rowpart);
    }
    xcd_barrier(bar, xb_x, xb_nloc, xb_nx);

    GEMM8_TILE_LOOP(4) {
      const int m0 = mt * 256, n0 = ntile * 256;
      f32x4 acc8[8][4];
      zero_acc8(acc8);
      gemm8_accum(acc8, p16 + (size_t)m0 * 256, 256, wl + W_PLE + (size_t)n0 * 256, 256, 4, lds_all);
      bf16_t* ppb = z + (size_t)T_TOK * 256;
      gemm8_epi_staged(acc8, m0, n0, lds_all, [&](int, int, f32x4&) {}, ppb, DM, 1024);
      zero_acc8(acc8);
      float rsv[8];
      row_rs8(rsv, rowpart, m0);
      gemm8_accum(acc8, hbuf + (size_t)m0 * DM, DM, wl + W_PG + (size_t)n0 * 1024, 1024, 16, lds_all);
      scale_rows8(acc8, rsv);
      gemm8_epi(acc8, m0, n0, [&](int m, int n, f32x4& a) {
        uint2 pv = *(const uint2*)(ppb + (size_t)m * DM + n);
        float4* o = (float4*)(p.out + (size_t)m * DM + n);
        float4 xv = *o;
        *o = make_float4(xv.x + sigmoidf(a[0]) * bflo(pv.x), xv.y + sigmoidf(a[1]) * bfhi(pv.x),
                         xv.z + sigmoidf(a[2]) * bflo(pv.y), xv.w + sigmoidf(a[3]) * bfhi(pv.y));
      });
    }
    xcd_barrier(bar, xb_x, xb_nloc, xb_nx);
  }
}

extern "C" void kernel_launch(void* const* d_in, const int* in_sizes, int n_in,
                              void* d_out, int out_size, void* d_ws, size_t ws_size,
                              hipStream_t stream) {
  static int grid_blocks = 0;
  if (!grid_blocks) {
    int dev = 0, cus = 0, per_cu = 0;
    hipGetDevice(&dev);
    hipDeviceGetAttribute(&cus, hipDeviceAttributeMultiprocessorCount, dev);
    hipFuncSetAttribute((const void*)mega, hipFuncAttributeMaxDynamicSharedMemorySize, DYN_LDS);
    hipOccupancyMaxActiveBlocksPerMultiprocessor(&per_cu, mega, 512, DYN_LDS);
    if (per_cu > 1) per_cu = 1;
    if (per_cu < 1) per_cu = 1;
    grid_blocks = cus * per_cu;
  }
  if (ws_size < WS_NEED) {
    fprintf(stderr, "workspace too small: %zu < %llu\n", ws_size, (unsigned long long)WS_NEED);
    return;
  }
  Params p{};
  p.x = (const float*)d_in[0]; p.p = (const float*)d_in[1]; p.norm_mix = (const float*)d_in[2]; p.w_in = (const float*)d_in[3];
  p.nsa_q_norm = (const float*)d_in[4]; p.nsa_k_norm = (const float*)d_in[5]; p.cmp_pos_k = (const float*)d_in[6];
  p.cmp_pos_v = (const float*)d_in[7]; p.cmp_w1_k = (const float*)d_in[8]; p.cmp_w2_k = (const float*)d_in[9];
  p.cmp_w1_v = (const float*)d_in[10]; p.cmp_w2_v = (const float*)d_in[11]; p.w_up_nsa = (const float*)d_in[12];
  p.w_up_ret = (const float*)d_in[13]; p.w_out = (const float*)d_in[14]; p.norm_mlp = (const float*)d_in[15];
  p.w_ff1 = (const float*)d_in[16]; p.w_ff2 = (const float*)d_in[17]; p.norm_ple = (const float*)d_in[18];
  p.w_ple = (const float*)d_in[19]; p.w_ple_gate = (const float*)d_in[20];
  p.out = (float*)d_out; p.ws = (char*)d_ws;
  hipMemsetAsync((char*)d_ws + O_BAR, 0, BAR_BYTES, stream);
  void* args[] = {&p};
  hipError_t e = hipLaunchCooperativeKernel((void*)mega, dim3(grid_blocks), dim3(512), args, DYN_LDS, stream);
  if (e != hipSuccess) fprintf(stderr, "cooperative launch failed: %s (grid %d)\n", hipGetErrorString(e), grid_blocks);
}
```

```cpp
#include <hip/hip_runtime.h>
#include <hip/hip_cooperative_groups.h>
#include <cstdio>
#include <cstdint>
namespace cg = cooperative_groups;

typedef __attribute__((ext_vector_type(8))) short bf16x8;
typedef __attribute__((ext_vector_type(4))) float f32x4;
typedef unsigned short bf16_t;
typedef __attribute__((ext_vector_type(4))) unsigned u32x4;
#define DI __device__ __forceinline__

#define T_TOK 32768
#define SEQ 8192
#define DM 1024
#define ZS 5400
#define C_Q 0
#define C_KC 512
#define C_VC 640
#define C_KS 768
#define C_VS 896
#define C_KW 1024
#define C_VW 1152
#define C_GT 1280
#define C_RQ 1304
#define C_RK 1816
#define C_RV 2328
#define C_RG 2840
#define C_MA 3352
#define C_MB 4376
#define NPAD_IN 5504
#define TS 8256

#define W_IN 0
#define W_C1K 5636096
#define W_C1V 6160384
#define W_UPA 6684672
#define W_UPR 7208960
#define W_OUT 7733248
#define W_FF1 8781824
#define W_FF2 12976128
#define W_PLE 17170432
#define W_PG 17432576
#define W_LAYER 18481152

#define O_WT 0ull
#define O_ROPE 36962304ull
#define O_BIAS 41156608ull
#define O_HID 41160704ull
#define O_KCMP 45355008ull
#define O_VCMPT 45879296ull
#define O_VST 46403584ull
#define O_VWT 54857728ull
#define O_RVT 63311872ull
#define O_KZT 97128448ull
#define O_Z 130945024ull
#define O_ONSA 484839424ull
#define O_BAR 518393856ull
#define BAR_BYTES 13824
#define O_KVD 518407680ull
#define O_RP 535184896ull
#define WS_NEED 536233472ull
#define DYN_LDS 131072

struct Params {
  const float* x; const float* p; const float* norm_mix; const float* w_in;
  const float* nsa_q_norm; const float* nsa_k_norm; const float* cmp_pos_k; const float* cmp_pos_v;
  const float* cmp_w1_k; const float* cmp_w2_k; const float* cmp_w1_v; const float* cmp_w2_v;
  const float* w_up_nsa; const float* w_up_ret; const float* w_out; const float* norm_mlp;
  const float* w_ff1; const float* w_ff2; const float* norm_ple; const float* w_ple; const float* w_ple_gate;
  float* out; char* ws;
};

DI unsigned pack2(float a, float b) {
  typedef __attribute__((ext_vector_type(2))) __bf16 bf2;
  typedef __attribute__((ext_vector_type(2))) float f2;
  f2 v = {a, b};
  bf2 r = __builtin_convertvector(v, bf2);
  return __builtin_bit_cast(unsigned, r);
}
DI bf16_t f2bf(float a) { return (bf16_t)(pack2(a, 0.f) & 0xffffu); }
DI float bf2f(bf16_t h) { return __uint_as_float(((unsigned)h) << 16); }
DI float bflo(unsigned u) { return __uint_as_float(u << 16); }
DI float bfhi(unsigned u) { return __uint_as_float(u & 0xffff0000u); }
DI float shx(float v, int mask, int lane) {
  return __int_as_float(__builtin_amdgcn_ds_bpermute((lane ^ mask) << 2, __float_as_int(v)));
}
DI uint32_t shxu(uint32_t v, int mask, int lane) {
  return (uint32_t)__builtin_amdgcn_ds_bpermute((lane ^ mask) << 2, (int)v);
}
DI float shfrom(float v, int srclane) {
  return __int_as_float(__builtin_amdgcn_ds_bpermute(srclane << 2, __float_as_int(v)));
}
DI float wave_sum(float v, int lane) {
#pragma unroll
  for (int o = 32; o > 0; o >>= 1) v += shx(v, o, lane);
  return v;
}
DI int TID() { int t = threadIdx.x & 255; asm volatile("" : "+v"(t)); return t; }
DI int HALF() { return __builtin_amdgcn_readfirstlane((int)(threadIdx.x >> 8)); }
#define VBID ((int)(blockIdx.x * 2) + HALF())
#define NVB ((int)(gridDim.x * 2))
DI float sigmoidf(float x) { return 1.f / (1.f + __expf(-x)); }
DI f32x4 mfma16(bf16x8 a, bf16x8 b, f32x4 c) { return __builtin_amdgcn_mfma_f32_16x16x32_bf16(a, b, c, 0, 0, 0); }
DI bf16x8 mk8(unsigned a, unsigned b, unsigned c, unsigned d) {
  uint4 u = make_uint4(a, b, c, d);
  return __builtin_bit_cast(bf16x8, u);
}

template <class AP, class BP>
DI void g_load(u32x4 (&ra)[4], u32x4 (&rb)[4], const AP& ap, const BP& bp, int kb, int lrow, int lch) {
#pragma unroll
  for (int i = 0; i < 4; ++i) {
    ra[i] = *(const u32x4*)(ap(lrow + 32 * i, kb) + lch * 8);
    rb[i] = *(const u32x4*)(bp(lrow + 32 * i, kb) + lch * 8);
  }
}
DI void g_store(bf16_t* As, bf16_t* Bs, const u32x4 (&ra)[4], const u32x4 (&rb)[4], int buf, int lrow, int lch) {
#pragma unroll
  for (int i = 0; i < 4; ++i) {
    int r = lrow + 32 * i;
    int off = buf * 8192 + r * 64 + ((lch ^ ((r >> 1) & 7)) << 3);
    *(u32x4*)(As + off) = ra[i];
    *(u32x4*)(Bs + off) = rb[i];
  }
}
DI void g_compute(f32x4 (&acc)[4][4], const bf16_t* a, const bf16_t* b, int wm, int wn, int lane) {
  bf16x8 af[2][4], bfr[2][4];
#pragma unroll
  for (int ks = 0; ks < 2; ++ks)
#pragma unroll
    for (int i = 0; i < 4; ++i) {
      int r = wm * 64 + i * 16 + (lane & 15);
      af[ks][i] = *(const bf16x8*)(a + r * 64 + (((ks * 4 + (lane >> 4)) ^ ((r >> 1) & 7)) << 3));
      int r2 = wn * 64 + i * 16 + (lane & 15);
      bfr[ks][i] = *(const bf16x8*)(b + r2 * 64 + (((ks * 4 + (lane >> 4)) ^ ((r2 >> 1) & 7)) << 3));
    }
  __builtin_amdgcn_s_setprio(1);
#pragma unroll
  for (int ks = 0; ks < 2; ++ks)
#pragma unroll
    for (int i = 0; i < 4; ++i)
#pragma unroll
      for (int j = 0; j < 4; ++j) acc[i][j] = mfma16(bfr[ks][j], af[ks][i], acc[i][j]);
  __builtin_amdgcn_s_setprio(0);
}
template <class AP, class BP>
DI void gemm_accum(f32x4 (&acc)[4][4], AP ap, BP bp, int nkb, bf16_t* lds) {
  const int tid = TID(), lane = tid & 63, w = tid >> 6;
  const int wm = w >> 1, wn = w & 1;
  const int lrow = tid >> 3, lch = tid & 7;
  bf16_t* As = lds;
  bf16_t* Bs = lds + 16384;
  u32x4 ra0[4], rb0[4], ra1[4], rb1[4];
  __syncthreads();
  g_load(ra0, rb0, ap, bp, 0, lrow, lch);
  g_load(ra1, rb1, ap, bp, 1, lrow, lch);
  g_store(As, Bs, ra0, rb0, 0, lrow, lch);
  __syncthreads();
  for (int kb = 0; kb < nkb; kb += 2) {
    const int k2 = (kb + 2 < nkb) ? kb + 2 : nkb - 2;
    g_load(ra0, rb0, ap, bp, k2, lrow, lch);
    __builtin_amdgcn_sched_barrier(0);
    g_compute(acc, As, Bs, wm, wn, lane);
    g_store(As, Bs, ra1, rb1, 1, lrow, lch);
    __syncthreads();
    g_load(ra1, rb1, ap, bp, k2 + 1, lrow, lch);
    __builtin_amdgcn_sched_barrier(0);
    g_compute(acc, As + 8192, Bs + 8192, wm, wn, lane);
    g_store(As, Bs, ra0, rb0, 0, lrow, lch);
    __syncthreads();
  }
}
template <class E>
DI void gemm_epi(f32x4 (&acc)[4][4], int m0, int n0, E e) {
  const int tid_ = TID();
  const int lane = tid_ & 63, w = tid_ >> 6;
  const int wm = w >> 1, wn = w & 1;
#pragma unroll
  for (int i = 0; i < 4; ++i)
#pragma unroll
    for (int j = 0; j < 4; ++j) {
      int m = m0 + wm * 64 + i * 16 + (lane & 15);
      int n = n0 + wn * 64 + j * 16 + (lane >> 4) * 4;
      e(m, n, acc[i][j]);
    }
}
template <class F>
DI void gemm_epi_staged(f32x4 (&acc)[4][4], int m0, int n0, bf16_t* lds, F f, bf16_t* dst, size_t ld, int nmax) {
  const int tid_ = TID();
  const int lane = tid_ & 63, w = tid_ >> 6;
  const int wm = w >> 1, wn = w & 1;
#pragma unroll
  for (int i = 0; i < 4; ++i)
#pragma unroll
    for (int j = 0; j < 4; ++j) {
      const int ml = wm * 64 + i * 16 + (lane & 15);
      const int nl = wn * 64 + j * 16 + (lane >> 4) * 4;
      f32x4 a = acc[i][j];
      f(m0 + ml, n0 + nl, a);
      uint2 u;
      u.x = pack2(a[0], a[1]);
      u.y = pack2(a[2], a[3]);
      *(uint2*)(lds + ml * 136 + nl) = u;
    }
  __syncthreads();
#pragma unroll
  for (int it = 0; it < 8; ++it) {
    const int idx = tid_ + 256 * it;
    const int row = idx >> 4, ch = idx & 15;
    const u32x4 v = *(const u32x4*)(lds + row * 136 + ch * 8);
    const int n = n0 + ch * 8;
    if (n < nmax) *(u32x4*)(dst + (size_t)(m0 + row) * ld + n) = v;
  }
}
DI void gemm_epi_resid(f32x4 (&acc)[4][4], int m0, int n0, int ntile, bf16_t* lds, const float* xin, float* out, bf16_t* xb, float* rowpart) {
  const int tid_ = TID();
  const int lane = tid_ & 63, w = tid_ >> 6;
  const int wm = w >> 1, wn = w & 1;
  float* red = (float*)lds;
#pragma unroll
  for (int i = 0; i < 4; ++i) {
    const int ml = wm * 64 + i * 16 + (lane & 15);
    const size_t rowoff = (size_t)(m0 + ml) * DM;
    float ss = 0.f;
#pragma unroll
    for (int j = 0; j < 4; ++j) {
      const int n = n0 + wn * 64 + j * 16 + (lane >> 4) * 4;
      const float4 xv = *(const float4*)(xin + rowoff + n);
      const float o0 = xv.x + acc[i][j][0], o1 = xv.y + acc[i][j][1], o2 = xv.z + acc[i][j][2], o3 = xv.w + acc[i][j][3];
      *(float4*)(out + rowoff + n) = make_float4(o0, o1, o2, o3);
      ss += o0 * o0 + o1 * o1 + o2 * o2 + o3 * o3;
      uint2 u;
      u.x = pack2(o0, o1);
      u.y = pack2(o2, o3);
      *(uint2*)(xb + rowoff + n) = u;
    }
    ss += shx(ss, 16, lane);
    ss += shx(ss, 32, lane);
    if ((lane >> 4) == 0) red[wn * 128 + ml] = ss;
  }
  __syncthreads();
  if (tid_ < 128) rowpart[(size_t)ntile * T_TOK + m0 + tid_] = red[tid_] + red[128 + tid_];
}
DI void row_rs(float (&rsv)[4], const float* rowpart, int m0) {
  const int tid_ = TID();
  const int lane = tid_ & 63, wm = tid_ >> 7;
#pragma unroll
  for (int i = 0; i < 4; ++i) {
    const int m = m0 + wm * 64 + i * 16 + (lane & 15);
    float s = 0.f;
#pragma unroll
    for (int t = 0; t < 8; ++t) s += rowpart[(size_t)t * T_TOK + m];
    rsv[i] = rsqrtf(s * (1.f / 1024.f) + 1e-6f);
  }
}
DI void scale_rows(f32x4 (&acc)[4][4], const float (&rsv)[4]) {
#pragma unroll
  for (int i = 0; i < 4; ++i)
#pragma unroll
    for (int j = 0; j < 4; ++j) acc[i][j] *= rsv[i];
}
DI void zero_acc(f32x4 (&acc)[4][4]) {
#pragma unroll
  for (int i = 0; i < 4; ++i)
#pragma unroll
    for (int j = 0; j < 4; ++j) acc[i][j] = f32x4{0.f, 0.f, 0.f, 0.f};
}
struct RowPtr {
  const bf16_t* base; size_t ld;
  DI const bf16_t* operator()(int r, int kb) const { return base + (size_t)r * ld + kb * 64; }
};

DI void convert_wt(const float* W, bf16_t* Wt, int K, int N, int Npad, int gtid, int gthreads, const float* gk = nullptr) {
  const int k8n = K >> 3;
  const long total = (long)Npad * k8n;
  for (long idx = gtid; idx < total; idx += gthreads) {
    int n = (int)(idx % Npad);
    int k8 = (int)(idx / Npad);
    uint4 o = make_uint4(0, 0, 0, 0);
    if (n < N) {
      const float* s = W + (size_t)(k8 * 8) * N + n;
      float v0 = s[0], v1 = s[(size_t)N], v2 = s[(size_t)2 * N], v3 = s[(size_t)3 * N];
      float v4 = s[(size_t)4 * N], v5 = s[(size_t)5 * N], v6 = s[(size_t)6 * N], v7 = s[(size_t)7 * N];
      if (gk) {
        const float* gp = gk + k8 * 8;
        v0 *= gp[0]; v1 *= gp[1]; v2 *= gp[2]; v3 *= gp[3]; v4 *= gp[4]; v5 *= gp[5]; v6 *= gp[6]; v7 *= gp[7];
      }
      o = make_uint4(pack2(v0, v1), pack2(v2, v3), pack2(v4, v5), pack2(v6, v7));
    }
    *(uint4*)(Wt + (size_t)n * K + k8 * 8) = o;
  }
}

DI void phase0(const Params& p, const int L) {
  const int gtid = VBID * 256 + TID();
  const int gthreads = NVB * 256;
  bf16_t* wl = (bf16_t*)(p.ws + O_WT);
  convert_wt(p.w_in + (size_t)L * 1024 * 5400, wl + W_IN, 1024, 5400, NPAD_IN, gtid, gthreads);
  convert_wt(p.cmp_w1_k + (size_t)L * 2048 * 256, wl + W_C1K, 2048, 256, 256, gtid, gthreads);
  convert_wt(p.cmp_w1_v + (size_t)L * 2048 * 256, wl + W_C1V, 2048, 256, 256, gtid, gthreads);
  convert_wt(p.w_up_nsa + (size_t)L * 512 * 1024, wl + W_UPA, 512, 1024, 1024, gtid, gthreads);
  convert_wt(p.w_up_ret + (size_t)L * 512 * 1024, wl + W_UPR, 512, 1024, 1024, gtid, gthreads);
  convert_wt(p.w_out + (size_t)L * 1024 * 1024, wl + W_OUT, 1024, 1024, 1024, gtid, gthreads);
  convert_wt(p.w_ff1 + (size_t)L * 1024 * 4096, wl + W_FF1, 1024, 4096, 4096, gtid, gthreads, p.norm_mlp + L * DM);
  convert_wt(p.w_ff2 + (size_t)L * 4096 * 1024, wl + W_FF2, 4096, 1024, 1024, gtid, gthreads);
  convert_wt(p.w_ple + (size_t)L * 256 * 1024, wl + W_PLE, 256, 1024, 1024, gtid, gthreads);
  convert_wt(p.w_ple_gate + (size_t)L * 1024 * 1024, wl + W_PG, 1024, 1024, 1024, gtid, gthreads, p.norm_ple + L * DM);
  if (L == 0) {
    float2* rope = (float2*)(p.ws + O_ROPE);
    for (int idx = gtid; idx < SEQ * 64; idx += gthreads) {
      int pos = idx >> 6, j = idx & 63;
      float inv = exp2f(-(float)j * (13.287712379549449f / 64.f));
      float ang = (float)pos * inv;
      double rev = (double)ang * 0.15915494309189535;
      rev -= rint(rev);
      float fr = (float)rev;
      rope[idx] = make_float2(__builtin_amdgcn_cosf(fr), __builtin_amdgcn_sinf(fr));
    }
  }
  float* part = (float*)(p.ws + O_HID);
  {
    const int n = gtid & 255;
    for (int item = VBID; item < 128; item += NVB) {
      const int kv = item >> 6, kc = item & 63;
      const float* pos = (kv ? p.cmp_pos_v : p.cmp_pos_k) + L * 2048 + kc * 32;
      const float* w1 = (kv ? p.cmp_w1_v : p.cmp_w1_k) + (size_t)L * 2048 * 256 + (size_t)kc * 32 * 256;
      float a = 0.f;
#pragma unroll 8
      for (int k = 0; k < 32; ++k) a += pos[k] * w1[(size_t)k * 256 + n];
      part[item * 256 + n] = a;
    }
  }
}

DI void norm_phase(const float* xin, const float* g, bf16_t* h) {
  const int tid_ = TID();
  const int lane = tid_ & 63;
  const int gw = (VBID * 256 + tid_) >> 6;
  const int nw = NVB * 4;
  float4 gv[4];
#pragma unroll
  for (int i = 0; i < 4; ++i) gv[i] = ((const float4*)g)[i * 64 + lane];
  for (int row = gw; row < T_TOK; row += nw) {
    const float4* xr = (const float4*)(xin + (size_t)row * DM);
    float4 v[4];
    float ss = 0.f;
#pragma unroll
    for (int i = 0; i < 4; ++i) {
      v[i] = xr[i * 64 + lane];
      ss += v[i].x * v[i].x + v[i].y * v[i].y + v[i].z * v[i].z + v[i].w * v[i].w;
    }
    ss = wave_sum(ss, lane);
    float rs = rsqrtf(ss * (1.f / 1024.f) + 1e-6f);
    uint2* hr = (uint2*)(h + (size_t)row * DM);
#pragma unroll
    for (int i = 0; i < 4; ++i) {
      uint2 o;
      o.x = pack2(v[i].x * rs * gv[i].x, v[i].y * rs * gv[i].y);
      o.y = pack2(v[i].z * rs * gv[i].z, v[i].w * rs * gv[i].w);
      hr[i * 64 + lane] = o;
    }
  }
}

DI void post_z(const Params& p, int layer) {
  const int tid_ = TID();
  const int lane = tid_ & 63;
  const int gw = (VBID * 256 + tid_) >> 6;
  const int nw = NVB * 4;
  bf16_t* z = (bf16_t*)(p.ws + O_Z);
  bf16_t* vsT = (bf16_t*)(p.ws + O_VST);
  bf16_t* vwT = (bf16_t*)(p.ws + O_VWT);
  bf16_t* rvT = (bf16_t*)(p.ws + O_RVT);
  bf16_t* kzT = (bf16_t*)(p.ws + O_KZT);
  const float2* rope = (const float2*)(p.ws + O_ROPE);
  const float* qn = p.nsa_q_norm + layer * 64;
  const float* kn = p.nsa_k_norm + layer * 64;
  {
    const float* part = (const float*)(p.ws + O_HID);
    float* bias = (float*)(p.ws + O_BIAS);
    const int idx = VBID * 256 + tid_;
    if (idx < 512) {
      const int kv = idx >> 8, n = idx & 255;
      float a = 0.f;
      for (int kc = 0; kc < 64; ++kc) a += part[(kv * 64 + kc) * 256 + n];
      bias[idx] = a;
    }
  }
  for (int item = gw; item < 1024 * 36; item += nw) {
    const int tc = item / 36, slab = item - tc * 36;
    const int tok0 = tc * 32;
    const int b = tok0 >> 13, spos = tok0 & 8191;
    bf16_t* zr = z + (size_t)tok0 * ZS;
    if (slab >= 32) {
      const int s4 = slab - 32, kv = s4 >> 1, gi = s4 & 1;
      const int colbase = (kv ? C_VC : C_KC) + gi * 64;
      bf16_t* dst = (bf16_t*)(p.ws + O_KVD) + ((size_t)((kv * 8 + b * 2 + gi) * SEQ + spos)) * 64 + lane;
      bf16_t u[32];
#pragma unroll
      for (int i = 0; i < 32; ++i) u[i] = zr[(size_t)i * ZS + colbase + lane];
#pragma unroll
      for (int i = 0; i < 32; ++i) dst[i * 64] = u[i];
    } else if (slab < 12) {
      int colbase; const float* g; float sc;
      if (slab < 8) { colbase = C_Q + slab * 64; g = qn; sc = 0.125f; }
      else if (slab < 10) { colbase = C_KS + (slab - 8) * 64; g = kn; sc = 1.f; }
      else { colbase = C_KW + (slab - 10) * 64; g = kn; sc = 1.f; }
      const float gv = g[lane] * sc;
      float v[32];
#pragma unroll
      for (int i = 0; i < 32; ++i) v[i] = bf2f(zr[(size_t)i * ZS + colbase + lane]);
#pragma unroll
      for (int i = 0; i < 32; ++i) {
        float ss = wave_sum(v[i] * v[i], lane);
        float rs = rsqrtf(ss * (1.f / 64.f) + 1e-6f);
        zr[(size_t)i * ZS + colbase + lane] = f2bf(v[i] * rs * gv);
      }
    } else if (slab < 16 || slab >= 24) {
      int colbase; bf16_t* dst;
      if (slab < 16) {
        const int gi = slab & 1;
        const bool isw = slab >= 14;
        colbase = (isw ? C_VW : C_VS) + gi * 64;
        dst = (isw ? vwT : vsT) + ((size_t)((b * 2 + gi) * 64 + lane)) * TS + spos;
      } else {
        const int s8 = slab - 24;
        const int h = s8 >> 1, half = s8 & 1;
        colbase = C_RV + s8 * 64;
        dst = rvT + ((size_t)((b * 4 + h) * 128 + half * 64 + lane)) * TS + spos;
      }
      unsigned u[32];
#pragma unroll
      for (int i = 0; i < 32; ++i) u[i] = zr[(size_t)i * ZS + colbase + lane];
#pragma unroll
      for (int q4 = 0; q4 < 4; ++q4)
        *(uint4*)(dst + q4 * 8) = make_uint4(u[q4 * 8 + 0] | (u[q4 * 8 + 1] << 16), u[q4 * 8 + 2] | (u[q4 * 8 + 3] << 16),
                                             u[q4 * 8 + 4] | (u[q4 * 8 + 5] << 16), u[q4 * 8 + 6] | (u[q4 * 8 + 7] << 16));
    } else if (slab < 20) {
      const int h = slab - 16;
      const int colbase = C_RQ + h * 128;
      float x1[32], x2[32];
#pragma unroll
      for (int i = 0; i < 32; ++i) {
        const bf16_t* p1 = zr + (size_t)i * ZS + colbase + lane;
        x1[i] = bf2f(p1[0]);
        x2[i] = bf2f(p1[64]);
      }
#pragma unroll
      for (int i = 0; i < 32; ++i) {
        bf16_t* p1 = zr + (size_t)i * ZS + colbase + lane;
        float2 cs = rope[(spos + i) * 64 + lane];
        p1[0] = f2bf(x1[i] * cs.x - x2[i] * cs.y);
        p1[64] = f2bf(x1[i] * cs.y + x2[i] * cs.x);
      }
    } else {
      const int h = slab - 20;
      const int colbase = C_RK + h * 128;
      const float lg2 = log2f(1.f - exp2f(-5.f - (float)h));
      float x1[32], x2[32];
#pragma unroll
      for (int i = 0; i < 32; ++i) {
        const bf16_t* p1 = zr + (size_t)i * ZS + colbase + lane;
        x1[i] = bf2f(p1[0]);
        x2[i] = bf2f(p1[64]);
      }
      unsigned u1[32], u2[32];
#pragma unroll
      for (int i = 0; i < 32; ++i) {
        bf16_t* p1 = zr + (size_t)i * ZS + colbase + lane;
        float2 cs = rope[(spos + i) * 64 + lane];
        float o1 = (x1[i] * cs.x - x2[i] * cs.y) * 0.08838834764831845f;
        float o2 = (x1[i] * cs.y + x2[i] * cs.x) * 0.08838834764831845f;
        p1[0] = f2bf(o1);
        p1[64] = f2bf(o2);
        float zeta = exp2f(lg2 * (float)(127 - ((spos + i) & 127)));
        u1[i] = f2bf(o1 * zeta);
        u2[i] = f2bf(o2 * zeta);
      }
      bf16_t* d1 = kzT + ((size_t)((b * 4 + h) * 128 + lane)) * TS + spos;
#pragma unroll
      for (int q4 = 0; q4 < 4; ++q4) {
        *(uint4*)(d1 + q4 * 8) = make_uint4(u1[q4 * 8 + 0] | (u1[q4 * 8 + 1] << 16), u1[q4 * 8 + 2] | (u1[q4 * 8 + 3] << 16),
                                            u1[q4 * 8 + 4] | (u1[q4 * 8 + 5] << 16), u1[q4 * 8 + 6] | (u1[q4 * 8 + 7] << 16));
        *(uint4*)(d1 + (size_t)64 * TS + q4 * 8) = make_uint4(u2[q4 * 8 + 0] | (u2[q4 * 8 + 1] << 16), u2[q4 * 8 + 2] | (u2[q4 * 8 + 3] << 16),
                                                              u2[q4 * 8 + 4] | (u2[q4 * 8 + 5] << 16), u2[q4 * 8 + 6] | (u2[q4 * 8 + 7] << 16));
      }
    }
  }
}

DI void phase4b(const Params& p, int layer) {
  const int tid_ = TID();
  const int lane = tid_ & 63;
  const int gw = (VBID * 256 + tid_) >> 6;
  const int nw = NVB * 4;
  bf16_t* z = (bf16_t*)(p.ws + O_Z);
  const bf16_t* hid = (const bf16_t*)(p.ws + O_HID);
  bf16_t* kcmp = (bf16_t*)(p.ws + O_KCMP);
  bf16_t* vcmpT = (bf16_t*)(p.ws + O_VCMPT);
  const float* kn = p.nsa_k_norm + layer * 64;
  for (int item = gw; item < 8192; item += nw) {
    const int kv = item >> 12, row = item & 4095;
    const bf16_t* hrow = hid + ((size_t)kv * 4096 + row) * 256;
    const float* w2 = (kv ? p.cmp_w2_v : p.cmp_w2_k) + (size_t)layer * 256 * 64;
    float acc = 0.f;
    for (int k8 = 0; k8 < 32; ++k8) {
      uint4 hv = *(const uint4*)(hrow + k8 * 8);
      const float* wr = w2 + (size_t)(k8 * 8) * 64 + lane;
      acc += bflo(hv.x) * wr[0];
      acc += bfhi(hv.x) * wr[64];
      acc += bflo(hv.y) * wr[128];
      acc += bfhi(hv.y) * wr[192];
      acc += bflo(hv.z) * wr[256];
      acc += bfhi(hv.z) * wr[320];
      acc += bflo(hv.w) * wr[384];
      acc += bfhi(hv.w) * wr[448];
    }
    if (kv == 0) {
      float ss = wave_sum(acc * acc, lane);
      float rs = rsqrtf(ss * (1.f / 64.f) + 1e-6f);
      kcmp[(size_t)row * 64 + lane] = f2bf(acc * rs * kn[lane]);
    } else {
      const int bg = row >> 9, c = row & 511;
      vcmpT[((size_t)(bg * 64 + lane)) * 512 + c] = f2bf(acc);
    }
  }
  const int gtid = VBID * 256 + tid_;
  const int gthreads = NVB * 256;
  for (int idx = gtid; idx < 65536; idx += gthreads) {
    const int d4 = idx & 31, e = (idx >> 5) & 127, h = (idx >> 12) & 3, b = idx >> 14;
    const float lg2 = log2f(1.f - exp2f(-5.f - (float)h));
    const float gch = exp2f(lg2 * 128.f);
    float r0 = 0.f, r1 = 0.f, r2 = 0.f, r3 = 0.f;
    bf16_t* ptr = z + ((size_t)(b * SEQ + e)) * ZS + C_RV + h * 128 + d4 * 4;
    for (int c0 = 0; c0 < 64; c0 += 16) {
      typedef __attribute__((ext_vector_type(2))) unsigned u32x2;
      u32x2 v[16];
#pragma unroll
      for (int i = 0; i < 16; ++i) v[i] = *(const u32x2*)(ptr + (size_t)(c0 + i) * 128 * ZS);
#pragma unroll
      for (int i = 0; i < 16; ++i) {
        u32x2 o;
        o.x = pack2(r0, r1);
        o.y = pack2(r2, r3);
        *(u32x2*)(ptr + (size_t)(c0 + i) * 128 * ZS) = o;
        r0 = gch * r0 + bflo(v[i].x);
        r1 = gch * r1 + bfhi(v[i].x);
        r2 = gch * r2 + bflo(v[i].y);
        r3 = gch * r3 + bfhi(v[i].y);
      }
    }
  }
}


DI void tile64_gload(int tid, u32x4& r0, u32x4& r1, const bf16_t* base, size_t stride) {
  {
    int idx = tid;
    int row = idx >> 3, ch = idx & 7;
    r0 = *(const u32x4*)(base + (size_t)row * stride + ch * 8);
  }
  {
    int idx = tid + 256;
    int row = idx >> 3, ch = idx & 7;
    r1 = *(const u32x4*)(base + (size_t)row * stride + ch * 8);
  }
}
DI void tile64_sstore(int tid, bf16_t* dst, const u32x4& r0, const u32x4& r1) {
  {
    int idx = tid;
    int row = idx >> 3, ch = idx & 7;
    *(u32x4*)(dst + row * 64 + ((ch ^ ((row >> 1) & 7)) << 3)) = r0;
  }
  {
    int idx = tid + 256;
    int row = idx >> 3, ch = idx & 7;
    *(u32x4*)(dst + row * 64 + ((ch ^ ((row >> 1) & 7)) << 3)) = r1;
  }
}

struct AttnSt { f32x4 O[2][4]; f32x4 L[2]; float m[2]; float l[2]; };

template <int MODE, bool FX>
DI void attn_compute(const int lane, const bf16_t* Ks, const bf16_t* Vs, const bf16x8 (&qf)[2][2], AttnSt& st, const float (&invl)[2],
                     int lo, int hi, float (&impA)[4], float (&impE)[4], const float CL) {
  const int quad = lane >> 4, col = lane & 15;
  f32x4 S[4][2];
#pragma unroll
  for (int kt = 0; kt < 4; ++kt)
#pragma unroll
    for (int hh = 0; hh < 2; ++hh) S[kt][hh] = f32x4{0.f, 0.f, 0.f, 0.f};
#pragma unroll
  for (int ks = 0; ks < 2; ++ks) {
#pragma unroll
    for (int kt = 0; kt < 4; ++kt) {
      int row = kt * 16 + col;
      bf16x8 kf = *(const bf16x8*)(Ks + row * 64 + (((ks * 4 + quad) ^ ((row >> 1) & 7)) << 3));
#pragma unroll
      for (int hh = 0; hh < 2; ++hh) S[kt][hh] = mfma16(kf, qf[hh][ks], S[kt][hh]);
    }
  }
  bf16x8 pf[2][2];
  const bool full = (lo <= 0) && (hi >= 63);
  const bool none = (hi < 0) || (lo > 63) || (hi < lo);
  if (__all(full || none)) {
    constexpr float L2E = 1.4426950408889634f;
#pragma unroll
    for (int hh = 0; hh < 2; ++hh) {
      float mL;
      float il = 1.f;
      if (FX) {
        mL = full ? CL : 1e30f;
        if (MODE == 1) il = invl[hh];
      } else if (MODE != 1) {
        float mx = -1e30f;
#pragma unroll
        for (int kt = 0; kt < 4; ++kt)
#pragma unroll
          for (int j = 0; j < 4; ++j) mx = fmaxf(mx, S[kt][hh][j]);
        mx = full ? mx : -1e30f;
        mx = fmaxf(mx, shx(mx, 16, lane));
        mx = fmaxf(mx, shx(mx, 32, lane));
        const float m_new = fmaxf(st.m[hh], mx);
        const float alpha = __expf(st.m[hh] - m_new);
        st.m[hh] = m_new;
        st.l[hh] *= alpha;
        if (MODE == 2) {
#pragma unroll
          for (int dt = 0; dt < 4; ++dt) st.O[hh][dt] *= alpha;
        }
        mL = full ? m_new * L2E : 1e30f;
      } else {
        mL = full ? st.m[hh] * L2E : 1e30f;
        il = invl[hh];
      }
      float rs = 0.f;
#pragma unroll
      for (int kt = 0; kt < 4; ++kt) {
        float a = 0.f;
#pragma unroll
        for (int j = 0; j < 4; ++j) {
          float pv = __builtin_amdgcn_exp2f(fmaf(S[kt][hh][j], L2E, -mL));
          if (MODE == 1) pv *= il;
          S[kt][hh][j] = pv;
          a += pv;
        }
        rs += a;
        if (MODE == 1) {
          impA[kt] += a;
          impE[kt] += S[kt][hh][3];
        }
      }
      if (MODE != 1 && !(FX && MODE == 2)) st.l[hh] += rs;
      if (MODE != 0) {
#pragma unroll
        for (int c = 0; c < 2; ++c)
          pf[hh][c] = mk8(pack2(S[2 * c][hh][0], S[2 * c][hh][1]), pack2(S[2 * c][hh][2], S[2 * c][hh][3]),
                          pack2(S[2 * c + 1][hh][0], S[2 * c + 1][hh][1]), pack2(S[2 * c + 1][hh][2], S[2 * c + 1][hh][3]));
      }
    }
  } else {
#pragma unroll
  for (int hh = 0; hh < 2; ++hh) {
    if (FX) {
      constexpr float L2E = 1.4426950408889634f;
      const float il = (MODE == 1) ? invl[hh] : 1.f;
      float rs = 0.f;
#pragma unroll
      for (int kt = 0; kt < 4; ++kt) {
        float a = 0.f;
#pragma unroll
        for (int j = 0; j < 4; ++j) {
          const int kl = kt * 16 + quad * 4 + j;
          const bool v = (kl >= lo) && (kl <= hi);
          float pv = v ? __builtin_amdgcn_exp2f(fmaf(S[kt][hh][j], L2E, -CL)) : 0.f;
          if (MODE == 1) pv *= il;
          S[kt][hh][j] = pv;
          a += pv;
        }
        rs += a;
        if (MODE == 1) {
          impA[kt] += a;
          impE[kt] += S[kt][hh][3];
        }
      }
      if (MODE != 1 && !(FX && MODE == 2)) st.l[hh] += rs;
      if (MODE != 0) {
#pragma unroll
        for (int c = 0; c < 2; ++c)
          pf[hh][c] = mk8(pack2(S[2 * c][hh][0], S[2 * c][hh][1]), pack2(S[2 * c][hh][2], S[2 * c][hh][3]),
                          pack2(S[2 * c + 1][hh][0], S[2 * c + 1][hh][1]), pack2(S[2 * c + 1][hh][2], S[2 * c + 1][hh][3]));
      }
      continue;
    }
    float mx = -1e30f;
#pragma unroll
    for (int kt = 0; kt < 4; ++kt)
#pragma unroll
      for (int j = 0; j < 4; ++j) {
        int kl = kt * 16 + quad * 4 + j;
        bool v = (kl >= lo) && (kl <= hi);
        float sv = v ? S[kt][hh][j] : -1e30f;
        S[kt][hh][j] = sv;
        mx = fmaxf(mx, sv);
      }
    if (MODE != 1) {
      mx = fmaxf(mx, shx(mx, 16, lane));
      mx = fmaxf(mx, shx(mx, 32, lane));
      float m_new = fmaxf(st.m[hh], mx);
      float alpha = __expf(st.m[hh] - m_new);
      st.m[hh] = m_new;
      float rs = 0.f;
#pragma unroll
      for (int kt = 0; kt < 4; ++kt)
#pragma unroll
        for (int j = 0; j < 4; ++j) {
          float sv = S[kt][hh][j];
          float pv = (sv > -1e29f) ? __expf(sv - m_new) : 0.f;
          rs += pv;
          S[kt][hh][j] = pv;
        }
      st.l[hh] = st.l[hh] * alpha + rs;
      if (MODE == 2) {
#pragma unroll
        for (int dt = 0; dt < 4; ++dt) st.O[hh][dt] *= alpha;
      }
    } else {
      const float mh = st.m[hh], il = invl[hh];
#pragma unroll
      for (int kt = 0; kt < 4; ++kt) {
        float a = 0.f;
#pragma unroll
        for (int j = 0; j < 4; ++j) {
          float sv = S[kt][hh][j];
          float pv = (sv > -1e29f) ? __expf(sv - mh) * il : 0.f;
          S[kt][hh][j] = pv;
          a += pv;
        }
        impA[kt] += a;
        impE[kt] += S[kt][hh][3];
      }
    }
    if (MODE != 0) {
#pragma unroll
      for (int c = 0; c < 2; ++c)
        pf[hh][c] = mk8(pack2(S[2 * c][hh][0], S[2 * c][hh][1]), pack2(S[2 * c][hh][2], S[2 * c][hh][3]),
                        pack2(S[2 * c + 1][hh][0], S[2 * c + 1][hh][1]), pack2(S[2 * c + 1][hh][2], S[2 * c + 1][hh][3]));
    }
  }
  }
  if (MODE != 0) {
#pragma unroll
    for (int dt = 0; dt < 4; ++dt) {
      const int row = dt * 16 + col;
      const int sw = (row >> 1) & 7;
#pragma unroll
      for (int c = 0; c < 2; ++c) {
        uint2 a = *(const uint2*)(Vs + row * 64 + (((4 * c + (quad >> 1)) ^ sw) << 3) + (quad & 1) * 4);
        uint2 b = *(const uint2*)(Vs + row * 64 + (((4 * c + 2 + (quad >> 1)) ^ sw) << 3) + (quad & 1) * 4);
        bf16x8 vf = mk8(a.x, a.y, b.x, b.y);
#pragma unroll
        for (int hh = 0; hh < 2; ++hh) st.O[hh][dt] = mfma16(vf, pf[hh][c], st.O[hh][dt]);
      }
    }
    if (FX && MODE == 2) {
      const bf16x8 ones = mk8(0x3F803F80u, 0x3F803F80u, 0x3F803F80u, 0x3F803F80u);
#pragma unroll
      for (int c = 0; c < 2; ++c)
#pragma unroll
        for (int hh = 0; hh < 2; ++hh) st.L[hh] = mfma16(ones, pf[hh][c], st.L[hh]);
    }
  }
}

DI void st_reset(AttnSt& st) {
#pragma unroll
  for (int h = 0; h < 2; ++h) {
    st.m[h] = -1e30f;
    st.l[h] = 0.f;
    st.L[h] = f32x4{0.f, 0.f, 0.f, 0.f};
#pragma unroll
    for (int dt = 0; dt < 4; ++dt) st.O[h][dt] = f32x4{0.f, 0.f, 0.f, 0.f};
  }
}

template <bool FIRST>
DI void nsa_flush(const int quad, bf16_t* optr, const AttnSt& st, const float (&sc)[2]) {
#pragma unroll
  for (int h = 0; h < 2; ++h)
#pragma unroll
    for (int dt = 0; dt < 4; ++dt) {
      uint2* q = (uint2*)(optr + h * 64 + dt * 16 + quad * 4);
      f32x4 o = st.O[h][dt] * sc[h];
      if (!FIRST) {
        uint2 pv = *q;
        o[0] += bflo(pv.x); o[1] += bfhi(pv.x); o[2] += bflo(pv.y); o[3] += bfhi(pv.y);
      }
      uint2 u;
      u.x = pack2(o[0], o[1]);
      u.y = pack2(o[2], o[3]);
      *q = u;
    }
}

template <bool FX>
DI void nsa_tile(const Params& p, int b, int g, int tile, bf16_t* lds, const float CL) {
  const int tid = TID(), lane = tid & 63, w = tid >> 6, quad = lane >> 4, col = lane & 15;
  const int cur = tile;
  const int tok = tile * 64 + w * 16 + col;
  bf16_t* z = (bf16_t*)(p.ws + O_Z);
  const bf16_t* kcmp = (const bf16_t*)(p.ws + O_KCMP) + (size_t)(b * 2 + g) * 512 * 64;
  const bf16_t* vcmpT = (const bf16_t*)(p.ws + O_VCMPT) + (size_t)(b * 2 + g) * 64 * 512;
  const bf16_t* vsT = (const bf16_t*)(p.ws + O_VST) + (size_t)(b * 2 + g) * 64 * TS;
  const bf16_t* vwT = (const bf16_t*)(p.ws + O_VWT) + (size_t)(b * 2 + g) * 64 * TS;
  const bf16_t* zb = z + (size_t)b * SEQ * ZS;
  const bf16_t* ztok = z + ((size_t)(b * SEQ + tok)) * ZS;
  bf16_t* otok = (bf16_t*)(p.ws + O_ONSA) + ((size_t)(b * SEQ + tok)) * 512 + g * 256;
  bf16_t* Ks = lds;
  bf16_t* Vs = lds + 4096;
  float* impl = (float*)(lds + 8192);

  AttnSt st;
  float invl[2] = {0.f, 0.f};
  float dA[4] = {0.f, 0.f, 0.f, 0.f}, dE[4] = {0.f, 0.f, 0.f, 0.f};
  u32x4 rk0, rk1, rv0, rv1;
  bf16x8 qf[2][2];

  const int ncs = (cur < 16) ? 1 : (cur >> 4) + 1;
  const int chi = (tok >= 31) ? ((tok - 31) >> 4) : -1;

  for (int hp = 0; hp < 2; ++hp) {
#pragma unroll
    for (int hh = 0; hh < 2; ++hh)
#pragma unroll
      for (int ks = 0; ks < 2; ++ks) qf[hh][ks] = *(const bf16x8*)(ztok + C_Q + g * 256 + (hp * 2 + hh) * 64 + ks * 32 + quad * 8);
    st_reset(st);
    tile64_gload(tid, rk0, rk1, kcmp, 64);
    for (int s = 0; s < ncs; ++s) {
      __syncthreads();
      tile64_sstore(tid, Ks, rk0, rk1);
      __syncthreads();
      if (s + 1 < ncs) tile64_gload(tid, rk0, rk1, kcmp + (size_t)(s + 1) * 4096, 64);
      attn_compute<0, FX>(lane, Ks, Vs, qf, st, invl, 0, chi - s * 64, dA, dE, CL);
    }
#pragma unroll
    for (int h = 0; h < 2; ++h) {
      float l = st.l[h];
      l += shx(l, 16, lane);
      l += shx(l, 32, lane);
      invl[h] = (l > 0.f) ? 1.f / l : 0.f;
    }
    {
      float carry = 0.f;
      tile64_gload(tid, rk0, rk1, kcmp, 64);
      tile64_gload(tid, rv0, rv1, vcmpT, 512);
      for (int s = 0; s < ncs; ++s) {
        float iA[4] = {0.f, 0.f, 0.f, 0.f}, iE[4] = {0.f, 0.f, 0.f, 0.f};
        __syncthreads();
        tile64_sstore(tid, Ks, rk0, rk1);
        tile64_sstore(tid, Vs, rv0, rv1);
        __syncthreads();
        if (s + 1 < ncs) {
          tile64_gload(tid, rk0, rk1, kcmp + (size_t)(s + 1) * 4096, 64);
          tile64_gload(tid, rv0, rv1, vcmpT + (s + 1) * 64, 512);
        }
        attn_compute<1, FX>(lane, Ks, Vs, qf, st, invl, 0, chi - s * 64, iA, iE, CL);
#pragma unroll
        for (int kt = 0; kt < 4; ++kt) {
          float recv = shfrom(iE[kt], (lane + 48) & 63);
          float val = iA[kt] + ((quad == 0) ? carry : recv);
          carry = recv;
          float* slot = impl + (s * 4 + kt) * 256 + tid;
          if (hp == 0) *slot = val; else *slot += val;
        }
      }
    }
    {
      float sc[2];
#pragma unroll
      for (int h = 0; h < 2; ++h) sc[h] = sigmoidf(bf2f(ztok[C_GT + 0 * 8 + g * 4 + hp * 2 + h]));
      nsa_flush<true>(quad, otok + hp * 128, st, sc);
    }
  }

  uint32_t sw0, sw1, sw2, sw3;
  {
    uint32_t key[32];
#pragma unroll
    for (int i = 0; i < 32; ++i) {
      int j = i * 4 + quad;
      float sc = (i < ncs * 4) ? impl[i * 256 + tid] : 0.f;
      if (j == 0 || j == cur || j == cur - 1) sc = 1e4f;
      uint32_t k = (__float_as_uint(sc) & ~127u) | (uint32_t)(127 - j);
      key[i] = (j > cur) ? 0u : k;
    }
    uint32_t prev = 0xFFFFFFFFu;
    for (int r = 0; r < 16; ++r) {
      uint32_t mx = 0u;
#pragma unroll
      for (int i = 0; i < 32; ++i) {
        uint32_t k = key[i];
        k = (k < prev) ? k : 0u;
        mx = (k > mx) ? k : mx;
      }
      uint32_t o = shxu(mx, 16, lane);
      mx = (o > mx) ? o : mx;
      o = shxu(mx, 32, lane);
      mx = (o > mx) ? o : mx;
      prev = mx;
    }
    sw0 = 0u; sw1 = 0u; sw2 = 0u; sw3 = 0u;
#pragma unroll
    for (int i = 0; i < 32; ++i) {
      bool sel = (key[i] != 0u) && (key[i] >= prev);
      uint32_t bit = sel ? (1u << ((i & 7) * 4 + quad)) : 0u;
      if ((i >> 3) == 0) sw0 |= bit;
      else if ((i >> 3) == 1) sw1 |= bit;
      else if ((i >> 3) == 2) sw2 |= bit;
      else sw3 |= bit;
    }
    sw0 |= shxu(sw0, 16, lane); sw0 |= shxu(sw0, 32, lane);
    sw1 |= shxu(sw1, 16, lane); sw1 |= shxu(sw1, 32, lane);
    sw2 |= shxu(sw2, 16, lane); sw2 |= shxu(sw2, 32, lane);
    sw3 |= shxu(sw3, 16, lane); sw3 |= shxu(sw3, 32, lane);
  }

  for (int hp = 0; hp < 2; ++hp) {
#pragma unroll
    for (int hh = 0; hh < 2; ++hh)
#pragma unroll
      for (int ks = 0; ks < 2; ++ks) qf[hh][ks] = *(const bf16x8*)(ztok + C_Q + g * 256 + (hp * 2 + hh) * 64 + ks * 32 + quad * 8);
    st_reset(st);
    {
      const bf16_t* kb = zb + C_KS + g * 64;
      tile64_gload(tid, rk0, rk1, kb, ZS);
      tile64_gload(tid, rv0, rv1, vsT, TS);
      for (int s = 0; s <= cur; ++s) {
        __syncthreads();
        tile64_sstore(tid, Ks, rk0, rk1);
        tile64_sstore(tid, Vs, rv0, rv1);
        __syncthreads();
        if (s < cur) {
          tile64_gload(tid, rk0, rk1, kb + (size_t)(s + 1) * 64 * ZS, ZS);
          tile64_gload(tid, rv0, rv1, vsT + (s + 1) * 64, TS);
        }
        uint32_t wsel = (s < 32) ? sw0 : (s < 64) ? sw1 : (s < 96) ? sw2 : sw3;
        bool sel = (wsel >> (s & 31)) & 1u;
        int hi = sel ? (tok - s * 64) : -1;
        if (__any(hi >= 0)) attn_compute<2, FX>(lane, Ks, Vs, qf, st, invl, 0, hi, dA, dE, CL);
      }
    }
    {
      float sc[2];
#pragma unroll
      for (int h = 0; h < 2; ++h) {
        float l;
        if (FX) {
          l = st.L[h][0];
        } else {
          l = st.l[h];
          l += shx(l, 16, lane);
          l += shx(l, 32, lane);
        }
        sc[h] = (l > 0.f) ? sigmoidf(bf2f(ztok[C_GT + 1 * 8 + g * 4 + hp * 2 + h])) / l : 0.f;
      }
      nsa_flush<false>(quad, otok + hp * 128, st, sc);
    }
    st_reset(st);
    {
      const bf16_t* kb = zb + C_KW + g * 64;
      const int s0 = (cur >= 8) ? cur - 8 : 0;
      tile64_gload(tid, rk0, rk1, kb + (size_t)s0 * 64 * ZS, ZS);
      tile64_gload(tid, rv0, rv1, vwT + s0 * 64, TS);
      for (int s = s0; s <= cur; ++s) {
        __syncthreads();
        tile64_sstore(tid, Ks, rk0, rk1);
        tile64_sstore(tid, Vs, rv0, rv1);
        __syncthreads();
        if (s < cur) {
          tile64_gload(tid, rk0, rk1, kb + (size_t)(s + 1) * 64 * ZS, ZS);
          tile64_gload(tid, rv0, rv1, vwT + (s + 1) * 64, TS);
        }
        attn_compute<2, FX>(lane, Ks, Vs, qf, st, invl, tok - 511 - s * 64, tok - s * 64, dA, dE, CL);
      }
    }
    {
      float sc[2];
#pragma unroll
      for (int h = 0; h < 2; ++h) {
        float l;
        if (FX) {
          l = st.L[h][0];
        } else {
          l = st.l[h];
          l += shx(l, 16, lane);
          l += shx(l, 32, lane);
        }
        sc[h] = (l > 0.f) ? sigmoidf(bf2f(ztok[C_GT + 2 * 8 + g * 4 + hp * 2 + h])) / l : 0.f;
      }
      nsa_flush<false>(quad, otok + hp * 128, st, sc);
    }
  }
}

DI void load128(int tid, bf16_t* lds, const bf16_t* base, size_t stride) {
  u32x4 r[8];
#pragma unroll
  for (int i = 0; i < 8; ++i) {
    int idx = tid + 256 * i;
    int row = idx >> 4, ch = idx & 15;
    r[i] = *(const u32x4*)(base + (size_t)row * stride + ch * 8);
  }
#pragma unroll
  for (int i = 0; i < 8; ++i) {
    int idx = tid + 256 * i;
    int row = idx >> 4, ch = idx & 15;
    *(u32x4*)(lds + row * 128 + ((ch ^ (row & 15)) << 3)) = r[i];
  }
}

DI void ret_tile(const Params& p, int b, int h, int c, bf16_t* lds) {
  const int tid = TID(), lane = tid & 63, w = tid >> 6, quad = lane >> 4, col = lane & 15;
  const float lg2 = log2f(1.f - exp2f(-5.f - (float)h));
  bf16_t* z = (bf16_t*)(p.ws + O_Z);
  const bf16_t* rvT = (const bf16_t*)(p.ws + O_RVT);
  bf16_t* zc = z + ((size_t)(b * SEQ + c * 128)) * ZS;
  bf16x8 qf[2][4];
#pragma unroll
  for (int nt = 0; nt < 2; ++nt)
#pragma unroll
    for (int ks = 0; ks < 4; ++ks) {
      int n = 32 * w + nt * 16 + col;
      qf[nt][ks] = *(const bf16x8*)(zc + (size_t)n * ZS + C_RQ + h * 128 + ks * 32 + quad * 8);
    }
  f32x4 acc[8][2];
#pragma unroll
  for (int et = 0; et < 8; ++et)
#pragma unroll
    for (int nt = 0; nt < 2; ++nt) acc[et][nt] = f32x4{0.f, 0.f, 0.f, 0.f};
  __syncthreads();
  load128(tid, lds, zc + C_RV + h * 128, ZS);
  __syncthreads();
#pragma unroll
  for (int ks = 0; ks < 4; ++ks)
#pragma unroll
    for (int et = 0; et < 8; ++et) {
      int row = et * 16 + col;
      bf16x8 af = *(const bf16x8*)(lds + row * 128 + (((ks * 4 + quad) ^ (row & 15)) << 3));
#pragma unroll
      for (int nt = 0; nt < 2; ++nt) acc[et][nt] = mfma16(af, qf[nt][ks], acc[et][nt]);
    }
#pragma unroll
  for (int nt = 0; nt < 2; ++nt) {
    int n = 32 * w + nt * 16 + col;
    float xi = exp2f(lg2 * (float)(n + 1));
#pragma unroll
    for (int et = 0; et < 8; ++et) acc[et][nt] *= xi;
  }
  __syncthreads();
  load128(tid, lds, zc + C_RK + h * 128, ZS);
  __syncthreads();
  bf16x8 pf[2][4];
#pragma unroll
  for (int nt = 0; nt < 2; ++nt) {
    f32x4 s[8];
#pragma unroll
    for (int mt = 0; mt < 8; ++mt) s[mt] = f32x4{0.f, 0.f, 0.f, 0.f};
#pragma unroll
    for (int ks = 0; ks < 4; ++ks)
#pragma unroll
      for (int mt = 0; mt < 8; ++mt) {
        if (mt <= 2 * w + 1) {
          int row = mt * 16 + col;
          bf16x8 af = *(const bf16x8*)(lds + row * 128 + (((ks * 4 + quad) ^ (row & 15)) << 3));
          s[mt] = mfma16(af, qf[nt][ks], s[mt]);
        }
      }
    const int n = 32 * w + nt * 16 + col;
#pragma unroll
    for (int c2 = 0; c2 < 4; ++c2) {
      float v[8];
#pragma unroll
      for (int i = 0; i < 8; ++i) {
        const int mt = 2 * c2 + (i >> 2), j = i & 3;
        const int m = mt * 16 + quad * 4 + j;
        v[i] = (n >= m) ? s[mt][j] * exp2f(lg2 * (float)(n - m)) : 0.f;
      }
      pf[nt][c2] = mk8(pack2(v[0], v[1]), pack2(v[2], v[3]), pack2(v[4], v[5]), pack2(v[6], v[7]));
    }
  }
  __syncthreads();
  load128(tid, lds, rvT + ((size_t)((b * 4 + h) * 128)) * TS + c * 128, TS);
  __syncthreads();
#pragma unroll
  for (int c2 = 0; c2 < 4; ++c2) {
    if (2 * c2 <= 2 * w + 1) {
#pragma unroll
      for (int et = 0; et < 8; ++et) {
        int row = et * 16 + col;
        int sw = row & 15;
        uint2 a = *(const uint2*)(lds + row * 128 + (((4 * c2 + (quad >> 1)) ^ sw) << 3) + (quad & 1) * 4);
        uint2 bb = *(const uint2*)(lds + row * 128 + (((4 * c2 + 2 + (quad >> 1)) ^ sw) << 3) + (quad & 1) * 4);
        bf16x8 vf = mk8(a.x, a.y, bb.x, bb.y);
#pragma unroll
        for (int nt = 0; nt < 2; ++nt) acc[et][nt] = mfma16(vf, pf[nt][c2], acc[et][nt]);
      }
    }
  }
#pragma unroll
  for (int nt = 0; nt < 2; ++nt) {
    float ss = 0.f;
#pragma unroll
    for (int et = 0; et < 8; ++et)
#pragma unroll
      for (int j = 0; j < 4; ++j) ss += acc[et][nt][j] * acc[et][nt][j];
    ss += shx(ss, 16, lane);
    ss += shx(ss, 32, lane);
    const float rs = rsqrtf(ss * (1.f / 128.f) + 1e-6f);
    const int n = 32 * w + nt * 16 + col;
    bf16_t* zr = zc + (size_t)n * ZS;
#pragma unroll
    for (int et = 0; et < 8; ++et) {
      const int e0 = et * 16 + quad * 4;
      uint2 gv = *(const uint2*)(zr + C_RG + h * 128 + e0);
      float g0 = bflo(gv.x), g1 = bfhi(gv.x), g2 = bflo(gv.y), g3 = bfhi(gv.y);
      uint2 o;
      o.x = pack2(acc[et][nt][0] * rs * g0 * sigmoidf(g0), acc[et][nt][1] * rs * g1 * sigmoidf(g1));
      o.y = pack2(acc[et][nt][2] * rs * g2 * sigmoidf(g2), acc[et][nt][3] * rs * g3 * sigmoidf(g3));
      *(uint2*)(zr + C_RQ + h * 128 + e0) = o;
    }
  }
}

#define GEMM_TILE_LOOP(NT)                                                             \
  for (int qp_ = (int)(blockIdx.x >> 3), per_ = (int)(gridDim.x >> 3), xcd_ = (int)(blockIdx.x & 7), q_ = 0, mt = 0, ntile = 0; \
       2 * qp_ < 32 * (NT) && ((q_ = 2 * qp_ + HALF()), (mt = (((xcd_ + 8 * (q_ / (8 * (NT)))) << 3) + ((q_ % (8 * (NT))) & 7)), ntile = ((q_ % (8 * (NT))) >> 3)), true); \
       qp_ += per_)


DI int TID8() { int t = threadIdx.x; asm volatile("" : "+v"(t)); return t; }
DI void g8_load(u32x4 (&ra)[4], u32x4 (&rb)[4], const bf16_t* a, size_t lda, const bf16_t* b, size_t ldb, int kb, int lrow, int lch) {
#pragma unroll
  for (int i = 0; i < 4; ++i) {
    ra[i] = *(const u32x4*)(a + (size_t)(lrow + 64 * i) * lda + kb * 64 + lch * 8);
    rb[i] = *(const u32x4*)(b + (size_t)(lrow + 64 * i) * ldb + kb * 64 + lch * 8);
  }
}
DI void g8_store(bf16_t* S, const u32x4 (&ra)[4], const u32x4 (&rb)[4], int lrow, int lch) {
#pragma unroll
  for (int i = 0; i < 4; ++i) {
    const int r = lrow + 64 * i;
    const int off = r * 64 + ((lch ^ ((r >> 1) & 7)) << 3);
    *(u32x4*)(S + off) = ra[i];
    *(u32x4*)(S + 16384 + off) = rb[i];
  }
}
DI void g8_load1(u32x4 (&r4)[4], const bf16_t* a, size_t lda, int kb, int lrow, int lch) {
#pragma unroll
  for (int i = 0; i < 4; ++i) r4[i] = *(const u32x4*)(a + (size_t)(lrow + 64 * i) * lda + kb * 64 + lch * 8);
}
DI void g8_store1(bf16_t* S, const u32x4 (&r4)[4], int lrow, int lch) {
#pragma unroll
  for (int i = 0; i < 4; ++i) {
    const int r = lrow + 64 * i;
    *(u32x4*)(S + r * 64 + ((lch ^ ((r >> 1) & 7)) << 3)) = r4[i];
  }
}
template <int KS0 = 0, int KS1 = 2>
DI void g8_compute(f32x4 (&acc)[8][4], const bf16_t* S, int wm, int wn, int lane) {
#pragma unroll
  for (int ks = KS0; ks < KS1; ++ks) {
    bf16x8 af[8], bfr[4];
#pragma unroll
    for (int i = 0; i < 8; ++i) {
      const int r = wm * 128 + i * 16 + (lane & 15);
      af[i] = *(const bf16x8*)(S + r * 64 + (((ks * 4 + (lane >> 4)) ^ ((r >> 1) & 7)) << 3));
    }
#pragma unroll
    for (int j = 0; j < 4; ++j) {
      const int r = wn * 64 + j * 16 + (lane & 15);
      bfr[j] = *(const bf16x8*)(S + 16384 + r * 64 + (((ks * 4 + (lane >> 4)) ^ ((r >> 1) & 7)) << 3));
    }
    __builtin_amdgcn_s_setprio(1);
#pragma unroll
    for (int i = 0; i < 8; ++i)
#pragma unroll
      for (int j = 0; j < 4; ++j) acc[i][j] = mfma16(bfr[j], af[i], acc[i][j]);
    __builtin_amdgcn_s_setprio(0);
  }
}
DI void gemm8_accum(f32x4 (&acc)[8][4], const bf16_t* a, size_t lda, const bf16_t* b, size_t ldb, int nkb, bf16_t* L) {
  const int tid = TID8(), lane = tid & 63, w = tid >> 6;
  const int wm = w >> 2, wn = w & 3;
  const int lrow = tid >> 3, lch = tid & 7;
  u32x4 ra[4], rb[4];
  g8_load(ra, rb, a, lda, b, ldb, 0, lrow, lch);
  __syncthreads();
  g8_store(L, ra, rb, lrow, lch);
  g8_load(ra, rb, a, lda, b, ldb, 1, lrow, lch);
  for (int kb = 0; kb + 1 < nkb; ++kb) {
    __syncthreads();
    const int k2 = (kb + 2 < nkb) ? kb + 2 : kb + 1;
    g8_store1(L + ((kb + 1) & 1) * 32768, ra, lrow, lch);
    g8_load1(ra, a, lda, k2, lrow, lch);
    __builtin_amdgcn_sched_barrier(0);
    g8_compute<0, 1>(acc, L + (kb & 1) * 32768, wm, wn, lane);
    __builtin_amdgcn_sched_barrier(0);
    g8_store1(L + ((kb + 1) & 1) * 32768 + 16384, rb, lrow, lch);
    g8_load1(rb, b, ldb, k2, lrow, lch);
    __builtin_amdgcn_sched_barrier(0);
    g8_compute<1, 2>(acc, L + (kb & 1) * 32768, wm, wn, lane);
  }
  __syncthreads();
  g8_compute(acc, L + ((nkb - 1) & 1) * 32768, wm, wn, lane);
  __syncthreads();
}
DI void zero_acc8(f32x4 (&acc)[8][4]) {
#pragma unroll
  for (int i = 0; i < 8; ++i)
#pragma unroll
    for (int j = 0; j < 4; ++j) acc[i][j] = f32x4{0.f, 0.f, 0.f, 0.f};
}
template <class F>
DI void gemm8_epi_staged(f32x4 (&acc)[8][4], int m0, int n0, bf16_t* L, F f, bf16_t* dst, size_t ld, int nmax) {
  const int tid = TID8(), lane = tid & 63, w = tid >> 6;
  const int wm = w >> 2, wn = w & 3;
#pragma unroll
  for (int half = 0; half < 2; ++half) {
    if (wm == half) {
#pragma unroll
      for (int i = 0; i < 8; ++i)
#pragma unroll
        for (int j = 0; j < 4; ++j) {
          const int ml = i * 16 + (lane & 15);
          const int nl = wn * 64 + j * 16 + (lane >> 4) * 4;
          f32x4 a = acc[i][j];
          f(m0 + half * 128 + ml, n0 + nl, a);
          uint2 u;
          u.x = pack2(a[0], a[1]);
          u.y = pack2(a[2], a[3]);
          *(uint2*)(L + ml * 264 + nl) = u;
        }
    }
    __syncthreads();
#pragma unroll
    for (int it = 0; it < 8; ++it) {
      const int idx = tid + 512 * it;
      const int row = idx >> 5, ch = idx & 31;
      const u32x4 v = *(const u32x4*)(L + row * 264 + ch * 8);
      const int n = n0 + ch * 8;
      if (n < nmax) *(u32x4*)(dst + (size_t)(m0 + half * 128 + row) * ld + n) = v;
    }
    __syncthreads();
  }
}
DI void gemm8_epi_resid(f32x4 (&acc)[8][4], int m0, int n0, int ntile8, bf16_t* L, const float* xin, float* out, bf16_t* xb, float* rowpart) {
  const int tid = TID8(), lane = tid & 63, w = tid >> 6;
  const int wm = w >> 2, wn = w & 3;
  float* red = (float*)L;
#pragma unroll
  for (int i = 0; i < 8; ++i) {
    const int ml = wm * 128 + i * 16 + (lane & 15);
    const size_t rowoff = (size_t)(m0 + ml) * DM;
    float ss = 0.f;
#pragma unroll
    for (int j = 0; j < 4; ++j) {
      const int n = n0 + wn * 64 + j * 16 + (lane >> 4) * 4;
      const float4 xv = *(const float4*)(xin + rowoff + n);
      const float o0 = xv.x + acc[i][j][0], o1 = xv.y + acc[i][j][1], o2 = xv.z + acc[i][j][2], o3 = xv.w + acc[i][j][3];
      *(float4*)(out + rowoff + n) = make_float4(o0, o1, o2, o3);
      ss += o0 * o0 + o1 * o1 + o2 * o2 + o3 * o3;
      uint2 u;
      u.x = pack2(o0, o1);
      u.y = pack2(o2, o3);
      *(uint2*)(xb + rowoff + n) = u;
    }
    ss += shx(ss, 16, lane);
    ss += shx(ss, 32, lane);
    if ((lane >> 4) == 0) red[wn * 256 + ml] = ss;
  }
  __syncthreads();
  {
    const int row = tid & 255, h = tid >> 8;
    rowpart[(size_t)(ntile8 * 2 + h) * T_TOK + m0 + row] = red[(2 * h) * 256 + row] + red[(2 * h + 1) * 256 + row];
  }
}
template <class E>
DI void gemm8_epi(f32x4 (&acc)[8][4], int m0, int n0, E e) {
  const int tid = TID8(), lane = tid & 63, w = tid >> 6;
  const int wm = w >> 2, wn = w & 3;
#pragma unroll
  for (int i = 0; i < 8; ++i)
#pragma unroll
    for (int j = 0; j < 4; ++j) {
      const int m = m0 + wm * 128 + i * 16 + (lane & 15);
      const int n = n0 + wn * 64 + j * 16 + (lane >> 4) * 4;
      e(m, n, acc[i][j]);
    }
}
DI void row_rs8(float (&rsv)[8], const float* rowpart, int m0) {
  const int tid = TID8(), lane = tid & 63, wm = tid >> 8;
#pragma unroll
  for (int i = 0; i < 8; ++i) {
    const int m = m0 + wm * 128 + i * 16 + (lane & 15);
    float s = 0.f;
#pragma unroll
    for (int t = 0; t < 8; ++t) s += rowpart[(size_t)t * T_TOK + m];
    rsv[i] = rsqrtf(s * (1.f / 1024.f) + 1e-6f);
  }
}
DI void scale_rows8(f32x4 (&acc)[8][4], const float (&rsv)[8]) {
#pragma unroll
  for (int i = 0; i < 8; ++i)
#pragma unroll
    for (int j = 0; j < 4; ++j) acc[i][j] *= rsv[i];
}
#define GEMM8_TILE_LOOP(NT8)                                                            \
  for (int q_ = (int)(blockIdx.x >> 3), per_ = (int)(gridDim.x >> 3), xcd_ = (int)(blockIdx.x & 7), mt = 0, ntile = 0; \
       q_ < 16 * (NT8) && ((mt = (((xcd_ + 8 * (q_ / (4 * (NT8)))) << 2) + ((q_ % (4 * (NT8))) & 3)), ntile = ((q_ % (4 * (NT8))) >> 2)), true); \
       q_ += per_)

#define XB_TMO      128
#define XB_XCNT(j)  (256  + 64 * (j))
#define XB_XSUB(j)  (1280 + 64 * (j))
#define XB_XGEN(j)  (2304 + 64 * (j))
#define XB_TOP      3328
#define XB_TOPGEN   3392
#define XB_SPIN_CAP (1u << 20)
DI unsigned xb_ld(unsigned* p) { return __hip_atomic_load(p, __ATOMIC_RELAXED, __HIP_MEMORY_SCOPE_AGENT); }
DI unsigned xb_add(unsigned* p, unsigned v) { return __hip_atomic_fetch_add(p, v, __ATOMIC_RELAXED, __HIP_MEMORY_SCOPE_AGENT); }
DI unsigned xb_xcc_id() { return (unsigned)__builtin_amdgcn_s_getreg((3 << 11) | 20) & 0xFu; }
#define XB_SPIN(cond, bar) do { unsigned _sp = 0; while (cond) { __builtin_amdgcn_s_sleep(1); \
    if ((++_sp & 255u) == 0u) { if (xb_ld(&(bar)[XB_TMO])) break; if (_sp > XB_SPIN_CAP) { atomicAdd(&(bar)[XB_TMO], 1u); break; } } } } while (0)

DI void xcd_barrier(unsigned* bar, const unsigned x, const unsigned nloc, const unsigned nx) {
  asm volatile("s_waitcnt vmcnt(0)" ::: "memory");
  __syncthreads();
  if (threadIdx.x == 0) {
    __builtin_amdgcn_s_waitcnt(0);
    const unsigned old = xb_add(&bar[XB_XSUB(x)], 1u);
    const unsigned gen = old / nloc;
    if (old + 1u == (gen + 1u) * nloc) {
      __builtin_amdgcn_fence(__ATOMIC_RELEASE, "agent");
      asm volatile("s_waitcnt vmcnt(0)" ::: "memory");
      const unsigned og = xb_add(&bar[XB_TOP], 1u);
      const unsigned tg = og / nx;
      if (og + 1u == (tg + 1u) * nx) xb_add(&bar[XB_TOPGEN], 1u);
      else XB_SPIN(xb_ld(&bar[XB_TOPGEN]) == tg, bar);
      __builtin_amdgcn_fence(__ATOMIC_ACQUIRE, "agent");
      xb_add(&bar[XB_XGEN(x)], 1u);
      asm volatile("s_waitcnt vmcnt(0)" ::: "memory");
    } else {
      XB_SPIN(xb_ld(&bar[XB_XGEN(x)]) == gen, bar);
      __builtin_amdgcn_fence(__ATOMIC_ACQUIRE, "agent");
      asm volatile("s_waitcnt vmcnt(0)" ::: "memory");
    }
  }
  __syncthreads();
}

__global__ void __launch_bounds__(512, 2) mega(Params p) {
  extern __shared__ __attribute__((aligned(16))) bf16_t lds_all[];
  bf16_t* lds = lds_all + HALF() * 32768;
  cg::grid_group grid = cg::this_grid();
  const int nb = NVB;
  bf16_t* wt = (bf16_t*)(p.ws + O_WT);
  bf16_t* z = (bf16_t*)(p.ws + O_Z);
  bf16_t* hbuf = (bf16_t*)(p.ws + O_VST);
  bf16_t* ubuf = z;
  bf16_t* p16 = (bf16_t*)(p.ws + O_KVD);
  float* rowpart = (float*)(p.ws + O_RP);
  bf16_t* hid = (bf16_t*)(p.ws + O_HID);
  const float* bias = (const float*)(p.ws + O_BIAS);

  unsigned* bar = (unsigned*)(p.ws + O_BAR);
  const unsigned xb_x = xb_xcc_id();
  if (threadIdx.x == 0) (void)xb_add(&bar[XB_XCNT(xb_x)], 1u);
  unsigned xb_nloc = 1u, xb_nx = 1u;

  for (int layer = 0; layer < 2; ++layer) {
    const bf16_t* wl = wt;
    const float* xin = (layer == 0) ? p.x : p.out;

    phase0(p, layer);
    norm_phase(xin, p.norm_mix + layer * DM, hbuf);
    if (layer == 0) {
      grid.sync();
      unsigned mine = 0u, cnt = 0u;
#pragma unroll
      for (unsigned j = 0; j < 16; ++j) {
        const unsigned c = xb_ld(&bar[XB_XCNT(j)]);
        cnt += (c > 0u) ? 1u : 0u;
        mine = (j == xb_x) ? c : mine;
      }
      xb_nloc = __builtin_amdgcn_readfirstlane(mine > 0u ? mine : 1u);
      xb_nx = __builtin_amdgcn_readfirstlane(cnt > 0u ? cnt : 1u);
    } else {
      xcd_barrier(bar, xb_x, xb_nloc, xb_nx);
    }

    GEMM8_TILE_LOOP(22) {
      const int m0 = mt * 256, n0 = ntile * 256;
      f32x4 acc8[8][4];
      zero_acc8(acc8);
      gemm8_accum(acc8, hbuf + (size_t)m0 * DM, DM, wl + W_IN + (size_t)n0 * 1024, 1024, 16, lds_all);
      gemm8_epi_staged(acc8, m0, n0, lds_all, [&](int, int, f32x4&) {}, z, ZS, ZS);
    }
    xcd_barrier(bar, xb_x, xb_nloc, xb_nx);

    post_z(p, layer);
    xcd_barrier(bar, xb_x, xb_nloc, xb_nx);

    for (int u_ = (int)blockIdx.x, t = 0; (u_ < 64 || u_ - 64 < 512) && ((t = (u_ < 64) ? 2 * u_ + HALF() : 128 + 2 * (u_ - 64) + HALF()), true); u_ = (u_ < 64) ? 1 << 20 : u_ + (int)gridDim.x - 64) {
      f32x4 acc[4][4];
      zero_acc(acc);
      if (t < 128) {
        const int kv = t >> 6, mt = (t >> 1) & 31, ntile = t & 1;
        const int m0 = mt * 128, n0 = ntile * 128;
        const bf16_t* kvd = (const bf16_t*)(p.ws + O_KVD) + (size_t)kv * 8 * SEQ * 64;
        auto ap = [&](int r, int kb) -> const bf16_t* {
          int row = m0 + r;
          int bg = row >> 9, c = row & 511;
          int tk = 16 * c + kb;
          tk = tk > (SEQ - 1) ? (SEQ - 1) : tk;
          return kvd + ((size_t)(bg * SEQ + tk)) * 64;
        };
        gemm_accum(acc, ap, RowPtr{wl + (kv ? W_C1V : W_C1K) + (size_t)n0 * 2048, 2048}, 32, lds);
        const float* bs = bias + kv * 256;
        bf16_t* hd = hid + (size_t)kv * 4096 * 256;
        gemm_epi(acc, m0, n0, [&](int m, int n, f32x4& a) {
          float o[4];
#pragma unroll
          for (int j = 0; j < 4; ++j) {
            float xv = a[j] + bs[n + j];
            float y = 0.7978845608028654f * (xv + 0.044715f * xv * xv * xv);
            float th = 1.f - 2.f / (__expf(2.f * y) + 1.f);
            o[j] = 0.5f * xv * (1.f + th);
          }
          uint2 u;
          u.x = pack2(o[0], o[1]);
          u.y = pack2(o[2], o[3]);
          *(uint2*)(hd + (size_t)m * 256 + n) = u;
        });
      } else {
        const int idx = t - 128;
        const int c = idx & 63, bh = idx >> 6;
        const bf16_t* rvT = (const bf16_t*)(p.ws + O_RVT) + ((size_t)bh * 128) * TS + c * 128;
        const bf16_t* kzT = (const bf16_t*)(p.ws + O_KZT) + ((size_t)bh * 128) * TS + c * 128;
        gemm_accum(acc, RowPtr{rvT, TS}, RowPtr{kzT, TS}, 2, lds);
        bf16_t* dst = z + ((size_t)((bh >> 2) * SEQ + c * 128)) * ZS + C_RV + (bh & 3) * 128;
        gemm_epi_staged(acc, 0, 0, lds, [&](int, int, f32x4&) {}, dst, ZS, 128);
      }
    }
    xcd_barrier(bar, xb_x, xb_nloc, xb_nx);

    phase4b(p, layer);
    {
      const float* pl = p.p + (size_t)layer * T_TOK * 256;
      const int gtid = VBID * 256 + TID();
      const int gthreads = nb * 256;
      for (int i = gtid; i < T_TOK * 32; i += gthreads) {
        float4 a = ((const float4*)pl)[2 * i], b2 = ((const float4*)pl)[2 * i + 1];
        ((uint4*)p16)[i] = make_uint4(pack2(a.x, a.y), pack2(a.z, a.w), pack2(b2.x, b2.y), pack2(b2.z, b2.w));
      }
    }
    xcd_barrier(bar, xb_x, xb_nloc, xb_nx);

    float nsa_c;
    {
      const int ln = TID() & 63;
      float gq = fabsf(p.nsa_q_norm[layer * 64 + ln]), gk = fabsf(p.nsa_k_norm[layer * 64 + ln]);
#pragma unroll
      for (int o = 32; o > 0; o >>= 1) {
        gq = fmaxf(gq, shx(gq, o, ln));
        gk = fmaxf(gk, shx(gk, o, ln));
      }
      nsa_c = 8.f * gq * gk;
    }
    const bool nsa_fx = nsa_c < 30.f;
    const float nsa_cl = nsa_c * 1.4426950408889634f;
    for (int t = VBID; t < 2048; t += nb) {
      if (t < 1024) {
        const int tile = (t < 512) ? 127 - (t >> 3) : ((t - 512) >> 3), bg = t & 7;
        if (nsa_fx) nsa_tile<true>(p, bg >> 1, bg & 1, tile, lds, nsa_cl);
        else nsa_tile<false>(p, bg >> 1, bg & 1, tile, lds, 0.f);
      } else {
        const int idx = t - 1024;
        ret_tile(p, idx >> 8, (idx >> 6) & 3, idx & 63, lds);
      }
    }
    xcd_barrier(bar, xb_x, xb_nloc, xb_nx);

    GEMM8_TILE_LOOP(4) {
      const int m0 = mt * 256, n0 = ntile * 256;
      f32x4 acc8[8][4];
      zero_acc8(acc8);
      gemm8_accum(acc8, (const bf16_t*)(p.ws + O_ONSA) + (size_t)m0 * 512, 512, wl + W_UPA + (size_t)n0 * 512, 512, 8, lds_all);
      gemm8_epi(acc8, m0, n0, [&](int m, int n, f32x4& a) {
        uint2 ua = *(const uint2*)(z + (size_t)m * ZS + C_MA + n);
        uint2 ub = *(const uint2*)(z + (size_t)m * ZS + C_MB + n);
        a[0] *= sigmoidf(bflo(ua.x)) / sigmoidf(bflo(ub.x));
        a[1] *= sigmoidf(bfhi(ua.x)) / sigmoidf(bfhi(ub.x));
        a[2] *= sigmoidf(bflo(ua.y)) / sigmoidf(bflo(ub.y));
        a[3] *= sigmoidf(bfhi(ua.y)) / sigmoidf(bfhi(ub.y));
      });
      gemm8_accum(acc8, z + (size_t)m0 * ZS + C_RQ, ZS, wl + W_UPR + (size_t)n0 * 512, 512, 8, lds_all);
      gemm8_epi_staged(acc8, m0, n0, lds_all, [&](int m, int n, f32x4& a) {
        uint2 ub = *(const uint2*)(z + (size_t)m * ZS + C_MB + n);
        a[0] *= sigmoidf(bflo(ub.x)); a[1] *= sigmoidf(bfhi(ub.x));
        a[2] *= sigmoidf(bflo(ub.y)); a[3] *= sigmoidf(bfhi(ub.y));
      }, z + C_RK, ZS, 1024);
    }
    xcd_barrier(bar, xb_x, xb_nloc, xb_nx);

    GEMM8_TILE_LOOP(4) {
      const int m0 = mt * 256, n0 = ntile * 256;
      f32x4 acc8[8][4];
      zero_acc8(acc8);
      gemm8_accum(acc8, z + (size_t)m0 * ZS + C_RK, ZS, wl + W_OUT + (size_t)n0 * 1024, 1024, 16, lds_all);
      gemm8_epi_resid(acc8, m0, n0, ntile, lds_all, xin, p.out, hbuf, rowpart);
    }
    xcd_barrier(bar, xb_x, xb_nloc, xb_nx);

    GEMM8_TILE_LOOP(16) {
      const int m0 = mt * 256, n0 = ntile * 256;
      f32x4 acc8[8][4];
      zero_acc8(acc8);
      float rsv[8];
      row_rs8(rsv, rowpart, m0);
      gemm8_accum(acc8, hbuf + (size_t)m0 * DM, DM, wl + W_FF1 + (size_t)n0 * 1024, 1024, 16, lds_all);
      scale_rows8(acc8, rsv);
      gemm8_epi_staged(acc8, m0, n0, lds_all, [&](int, int, f32x4& a) {
        float r0 = fmaxf(a[0], 0.f), r1 = fmaxf(a[1], 0.f), r2 = fmaxf(a[2], 0.f), r3 = fmaxf(a[3], 0.f);
        a[0] = r0 * r0; a[1] = r1 * r1; a[2] = r2 * r2; a[3] = r3 * r3;
      }, ubuf, 4096, 4096);
    }
    xcd_barrier(bar, xb_x, xb_nloc, xb_nx);

    GEMM8_TILE_LOOP(4) {
      const int m0 = mt * 256, n0 = ntile * 256;
      f32x4 acc8[8][4];
      zero_acc8(acc8);
      gemm8_accum(acc8, ubuf + (size_t)m0 * 4096, 4096, wl + W_FF2 + (size_t)n0 * 4096, 4096, 64, lds_all);
      gemm8_epi_resid(acc8, m0, n0, ntile, lds_all, p.out, p.out, hbuf, rowpart);
    }
    xcd_barrier(bar, xb_x, xb_nloc, xb_nx);

    GEMM8_TILE_LOOP(4) {
      const int m0 = mt * 256, n0 = ntile * 256;
      f32x4 acc8[8][4];
      zero_acc8(acc8);
      gemm8_accum(acc8, p16 + (size_t)m0 * 256, 256, wl + W_PLE + (size_t)n0 * 256, 256, 4, lds_all);
      bf16_t* ppb = z + (size_t)T_TOK * 256;
      gemm8_epi_staged(acc8, m0, n0, lds_all, [&](int, int, f32x4&) {}, ppb, DM, 1024);
      zero_acc8(acc8);
      float rsv[8];
      row_rs8(rsv, rowpart, m0);
      gemm8_accum(acc8, hbuf + (size_t)m0 * DM, DM, wl + W_PG + (size_t)n0 * 1024, 1024, 16, lds_all);
      scale_rows8(acc8, rsv);
      gemm8_epi(acc8, m0, n0, [&](int m, int n, f32x4& a) {
        uint2 pv = *(const uint2*)(ppb + (size_t)m * DM + n);
        float4* o = (float4*)(p.out + (size_t)m * DM + n);
        float4 xv = *o;
        *o = make_float4(xv.x + sigmoidf(a[0]) * bflo(pv.x), xv.y + sigmoidf(a[1]) * bfhi(pv.x),
                         xv.z + sigmoidf(a[2]) * bflo(pv.y), xv.w + sigmoidf(a[3]) * bfhi(pv.y));
      });
    }
    xcd_barrier(bar, xb_x, xb_nloc, xb_nx);
  }
}

extern "C" void kernel_launch(void* const* d_in, const int* in_sizes, int n_in,
                              void* d_out, int out_size, void* d_ws, size_t ws_size,
                              hipStream_t stream) {
  static int grid_blocks = 0;
  if (!grid_blocks) {
    int dev = 0, cus = 0, per_cu = 0;
    hipGetDevice(&dev);
    hipDeviceGetAttribute(&cus, hipDeviceAttributeMultiprocessorCount, dev);
    hipFuncSetAttribute((const void*)mega, hipFuncAttributeMaxDynamicSharedMemorySize, DYN_LDS);
    hipOccupancyMaxActiveBlocksPerMultiprocessor(&per_cu, mega, 512, DYN_LDS);
    if (per_cu > 1) per_cu = 1;
    if (per_cu < 1) per_cu = 1;
    grid_blocks = cus * per_cu;
  }
  if (ws_size < WS_NEED) {
    fprintf(stderr, "workspace too small: %zu < %llu\n", ws_size, (unsigned long long)WS_NEED);
    return;
  }
  Params p{};
  p.x = (const float*)d_in[0]; p.p = (const float*)d_in[1]; p.norm_mix = (const float*)d_in[2]; p.w_in = (const float*)d_in[3];
  p.nsa_q_norm = (const float*)d_in[4]; p.nsa_k_norm = (const float*)d_in[5]; p.cmp_pos_k = (const float*)d_in[6];
  p.cmp_pos_v = (const float*)d_in[7]; p.cmp_w1_k = (const float*)d_in[8]; p.cmp_w2_k = (const float*)d_in[9];
  p.cmp_w1_v = (const float*)d_in[10]; p.cmp_w2_v = (const float*)d_in[11]; p.w_up_nsa = (const float*)d_in[12];
  p.w_up_ret = (const float*)d_in[13]; p.w_out = (const float*)d_in[14]; p.norm_mlp = (const float*)d_in[15];
  p.w_ff1 = (const float*)d_in[16]; p.w_ff2 = (const float*)d_in[17]; p.norm_ple = (const float*)d_in[18];
  p.w_ple = (const float*)d_in[19]; p.w_ple_gate = (const float*)d_in[20];
  p.out = (float*)d_out; p.ws = (char*)d_ws;
  hipMemsetAsync((char*)d_ws + O_BAR, 0, BAR_BYTES, stream);
  void* args[] = {&p};
  hipError_t e = hipLaunchCooperativeKernel((void*)mega, dim3(grid_blocks), dim3(512), args, DYN_LDS, stream);
  if (e != hipSuccess) fprintf(stderr, "cooperative launch failed: %s (grid %d)\n", hipGetErrorString(e), grid_blocks);
}
```

```cpp
#include <hip/hip_runtime.h>
#include <hip/hip_cooperative_groups.h>
#include <cstdio>
#include <cstdint>
namespace cg = cooperative_groups;

typedef __attribute__((ext_vector_type(8))) short bf16x8;
typedef __attribute__((ext_vector_type(4))) float f32x4;
typedef unsigned short bf16_t;
typedef __attribute__((ext_vector_type(4))) unsigned u32x4;
#define DI __device__ __forceinline__

#define T_TOK 32768
#define SEQ 8192
#define DM 1024
#define ZS 5400
#define C_Q 0
#define C_KC 512
#define C_VC 640
#define C_KS 768
#define C_VS 896
#define C_KW 1024
#define C_VW 1152
#define C_GT 1280
#define C_RQ 1304
#define C_RK 1816
#define C_RV 2328
#define C_RG 2840
#define C_MA 3352
#define C_MB 4376
#define NPAD_IN 5504
#define TS 8256

#define W_IN 0
#define W_C1K 5636096
#define W_C1V 6160384
#define W_UPA 6684672
#define W_UPR 7208960
#define W_OUT 7733248
#define W_FF1 8781824
#define W_FF2 12976128
#define W_PLE 17170432
#define W_PG 17432576
#define W_LAYER 18481152

#define O_WT 0ull
#define O_ROPE 36962304ull
#define O_BIAS 41156608ull
#define O_HID 41160704ull
#define O_KCMP 45355008ull
#define O_VCMPT 45879296ull
#define O_VST 46403584ull
#define O_VWT 54857728ull
#define O_RVT 63311872ull
#define O_KZT 97128448ull
#define O_Z 130945024ull
#define O_ONSA 484839424ull
#define O_BAR 518393856ull
#define BAR_BYTES 13824
#define O_KVD 518407680ull
#define O_RP 535184896ull
#define WS_NEED 536233472ull
#define DYN_LDS 139264

struct Params {
  const float* x; const float* p; const float* norm_mix; const float* w_in;
  const float* nsa_q_norm; const float* nsa_k_norm; const float* cmp_pos_k; const float* cmp_pos_v;
  const float* cmp_w1_k; const float* cmp_w2_k; const float* cmp_w1_v; const float* cmp_w2_v;
  const float* w_up_nsa; const float* w_up_ret; const float* w_out; const float* norm_mlp;
  const float* w_ff1; const float* w_ff2; const float* norm_ple; const float* w_ple; const float* w_ple_gate;
  float* out; char* ws;
};

DI unsigned pack2(float a, float b) {
  typedef __attribute__((ext_vector_type(2))) __bf16 bf2;
  typedef __attribute__((ext_vector_type(2))) float f2;
  f2 v = {a, b};
  bf2 r = __builtin_convertvector(v, bf2);
  return __builtin_bit_cast(unsigned, r);
}
DI bf16_t f2bf(float a) { return (bf16_t)(pack2(a, 0.f) & 0xffffu); }
DI float bf2f(bf16_t h) { return __uint_as_float(((unsigned)h) << 16); }
DI float bflo(unsigned u) { return __uint_as_float(u << 16); }
DI float bfhi(unsigned u) { return __uint_as_float(u & 0xffff0000u); }
DI float shx(float v, int mask, int lane) {
  return __int_as_float(__builtin_amdgcn_ds_bpermute((lane ^ mask) << 2, __float_as_int(v)));
}
DI uint32_t shxu(uint32_t v, int mask, int lane) {
  return (uint32_t)__builtin_amdgcn_ds_bpermute((lane ^ mask) << 2, (int)v);
}
DI float shfrom(float v, int srclane) {
  return __int_as_float(__builtin_amdgcn_ds_bpermute(srclane << 2, __float_as_int(v)));
}
DI float wave_sum(float v, int lane) {
#pragma unroll
  for (int o = 32; o > 0; o >>= 1) v += shx(v, o, lane);
  return v;
}
DI int TID() { int t = threadIdx.x & 255; asm volatile("" : "+v"(t)); return t; }
DI int HALF() { return __builtin_amdgcn_readfirstlane((int)(threadIdx.x >> 8)); }
#define VBID ((int)(blockIdx.x * 2) + HALF())
#define NVB ((int)(gridDim.x * 2))
DI float sigmoidf(float x) { return 1.f / (1.f + __expf(-x)); }
DI f32x4 mfma16(bf16x8 a, bf16x8 b, f32x4 c) { return __builtin_amdgcn_mfma_f32_16x16x32_bf16(a, b, c, 0, 0, 0); }
DI bf16x8 mk8(unsigned a, unsigned b, unsigned c, unsigned d) {
  uint4 u = make_uint4(a, b, c, d);
  return __builtin_bit_cast(bf16x8, u);
}

template <class AP, class BP>
DI void g_load(u32x4 (&ra)[4], u32x4 (&rb)[4], const AP& ap, const BP& bp, int kb, int lrow, int lch) {
#pragma unroll
  for (int i = 0; i < 4; ++i) {
    ra[i] = *(const u32x4*)(ap(lrow + 32 * i, kb) + lch * 8);
    rb[i] = *(const u32x4*)(bp(lrow + 32 * i, kb) + lch * 8);
  }
}
DI void g_store(bf16_t* As, bf16_t* Bs, const u32x4 (&ra)[4], const u32x4 (&rb)[4], int buf, int lrow, int lch) {
#pragma unroll
  for (int i = 0; i < 4; ++i) {
    int r = lrow + 32 * i;
    int off = buf * 8192 + r * 64 + ((lch ^ ((r >> 1) & 7)) << 3);
    *(u32x4*)(As + off) = ra[i];
    *(u32x4*)(Bs + off) = rb[i];
  }
}
DI void g_compute(f32x4 (&acc)[4][4], const bf16_t* a, const bf16_t* b, int wm, int wn, int lane) {
  bf16x8 af[2][4], bfr[2][4];
#pragma unroll
  for (int ks = 0; ks < 2; ++ks)
#pragma unroll
    for (int i = 0; i < 4; ++i) {
      int r = wm * 64 + i * 16 + (lane & 15);
      af[ks][i] = *(const bf16x8*)(a + r * 64 + (((ks * 4 + (lane >> 4)) ^ ((r >> 1) & 7)) << 3));
      int r2 = wn * 64 + i * 16 + (lane & 15);
      bfr[ks][i] = *(const bf16x8*)(b + r2 * 64 + (((ks * 4 + (lane >> 4)) ^ ((r2 >> 1) & 7)) << 3));
    }
  __builtin_amdgcn_s_setprio(1);
#pragma unroll
  for (int ks = 0; ks < 2; ++ks)
#pragma unroll
    for (int i = 0; i < 4; ++i)
#pragma unroll
      for (int j = 0; j < 4; ++j) acc[i][j] = mfma16(bfr[ks][j], af[ks][i], acc[i][j]);
  __builtin_amdgcn_s_setprio(0);
}
template <class AP, class BP>
DI void gemm_accum(f32x4 (&acc)[4][4], AP ap, BP bp, int nkb, bf16_t* lds) {
  const int tid = TID(), lane = tid & 63, w = tid >> 6;
  const int wm = w >> 1, wn = w & 1;
  const int lrow = tid >> 3, lch = tid & 7;
  bf16_t* As = lds;
  bf16_t* Bs = lds + 16384;
  u32x4 ra0[4], rb0[4], ra1[4], rb1[4];
  __syncthreads();
  g_load(ra0, rb0, ap, bp, 0, lrow, lch);
  g_load(ra1, rb1, ap, bp, 1, lrow, lch);
  g_store(As, Bs, ra0, rb0, 0, lrow, lch);
  __syncthreads();
  for (int kb = 0; kb < nkb; kb += 2) {
    const int k2 = (kb + 2 < nkb) ? kb + 2 : nkb - 2;
    g_load(ra0, rb0, ap, bp, k2, lrow, lch);
    __builtin_amdgcn_sched_barrier(0);
    g_compute(acc, As, Bs, wm, wn, lane);
    g_store(As, Bs, ra1, rb1, 1, lrow, lch);
    __syncthreads();
    g_load(ra1, rb1, ap, bp, k2 + 1, lrow, lch);
    __builtin_amdgcn_sched_barrier(0);
    g_compute(acc, As + 8192, Bs + 8192, wm, wn, lane);
    g_store(As, Bs, ra0, rb0, 0, lrow, lch);
    __syncthreads();
  }
}
template <class E>
DI void gemm_epi(f32x4 (&acc)[4][4], int m0, int n0, E e) {
  const int tid_ = TID();
  const int lane = tid_ & 63, w = tid_ >> 6;
  const int wm = w >> 1, wn = w & 1;
#pragma unroll
  for (int i = 0; i < 4; ++i)
#pragma unroll
    for (int j = 0; j < 4; ++j) {
      int m = m0 + wm * 64 + i * 16 + (lane & 15);
      int n = n0 + wn * 64 + j * 16 + (lane >> 4) * 4;
      e(m, n, acc[i][j]);
    }
}
template <class F>
DI void gemm_epi_staged(f32x4 (&acc)[4][4], int m0, int n0, bf16_t* lds, F f, bf16_t* dst, size_t ld, int nmax) {
  const int tid_ = TID();
  const int lane = tid_ & 63, w = tid_ >> 6;
  const int wm = w >> 1, wn = w & 1;
#pragma unroll
  for (int i = 0; i < 4; ++i)
#pragma unroll
    for (int j = 0; j < 4; ++j) {
      const int ml = wm * 64 + i * 16 + (lane & 15);
      const int nl = wn * 64 + j * 16 + (lane >> 4) * 4;
      f32x4 a = acc[i][j];
      f(m0 + ml, n0 + nl, a);
      uint2 u;
      u.x = pack2(a[0], a[1]);
      u.y = pack2(a[2], a[3]);
      *(uint2*)(lds + ml * 136 + nl) = u;
    }
  __syncthreads();
#pragma unroll
  for (int it = 0; it < 8; ++it) {
    const int idx = tid_ + 256 * it;
    const int row = idx >> 4, ch = idx & 15;
    const u32x4 v = *(const u32x4*)(lds + row * 136 + ch * 8);
    const int n = n0 + ch * 8;
    if (n < nmax) *(u32x4*)(dst + (size_t)(m0 + row) * ld + n) = v;
  }
}
DI void gemm_epi_resid(f32x4 (&acc)[4][4], int m0, int n0, int ntile, bf16_t* lds, const float* xin, float* out, bf16_t* xb, float* rowpart) {
  const int tid_ = TID();
  const int lane = tid_ & 63, w = tid_ >> 6;
  const int wm = w >> 1, wn = w & 1;
  float* red = (float*)lds;
#pragma unroll
  for (int i = 0; i < 4; ++i) {
    const int ml = wm * 64 + i * 16 + (lane & 15);
    const size_t rowoff = (size_t)(m0 + ml) * DM;
    float ss = 0.f;
#pragma unroll
    for (int j = 0; j < 4; ++j) {
      const int n = n0 + wn * 64 + j * 16 + (lane >> 4) * 4;
      const float4 xv = *(const float4*)(xin + rowoff + n);
      const float o0 = xv.x + acc[i][j][0], o1 = xv.y + acc[i][j][1], o2 = xv.z + acc[i][j][2], o3 = xv.w + acc[i][j][3];
      *(float4*)(out + rowoff + n) = make_float4(o0, o1, o2, o3);
      ss += o0 * o0 + o1 * o1 + o2 * o2 + o3 * o3;
      uint2 u;
      u.x = pack2(o0, o1);
      u.y = pack2(o2, o3);
      *(uint2*)(xb + rowoff + n) = u;
    }
    ss += shx(ss, 16, lane);
    ss += shx(ss, 32, lane);
    if ((lane >> 4) == 0) red[wn * 128 + ml] = ss;
  }
  __syncthreads();
  if (tid_ < 128) rowpart[(size_t)ntile * T_TOK + m0 + tid_] = red[tid_] + red[128 + tid_];
}
DI void row_rs(float (&rsv)[4], const float* rowpart, int m0) {
  const int tid_ = TID();
  const int lane = tid_ & 63, wm = tid_ >> 7;
#pragma unroll
  for (int i = 0; i < 4; ++i) {
    const int m = m0 + wm * 64 + i * 16 + (lane & 15);
    float s = 0.f;
#pragma unroll
    for (int t = 0; t < 8; ++t) s += rowpart[(size_t)t * T_TOK + m];
    rsv[i] = rsqrtf(s * (1.f / 1024.f) + 1e-6f);
  }
}
DI void scale_rows(f32x4 (&acc)[4][4], const float (&rsv)[4]) {
#pragma unroll
  for (int i = 0; i < 4; ++i)
#pragma unroll
    for (int j = 0; j < 4; ++j) acc[i][j] *= rsv[i];
}
DI void zero_acc(f32x4 (&acc)[4][4]) {
#pragma unroll
  for (int i = 0; i < 4; ++i)
#pragma unroll
    for (int j = 0; j < 4; ++j) acc[i][j] = f32x4{0.f, 0.f, 0.f, 0.f};
}
struct RowPtr {
  const bf16_t* base; size_t ld;
  DI const bf16_t* operator()(int r, int kb) const { return base + (size_t)r * ld + kb * 64; }
};

DI void convert_wt(const float* W, bf16_t* Wt, int K, int N, int Npad, int gtid, int gthreads, const float* gk = nullptr) {
  const int k8n = K >> 3;
  const long total = (long)Npad * k8n;
  for (long idx = gtid; idx < total; idx += gthreads) {
    int n = (int)(idx % Npad);
    int k8 = (int)(idx / Npad);
    uint4 o = make_uint4(0, 0, 0, 0);
    if (n < N) {
      const float* s = W + (size_t)(k8 * 8) * N + n;
      float v0 = s[0], v1 = s[(size_t)N], v2 = s[(size_t)2 * N], v3 = s[(size_t)3 * N];
      float v4 = s[(size_t)4 * N], v5 = s[(size_t)5 * N], v6 = s[(size_t)6 * N], v7 = s[(size_t)7 * N];
      if (gk) {
        const float* gp = gk + k8 * 8;
        v0 *= gp[0]; v1 *= gp[1]; v2 *= gp[2]; v3 *= gp[3]; v4 *= gp[4]; v5 *= gp[5]; v6 *= gp[6]; v7 *= gp[7];
      }
      o = make_uint4(pack2(v0, v1), pack2(v2, v3), pack2(v4, v5), pack2(v6, v7));
    }
    *(uint4*)(Wt + (size_t)n * K + k8 * 8) = o;
  }
}

DI void phase0(const Params& p, const int L) {
  const int gtid = VBID * 256 + TID();
  const int gthreads = NVB * 256;
  bf16_t* wl = (bf16_t*)(p.ws + O_WT);
  convert_wt(p.w_in + (size_t)L * 1024 * 5400, wl + W_IN, 1024, 5400, NPAD_IN, gtid, gthreads);
  convert_wt(p.cmp_w1_k + (size_t)L * 2048 * 256, wl + W_C1K, 2048, 256, 256, gtid, gthreads);
  convert_wt(p.cmp_w1_v + (size_t)L * 2048 * 256, wl + W_C1V, 2048, 256, 256, gtid, gthreads);
  convert_wt(p.w_up_nsa + (size_t)L * 512 * 1024, wl + W_UPA, 512, 1024, 1024, gtid, gthreads);
  convert_wt(p.w_up_ret + (size_t)L * 512 * 1024, wl + W_UPR, 512, 1024, 1024, gtid, gthreads);
  convert_wt(p.w_out + (size_t)L * 1024 * 1024, wl + W_OUT, 1024, 1024, 1024, gtid, gthreads);
  convert_wt(p.w_ff1 + (size_t)L * 1024 * 4096, wl + W_FF1, 1024, 4096, 4096, gtid, gthreads, p.norm_mlp + L * DM);
  convert_wt(p.w_ff2 + (size_t)L * 4096 * 1024, wl + W_FF2, 4096, 1024, 1024, gtid, gthreads);
  convert_wt(p.w_ple + (size_t)L * 256 * 1024, wl + W_PLE, 256, 1024, 1024, gtid, gthreads);
  convert_wt(p.w_ple_gate + (size_t)L * 1024 * 1024, wl + W_PG, 1024, 1024, 1024, gtid, gthreads, p.norm_ple + L * DM);
  if (L == 0) {
    float2* rope = (float2*)(p.ws + O_ROPE);
    for (int idx = gtid; idx < SEQ * 64; idx += gthreads) {
      int pos = idx >> 6, j = idx & 63;
      float inv = exp2f(-(float)j * (13.287712379549449f / 64.f));
      float ang = (float)pos * inv;
      double rev = (double)ang * 0.15915494309189535;
      rev -= rint(rev);
      float fr = (float)rev;
      rope[idx] = make_float2(__builtin_amdgcn_cosf(fr), __builtin_amdgcn_sinf(fr));
    }
  }
  float* part = (float*)(p.ws + O_HID);
  {
    const int n = gtid & 255;
    for (int item = VBID; item < 128; item += NVB) {
      const int kv = item >> 6, kc = item & 63;
      const float* pos = (kv ? p.cmp_pos_v : p.cmp_pos_k) + L * 2048 + kc * 32;
      const float* w1 = (kv ? p.cmp_w1_v : p.cmp_w1_k) + (size_t)L * 2048 * 256 + (size_t)kc * 32 * 256;
      float a = 0.f;
#pragma unroll 8
      for (int k = 0; k < 32; ++k) a += pos[k] * w1[(size_t)k * 256 + n];
      part[item * 256 + n] = a;
    }
  }
}

DI void norm_phase(const float* xin, const float* g, bf16_t* h) {
  const int tid_ = TID();
  const int lane = tid_ & 63;
  const int gw = (VBID * 256 + tid_) >> 6;
  const int nw = NVB * 4;
  float4 gv[4];
#pragma unroll
  for (int i = 0; i < 4; ++i) gv[i] = ((const float4*)g)[i * 64 + lane];
  for (int row = gw; row < T_TOK; row += nw) {
    const float4* xr = (const float4*)(xin + (size_t)row * DM);
    float4 v[4];
    float ss = 0.f;
#pragma unroll
    for (int i = 0; i < 4; ++i) {
      v[i] = xr[i * 64 + lane];
      ss += v[i].x * v[i].x + v[i].y * v[i].y + v[i].z * v[i].z + v[i].w * v[i].w;
    }
    ss = wave_sum(ss, lane);
    float rs = rsqrtf(ss * (1.f / 1024.f) + 1e-6f);
    uint2* hr = (uint2*)(h + (size_t)row * DM);
#pragma unroll
    for (int i = 0; i < 4; ++i) {
      uint2 o;
      o.x = pack2(v[i].x * rs * gv[i].x, v[i].y * rs * gv[i].y);
      o.y = pack2(v[i].z * rs * gv[i].z, v[i].w * rs * gv[i].w);
      hr[i * 64 + lane] = o;
    }
  }
}

DI void post_z(const Params& p, int layer) {
  const int tid_ = TID();
  const int lane = tid_ & 63;
  const int gw = (VBID * 256 + tid_) >> 6;
  const int nw = NVB * 4;
  bf16_t* z = (bf16_t*)(p.ws + O_Z);
  bf16_t* vsT = (bf16_t*)(p.ws + O_VST);
  bf16_t* vwT = (bf16_t*)(p.ws + O_VWT);
  bf16_t* rvT = (bf16_t*)(p.ws + O_RVT);
  bf16_t* kzT = (bf16_t*)(p.ws + O_KZT);
  const float2* rope = (const float2*)(p.ws + O_ROPE);
  const float* qn = p.nsa_q_norm + layer * 64;
  const float* kn = p.nsa_k_norm + layer * 64;
  {
    const float* part = (const float*)(p.ws + O_HID);
    float* bias = (float*)(p.ws + O_BIAS);
    const int idx = VBID * 256 + tid_;
    if (idx < 512) {
      const int kv = idx >> 8, n = idx & 255;
      float a = 0.f;
      for (int kc = 0; kc < 64; ++kc) a += part[(kv * 64 + kc) * 256 + n];
      bias[idx] = a;
    }
  }
  for (int item = gw; item < 1024 * 36; item += nw) {
    const int tc = item / 36, slab = item - tc * 36;
    const int tok0 = tc * 32;
    const int b = tok0 >> 13, spos = tok0 & 8191;
    bf16_t* zr = z + (size_t)tok0 * ZS;
    if (slab >= 32) {
      const int s4 = slab - 32, kv = s4 >> 1, gi = s4 & 1;
      const int colbase = (kv ? C_VC : C_KC) + gi * 64;
      bf16_t* dst = (bf16_t*)(p.ws + O_KVD) + ((size_t)((kv * 8 + b * 2 + gi) * SEQ + spos)) * 64 + lane;
      bf16_t u[32];
#pragma unroll
      for (int i = 0; i < 32; ++i) u[i] = zr[(size_t)i * ZS + colbase + lane];
#pragma unroll
      for (int i = 0; i < 32; ++i) dst[i * 64] = u[i];
    } else if (slab < 12) {
      int colbase; const float* g; float sc;
      if (slab < 8) { colbase = C_Q + slab * 64; g = qn; sc = 0.125f; }
      else if (slab < 10) { colbase = C_KS + (slab - 8) * 64; g = kn; sc = 1.f; }
      else { colbase = C_KW + (slab - 10) * 64; g = kn; sc = 1.f; }
      const float gv = g[lane] * sc;
      float v[32];
#pragma unroll
      for (int i = 0; i < 32; ++i) v[i] = bf2f(zr[(size_t)i * ZS + colbase + lane]);
#pragma unroll
      for (int i = 0; i < 32; ++i) {
        float ss = wave_sum(v[i] * v[i], lane);
        float rs = rsqrtf(ss * (1.f / 64.f) + 1e-6f);
        zr[(size_t)i * ZS + colbase + lane] = f2bf(v[i] * rs * gv);
      }
    } else if (slab < 16 || slab >= 24) {
      int colbase; bf16_t* dst;
      if (slab < 16) {
        const int gi = slab & 1;
        const bool isw = slab >= 14;
        colbase = (isw ? C_VW : C_VS) + gi * 64;
        dst = (isw ? vwT : vsT) + ((size_t)((b * 2 + gi) * 64 + lane)) * TS + spos;
      } else {
        const int s8 = slab - 24;
        const int h = s8 >> 1, half = s8 & 1;
        colbase = C_RV + s8 * 64;
        dst = rvT + ((size_t)((b * 4 + h) * 128 + half * 64 + lane)) * TS + spos;
      }
      unsigned u[32];
#pragma unroll
      for (int i = 0; i < 32; ++i) u[i] = zr[(size_t)i * ZS + colbase + lane];
#pragma unroll
      for (int q4 = 0; q4 < 4; ++q4)
        *(uint4*)(dst + q4 * 8) = make_uint4(u[q4 * 8 + 0] | (u[q4 * 8 + 1] << 16), u[q4 * 8 + 2] | (u[q4 * 8 + 3] << 16),
                                             u[q4 * 8 + 4] | (u[q4 * 8 + 5] << 16), u[q4 * 8 + 6] | (u[q4 * 8 + 7] << 16));
    } else if (slab < 20) {
      const int h = slab - 16;
      const int colbase = C_RQ + h * 128;
      float x1[32], x2[32];
#pragma unroll
      for (int i = 0; i < 32; ++i) {
        const bf16_t* p1 = zr + (size_t)i * ZS + colbase + lane;
        x1[i] = bf2f(p1[0]);
        x2[i] = bf2f(p1[64]);
      }
#pragma unroll
      for (int i = 0; i < 32; ++i) {
        bf16_t* p1 = zr + (size_t)i * ZS + colbase + lane;
        float2 cs = rope[(spos + i) * 64 + lane];
        p1[0] = f2bf(x1[i] * cs.x - x2[i] * cs.y);
        p1[64] = f2bf(x1[i] * cs.y + x2[i] * cs.x);
      }
    } else {
      const int h = slab - 20;
      const int colbase = C_RK + h * 128;
      const float lg2 = log2f(1.f - exp2f(-5.f - (float)h));
      float x1[32], x2[32];
#pragma unroll
      for (int i = 0; i < 32; ++i) {
        const bf16_t* p1 = zr + (size_t)i * ZS + colbase + lane;
        x1[i] = bf2f(p1[0]);
        x2[i] = bf2f(p1[64]);
      }
      unsigned u1[32], u2[32];
#pragma unroll
      for (int i = 0; i < 32; ++i) {
        bf16_t* p1 = zr + (size_t)i * ZS + colbase + lane;
        float2 cs = rope[(spos + i) * 64 + lane];
        float o1 = (x1[i] * cs.x - x2[i] * cs.y) * 0.08838834764831845f;
        float o2 = (x1[i] * cs.y + x2[i] * cs.x) * 0.08838834764831845f;
        p1[0] = f2bf(o1);
        p1[64] = f2bf(o2);
        float zeta = exp2f(lg2 * (float)(127 - ((spos + i) & 127)));
        u1[i] = f2bf(o1 * zeta);
        u2[i] = f2bf(o2 * zeta);
      }
      bf16_t* d1 = kzT + ((size_t)((b * 4 + h) * 128 + lane)) * TS + spos;
#pragma unroll
      for (int q4 = 0; q4 < 4; ++q4) {
        *(uint4*)(d1 + q4 * 8) = make_uint4(u1[q4 * 8 + 0] | (u1[q4 * 8 + 1] << 16), u1[q4 * 8 + 2] | (u1[q4 * 8 + 3] << 16),
                                            u1[q4 * 8 + 4] | (u1[q4 * 8 + 5] << 16), u1[q4 * 8 + 6] | (u1[q4 * 8 + 7] << 16));
        *(uint4*)(d1 + (size_t)64 * TS + q4 * 8) = make_uint4(u2[q4 * 8 + 0] | (u2[q4 * 8 + 1] << 16), u2[q4 * 8 + 2] | (u2[q4 * 8 + 3] << 16),
                                                              u2[q4 * 8 + 4] | (u2[q4 * 8 + 5] << 16), u2[q4 * 8 + 6] | (u2[q4 * 8 + 7] << 16));
      }
    }
  }
}

DI void phase4b(const Params& p, int layer) {
  const int tid_ = TID();
  const int lane = tid_ & 63;
  const int gw = (VBID * 256 + tid_) >> 6;
  const int nw = NVB * 4;
  bf16_t* z = (bf16_t*)(p.ws + O_Z);
  const bf16_t* hid = (const bf16_t*)(p.ws + O_HID);
  bf16_t* kcmp = (bf16_t*)(p.ws + O_KCMP);
  bf16_t* vcmpT = (bf16_t*)(p.ws + O_VCMPT);
  const float* kn = p.nsa_k_norm + layer * 64;
  for (int item = gw; item < 8192; item += nw) {
    const int kv = item >> 12, row = item & 4095;
    const bf16_t* hrow = hid + ((size_t)kv * 4096 + row) * 256;
    const float* w2 = (kv ? p.cmp_w2_v : p.cmp_w2_k) + (size_t)layer * 256 * 64;
    float acc = 0.f;
    for (int k8 = 0; k8 < 32; ++k8) {
      uint4 hv = *(const uint4*)(hrow + k8 * 8);
      const float* wr = w2 + (size_t)(k8 * 8) * 64 + lane;
      acc += bflo(hv.x) * wr[0];
      acc += bfhi(hv.x) * wr[64];
      acc += bflo(hv.y) * wr[128];
      acc += bfhi(hv.y) * wr[192];
      acc += bflo(hv.z) * wr[256];
      acc += bfhi(hv.z) * wr[320];
      acc += bflo(hv.w) * wr[384];
      acc += bfhi(hv.w) * wr[448];
    }
    if (kv == 0) {
      float ss = wave_sum(acc * acc, lane);
      float rs = rsqrtf(ss * (1.f / 64.f) + 1e-6f);
      kcmp[(size_t)row * 64 + lane] = f2bf(acc * rs * kn[lane]);
    } else {
      const int bg = row >> 9, c = row & 511;
      vcmpT[((size_t)(bg * 64 + lane)) * 512 + c] = f2bf(acc);
    }
  }
  const int gtid = VBID * 256 + tid_;
  const int gthreads = NVB * 256;
  for (int idx = gtid; idx < 65536; idx += gthreads) {
    const int d4 = idx & 31, e = (idx >> 5) & 127, h = (idx >> 12) & 3, b = idx >> 14;
    const float lg2 = log2f(1.f - exp2f(-5.f - (float)h));
    const float gch = exp2f(lg2 * 128.f);
    float r0 = 0.f, r1 = 0.f, r2 = 0.f, r3 = 0.f;
    bf16_t* ptr = z + ((size_t)(b * SEQ + e)) * ZS + C_RV + h * 128 + d4 * 4;
    for (int c0 = 0; c0 < 64; c0 += 16) {
      typedef __attribute__((ext_vector_type(2))) unsigned u32x2;
      u32x2 v[16];
#pragma unroll
      for (int i = 0; i < 16; ++i) v[i] = *(const u32x2*)(ptr + (size_t)(c0 + i) * 128 * ZS);
#pragma unroll
      for (int i = 0; i < 16; ++i) {
        u32x2 o;
        o.x = pack2(r0, r1);
        o.y = pack2(r2, r3);
        *(u32x2*)(ptr + (size_t)(c0 + i) * 128 * ZS) = o;
        r0 = gch * r0 + bflo(v[i].x);
        r1 = gch * r1 + bfhi(v[i].x);
        r2 = gch * r2 + bflo(v[i].y);
        r3 = gch * r3 + bfhi(v[i].y);
      }
    }
  }
}


DI void tile64_gload(int tid, u32x4& r0, u32x4& r1, const bf16_t* base, size_t stride) {
  {
    int idx = tid;
    int row = idx >> 3, ch = idx & 7;
    r0 = *(const u32x4*)(base + (size_t)row * stride + ch * 8);
  }
  {
    int idx = tid + 256;
    int row = idx >> 3, ch = idx & 7;
    r1 = *(const u32x4*)(base + (size_t)row * stride + ch * 8);
  }
}
DI void tile64_sstore(int tid, bf16_t* dst, const u32x4& r0, const u32x4& r1) {
  {
    int idx = tid;
    int row = idx >> 3, ch = idx & 7;
    *(u32x4*)(dst + row * 64 + ((ch ^ ((row >> 1) & 7)) << 3)) = r0;
  }
  {
    int idx = tid + 256;
    int row = idx >> 3, ch = idx & 7;
    *(u32x4*)(dst + row * 64 + ((ch ^ ((row >> 1) & 7)) << 3)) = r1;
  }
}

struct AttnSt { f32x4 O[2][4]; f32x4 L[2]; float m[2]; float l[2]; };

template <int MODE, bool FX>
DI void attn_compute(const int lane, const bf16_t* Ks, const bf16_t* Vs, const bf16x8 (&qf)[2][2], AttnSt& st, const float (&invl)[2],
                     int lo, int hi, float (&impA)[4], float (&impE)[4], const float CL) {
  const int quad = lane >> 4, col = lane & 15;
  f32x4 S[4][2];
#pragma unroll
  for (int kt = 0; kt < 4; ++kt)
#pragma unroll
    for (int hh = 0; hh < 2; ++hh) S[kt][hh] = f32x4{0.f, 0.f, 0.f, 0.f};
#pragma unroll
  for (int ks = 0; ks < 2; ++ks) {
#pragma unroll
    for (int kt = 0; kt < 4; ++kt) {
      int row = kt * 16 + col;
      bf16x8 kf = *(const bf16x8*)(Ks + row * 64 + (((ks * 4 + quad) ^ ((row >> 1) & 7)) << 3));
#pragma unroll
      for (int hh = 0; hh < 2; ++hh) S[kt][hh] = mfma16(kf, qf[hh][ks], S[kt][hh]);
    }
  }
  bf16x8 pf[2][2];
  const bool full = (lo <= 0) && (hi >= 63);
  const bool none = (hi < 0) || (lo > 63) || (hi < lo);
  if (__all(full || none)) {
    constexpr float L2E = 1.4426950408889634f;
#pragma unroll
    for (int hh = 0; hh < 2; ++hh) {
      float mL;
      float il = 1.f;
      if (FX) {
        mL = full ? CL : 1e30f;
        if (MODE == 1) il = invl[hh];
      } else if (MODE != 1) {
        float mx = -1e30f;
#pragma unroll
        for (int kt = 0; kt < 4; ++kt)
#pragma unroll
          for (int j = 0; j < 4; ++j) mx = fmaxf(mx, S[kt][hh][j]);
        mx = full ? mx : -1e30f;
        mx = fmaxf(mx, shx(mx, 16, lane));
        mx = fmaxf(mx, shx(mx, 32, lane));
        const float m_new = fmaxf(st.m[hh], mx);
        const float alpha = __expf(st.m[hh] - m_new);
        st.m[hh] = m_new;
        st.l[hh] *= alpha;
        if (MODE == 2) {
#pragma unroll
          for (int dt = 0; dt < 4; ++dt) st.O[hh][dt] *= alpha;
        }
        mL = full ? m_new * L2E : 1e30f;
      } else {
        mL = full ? st.m[hh] * L2E : 1e30f;
        il = invl[hh];
      }
      float rs = 0.f;
#pragma unroll
      for (int kt = 0; kt < 4; ++kt) {
        float a = 0.f;
#pragma unroll
        for (int j = 0; j < 4; ++j) {
          float pv = __builtin_amdgcn_exp2f(fmaf(S[kt][hh][j], L2E, -mL));
          if (MODE == 1) pv *= il;
          S[kt][hh][j] = pv;
          a += pv;
        }
        rs += a;
        if (MODE == 1) {
          impA[kt] += a;
          impE[kt] += S[kt][hh][3];
        }
      }
      if (MODE != 1 && !(FX && MODE == 2)) st.l[hh] += rs;
      if (MODE != 0) {
#pragma unroll
        for (int c = 0; c < 2; ++c)
          pf[hh][c] = mk8(pack2(S[2 * c][hh][0], S[2 * c][hh][1]), pack2(S[2 * c][hh][2], S[2 * c][hh][3]),
                          pack2(S[2 * c + 1][hh][0], S[2 * c + 1][hh][1]), pack2(S[2 * c + 1][hh][2], S[2 * c + 1][hh][3]));
      }
    }
  } else {
#pragma unroll
  for (int hh = 0; hh < 2; ++hh) {
    if (FX) {
      constexpr float L2E = 1.4426950408889634f;
      const float il = (MODE == 1) ? invl[hh] : 1.f;
      float rs = 0.f;
#pragma unroll
      for (int kt = 0; kt < 4; ++kt) {
        float a = 0.f;
#pragma unroll
        for (int j = 0; j < 4; ++j) {
          const int kl = kt * 16 + quad * 4 + j;
          const bool v = (kl >= lo) && (kl <= hi);
          float pv = v ? __builtin_amdgcn_exp2f(fmaf(S[kt][hh][j], L2E, -CL)) : 0.f;
          if (MODE == 1) pv *= il;
          S[kt][hh][j] = pv;
          a += pv;
        }
        rs += a;
        if (MODE == 1) {
          impA[kt] += a;
          impE[kt] += S[kt][hh][3];
        }
      }
      if (MODE != 1 && !(FX && MODE == 2)) st.l[hh] += rs;
      if (MODE != 0) {
#pragma unroll
        for (int c = 0; c < 2; ++c)
          pf[hh][c] = mk8(pack2(S[2 * c][hh][0], S[2 * c][hh][1]), pack2(S[2 * c][hh][2], S[2 * c][hh][3]),
                          pack2(S[2 * c + 1][hh][0], S[2 * c + 1][hh][1]), pack2(S[2 * c + 1][hh][2], S[2 * c + 1][hh][3]));
      }
      continue;
    }
    float mx = -1e30f;
#pragma unroll
    for (int kt = 0; kt < 4; ++kt)
#pragma unroll
      for (int j = 0; j < 4; ++j) {
        int kl = kt * 16 + quad * 4 + j;
        bool v = (kl >= lo) && (kl <= hi);
        float sv = v ? S[kt][hh][j] : -1e30f;
        S[kt][hh][j] = sv;
        mx = fmaxf(mx, sv);
      }
    if (MODE != 1) {
      mx = fmaxf(mx, shx(mx, 16, lane));
      mx = fmaxf(mx, shx(mx, 32, lane));
      float m_new = fmaxf(st.m[hh], mx);
      float alpha = __expf(st.m[hh] - m_new);
      st.m[hh] = m_new;
      float rs = 0.f;
#pragma unroll
      for (int kt = 0; kt < 4; ++kt)
#pragma unroll
        for (int j = 0; j < 4; ++j) {
          float sv = S[kt][hh][j];
          float pv = (sv > -1e29f) ? __expf(sv - m_new) : 0.f;
          rs += pv;
          S[kt][hh][j] = pv;
        }
      st.l[hh] = st.l[hh] * alpha + rs;
      if (MODE == 2) {
#pragma unroll
        for (int dt = 0; dt < 4; ++dt) st.O[hh][dt] *= alpha;
      }
    } else {
      const float mh = st.m[hh], il = invl[hh];
#pragma unroll
      for (int kt = 0; kt < 4; ++kt) {
        float a = 0.f;
#pragma unroll
        for (int j = 0; j < 4; ++j) {
          float sv = S[kt][hh][j];
          float pv = (sv > -1e29f) ? __expf(sv - mh) * il : 0.f;
          S[kt][hh][j] = pv;
          a += pv;
        }
        impA[kt] += a;
        impE[kt] += S[kt][hh][3];
      }
    }
    if (MODE != 0) {
#pragma unroll
      for (int c = 0; c < 2; ++c)
        pf[hh][c] = mk8(pack2(S[2 * c][hh][0], S[2 * c][hh][1]), pack2(S[2 * c][hh][2], S[2 * c][hh][3]),
                        pack2(S[2 * c + 1][hh][0], S[2 * c + 1][hh][1]), pack2(S[2 * c + 1][hh][2], S[2 * c + 1][hh][3]));
    }
  }
  }
  if (MODE != 0) {
#pragma unroll
    for (int dt = 0; dt < 4; ++dt) {
      const int row = dt * 16 + col;
      const int sw = (row >> 1) & 7;
#pragma unroll
      for (int c = 0; c < 2; ++c) {
        uint2 a = *(const uint2*)(Vs + row * 64 + (((4 * c + (quad >> 1)) ^ sw) << 3) + (quad & 1) * 4);
        uint2 b = *(const uint2*)(Vs + row * 64 + (((4 * c + 2 + (quad >> 1)) ^ sw) << 3) + (quad & 1) * 4);
        bf16x8 vf = mk8(a.x, a.y, b.x, b.y);
#pragma unroll
        for (int hh = 0; hh < 2; ++hh) st.O[hh][dt] = mfma16(vf, pf[hh][c], st.O[hh][dt]);
      }
    }
    if (FX && MODE == 2) {
      const bf16x8 ones = mk8(0x3F803F80u, 0x3F803F80u, 0x3F803F80u, 0x3F803F80u);
#pragma unroll
      for (int c = 0; c < 2; ++c)
#pragma unroll
        for (int hh = 0; hh < 2; ++hh) st.L[hh] = mfma16(ones, pf[hh][c], st.L[hh]);
    }
  }
}

DI void st_reset(AttnSt& st) {
#pragma unroll
  for (int h = 0; h < 2; ++h) {
    st.m[h] = -1e30f;
    st.l[h] = 0.f;
    st.L[h] = f32x4{0.f, 0.f, 0.f, 0.f};
#pragma unroll
    for (int dt = 0; dt < 4; ++dt) st.O[h][dt] = f32x4{0.f, 0.f, 0.f, 0.f};
  }
}

template <bool FIRST>
DI void nsa_flush(const int quad, bf16_t* optr, const AttnSt& st, const float (&sc)[2]) {
#pragma unroll
  for (int h = 0; h < 2; ++h)
#pragma unroll
    for (int dt = 0; dt < 4; ++dt) {
      uint2* q = (uint2*)(optr + h * 64 + dt * 16 + quad * 4);
      f32x4 o = st.O[h][dt] * sc[h];
      if (!FIRST) {
        uint2 pv = *q;
        o[0] += bflo(pv.x); o[1] += bfhi(pv.x); o[2] += bflo(pv.y); o[3] += bfhi(pv.y);
      }
      uint2 u;
      u.x = pack2(o[0], o[1]);
      u.y = pack2(o[2], o[3]);
      *q = u;
    }
}

template <bool FX>
DI void nsa_tile(const Params& p, int b, int g, int tile, bf16_t* lds, const float CL) {
  const int tid = TID(), lane = tid & 63, w = tid >> 6, quad = lane >> 4, col = lane & 15;
  const int cur = tile;
  const int tok = tile * 64 + w * 16 + col;
  bf16_t* z = (bf16_t*)(p.ws + O_Z);
  const bf16_t* kcmp = (const bf16_t*)(p.ws + O_KCMP) + (size_t)(b * 2 + g) * 512 * 64;
  const bf16_t* vcmpT = (const bf16_t*)(p.ws + O_VCMPT) + (size_t)(b * 2 + g) * 64 * 512;
  const bf16_t* vsT = (const bf16_t*)(p.ws + O_VST) + (size_t)(b * 2 + g) * 64 * TS;
  const bf16_t* vwT = (const bf16_t*)(p.ws + O_VWT) + (size_t)(b * 2 + g) * 64 * TS;
  const bf16_t* zb = z + (size_t)b * SEQ * ZS;
  const bf16_t* ztok = z + ((size_t)(b * SEQ + tok)) * ZS;
  bf16_t* otok = (bf16_t*)(p.ws + O_ONSA) + ((size_t)(b * SEQ + tok)) * 512 + g * 256;
  bf16_t* Ks = lds;
  bf16_t* Vs = lds + 4096;
  float* impl = (float*)(lds + 8192);

  AttnSt st;
  float invl[2] = {0.f, 0.f};
  float dA[4] = {0.f, 0.f, 0.f, 0.f}, dE[4] = {0.f, 0.f, 0.f, 0.f};
  u32x4 rk0, rk1, rv0, rv1;
  bf16x8 qf[2][2];

  const int ncs = (cur < 16) ? 1 : (cur >> 4) + 1;
  const int chi = (tok >= 31) ? ((tok - 31) >> 4) : -1;

  for (int hp = 0; hp < 2; ++hp) {
#pragma unroll
    for (int hh = 0; hh < 2; ++hh)
#pragma unroll
      for (int ks = 0; ks < 2; ++ks) qf[hh][ks] = *(const bf16x8*)(ztok + C_Q + g * 256 + (hp * 2 + hh) * 64 + ks * 32 + quad * 8);
    st_reset(st);
    tile64_gload(tid, rk0, rk1, kcmp, 64);
    for (int s = 0; s < ncs; ++s) {
      __syncthreads();
      tile64_sstore(tid, Ks, rk0, rk1);
      __syncthreads();
      if (s + 1 < ncs) tile64_gload(tid, rk0, rk1, kcmp + (size_t)(s + 1) * 4096, 64);
      attn_compute<0, FX>(lane, Ks, Vs, qf, st, invl, 0, chi - s * 64, dA, dE, CL);
    }
#pragma unroll
    for (int h = 0; h < 2; ++h) {
      float l = st.l[h];
      l += shx(l, 16, lane);
      l += shx(l, 32, lane);
      invl[h] = (l > 0.f) ? 1.f / l : 0.f;
    }
    {
      float carry = 0.f;
      tile64_gload(tid, rk0, rk1, kcmp, 64);
      tile64_gload(tid, rv0, rv1, vcmpT, 512);
      for (int s = 0; s < ncs; ++s) {
        float iA[4] = {0.f, 0.f, 0.f, 0.f}, iE[4] = {0.f, 0.f, 0.f, 0.f};
        __syncthreads();
        tile64_sstore(tid, Ks, rk0, rk1);
        tile64_sstore(tid, Vs, rv0, rv1);
        __syncthreads();
        if (s + 1 < ncs) {
          tile64_gload(tid, rk0, rk1, kcmp + (size_t)(s + 1) * 4096, 64);
          tile64_gload(tid, rv0, rv1, vcmpT + (s + 1) * 64, 512);
        }
        attn_compute<1, FX>(lane, Ks, Vs, qf, st, invl, 0, chi - s * 64, iA, iE, CL);
#pragma unroll
        for (int kt = 0; kt < 4; ++kt) {
          float recv = shfrom(iE[kt], (lane + 48) & 63);
          float val = iA[kt] + ((quad == 0) ? carry : recv);
          carry = recv;
          float* slot = impl + (s * 4 + kt) * 256 + tid;
          if (hp == 0) *slot = val; else *slot += val;
        }
      }
    }
    {
      float sc[2];
#pragma unroll
      for (int h = 0; h < 2; ++h) sc[h] = sigmoidf(bf2f(ztok[C_GT + 0 * 8 + g * 4 + hp * 2 + h]));
      nsa_flush<true>(quad, otok + hp * 128, st, sc);
    }
  }

  uint32_t sw0, sw1, sw2, sw3;
  {
    uint32_t key[32];
#pragma unroll
    for (int i = 0; i < 32; ++i) {
      int j = i * 4 + quad;
      float sc = (i < ncs * 4) ? impl[i * 256 + tid] : 0.f;
      if (j == 0 || j == cur || j == cur - 1) sc = 1e4f;
      uint32_t k = (__float_as_uint(sc) & ~127u) | (uint32_t)(127 - j);
      key[i] = (j > cur) ? 0u : k;
    }
    uint32_t prev = 0xFFFFFFFFu;
    for (int r = 0; r < 16; ++r) {
      uint32_t mx = 0u;
#pragma unroll
      for (int i = 0; i < 32; ++i) {
        uint32_t k = key[i];
        k = (k < prev) ? k : 0u;
        mx = (k > mx) ? k : mx;
      }
      uint32_t o = shxu(mx, 16, lane);
      mx = (o > mx) ? o : mx;
      o = shxu(mx, 32, lane);
      mx = (o > mx) ? o : mx;
      prev = mx;
    }
    sw0 = 0u; sw1 = 0u; sw2 = 0u; sw3 = 0u;
#pragma unroll
    for (int i = 0; i < 32; ++i) {
      bool sel = (key[i] != 0u) && (key[i] >= prev);
      uint32_t bit = sel ? (1u << ((i & 7) * 4 + quad)) : 0u;
      if ((i >> 3) == 0) sw0 |= bit;
      else if ((i >> 3) == 1) sw1 |= bit;
      else if ((i >> 3) == 2) sw2 |= bit;
      else sw3 |= bit;
    }
    sw0 |= shxu(sw0, 16, lane); sw0 |= shxu(sw0, 32, lane);
    sw1 |= shxu(sw1, 16, lane); sw1 |= shxu(sw1, 32, lane);
    sw2 |= shxu(sw2, 16, lane); sw2 |= shxu(sw2, 32, lane);
    sw3 |= shxu(sw3, 16, lane); sw3 |= shxu(sw3, 32, lane);
  }

  for (int hp = 0; hp < 2; ++hp) {
#pragma unroll
    for (int hh = 0; hh < 2; ++hh)
#pragma unroll
      for (int ks = 0; ks < 2; ++ks) qf[hh][ks] = *(const bf16x8*)(ztok + C_Q + g * 256 + (hp * 2 + hh) * 64 + ks * 32 + quad * 8);
    st_reset(st);
    {
      const bf16_t* kb = zb + C_KS + g * 64;
      tile64_gload(tid, rk0, rk1, kb, ZS);
      tile64_gload(tid, rv0, rv1, vsT, TS);
      for (int s = 0; s <= cur; ++s) {
        __syncthreads();
        tile64_sstore(tid, Ks, rk0, rk1);
        tile64_sstore(tid, Vs, rv0, rv1);
        __syncthreads();
        if (s < cur) {
          tile64_gload(tid, rk0, rk1, kb + (size_t)(s + 1) * 64 * ZS, ZS);
          tile64_gload(tid, rv0, rv1, vsT + (s + 1) * 64, TS);
        }
        uint32_t wsel = (s < 32) ? sw0 : (s < 64) ? sw1 : (s < 96) ? sw2 : sw3;
        bool sel = (wsel >> (s & 31)) & 1u;
        int hi = sel ? (tok - s * 64) : -1;
        if (__any(hi >= 0)) attn_compute<2, FX>(lane, Ks, Vs, qf, st, invl, 0, hi, dA, dE, CL);
      }
    }
    {
      float sc[2];
#pragma unroll
      for (int h = 0; h < 2; ++h) {
        float l;
        if (FX) {
          l = st.L[h][0];
        } else {
          l = st.l[h];
          l += shx(l, 16, lane);
          l += shx(l, 32, lane);
        }
        sc[h] = (l > 0.f) ? sigmoidf(bf2f(ztok[C_GT + 1 * 8 + g * 4 + hp * 2 + h])) / l : 0.f;
      }
      nsa_flush<false>(quad, otok + hp * 128, st, sc);
    }
    st_reset(st);
    {
      const bf16_t* kb = zb + C_KW + g * 64;
      const int s0 = (cur >= 8) ? cur - 8 : 0;
      tile64_gload(tid, rk0, rk1, kb + (size_t)s0 * 64 * ZS, ZS);
      tile64_gload(tid, rv0, rv1, vwT + s0 * 64, TS);
      for (int s = s0; s <= cur; ++s) {
        __syncthreads();
        tile64_sstore(tid, Ks, rk0, rk1);
        tile64_sstore(tid, Vs, rv0, rv1);
        __syncthreads();
        if (s < cur) {
          tile64_gload(tid, rk0, rk1, kb + (size_t)(s + 1) * 64 * ZS, ZS);
          tile64_gload(tid, rv0, rv1, vwT + (s + 1) * 64, TS);
        }
        attn_compute<2, FX>(lane, Ks, Vs, qf, st, invl, tok - 511 - s * 64, tok - s * 64, dA, dE, CL);
      }
    }
    {
      float sc[2];
#pragma unroll
      for (int h = 0; h < 2; ++h) {
        float l;
        if (FX) {
          l = st.L[h][0];
        } else {
          l = st.l[h];
          l += shx(l, 16, lane);
          l += shx(l, 32, lane);
        }
        sc[h] = (l > 0.f) ? sigmoidf(bf2f(ztok[C_GT + 2 * 8 + g * 4 + hp * 2 + h])) / l : 0.f;
      }
      nsa_flush<false>(quad, otok + hp * 128, st, sc);
    }
  }
}

DI void load128(int tid, bf16_t* lds, const bf16_t* base, size_t stride) {
  u32x4 r[8];
#pragma unroll
  for (int i = 0; i < 8; ++i) {
    int idx = tid + 256 * i;
    int row = idx >> 4, ch = idx & 15;
    r[i] = *(const u32x4*)(base + (size_t)row * stride + ch * 8);
  }
#pragma unroll
  for (int i = 0; i < 8; ++i) {
    int idx = tid + 256 * i;
    int row = idx >> 4, ch = idx & 15;
    *(u32x4*)(lds + row * 128 + ((ch ^ (row & 15)) << 3)) = r[i];
  }
}

DI void ret_tile(const Params& p, int b, int h, int c, bf16_t* lds) {
  const int tid = TID(), lane = tid & 63, w = tid >> 6, quad = lane >> 4, col = lane & 15;
  const float lg2 = log2f(1.f - exp2f(-5.f - (float)h));
  bf16_t* z = (bf16_t*)(p.ws + O_Z);
  const bf16_t* rvT = (const bf16_t*)(p.ws + O_RVT);
  bf16_t* zc = z + ((size_t)(b * SEQ + c * 128)) * ZS;
  bf16x8 qf[2][4];
#pragma unroll
  for (int nt = 0; nt < 2; ++nt)
#pragma unroll
    for (int ks = 0; ks < 4; ++ks) {
      int n = 32 * w + nt * 16 + col;
      qf[nt][ks] = *(const bf16x8*)(zc + (size_t)n * ZS + C_RQ + h * 128 + ks * 32 + quad * 8);
    }
  f32x4 acc[8][2];
#pragma unroll
  for (int et = 0; et < 8; ++et)
#pragma unroll
    for (int nt = 0; nt < 2; ++nt) acc[et][nt] = f32x4{0.f, 0.f, 0.f, 0.f};
  __syncthreads();
  load128(tid, lds, zc + C_RV + h * 128, ZS);
  __syncthreads();
#pragma unroll
  for (int ks = 0; ks < 4; ++ks)
#pragma unroll
    for (int et = 0; et < 8; ++et) {
      int row = et * 16 + col;
      bf16x8 af = *(const bf16x8*)(lds + row * 128 + (((ks * 4 + quad) ^ (row & 15)) << 3));
#pragma unroll
      for (int nt = 0; nt < 2; ++nt) acc[et][nt] = mfma16(af, qf[nt][ks], acc[et][nt]);
    }
#pragma unroll
  for (int nt = 0; nt < 2; ++nt) {
    int n = 32 * w + nt * 16 + col;
    float xi = exp2f(lg2 * (float)(n + 1));
#pragma unroll
    for (int et = 0; et < 8; ++et) acc[et][nt] *= xi;
  }
  __syncthreads();
  load128(tid, lds, zc + C_RK + h * 128, ZS);
  __syncthreads();
  bf16x8 pf[2][4];
#pragma unroll
  for (int nt = 0; nt < 2; ++nt) {
    f32x4 s[8];
#pragma unroll
    for (int mt = 0; mt < 8; ++mt) s[mt] = f32x4{0.f, 0.f, 0.f, 0.f};
#pragma unroll
    for (int ks = 0; ks < 4; ++ks)
#pragma unroll
      for (int mt = 0; mt < 8; ++mt) {
        if (mt <= 2 * w + 1) {
          int row = mt * 16 + col;
          bf16x8 af = *(const bf16x8*)(lds + row * 128 + (((ks * 4 + quad) ^ (row & 15)) << 3));
          s[mt] = mfma16(af, qf[nt][ks], s[mt]);
        }
      }
    const int n = 32 * w + nt * 16 + col;
#pragma unroll
    for (int c2 = 0; c2 < 4; ++c2) {
      float v[8];
#pragma unroll
      for (int i = 0; i < 8; ++i) {
        const int mt = 2 * c2 + (i >> 2), j = i & 3;
        const int m = mt * 16 + quad * 4 + j;
        v[i] = (n >= m) ? s[mt][j] * exp2f(lg2 * (float)(n - m)) : 0.f;
      }
      pf[nt][c2] = mk8(pack2(v[0], v[1]), pack2(v[2], v[3]), pack2(v[4], v[5]), pack2(v[6], v[7]));
    }
  }
  __syncthreads();
  load128(tid, lds, rvT + ((size_t)((b * 4 + h) * 128)) * TS + c * 128, TS);
  __syncthreads();
#pragma unroll
  for (int c2 = 0; c2 < 4; ++c2) {
    if (2 * c2 <= 2 * w + 1) {
#pragma unroll
      for (int et = 0; et < 8; ++et) {
        int row = et * 16 + col;
        int sw = row & 15;
        uint2 a = *(const uint2*)(lds + row * 128 + (((4 * c2 + (quad >> 1)) ^ sw) << 3) + (quad & 1) * 4);
        uint2 bb = *(const uint2*)(lds + row * 128 + (((4 * c2 + 2 + (quad >> 1)) ^ sw) << 3) + (quad & 1) * 4);
        bf16x8 vf = mk8(a.x, a.y, bb.x, bb.y);
#pragma unroll
        for (int nt = 0; nt < 2; ++nt) acc[et][nt] = mfma16(vf, pf[nt][c2], acc[et][nt]);
      }
    }
  }
#pragma unroll
  for (int nt = 0; nt < 2; ++nt) {
    float ss = 0.f;
#pragma unroll
    for (int et = 0; et < 8; ++et)
#pragma unroll
      for (int j = 0; j < 4; ++j) ss += acc[et][nt][j] * acc[et][nt][j];
    ss += shx(ss, 16, lane);
    ss += shx(ss, 32, lane);
    const float rs = rsqrtf(ss * (1.f / 128.f) + 1e-6f);
    const int n = 32 * w + nt * 16 + col;
    bf16_t* zr = zc + (size_t)n * ZS;
#pragma unroll
    for (int et = 0; et < 8; ++et) {
      const int e0 = et * 16 + quad * 4;
      uint2 gv = *(const uint2*)(zr + C_RG + h * 128 + e0);
      float g0 = bflo(gv.x), g1 = bfhi(gv.x), g2 = bflo(gv.y), g3 = bfhi(gv.y);
      uint2 o;
      o.x = pack2(acc[et][nt][0] * rs * g0 * sigmoidf(g0), acc[et][nt][1] * rs * g1 * sigmoidf(g1));
      o.y = pack2(acc[et][nt][2] * rs * g2 * sigmoidf(g2), acc[et][nt][3] * rs * g3 * sigmoidf(g3));
      *(uint2*)(zr + C_RQ + h * 128 + e0) = o;
    }
  }
}

#define GEMM_TILE_LOOP(NT)                                                             \
  for (int qp_ = (int)(blockIdx.x >> 3), per_ = (int)(gridDim.x >> 3), xcd_ = (int)(blockIdx.x & 7), q_ = 0, mt = 0, ntile = 0; \
       2 * qp_ < 32 * (NT) && ((q_ = 2 * qp_ + HALF()), (mt = (((xcd_ + 8 * (q_ / (8 * (NT)))) << 3) + ((q_ % (8 * (NT))) & 7)), ntile = ((q_ % (8 * (NT))) >> 3)), true); \
       qp_ += per_)


DI int TID8() { int t = threadIdx.x; asm volatile("" : "+v"(t)); return t; }
DI void g8_load(u32x4 (&ra)[4], u32x4 (&rb)[4], const bf16_t* a, size_t lda, const bf16_t* b, size_t ldb, int kb, int lrow, int lch) {
#pragma unroll
  for (int i = 0; i < 4; ++i) {
    ra[i] = *(const u32x4*)(a + (size_t)(lrow + 64 * i) * lda + kb * 64 + lch * 8);
    rb[i] = *(const u32x4*)(b + (size_t)(lrow + 64 * i) * ldb + kb * 64 + lch * 8);
  }
}
DI void g8_store(bf16_t* S, const u32x4 (&ra)[4], const u32x4 (&rb)[4], int lrow, int lch) {
#pragma unroll
  for (int i = 0; i < 4; ++i) {
    const int r = lrow + 64 * i;
    const int off = r * 64 + ((lch ^ ((r >> 1) & 7)) << 3);
    *(u32x4*)(S + off) = ra[i];
    *(u32x4*)(S + 16384 + off) = rb[i];
  }
}
DI void g8_load1(u32x4 (&r4)[4], const bf16_t* a, size_t lda, int kb, int lrow, int lch) {
  const bf16_t* base = a + kb * 64;
  const unsigned ld32 = (unsigned)lda;
#pragma unroll
  for (int i = 0; i < 4; ++i) {
    const unsigned off = (unsigned)(lrow + 64 * i) * ld32 + (unsigned)(lch * 8);
    r4[i] = *(const u32x4*)(base + off);
  }
}
DI void g8_store1(bf16_t* S, const u32x4 (&r4)[4], int lrow, int lch) {
#pragma unroll
  for (int i = 0; i < 4; ++i) {
    const int r = lrow + 64 * i;
    *(u32x4*)(S + r * 64 + ((lch ^ ((r >> 1) & 7)) << 3)) = r4[i];
  }
}
template <int KS0 = 0, int KS1 = 2>
DI void g8_compute(f32x4 (&acc)[8][4], const bf16_t* S, int wm, int wn, int lane) {
#pragma unroll
  for (int ks = KS0; ks < KS1; ++ks) {
    bf16x8 af[8], bfr[4];
#pragma unroll
    for (int i = 0; i < 8; ++i) {
      const int r = wm * 128 + i * 16 + (lane & 15);
      af[i] = *(const bf16x8*)(S + r * 64 + (((ks * 4 + (lane >> 4)) ^ ((r >> 1) & 7)) << 3));
    }
#pragma unroll
    for (int j = 0; j < 4; ++j) {
      const int r = wn * 64 + j * 16 + (lane & 15);
      bfr[j] = *(const bf16x8*)(S + 16384 + r * 64 + (((ks * 4 + (lane >> 4)) ^ ((r >> 1) & 7)) << 3));
    }
    __builtin_amdgcn_s_setprio(1);
#pragma unroll
    for (int i = 0; i < 8; ++i)
#pragma unroll
      for (int j = 0; j < 4; ++j) acc[i][j] = mfma16(bfr[j], af[i], acc[i][j]);
    __builtin_amdgcn_s_setprio(0);
  }
}
DI void g8_load1o(u32x4 (&r4)[4], const bf16_t* base, const unsigned (&off)[4]) {
#pragma unroll
  for (int i = 0; i < 4; ++i) r4[i] = *(const u32x4*)(base + off[i]);
}
DI void gemm8_accum(f32x4 (&acc)[8][4], const bf16_t* a, size_t lda, const bf16_t* b, size_t ldb, int nkb, bf16_t* L,
                    const bool pre, const bf16_t* an, size_t ldan, const bf16_t* bn, size_t ldbn) {
  const int tid = TID8(), lane = tid & 63, w = tid >> 6;
  const int wm = w >> 2, wn = w & 3;
  const int lrow = tid >> 3, lch = tid & 7;
  u32x4 ra[4], rb[4];
  unsigned offa[4], offb[4];
#pragma unroll
  for (int i = 0; i < 4; ++i) {
    offa[i] = (unsigned)(lrow + 64 * i) * (unsigned)lda + (unsigned)(lch * 8);
    offb[i] = (unsigned)(lrow + 64 * i) * (unsigned)ldb + (unsigned)(lch * 8);
  }
  if (!pre) {
    g8_load1o(ra, a, offa);
    g8_load1o(rb, b, offb);
    __syncthreads();
    g8_store(L, ra, rb, lrow, lch);
  }
  g8_load1o(ra, a + 64, offa);
  g8_load1o(rb, b + 64, offb);
  for (int kb = 0; kb + 2 < nkb; ++kb) {
    __syncthreads();
    g8_store1(L + ((kb + 1) & 1) * 32768, ra, lrow, lch);
    g8_load1o(ra, a + (kb + 2) * 64, offa);
    __builtin_amdgcn_sched_barrier(0);
    g8_compute<0, 1>(acc, L + (kb & 1) * 32768, wm, wn, lane);
    __builtin_amdgcn_sched_barrier(0);
    g8_store1(L + ((kb + 1) & 1) * 32768 + 16384, rb, lrow, lch);
    g8_load1o(rb, b + (kb + 2) * 64, offb);
    __builtin_amdgcn_sched_barrier(0);
    g8_compute<1, 2>(acc, L + (kb & 1) * 32768, wm, wn, lane);
  }
  __syncthreads();
  g8_store1(L + 32768, ra, lrow, lch);
  g8_load1(ra, an, ldan, 0, lrow, lch);
  __builtin_amdgcn_sched_barrier(0);
  g8_compute<0, 1>(acc, L, wm, wn, lane);
  __builtin_amdgcn_sched_barrier(0);
  g8_store1(L + 32768 + 16384, rb, lrow, lch);
  g8_load1(rb, bn, ldbn, 0, lrow, lch);
  __builtin_amdgcn_sched_barrier(0);
  g8_compute<1, 2>(acc, L, wm, wn, lane);
  __syncthreads();
  g8_store1(L, ra, lrow, lch);
  __builtin_amdgcn_sched_barrier(0);
  g8_compute<0, 1>(acc, L + 32768, wm, wn, lane);
  __builtin_amdgcn_sched_barrier(0);
  g8_store1(L + 16384, rb, lrow, lch);
  __builtin_amdgcn_sched_barrier(0);
  g8_compute<1, 2>(acc, L + 32768, wm, wn, lane);
  __syncthreads();
}
DI void zero_acc8(f32x4 (&acc)[8][4]) {
#pragma unroll
  for (int i = 0; i < 8; ++i)
#pragma unroll
    for (int j = 0; j < 4; ++j) acc[i][j] = f32x4{0.f, 0.f, 0.f, 0.f};
}
template <class F>
DI void gemm8_epi_staged(f32x4 (&acc)[8][4], int m0, int n0, bf16_t* L0, F f, bf16_t* dst, size_t ld, int nmax) {
  bf16_t* L = L0 + 32768;
  const int tid = TID8(), lane = tid & 63, w = tid >> 6;
  const int wm = w >> 2, wn = w & 3;
#pragma unroll
  for (int half = 0; half < 2; ++half) {
    if (wm == half) {
#pragma unroll
      for (int i = 0; i < 8; ++i)
#pragma unroll
        for (int j = 0; j < 4; ++j) {
          const int ml = i * 16 + (lane & 15);
          const int nl = wn * 64 + j * 16 + (lane >> 4) * 4;
          f32x4 a = acc[i][j];
          f(m0 + half * 128 + ml, n0 + nl, a);
          uint2 u;
          u.x = pack2(a[0], a[1]);
          u.y = pack2(a[2], a[3]);
          *(uint2*)(L + ml * 264 + nl) = u;
        }
    }
    __syncthreads();
#pragma unroll
    for (int it = 0; it < 8; ++it) {
      const int idx = tid + 512 * it;
      const int row = idx >> 5, ch = idx & 31;
      const u32x4 v = *(const u32x4*)(L + row * 264 + ch * 8);
      const int n = n0 + ch * 8;
      if (n < nmax) *(u32x4*)(dst + (size_t)(m0 + half * 128 + row) * ld + n) = v;
    }
    __syncthreads();
  }
}
DI void gemm8_epi_resid(f32x4 (&acc)[8][4], int m0, int n0, int ntile8, bf16_t* L, const float* xin, float* out, bf16_t* xb, float* rowpart) {
  const int tid = TID8(), lane = tid & 63, w = tid >> 6;
  const int wm = w >> 2, wn = w & 3;
  float* red = (float*)(L + 32768);
#pragma unroll
  for (int i = 0; i < 8; ++i) {
    const int ml = wm * 128 + i * 16 + (lane & 15);
    const size_t rowoff = (size_t)(m0 + ml) * DM;
    float ss = 0.f;
#pragma unroll
    for (int j = 0; j < 4; ++j) {
      const int n = n0 + wn * 64 + j * 16 + (lane >> 4) * 4;
      const float4 xv = *(const float4*)(xin + rowoff + n);
      const float o0 = xv.x + acc[i][j][0], o1 = xv.y + acc[i][j][1], o2 = xv.z + acc[i][j][2], o3 = xv.w + acc[i][j][3];
      *(float4*)(out + rowoff + n) = make_float4(o0, o1, o2, o3);
      ss += o0 * o0 + o1 * o1 + o2 * o2 + o3 * o3;
      uint2 u;
      u.x = pack2(o0, o1);
      u.y = pack2(o2, o3);
      *(uint2*)(xb + rowoff + n) = u;
    }
    ss += shx(ss, 16, lane);
    ss += shx(ss, 32, lane);
    if ((lane >> 4) == 0) red[wn * 256 + ml] = ss;
  }
  __syncthreads();
  {
    const int row = tid & 255, h = tid >> 8;
    rowpart[(size_t)(ntile8 * 2 + h) * T_TOK + m0 + row] = red[(2 * h) * 256 + row] + red[(2 * h + 1) * 256 + row];
  }
}
template <class E>
DI void gemm8_epi(f32x4 (&acc)[8][4], int m0, int n0, E e) {
  const int tid = TID8(), lane = tid & 63, w = tid >> 6;
  const int wm = w >> 2, wn = w & 3;
#pragma unroll
  for (int i = 0; i < 8; ++i)
#pragma unroll
    for (int j = 0; j < 4; ++j) {
      const int m = m0 + wm * 128 + i * 16 + (lane & 15);
      const int n = n0 + wn * 64 + j * 16 + (lane >> 4) * 4;
      e(m, n, acc[i][j]);
    }
}
DI void row_rs8(float (&rsv)[8], const float* rowpart, int m0) {
  const int tid = TID8(), lane = tid & 63, wm = tid >> 8;
#pragma unroll
  for (int i = 0; i < 8; ++i) {
    const int m = m0 + wm * 128 + i * 16 + (lane & 15);
    float s = 0.f;
#pragma unroll
    for (int t = 0; t < 8; ++t) s += rowpart[(size_t)t * T_TOK + m];
    rsv[i] = rsqrtf(s * (1.f / 1024.f) + 1e-6f);
  }
}
DI void scale_rows8(f32x4 (&acc)[8][4], const float (&rsv)[8]) {
#pragma unroll
  for (int i = 0; i < 8; ++i)
#pragma unroll
    for (int j = 0; j < 4; ++j) acc[i][j] *= rsv[i];
}
#define G8_TILE(q, NT8, MT, NTL) \
  MT = (((xcd_ + 8 * ((q) / (4 * (NT8)))) << 2) + (((q) % (4 * (NT8))) & 3)); NTL = (((q) % (4 * (NT8))) >> 2);
#define GEMM8_TILE_LOOP(NT8)                                                            \
  for (int q_ = (int)(blockIdx.x >> 3), per_ = (int)(gridDim.x >> 3), xcd_ = (int)(blockIdx.x & 7), first_ = 1, mt = 0, ntile = 0, mtn = 0, ntilen = 0; \
       q_ < 16 * (NT8) && ([&] { G8_TILE(q_, NT8, mt, ntile) const int qn_ = (q_ + per_ < 16 * (NT8)) ? q_ + per_ : q_; G8_TILE(qn_, NT8, mtn, ntilen) }(), true); \
       q_ += per_, first_ = 0)

#define XB_TMO      128
#define XB_XCNT(j)  (256  + 64 * (j))
#define XB_XSUB(j)  (1280 + 64 * (j))
#define XB_XGEN(j)  (2304 + 64 * (j))
#define XB_TOP      3328
#define XB_TOPGEN   3392
#define XB_SPIN_CAP (1u << 20)
DI unsigned xb_ld(unsigned* p) { return __hip_atomic_load(p, __ATOMIC_RELAXED, __HIP_MEMORY_SCOPE_AGENT); }
DI unsigned xb_add(unsigned* p, unsigned v) { return __hip_atomic_fetch_add(p, v, __ATOMIC_RELAXED, __HIP_MEMORY_SCOPE_AGENT); }
DI unsigned xb_xcc_id() { return (unsigned)__builtin_amdgcn_s_getreg((3 << 11) | 20) & 0xFu; }
#define XB_SPIN(cond, bar) do { unsigned _sp = 0; while (cond) { __builtin_amdgcn_s_sleep(1); \
    if ((++_sp & 255u) == 0u) { if (xb_ld(&(bar)[XB_TMO])) break; if (_sp > XB_SPIN_CAP) { atomicAdd(&(bar)[XB_TMO], 1u); break; } } } } while (0)

DI void xcd_barrier(unsigned* bar, const unsigned x, const unsigned nloc, const unsigned nx) {
  asm volatile("s_waitcnt vmcnt(0)" ::: "memory");
  __syncthreads();
  if (threadIdx.x == 0) {
    __builtin_amdgcn_s_waitcnt(0);
    const unsigned old = xb_add(&bar[XB_XSUB(x)], 1u);
    const unsigned gen = old / nloc;
    if (old + 1u == (gen + 1u) * nloc) {
      __builtin_amdgcn_fence(__ATOMIC_RELEASE, "agent");
      asm volatile("s_waitcnt vmcnt(0)" ::: "memory");
      const unsigned og = xb_add(&bar[XB_TOP], 1u);
      const unsigned tg = og / nx;
      if (og + 1u == (tg + 1u) * nx) xb_add(&bar[XB_TOPGEN], 1u);
      else XB_SPIN(xb_ld(&bar[XB_TOPGEN]) == tg, bar);
      __builtin_amdgcn_fence(__ATOMIC_ACQUIRE, "agent");
      xb_add(&bar[XB_XGEN(x)], 1u);
      asm volatile("s_waitcnt vmcnt(0)" ::: "memory");
    } else {
      XB_SPIN(xb_ld(&bar[XB_XGEN(x)]) == gen, bar);
      __builtin_amdgcn_fence(__ATOMIC_ACQUIRE, "agent");
      asm volatile("s_waitcnt vmcnt(0)" ::: "memory");
    }
  }
  __syncthreads();
}

__global__ void __launch_bounds__(512, 2) mega(Params p) {
  extern __shared__ __attribute__((aligned(16))) bf16_t lds_all[];
  bf16_t* lds = lds_all + HALF() * 32768;
  cg::grid_group grid = cg::this_grid();
  const int nb = NVB;
  bf16_t* wt = (bf16_t*)(p.ws + O_WT);
  bf16_t* z = (bf16_t*)(p.ws + O_Z);
  bf16_t* hbuf = (bf16_t*)(p.ws + O_VST);
  bf16_t* ubuf = z;
  bf16_t* p16 = (bf16_t*)(p.ws + O_KVD);
  float* rowpart = (float*)(p.ws + O_RP);
  bf16_t* hid = (bf16_t*)(p.ws + O_HID);
  const float* bias = (const float*)(p.ws + O_BIAS);

  unsigned* bar = (unsigned*)(p.ws + O_BAR);
  const unsigned xb_x = xb_xcc_id();
  if (threadIdx.x == 0) (void)xb_add(&bar[XB_XCNT(xb_x)], 1u);
  unsigned xb_nloc = 1u, xb_nx = 1u;

  for (int layer = 0; layer < 2; ++layer) {
    const bf16_t* wl = wt;
    const float* xin = (layer == 0) ? p.x : p.out;

    phase0(p, layer);
    norm_phase(xin, p.norm_mix + layer * DM, hbuf);
    if (layer == 0) {
      grid.sync();
      unsigned mine = 0u, cnt = 0u;
#pragma unroll
      for (unsigned j = 0; j < 16; ++j) {
        const unsigned c = xb_ld(&bar[XB_XCNT(j)]);
        cnt += (c > 0u) ? 1u : 0u;
        mine = (j == xb_x) ? c : mine;
      }
      xb_nloc = __builtin_amdgcn_readfirstlane(mine > 0u ? mine : 1u);
      xb_nx = __builtin_amdgcn_readfirstlane(cnt > 0u ? cnt : 1u);
    } else {
      xcd_barrier(bar, xb_x, xb_nloc, xb_nx);
    }

    GEMM8_TILE_LOOP(22) {
      const int m0 = mt * 256, n0 = ntile * 256;
      f32x4 acc8[8][4];
      zero_acc8(acc8);
      gemm8_accum(acc8, hbuf + (size_t)m0 * DM, DM, wl + W_IN + (size_t)n0 * 1024, 1024, 16, lds_all, !first_,
                  hbuf + (size_t)mtn * 256 * DM, DM, wl + W_IN + (size_t)ntilen * 256 * 1024, 1024);
      gemm8_epi_staged(acc8, m0, n0, lds_all, [&](int, int, f32x4&) {}, z, ZS, ZS);
    }
    xcd_barrier(bar, xb_x, xb_nloc, xb_nx);

    post_z(p, layer);
    xcd_barrier(bar, xb_x, xb_nloc, xb_nx);

    for (int u_ = (int)blockIdx.x, t = 0; (u_ < 64 || u_ - 64 < 512) && ((t = (u_ < 64) ? 2 * u_ + HALF() : 128 + 2 * (u_ - 64) + HALF()), true); u_ = (u_ < 64) ? 1 << 20 : u_ + (int)gridDim.x - 64) {
      f32x4 acc[4][4];
      zero_acc(acc);
      if (t < 128) {
        const int kv = t >> 6, mt = (t >> 1) & 31, ntile = t & 1;
        const int m0 = mt * 128, n0 = ntile * 128;
        const bf16_t* kvd = (const bf16_t*)(p.ws + O_KVD) + (size_t)kv * 8 * SEQ * 64;
        auto ap = [&](int r, int kb) -> const bf16_t* {
          int row = m0 + r;
          int bg = row >> 9, c = row & 511;
          int tk = 16 * c + kb;
          tk = tk > (SEQ - 1) ? (SEQ - 1) : tk;
          return kvd + ((size_t)(bg * SEQ + tk)) * 64;
        };
        gemm_accum(acc, ap, RowPtr{wl + (kv ? W_C1V : W_C1K) + (size_t)n0 * 2048, 2048}, 32, lds);
        const float* bs = bias + kv * 256;
        bf16_t* hd = hid + (size_t)kv * 4096 * 256;
        gemm_epi(acc, m0, n0, [&](int m, int n, f32x4& a) {
          float o[4];
#pragma unroll
          for (int j = 0; j < 4; ++j) {
            float xv = a[j] + bs[n + j];
            float y = 0.7978845608028654f * (xv + 0.044715f * xv * xv * xv);
            float th = 1.f - 2.f / (__expf(2.f * y) + 1.f);
            o[j] = 0.5f * xv * (1.f + th);
          }
          uint2 u;
          u.x = pack2(o[0], o[1]);
          u.y = pack2(o[2], o[3]);
          *(uint2*)(hd + (size_t)m * 256 + n) = u;
        });
      } else {
        const int idx = t - 128;
        const int c = idx & 63, bh = idx >> 6;
        const bf16_t* rvT = (const bf16_t*)(p.ws + O_RVT) + ((size_t)bh * 128) * TS + c * 128;
        const bf16_t* kzT = (const bf16_t*)(p.ws + O_KZT) + ((size_t)bh * 128) * TS + c * 128;
        gemm_accum(acc, RowPtr{rvT, TS}, RowPtr{kzT, TS}, 2, lds);
        bf16_t* dst = z + ((size_t)((bh >> 2) * SEQ + c * 128)) * ZS + C_RV + (bh & 3) * 128;
        gemm_epi_staged(acc, 0, 0, lds, [&](int, int, f32x4&) {}, dst, ZS, 128);
      }
    }
    xcd_barrier(bar, xb_x, xb_nloc, xb_nx);

    phase4b(p, layer);
    {
      const float* pl = p.p + (size_t)layer * T_TOK * 256;
      const int gtid = VBID * 256 + TID();
      const int gthreads = nb * 256;
      for (int i = gtid; i < T_TOK * 32; i += gthreads) {
        float4 a = ((const float4*)pl)[2 * i], b2 = ((const float4*)pl)[2 * i + 1];
        ((uint4*)p16)[i] = make_uint4(pack2(a.x, a.y), pack2(a.z, a.w), pack2(b2.x, b2.y), pack2(b2.z, b2.w));
      }
    }
    xcd_barrier(bar, xb_x, xb_nloc, xb_nx);

    float nsa_c;
    {
      const int ln = TID() & 63;
      float gq = fabsf(p.nsa_q_norm[layer * 64 + ln]), gk = fabsf(p.nsa_k_norm[layer * 64 + ln]);
#pragma unroll
      for (int o = 32; o > 0; o >>= 1) {
        gq = fmaxf(gq, shx(gq, o, ln));
        gk = fmaxf(gk, shx(gk, o, ln));
      }
      nsa_c = 8.f * gq * gk;
    }
    const bool nsa_fx = nsa_c < 30.f;
    const float nsa_cl = nsa_c * 1.4426950408889634f;
    for (int t = VBID; t < 2048; t += nb) {
      if (t < 1024) {
        const int tile = (t < 512) ? 127 - (t >> 3) : ((t - 512) >> 3), bg = t & 7;
        if (nsa_fx) nsa_tile<true>(p, bg >> 1, bg & 1, tile, lds, nsa_cl);
        else nsa_tile<false>(p, bg >> 1, bg & 1, tile, lds, 0.f);
      } else {
        const int idx = t - 1024;
        ret_tile(p, idx >> 8, (idx >> 6) & 3, idx & 63, lds);
      }
    }
    xcd_barrier(bar, xb_x, xb_nloc, xb_nx);

    GEMM8_TILE_LOOP(4) {
      const int m0 = mt * 256, n0 = ntile * 256;
      f32x4 acc8[8][4];
      zero_acc8(acc8);
      gemm8_accum(acc8, (const bf16_t*)(p.ws + O_ONSA) + (size_t)m0 * 512, 512, wl + W_UPA + (size_t)n0 * 512, 512, 8, lds_all, !first_,
                  z + (size_t)m0 * ZS + C_RQ, ZS, wl + W_UPR + (size_t)n0 * 512, 512);
      gemm8_epi(acc8, m0, n0, [&](int m, int n, f32x4& a) {
        uint2 ua = *(const uint2*)(z + (size_t)m * ZS + C_MA + n);
        uint2 ub = *(const uint2*)(z + (size_t)m * ZS + C_MB + n);
        a[0] *= sigmoidf(bflo(ua.x)) / sigmoidf(bflo(ub.x));
        a[1] *= sigmoidf(bfhi(ua.x)) / sigmoidf(bfhi(ub.x));
        a[2] *= sigmoidf(bflo(ua.y)) / sigmoidf(bflo(ub.y));
        a[3] *= sigmoidf(bfhi(ua.y)) / sigmoidf(bfhi(ub.y));
      });
      gemm8_accum(acc8, z + (size_t)m0 * ZS + C_RQ, ZS, wl + W_UPR + (size_t)n0 * 512, 512, 8, lds_all, true,
                  (const bf16_t*)(p.ws + O_ONSA) + (size_t)mtn * 256 * 512, 512, wl + W_UPA + (size_t)ntilen * 256 * 512, 512);
      gemm8_epi_staged(acc8, m0, n0, lds_all, [&](int m, int n, f32x4& a) {
        uint2 ub = *(const uint2*)(z + (size_t)m * ZS + C_MB + n);
        a[0] *= sigmoidf(bflo(ub.x)); a[1] *= sigmoidf(bfhi(ub.x));
        a[2] *= sigmoidf(bflo(ub.y)); a[3] *= sigmoidf(bfhi(ub.y));
      }, z + C_RK, ZS, 1024);
    }
    xcd_barrier(bar, xb_x, xb_nloc, xb_nx);

    GEMM8_TILE_LOOP(4) {
      const int m0 = mt * 256, n0 = ntile * 256;
      f32x4 acc8[8][4];
      zero_acc8(acc8);
      gemm8_accum(acc8, z + (size_t)m0 * ZS + C_RK, ZS, wl + W_OUT + (size_t)n0 * 1024, 1024, 16, lds_all, !first_,
                  z + (size_t)mtn * 256 * ZS + C_RK, ZS, wl + W_OUT + (size_t)ntilen * 256 * 1024, 1024);
      gemm8_epi_resid(acc8, m0, n0, ntile, lds_all, xin, p.out, hbuf, rowpart);
    }
    xcd_barrier(bar, xb_x, xb_nloc, xb_nx);

    GEMM8_TILE_LOOP(16) {
      const int m0 = mt * 256, n0 = ntile * 256;
      f32x4 acc8[8][4];
      zero_acc8(acc8);
      gemm8_accum(acc8, hbuf + (size_t)m0 * DM, DM, wl + W_FF1 + (size_t)n0 * 1024, 1024, 16, lds_all, !first_,
                  hbuf + (size_t)mtn * 256 * DM, DM, wl + W_FF1 + (size_t)ntilen * 256 * 1024, 1024);
      float rsv[8];
      row_rs8(rsv, rowpart, m0);
      scale_rows8(acc8, rsv);
      gemm8_epi_staged(acc8, m0, n0, lds_all, [&](int, int, f32x4& a) {
        float r0 = fmaxf(a[0], 0.f), r1 = fmaxf(a[1], 0.f), r2 = fmaxf(a[2], 0.f), r3 = fmaxf(a[3], 0.f);
        a[0] = r0 * r0; a[1] = r1 * r1; a[2] = r2 * r2; a[3] = r3 * r3;
      }, ubuf, 4096, 4096);
    }
    xcd_barrier(bar, xb_x, xb_nloc, xb_nx);

    GEMM8_TILE_LOOP(4) {
      const int m0 = mt * 256, n0 = ntile * 256;
      f32x4 acc8[8][4];
      zero_acc8(acc8);
      gemm8_accum(acc8, ubuf + (size_t)m0 * 4096, 4096, wl + W_FF2 + (size_t)n0 * 4096, 4096, 64, lds_all, !first_,
                  ubuf + (size_t)mtn * 256 * 4096, 4096, wl + W_FF2 + (size_t)ntilen * 256 * 4096, 4096);
      gemm8_epi_resid(acc8, m0, n0, ntile, lds_all, p.out, p.out, hbuf, rowpart);
    }
    xcd_barrier(bar, xb_x, xb_nloc, xb_nx);

    GEMM8_TILE_LOOP(4) {
      const int m0 = mt * 256, n0 = ntile * 256;
      f32x4 acc8[8][4];
      zero_acc8(acc8);
      gemm8_accum(acc8, p16 + (size_t)m0 * 256, 256, wl + W_PLE + (size_t)n0 * 256, 256, 4, lds_all, !first_,
                  hbuf + (size_t)m0 * DM, DM, wl + W_PG + (size_t)n0 * 1024, 1024);
      bf16_t* ppb = z + (size_t)T_TOK * 256;
      gemm8_epi_staged(acc8, m0, n0, lds_all, [&](int, int, f32x4&) {}, ppb, DM, 1024);
      zero_acc8(acc8);
      gemm8_accum(acc8, hbuf + (size_t)m0 * DM, DM, wl + W_PG + (size_t)n0 * 1024, 1024, 16, lds_all, true,
                  p16 + (size_t)mtn * 256 * 256, 256, wl + W_PLE + (size_t)ntilen * 256 * 256, 256);
      float rsv[8];
      row_rs8(rsv, rowpart, m0);
      scale_rows8(acc8, rsv);
      gemm8_epi(acc8, m0, n0, [&](int m, int n, f32x4& a) {
        uint2 pv = *(const uint2*)(ppb + (size_t)m * DM + n);
        float4* o = (float4*)(p.out + (size_t)m * DM + n);
        float4 xv = *o;
        *o = make_float4(xv.x + sigmoidf(a[0]) * bflo(pv.x), xv.y + sigmoidf(a[1]) * bfhi(pv.x),
                         xv.z + sigmoidf(a[2]) * bflo(pv.y), xv.w + sigmoidf(a[3]) * bfhi(pv.y));
      });
    }
    xcd_barrier(bar, xb_x, xb_nloc, xb_nx);
  }
}

extern "C" void kernel_launch(void* const* d_in, const int* in_sizes, int n_in,
                              void* d_out, int out_size, void* d_ws, size_t ws_size,
                              hipStream_t stream) {
  static int grid_blocks = 0;
  if (!grid_blocks) {
    int dev = 0, cus = 0, per_cu = 0;
    hipGetDevice(&dev);
    hipDeviceGetAttribute(&cus, hipDeviceAttributeMultiprocessorCount, dev);
    hipFuncSetAttribute((const void*)mega, hipFuncAttributeMaxDynamicSharedMemorySize, DYN_LDS);
    hipOccupancyMaxActiveBlocksPerMultiprocessor(&per_cu, mega, 512, DYN_LDS);
    if (per_cu > 1) per_cu = 1;
    if (per_cu < 1) per_cu = 1;
    grid_blocks = cus * per_cu;
  }
  if (ws_size < WS_NEED) {
    fprintf(stderr, "workspace too small: %zu < %llu\n", ws_size, (unsigned long long)WS_NEED);
    return;
  }
  Params p{};
  p.x = (const float*)d_in[0]; p.p = (const float*)d_in[1]; p.norm_mix = (const float*)d_in[2]; p.w_in = (const float*)d_in[3];
  p.nsa_q_norm = (const float*)d_in[4]; p.nsa_k_norm = (const float*)d_in[5]; p.cmp_pos_k = (const float*)d_in[6];
  p.cmp_pos_v = (const float*)d_in[7]; p.cmp_w1_k = (const float*)d_in[8]; p.cmp_w2_k = (const float*)d_in[9];
  p.cmp_w1_v = (const float*)d_in[10]; p.cmp_w2_v = (const float*)d_in[11]; p.w_up_nsa = (const float*)d_in[12];
  p.w_up_ret = (const float*)d_in[13]; p.w_out = (const float*)d_in[14]; p.norm_mlp = (const float*)d_in[15];
  p.w_ff1 = (const float*)d_in[16]; p.w_ff2 = (const float*)d_in[17]; p.norm_ple = (const float*)d_in[18];
  p.w_ple = (const float*)d_in[19]; p.w_ple_gate = (const float*)d_in[20];
  p.out = (float*)d_out; p.ws = (char*)d_ws;
  hipMemsetAsync((char*)d_ws + O_BAR, 0, BAR_BYTES, stream);
  void* args[] = {&p};
  hipError_t e = hipLaunchCooperativeKernel((void*)mega, dim3(grid_blocks), dim3(512), args, DYN_LDS, stream);
  if (e != hipSuccess) fprintf(stderr, "cooperative launch failed: %s (grid %d)\n", hipGetErrorString(e), grid_blocks);
}
```

```cpp
#include <hip/hip_runtime.h>
#include <hip/hip_cooperative_groups.h>
#include <cstdio>
#include <cstdint>
namespace cg = cooperative_groups;

typedef __attribute__((ext_vector_type(8))) short bf16x8;
typedef __attribute__((ext_vector_type(4))) float f32x4;
typedef unsigned short bf16_t;
typedef __attribute__((ext_vector_type(4))) unsigned u32x4;
#define DI __device__ __forceinline__

#define T_TOK 32768
#define SEQ 8192
#define DM 1024
#define ZS 5400
#define C_Q 0
#define C_KC 512
#define C_VC 640
#define C_KS 768
#define C_VS 896
#define C_KW 1024
#define C_VW 1152
#define C_GT 1280
#define C_RQ 1304
#define C_RK 1816
#define C_RV 2328
#define C_RG 2840
#define C_MA 3352
#define C_MB 4376
#define NPAD_IN 5504
#define TS 8256

#define W_IN 0
#define W_C1K 5636096
#define W_C1V 6160384
#define W_UPA 6684672
#define W_UPR 7208960
#define W_OUT 7733248
#define W_FF1 8781824
#define W_FF2 12976128
#define W_PLE 17170432
#define W_PG 17432576
#define W_LAYER 18481152

#define O_WT 0ull
#define O_ROPE 36962304ull
#define O_BIAS 41156608ull
#define O_HID 41160704ull
#define O_KCMP 45355008ull
#define O_VCMPT 45879296ull
#define O_VST 46403584ull
#define O_VWT 54857728ull
#define O_RVT 63311872ull
#define O_KZT 97128448ull
#define O_Z 130945024ull
#define O_ONSA 484839424ull
#define O_BAR 518393856ull
#define BAR_BYTES 13824
#define O_KVD 518407680ull
#define O_RP 535184896ull
#define WS_NEED 536233472ull
#define DYN_LDS 139264

struct Params {
  const float* x; const float* p; const float* norm_mix; const float* w_in;
  const float* nsa_q_norm; const float* nsa_k_norm; const float* cmp_pos_k; const float* cmp_pos_v;
  const float* cmp_w1_k; const float* cmp_w2_k; const float* cmp_w1_v; const float* cmp_w2_v;
  const float* w_up_nsa; const float* w_up_ret; const float* w_out; const float* norm_mlp;
  const float* w_ff1; const float* w_ff2; const float* norm_ple; const float* w_ple; const float* w_ple_gate;
  float* out; char* ws;
};

DI unsigned pack2(float a, float b) {
  typedef __attribute__((ext_vector_type(2))) __bf16 bf2;
  typedef __attribute__((ext_vector_type(2))) float f2;
  f2 v = {a, b};
  bf2 r = __builtin_convertvector(v, bf2);
  return __builtin_bit_cast(unsigned, r);
}
DI bf16_t f2bf(float a) { return (bf16_t)(pack2(a, 0.f) & 0xffffu); }
DI float bf2f(bf16_t h) { return __uint_as_float(((unsigned)h) << 16); }
DI float bflo(unsigned u) { return __uint_as_float(u << 16); }
DI float bfhi(unsigned u) { return __uint_as_float(u & 0xffff0000u); }
DI float shx(float v, int mask, int lane) {
  return __int_as_float(__builtin_amdgcn_ds_bpermute((lane ^ mask) << 2, __float_as_int(v)));
}
DI uint32_t shxu(uint32_t v, int mask, int lane) {
  return (uint32_t)__builtin_amdgcn_ds_bpermute((lane ^ mask) << 2, (int)v);
}
DI float shfrom(float v, int srclane) {
  return __int_as_float(__builtin_amdgcn_ds_bpermute(srclane << 2, __float_as_int(v)));
}
DI float wave_sum(float v, int lane) {
#pragma unroll
  for (int o = 32; o > 0; o >>= 1) v += shx(v, o, lane);
  return v;
}
DI int TID() { int t = threadIdx.x & 255; asm volatile("" : "+v"(t)); return t; }
DI int HALF() { return __builtin_amdgcn_readfirstlane((int)(threadIdx.x >> 8)); }
#define VBID ((int)(blockIdx.x * 2) + HALF())
#define NVB ((int)(gridDim.x * 2))
DI float sigmoidf(float x) { return 1.f / (1.f + __expf(-x)); }
DI f32x4 mfma16(bf16x8 a, bf16x8 b, f32x4 c) { return __builtin_amdgcn_mfma_f32_16x16x32_bf16(a, b, c, 0, 0, 0); }
DI bf16x8 mk8(unsigned a, unsigned b, unsigned c, unsigned d) {
  uint4 u = make_uint4(a, b, c, d);
  return __builtin_bit_cast(bf16x8, u);
}

template <class AP, class BP>
DI void g_load(u32x4 (&ra)[4], u32x4 (&rb)[4], const AP& ap, const BP& bp, int kb, int lrow, int lch) {
#pragma unroll
  for (int i = 0; i < 4; ++i) {
    ra[i] = *(const u32x4*)(ap(lrow + 32 * i, kb) + lch * 8);
    rb[i] = *(const u32x4*)(bp(lrow + 32 * i, kb) + lch * 8);
  }
}
DI void g_store(bf16_t* As, bf16_t* Bs, const u32x4 (&ra)[4], const u32x4 (&rb)[4], int buf, int lrow, int lch) {
#pragma unroll
  for (int i = 0; i < 4; ++i) {
    int r = lrow + 32 * i;
    int off = buf * 8192 + r * 64 + ((lch ^ ((r >> 1) & 7)) << 3);
    *(u32x4*)(As + off) = ra[i];
    *(u32x4*)(Bs + off) = rb[i];
  }
}
DI void g_compute(f32x4 (&acc)[4][4], const bf16_t* a, const bf16_t* b, int wm, int wn, int lane) {
  bf16x8 af[2][4], bfr[2][4];
#pragma unroll
  for (int ks = 0; ks < 2; ++ks)
#pragma unroll
    for (int i = 0; i < 4; ++i) {
      int r = wm * 64 + i * 16 + (lane & 15);
      af[ks][i] = *(const bf16x8*)(a + r * 64 + (((ks * 4 + (lane >> 4)) ^ ((r >> 1) & 7)) << 3));
      int r2 = wn * 64 + i * 16 + (lane & 15);
      bfr[ks][i] = *(const bf16x8*)(b + r2 * 64 + (((ks * 4 + (lane >> 4)) ^ ((r2 >> 1) & 7)) << 3));
    }
  __builtin_amdgcn_s_setprio(1);
#pragma unroll
  for (int ks = 0; ks < 2; ++ks)
#pragma unroll
    for (int i = 0; i < 4; ++i)
#pragma unroll
      for (int j = 0; j < 4; ++j) acc[i][j] = mfma16(bfr[ks][j], af[ks][i], acc[i][j]);
  __builtin_amdgcn_s_setprio(0);
}
template <class AP, class BP>
DI void gemm_accum(f32x4 (&acc)[4][4], AP ap, BP bp, int nkb, bf16_t* lds) {
  const int tid = TID(), lane = tid & 63, w = tid >> 6;
  const int wm = w >> 1, wn = w & 1;
  const int lrow = tid >> 3, lch = tid & 7;
  bf16_t* As = lds;
  bf16_t* Bs = lds + 16384;
  u32x4 ra0[4], rb0[4], ra1[4], rb1[4];
  __syncthreads();
  g_load(ra0, rb0, ap, bp, 0, lrow, lch);
  g_load(ra1, rb1, ap, bp, 1, lrow, lch);
  g_store(As, Bs, ra0, rb0, 0, lrow, lch);
  __syncthreads();
  for (int kb = 0; kb < nkb; kb += 2) {
    const int k2 = (kb + 2 < nkb) ? kb + 2 : nkb - 2;
    g_load(ra0, rb0, ap, bp, k2, lrow, lch);
    __builtin_amdgcn_sched_barrier(0);
    g_compute(acc, As, Bs, wm, wn, lane);
    g_store(As, Bs, ra1, rb1, 1, lrow, lch);
    __syncthreads();
    g_load(ra1, rb1, ap, bp, k2 + 1, lrow, lch);
    __builtin_amdgcn_sched_barrier(0);
    g_compute(acc, As + 8192, Bs + 8192, wm, wn, lane);
    g_store(As, Bs, ra0, rb0, 0, lrow, lch);
    __syncthreads();
  }
}
template <class E>
DI void gemm_epi(f32x4 (&acc)[4][4], int m0, int n0, E e) {
  const int tid_ = TID();
  const int lane = tid_ & 63, w = tid_ >> 6;
  const int wm = w >> 1, wn = w & 1;
#pragma unroll
  for (int i = 0; i < 4; ++i)
#pragma unroll
    for (int j = 0; j < 4; ++j) {
      int m = m0 + wm * 64 + i * 16 + (lane & 15);
      int n = n0 + wn * 64 + j * 16 + (lane >> 4) * 4;
      e(m, n, acc[i][j]);
    }
}
template <class F>
DI void gemm_epi_staged(f32x4 (&acc)[4][4], int m0, int n0, bf16_t* lds, F f, bf16_t* dst, size_t ld, int nmax) {
  const int tid_ = TID();
  const int lane = tid_ & 63, w = tid_ >> 6;
  const int wm = w >> 1, wn = w & 1;
#pragma unroll
  for (int i = 0; i < 4; ++i)
#pragma unroll
    for (int j = 0; j < 4; ++j) {
      const int ml = wm * 64 + i * 16 + (lane & 15);
      const int nl = wn * 64 + j * 16 + (lane >> 4) * 4;
      f32x4 a = acc[i][j];
      f(m0 + ml, n0 + nl, a);
      uint2 u;
      u.x = pack2(a[0], a[1]);
      u.y = pack2(a[2], a[3]);
      *(uint2*)(lds + ml * 136 + nl) = u;
    }
  __syncthreads();
#pragma unroll
  for (int it = 0; it < 8; ++it) {
    const int idx = tid_ + 256 * it;
    const int row = idx >> 4, ch = idx & 15;
    const u32x4 v = *(const u32x4*)(lds + row * 136 + ch * 8);
    const int n = n0 + ch * 8;
    if (n < nmax) *(u32x4*)(dst + (size_t)(m0 + row) * ld + n) = v;
  }
}
DI void gemm_epi_resid(f32x4 (&acc)[4][4], int m0, int n0, int ntile, bf16_t* lds, const float* xin, float* out, bf16_t* xb, float* rowpart) {
  const int tid_ = TID();
  const int lane = tid_ & 63, w = tid_ >> 6;
  const int wm = w >> 1, wn = w & 1;
  float* red = (float*)lds;
#pragma unroll
  for (int i = 0; i < 4; ++i) {
    const int ml = wm * 64 + i * 16 + (lane & 15);
    const size_t rowoff = (size_t)(m0 + ml) * DM;
    float ss = 0.f;
#pragma unroll
    for (int j = 0; j < 4; ++j) {
      const int n = n0 + wn * 64 + j * 16 + (lane >> 4) * 4;
      const float4 xv = *(const float4*)(xin + rowoff + n);
      const float o0 = xv.x + acc[i][j][0], o1 = xv.y + acc[i][j][1], o2 = xv.z + acc[i][j][2], o3 = xv.w + acc[i][j][3];
      *(float4*)(out + rowoff + n) = make_float4(o0, o1, o2, o3);
      ss += o0 * o0 + o1 * o1 + o2 * o2 + o3 * o3;
      uint2 u;
      u.x = pack2(o0, o1);
      u.y = pack2(o2, o3);
      *(uint2*)(xb + rowoff + n) = u;
    }
    ss += shx(ss, 16, lane);
    ss += shx(ss, 32, lane);
    if ((lane >> 4) == 0) red[wn * 128 + ml] = ss;
  }
  __syncthreads();
  if (tid_ < 128) rowpart[(size_t)ntile * T_TOK + m0 + tid_] = red[tid_] + red[128 + tid_];
}
DI void row_rs(float (&rsv)[4], const float* rowpart, int m0) {
  const int tid_ = TID();
  const int lane = tid_ & 63, wm = tid_ >> 7;
#pragma unroll
  for (int i = 0; i < 4; ++i) {
    const int m = m0 + wm * 64 + i * 16 + (lane & 15);
    float s = 0.f;
#pragma unroll
    for (int t = 0; t < 8; ++t) s += rowpart[(size_t)t * T_TOK + m];
    rsv[i] = rsqrtf(s * (1.f / 1024.f) + 1e-6f);
  }
}
DI void scale_rows(f32x4 (&acc)[4][4], const float (&rsv)[4]) {
#pragma unroll
  for (int i = 0; i < 4; ++i)
#pragma unroll
    for (int j = 0; j < 4; ++j) acc[i][j] *= rsv[i];
}
DI void zero_acc(f32x4 (&acc)[4][4]) {
#pragma unroll
  for (int i = 0; i < 4; ++i)
#pragma unroll
    for (int j = 0; j < 4; ++j) acc[i][j] = f32x4{0.f, 0.f, 0.f, 0.f};
}
struct RowPtr {
  const bf16_t* base; size_t ld;
  DI const bf16_t* operator()(int r, int kb) const { return base + (size_t)r * ld + kb * 64; }
};

DI void convert_wt(const float* W, bf16_t* Wt, int K, int N, int Npad, int gtid, int gthreads, const float* gk = nullptr) {
  const int k8n = K >> 3;
  const long total = (long)Npad * k8n;
  for (long idx = gtid; idx < total; idx += gthreads) {
    int n = (int)(idx % Npad);
    int k8 = (int)(idx / Npad);
    uint4 o = make_uint4(0, 0, 0, 0);
    if (n < N) {
      const float* s = W + (size_t)(k8 * 8) * N + n;
      float v0 = s[0], v1 = s[(size_t)N], v2 = s[(size_t)2 * N], v3 = s[(size_t)3 * N];
      float v4 = s[(size_t)4 * N], v5 = s[(size_t)5 * N], v6 = s[(size_t)6 * N], v7 = s[(size_t)7 * N];
      if (gk) {
        const float* gp = gk + k8 * 8;
        v0 *= gp[0]; v1 *= gp[1]; v2 *= gp[2]; v3 *= gp[3]; v4 *= gp[4]; v5 *= gp[5]; v6 *= gp[6]; v7 *= gp[7];
      }
      o = make_uint4(pack2(v0, v1), pack2(v2, v3), pack2(v4, v5), pack2(v6, v7));
    }
    *(uint4*)(Wt + (size_t)n * K + k8 * 8) = o;
  }
}

DI void phase0(const Params& p, const int L, bf16_t* lds) {
  bf16_t* wl = (bf16_t*)(p.ws + O_WT);
  {
    bf16_t* T = lds;
    const int tid = TID();
    const int half = HALF();
    for (int pr = (int)blockIdx.x; pr < 2256; pr += (int)gridDim.x) {
      int t = 2 * pr + half;
      const float* W; bf16_t* Wt; int K, N; const float* gk = nullptr;
      if (t < 1376) { W = p.w_in + (size_t)L * 1024 * 5400; Wt = wl + W_IN; K = 1024; N = 5400; }
      else if ((t -= 1376) < 128) { W = p.cmp_w1_k + (size_t)L * 2048 * 256; Wt = wl + W_C1K; K = 2048; N = 256; }
      else if ((t -= 128) < 128) { W = p.cmp_w1_v + (size_t)L * 2048 * 256; Wt = wl + W_C1V; K = 2048; N = 256; }
      else if ((t -= 128) < 128) { W = p.w_up_nsa + (size_t)L * 512 * 1024; Wt = wl + W_UPA; K = 512; N = 1024; }
      else if ((t -= 128) < 128) { W = p.w_up_ret + (size_t)L * 512 * 1024; Wt = wl + W_UPR; K = 512; N = 1024; }
      else if ((t -= 128) < 256) { W = p.w_out + (size_t)L * 1024 * 1024; Wt = wl + W_OUT; K = 1024; N = 1024; }
      else if ((t -= 256) < 1024) { W = p.w_ff1 + (size_t)L * 1024 * 4096; Wt = wl + W_FF1; K = 1024; N = 4096; gk = p.norm_mlp + L * DM; }
      else if ((t -= 1024) < 1024) { W = p.w_ff2 + (size_t)L * 4096 * 1024; Wt = wl + W_FF2; K = 4096; N = 1024; }
      else if ((t -= 1024) < 64) { W = p.w_ple + (size_t)L * 256 * 1024; Wt = wl + W_PLE; K = 256; N = 1024; }
      else { t -= 64; W = p.w_ple_gate + (size_t)L * 1024 * 1024; Wt = wl + W_PG; K = 1024; N = 1024; gk = p.norm_ple + L * DM; }
      const int nkt = K >> 6;
      const int nt = t / nkt, kt = t - nt * nkt;
      const int k0 = kt * 64, n0 = nt * 64;
      __syncthreads();
      {
        const int c4 = tid & 15, n = n0 + c4 * 4;
#pragma unroll
        for (int i = 0; i < 4; ++i) {
          const int k = (tid >> 4) + 16 * i;
          float4 v = make_float4(0.f, 0.f, 0.f, 0.f);
          if (n < N) v = *(const float4*)(W + (size_t)(k0 + k) * N + n);
          if (gk) { const float g = gk[k0 + k]; v.x *= g; v.y *= g; v.z *= g; v.w *= g; }
          T[(c4 * 4 + 0) * 66 + k] = f2bf(v.x);
          T[(c4 * 4 + 1) * 66 + k] = f2bf(v.y);
          T[(c4 * 4 + 2) * 66 + k] = f2bf(v.z);
          T[(c4 * 4 + 3) * 66 + k] = f2bf(v.w);
        }
      }
      __syncthreads();
      {
        const int n = tid >> 2, kc = tid & 3;
        const unsigned* s32 = (const unsigned*)(T + n * 66 + kc * 16);
        u32x4 o0, o1;
        o0.x = s32[0]; o0.y = s32[1]; o0.z = s32[2]; o0.w = s32[3];
        o1.x = s32[4]; o1.y = s32[5]; o1.z = s32[6]; o1.w = s32[7];
        bf16_t* dst = Wt + (size_t)(n0 + n) * K + k0 + kc * 16;
        *(u32x4*)dst = o0;
        *(u32x4*)(dst + 8) = o1;
      }
    }
  }
  const int gtid = VBID * 256 + TID();
  const int gthreads = NVB * 256;
  if (L == 0) {
    float2* rope = (float2*)(p.ws + O_ROPE);
    for (int idx = gtid; idx < SEQ * 64; idx += gthreads) {
      int pos = idx >> 6, j = idx & 63;
      float inv = exp2f(-(float)j * (13.287712379549449f / 64.f));
      float ang = (float)pos * inv;
      double rev = (double)ang * 0.15915494309189535;
      rev -= rint(rev);
      float fr = (float)rev;
      rope[idx] = make_float2(__builtin_amdgcn_cosf(fr), __builtin_amdgcn_sinf(fr));
    }
  }
  float* part = (float*)(p.ws + O_HID);
  {
    const int n = gtid & 255;
    for (int item = VBID; item < 128; item += NVB) {
      const int kv = item >> 6, kc = item & 63;
      const float* pos = (kv ? p.cmp_pos_v : p.cmp_pos_k) + L * 2048 + kc * 32;
      const float* w1 = (kv ? p.cmp_w1_v : p.cmp_w1_k) + (size_t)L * 2048 * 256 + (size_t)kc * 32 * 256;
      float a = 0.f;
#pragma unroll 8
      for (int k = 0; k < 32; ++k) a += pos[k] * w1[(size_t)k * 256 + n];
      part[item * 256 + n] = a;
    }
  }
}

DI void norm_phase(const float* xin, const float* g, bf16_t* h) {
  const int tid_ = TID();
  const int lane = tid_ & 63;
  const int gw = (VBID * 256 + tid_) >> 6;
  const int nw = NVB * 4;
  float4 gv[4];
#pragma unroll
  for (int i = 0; i < 4; ++i) gv[i] = ((const float4*)g)[i * 64 + lane];
  for (int row = gw; row < T_TOK; row += nw) {
    const float4* xr = (const float4*)(xin + (size_t)row * DM);
    float4 v[4];
    float ss = 0.f;
#pragma unroll
    for (int i = 0; i < 4; ++i) {
      v[i] = xr[i * 64 + lane];
      ss += v[i].x * v[i].x + v[i].y * v[i].y + v[i].z * v[i].z + v[i].w * v[i].w;
    }
    ss = wave_sum(ss, lane);
    float rs = rsqrtf(ss * (1.f / 1024.f) + 1e-6f);
    uint2* hr = (uint2*)(h + (size_t)row * DM);
#pragma unroll
    for (int i = 0; i < 4; ++i) {
      uint2 o;
      o.x = pack2(v[i].x * rs * gv[i].x, v[i].y * rs * gv[i].y);
      o.y = pack2(v[i].z * rs * gv[i].z, v[i].w * rs * gv[i].w);
      hr[i * 64 + lane] = o;
    }
  }
}

DI void post_z(const Params& p, int layer) {
  const int tid_ = TID();
  const int lane = tid_ & 63;
  const int gw = (VBID * 256 + tid_) >> 6;
  const int nw = NVB * 4;
  bf16_t* z = (bf16_t*)(p.ws + O_Z);
  bf16_t* vsT = (bf16_t*)(p.ws + O_VST);
  bf16_t* vwT = (bf16_t*)(p.ws + O_VWT);
  bf16_t* rvT = (bf16_t*)(p.ws + O_RVT);
  bf16_t* kzT = (bf16_t*)(p.ws + O_KZT);
  const float2* rope = (const float2*)(p.ws + O_ROPE);
  const float* qn = p.nsa_q_norm + layer * 64;
  const float* kn = p.nsa_k_norm + layer * 64;
  {
    const float* part = (const float*)(p.ws + O_HID);
    float* bias = (float*)(p.ws + O_BIAS);
    const int idx = VBID * 256 + tid_;
    if (idx < 512) {
      const int kv = idx >> 8, n = idx & 255;
      float a = 0.f;
      for (int kc = 0; kc < 64; ++kc) a += part[(kv * 64 + kc) * 256 + n];
      bias[idx] = a;
    }
  }
  for (int item = gw; item < 1024 * 36; item += nw) {
    const int tc = item / 36, slab = item - tc * 36;
    const int tok0 = tc * 32;
    const int b = tok0 >> 13, spos = tok0 & 8191;
    bf16_t* zr = z + (size_t)tok0 * ZS;
    if (slab >= 32) {
      const int s4 = slab - 32, kv = s4 >> 1, gi = s4 & 1;
      const int colbase = (kv ? C_VC : C_KC) + gi * 64;
      bf16_t* dst = (bf16_t*)(p.ws + O_KVD) + ((size_t)((kv * 8 + b * 2 + gi) * SEQ + spos)) * 64 + lane;
      bf16_t u[32];
#pragma unroll
      for (int i = 0; i < 32; ++i) u[i] = zr[(size_t)i * ZS + colbase + lane];
#pragma unroll
      for (int i = 0; i < 32; ++i) dst[i * 64] = u[i];
    } else if (slab < 12) {
      int colbase; const float* g; float sc;
      if (slab < 8) { colbase = C_Q + slab * 64; g = qn; sc = 0.125f; }
      else if (slab < 10) { colbase = C_KS + (slab - 8) * 64; g = kn; sc = 1.f; }
      else { colbase = C_KW + (slab - 10) * 64; g = kn; sc = 1.f; }
      const float gv = g[lane] * sc;
      float v[32];
#pragma unroll
      for (int i = 0; i < 32; ++i) v[i] = bf2f(zr[(size_t)i * ZS + colbase + lane]);
#pragma unroll
      for (int i = 0; i < 32; ++i) {
        float ss = wave_sum(v[i] * v[i], lane);
        float rs = rsqrtf(ss * (1.f / 64.f) + 1e-6f);
        zr[(size_t)i * ZS + colbase + lane] = f2bf(v[i] * rs * gv);
      }
    } else if (slab < 16 || slab >= 24) {
      int colbase; bf16_t* dst;
      if (slab < 16) {
        const int gi = slab & 1;
        const bool isw = slab >= 14;
        colbase = (isw ? C_VW : C_VS) + gi * 64;
        dst = (isw ? vwT : vsT) + ((size_t)((b * 2 + gi) * 64 + lane)) * TS + spos;
      } else {
        const int s8 = slab - 24;
        const int h = s8 >> 1, half = s8 & 1;
        colbase = C_RV + s8 * 64;
        dst = rvT + ((size_t)((b * 4 + h) * 128 + half * 64 + lane)) * TS + spos;
      }
      unsigned u[32];
#pragma unroll
      for (int i = 0; i < 32; ++i) u[i] = zr[(size_t)i * ZS + colbase + lane];
#pragma unroll
      for (int q4 = 0; q4 < 4; ++q4)
        *(uint4*)(dst + q4 * 8) = make_uint4(u[q4 * 8 + 0] | (u[q4 * 8 + 1] << 16), u[q4 * 8 + 2] | (u[q4 * 8 + 3] << 16),
                                             u[q4 * 8 + 4] | (u[q4 * 8 + 5] << 16), u[q4 * 8 + 6] | (u[q4 * 8 + 7] << 16));
    } else if (slab < 20) {
      const int h = slab - 16;
      const int colbase = C_RQ + h * 128;
      float x1[32], x2[32];
#pragma unroll
      for (int i = 0; i < 32; ++i) {
        const bf16_t* p1 = zr + (size_t)i * ZS + colbase + lane;
        x1[i] = bf2f(p1[0]);
        x2[i] = bf2f(p1[64]);
      }
#pragma unroll
      for (int i = 0; i < 32; ++i) {
        bf16_t* p1 = zr + (size_t)i * ZS + colbase + lane;
        float2 cs = rope[(spos + i) * 64 + lane];
        p1[0] = f2bf(x1[i] * cs.x - x2[i] * cs.y);
        p1[64] = f2bf(x1[i] * cs.y + x2[i] * cs.x);
      }
    } else {
      const int h = slab - 20;
      const int colbase = C_RK + h * 128;
      const float lg2 = log2f(1.f - exp2f(-5.f - (float)h));
      float x1[32], x2[32];
#pragma unroll
      for (int i = 0; i < 32; ++i) {
        const bf16_t* p1 = zr + (size_t)i * ZS + colbase + lane;
        x1[i] = bf2f(p1[0]);
        x2[i] = bf2f(p1[64]);
      }
      unsigned u1[32], u2[32];
#pragma unroll
      for (int i = 0; i < 32; ++i) {
        bf16_t* p1 = zr + (size_t)i * ZS + colbase + lane;
        float2 cs = rope[(spos + i) * 64 + lane];
        float o1 = (x1[i] * cs.x - x2[i] * cs.y) * 0.08838834764831845f;
        float o2 = (x1[i] * cs.y + x2[i] * cs.x) * 0.08838834764831845f;
        p1[0] = f2bf(o1);
        p1[64] = f2bf(o2);
        float zeta = exp2f(lg2 * (float)(127 - ((spos + i) & 127)));
        u1[i] = f2bf(o1 * zeta);
        u2[i] = f2bf(o2 * zeta);
      }
      bf16_t* d1 = kzT + ((size_t)((b * 4 + h) * 128 + lane)) * TS + spos;
#pragma unroll
      for (int q4 = 0; q4 < 4; ++q4) {
        *(uint4*)(d1 + q4 * 8) = make_uint4(u1[q4 * 8 + 0] | (u1[q4 * 8 + 1] << 16), u1[q4 * 8 + 2] | (u1[q4 * 8 + 3] << 16),
                                            u1[q4 * 8 + 4] | (u1[q4 * 8 + 5] << 16), u1[q4 * 8 + 6] | (u1[q4 * 8 + 7] << 16));
        *(uint4*)(d1 + (size_t)64 * TS + q4 * 8) = make_uint4(u2[q4 * 8 + 0] | (u2[q4 * 8 + 1] << 16), u2[q4 * 8 + 2] | (u2[q4 * 8 + 3] << 16),
                                                              u2[q4 * 8 + 4] | (u2[q4 * 8 + 5] << 16), u2[q4 * 8 + 6] | (u2[q4 * 8 + 7] << 16));
      }
    }
  }
}

DI void phase4b(const Params& p, int layer) {
  const int tid_ = TID();
  const int lane = tid_ & 63;
  const int gw = (VBID * 256 + tid_) >> 6;
  const int nw = NVB * 4;
  bf16_t* z = (bf16_t*)(p.ws + O_Z);
  const bf16_t* hid = (const bf16_t*)(p.ws + O_HID);
  bf16_t* kcmp = (bf16_t*)(p.ws + O_KCMP);
  bf16_t* vcmpT = (bf16_t*)(p.ws + O_VCMPT);
  const float* kn = p.nsa_k_norm + layer * 64;
  for (int item = gw; item < 8192; item += nw) {
    const int kv = item >> 12, row = item & 4095;
    const bf16_t* hrow = hid + ((size_t)kv * 4096 + row) * 256;
    const float* w2 = (kv ? p.cmp_w2_v : p.cmp_w2_k) + (size_t)layer * 256 * 64;
    float acc = 0.f;
    for (int k8 = 0; k8 < 32; ++k8) {
      uint4 hv = *(const uint4*)(hrow + k8 * 8);
      const float* wr = w2 + (size_t)(k8 * 8) * 64 + lane;
      acc += bflo(hv.x) * wr[0];
      acc += bfhi(hv.x) * wr[64];
      acc += bflo(hv.y) * wr[128];
      acc += bfhi(hv.y) * wr[192];
      acc += bflo(hv.z) * wr[256];
      acc += bfhi(hv.z) * wr[320];
      acc += bflo(hv.w) * wr[384];
      acc += bfhi(hv.w) * wr[448];
    }
    if (kv == 0) {
      float ss = wave_sum(acc * acc, lane);
      float rs = rsqrtf(ss * (1.f / 64.f) + 1e-6f);
      kcmp[(size_t)row * 64 + lane] = f2bf(acc * rs * kn[lane]);
    } else {
      const int bg = row >> 9, c = row & 511;
      vcmpT[((size_t)(bg * 64 + lane)) * 512 + c] = f2bf(acc);
    }
  }
  const int gtid = VBID * 256 + tid_;
  const int gthreads = NVB * 256;
  for (int idx = gtid; idx < 65536; idx += gthreads) {
    const int d4 = idx & 31, e = (idx >> 5) & 127, h = (idx >> 12) & 3, b = idx >> 14;
    const float lg2 = log2f(1.f - exp2f(-5.f - (float)h));
    const float gch = exp2f(lg2 * 128.f);
    float r0 = 0.f, r1 = 0.f, r2 = 0.f, r3 = 0.f;
    bf16_t* ptr = z + ((size_t)(b * SEQ + e)) * ZS + C_RV + h * 128 + d4 * 4;
    for (int c0 = 0; c0 < 64; c0 += 16) {
      typedef __attribute__((ext_vector_type(2))) unsigned u32x2;
      u32x2 v[16];
#pragma unroll
      for (int i = 0; i < 16; ++i) v[i] = *(const u32x2*)(ptr + (size_t)(c0 + i) * 128 * ZS);
#pragma unroll
      for (int i = 0; i < 16; ++i) {
        u32x2 o;
        o.x = pack2(r0, r1);
        o.y = pack2(r2, r3);
        *(u32x2*)(ptr + (size_t)(c0 + i) * 128 * ZS) = o;
        r0 = gch * r0 + bflo(v[i].x);
        r1 = gch * r1 + bfhi(v[i].x);
        r2 = gch * r2 + bflo(v[i].y);
        r3 = gch * r3 + bfhi(v[i].y);
      }
    }
  }
}


DI void tile64_gload(int tid, u32x4& r0, u32x4& r1, const bf16_t* base, size_t stride) {
  {
    int idx = tid;
    int row = idx >> 3, ch = idx & 7;
    r0 = *(const u32x4*)(base + (size_t)row * stride + ch * 8);
  }
  {
    int idx = tid + 256;
    int row = idx >> 3, ch = idx & 7;
    r1 = *(const u32x4*)(base + (size_t)row * stride + ch * 8);
  }
}
DI void tile64_sstore(int tid, bf16_t* dst, const u32x4& r0, const u32x4& r1) {
  {
    int idx = tid;
    int row = idx >> 3, ch = idx & 7;
    *(u32x4*)(dst + row * 64 + ((ch ^ ((row >> 1) & 7)) << 3)) = r0;
  }
  {
    int idx = tid + 256;
    int row = idx >> 3, ch = idx & 7;
    *(u32x4*)(dst + row * 64 + ((ch ^ ((row >> 1) & 7)) << 3)) = r1;
  }
}

struct AttnSt { f32x4 O[2][4]; f32x4 L[2]; float m[2]; float l[2]; };

template <int MODE, bool FX>
DI void attn_compute(const int lane, const bf16_t* Ks, const bf16_t* Vs, const bf16x8 (&qf)[2][2], AttnSt& st, const float (&invl)[2],
                     int lo, int hi, float (&impA)[4], float (&impE)[4], const float CL) {
  const int quad = lane >> 4, col = lane & 15;
  f32x4 S[4][2];
#pragma unroll
  for (int kt = 0; kt < 4; ++kt)
#pragma unroll
    for (int hh = 0; hh < 2; ++hh) S[kt][hh] = f32x4{0.f, 0.f, 0.f, 0.f};
#pragma unroll
  for (int ks = 0; ks < 2; ++ks) {
#pragma unroll
    for (int kt = 0; kt < 4; ++kt) {
      int row = kt * 16 + col;
      bf16x8 kf = *(const bf16x8*)(Ks + row * 64 + (((ks * 4 + quad) ^ ((row >> 1) & 7)) << 3));
#pragma unroll
      for (int hh = 0; hh < 2; ++hh) S[kt][hh] = mfma16(kf, qf[hh][ks], S[kt][hh]);
    }
  }
  bf16x8 pf[2][2];
  const bool full = (lo <= 0) && (hi >= 63);
  const bool none = (hi < 0) || (lo > 63) || (hi < lo);
  if (__all(full || none)) {
    constexpr float L2E = 1.4426950408889634f;
#pragma unroll
    for (int hh = 0; hh < 2; ++hh) {
      float mL;
      float il = 1.f;
      if (FX) {
        mL = full ? CL : 1e30f;
        if (MODE == 1) il = invl[hh];
      } else if (MODE != 1) {
        float mx = -1e30f;
#pragma unroll
        for (int kt = 0; kt < 4; ++kt)
#pragma unroll
          for (int j = 0; j < 4; ++j) mx = fmaxf(mx, S[kt][hh][j]);
        mx = full ? mx : -1e30f;
        mx = fmaxf(mx, shx(mx, 16, lane));
        mx = fmaxf(mx, shx(mx, 32, lane));
        const float m_new = fmaxf(st.m[hh], mx);
        const float alpha = __expf(st.m[hh] - m_new);
        st.m[hh] = m_new;
        st.l[hh] *= alpha;
        if (MODE == 2) {
#pragma unroll
          for (int dt = 0; dt < 4; ++dt) st.O[hh][dt] *= alpha;
        }
        mL = full ? m_new * L2E : 1e30f;
      } else {
        mL = full ? st.m[hh] * L2E : 1e30f;
        il = invl[hh];
      }
      float rs = 0.f;
#pragma unroll
      for (int kt = 0; kt < 4; ++kt) {
        float a = 0.f;
#pragma unroll
        for (int j = 0; j < 4; ++j) {
          float pv = __builtin_amdgcn_exp2f(fmaf(S[kt][hh][j], L2E, -mL));
          if (MODE == 1) pv *= il;
          S[kt][hh][j] = pv;
          a += pv;
        }
        rs += a;
        if (MODE == 1) {
          impA[kt] += a;
          impE[kt] += S[kt][hh][3];
        }
      }
      if (MODE != 1 && !(FX && MODE == 2)) st.l[hh] += rs;
      if (MODE != 0) {
#pragma unroll
        for (int c = 0; c < 2; ++c)
          pf[hh][c] = mk8(pack2(S[2 * c][hh][0], S[2 * c][hh][1]), pack2(S[2 * c][hh][2], S[2 * c][hh][3]),
                          pack2(S[2 * c + 1][hh][0], S[2 * c + 1][hh][1]), pack2(S[2 * c + 1][hh][2], S[2 * c + 1][hh][3]));
      }
    }
  } else {
#pragma unroll
  for (int hh = 0; hh < 2; ++hh) {
    if (FX) {
      constexpr float L2E = 1.4426950408889634f;
      const float il = (MODE == 1) ? invl[hh] : 1.f;
      float rs = 0.f;
#pragma unroll
      for (int kt = 0; kt < 4; ++kt) {
        float a = 0.f;
#pragma unroll
        for (int j = 0; j < 4; ++j) {
          const int kl = kt * 16 + quad * 4 + j;
          const bool v = (kl >= lo) && (kl <= hi);
          float pv = v ? __builtin_amdgcn_exp2f(fmaf(S[kt][hh][j], L2E, -CL)) : 0.f;
          if (MODE == 1) pv *= il;
          S[kt][hh][j] = pv;
          a += pv;
        }
        rs += a;
        if (MODE == 1) {
          impA[kt] += a;
          impE[kt] += S[kt][hh][3];
        }
      }
      if (MODE != 1 && !(FX && MODE == 2)) st.l[hh] += rs;
      if (MODE != 0) {
#pragma unroll
        for (int c = 0; c < 2; ++c)
          pf[hh][c] = mk8(pack2(S[2 * c][hh][0], S[2 * c][hh][1]), pack2(S[2 * c][hh][2], S[2 * c][hh][3]),
                          pack2(S[2 * c + 1][hh][0], S[2 * c + 1][hh][1]), pack2(S[2 * c + 1][hh][2], S[2 * c + 1][hh][3]));
      }
      continue;
    }
    float mx = -1e30f;
#pragma unroll
    for (int kt = 0; kt < 4; ++kt)
#pragma unroll
      for (int j = 0; j < 4; ++j) {
        int kl = kt * 16 + quad * 4 + j;
        bool v = (kl >= lo) && (kl <= hi);
        float sv = v ? S[kt][hh][j] : -1e30f;
        S[kt][hh][j] = sv;
        mx = fmaxf(mx, sv);
      }
    if (MODE != 1) {
      mx = fmaxf(mx, shx(mx, 16, lane));
      mx = fmaxf(mx, shx(mx, 32, lane));
      float m_new = fmaxf(st.m[hh], mx);
      float alpha = __expf(st.m[hh] - m_new);
      st.m[hh] = m_new;
      float rs = 0.f;
#pragma unroll
      for (int kt = 0; kt < 4; ++kt)
#pragma unroll
        for (int j = 0; j < 4; ++j) {
          float sv = S[kt][hh][j];
          float pv = (sv > -1e29f) ? __expf(sv - m_new) : 0.f;
          rs += pv;
          S[kt][hh][j] = pv;
        }
      st.l[hh] = st.l[hh] * alpha + rs;
      if (MODE == 2) {
#pragma unroll
        for (int dt = 0; dt < 4; ++dt) st.O[hh][dt] *= alpha;
      }
    } else {
      const float mh = st.m[hh], il = invl[hh];
#pragma unroll
      for (int kt = 0; kt < 4; ++kt) {
        float a = 0.f;
#pragma unroll
        for (int j = 0; j < 4; ++j) {
          float sv = S[kt][hh][j];
          float pv = (sv > -1e29f) ? __expf(sv - mh) * il : 0.f;
          S[kt][hh][j] = pv;
          a += pv;
        }
        impA[kt] += a;
        impE[kt] += S[kt][hh][3];
      }
    }
    if (MODE != 0) {
#pragma unroll
      for (int c = 0; c < 2; ++c)
        pf[hh][c] = mk8(pack2(S[2 * c][hh][0], S[2 * c][hh][1]), pack2(S[2 * c][hh][2], S[2 * c][hh][3]),
                        pack2(S[2 * c + 1][hh][0], S[2 * c + 1][hh][1]), pack2(S[2 * c + 1][hh][2], S[2 * c + 1][hh][3]));
    }
  }
  }
  if (MODE != 0) {
#pragma unroll
    for (int dt = 0; dt < 4; ++dt) {
      const int row = dt * 16 + col;
      const int sw = (row >> 1) & 7;
#pragma unroll
      for (int c = 0; c < 2; ++c) {
        uint2 a = *(const uint2*)(Vs + row * 64 + (((4 * c + (quad >> 1)) ^ sw) << 3) + (quad & 1) * 4);
        uint2 b = *(const uint2*)(Vs + row * 64 + (((4 * c + 2 + (quad >> 1)) ^ sw) << 3) + (quad & 1) * 4);
        bf16x8 vf = mk8(a.x, a.y, b.x, b.y);
#pragma unroll
        for (int hh = 0; hh < 2; ++hh) st.O[hh][dt] = mfma16(vf, pf[hh][c], st.O[hh][dt]);
      }
    }
    if (FX && MODE == 2) {
      const bf16x8 ones = mk8(0x3F803F80u, 0x3F803F80u, 0x3F803F80u, 0x3F803F80u);
#pragma unroll
      for (int c = 0; c < 2; ++c)
#pragma unroll
        for (int hh = 0; hh < 2; ++hh) st.L[hh] = mfma16(ones, pf[hh][c], st.L[hh]);
    }
  }
}

DI void st_reset(AttnSt& st) {
#pragma unroll
  for (int h = 0; h < 2; ++h) {
    st.m[h] = -1e30f;
    st.l[h] = 0.f;
    st.L[h] = f32x4{0.f, 0.f, 0.f, 0.f};
#pragma unroll
    for (int dt = 0; dt < 4; ++dt) st.O[h][dt] = f32x4{0.f, 0.f, 0.f, 0.f};
  }
}

template <bool FIRST>
DI void nsa_flush(const int quad, bf16_t* optr, const AttnSt& st, const float (&sc)[2]) {
#pragma unroll
  for (int h = 0; h < 2; ++h)
#pragma unroll
    for (int dt = 0; dt < 4; ++dt) {
      uint2* q = (uint2*)(optr + h * 64 + dt * 16 + quad * 4);
      f32x4 o = st.O[h][dt] * sc[h];
      if (!FIRST) {
        uint2 pv = *q;
        o[0] += bflo(pv.x); o[1] += bfhi(pv.x); o[2] += bflo(pv.y); o[3] += bfhi(pv.y);
      }
      uint2 u;
      u.x = pack2(o[0], o[1]);
      u.y = pack2(o[2], o[3]);
      *q = u;
    }
}

template <bool FX>
DI void nsa_tile(const Params& p, int b, int g, int tile, bf16_t* lds, const float CL) {
  const int tid = TID(), lane = tid & 63, w = tid >> 6, quad = lane >> 4, col = lane & 15;
  const int cur = tile;
  const int tok = tile * 64 + w * 16 + col;
  bf16_t* z = (bf16_t*)(p.ws + O_Z);
  const bf16_t* kcmp = (const bf16_t*)(p.ws + O_KCMP) + (size_t)(b * 2 + g) * 512 * 64;
  const bf16_t* vcmpT = (const bf16_t*)(p.ws + O_VCMPT) + (size_t)(b * 2 + g) * 64 * 512;
  const bf16_t* vsT = (const bf16_t*)(p.ws + O_VST) + (size_t)(b * 2 + g) * 64 * TS;
  const bf16_t* vwT = (const bf16_t*)(p.ws + O_VWT) + (size_t)(b * 2 + g) * 64 * TS;
  const bf16_t* zb = z + (size_t)b * SEQ * ZS;
  const bf16_t* ztok = z + ((size_t)(b * SEQ + tok)) * ZS;
  bf16_t* otok = (bf16_t*)(p.ws + O_ONSA) + ((size_t)(b * SEQ + tok)) * 512 + g * 256;
  bf16_t* Ks = lds;
  bf16_t* Vs = lds + 4096;
  float* impl = (float*)(lds + 8192);

  AttnSt st;
  float invl[2] = {0.f, 0.f};
  float dA[4] = {0.f, 0.f, 0.f, 0.f}, dE[4] = {0.f, 0.f, 0.f, 0.f};
  u32x4 rk0, rk1, rv0, rv1;
  bf16x8 qf[2][2];

  const int ncs = (cur < 16) ? 1 : (cur >> 4) + 1;
  const int chi = (tok >= 31) ? ((tok - 31) >> 4) : -1;

  for (int hp = 0; hp < 2; ++hp) {
#pragma unroll
    for (int hh = 0; hh < 2; ++hh)
#pragma unroll
      for (int ks = 0; ks < 2; ++ks) qf[hh][ks] = *(const bf16x8*)(ztok + C_Q + g * 256 + (hp * 2 + hh) * 64 + ks * 32 + quad * 8);
    st_reset(st);
    tile64_gload(tid, rk0, rk1, kcmp, 64);
    for (int s = 0; s < ncs; ++s) {
      __syncthreads();
      tile64_sstore(tid, Ks, rk0, rk1);
      __syncthreads();
      if (s + 1 < ncs) tile64_gload(tid, rk0, rk1, kcmp + (size_t)(s + 1) * 4096, 64);
      attn_compute<0, FX>(lane, Ks, Vs, qf, st, invl, 0, chi - s * 64, dA, dE, CL);
    }
#pragma unroll
    for (int h = 0; h < 2; ++h) {
      float l = st.l[h];
      l += shx(l, 16, lane);
      l += shx(l, 32, lane);
      invl[h] = (l > 0.f) ? 1.f / l : 0.f;
    }
    {
      float carry = 0.f;
      tile64_gload(tid, rk0, rk1, kcmp, 64);
      tile64_gload(tid, rv0, rv1, vcmpT, 512);
      for (int s = 0; s < ncs; ++s) {
        float iA[4] = {0.f, 0.f, 0.f, 0.f}, iE[4] = {0.f, 0.f, 0.f, 0.f};
        __syncthreads();
        tile64_sstore(tid, Ks, rk0, rk1);
        tile64_sstore(tid, Vs, rv0, rv1);
        __syncthreads();
        if (s + 1 < ncs) {
          tile64_gload(tid, rk0, rk1, kcmp + (size_t)(s + 1) * 4096, 64);
          tile64_gload(tid, rv0, rv1, vcmpT + (s + 1) * 64, 512);
        }
        attn_compute<1, FX>(lane, Ks, Vs, qf, st, invl, 0, chi - s * 64, iA, iE, CL);
#pragma unroll
        for (int kt = 0; kt < 4; ++kt) {
          float recv = shfrom(iE[kt], (lane + 48) & 63);
          float val = iA[kt] + ((quad == 0) ? carry : recv);
          carry = recv;
          float* slot = impl + (s * 4 + kt) * 256 + tid;
          if (hp == 0) *slot = val; else *slot += val;
        }
      }
    }
    {
      float sc[2];
#pragma unroll
      for (int h = 0; h < 2; ++h) sc[h] = sigmoidf(bf2f(ztok[C_GT + 0 * 8 + g * 4 + hp * 2 + h]));
      nsa_flush<true>(quad, otok + hp * 128, st, sc);
    }
  }

  uint32_t sw0, sw1, sw2, sw3;
  {
    uint32_t key[32];
#pragma unroll
    for (int i = 0; i < 32; ++i) {
      int j = i * 4 + quad;
      float sc = (i < ncs * 4) ? impl[i * 256 + tid] : 0.f;
      if (j == 0 || j == cur || j == cur - 1) sc = 1e4f;
      uint32_t k = (__float_as_uint(sc) & ~127u) | (uint32_t)(127 - j);
      key[i] = (j > cur) ? 0u : k;
    }
    uint32_t prev = 0xFFFFFFFFu;
    for (int r = 0; r < 16; ++r) {
      uint32_t mx = 0u;
#pragma unroll
      for (int i = 0; i < 32; ++i) {
        uint32_t k = key[i];
        k = (k < prev) ? k : 0u;
        mx = (k > mx) ? k : mx;
      }
      uint32_t o = shxu(mx, 16, lane);
      mx = (o > mx) ? o : mx;
      o = shxu(mx, 32, lane);
      mx = (o > mx) ? o : mx;
      prev = mx;
    }
    sw0 = 0u; sw1 = 0u; sw2 = 0u; sw3 = 0u;
#pragma unroll
    for (int i = 0; i < 32; ++i) {
      bool sel = (key[i] != 0u) && (key[i] >= prev);
      uint32_t bit = sel ? (1u << ((i & 7) * 4 + quad)) : 0u;
      if ((i >> 3) == 0) sw0 |= bit;
      else if ((i >> 3) == 1) sw1 |= bit;
      else if ((i >> 3) == 2) sw2 |= bit;
      else sw3 |= bit;
    }
    sw0 |= shxu(sw0, 16, lane); sw0 |= shxu(sw0, 32, lane);
    sw1 |= shxu(sw1, 16, lane); sw1 |= shxu(sw1, 32, lane);
    sw2 |= shxu(sw2, 16, lane); sw2 |= shxu(sw2, 32, lane);
    sw3 |= shxu(sw3, 16, lane); sw3 |= shxu(sw3, 32, lane);
  }

  for (int hp = 0; hp < 2; ++hp) {
#pragma unroll
    for (int hh = 0; hh < 2; ++hh)
#pragma unroll
      for (int ks = 0; ks < 2; ++ks) qf[hh][ks] = *(const bf16x8*)(ztok + C_Q + g * 256 + (hp * 2 + hh) * 64 + ks * 32 + quad * 8);
    st_reset(st);
    {
      const bf16_t* kb = zb + C_KS + g * 64;
      tile64_gload(tid, rk0, rk1, kb, ZS);
      tile64_gload(tid, rv0, rv1, vsT, TS);
      for (int s = 0; s <= cur; ++s) {
        __syncthreads();
        tile64_sstore(tid, Ks, rk0, rk1);
        tile64_sstore(tid, Vs, rv0, rv1);
        __syncthreads();
        if (s < cur) {
          tile64_gload(tid, rk0, rk1, kb + (size_t)(s + 1) * 64 * ZS, ZS);
          tile64_gload(tid, rv0, rv1, vsT + (s + 1) * 64, TS);
        }
        uint32_t wsel = (s < 32) ? sw0 : (s < 64) ? sw1 : (s < 96) ? sw2 : sw3;
        bool sel = (wsel >> (s & 31)) & 1u;
        int hi = sel ? (tok - s * 64) : -1;
        if (__any(hi >= 0)) attn_compute<2, FX>(lane, Ks, Vs, qf, st, invl, 0, hi, dA, dE, CL);
      }
    }
    {
      float sc[2];
#pragma unroll
      for (int h = 0; h < 2; ++h) {
        float l;
        if (FX) {
          l = st.L[h][0];
        } else {
          l = st.l[h];
          l += shx(l, 16, lane);
          l += shx(l, 32, lane);
        }
        sc[h] = (l > 0.f) ? sigmoidf(bf2f(ztok[C_GT + 1 * 8 + g * 4 + hp * 2 + h])) / l : 0.f;
      }
      nsa_flush<false>(quad, otok + hp * 128, st, sc);
    }
    st_reset(st);
    {
      const bf16_t* kb = zb + C_KW + g * 64;
      const int s0 = (cur >= 8) ? cur - 8 : 0;
      tile64_gload(tid, rk0, rk1, kb + (size_t)s0 * 64 * ZS, ZS);
      tile64_gload(tid, rv0, rv1, vwT + s0 * 64, TS);
      for (int s = s0; s <= cur; ++s) {
        __syncthreads();
        tile64_sstore(tid, Ks, rk0, rk1);
        tile64_sstore(tid, Vs, rv0, rv1);
        __syncthreads();
        if (s < cur) {
          tile64_gload(tid, rk0, rk1, kb + (size_t)(s + 1) * 64 * ZS, ZS);
          tile64_gload(tid, rv0, rv1, vwT + (s + 1) * 64, TS);
        }
        attn_compute<2, FX>(lane, Ks, Vs, qf, st, invl, tok - 511 - s * 64, tok - s * 64, dA, dE, CL);
      }
    }
    {
      float sc[2];
#pragma unroll
      for (int h = 0; h < 2; ++h) {
        float l;
        if (FX) {
          l = st.L[h][0];
        } else {
          l = st.l[h];
          l += shx(l, 16, lane);
          l += shx(l, 32, lane);
        }
        sc[h] = (l > 0.f) ? sigmoidf(bf2f(ztok[C_GT + 2 * 8 + g * 4 + hp * 2 + h])) / l : 0.f;
      }
      nsa_flush<false>(quad, otok + hp * 128, st, sc);
    }
  }
}

DI void load128(int tid, bf16_t* lds, const bf16_t* base, size_t stride) {
  u32x4 r[8];
#pragma unroll
  for (int i = 0; i < 8; ++i) {
    int idx = tid + 256 * i;
    int row = idx >> 4, ch = idx & 15;
    r[i] = *(const u32x4*)(base + (size_t)row * stride + ch * 8);
  }
#pragma unroll
  for (int i = 0; i < 8; ++i) {
    int idx = tid + 256 * i;
    int row = idx >> 4, ch = idx & 15;
    *(u32x4*)(lds + row * 128 + ((ch ^ (row & 15)) << 3)) = r[i];
  }
}

DI void ret_tile(const Params& p, int b, int h, int c, bf16_t* lds) {
  const int tid = TID(), lane = tid & 63, w = tid >> 6, quad = lane >> 4, col = lane & 15;
  const float lg2 = log2f(1.f - exp2f(-5.f - (float)h));
  bf16_t* z = (bf16_t*)(p.ws + O_Z);
  const bf16_t* rvT = (const bf16_t*)(p.ws + O_RVT);
  bf16_t* zc = z + ((size_t)(b * SEQ + c * 128)) * ZS;
  bf16x8 qf[2][4];
#pragma unroll
  for (int nt = 0; nt < 2; ++nt)
#pragma unroll
    for (int ks = 0; ks < 4; ++ks) {
      int n = 32 * w + nt * 16 + col;
      qf[nt][ks] = *(const bf16x8*)(zc + (size_t)n * ZS + C_RQ + h * 128 + ks * 32 + quad * 8);
    }
  f32x4 acc[8][2];
#pragma unroll
  for (int et = 0; et < 8; ++et)
#pragma unroll
    for (int nt = 0; nt < 2; ++nt) acc[et][nt] = f32x4{0.f, 0.f, 0.f, 0.f};
  __syncthreads();
  load128(tid, lds, zc + C_RV + h * 128, ZS);
  __syncthreads();
#pragma unroll
  for (int ks = 0; ks < 4; ++ks)
#pragma unroll
    for (int et = 0; et < 8; ++et) {
      int row = et * 16 + col;
      bf16x8 af = *(const bf16x8*)(lds + row * 128 + (((ks * 4 + quad) ^ (row & 15)) << 3));
#pragma unroll
      for (int nt = 0; nt < 2; ++nt) acc[et][nt] = mfma16(af, qf[nt][ks], acc[et][nt]);
    }
#pragma unroll
  for (int nt = 0; nt < 2; ++nt) {
    int n = 32 * w + nt * 16 + col;
    float xi = exp2f(lg2 * (float)(n + 1));
#pragma unroll
    for (int et = 0; et < 8; ++et) acc[et][nt] *= xi;
  }
  __syncthreads();
  load128(tid, lds, zc + C_RK + h * 128, ZS);
  __syncthreads();
  bf16x8 pf[2][4];
#pragma unroll
  for (int nt = 0; nt < 2; ++nt) {
    f32x4 s[8];
#pragma unroll
    for (int mt = 0; mt < 8; ++mt) s[mt] = f32x4{0.f, 0.f, 0.f, 0.f};
#pragma unroll
    for (int ks = 0; ks < 4; ++ks)
#pragma unroll
      for (int mt = 0; mt < 8; ++mt) {
        if (mt <= 2 * w + 1) {
          int row = mt * 16 + col;
          bf16x8 af = *(const bf16x8*)(lds + row * 128 + (((ks * 4 + quad) ^ (row & 15)) << 3));
          s[mt] = mfma16(af, qf[nt][ks], s[mt]);
        }
      }
    const int n = 32 * w + nt * 16 + col;
#pragma unroll
    for (int c2 = 0; c2 < 4; ++c2) {
      float v[8];
#pragma unroll
      for (int i = 0; i < 8; ++i) {
        const int mt = 2 * c2 + (i >> 2), j = i & 3;
        const int m = mt * 16 + quad * 4 + j;
        v[i] = (n >= m) ? s[mt][j] * exp2f(lg2 * (float)(n - m)) : 0.f;
      }
      pf[nt][c2] = mk8(pack2(v[0], v[1]), pack2(v[2], v[3]), pack2(v[4], v[5]), pack2(v[6], v[7]));
    }
  }
  __syncthreads();
  load128(tid, lds, rvT + ((size_t)((b * 4 + h) * 128)) * TS + c * 128, TS);
  __syncthreads();
#pragma unroll
  for (int c2 = 0; c2 < 4; ++c2) {
    if (2 * c2 <= 2 * w + 1) {
#pragma unroll
      for (int et = 0; et < 8; ++et) {
        int row = et * 16 + col;
        int sw = row & 15;
        uint2 a = *(const uint2*)(lds + row * 128 + (((4 * c2 + (quad >> 1)) ^ sw) << 3) + (quad & 1) * 4);
        uint2 bb = *(const uint2*)(lds + row * 128 + (((4 * c2 + 2 + (quad >> 1)) ^ sw) << 3) + (quad & 1) * 4);
        bf16x8 vf = mk8(a.x, a.y, bb.x, bb.y);
#pragma unroll
        for (int nt = 0; nt < 2; ++nt) acc[et][nt] = mfma16(vf, pf[nt][c2], acc[et][nt]);
      }
    }
  }
#pragma unroll
  for (int nt = 0; nt < 2; ++nt) {
    float ss = 0.f;
#pragma unroll
    for (int et = 0; et < 8; ++et)
#pragma unroll
      for (int j = 0; j < 4; ++j) ss += acc[et][nt][j] * acc[et][nt][j];
    ss += shx(ss, 16, lane);
    ss += shx(ss, 32, lane);
    const float rs = rsqrtf(ss * (1.f / 128.f) + 1e-6f);
    const int n = 32 * w + nt * 16 + col;
    bf16_t* zr = zc + (size_t)n * ZS;
#pragma unroll
    for (int et = 0; et < 8; ++et) {
      const int e0 = et * 16 + quad * 4;
      uint2 gv = *(const uint2*)(zr + C_RG + h * 128 + e0);
      float g0 = bflo(gv.x), g1 = bfhi(gv.x), g2 = bflo(gv.y), g3 = bfhi(gv.y);
      uint2 o;
      o.x = pack2(acc[et][nt][0] * rs * g0 * sigmoidf(g0), acc[et][nt][1] * rs * g1 * sigmoidf(g1));
      o.y = pack2(acc[et][nt][2] * rs * g2 * sigmoidf(g2), acc[et][nt][3] * rs * g3 * sigmoidf(g3));
      *(uint2*)(zr + C_RQ + h * 128 + e0) = o;
    }
  }
}

#define GEMM_TILE_LOOP(NT)                                                             \
  for (int qp_ = (int)(blockIdx.x >> 3), per_ = (int)(gridDim.x >> 3), xcd_ = (int)(blockIdx.x & 7), q_ = 0, mt = 0, ntile = 0; \
       2 * qp_ < 32 * (NT) && ((q_ = 2 * qp_ + HALF()), (mt = (((xcd_ + 8 * (q_ / (8 * (NT)))) << 3) + ((q_ % (8 * (NT))) & 7)), ntile = ((q_ % (8 * (NT))) >> 3)), true); \
       qp_ += per_)


DI int TID8() { int t = threadIdx.x; asm volatile("" : "+v"(t)); return t; }
DI void g8_load(u32x4 (&ra)[4], u32x4 (&rb)[4], const bf16_t* a, size_t lda, const bf16_t* b, size_t ldb, int kb, int lrow, int lch) {
#pragma unroll
  for (int i = 0; i < 4; ++i) {
    ra[i] = *(const u32x4*)(a + (size_t)(lrow + 64 * i) * lda + kb * 64 + lch * 8);
    rb[i] = *(const u32x4*)(b + (size_t)(lrow + 64 * i) * ldb + kb * 64 + lch * 8);
  }
}
DI void g8_store(bf16_t* S, const u32x4 (&ra)[4], const u32x4 (&rb)[4], int lrow, int lch) {
#pragma unroll
  for (int i = 0; i < 4; ++i) {
    const int r = lrow + 64 * i;
    const int off = r * 64 + ((lch ^ ((r >> 1) & 7)) << 3);
    *(u32x4*)(S + off) = ra[i];
    *(u32x4*)(S + 16384 + off) = rb[i];
  }
}
DI void g8_load1(u32x4 (&r4)[4], const bf16_t* a, size_t lda, int kb, int lrow, int lch) {
  const bf16_t* base = a + kb * 64;
  const unsigned ld32 = (unsigned)lda;
#pragma unroll
  for (int i = 0; i < 4; ++i) {
    const unsigned off = (unsigned)(lrow + 64 * i) * ld32 + (unsigned)(lch * 8);
    r4[i] = *(const u32x4*)(base + off);
  }
}
DI void g8_store1(bf16_t* S, const u32x4 (&r4)[4], int lrow, int lch) {
#pragma unroll
  for (int i = 0; i < 4; ++i) {
    const int r = lrow + 64 * i;
    *(u32x4*)(S + r * 64 + ((lch ^ ((r >> 1) & 7)) << 3)) = r4[i];
  }
}
template <int KS0 = 0, int KS1 = 2>
DI void g8_compute(f32x4 (&acc)[8][4], const bf16_t* S, int wm, int wn, int lane) {
#pragma unroll
  for (int ks = KS0; ks < KS1; ++ks) {
    bf16x8 af[8], bfr[4];
#pragma unroll
    for (int i = 0; i < 8; ++i) {
      const int r = wm * 128 + i * 16 + (lane & 15);
      af[i] = *(const bf16x8*)(S + r * 64 + (((ks * 4 + (lane >> 4)) ^ ((r >> 1) & 7)) << 3));
    }
#pragma unroll
    for (int j = 0; j < 4; ++j) {
      const int r = wn * 64 + j * 16 + (lane & 15);
      bfr[j] = *(const bf16x8*)(S + 16384 + r * 64 + (((ks * 4 + (lane >> 4)) ^ ((r >> 1) & 7)) << 3));
    }
    __builtin_amdgcn_s_setprio(1);
#pragma unroll
    for (int i = 0; i < 8; ++i)
#pragma unroll
      for (int j = 0; j < 4; ++j) acc[i][j] = mfma16(bfr[j], af[i], acc[i][j]);
    __builtin_amdgcn_s_setprio(0);
  }
}
DI void g8_load1o(u32x4 (&r4)[4], const bf16_t* base, const unsigned (&off)[4]) {
#pragma unroll
  for (int i = 0; i < 4; ++i) r4[i] = *(const u32x4*)(base + off[i]);
}
DI void gemm8_accum(f32x4 (&acc)[8][4], const bf16_t* a, size_t lda, const bf16_t* b, size_t ldb, int nkb, bf16_t* L,
                    const bool pre, const bf16_t* an, size_t ldan, const bf16_t* bn, size_t ldbn) {
  const int tid = TID8(), lane = tid & 63, w = tid >> 6;
  const int wm = w >> 2, wn = w & 3;
  const int lrow = tid >> 3, lch = tid & 7;
  u32x4 ra[4], rb[4];
  unsigned offa[4], offb[4];
#pragma unroll
  for (int i = 0; i < 4; ++i) {
    offa[i] = (unsigned)(lrow + 64 * i) * (unsigned)lda + (unsigned)(lch * 8);
    offb[i] = (unsigned)(lrow + 64 * i) * (unsigned)ldb + (unsigned)(lch * 8);
  }
  if (!pre) {
    g8_load1o(ra, a, offa);
    g8_load1o(rb, b, offb);
    __syncthreads();
    g8_store(L, ra, rb, lrow, lch);
  }
  g8_load1o(ra, a + 64, offa);
  g8_load1o(rb, b + 64, offb);
  for (int kb = 0; kb + 2 < nkb; ++kb) {
    __syncthreads();
    g8_store1(L + ((kb + 1) & 1) * 32768, ra, lrow, lch);
    g8_load1o(ra, a + (kb + 2) * 64, offa);
    __builtin_amdgcn_sched_barrier(0);
    g8_compute<0, 1>(acc, L + (kb & 1) * 32768, wm, wn, lane);
    __builtin_amdgcn_sched_barrier(0);
    g8_store1(L + ((kb + 1) & 1) * 32768 + 16384, rb, lrow, lch);
    g8_load1o(rb, b + (kb + 2) * 64, offb);
    __builtin_amdgcn_sched_barrier(0);
    g8_compute<1, 2>(acc, L + (kb & 1) * 32768, wm, wn, lane);
  }
  __syncthreads();
  g8_store1(L + 32768, ra, lrow, lch);
  g8_load1(ra, an, ldan, 0, lrow, lch);
  __builtin_amdgcn_sched_barrier(0);
  g8_compute<0, 1>(acc, L, wm, wn, lane);
  __builtin_amdgcn_sched_barrier(0);
  g8_store1(L + 32768 + 16384, rb, lrow, lch);
  g8_load1(rb, bn, ldbn, 0, lrow, lch);
  __builtin_amdgcn_sched_barrier(0);
  g8_compute<1, 2>(acc, L, wm, wn, lane);
  __syncthreads();
  g8_store1(L, ra, lrow, lch);
  __builtin_amdgcn_sched_barrier(0);
  g8_compute<0, 1>(acc, L + 32768, wm, wn, lane);
  __builtin_amdgcn_sched_barrier(0);
  g8_store1(L + 16384, rb, lrow, lch);
  __builtin_amdgcn_sched_barrier(0);
  g8_compute<1, 2>(acc, L + 32768, wm, wn, lane);
  __syncthreads();
}
DI void zero_acc8(f32x4 (&acc)[8][4]) {
#pragma unroll
  for (int i = 0; i < 8; ++i)
#pragma unroll
    for (int j = 0; j < 4; ++j) acc[i][j] = f32x4{0.f, 0.f, 0.f, 0.f};
}
template <class F>
DI void gemm8_epi_staged(f32x4 (&acc)[8][4], int m0, int n0, bf16_t* L0, F f, bf16_t* dst, size_t ld, int nmax) {
  bf16_t* L = L0 + 32768;
  const int tid = TID8(), lane = tid & 63, w = tid >> 6;
  const int wm = w >> 2, wn = w & 3;
#pragma unroll
  for (int half = 0; half < 2; ++half) {
    if (wm == half) {
#pragma unroll
      for (int i = 0; i < 8; ++i)
#pragma unroll
        for (int j = 0; j < 4; ++j) {
          const int ml = i * 16 + (lane & 15);
          const int nl = wn * 64 + j * 16 + (lane >> 4) * 4;
          f32x4 a = acc[i][j];
          f(m0 + half * 128 + ml, n0 + nl, a);
          uint2 u;
          u.x = pack2(a[0], a[1]);
          u.y = pack2(a[2], a[3]);
          *(uint2*)(L + ml * 264 + nl) = u;
        }
    }
    __syncthreads();
#pragma unroll
    for (int it = 0; it < 8; ++it) {
      const int idx = tid + 512 * it;
      const int row = idx >> 5, ch = idx & 31;
      const u32x4 v = *(const u32x4*)(L + row * 264 + ch * 8);
      const int n = n0 + ch * 8;
      if (n < nmax) *(u32x4*)(dst + (size_t)(m0 + half * 128 + row) * ld + n) = v;
    }
    __syncthreads();
  }
}
DI void gemm8_epi_resid(f32x4 (&acc)[8][4], int m0, int n0, int ntile8, bf16_t* L, const float* xin, float* out, bf16_t* xb, float* rowpart) {
  const int tid = TID8(), lane = tid & 63, w = tid >> 6;
  const int wm = w >> 2, wn = w & 3;
  float* red = (float*)(L + 32768);
#pragma unroll
  for (int i = 0; i < 8; ++i) {
    const int ml = wm * 128 + i * 16 + (lane & 15);
    const size_t rowoff = (size_t)(m0 + ml) * DM;
    float ss = 0.f;
#pragma unroll
    for (int j = 0; j < 4; ++j) {
      const int n = n0 + wn * 64 + j * 16 + (lane >> 4) * 4;
      const float4 xv = *(const float4*)(xin + rowoff + n);
      const float o0 = xv.x + acc[i][j][0], o1 = xv.y + acc[i][j][1], o2 = xv.z + acc[i][j][2], o3 = xv.w + acc[i][j][3];
      *(float4*)(out + rowoff + n) = make_float4(o0, o1, o2, o3);
      ss += o0 * o0 + o1 * o1 + o2 * o2 + o3 * o3;
      uint2 u;
      u.x = pack2(o0, o1);
      u.y = pack2(o2, o3);
      *(uint2*)(xb + rowoff + n) = u;
    }
    ss += shx(ss, 16, lane);
    ss += shx(ss, 32, lane);
    if ((lane >> 4) == 0) red[wn * 256 + ml] = ss;
  }
  __syncthreads();
  {
    const int row = tid & 255, h = tid >> 8;
    rowpart[(size_t)(ntile8 * 2 + h) * T_TOK + m0 + row] = red[(2 * h) * 256 + row] + red[(2 * h + 1) * 256 + row];
  }
}
template <class E>
DI void gemm8_epi(f32x4 (&acc)[8][4], int m0, int n0, E e) {
  const int tid = TID8(), lane = tid & 63, w = tid >> 6;
  const int wm = w >> 2, wn = w & 3;
#pragma unroll
  for (int i = 0; i < 8; ++i)
#pragma unroll
    for (int j = 0; j < 4; ++j) {
      const int m = m0 + wm * 128 + i * 16 + (lane & 15);
      const int n = n0 + wn * 64 + j * 16 + (lane >> 4) * 4;
      e(m, n, acc[i][j]);
    }
}
DI void row_rs8(float (&rsv)[8], const float* rowpart, int m0) {
  const int tid = TID8(), lane = tid & 63, wm = tid >> 8;
#pragma unroll
  for (int i = 0; i < 8; ++i) {
    const int m = m0 + wm * 128 + i * 16 + (lane & 15);
    float s = 0.f;
#pragma unroll
    for (int t = 0; t < 8; ++t) s += rowpart[(size_t)t * T_TOK + m];
    rsv[i] = rsqrtf(s * (1.f / 1024.f) + 1e-6f);
  }
}
DI void scale_rows8(f32x4 (&acc)[8][4], const float (&rsv)[8]) {
#pragma unroll
  for (int i = 0; i < 8; ++i)
#pragma unroll
    for (int j = 0; j < 4; ++j) acc[i][j] *= rsv[i];
}
#define G8_TILE(q, NT8, MT, NTL) \
  MT = (((xcd_ + 8 * ((q) / (4 * (NT8)))) << 2) + (((q) % (4 * (NT8))) & 3)); NTL = (((q) % (4 * (NT8))) >> 2);
#define GEMM8_TILE_LOOP(NT8)                                                            \
  for (int q_ = (int)(blockIdx.x >> 3), per_ = (int)(gridDim.x >> 3), xcd_ = (int)(blockIdx.x & 7), first_ = 1, mt = 0, ntile = 0, mtn = 0, ntilen = 0; \
       q_ < 16 * (NT8) && ([&] { G8_TILE(q_, NT8, mt, ntile) const int qn_ = (q_ + per_ < 16 * (NT8)) ? q_ + per_ : q_; G8_TILE(qn_, NT8, mtn, ntilen) }(), true); \
       q_ += per_, first_ = 0)

#define XB_TMO      128
#define XB_XCNT(j)  (256  + 64 * (j))
#define XB_XSUB(j)  (1280 + 64 * (j))
#define XB_XGEN(j)  (2304 + 64 * (j))
#define XB_TOP      3328
#define XB_TOPGEN   3392
#define XB_SPIN_CAP (1u << 20)
DI unsigned xb_ld(unsigned* p) { return __hip_atomic_load(p, __ATOMIC_RELAXED, __HIP_MEMORY_SCOPE_AGENT); }
DI unsigned xb_add(unsigned* p, unsigned v) { return __hip_atomic_fetch_add(p, v, __ATOMIC_RELAXED, __HIP_MEMORY_SCOPE_AGENT); }
DI unsigned xb_xcc_id() { return (unsigned)__builtin_amdgcn_s_getreg((3 << 11) | 20) & 0xFu; }
#define XB_SPIN(cond, bar) do { unsigned _sp = 0; while (cond) { __builtin_amdgcn_s_sleep(1); \
    if ((++_sp & 255u) == 0u) { if (xb_ld(&(bar)[XB_TMO])) break; if (_sp > XB_SPIN_CAP) { atomicAdd(&(bar)[XB_TMO], 1u); break; } } } } while (0)

DI void xcd_barrier(unsigned* bar, const unsigned x, const unsigned nloc, const unsigned nx) {
  asm volatile("s_waitcnt vmcnt(0)" ::: "memory");
  __syncthreads();
  if (threadIdx.x == 0) {
    __builtin_amdgcn_s_waitcnt(0);
    const unsigned old = xb_add(&bar[XB_XSUB(x)], 1u);
    const unsigned gen = old / nloc;
    if (old + 1u == (gen + 1u) * nloc) {
      __builtin_amdgcn_fence(__ATOMIC_RELEASE, "agent");
      asm volatile("s_waitcnt vmcnt(0)" ::: "memory");
      const unsigned og = xb_add(&bar[XB_TOP], 1u);
      const unsigned tg = og / nx;
      if (og + 1u == (tg + 1u) * nx) xb_add(&bar[XB_TOPGEN], 1u);
      else XB_SPIN(xb_ld(&bar[XB_TOPGEN]) == tg, bar);
      __builtin_amdgcn_fence(__ATOMIC_ACQUIRE, "agent");
      xb_add(&bar[XB_XGEN(x)], 1u);
      asm volatile("s_waitcnt vmcnt(0)" ::: "memory");
    } else {
      XB_SPIN(xb_ld(&bar[XB_XGEN(x)]) == gen, bar);
      __builtin_amdgcn_fence(__ATOMIC_ACQUIRE, "agent");
      asm volatile("s_waitcnt vmcnt(0)" ::: "memory");
    }
  }
  __syncthreads();
}

__global__ void __launch_bounds__(512, 2) mega(Params p) {
  extern __shared__ __attribute__((aligned(16))) bf16_t lds_all[];
  bf16_t* lds = lds_all + HALF() * 32768;
  cg::grid_group grid = cg::this_grid();
  const int nb = NVB;
  bf16_t* wt = (bf16_t*)(p.ws + O_WT);
  bf16_t* z = (bf16_t*)(p.ws + O_Z);
  bf16_t* hbuf = (bf16_t*)(p.ws + O_VST);
  bf16_t* ubuf = z;
  bf16_t* p16 = (bf16_t*)(p.ws + O_KVD);
  float* rowpart = (float*)(p.ws + O_RP);
  bf16_t* hid = (bf16_t*)(p.ws + O_HID);
  const float* bias = (const float*)(p.ws + O_BIAS);

  unsigned* bar = (unsigned*)(p.ws + O_BAR);
  const unsigned xb_x = xb_xcc_id();
  if (threadIdx.x == 0) (void)xb_add(&bar[XB_XCNT(xb_x)], 1u);
  unsigned xb_nloc = 1u, xb_nx = 1u;

  for (int layer = 0; layer < 2; ++layer) {
    const bf16_t* wl = wt;
    const float* xin = (layer == 0) ? p.x : p.out;

    phase0(p, layer, lds);
    norm_phase(xin, p.norm_mix + layer * DM, hbuf);
    if (layer == 0) {
      grid.sync();
      unsigned mine = 0u, cnt = 0u;
#pragma unroll
      for (unsigned j = 0; j < 16; ++j) {
        const unsigned c = xb_ld(&bar[XB_XCNT(j)]);
        cnt += (c > 0u) ? 1u : 0u;
        mine = (j == xb_x) ? c : mine;
      }
      xb_nloc = __builtin_amdgcn_readfirstlane(mine > 0u ? mine : 1u);
      xb_nx = __builtin_amdgcn_readfirstlane(cnt > 0u ? cnt : 1u);
    } else {
      xcd_barrier(bar, xb_x, xb_nloc, xb_nx);
    }

    GEMM8_TILE_LOOP(22) {
      const int m0 = mt * 256, n0 = ntile * 256;
      f32x4 acc8[8][4];
      zero_acc8(acc8);
      gemm8_accum(acc8, hbuf + (size_t)m0 * DM, DM, wl + W_IN + (size_t)n0 * 1024, 1024, 16, lds_all, !first_,
                  hbuf + (size_t)mtn * 256 * DM, DM, wl + W_IN + (size_t)ntilen * 256 * 1024, 1024);
      gemm8_epi_staged(acc8, m0, n0, lds_all, [&](int, int, f32x4&) {}, z, ZS, ZS);
    }
    xcd_barrier(bar, xb_x, xb_nloc, xb_nx);

    post_z(p, layer);
    xcd_barrier(bar, xb_x, xb_nloc, xb_nx);

    for (int u_ = (int)blockIdx.x, t = 0; (u_ < 64 || u_ - 64 < 512) && ((t = (u_ < 64) ? 2 * u_ + HALF() : 128 + 2 * (u_ - 64) + HALF()), true); u_ = (u_ < 64) ? 1 << 20 : u_ + (int)gridDim.x - 64) {
      f32x4 acc[4][4];
      zero_acc(acc);
      if (t < 128) {
        const int kv = t >> 6, mt = (t >> 1) & 31, ntile = t & 1;
        const int m0 = mt * 128, n0 = ntile * 128;
        const bf16_t* kvd = (const bf16_t*)(p.ws + O_KVD) + (size_t)kv * 8 * SEQ * 64;
        auto ap = [&](int r, int kb) -> const bf16_t* {
          int row = m0 + r;
          int bg = row >> 9, c = row & 511;
          int tk = 16 * c + kb;
          tk = tk > (SEQ - 1) ? (SEQ - 1) : tk;
          return kvd + ((size_t)(bg * SEQ + tk)) * 64;
        };
        gemm_accum(acc, ap, RowPtr{wl + (kv ? W_C1V : W_C1K) + (size_t)n0 * 2048, 2048}, 32, lds);
        const float* bs = bias + kv * 256;
        bf16_t* hd = hid + (size_t)kv * 4096 * 256;
        gemm_epi(acc, m0, n0, [&](int m, int n, f32x4& a) {
          float o[4];
#pragma unroll
          for (int j = 0; j < 4; ++j) {
            float xv = a[j] + bs[n + j];
            float y = 0.7978845608028654f * (xv + 0.044715f * xv * xv * xv);
            float th = 1.f - 2.f / (__expf(2.f * y) + 1.f);
            o[j] = 0.5f * xv * (1.f + th);
          }
          uint2 u;
          u.x = pack2(o[0], o[1]);
          u.y = pack2(o[2], o[3]);
          *(uint2*)(hd + (size_t)m * 256 + n) = u;
        });
      } else {
        const int idx = t - 128;
        const int c = idx & 63, bh = idx >> 6;
        const bf16_t* rvT = (const bf16_t*)(p.ws + O_RVT) + ((size_t)bh * 128) * TS + c * 128;
        const bf16_t* kzT = (const bf16_t*)(p.ws + O_KZT) + ((size_t)bh * 128) * TS + c * 128;
        gemm_accum(acc, RowPtr{rvT, TS}, RowPtr{kzT, TS}, 2, lds);
        bf16_t* dst = z + ((size_t)((bh >> 2) * SEQ + c * 128)) * ZS + C_RV + (bh & 3) * 128;
        gemm_epi_staged(acc, 0, 0, lds, [&](int, int, f32x4&) {}, dst, ZS, 128);
      }
    }
    xcd_barrier(bar, xb_x, xb_nloc, xb_nx);

    phase4b(p, layer);
    {
      const float* pl = p.p + (size_t)layer * T_TOK * 256;
      const int gtid = VBID * 256 + TID();
      const int gthreads = nb * 256;
      for (int i = gtid; i < T_TOK * 32; i += gthreads) {
        float4 a = ((const float4*)pl)[2 * i], b2 = ((const float4*)pl)[2 * i + 1];
        ((uint4*)p16)[i] = make_uint4(pack2(a.x, a.y), pack2(a.z, a.w), pack2(b2.x, b2.y), pack2(b2.z, b2.w));
      }
    }
    xcd_barrier(bar, xb_x, xb_nloc, xb_nx);

    float nsa_c;
    {
      const int ln = TID() & 63;
      float gq = fabsf(p.nsa_q_norm[layer * 64 + ln]), gk = fabsf(p.nsa_k_norm[layer * 64 + ln]);
#pragma unroll
      for (int o = 32; o > 0; o >>= 1) {
        gq = fmaxf(gq, shx(gq, o, ln));
        gk = fmaxf(gk, shx(gk, o, ln));
      }
      nsa_c = 8.f * gq * gk;
    }
    const bool nsa_fx = nsa_c < 30.f;
    const float nsa_cl = nsa_c * 1.4426950408889634f;
    for (int t = VBID; t < 2048; t += nb) {
      if (t < 1024) {
        const int tile = (t < 512) ? 127 - (t >> 3) : ((t - 512) >> 3), bg = t & 7;
        if (nsa_fx) nsa_tile<true>(p, bg >> 1, bg & 1, tile, lds, nsa_cl);
        else nsa_tile<false>(p, bg >> 1, bg & 1, tile, lds, 0.f);
      } else {
        const int idx = t - 1024;
        ret_tile(p, idx >> 8, (idx >> 6) & 3, idx & 63, lds);
      }
    }
    xcd_barrier(bar, xb_x, xb_nloc, xb_nx);

    GEMM8_TILE_LOOP(4) {
      const int m0 = mt * 256, n0 = ntile * 256;
      f32x4 acc8[8][4];
      zero_acc8(acc8);
      gemm8_accum(acc8, (const bf16_t*)(p.ws + O_ONSA) + (size_t)m0 * 512, 512, wl + W_UPA + (size_t)n0 * 512, 512, 8, lds_all, !first_,
                  z + (size_t)m0 * ZS + C_RQ, ZS, wl + W_UPR + (size_t)n0 * 512, 512);
      gemm8_epi(acc8, m0, n0, [&](int m, int n, f32x4& a) {
        uint2 ua = *(const uint2*)(z + (size_t)m * ZS + C_MA + n);
        uint2 ub = *(const uint2*)(z + (size_t)m * ZS + C_MB + n);
        a[0] *= sigmoidf(bflo(ua.x)) / sigmoidf(bflo(ub.x));
        a[1] *= sigmoidf(bfhi(ua.x)) / sigmoidf(bfhi(ub.x));
        a[2] *= sigmoidf(bflo(ua.y)) / sigmoidf(bflo(ub.y));
        a[3] *= sigmoidf(bfhi(ua.y)) / sigmoidf(bfhi(ub.y));
      });
      gemm8_accum(acc8, z + (size_t)m0 * ZS + C_RQ, ZS, wl + W_UPR + (size_t)n0 * 512, 512, 8, lds_all, true,
                  (const bf16_t*)(p.ws + O_ONSA) + (size_t)mtn * 256 * 512, 512, wl + W_UPA + (size_t)ntilen * 256 * 512, 512);
      gemm8_epi_staged(acc8, m0, n0, lds_all, [&](int m, int n, f32x4& a) {
        uint2 ub = *(const uint2*)(z + (size_t)m * ZS + C_MB + n);
        a[0] *= sigmoidf(bflo(ub.x)); a[1] *= sigmoidf(bfhi(ub.x));
        a[2] *= sigmoidf(bflo(ub.y)); a[3] *= sigmoidf(bfhi(ub.y));
      }, z + C_RK, ZS, 1024);
    }
    xcd_barrier(bar, xb_x, xb_nloc, xb_nx);

    GEMM8_TILE_LOOP(4) {
      const int m0 = mt * 256, n0 = ntile * 256;
      f32x4 acc8[8][4];
      zero_acc8(acc8);
      gemm8_accum(acc8, z + (size_t)m0 * ZS + C_RK, ZS, wl + W_OUT + (size_t)n0 * 1024, 1024, 16, lds_all, !first_,
                  z + (size_t)mtn * 256 * ZS + C_RK, ZS, wl + W_OUT + (size_t)ntilen * 256 * 1024, 1024);
      gemm8_epi_resid(acc8, m0, n0, ntile, lds_all, xin, p.out, hbuf, rowpart);
    }
    xcd_barrier(bar, xb_x, xb_nloc, xb_nx);

    GEMM8_TILE_LOOP(16) {
      const int m0 = mt * 256, n0 = ntile * 256;
      f32x4 acc8[8][4];
      zero_acc8(acc8);
      gemm8_accum(acc8, hbuf + (size_t)m0 * DM, DM, wl + W_FF1 + (size_t)n0 * 1024, 1024, 16, lds_all, !first_,
                  hbuf + (size_t)mtn * 256 * DM, DM, wl + W_FF1 + (size_t)ntilen * 256 * 1024, 1024);
      float rsv[8];
      row_rs8(rsv, rowpart, m0);
      scale_rows8(acc8, rsv);
      gemm8_epi_staged(acc8, m0, n0, lds_all, [&](int, int, f32x4& a) {
        float r0 = fmaxf(a[0], 0.f), r1 = fmaxf(a[1], 0.f), r2 = fmaxf(a[2], 0.f), r3 = fmaxf(a[3], 0.f);
        a[0] = r0 * r0; a[1] = r1 * r1; a[2] = r2 * r2; a[3] = r3 * r3;
      }, ubuf, 4096, 4096);
    }
    xcd_barrier(bar, xb_x, xb_nloc, xb_nx);

    GEMM8_TILE_LOOP(4) {
      const int m0 = mt * 256, n0 = ntile * 256;
      f32x4 acc8[8][4];
      zero_acc8(acc8);
      gemm8_accum(acc8, ubuf + (size_t)m0 * 4096, 4096, wl + W_FF2 + (size_t)n0 * 4096, 4096, 64, lds_all, !first_,
                  ubuf + (size_t)mtn * 256 * 4096, 4096, wl + W_FF2 + (size_t)ntilen * 256 * 4096, 4096);
      gemm8_epi_resid(acc8, m0, n0, ntile, lds_all, p.out, p.out, hbuf, rowpart);
    }
    xcd_barrier(bar, xb_x, xb_nloc, xb_nx);

    GEMM8_TILE_LOOP(4) {
      const int m0 = mt * 256, n0 = ntile * 256;
      f32x4 acc8[8][4];
      zero_acc8(acc8);
      gemm8_accum(acc8, p16 + (size_t)m0 * 256, 256, wl + W_PLE + (size_t)n0 * 256, 256, 4, lds_all, !first_,
                  hbuf + (size_t)m0 * DM, DM, wl + W_PG + (size_t)n0 * 1024, 1024);
      bf16_t* ppb = z + (size_t)T_TOK * 256;
      gemm8_epi_staged(acc8, m0, n0, lds_all, [&](int, int, f32x4&) {}, ppb, DM, 1024);
      zero_acc8(acc8);
      gemm8_accum(acc8, hbuf + (size_t)m0 * DM, DM, wl + W_PG + (size_t)n0 * 1024, 1024, 16, lds_all, true,
                  p16 + (size_t)mtn * 256 * 256, 256, wl + W_PLE + (size_t)ntilen * 256 * 256, 256);
      float rsv[8];
      row_rs8(rsv, rowpart, m0);
      scale_rows8(acc8, rsv);
      gemm8_epi(acc8, m0, n0, [&](int m, int n, f32x4& a) {
        uint2 pv = *(const uint2*)(ppb + (size_t)m * DM + n);
        float4* o = (float4*)(p.out + (size_t)m * DM + n);
        float4 xv = *o;
        *o = make_float4(xv.x + sigmoidf(a[0]) * bflo(pv.x), xv.y + sigmoidf(a[1]) * bfhi(pv.x),
                         xv.z + sigmoidf(a[2]) * bflo(pv.y), xv.w + sigmoidf(a[3]) * bfhi(pv.y));
      });
    }
    xcd_barrier(bar, xb_x, xb_nloc, xb_nx);
  }
}

extern "C" void kernel_launch(void* const* d_in, const int* in_sizes, int n_in,
                              void* d_out, int out_size, void* d_ws, size_t ws_size,
                              hipStream_t stream) {
  static int grid_blocks = 0;
  if (!grid_blocks) {
    int dev = 0, cus = 0, per_cu = 0;
    hipGetDevice(&dev);
    hipDeviceGetAttribute(&cus, hipDeviceAttributeMultiprocessorCount, dev);
    hipFuncSetAttribute((const void*)mega, hipFuncAttributeMaxDynamicSharedMemorySize, DYN_LDS);
    hipOccupancyMaxActiveBlocksPerMultiprocessor(&per_cu, mega, 512, DYN_LDS);
    if (per_cu > 1) per_cu = 1;
    if (per_cu < 1) per_cu = 1;
    grid_blocks = cus * per_cu;
  }
  if (ws_size < WS_NEED) {
    fprintf(stderr, "workspace too small: %zu < %llu\n", ws_size, (unsigned long long)WS_NEED);
    return;
  }
  Params p{};
  p.x = (const float*)d_in[0]; p.p = (const float*)d_in[1]; p.norm_mix = (const float*)d_in[2]; p.w_in = (const float*)d_in[3];
  p.nsa_q_norm = (const float*)d_in[4]; p.nsa_k_norm = (const float*)d_in[5]; p.cmp_pos_k = (const float*)d_in[6];
  p.cmp_pos_v = (const float*)d_in[7]; p.cmp_w1_k = (const float*)d_in[8]; p.cmp_w2_k = (const float*)d_in[9];
  p.cmp_w1_v = (const float*)d_in[10]; p.cmp_w2_v = (const float*)d_in[11]; p.w_up_nsa = (const float*)d_in[12];
  p.w_up_ret = (const float*)d_in[13]; p.w_out = (const float*)d_in[14]; p.norm_mlp = (const float*)d_in[15];
  p.w_ff1 = (const float*)d_in[16]; p.w_ff2 = (const float*)d_in[17]; p.norm_ple = (const float*)d_in[18];
  p.w_ple = (const float*)d_in[19]; p.w_ple_gate = (const float*)d_in[20];
  p.out = (float*)d_out; p.ws = (char*)d_ws;
  hipMemsetAsync((char*)d_ws + O_BAR, 0, BAR_BYTES, stream);
  void* args[] = {&p};
  hipError_t e = hipLaunchCooperativeKernel((void*)mega, dim3(grid_blocks), dim3(512), args, DYN_LDS, stream);
  if (e != hipSuccess) fprintf(stderr, "cooperative launch failed: %s (grid %d)\n", hipGetErrorString(e), grid_blocks);
}
```

```cpp
#include <hip/hip_runtime.h>
#include <hip/hip_cooperative_groups.h>
#include <cstdio>
#include <cstdint>
namespace cg = cooperative_groups;

typedef __attribute__((ext_vector_type(8))) short bf16x8;
typedef __attribute__((ext_vector_type(4))) float f32x4;
typedef unsigned short bf16_t;
typedef __attribute__((ext_vector_type(4))) unsigned u32x4;
#define DI __device__ __forceinline__

#define T_TOK 32768
#define SEQ 8192
#define DM 1024
#define ZS 5400
#define C_Q 0
#define C_KC 512
#define C_VC 640
#define C_KS 768
#define C_VS 896
#define C_KW 1024
#define C_VW 1152
#define C_GT 1280
#define C_RQ 1304
#define C_RK 1816
#define C_RV 2328
#define C_RG 2840
#define C_MA 3352
#define C_MB 4376
#define NPAD_IN 5504
#define TS 8256

#define W_IN 0
#define W_C1K 5636096
#define W_C1V 6160384
#define W_UPA 6684672
#define W_UPR 7208960
#define W_OUT 7733248
#define W_FF1 8781824
#define W_FF2 12976128
#define W_PLE 17170432
#define W_PG 17432576
#define W_LAYER 18481152

#define O_WT 0ull
#define O_ROPE 36962304ull
#define O_BIAS 41156608ull
#define O_HID 41160704ull
#define O_KCMP 45355008ull
#define O_VCMPT 45879296ull
#define O_VST 46403584ull
#define O_VWT 54857728ull
#define O_RVT 63311872ull
#define O_KZT 97128448ull
#define O_Z 130945024ull
#define O_ONSA 484839424ull
#define O_BAR 518393856ull
#define BAR_BYTES 13824
#define O_KVD 518407680ull
#define O_RP 535184896ull
#define WS_NEED 536233472ull
#define DYN_LDS 139264

struct Params {
  const float* x; const float* p; const float* norm_mix; const float* w_in;
  const float* nsa_q_norm; const float* nsa_k_norm; const float* cmp_pos_k; const float* cmp_pos_v;
  const float* cmp_w1_k; const float* cmp_w2_k; const float* cmp_w1_v; const float* cmp_w2_v;
  const float* w_up_nsa; const float* w_up_ret; const float* w_out; const float* norm_mlp;
  const float* w_ff1; const float* w_ff2; const float* norm_ple; const float* w_ple; const float* w_ple_gate;
  float* out; char* ws;
};

DI unsigned pack2(float a, float b) {
  typedef __attribute__((ext_vector_type(2))) __bf16 bf2;
  typedef __attribute__((ext_vector_type(2))) float f2;
  f2 v = {a, b};
  bf2 r = __builtin_convertvector(v, bf2);
  return __builtin_bit_cast(unsigned, r);
}
DI bf16_t f2bf(float a) { return (bf16_t)(pack2(a, 0.f) & 0xffffu); }
DI float bf2f(bf16_t h) { return __uint_as_float(((unsigned)h) << 16); }
DI float bflo(unsigned u) { return __uint_as_float(u << 16); }
DI float bfhi(unsigned u) { return __uint_as_float(u & 0xffff0000u); }
DI float shx(float v, int mask, int lane) {
  return __int_as_float(__builtin_amdgcn_ds_bpermute((lane ^ mask) << 2, __float_as_int(v)));
}
DI uint32_t shxu(uint32_t v, int mask, int lane) {
  return (uint32_t)__builtin_amdgcn_ds_bpermute((lane ^ mask) << 2, (int)v);
}
DI float shfrom(float v, int srclane) {
  return __int_as_float(__builtin_amdgcn_ds_bpermute(srclane << 2, __float_as_int(v)));
}
DI float wave_sum(float v, int lane) {
#pragma unroll
  for (int o = 32; o > 0; o >>= 1) v += shx(v, o, lane);
  return v;
}
DI int TID() { int t = threadIdx.x & 255; asm volatile("" : "+v"(t)); return t; }
DI int HALF() { return __builtin_amdgcn_readfirstlane((int)(threadIdx.x >> 8)); }
#define VBID ((int)(blockIdx.x * 2) + HALF())
#define NVB ((int)(gridDim.x * 2))
DI float sigmoidf(float x) { return __builtin_amdgcn_rcpf(1.f + __expf(-x)); }
DI float inv_sigmoidf(float x) { return 1.f + __expf(-x); }
DI f32x4 mfma16(bf16x8 a, bf16x8 b, f32x4 c) { return __builtin_amdgcn_mfma_f32_16x16x32_bf16(a, b, c, 0, 0, 0); }
DI bf16x8 mk8(unsigned a, unsigned b, unsigned c, unsigned d) {
  uint4 u = make_uint4(a, b, c, d);
  return __builtin_bit_cast(bf16x8, u);
}

template <class AP, class BP>
DI void g_load(u32x4 (&ra)[4], u32x4 (&rb)[4], const AP& ap, const BP& bp, int kb, int lrow, int lch) {
#pragma unroll
  for (int i = 0; i < 4; ++i) {
    ra[i] = *(const u32x4*)(ap(lrow + 32 * i, kb) + lch * 8);
    rb[i] = *(const u32x4*)(bp(lrow + 32 * i, kb) + lch * 8);
  }
}
DI void g_store(bf16_t* As, bf16_t* Bs, const u32x4 (&ra)[4], const u32x4 (&rb)[4], int buf, int lrow, int lch) {
#pragma unroll
  for (int i = 0; i < 4; ++i) {
    int r = lrow + 32 * i;
    int off = buf * 8192 + r * 64 + ((lch ^ ((r >> 1) & 7)) << 3);
    *(u32x4*)(As + off) = ra[i];
    *(u32x4*)(Bs + off) = rb[i];
  }
}
DI void g_compute(f32x4 (&acc)[4][4], const bf16_t* a, const bf16_t* b, int wm, int wn, int lane) {
  bf16x8 af[2][4], bfr[2][4];
#pragma unroll
  for (int ks = 0; ks < 2; ++ks)
#pragma unroll
    for (int i = 0; i < 4; ++i) {
      int r = wm * 64 + i * 16 + (lane & 15);
      af[ks][i] = *(const bf16x8*)(a + r * 64 + (((ks * 4 + (lane >> 4)) ^ ((r >> 1) & 7)) << 3));
      int r2 = wn * 64 + i * 16 + (lane & 15);
      bfr[ks][i] = *(const bf16x8*)(b + r2 * 64 + (((ks * 4 + (lane >> 4)) ^ ((r2 >> 1) & 7)) << 3));
    }
  __builtin_amdgcn_s_setprio(1);
#pragma unroll
  for (int ks = 0; ks < 2; ++ks)
#pragma unroll
    for (int i = 0; i < 4; ++i)
#pragma unroll
      for (int j = 0; j < 4; ++j) acc[i][j] = mfma16(bfr[ks][j], af[ks][i], acc[i][j]);
  __builtin_amdgcn_s_setprio(0);
}
template <class AP, class BP>
DI void gemm_accum(f32x4 (&acc)[4][4], AP ap, BP bp, int nkb, bf16_t* lds) {
  const int tid = TID(), lane = tid & 63, w = tid >> 6;
  const int wm = w >> 1, wn = w & 1;
  const int lrow = tid >> 3, lch = tid & 7;
  bf16_t* As = lds;
  bf16_t* Bs = lds + 16384;
  u32x4 ra0[4], rb0[4], ra1[4], rb1[4];
  __syncthreads();
  g_load(ra0, rb0, ap, bp, 0, lrow, lch);
  g_load(ra1, rb1, ap, bp, 1, lrow, lch);
  g_store(As, Bs, ra0, rb0, 0, lrow, lch);
  __syncthreads();
  for (int kb = 0; kb < nkb; kb += 2) {
    const int k2 = (kb + 2 < nkb) ? kb + 2 : nkb - 2;
    g_load(ra0, rb0, ap, bp, k2, lrow, lch);
    __builtin_amdgcn_sched_barrier(0);
    g_compute(acc, As, Bs, wm, wn, lane);
    g_store(As, Bs, ra1, rb1, 1, lrow, lch);
    __syncthreads();
    g_load(ra1, rb1, ap, bp, k2 + 1, lrow, lch);
    __builtin_amdgcn_sched_barrier(0);
    g_compute(acc, As + 8192, Bs + 8192, wm, wn, lane);
    g_store(As, Bs, ra0, rb0, 0, lrow, lch);
    __syncthreads();
  }
}
template <class E>
DI void gemm_epi(f32x4 (&acc)[4][4], int m0, int n0, E e) {
  const int tid_ = TID();
  const int lane = tid_ & 63, w = tid_ >> 6;
  const int wm = w >> 1, wn = w & 1;
#pragma unroll
  for (int i = 0; i < 4; ++i)
#pragma unroll
    for (int j = 0; j < 4; ++j) {
      int m = m0 + wm * 64 + i * 16 + (lane & 15);
      int n = n0 + wn * 64 + j * 16 + (lane >> 4) * 4;
      e(m, n, acc[i][j]);
    }
}
template <class F>
DI void gemm_epi_staged(f32x4 (&acc)[4][4], int m0, int n0, bf16_t* lds, F f, bf16_t* dst, size_t ld, int nmax) {
  const int tid_ = TID();
  const int lane = tid_ & 63, w = tid_ >> 6;
  const int wm = w >> 1, wn = w & 1;
#pragma unroll
  for (int i = 0; i < 4; ++i)
#pragma unroll
    for (int j = 0; j < 4; ++j) {
      const int ml = wm * 64 + i * 16 + (lane & 15);
      const int nl = wn * 64 + j * 16 + (lane >> 4) * 4;
      f32x4 a = acc[i][j];
      f(m0 + ml, n0 + nl, a);
      uint2 u;
      u.x = pack2(a[0], a[1]);
      u.y = pack2(a[2], a[3]);
      *(uint2*)(lds + ml * 136 + nl) = u;
    }
  __syncthreads();
#pragma unroll
  for (int it = 0; it < 8; ++it) {
    const int idx = tid_ + 256 * it;
    const int row = idx >> 4, ch = idx & 15;
    const u32x4 v = *(const u32x4*)(lds + row * 136 + ch * 8);
    const int n = n0 + ch * 8;
    if (n < nmax) *(u32x4*)(dst + (size_t)(m0 + row) * ld + n) = v;
  }
}
DI void gemm_epi_resid(f32x4 (&acc)[4][4], int m0, int n0, int ntile, bf16_t* lds, const float* xin, float* out, bf16_t* xb, float* rowpart) {
  const int tid_ = TID();
  const int lane = tid_ & 63, w = tid_ >> 6;
  const int wm = w >> 1, wn = w & 1;
  float* red = (float*)lds;
#pragma unroll
  for (int i = 0; i < 4; ++i) {
    const int ml = wm * 64 + i * 16 + (lane & 15);
    const size_t rowoff = (size_t)(m0 + ml) * DM;
    float ss = 0.f;
#pragma unroll
    for (int j = 0; j < 4; ++j) {
      const int n = n0 + wn * 64 + j * 16 + (lane >> 4) * 4;
      const float4 xv = *(const float4*)(xin + rowoff + n);
      const float o0 = xv.x + acc[i][j][0], o1 = xv.y + acc[i][j][1], o2 = xv.z + acc[i][j][2], o3 = xv.w + acc[i][j][3];
      *(float4*)(out + rowoff + n) = make_float4(o0, o1, o2, o3);
      ss += o0 * o0 + o1 * o1 + o2 * o2 + o3 * o3;
      uint2 u;
      u.x = pack2(o0, o1);
      u.y = pack2(o2, o3);
      *(uint2*)(xb + rowoff + n) = u;
    }
    ss += shx(ss, 16, lane);
    ss += shx(ss, 32, lane);
    if ((lane >> 4) == 0) red[wn * 128 + ml] = ss;
  }
  __syncthreads();
  if (tid_ < 128) rowpart[(size_t)ntile * T_TOK + m0 + tid_] = red[tid_] + red[128 + tid_];
}
DI void row_rs(float (&rsv)[4], const float* rowpart, int m0) {
  const int tid_ = TID();
  const int lane = tid_ & 63, wm = tid_ >> 7;
#pragma unroll
  for (int i = 0; i < 4; ++i) {
    const int m = m0 + wm * 64 + i * 16 + (lane & 15);
    float s = 0.f;
#pragma unroll
    for (int t = 0; t < 8; ++t) s += rowpart[(size_t)t * T_TOK + m];
    rsv[i] = rsqrtf(s * (1.f / 1024.f) + 1e-6f);
  }
}
DI void scale_rows(f32x4 (&acc)[4][4], const float (&rsv)[4]) {
#pragma unroll
  for (int i = 0; i < 4; ++i)
#pragma unroll
    for (int j = 0; j < 4; ++j) acc[i][j] *= rsv[i];
}
DI void zero_acc(f32x4 (&acc)[4][4]) {
#pragma unroll
  for (int i = 0; i < 4; ++i)
#pragma unroll
    for (int j = 0; j < 4; ++j) acc[i][j] = f32x4{0.f, 0.f, 0.f, 0.f};
}
struct RowPtr {
  const bf16_t* base; size_t ld;
  DI const bf16_t* operator()(int r, int kb) const { return base + (size_t)r * ld + kb * 64; }
};

DI void convert_wt(const float* W, bf16_t* Wt, int K, int N, int Npad, int gtid, int gthreads, const float* gk = nullptr) {
  const int k8n = K >> 3;
  const long total = (long)Npad * k8n;
  for (long idx = gtid; idx < total; idx += gthreads) {
    int n = (int)(idx % Npad);
    int k8 = (int)(idx / Npad);
    uint4 o = make_uint4(0, 0, 0, 0);
    if (n < N) {
      const float* s = W + (size_t)(k8 * 8) * N + n;
      float v0 = s[0], v1 = s[(size_t)N], v2 = s[(size_t)2 * N], v3 = s[(size_t)3 * N];
      float v4 = s[(size_t)4 * N], v5 = s[(size_t)5 * N], v6 = s[(size_t)6 * N], v7 = s[(size_t)7 * N];
      if (gk) {
        const float* gp = gk + k8 * 8;
        v0 *= gp[0]; v1 *= gp[1]; v2 *= gp[2]; v3 *= gp[3]; v4 *= gp[4]; v5 *= gp[5]; v6 *= gp[6]; v7 *= gp[7];
      }
      o = make_uint4(pack2(v0, v1), pack2(v2, v3), pack2(v4, v5), pack2(v6, v7));
    }
    *(uint4*)(Wt + (size_t)n * K + k8 * 8) = o;
  }
}

DI void phase0(const Params& p, const int L, bf16_t* lds) {
  bf16_t* wl = (bf16_t*)(p.ws + O_WT);
  {
    bf16_t* T = lds;
    const int tid = TID();
    const int half = HALF();
    for (int pr = (int)blockIdx.x; pr < 2256; pr += (int)gridDim.x) {
      int t = 2 * pr + half;
      const float* W; bf16_t* Wt; int K, N; const float* gk = nullptr;
      if (t < 1376) { W = p.w_in + (size_t)L * 1024 * 5400; Wt = wl + W_IN; K = 1024; N = 5400; }
      else if ((t -= 1376) < 128) { W = p.cmp_w1_k + (size_t)L * 2048 * 256; Wt = wl + W_C1K; K = 2048; N = 256; }
      else if ((t -= 128) < 128) { W = p.cmp_w1_v + (size_t)L * 2048 * 256; Wt = wl + W_C1V; K = 2048; N = 256; }
      else if ((t -= 128) < 128) { W = p.w_up_nsa + (size_t)L * 512 * 1024; Wt = wl + W_UPA; K = 512; N = 1024; }
      else if ((t -= 128) < 128) { W = p.w_up_ret + (size_t)L * 512 * 1024; Wt = wl + W_UPR; K = 512; N = 1024; }
      else if ((t -= 128) < 256) { W = p.w_out + (size_t)L * 1024 * 1024; Wt = wl + W_OUT; K = 1024; N = 1024; }
      else if ((t -= 256) < 1024) { W = p.w_ff1 + (size_t)L * 1024 * 4096; Wt = wl + W_FF1; K = 1024; N = 4096; gk = p.norm_mlp + L * DM; }
      else if ((t -= 1024) < 1024) { W = p.w_ff2 + (size_t)L * 4096 * 1024; Wt = wl + W_FF2; K = 4096; N = 1024; }
      else if ((t -= 1024) < 64) { W = p.w_ple + (size_t)L * 256 * 1024; Wt = wl + W_PLE; K = 256; N = 1024; }
      else { t -= 64; W = p.w_ple_gate + (size_t)L * 1024 * 1024; Wt = wl + W_PG; K = 1024; N = 1024; gk = p.norm_ple + L * DM; }
      const int nkt = K >> 6;
      const int nt = t / nkt, kt = t - nt * nkt;
      const int k0 = kt * 64, n0 = nt * 64;
      __syncthreads();
      {
        const int c4 = tid & 15, n = n0 + c4 * 4;
#pragma unroll
        for (int i = 0; i < 4; ++i) {
          const int k = (tid >> 4) + 16 * i;
          float4 v = make_float4(0.f, 0.f, 0.f, 0.f);
          if (n < N) v = *(const float4*)(W + (size_t)(k0 + k) * N + n);
          if (gk) { const float g = gk[k0 + k]; v.x *= g; v.y *= g; v.z *= g; v.w *= g; }
          T[(c4 * 4 + 0) * 66 + k] = f2bf(v.x);
          T[(c4 * 4 + 1) * 66 + k] = f2bf(v.y);
          T[(c4 * 4 + 2) * 66 + k] = f2bf(v.z);
          T[(c4 * 4 + 3) * 66 + k] = f2bf(v.w);
        }
      }
      __syncthreads();
      {
        const int n = tid >> 2, kc = tid & 3;
        const unsigned* s32 = (const unsigned*)(T + n * 66 + kc * 16);
        u32x4 o0, o1;
        o0.x = s32[0]; o0.y = s32[1]; o0.z = s32[2]; o0.w = s32[3];
        o1.x = s32[4]; o1.y = s32[5]; o1.z = s32[6]; o1.w = s32[7];
        bf16_t* dst = Wt + (size_t)(n0 + n) * K + k0 + kc * 16;
        *(u32x4*)dst = o0;
        *(u32x4*)(dst + 8) = o1;
      }
    }
  }
  const int gtid = VBID * 256 + TID();
  const int gthreads = NVB * 256;
  if (L == 0) {
    float2* rope = (float2*)(p.ws + O_ROPE);
    for (int idx = gtid; idx < SEQ * 64; idx += gthreads) {
      int pos = idx >> 6, j = idx & 63;
      float inv = exp2f(-(float)j * (13.287712379549449f / 64.f));
      float ang = (float)pos * inv;
      double rev = (double)ang * 0.15915494309189535;
      rev -= rint(rev);
      float fr = (float)rev;
      rope[idx] = make_float2(__builtin_amdgcn_cosf(fr), __builtin_amdgcn_sinf(fr));
    }
  }
  float* part = (float*)(p.ws + O_HID);
  {
    const int n = gtid & 255;
    for (int item = VBID; item < 128; item += NVB) {
      const int kv = item >> 6, kc = item & 63;
      const float* pos = (kv ? p.cmp_pos_v : p.cmp_pos_k) + L * 2048 + kc * 32;
      const float* w1 = (kv ? p.cmp_w1_v : p.cmp_w1_k) + (size_t)L * 2048 * 256 + (size_t)kc * 32 * 256;
      float a = 0.f;
#pragma unroll 8
      for (int k = 0; k < 32; ++k) a += pos[k] * w1[(size_t)k * 256 + n];
      part[item * 256 + n] = a;
    }
  }
}

DI void norm_phase(const float* xin, const float* g, bf16_t* h) {
  const int tid_ = TID();
  const int lane = tid_ & 63;
  const int gw = (VBID * 256 + tid_) >> 6;
  const int nw = NVB * 4;
  float4 gv[4];
#pragma unroll
  for (int i = 0; i < 4; ++i) gv[i] = ((const float4*)g)[i * 64 + lane];
  for (int row = gw; row < T_TOK; row += nw) {
    const float4* xr = (const float4*)(xin + (size_t)row * DM);
    float4 v[4];
    float ss = 0.f;
#pragma unroll
    for (int i = 0; i < 4; ++i) {
      v[i] = xr[i * 64 + lane];
      ss += v[i].x * v[i].x + v[i].y * v[i].y + v[i].z * v[i].z + v[i].w * v[i].w;
    }
    ss = wave_sum(ss, lane);
    float rs = rsqrtf(ss * (1.f / 1024.f) + 1e-6f);
    uint2* hr = (uint2*)(h + (size_t)row * DM);
#pragma unroll
    for (int i = 0; i < 4; ++i) {
      uint2 o;
      o.x = pack2(v[i].x * rs * gv[i].x, v[i].y * rs * gv[i].y);
      o.y = pack2(v[i].z * rs * gv[i].z, v[i].w * rs * gv[i].w);
      hr[i * 64 + lane] = o;
    }
  }
}

DI void post_z(const Params& p, int layer) {
  const int tid_ = TID();
  const int lane = tid_ & 63;
  const int gw = (VBID * 256 + tid_) >> 6;
  const int nw = NVB * 4;
  bf16_t* z = (bf16_t*)(p.ws + O_Z);
  bf16_t* vsT = (bf16_t*)(p.ws + O_VST);
  bf16_t* vwT = (bf16_t*)(p.ws + O_VWT);
  bf16_t* rvT = (bf16_t*)(p.ws + O_RVT);
  bf16_t* kzT = (bf16_t*)(p.ws + O_KZT);
  const float2* rope = (const float2*)(p.ws + O_ROPE);
  const float* qn = p.nsa_q_norm + layer * 64;
  const float* kn = p.nsa_k_norm + layer * 64;
  {
    const float* part = (const float*)(p.ws + O_HID);
    float* bias = (float*)(p.ws + O_BIAS);
    const int idx = VBID * 256 + tid_;
    if (idx < 512) {
      const int kv = idx >> 8, n = idx & 255;
      float a = 0.f;
      for (int kc = 0; kc < 64; ++kc) a += part[(kv * 64 + kc) * 256 + n];
      bias[idx] = a;
    }
  }
  for (int item = gw; item < 1024 * 36; item += nw) {
    const int tc = item / 36, slab = item - tc * 36;
    const int tok0 = tc * 32;
    const int b = tok0 >> 13, spos = tok0 & 8191;
    bf16_t* zr = z + (size_t)tok0 * ZS;
    if (slab >= 32) {
      const int s4 = slab - 32, kv = s4 >> 1, gi = s4 & 1;
      const int colbase = (kv ? C_VC : C_KC) + gi * 64;
      bf16_t* dst = (bf16_t*)(p.ws + O_KVD) + ((size_t)((kv * 8 + b * 2 + gi) * SEQ + spos)) * 64 + lane;
      bf16_t u[32];
#pragma unroll
      for (int i = 0; i < 32; ++i) u[i] = zr[(size_t)i * ZS + colbase + lane];
#pragma unroll
      for (int i = 0; i < 32; ++i) dst[i * 64] = u[i];
    } else if (slab < 12) {
      int colbase; const float* g; float sc;
      if (slab < 8) { colbase = C_Q + slab * 64; g = qn; sc = 0.125f; }
      else if (slab < 10) { colbase = C_KS + (slab - 8) * 64; g = kn; sc = 1.f; }
      else { colbase = C_KW + (slab - 10) * 64; g = kn; sc = 1.f; }
      const float gv = g[lane] * sc;
      float v[32];
#pragma unroll
      for (int i = 0; i < 32; ++i) v[i] = bf2f(zr[(size_t)i * ZS + colbase + lane]);
#pragma unroll
      for (int i = 0; i < 32; ++i) {
        float ss = wave_sum(v[i] * v[i], lane);
        float rs = rsqrtf(ss * (1.f / 64.f) + 1e-6f);
        zr[(size_t)i * ZS + colbase + lane] = f2bf(v[i] * rs * gv);
      }
    } else if (slab < 16 || slab >= 24) {
      int colbase; bf16_t* dst;
      if (slab < 16) {
        const int gi = slab & 1;
        const bool isw = slab >= 14;
        colbase = (isw ? C_VW : C_VS) + gi * 64;
        dst = (isw ? vwT : vsT) + ((size_t)((b * 2 + gi) * 64 + lane)) * TS + spos;
      } else {
        const int s8 = slab - 24;
        const int h = s8 >> 1, half = s8 & 1;
        colbase = C_RV + s8 * 64;
        dst = rvT + ((size_t)((b * 4 + h) * 128 + half * 64 + lane)) * TS + spos;
      }
      unsigned u[32];
#pragma unroll
      for (int i = 0; i < 32; ++i) u[i] = zr[(size_t)i * ZS + colbase + lane];
#pragma unroll
      for (int q4 = 0; q4 < 4; ++q4)
        *(uint4*)(dst + q4 * 8) = make_uint4(u[q4 * 8 + 0] | (u[q4 * 8 + 1] << 16), u[q4 * 8 + 2] | (u[q4 * 8 + 3] << 16),
                                             u[q4 * 8 + 4] | (u[q4 * 8 + 5] << 16), u[q4 * 8 + 6] | (u[q4 * 8 + 7] << 16));
    } else if (slab < 20) {
      const int h = slab - 16;
      const int colbase = C_RQ + h * 128;
      float x1[32], x2[32];
#pragma unroll
      for (int i = 0; i < 32; ++i) {
        const bf16_t* p1 = zr + (size_t)i * ZS + colbase + lane;
        x1[i] = bf2f(p1[0]);
        x2[i] = bf2f(p1[64]);
      }
#pragma unroll
      for (int i = 0; i < 32; ++i) {
        bf16_t* p1 = zr + (size_t)i * ZS + colbase + lane;
        float2 cs = rope[(spos + i) * 64 + lane];
        p1[0] = f2bf(x1[i] * cs.x - x2[i] * cs.y);
        p1[64] = f2bf(x1[i] * cs.y + x2[i] * cs.x);
      }
    } else {
      const int h = slab - 20;
      const int colbase = C_RK + h * 128;
      const float lg2 = log2f(1.f - exp2f(-5.f - (float)h));
      float x1[32], x2[32];
#pragma unroll
      for (int i = 0; i < 32; ++i) {
        const bf16_t* p1 = zr + (size_t)i * ZS + colbase + lane;
        x1[i] = bf2f(p1[0]);
        x2[i] = bf2f(p1[64]);
      }
      unsigned u1[32], u2[32];
#pragma unroll
      for (int i = 0; i < 32; ++i) {
        bf16_t* p1 = zr + (size_t)i * ZS + colbase + lane;
        float2 cs = rope[(spos + i) * 64 + lane];
        float o1 = (x1[i] * cs.x - x2[i] * cs.y) * 0.08838834764831845f;
        float o2 = (x1[i] * cs.y + x2[i] * cs.x) * 0.08838834764831845f;
        p1[0] = f2bf(o1);
        p1[64] = f2bf(o2);
        float zeta = exp2f(lg2 * (float)(127 - ((spos + i) & 127)));
        u1[i] = f2bf(o1 * zeta);
        u2[i] = f2bf(o2 * zeta);
      }
      bf16_t* d1 = kzT + ((size_t)((b * 4 + h) * 128 + lane)) * TS + spos;
#pragma unroll
      for (int q4 = 0; q4 < 4; ++q4) {
        *(uint4*)(d1 + q4 * 8) = make_uint4(u1[q4 * 8 + 0] | (u1[q4 * 8 + 1] << 16), u1[q4 * 8 + 2] | (u1[q4 * 8 + 3] << 16),
                                            u1[q4 * 8 + 4] | (u1[q4 * 8 + 5] << 16), u1[q4 * 8 + 6] | (u1[q4 * 8 + 7] << 16));
        *(uint4*)(d1 + (size_t)64 * TS + q4 * 8) = make_uint4(u2[q4 * 8 + 0] | (u2[q4 * 8 + 1] << 16), u2[q4 * 8 + 2] | (u2[q4 * 8 + 3] << 16),
                                                              u2[q4 * 8 + 4] | (u2[q4 * 8 + 5] << 16), u2[q4 * 8 + 6] | (u2[q4 * 8 + 7] << 16));
      }
    }
  }
}

DI void phase4b(const Params& p, int layer) {
  const int tid_ = TID();
  const int lane = tid_ & 63;
  const int gw = (VBID * 256 + tid_) >> 6;
  const int nw = NVB * 4;
  bf16_t* z = (bf16_t*)(p.ws + O_Z);
  const bf16_t* hid = (const bf16_t*)(p.ws + O_HID);
  bf16_t* kcmp = (bf16_t*)(p.ws + O_KCMP);
  bf16_t* vcmpT = (bf16_t*)(p.ws + O_VCMPT);
  const float* kn = p.nsa_k_norm + layer * 64;
  for (int item = gw; item < 8192; item += nw) {
    const int kv = item >> 12, row = item & 4095;
    const bf16_t* hrow = hid + ((size_t)kv * 4096 + row) * 256;
    const float* w2 = (kv ? p.cmp_w2_v : p.cmp_w2_k) + (size_t)layer * 256 * 64;
    float acc = 0.f;
    for (int k8 = 0; k8 < 32; ++k8) {
      uint4 hv = *(const uint4*)(hrow + k8 * 8);
      const float* wr = w2 + (size_t)(k8 * 8) * 64 + lane;
      acc += bflo(hv.x) * wr[0];
      acc += bfhi(hv.x) * wr[64];
      acc += bflo(hv.y) * wr[128];
      acc += bfhi(hv.y) * wr[192];
      acc += bflo(hv.z) * wr[256];
      acc += bfhi(hv.z) * wr[320];
      acc += bflo(hv.w) * wr[384];
      acc += bfhi(hv.w) * wr[448];
    }
    if (kv == 0) {
      float ss = wave_sum(acc * acc, lane);
      float rs = rsqrtf(ss * (1.f / 64.f) + 1e-6f);
      kcmp[(size_t)row * 64 + lane] = f2bf(acc * rs * kn[lane]);
    } else {
      const int bg = row >> 9, c = row & 511;
      vcmpT[((size_t)(bg * 64 + lane)) * 512 + c] = f2bf(acc);
    }
  }
  const int gtid = VBID * 256 + tid_;
  const int gthreads = NVB * 256;
  for (int idx = gtid; idx < 65536; idx += gthreads) {
    const int d4 = idx & 31, e = (idx >> 5) & 127, h = (idx >> 12) & 3, b = idx >> 14;
    const float lg2 = log2f(1.f - exp2f(-5.f - (float)h));
    const float gch = exp2f(lg2 * 128.f);
    float r0 = 0.f, r1 = 0.f, r2 = 0.f, r3 = 0.f;
    bf16_t* ptr = z + ((size_t)(b * SEQ + e)) * ZS + C_RV + h * 128 + d4 * 4;
    for (int c0 = 0; c0 < 64; c0 += 16) {
      typedef __attribute__((ext_vector_type(2))) unsigned u32x2;
      u32x2 v[16];
#pragma unroll
      for (int i = 0; i < 16; ++i) v[i] = *(const u32x2*)(ptr + (size_t)(c0 + i) * 128 * ZS);
#pragma unroll
      for (int i = 0; i < 16; ++i) {
        u32x2 o;
        o.x = pack2(r0, r1);
        o.y = pack2(r2, r3);
        *(u32x2*)(ptr + (size_t)(c0 + i) * 128 * ZS) = o;
        r0 = gch * r0 + bflo(v[i].x);
        r1 = gch * r1 + bfhi(v[i].x);
        r2 = gch * r2 + bflo(v[i].y);
        r3 = gch * r3 + bfhi(v[i].y);
      }
    }
  }
}


DI void tile64_gload(int tid, u32x4& r0, u32x4& r1, const bf16_t* base, size_t stride) {
  {
    int idx = tid;
    int row = idx >> 3, ch = idx & 7;
    r0 = *(const u32x4*)(base + (size_t)row * stride + ch * 8);
  }
  {
    int idx = tid + 256;
    int row = idx >> 3, ch = idx & 7;
    r1 = *(const u32x4*)(base + (size_t)row * stride + ch * 8);
  }
}
DI void tile64_sstore(int tid, bf16_t* dst, const u32x4& r0, const u32x4& r1) {
  {
    int idx = tid;
    int row = idx >> 3, ch = idx & 7;
    *(u32x4*)(dst + row * 64 + ((ch ^ ((row >> 1) & 7)) << 3)) = r0;
  }
  {
    int idx = tid + 256;
    int row = idx >> 3, ch = idx & 7;
    *(u32x4*)(dst + row * 64 + ((ch ^ ((row >> 1) & 7)) << 3)) = r1;
  }
}

struct AttnSt { f32x4 O[2][4]; f32x4 L[2]; float m[2]; float l[2]; };

template <int MODE, bool FX>
DI void attn_compute(const int lane, const bf16_t* Ks, const bf16_t* Vs, const bf16x8 (&qf)[2][2], AttnSt& st, const float (&invl)[2],
                     int lo, int hi, float (&impA)[4], float (&impE)[4], const float CL) {
  const int quad = lane >> 4, col = lane & 15;
  f32x4 S[4][2];
#pragma unroll
  for (int kt = 0; kt < 4; ++kt)
#pragma unroll
    for (int hh = 0; hh < 2; ++hh) S[kt][hh] = f32x4{0.f, 0.f, 0.f, 0.f};
#pragma unroll
  for (int ks = 0; ks < 2; ++ks) {
#pragma unroll
    for (int kt = 0; kt < 4; ++kt) {
      int row = kt * 16 + col;
      bf16x8 kf = *(const bf16x8*)(Ks + row * 64 + (((ks * 4 + quad) ^ ((row >> 1) & 7)) << 3));
#pragma unroll
      for (int hh = 0; hh < 2; ++hh) S[kt][hh] = mfma16(kf, qf[hh][ks], S[kt][hh]);
    }
  }
  bf16x8 pf[2][2];
  const bool full = (lo <= 0) && (hi >= 63);
  const bool none = (hi < 0) || (lo > 63) || (hi < lo);
  if (__all(full || none)) {
    constexpr float L2E = 1.4426950408889634f;
#pragma unroll
    for (int hh = 0; hh < 2; ++hh) {
      float mL;
      float il = 1.f;
      if (FX) {
        mL = full ? CL : 1e30f;
        if (MODE == 1) il = invl[hh];
      } else if (MODE != 1) {
        float mx = -1e30f;
#pragma unroll
        for (int kt = 0; kt < 4; ++kt)
#pragma unroll
          for (int j = 0; j < 4; ++j) mx = fmaxf(mx, S[kt][hh][j]);
        mx = full ? mx : -1e30f;
        mx = fmaxf(mx, shx(mx, 16, lane));
        mx = fmaxf(mx, shx(mx, 32, lane));
        const float m_new = fmaxf(st.m[hh], mx);
        const float alpha = __expf(st.m[hh] - m_new);
        st.m[hh] = m_new;
        st.l[hh] *= alpha;
        if (MODE == 2) {
#pragma unroll
          for (int dt = 0; dt < 4; ++dt) st.O[hh][dt] *= alpha;
        }
        mL = full ? m_new * L2E : 1e30f;
      } else {
        mL = full ? st.m[hh] * L2E : 1e30f;
        il = invl[hh];
      }
      float rs = 0.f;
#pragma unroll
      for (int kt = 0; kt < 4; ++kt) {
        float a = 0.f;
#pragma unroll
        for (int j = 0; j < 4; ++j) {
          float pv = __builtin_amdgcn_exp2f(fmaf(S[kt][hh][j], L2E, -mL));
          if (MODE == 1) pv *= il;
          S[kt][hh][j] = pv;
          a += pv;
        }
        rs += a;
        if (MODE == 1) {
          impA[kt] += a;
          impE[kt] += S[kt][hh][3];
        }
      }
      if (MODE != 1 && !(FX && MODE == 2)) st.l[hh] += rs;
      if (MODE != 0) {
#pragma unroll
        for (int c = 0; c < 2; ++c)
          pf[hh][c] = mk8(pack2(S[2 * c][hh][0], S[2 * c][hh][1]), pack2(S[2 * c][hh][2], S[2 * c][hh][3]),
                          pack2(S[2 * c + 1][hh][0], S[2 * c + 1][hh][1]), pack2(S[2 * c + 1][hh][2], S[2 * c + 1][hh][3]));
      }
    }
  } else {
#pragma unroll
  for (int hh = 0; hh < 2; ++hh) {
    if (FX) {
      constexpr float L2E = 1.4426950408889634f;
      const float il = (MODE == 1) ? invl[hh] : 1.f;
      float rs = 0.f;
#pragma unroll
      for (int kt = 0; kt < 4; ++kt) {
        float a = 0.f;
#pragma unroll
        for (int j = 0; j < 4; ++j) {
          const int kl = kt * 16 + quad * 4 + j;
          const bool v = (kl >= lo) && (kl <= hi);
          float pv = v ? __builtin_amdgcn_exp2f(fmaf(S[kt][hh][j], L2E, -CL)) : 0.f;
          if (MODE == 1) pv *= il;
          S[kt][hh][j] = pv;
          a += pv;
        }
        rs += a;
        if (MODE == 1) {
          impA[kt] += a;
          impE[kt] += S[kt][hh][3];
        }
      }
      if (MODE != 1 && !(FX && MODE == 2)) st.l[hh] += rs;
      if (MODE != 0) {
#pragma unroll
        for (int c = 0; c < 2; ++c)
          pf[hh][c] = mk8(pack2(S[2 * c][hh][0], S[2 * c][hh][1]), pack2(S[2 * c][hh][2], S[2 * c][hh][3]),
                          pack2(S[2 * c + 1][hh][0], S[2 * c + 1][hh][1]), pack2(S[2 * c + 1][hh][2], S[2 * c + 1][hh][3]));
      }
      continue;
    }
    float mx = -1e30f;
#pragma unroll
    for (int kt = 0; kt < 4; ++kt)
#pragma unroll
      for (int j = 0; j < 4; ++j) {
        int kl = kt * 16 + quad * 4 + j;
        bool v = (kl >= lo) && (kl <= hi);
        float sv = v ? S[kt][hh][j] : -1e30f;
        S[kt][hh][j] = sv;
        mx = fmaxf(mx, sv);
      }
    if (MODE != 1) {
      mx = fmaxf(mx, shx(mx, 16, lane));
      mx = fmaxf(mx, shx(mx, 32, lane));
      float m_new = fmaxf(st.m[hh], mx);
      float alpha = __expf(st.m[hh] - m_new);
      st.m[hh] = m_new;
      float rs = 0.f;
#pragma unroll
      for (int kt = 0; kt < 4; ++kt)
#pragma unroll
        for (int j = 0; j < 4; ++j) {
          float sv = S[kt][hh][j];
          float pv = (sv > -1e29f) ? __expf(sv - m_new) : 0.f;
          rs += pv;
          S[kt][hh][j] = pv;
        }
      st.l[hh] = st.l[hh] * alpha + rs;
      if (MODE == 2) {
#pragma unroll
        for (int dt = 0; dt < 4; ++dt) st.O[hh][dt] *= alpha;
      }
    } else {
      const float mh = st.m[hh], il = invl[hh];
#pragma unroll
      for (int kt = 0; kt < 4; ++kt) {
        float a = 0.f;
#pragma unroll
        for (int j = 0; j < 4; ++j) {
          float sv = S[kt][hh][j];
          float pv = (sv > -1e29f) ? __expf(sv - mh) * il : 0.f;
          S[kt][hh][j] = pv;
          a += pv;
        }
        impA[kt] += a;
        impE[kt] += S[kt][hh][3];
      }
    }
    if (MODE != 0) {
#pragma unroll
      for (int c = 0; c < 2; ++c)
        pf[hh][c] = mk8(pack2(S[2 * c][hh][0], S[2 * c][hh][1]), pack2(S[2 * c][hh][2], S[2 * c][hh][3]),
                        pack2(S[2 * c + 1][hh][0], S[2 * c + 1][hh][1]), pack2(S[2 * c + 1][hh][2], S[2 * c + 1][hh][3]));
    }
  }
  }
  if (MODE != 0) {
#pragma unroll
    for (int dt = 0; dt < 4; ++dt) {
      const int row = dt * 16 + col;
      const int sw = (row >> 1) & 7;
#pragma unroll
      for (int c = 0; c < 2; ++c) {
        uint2 a = *(const uint2*)(Vs + row * 64 + (((4 * c + (quad >> 1)) ^ sw) << 3) + (quad & 1) * 4);
        uint2 b = *(const uint2*)(Vs + row * 64 + (((4 * c + 2 + (quad >> 1)) ^ sw) << 3) + (quad & 1) * 4);
        bf16x8 vf = mk8(a.x, a.y, b.x, b.y);
#pragma unroll
        for (int hh = 0; hh < 2; ++hh) st.O[hh][dt] = mfma16(vf, pf[hh][c], st.O[hh][dt]);
      }
    }
    if (FX && MODE == 2) {
      const bf16x8 ones = mk8(0x3F803F80u, 0x3F803F80u, 0x3F803F80u, 0x3F803F80u);
#pragma unroll
      for (int c = 0; c < 2; ++c)
#pragma unroll
        for (int hh = 0; hh < 2; ++hh) st.L[hh] = mfma16(ones, pf[hh][c], st.L[hh]);
    }
  }
}

DI void st_reset(AttnSt& st) {
#pragma unroll
  for (int h = 0; h < 2; ++h) {
    st.m[h] = -1e30f;
    st.l[h] = 0.f;
    st.L[h] = f32x4{0.f, 0.f, 0.f, 0.f};
#pragma unroll
    for (int dt = 0; dt < 4; ++dt) st.O[h][dt] = f32x4{0.f, 0.f, 0.f, 0.f};
  }
}

template <bool FIRST>
DI void nsa_flush(const int quad, bf16_t* optr, const AttnSt& st, const float (&sc)[2]) {
#pragma unroll
  for (int h = 0; h < 2; ++h)
#pragma unroll
    for (int dt = 0; dt < 4; ++dt) {
      uint2* q = (uint2*)(optr + h * 64 + dt * 16 + quad * 4);
      f32x4 o = st.O[h][dt] * sc[h];
      if (!FIRST) {
        uint2 pv = *q;
        o[0] += bflo(pv.x); o[1] += bfhi(pv.x); o[2] += bflo(pv.y); o[3] += bfhi(pv.y);
      }
      uint2 u;
      u.x = pack2(o[0], o[1]);
      u.y = pack2(o[2], o[3]);
      *q = u;
    }
}

template <bool FX>
DI void nsa_tile(const Params& p, int b, int g, int tile, bf16_t* lds, const float CL) {
  const int tid = TID(), lane = tid & 63, w = tid >> 6, quad = lane >> 4, col = lane & 15;
  const int cur = tile;
  const int tok = tile * 64 + w * 16 + col;
  bf16_t* z = (bf16_t*)(p.ws + O_Z);
  const bf16_t* kcmp = (const bf16_t*)(p.ws + O_KCMP) + (size_t)(b * 2 + g) * 512 * 64;
  const bf16_t* vcmpT = (const bf16_t*)(p.ws + O_VCMPT) + (size_t)(b * 2 + g) * 64 * 512;
  const bf16_t* vsT = (const bf16_t*)(p.ws + O_VST) + (size_t)(b * 2 + g) * 64 * TS;
  const bf16_t* vwT = (const bf16_t*)(p.ws + O_VWT) + (size_t)(b * 2 + g) * 64 * TS;
  const bf16_t* zb = z + (size_t)b * SEQ * ZS;
  const bf16_t* ztok = z + ((size_t)(b * SEQ + tok)) * ZS;
  bf16_t* otok = (bf16_t*)(p.ws + O_ONSA) + ((size_t)(b * SEQ + tok)) * 512 + g * 256;
  bf16_t* Ks = lds;
  bf16_t* Vs = lds + 4096;
  float* impl = (float*)(lds + 8192);

  AttnSt st;
  float invl[2] = {0.f, 0.f};
  float dA[4] = {0.f, 0.f, 0.f, 0.f}, dE[4] = {0.f, 0.f, 0.f, 0.f};
  u32x4 rk0, rk1, rv0, rv1;
  bf16x8 qf[2][2];

  const int ncs = (cur < 16) ? 1 : (cur >> 4) + 1;
  const int chi = (tok >= 31) ? ((tok - 31) >> 4) : -1;

  for (int hp = 0; hp < 2; ++hp) {
#pragma unroll
    for (int hh = 0; hh < 2; ++hh)
#pragma unroll
      for (int ks = 0; ks < 2; ++ks) qf[hh][ks] = *(const bf16x8*)(ztok + C_Q + g * 256 + (hp * 2 + hh) * 64 + ks * 32 + quad * 8);
    st_reset(st);
    tile64_gload(tid, rk0, rk1, kcmp, 64);
    for (int s = 0; s < ncs; ++s) {
      __syncthreads();
      tile64_sstore(tid, Ks, rk0, rk1);
      __syncthreads();
      if (s + 1 < ncs) tile64_gload(tid, rk0, rk1, kcmp + (size_t)(s + 1) * 4096, 64);
      attn_compute<0, FX>(lane, Ks, Vs, qf, st, invl, 0, chi - s * 64, dA, dE, CL);
    }
#pragma unroll
    for (int h = 0; h < 2; ++h) {
      float l = st.l[h];
      l += shx(l, 16, lane);
      l += shx(l, 32, lane);
      invl[h] = (l > 0.f) ? 1.f / l : 0.f;
    }
    {
      float carry = 0.f;
      tile64_gload(tid, rk0, rk1, kcmp, 64);
      tile64_gload(tid, rv0, rv1, vcmpT, 512);
      for (int s = 0; s < ncs; ++s) {
        float iA[4] = {0.f, 0.f, 0.f, 0.f}, iE[4] = {0.f, 0.f, 0.f, 0.f};
        __syncthreads();
        tile64_sstore(tid, Ks, rk0, rk1);
        tile64_sstore(tid, Vs, rv0, rv1);
        __syncthreads();
        if (s + 1 < ncs) {
          tile64_gload(tid, rk0, rk1, kcmp + (size_t)(s + 1) * 4096, 64);
          tile64_gload(tid, rv0, rv1, vcmpT + (s + 1) * 64, 512);
        }
        attn_compute<1, FX>(lane, Ks, Vs, qf, st, invl, 0, chi - s * 64, iA, iE, CL);
#pragma unroll
        for (int kt = 0; kt < 4; ++kt) {
          float recv = shfrom(iE[kt], (lane + 48) & 63);
          float val = iA[kt] + ((quad == 0) ? carry : recv);
          carry = recv;
          float* slot = impl + (s * 4 + kt) * 256 + tid;
          if (hp == 0) *slot = val; else *slot += val;
        }
      }
    }
    {
      float sc[2];
#pragma unroll
      for (int h = 0; h < 2; ++h) sc[h] = sigmoidf(bf2f(ztok[C_GT + 0 * 8 + g * 4 + hp * 2 + h]));
      nsa_flush<true>(quad, otok + hp * 128, st, sc);
    }
  }

  uint32_t sw0, sw1, sw2, sw3;
  {
    uint32_t key[32];
#pragma unroll
    for (int i = 0; i < 32; ++i) {
      int j = i * 4 + quad;
      float sc = (i < ncs * 4) ? impl[i * 256 + tid] : 0.f;
      if (j == 0 || j == cur || j == cur - 1) sc = 1e4f;
      uint32_t k = (__float_as_uint(sc) & ~127u) | (uint32_t)(127 - j);
      key[i] = (j > cur) ? 0u : k;
    }
    uint32_t prev = 0xFFFFFFFFu;
    for (int r = 0; r < 16; ++r) {
      uint32_t mx = 0u;
#pragma unroll
      for (int i = 0; i < 32; ++i) {
        uint32_t k = key[i];
        k = (k < prev) ? k : 0u;
        mx = (k > mx) ? k : mx;
      }
      uint32_t o = shxu(mx, 16, lane);
      mx = (o > mx) ? o : mx;
      o = shxu(mx, 32, lane);
      mx = (o > mx) ? o : mx;
      prev = mx;
    }
    sw0 = 0u; sw1 = 0u; sw2 = 0u; sw3 = 0u;
#pragma unroll
    for (int i = 0; i < 32; ++i) {
      bool sel = (key[i] != 0u) && (key[i] >= prev);
      uint32_t bit = sel ? (1u << ((i & 7) * 4 + quad)) : 0u;
      if ((i >> 3) == 0) sw0 |= bit;
      else if ((i >> 3) == 1) sw1 |= bit;
      else if ((i >> 3) == 2) sw2 |= bit;
      else sw3 |= bit;
    }
    sw0 |= shxu(sw0, 16, lane); sw0 |= shxu(sw0, 32, lane);
    sw1 |= shxu(sw1, 16, lane); sw1 |= shxu(sw1, 32, lane);
    sw2 |= shxu(sw2, 16, lane); sw2 |= shxu(sw2, 32, lane);
    sw3 |= shxu(sw3, 16, lane); sw3 |= shxu(sw3, 32, lane);
  }

  for (int hp = 0; hp < 2; ++hp) {
#pragma unroll
    for (int hh = 0; hh < 2; ++hh)
#pragma unroll
      for (int ks = 0; ks < 2; ++ks) qf[hh][ks] = *(const bf16x8*)(ztok + C_Q + g * 256 + (hp * 2 + hh) * 64 + ks * 32 + quad * 8);
    st_reset(st);
    {
      const bf16_t* kb = zb + C_KS + g * 64;
      tile64_gload(tid, rk0, rk1, kb, ZS);
      tile64_gload(tid, rv0, rv1, vsT, TS);
      for (int s = 0; s <= cur; ++s) {
        __syncthreads();
        tile64_sstore(tid, Ks, rk0, rk1);
        tile64_sstore(tid, Vs, rv0, rv1);
        __syncthreads();
        if (s < cur) {
          tile64_gload(tid, rk0, rk1, kb + (size_t)(s + 1) * 64 * ZS, ZS);
          tile64_gload(tid, rv0, rv1, vsT + (s + 1) * 64, TS);
        }
        uint32_t wsel = (s < 32) ? sw0 : (s < 64) ? sw1 : (s < 96) ? sw2 : sw3;
        bool sel = (wsel >> (s & 31)) & 1u;
        int hi = sel ? (tok - s * 64) : -1;
        if (__any(hi >= 0)) attn_compute<2, FX>(lane, Ks, Vs, qf, st, invl, 0, hi, dA, dE, CL);
      }
    }
    {
      float sc[2];
#pragma unroll
      for (int h = 0; h < 2; ++h) {
        float l;
        if (FX) {
          l = st.L[h][0];
        } else {
          l = st.l[h];
          l += shx(l, 16, lane);
          l += shx(l, 32, lane);
        }
        sc[h] = (l > 0.f) ? sigmoidf(bf2f(ztok[C_GT + 1 * 8 + g * 4 + hp * 2 + h])) / l : 0.f;
      }
      nsa_flush<false>(quad, otok + hp * 128, st, sc);
    }
    st_reset(st);
    {
      const bf16_t* kb = zb + C_KW + g * 64;
      const int s0 = (cur >= 8) ? cur - 8 : 0;
      tile64_gload(tid, rk0, rk1, kb + (size_t)s0 * 64 * ZS, ZS);
      tile64_gload(tid, rv0, rv1, vwT + s0 * 64, TS);
      for (int s = s0; s <= cur; ++s) {
        __syncthreads();
        tile64_sstore(tid, Ks, rk0, rk1);
        tile64_sstore(tid, Vs, rv0, rv1);
        __syncthreads();
        if (s < cur) {
          tile64_gload(tid, rk0, rk1, kb + (size_t)(s + 1) * 64 * ZS, ZS);
          tile64_gload(tid, rv0, rv1, vwT + (s + 1) * 64, TS);
        }
        attn_compute<2, FX>(lane, Ks, Vs, qf, st, invl, tok - 511 - s * 64, tok - s * 64, dA, dE, CL);
      }
    }
    {
      float sc[2];
#pragma unroll
      for (int h = 0; h < 2; ++h) {
        float l;
        if (FX) {
          l = st.L[h][0];
        } else {
          l = st.l[h];
          l += shx(l, 16, lane);
          l += shx(l, 32, lane);
        }
        sc[h] = (l > 0.f) ? sigmoidf(bf2f(ztok[C_GT + 2 * 8 + g * 4 + hp * 2 + h])) / l : 0.f;
      }
      nsa_flush<false>(quad, otok + hp * 128, st, sc);
    }
  }
}

DI void load128(int tid, bf16_t* lds, const bf16_t* base, size_t stride) {
  u32x4 r[8];
#pragma unroll
  for (int i = 0; i < 8; ++i) {
    int idx = tid + 256 * i;
    int row = idx >> 4, ch = idx & 15;
    r[i] = *(const u32x4*)(base + (size_t)row * stride + ch * 8);
  }
#pragma unroll
  for (int i = 0; i < 8; ++i) {
    int idx = tid + 256 * i;
    int row = idx >> 4, ch = idx & 15;
    *(u32x4*)(lds + row * 128 + ((ch ^ (row & 15)) << 3)) = r[i];
  }
}

DI void ret_tile(const Params& p, int b, int h, int c, bf16_t* lds) {
  const int tid = TID(), lane = tid & 63, w = tid >> 6, quad = lane >> 4, col = lane & 15;
  const float lg2 = log2f(1.f - exp2f(-5.f - (float)h));
  bf16_t* z = (bf16_t*)(p.ws + O_Z);
  const bf16_t* rvT = (const bf16_t*)(p.ws + O_RVT);
  bf16_t* zc = z + ((size_t)(b * SEQ + c * 128)) * ZS;
  bf16x8 qf[2][4];
#pragma unroll
  for (int nt = 0; nt < 2; ++nt)
#pragma unroll
    for (int ks = 0; ks < 4; ++ks) {
      int n = 32 * w + nt * 16 + col;
      qf[nt][ks] = *(const bf16x8*)(zc + (size_t)n * ZS + C_RQ + h * 128 + ks * 32 + quad * 8);
    }
  f32x4 acc[8][2];
#pragma unroll
  for (int et = 0; et < 8; ++et)
#pragma unroll
    for (int nt = 0; nt < 2; ++nt) acc[et][nt] = f32x4{0.f, 0.f, 0.f, 0.f};
  __syncthreads();
  load128(tid, lds, zc + C_RV + h * 128, ZS);
  __syncthreads();
#pragma unroll
  for (int ks = 0; ks < 4; ++ks)
#pragma unroll
    for (int et = 0; et < 8; ++et) {
      int row = et * 16 + col;
      bf16x8 af = *(const bf16x8*)(lds + row * 128 + (((ks * 4 + quad) ^ (row & 15)) << 3));
#pragma unroll
      for (int nt = 0; nt < 2; ++nt) acc[et][nt] = mfma16(af, qf[nt][ks], acc[et][nt]);
    }
#pragma unroll
  for (int nt = 0; nt < 2; ++nt) {
    int n = 32 * w + nt * 16 + col;
    float xi = exp2f(lg2 * (float)(n + 1));
#pragma unroll
    for (int et = 0; et < 8; ++et) acc[et][nt] *= xi;
  }
  __syncthreads();
  load128(tid, lds, zc + C_RK + h * 128, ZS);
  __syncthreads();
  bf16x8 pf[2][4];
#pragma unroll
  for (int nt = 0; nt < 2; ++nt) {
    f32x4 s[8];
#pragma unroll
    for (int mt = 0; mt < 8; ++mt) s[mt] = f32x4{0.f, 0.f, 0.f, 0.f};
#pragma unroll
    for (int ks = 0; ks < 4; ++ks)
#pragma unroll
      for (int mt = 0; mt < 8; ++mt) {
        if (mt <= 2 * w + 1) {
          int row = mt * 16 + col;
          bf16x8 af = *(const bf16x8*)(lds + row * 128 + (((ks * 4 + quad) ^ (row & 15)) << 3));
          s[mt] = mfma16(af, qf[nt][ks], s[mt]);
        }
      }
    const int n = 32 * w + nt * 16 + col;
#pragma unroll
    for (int c2 = 0; c2 < 4; ++c2) {
      float v[8];
#pragma unroll
      for (int i = 0; i < 8; ++i) {
        const int mt = 2 * c2 + (i >> 2), j = i & 3;
        const int m = mt * 16 + quad * 4 + j;
        v[i] = (n >= m) ? s[mt][j] * exp2f(lg2 * (float)(n - m)) : 0.f;
      }
      pf[nt][c2] = mk8(pack2(v[0], v[1]), pack2(v[2], v[3]), pack2(v[4], v[5]), pack2(v[6], v[7]));
    }
  }
  __syncthreads();
  load128(tid, lds, rvT + ((size_t)((b * 4 + h) * 128)) * TS + c * 128, TS);
  __syncthreads();
#pragma unroll
  for (int c2 = 0; c2 < 4; ++c2) {
    if (2 * c2 <= 2 * w + 1) {
#pragma unroll
      for (int et = 0; et < 8; ++et) {
        int row = et * 16 + col;
        int sw = row & 15;
        uint2 a = *(const uint2*)(lds + row * 128 + (((4 * c2 + (quad >> 1)) ^ sw) << 3) + (quad & 1) * 4);
        uint2 bb = *(const uint2*)(lds + row * 128 + (((4 * c2 + 2 + (quad >> 1)) ^ sw) << 3) + (quad & 1) * 4);
        bf16x8 vf = mk8(a.x, a.y, bb.x, bb.y);
#pragma unroll
        for (int nt = 0; nt < 2; ++nt) acc[et][nt] = mfma16(vf, pf[nt][c2], acc[et][nt]);
      }
    }
  }
#pragma unroll
  for (int nt = 0; nt < 2; ++nt) {
    float ss = 0.f;
#pragma unroll
    for (int et = 0; et < 8; ++et)
#pragma unroll
      for (int j = 0; j < 4; ++j) ss += acc[et][nt][j] * acc[et][nt][j];
    ss += shx(ss, 16, lane);
    ss += shx(ss, 32, lane);
    const float rs = rsqrtf(ss * (1.f / 128.f) + 1e-6f);
    const int n = 32 * w + nt * 16 + col;
    bf16_t* zr = zc + (size_t)n * ZS;
#pragma unroll
    for (int et = 0; et < 8; ++et) {
      const int e0 = et * 16 + quad * 4;
      uint2 gv = *(const uint2*)(zr + C_RG + h * 128 + e0);
      float g0 = bflo(gv.x), g1 = bfhi(gv.x), g2 = bflo(gv.y), g3 = bfhi(gv.y);
      uint2 o;
      o.x = pack2(acc[et][nt][0] * rs * g0 * sigmoidf(g0), acc[et][nt][1] * rs * g1 * sigmoidf(g1));
      o.y = pack2(acc[et][nt][2] * rs * g2 * sigmoidf(g2), acc[et][nt][3] * rs * g3 * sigmoidf(g3));
      *(uint2*)(zr + C_RQ + h * 128 + e0) = o;
    }
  }
}

#define GEMM_TILE_LOOP(NT)                                                             \
  for (int qp_ = (int)(blockIdx.x >> 3), per_ = (int)(gridDim.x >> 3), xcd_ = (int)(blockIdx.x & 7), q_ = 0, mt = 0, ntile = 0; \
       2 * qp_ < 32 * (NT) && ((q_ = 2 * qp_ + HALF()), (mt = (((xcd_ + 8 * (q_ / (8 * (NT)))) << 3) + ((q_ % (8 * (NT))) & 7)), ntile = ((q_ % (8 * (NT))) >> 3)), true); \
       qp_ += per_)


DI int TID8() { int t = threadIdx.x; asm volatile("" : "+v"(t)); return t; }
DI void g8_load(u32x4 (&ra)[4], u32x4 (&rb)[4], const bf16_t* a, size_t lda, const bf16_t* b, size_t ldb, int kb, int lrow, int lch) {
#pragma unroll
  for (int i = 0; i < 4; ++i) {
    ra[i] = *(const u32x4*)(a + (size_t)(lrow + 64 * i) * lda + kb * 64 + lch * 8);
    rb[i] = *(const u32x4*)(b + (size_t)(lrow + 64 * i) * ldb + kb * 64 + lch * 8);
  }
}
DI void g8_store(bf16_t* S, const u32x4 (&ra)[4], const u32x4 (&rb)[4], int lrow, int lch) {
#pragma unroll
  for (int i = 0; i < 4; ++i) {
    const int r = lrow + 64 * i;
    const int off = r * 64 + ((lch ^ ((r >> 1) & 7)) << 3);
    *(u32x4*)(S + off) = ra[i];
    *(u32x4*)(S + 16384 + off) = rb[i];
  }
}
DI void g8_load1(u32x4 (&r4)[4], const bf16_t* a, size_t lda, int kb, int lrow, int lch) {
  const bf16_t* base = a + kb * 64;
  const unsigned ld32 = (unsigned)lda;
#pragma unroll
  for (int i = 0; i < 4; ++i) {
    const unsigned off = (unsigned)(lrow + 64 * i) * ld32 + (unsigned)(lch * 8);
    r4[i] = *(const u32x4*)(base + off);
  }
}
DI void g8_store1(bf16_t* S, const u32x4 (&r4)[4], int lrow, int lch) {
#pragma unroll
  for (int i = 0; i < 4; ++i) {
    const int r = lrow + 64 * i;
    *(u32x4*)(S + r * 64 + ((lch ^ ((r >> 1) & 7)) << 3)) = r4[i];
  }
}
template <int KS0 = 0, int KS1 = 2>
DI void g8_compute(f32x4 (&acc)[8][4], const bf16_t* S, int wm, int wn, int lane) {
#pragma unroll
  for (int ks = KS0; ks < KS1; ++ks) {
    bf16x8 af[8], bfr[4];
#pragma unroll
    for (int i = 0; i < 8; ++i) {
      const int r = wm * 128 + i * 16 + (lane & 15);
      af[i] = *(const bf16x8*)(S + r * 64 + (((ks * 4 + (lane >> 4)) ^ ((r >> 1) & 7)) << 3));
    }
#pragma unroll
    for (int j = 0; j < 4; ++j) {
      const int r = wn * 64 + j * 16 + (lane & 15);
      bfr[j] = *(const bf16x8*)(S + 16384 + r * 64 + (((ks * 4 + (lane >> 4)) ^ ((r >> 1) & 7)) << 3));
    }
    __builtin_amdgcn_s_setprio(1);
#pragma unroll
    for (int i = 0; i < 8; ++i)
#pragma unroll
      for (int j = 0; j < 4; ++j) acc[i][j] = mfma16(bfr[j], af[i], acc[i][j]);
    __builtin_amdgcn_s_setprio(0);
  }
}
DI void g8_load1o(u32x4 (&r4)[4], const bf16_t* base, const unsigned (&off)[4]) {
#pragma unroll
  for (int i = 0; i < 4; ++i) r4[i] = *(const u32x4*)(base + off[i]);
}
DI void gemm8_accum(f32x4 (&acc)[8][4], const bf16_t* a, size_t lda, const bf16_t* b, size_t ldb, int nkb, bf16_t* L,
                    const bool pre, const bf16_t* an, size_t ldan, const bf16_t* bn, size_t ldbn) {
  const int tid = TID8(), lane = tid & 63, w = tid >> 6;
  const int wm = w >> 2, wn = w & 3;
  const int lrow = tid >> 3, lch = tid & 7;
  u32x4 ra[4], rb[4];
  unsigned offa[4], offb[4];
#pragma unroll
  for (int i = 0; i < 4; ++i) {
    offa[i] = (unsigned)(lrow + 64 * i) * (unsigned)lda + (unsigned)(lch * 8);
    offb[i] = (unsigned)(lrow + 64 * i) * (unsigned)ldb + (unsigned)(lch * 8);
  }
  if (!pre) {
    g8_load1o(ra, a, offa);
    g8_load1o(rb, b, offb);
    __syncthreads();
    g8_store(L, ra, rb, lrow, lch);
  }
  g8_load1o(ra, a + 64, offa);
  g8_load1o(rb, b + 64, offb);
  for (int kb = 0; kb + 2 < nkb; ++kb) {
    __syncthreads();
    g8_store1(L + ((kb + 1) & 1) * 32768, ra, lrow, lch);
    g8_load1o(ra, a + (kb + 2) * 64, offa);
    __builtin_amdgcn_sched_barrier(0);
    g8_compute<0, 1>(acc, L + (kb & 1) * 32768, wm, wn, lane);
    __builtin_amdgcn_sched_barrier(0);
    g8_store1(L + ((kb + 1) & 1) * 32768 + 16384, rb, lrow, lch);
    g8_load1o(rb, b + (kb + 2) * 64, offb);
    __builtin_amdgcn_sched_barrier(0);
    g8_compute<1, 2>(acc, L + (kb & 1) * 32768, wm, wn, lane);
  }
  __syncthreads();
  g8_store1(L + 32768, ra, lrow, lch);
  g8_load1(ra, an, ldan, 0, lrow, lch);
  __builtin_amdgcn_sched_barrier(0);
  g8_compute<0, 1>(acc, L, wm, wn, lane);
  __builtin_amdgcn_sched_barrier(0);
  g8_store1(L + 32768 + 16384, rb, lrow, lch);
  g8_load1(rb, bn, ldbn, 0, lrow, lch);
  __builtin_amdgcn_sched_barrier(0);
  g8_compute<1, 2>(acc, L, wm, wn, lane);
  __syncthreads();
  g8_store1(L, ra, lrow, lch);
  __builtin_amdgcn_sched_barrier(0);
  g8_compute<0, 1>(acc, L + 32768, wm, wn, lane);
  __builtin_amdgcn_sched_barrier(0);
  g8_store1(L + 16384, rb, lrow, lch);
  __builtin_amdgcn_sched_barrier(0);
  g8_compute<1, 2>(acc, L + 32768, wm, wn, lane);
  __syncthreads();
}
DI void zero_acc8(f32x4 (&acc)[8][4]) {
#pragma unroll
  for (int i = 0; i < 8; ++i)
#pragma unroll
    for (int j = 0; j < 4; ++j) acc[i][j] = f32x4{0.f, 0.f, 0.f, 0.f};
}
template <class F>
DI void gemm8_epi_staged(f32x4 (&acc)[8][4], int m0, int n0, bf16_t* L0, F f, bf16_t* dst, size_t ld, int nmax) {
  bf16_t* L = L0 + 32768;
  const int tid = TID8(), lane = tid & 63, w = tid >> 6;
  const int wm = w >> 2, wn = w & 3;
#pragma unroll
  for (int half = 0; half < 2; ++half) {
    if (wm == half) {
#pragma unroll
      for (int i = 0; i < 8; ++i)
#pragma unroll
        for (int j = 0; j < 4; ++j) {
          const int ml = i * 16 + (lane & 15);
          const int nl = wn * 64 + j * 16 + (lane >> 4) * 4;
          f32x4 a = acc[i][j];
          f(m0 + half * 128 + ml, n0 + nl, a);
          uint2 u;
          u.x = pack2(a[0], a[1]);
          u.y = pack2(a[2], a[3]);
          *(uint2*)(L + ml * 264 + nl) = u;
        }
    }
    __syncthreads();
#pragma unroll
    for (int it = 0; it < 8; ++it) {
      const int idx = tid + 512 * it;
      const int row = idx >> 5, ch = idx & 31;
      const u32x4 v = *(const u32x4*)(L + row * 264 + ch * 8);
      const int n = n0 + ch * 8;
      if (n < nmax) *(u32x4*)(dst + (size_t)(m0 + half * 128 + row) * ld + n) = v;
    }
    __syncthreads();
  }
}
DI void gemm8_epi_resid(f32x4 (&acc)[8][4], int m0, int n0, int ntile8, bf16_t* L, const float* xin, float* out, bf16_t* xb, float* rowpart) {
  const int tid = TID8(), lane = tid & 63, w = tid >> 6;
  const int wm = w >> 2, wn = w & 3;
  float* red = (float*)(L + 32768);
#pragma unroll
  for (int i = 0; i < 8; ++i) {
    const int ml = wm * 128 + i * 16 + (lane & 15);
    const size_t rowoff = (size_t)(m0 + ml) * DM;
    float ss = 0.f;
#pragma unroll
    for (int j = 0; j < 4; ++j) {
      const int n = n0 + wn * 64 + j * 16 + (lane >> 4) * 4;
      const float4 xv = *(const float4*)(xin + rowoff + n);
      const float o0 = xv.x + acc[i][j][0], o1 = xv.y + acc[i][j][1], o2 = xv.z + acc[i][j][2], o3 = xv.w + acc[i][j][3];
      *(float4*)(out + rowoff + n) = make_float4(o0, o1, o2, o3);
      ss += o0 * o0 + o1 * o1 + o2 * o2 + o3 * o3;
      uint2 u;
      u.x = pack2(o0, o1);
      u.y = pack2(o2, o3);
      *(uint2*)(xb + rowoff + n) = u;
    }
    ss += shx(ss, 16, lane);
    ss += shx(ss, 32, lane);
    if ((lane >> 4) == 0) red[wn * 256 + ml] = ss;
  }
  __syncthreads();
  {
    const int row = tid & 255, h = tid >> 8;
    rowpart[(size_t)(ntile8 * 2 + h) * T_TOK + m0 + row] = red[(2 * h) * 256 + row] + red[(2 * h + 1) * 256 + row];
  }
}
template <class E>
DI void gemm8_epi(f32x4 (&acc)[8][4], int m0, int n0, E e) {
  const int tid = TID8(), lane = tid & 63, w = tid >> 6;
  const int wm = w >> 2, wn = w & 3;
#pragma unroll
  for (int i = 0; i < 8; ++i)
#pragma unroll
    for (int j = 0; j < 4; ++j) {
      const int m = m0 + wm * 128 + i * 16 + (lane & 15);
      const int n = n0 + wn * 64 + j * 16 + (lane >> 4) * 4;
      e(m, n, acc[i][j]);
    }
}
DI void row_rs8(float (&rsv)[8], const float* rowpart, int m0) {
  const int tid = TID8(), lane = tid & 63, wm = tid >> 8;
#pragma unroll
  for (int i = 0; i < 8; ++i) {
    const int m = m0 + wm * 128 + i * 16 + (lane & 15);
    float s = 0.f;
#pragma unroll
    for (int t = 0; t < 8; ++t) s += rowpart[(size_t)t * T_TOK + m];
    rsv[i] = rsqrtf(s * (1.f / 1024.f) + 1e-6f);
  }
}
DI void scale_rows8(f32x4 (&acc)[8][4], const float (&rsv)[8]) {
#pragma unroll
  for (int i = 0; i < 8; ++i)
#pragma unroll
    for (int j = 0; j < 4; ++j) acc[i][j] *= rsv[i];
}
#define G8_TILE(q, NT8, MT, NTL) \
  MT = (((xcd_ + 8 * ((q) / (4 * (NT8)))) << 2) + (((q) % (4 * (NT8))) & 3)); NTL = (((q) % (4 * (NT8))) >> 2);
#define GEMM8_TILE_LOOP(NT8)                                                            \
  for (int q_ = (int)(blockIdx.x >> 3), per_ = (int)(gridDim.x >> 3), xcd_ = (int)(blockIdx.x & 7), first_ = 1, mt = 0, ntile = 0, mtn = 0, ntilen = 0; \
       q_ < 16 * (NT8) && ([&] { G8_TILE(q_, NT8, mt, ntile) const int qn_ = (q_ + per_ < 16 * (NT8)) ? q_ + per_ : q_; G8_TILE(qn_, NT8, mtn, ntilen) }(), true); \
       q_ += per_, first_ = 0)

#define XB_TMO      128
#define XB_XCNT(j)  (256  + 64 * (j))
#define XB_XSUB(j)  (1280 + 64 * (j))
#define XB_XGEN(j)  (2304 + 64 * (j))
#define XB_TOP      3328
#define XB_TOPGEN   3392
#define XB_SPIN_CAP (1u << 20)
DI unsigned xb_ld(unsigned* p) { return __hip_atomic_load(p, __ATOMIC_RELAXED, __HIP_MEMORY_SCOPE_AGENT); }
DI unsigned xb_add(unsigned* p, unsigned v) { return __hip_atomic_fetch_add(p, v, __ATOMIC_RELAXED, __HIP_MEMORY_SCOPE_AGENT); }
DI unsigned xb_xcc_id() { return (unsigned)__builtin_amdgcn_s_getreg((3 << 11) | 20) & 0xFu; }
#define XB_SPIN(cond, bar) do { unsigned _sp = 0; while (cond) { __builtin_amdgcn_s_sleep(1); \
    if ((++_sp & 255u) == 0u) { if (xb_ld(&(bar)[XB_TMO])) break; if (_sp > XB_SPIN_CAP) { atomicAdd(&(bar)[XB_TMO], 1u); break; } } } } while (0)

DI void xcd_barrier(unsigned* bar, const unsigned x, const unsigned nloc, const unsigned nx) {
  asm volatile("s_waitcnt vmcnt(0)" ::: "memory");
  __syncthreads();
  if (threadIdx.x == 0) {
    __builtin_amdgcn_s_waitcnt(0);
    const unsigned old = xb_add(&bar[XB_XSUB(x)], 1u);
    const unsigned gen = old / nloc;
    if (old + 1u == (gen + 1u) * nloc) {
      __builtin_amdgcn_fence(__ATOMIC_RELEASE, "agent");
      asm volatile("s_waitcnt vmcnt(0)" ::: "memory");
      const unsigned og = xb_add(&bar[XB_TOP], 1u);
      const unsigned tg = og / nx;
      if (og + 1u == (tg + 1u) * nx) xb_add(&bar[XB_TOPGEN], 1u);
      else XB_SPIN(xb_ld(&bar[XB_TOPGEN]) == tg, bar);
      __builtin_amdgcn_fence(__ATOMIC_ACQUIRE, "agent");
      xb_add(&bar[XB_XGEN(x)], 1u);
      asm volatile("s_waitcnt vmcnt(0)" ::: "memory");
    } else {
      XB_SPIN(xb_ld(&bar[XB_XGEN(x)]) == gen, bar);
      __builtin_amdgcn_fence(__ATOMIC_ACQUIRE, "agent");
      asm volatile("s_waitcnt vmcnt(0)" ::: "memory");
    }
  }
  __syncthreads();
}

__global__ void __launch_bounds__(512, 2) mega(Params p) {
  extern __shared__ __attribute__((aligned(16))) bf16_t lds_all[];
  bf16_t* lds = lds_all + HALF() * 32768;
  cg::grid_group grid = cg::this_grid();
  const int nb = NVB;
  bf16_t* wt = (bf16_t*)(p.ws + O_WT);
  bf16_t* z = (bf16_t*)(p.ws + O_Z);
  bf16_t* hbuf = (bf16_t*)(p.ws + O_VST);
  bf16_t* ubuf = z;
  bf16_t* p16 = (bf16_t*)(p.ws + O_KVD);
  float* rowpart = (float*)(p.ws + O_RP);
  bf16_t* hid = (bf16_t*)(p.ws + O_HID);
  const float* bias = (const float*)(p.ws + O_BIAS);

  unsigned* bar = (unsigned*)(p.ws + O_BAR);
  const unsigned xb_x = xb_xcc_id();
  if (threadIdx.x == 0) (void)xb_add(&bar[XB_XCNT(xb_x)], 1u);
  unsigned xb_nloc = 1u, xb_nx = 1u;

  for (int layer = 0; layer < 2; ++layer) {
    const bf16_t* wl = wt;
    const float* xin = (layer == 0) ? p.x : p.out;

    phase0(p, layer, lds);
    norm_phase(xin, p.norm_mix + layer * DM, hbuf);
    if (layer == 0) {
      grid.sync();
      unsigned mine = 0u, cnt = 0u;
#pragma unroll
      for (unsigned j = 0; j < 16; ++j) {
        const unsigned c = xb_ld(&bar[XB_XCNT(j)]);
        cnt += (c > 0u) ? 1u : 0u;
        mine = (j == xb_x) ? c : mine;
      }
      xb_nloc = __builtin_amdgcn_readfirstlane(mine > 0u ? mine : 1u);
      xb_nx = __builtin_amdgcn_readfirstlane(cnt > 0u ? cnt : 1u);
    } else {
      xcd_barrier(bar, xb_x, xb_nloc, xb_nx);
    }

    GEMM8_TILE_LOOP(22) {
      const int m0 = mt * 256, n0 = ntile * 256;
      f32x4 acc8[8][4];
      zero_acc8(acc8);
      gemm8_accum(acc8, hbuf + (size_t)m0 * DM, DM, wl + W_IN + (size_t)n0 * 1024, 1024, 16, lds_all, !first_,
                  hbuf + (size_t)mtn * 256 * DM, DM, wl + W_IN + (size_t)ntilen * 256 * 1024, 1024);
      gemm8_epi_staged(acc8, m0, n0, lds_all, [&](int, int, f32x4&) {}, z, ZS, ZS);
    }
    xcd_barrier(bar, xb_x, xb_nloc, xb_nx);

    post_z(p, layer);
    xcd_barrier(bar, xb_x, xb_nloc, xb_nx);

    for (int u_ = (int)blockIdx.x, t = 0; (u_ < 64 || u_ - 64 < 512) && ((t = (u_ < 64) ? 2 * u_ + HALF() : 128 + 2 * (u_ - 64) + HALF()), true); u_ = (u_ < 64) ? 1 << 20 : u_ + (int)gridDim.x - 64) {
      f32x4 acc[4][4];
      zero_acc(acc);
      if (t < 128) {
        const int kv = t >> 6, mt = (t >> 1) & 31, ntile = t & 1;
        const int m0 = mt * 128, n0 = ntile * 128;
        const bf16_t* kvd = (const bf16_t*)(p.ws + O_KVD) + (size_t)kv * 8 * SEQ * 64;
        auto ap = [&](int r, int kb) -> const bf16_t* {
          int row = m0 + r;
          int bg = row >> 9, c = row & 511;
          int tk = 16 * c + kb;
          tk = tk > (SEQ - 1) ? (SEQ - 1) : tk;
          return kvd + ((size_t)(bg * SEQ + tk)) * 64;
        };
        gemm_accum(acc, ap, RowPtr{wl + (kv ? W_C1V : W_C1K) + (size_t)n0 * 2048, 2048}, 32, lds);
        const float* bs = bias + kv * 256;
        bf16_t* hd = hid + (size_t)kv * 4096 * 256;
        gemm_epi(acc, m0, n0, [&](int m, int n, f32x4& a) {
          float o[4];
#pragma unroll
          for (int j = 0; j < 4; ++j) {
            float xv = a[j] + bs[n + j];
            float y = 0.7978845608028654f * (xv + 0.044715f * xv * xv * xv);
            float th = 1.f - 2.f * __builtin_amdgcn_rcpf(__expf(2.f * y) + 1.f);
            o[j] = 0.5f * xv * (1.f + th);
          }
          uint2 u;
          u.x = pack2(o[0], o[1]);
          u.y = pack2(o[2], o[3]);
          *(uint2*)(hd + (size_t)m * 256 + n) = u;
        });
      } else {
        const int idx = t - 128;
        const int c = idx & 63, bh = idx >> 6;
        const bf16_t* rvT = (const bf16_t*)(p.ws + O_RVT) + ((size_t)bh * 128) * TS + c * 128;
        const bf16_t* kzT = (const bf16_t*)(p.ws + O_KZT) + ((size_t)bh * 128) * TS + c * 128;
        gemm_accum(acc, RowPtr{rvT, TS}, RowPtr{kzT, TS}, 2, lds);
        bf16_t* dst = z + ((size_t)((bh >> 2) * SEQ + c * 128)) * ZS + C_RV + (bh & 3) * 128;
        gemm_epi_staged(acc, 0, 0, lds, [&](int, int, f32x4&) {}, dst, ZS, 128);
      }
    }
    xcd_barrier(bar, xb_x, xb_nloc, xb_nx);

    phase4b(p, layer);
    {
      const float* pl = p.p + (size_t)layer * T_TOK * 256;
      const int gtid = VBID * 256 + TID();
      const int gthreads = nb * 256;
      for (int i = gtid; i < T_TOK * 32; i += gthreads) {
        float4 a = ((const float4*)pl)[2 * i], b2 = ((const float4*)pl)[2 * i + 1];
        ((uint4*)p16)[i] = make_uint4(pack2(a.x, a.y), pack2(a.z, a.w), pack2(b2.x, b2.y), pack2(b2.z, b2.w));
      }
    }
    xcd_barrier(bar, xb_x, xb_nloc, xb_nx);

    float nsa_c;
    {
      const int ln = TID() & 63;
      float gq = fabsf(p.nsa_q_norm[layer * 64 + ln]), gk = fabsf(p.nsa_k_norm[layer * 64 + ln]);
#pragma unroll
      for (int o = 32; o > 0; o >>= 1) {
        gq = fmaxf(gq, shx(gq, o, ln));
        gk = fmaxf(gk, shx(gk, o, ln));
      }
      nsa_c = 8.f * gq * gk;
    }
    const bool nsa_fx = nsa_c < 30.f;
    const float nsa_cl = nsa_c * 1.4426950408889634f;
    for (int t = VBID; t < 2048; t += nb) {
      if (t < 1024) {
        const int tile = (t < 512) ? 127 - (t >> 3) : ((t - 512) >> 3), bg = t & 7;
        if (nsa_fx) nsa_tile<true>(p, bg >> 1, bg & 1, tile, lds, nsa_cl);
        else nsa_tile<false>(p, bg >> 1, bg & 1, tile, lds, 0.f);
      } else {
        const int idx = t - 1024;
        ret_tile(p, idx >> 8, (idx >> 6) & 3, idx & 63, lds);
      }
    }
    xcd_barrier(bar, xb_x, xb_nloc, xb_nx);

    GEMM8_TILE_LOOP(4) {
      const int m0 = mt * 256, n0 = ntile * 256;
      f32x4 acc8[8][4];
      zero_acc8(acc8);
      gemm8_accum(acc8, (const bf16_t*)(p.ws + O_ONSA) + (size_t)m0 * 512, 512, wl + W_UPA + (size_t)n0 * 512, 512, 8, lds_all, !first_,
                  z + (size_t)m0 * ZS + C_RQ, ZS, wl + W_UPR + (size_t)n0 * 512, 512);
      gemm8_epi(acc8, m0, n0, [&](int m, int n, f32x4& a) {
        uint2 ua = *(const uint2*)(z + (size_t)m * ZS + C_MA + n);
        uint2 ub = *(const uint2*)(z + (size_t)m * ZS + C_MB + n);
        a[0] *= sigmoidf(bflo(ua.x)) * inv_sigmoidf(bflo(ub.x));
        a[1] *= sigmoidf(bfhi(ua.x)) * inv_sigmoidf(bfhi(ub.x));
        a[2] *= sigmoidf(bflo(ua.y)) * inv_sigmoidf(bflo(ub.y));
        a[3] *= sigmoidf(bfhi(ua.y)) * inv_sigmoidf(bfhi(ub.y));
      });
      gemm8_accum(acc8, z + (size_t)m0 * ZS + C_RQ, ZS, wl + W_UPR + (size_t)n0 * 512, 512, 8, lds_all, true,
                  (const bf16_t*)(p.ws + O_ONSA) + (size_t)mtn * 256 * 512, 512, wl + W_UPA + (size_t)ntilen * 256 * 512, 512);
      gemm8_epi_staged(acc8, m0, n0, lds_all, [&](int m, int n, f32x4& a) {
        uint2 ub = *(const uint2*)(z + (size_t)m * ZS + C_MB + n);
        a[0] *= sigmoidf(bflo(ub.x)); a[1] *= sigmoidf(bfhi(ub.x));
        a[2] *= sigmoidf(bflo(ub.y)); a[3] *= sigmoidf(bfhi(ub.y));
      }, z + C_RK, ZS, 1024);
    }
    xcd_barrier(bar, xb_x, xb_nloc, xb_nx);

    GEMM8_TILE_LOOP(4) {
      const int m0 = mt * 256, n0 = ntile * 256;
      f32x4 acc8[8][4];
      zero_acc8(acc8);
      gemm8_accum(acc8, z + (size_t)m0 * ZS + C_RK, ZS, wl + W_OUT + (size_t)n0 * 1024, 1024, 16, lds_all, !first_,
                  z + (size_t)mtn * 256 * ZS + C_RK, ZS, wl + W_OUT + (size_t)ntilen * 256 * 1024, 1024);
      gemm8_epi_resid(acc8, m0, n0, ntile, lds_all, xin, p.out, hbuf, rowpart);
    }
    xcd_barrier(bar, xb_x, xb_nloc, xb_nx);

    GEMM8_TILE_LOOP(16) {
      const int m0 = mt * 256, n0 = ntile * 256;
      f32x4 acc8[8][4];
      zero_acc8(acc8);
      gemm8_accum(acc8, hbuf + (size_t)m0 * DM, DM, wl + W_FF1 + (size_t)n0 * 1024, 1024, 16, lds_all, !first_,
                  hbuf + (size_t)mtn * 256 * DM, DM, wl + W_FF1 + (size_t)ntilen * 256 * 1024, 1024);
      float rsv[8];
      row_rs8(rsv, rowpart, m0);
      scale_rows8(acc8, rsv);
      gemm8_epi_staged(acc8, m0, n0, lds_all, [&](int, int, f32x4& a) {
        float r0 = fmaxf(a[0], 0.f), r1 = fmaxf(a[1], 0.f), r2 = fmaxf(a[2], 0.f), r3 = fmaxf(a[3], 0.f);
        a[0] = r0 * r0; a[1] = r1 * r1; a[2] = r2 * r2; a[3] = r3 * r3;
      }, ubuf, 4096, 4096);
    }
    xcd_barrier(bar, xb_x, xb_nloc, xb_nx);

    GEMM8_TILE_LOOP(4) {
      const int m0 = mt * 256, n0 = ntile * 256;
      f32x4 acc8[8][4];
      zero_acc8(acc8);
      gemm8_accum(acc8, ubuf + (size_t)m0 * 4096, 4096, wl + W_FF2 + (size_t)n0 * 4096, 4096, 64, lds_all, !first_,
                  ubuf + (size_t)mtn * 256 * 4096, 4096, wl + W_FF2 + (size_t)ntilen * 256 * 4096, 4096);
      gemm8_epi_resid(acc8, m0, n0, ntile, lds_all, p.out, p.out, hbuf, rowpart);
    }
    xcd_barrier(bar, xb_x, xb_nloc, xb_nx);

    GEMM8_TILE_LOOP(4) {
      const int m0 = mt * 256, n0 = ntile * 256;
      f32x4 acc8[8][4];
      zero_acc8(acc8);
      gemm8_accum(acc8, p16 + (size_t)m0 * 256, 256, wl + W_PLE + (size_t)n0 * 256, 256, 4, lds_all, !first_,
                  hbuf + (size_t)m0 * DM, DM, wl + W_PG + (size_t)n0 * 1024, 1024);
      bf16_t* ppb = z + (size_t)T_TOK * 256;
      gemm8_epi_staged(acc8, m0, n0, lds_all, [&](int, int, f32x4&) {}, ppb, DM, 1024);
      zero_acc8(acc8);
      gemm8_accum(acc8, hbuf + (size_t)m0 * DM, DM, wl + W_PG + (size_t)n0 * 1024, 1024, 16, lds_all, true,
                  p16 + (size_t)mtn * 256 * 256, 256, wl + W_PLE + (size_t)ntilen * 256 * 256, 256);
      float rsv[8];
      row_rs8(rsv, rowpart, m0);
      scale_rows8(acc8, rsv);
      gemm8_epi(acc8, m0, n0, [&](int m, int n, f32x4& a) {
        uint2 pv = *(const uint2*)(ppb + (size_t)m * DM + n);
        float4* o = (float4*)(p.out + (size_t)m * DM + n);
        float4 xv = *o;
        *o = make_float4(xv.x + sigmoidf(a[0]) * bflo(pv.x), xv.y + sigmoidf(a[1]) * bfhi(pv.x),
                         xv.z + sigmoidf(a[2]) * bflo(pv.y), xv.w + sigmoidf(a[3]) * bfhi(pv.y));
      });
    }
    xcd_barrier(bar, xb_x, xb_nloc, xb_nx);
  }
}

extern "C" void kernel_launch(void* const* d_in, const int* in_sizes, int n_in,
                              void* d_out, int out_size, void* d_ws, size_t ws_size,
                              hipStream_t stream) {
  static int grid_blocks = 0;
  if (!grid_blocks) {
    int dev = 0, cus = 0, per_cu = 0;
    hipGetDevice(&dev);
    hipDeviceGetAttribute(&cus, hipDeviceAttributeMultiprocessorCount, dev);
    hipFuncSetAttribute((const void*)mega, hipFuncAttributeMaxDynamicSharedMemorySize, DYN_LDS);
    hipOccupancyMaxActiveBlocksPerMultiprocessor(&per_cu, mega, 512, DYN_LDS);
    if (per_cu > 1) per_cu = 1;
    if (per_cu < 1) per_cu = 1;
    grid_blocks = cus * per_cu;
  }
  if (ws_size < WS_NEED) {
    fprintf(stderr, "workspace too small: %zu < %llu\n", ws_size, (unsigned long long)WS_NEED);
    return;
  }
  Params p{};
  p.x = (const float*)d_in[0]; p.p = (const float*)d_in[1]; p.norm_mix = (const float*)d_in[2]; p.w_in = (const float*)d_in[3];
  p.nsa_q_norm = (const float*)d_in[4]; p.nsa_k_norm = (const float*)d_in[5]; p.cmp_pos_k = (const float*)d_in[6];
  p.cmp_pos_v = (const float*)d_in[7]; p.cmp_w1_k = (const float*)d_in[8]; p.cmp_w2_k = (const float*)d_in[9];
  p.cmp_w1_v = (const float*)d_in[10]; p.cmp_w2_v = (const float*)d_in[11]; p.w_up_nsa = (const float*)d_in[12];
  p.w_up_ret = (const float*)d_in[13]; p.w_out = (const float*)d_in[14]; p.norm_mlp = (const float*)d_in[15];
  p.w_ff1 = (const float*)d_in[16]; p.w_ff2 = (const float*)d_in[17]; p.norm_ple = (const float*)d_in[18];
  p.w_ple = (const float*)d_in[19]; p.w_ple_gate = (const float*)d_in[20];
  p.out = (float*)d_out; p.ws = (char*)d_ws;
  hipMemsetAsync((char*)d_ws + O_BAR, 0, BAR_BYTES, stream);
  void* args[] = {&p};
  hipError_t e = hipLaunchCooperativeKernel((void*)mega, dim3(grid_blocks), dim3(512), args, DYN_LDS, stream);
  if (e != hipSuccess) fprintf(stderr, "cooperative launch failed: %s (grid %d)\n", hipGetErrorString(e), grid_blocks);
}
```

```cpp
#include <hip/hip_runtime.h>
#include <hip/hip_cooperative_groups.h>
#include <cstdio>
#include <cstdint>
namespace cg = cooperative_groups;

typedef __attribute__((ext_vector_type(8))) short bf16x8;
typedef __attribute__((ext_vector_type(4))) float f32x4;
typedef unsigned short bf16_t;
typedef __attribute__((ext_vector_type(4))) unsigned u32x4;
#define DI __device__ __forceinline__

#define T_TOK 32768
#define SEQ 8192
#define DM 1024
#define ZS 5400
#define C_Q 0
#define C_KC 512
#define C_VC 640
#define C_KS 768
#define C_VS 896
#define C_KW 1024
#define C_VW 1152
#define C_GT 1280
#define C_RQ 1304
#define C_RK 1816
#define C_RV 2328
#define C_RG 2840
#define C_MA 3352
#define C_MB 4376
#define NPAD_IN 5504
#define TS 8256

#define W_IN 0
#define W_C1K 5636096
#define W_C1V 6160384
#define W_UPA 6684672
#define W_UPR 7208960
#define W_OUT 7733248
#define W_FF1 8781824
#define W_FF2 12976128
#define W_PLE 17170432
#define W_PG 17432576
#define W_LAYER 18481152

#define O_WT 0ull
#define O_ROPE 36962304ull
#define O_BIAS 41156608ull
#define O_HID 41160704ull
#define O_KCMP 45355008ull
#define O_VCMPT 45879296ull
#define O_VST 46403584ull
#define O_VWT 54857728ull
#define O_RVT 63311872ull
#define O_KZT 97128448ull
#define O_Z 130945024ull
#define O_ONSA 484839424ull
#define O_BAR 518393856ull
#define BAR_BYTES 13824
#define O_KVD 518407680ull
#define O_RP 535184896ull
#define WS_NEED 536233472ull
#define DYN_LDS 139264

struct Params {
  const float* x; const float* p; const float* norm_mix; const float* w_in;
  const float* nsa_q_norm; const float* nsa_k_norm; const float* cmp_pos_k; const float* cmp_pos_v;
  const float* cmp_w1_k; const float* cmp_w2_k; const float* cmp_w1_v; const float* cmp_w2_v;
  const float* w_up_nsa; const float* w_up_ret; const float* w_out; const float* norm_mlp;
  const float* w_ff1; const float* w_ff2; const float* norm_ple; const float* w_ple; const float* w_ple_gate;
  float* out; char* ws;
};

DI unsigned pack2(float a, float b) {
  typedef __attribute__((ext_vector_type(2))) __bf16 bf2;
  typedef __attribute__((ext_vector_type(2))) float f2;
  f2 v = {a, b};
  bf2 r = __builtin_convertvector(v, bf2);
  return __builtin_bit_cast(unsigned, r);
}
DI bf16_t f2bf(float a) { return (bf16_t)(pack2(a, 0.f) & 0xffffu); }
DI float bf2f(bf16_t h) { return __uint_as_float(((unsigned)h) << 16); }
DI float bflo(unsigned u) { return __uint_as_float(u << 16); }
DI float bfhi(unsigned u) { return __uint_as_float(u & 0xffff0000u); }
DI float shx(float v, int mask, int lane) {
  return __int_as_float(__builtin_amdgcn_ds_bpermute((lane ^ mask) << 2, __float_as_int(v)));
}
DI uint32_t shxu(uint32_t v, int mask, int lane) {
  return (uint32_t)__builtin_amdgcn_ds_bpermute((lane ^ mask) << 2, (int)v);
}
DI float shfrom(float v, int srclane) {
  return __int_as_float(__builtin_amdgcn_ds_bpermute(srclane << 2, __float_as_int(v)));
}
DI float wave_sum(float v, int lane) {
#pragma unroll
  for (int o = 32; o > 0; o >>= 1) v += shx(v, o, lane);
  return v;
}
DI int TID() { int t = threadIdx.x & 255; asm volatile("" : "+v"(t)); return t; }
DI int HALF() { return __builtin_amdgcn_readfirstlane((int)(threadIdx.x >> 8)); }
#define VBID ((int)(blockIdx.x * 2) + HALF())
#define NVB ((int)(gridDim.x * 2))
DI float sigmoidf(float x) { return __builtin_amdgcn_rcpf(1.f + __expf(-x)); }
DI float inv_sigmoidf(float x) { return 1.f + __expf(-x); }
DI f32x4 mfma16(bf16x8 a, bf16x8 b, f32x4 c) { return __builtin_amdgcn_mfma_f32_16x16x32_bf16(a, b, c, 0, 0, 0); }
DI bf16x8 mk8(unsigned a, unsigned b, unsigned c, unsigned d) {
  uint4 u = make_uint4(a, b, c, d);
  return __builtin_bit_cast(bf16x8, u);
}

template <class AP, class BP>
DI void g_load(u32x4 (&ra)[4], u32x4 (&rb)[4], const AP& ap, const BP& bp, int kb, int lrow, int lch) {
#pragma unroll
  for (int i = 0; i < 4; ++i) {
    ra[i] = *(const u32x4*)(ap(lrow + 32 * i, kb) + lch * 8);
    rb[i] = *(const u32x4*)(bp(lrow + 32 * i, kb) + lch * 8);
  }
}
DI void g_store(bf16_t* As, bf16_t* Bs, const u32x4 (&ra)[4], const u32x4 (&rb)[4], int buf, int lrow, int lch) {
#pragma unroll
  for (int i = 0; i < 4; ++i) {
    int r = lrow + 32 * i;
    int off = buf * 8192 + r * 64 + ((lch ^ ((r >> 1) & 7)) << 3);
    *(u32x4*)(As + off) = ra[i];
    *(u32x4*)(Bs + off) = rb[i];
  }
}
DI void g_compute(f32x4 (&acc)[4][4], const bf16_t* a, const bf16_t* b, int wm, int wn, int lane) {
  bf16x8 af[2][4], bfr[2][4];
#pragma unroll
  for (int ks = 0; ks < 2; ++ks)
#pragma unroll
    for (int i = 0; i < 4; ++i) {
      int r = wm * 64 + i * 16 + (lane & 15);
      af[ks][i] = *(const bf16x8*)(a + r * 64 + (((ks * 4 + (lane >> 4)) ^ ((r >> 1) & 7)) << 3));
      int r2 = wn * 64 + i * 16 + (lane & 15);
      bfr[ks][i] = *(const bf16x8*)(b + r2 * 64 + (((ks * 4 + (lane >> 4)) ^ ((r2 >> 1) & 7)) << 3));
    }
  __builtin_amdgcn_s_setprio(1);
#pragma unroll
  for (int ks = 0; ks < 2; ++ks)
#pragma unroll
    for (int i = 0; i < 4; ++i)
#pragma unroll
      for (int j = 0; j < 4; ++j) acc[i][j] = mfma16(bfr[ks][j], af[ks][i], acc[i][j]);
  __builtin_amdgcn_s_setprio(0);
}
template <class AP, class BP>
DI void gemm_accum(f32x4 (&acc)[4][4], AP ap, BP bp, int nkb, bf16_t* lds) {
  const int tid = TID(), lane = tid & 63, w = tid >> 6;
  const int wm = w >> 1, wn = w & 1;
  const int lrow = tid >> 3, lch = tid & 7;
  bf16_t* As = lds;
  bf16_t* Bs = lds + 16384;
  u32x4 ra0[4], rb0[4], ra1[4], rb1[4];
  __syncthreads();
  g_load(ra0, rb0, ap, bp, 0, lrow, lch);
  g_load(ra1, rb1, ap, bp, 1, lrow, lch);
  g_store(As, Bs, ra0, rb0, 0, lrow, lch);
  __syncthreads();
  for (int kb = 0; kb < nkb; kb += 2) {
    const int k2 = (kb + 2 < nkb) ? kb + 2 : nkb - 2;
    g_load(ra0, rb0, ap, bp, k2, lrow, lch);
    __builtin_amdgcn_sched_barrier(0);
    g_compute(acc, As, Bs, wm, wn, lane);
    g_store(As, Bs, ra1, rb1, 1, lrow, lch);
    __syncthreads();
    g_load(ra1, rb1, ap, bp, k2 + 1, lrow, lch);
    __builtin_amdgcn_sched_barrier(0);
    g_compute(acc, As + 8192, Bs + 8192, wm, wn, lane);
    g_store(As, Bs, ra0, rb0, 0, lrow, lch);
    __syncthreads();
  }
}
template <class E>
DI void gemm_epi(f32x4 (&acc)[4][4], int m0, int n0, E e) {
  const int tid_ = TID();
  const int lane = tid_ & 63, w = tid_ >> 6;
  const int wm = w >> 1, wn = w & 1;
#pragma unroll
  for (int i = 0; i < 4; ++i)
#pragma unroll
    for (int j = 0; j < 4; ++j) {
      int m = m0 + wm * 64 + i * 16 + (lane & 15);
      int n = n0 + wn * 64 + j * 16 + (lane >> 4) * 4;
      e(m, n, acc[i][j]);
    }
}
template <class F>
DI void gemm_epi_staged(f32x4 (&acc)[4][4], int m0, int n0, bf16_t* lds, F f, bf16_t* dst, size_t ld, int nmax) {
  const int tid_ = TID();
  const int lane = tid_ & 63, w = tid_ >> 6;
  const int wm = w >> 1, wn = w & 1;
#pragma unroll
  for (int i = 0; i < 4; ++i)
#pragma unroll
    for (int j = 0; j < 4; ++j) {
      const int ml = wm * 64 + i * 16 + (lane & 15);
      const int nl = wn * 64 + j * 16 + (lane >> 4) * 4;
      f32x4 a = acc[i][j];
      f(m0 + ml, n0 + nl, a);
      uint2 u;
      u.x = pack2(a[0], a[1]);
      u.y = pack2(a[2], a[3]);
      *(uint2*)(lds + ml * 136 + nl) = u;
    }
  __syncthreads();
#pragma unroll
  for (int it = 0; it < 8; ++it) {
    const int idx = tid_ + 256 * it;
    const int row = idx >> 4, ch = idx & 15;
    const u32x4 v = *(const u32x4*)(lds + row * 136 + ch * 8);
    const int n = n0 + ch * 8;
    if (n < nmax) *(u32x4*)(dst + (size_t)(m0 + row) * ld + n) = v;
  }
}
DI void gemm_epi_resid(f32x4 (&acc)[4][4], int m0, int n0, int ntile, bf16_t* lds, const float* xin, float* out, bf16_t* xb, float* rowpart) {
  const int tid_ = TID();
  const int lane = tid_ & 63, w = tid_ >> 6;
  const int wm = w >> 1, wn = w & 1;
  float* red = (float*)lds;
#pragma unroll
  for (int i = 0; i < 4; ++i) {
    const int ml = wm * 64 + i * 16 + (lane & 15);
    const size_t rowoff = (size_t)(m0 + ml) * DM;
    float ss = 0.f;
#pragma unroll
    for (int j = 0; j < 4; ++j) {
      const int n = n0 + wn * 64 + j * 16 + (lane >> 4) * 4;
      const float4 xv = *(const float4*)(xin + rowoff + n);
      const float o0 = xv.x + acc[i][j][0], o1 = xv.y + acc[i][j][1], o2 = xv.z + acc[i][j][2], o3 = xv.w + acc[i][j][3];
      *(float4*)(out + rowoff + n) = make_float4(o0, o1, o2, o3);
      ss += o0 * o0 + o1 * o1 + o2 * o2 + o3 * o3;
      uint2 u;
      u.x = pack2(o0, o1);
      u.y = pack2(o2, o3);
      *(uint2*)(xb + rowoff + n) = u;
    }
    ss += shx(ss, 16, lane);
    ss += shx(ss, 32, lane);
    if ((lane >> 4) == 0) red[wn * 128 + ml] = ss;
  }
  __syncthreads();
  if (tid_ < 128) rowpart[(size_t)ntile * T_TOK + m0 + tid_] = red[tid_] + red[128 + tid_];
}
DI void row_rs(float (&rsv)[4], const float* rowpart, int m0) {
  const int tid_ = TID();
  const int lane = tid_ & 63, wm = tid_ >> 7;
#pragma unroll
  for (int i = 0; i < 4; ++i) {
    const int m = m0 + wm * 64 + i * 16 + (lane & 15);
    float s = 0.f;
#pragma unroll
    for (int t = 0; t < 8; ++t) s += rowpart[(size_t)t * T_TOK + m];
    rsv[i] = rsqrtf(s * (1.f / 1024.f) + 1e-6f);
  }
}
DI void scale_rows(f32x4 (&acc)[4][4], const float (&rsv)[4]) {
#pragma unroll
  for (int i = 0; i < 4; ++i)
#pragma unroll
    for (int j = 0; j < 4; ++j) acc[i][j] *= rsv[i];
}
DI void zero_acc(f32x4 (&acc)[4][4]) {
#pragma unroll
  for (int i = 0; i < 4; ++i)
#pragma unroll
    for (int j = 0; j < 4; ++j) acc[i][j] = f32x4{0.f, 0.f, 0.f, 0.f};
}
struct RowPtr {
  const bf16_t* base; size_t ld;
  DI const bf16_t* operator()(int r, int kb) const { return base + (size_t)r * ld + kb * 64; }
};

DI void convert_wt(const float* W, bf16_t* Wt, int K, int N, int Npad, int gtid, int gthreads, const float* gk = nullptr) {
  const int k8n = K >> 3;
  const long total = (long)Npad * k8n;
  for (long idx = gtid; idx < total; idx += gthreads) {
    int n = (int)(idx % Npad);
    int k8 = (int)(idx / Npad);
    uint4 o = make_uint4(0, 0, 0, 0);
    if (n < N) {
      const float* s = W + (size_t)(k8 * 8) * N + n;
      float v0 = s[0], v1 = s[(size_t)N], v2 = s[(size_t)2 * N], v3 = s[(size_t)3 * N];
      float v4 = s[(size_t)4 * N], v5 = s[(size_t)5 * N], v6 = s[(size_t)6 * N], v7 = s[(size_t)7 * N];
      if (gk) {
        const float* gp = gk + k8 * 8;
        v0 *= gp[0]; v1 *= gp[1]; v2 *= gp[2]; v3 *= gp[3]; v4 *= gp[4]; v5 *= gp[5]; v6 *= gp[6]; v7 *= gp[7];
      }
      o = make_uint4(pack2(v0, v1), pack2(v2, v3), pack2(v4, v5), pack2(v6, v7));
    }
    *(uint4*)(Wt + (size_t)n * K + k8 * 8) = o;
  }
}

DI void phase0(const Params& p, const int L, bf16_t* lds) {
  bf16_t* wl = (bf16_t*)(p.ws + O_WT);
  {
    bf16_t* T = lds;
    const int tid = TID();
    const int half = HALF();
    for (int pr = (int)blockIdx.x; pr < 2256; pr += (int)gridDim.x) {
      int t = 2 * pr + half;
      const float* W; bf16_t* Wt; int K, N; const float* gk = nullptr;
      if (t < 1376) { W = p.w_in + (size_t)L * 1024 * 5400; Wt = wl + W_IN; K = 1024; N = 5400; }
      else if ((t -= 1376) < 128) { W = p.cmp_w1_k + (size_t)L * 2048 * 256; Wt = wl + W_C1K; K = 2048; N = 256; }
      else if ((t -= 128) < 128) { W = p.cmp_w1_v + (size_t)L * 2048 * 256; Wt = wl + W_C1V; K = 2048; N = 256; }
      else if ((t -= 128) < 128) { W = p.w_up_nsa + (size_t)L * 512 * 1024; Wt = wl + W_UPA; K = 512; N = 1024; }
      else if ((t -= 128) < 128) { W = p.w_up_ret + (size_t)L * 512 * 1024; Wt = wl + W_UPR; K = 512; N = 1024; }
      else if ((t -= 128) < 256) { W = p.w_out + (size_t)L * 1024 * 1024; Wt = wl + W_OUT; K = 1024; N = 1024; }
      else if ((t -= 256) < 1024) { W = p.w_ff1 + (size_t)L * 1024 * 4096; Wt = wl + W_FF1; K = 1024; N = 4096; gk = p.norm_mlp + L * DM; }
      else if ((t -= 1024) < 1024) { W = p.w_ff2 + (size_t)L * 4096 * 1024; Wt = wl + W_FF2; K = 4096; N = 1024; }
      else if ((t -= 1024) < 64) { W = p.w_ple + (size_t)L * 256 * 1024; Wt = wl + W_PLE; K = 256; N = 1024; }
      else { t -= 64; W = p.w_ple_gate + (size_t)L * 1024 * 1024; Wt = wl + W_PG; K = 1024; N = 1024; gk = p.norm_ple + L * DM; }
      const int nkt = K >> 6;
      const int nt = t / nkt, kt = t - nt * nkt;
      const int k0 = kt * 64, n0 = nt * 64;
      __syncthreads();
      {
        const int c4 = tid & 15, n = n0 + c4 * 4;
#pragma unroll
        for (int i = 0; i < 4; ++i) {
          const int k = (tid >> 4) + 16 * i;
          float4 v = make_float4(0.f, 0.f, 0.f, 0.f);
          if (n < N) v = *(const float4*)(W + (size_t)(k0 + k) * N + n);
          if (gk) { const float g = gk[k0 + k]; v.x *= g; v.y *= g; v.z *= g; v.w *= g; }
          T[(c4 * 4 + 0) * 66 + k] = f2bf(v.x);
          T[(c4 * 4 + 1) * 66 + k] = f2bf(v.y);
          T[(c4 * 4 + 2) * 66 + k] = f2bf(v.z);
          T[(c4 * 4 + 3) * 66 + k] = f2bf(v.w);
        }
      }
      __syncthreads();
      {
        const int n = tid >> 2, kc = tid & 3;
        const unsigned* s32 = (const unsigned*)(T + n * 66 + kc * 16);
        u32x4 o0, o1;
        o0.x = s32[0]; o0.y = s32[1]; o0.z = s32[2]; o0.w = s32[3];
        o1.x = s32[4]; o1.y = s32[5]; o1.z = s32[6]; o1.w = s32[7];
        bf16_t* dst = Wt + (size_t)(n0 + n) * K + k0 + kc * 16;
        *(u32x4*)dst = o0;
        *(u32x4*)(dst + 8) = o1;
      }
    }
  }
  const int gtid = VBID * 256 + TID();
  const int gthreads = NVB * 256;
  if (L == 0) {
    float2* rope = (float2*)(p.ws + O_ROPE);
    for (int idx = gtid; idx < SEQ * 64; idx += gthreads) {
      int pos = idx >> 6, j = idx & 63;
      float inv = exp2f(-(float)j * (13.287712379549449f / 64.f));
      float ang = (float)pos * inv;
      double rev = (double)ang * 0.15915494309189535;
      rev -= rint(rev);
      float fr = (float)rev;
      rope[idx] = make_float2(__builtin_amdgcn_cosf(fr), __builtin_amdgcn_sinf(fr));
    }
  }
  float* part = (float*)(p.ws + O_HID);
  {
    const int n = gtid & 255;
    for (int item = VBID; item < 128; item += NVB) {
      const int kv = item >> 6, kc = item & 63;
      const float* pos = (kv ? p.cmp_pos_v : p.cmp_pos_k) + L * 2048 + kc * 32;
      const float* w1 = (kv ? p.cmp_w1_v : p.cmp_w1_k) + (size_t)L * 2048 * 256 + (size_t)kc * 32 * 256;
      float a = 0.f;
#pragma unroll 8
      for (int k = 0; k < 32; ++k) a += pos[k] * w1[(size_t)k * 256 + n];
      part[item * 256 + n] = a;
    }
  }
}

DI void norm_phase(const float* xin, const float* g, bf16_t* h) {
  const int tid_ = TID();
  const int lane = tid_ & 63;
  const int gw = (VBID * 256 + tid_) >> 6;
  const int nw = NVB * 4;
  float4 gv[4];
#pragma unroll
  for (int i = 0; i < 4; ++i) gv[i] = ((const float4*)g)[i * 64 + lane];
  for (int row = gw; row < T_TOK; row += nw) {
    const float4* xr = (const float4*)(xin + (size_t)row * DM);
    float4 v[4];
    float ss = 0.f;
#pragma unroll
    for (int i = 0; i < 4; ++i) {
      v[i] = xr[i * 64 + lane];
      ss += v[i].x * v[i].x + v[i].y * v[i].y + v[i].z * v[i].z + v[i].w * v[i].w;
    }
    ss = wave_sum(ss, lane);
    float rs = rsqrtf(ss * (1.f / 1024.f) + 1e-6f);
    uint2* hr = (uint2*)(h + (size_t)row * DM);
#pragma unroll
    for (int i = 0; i < 4; ++i) {
      uint2 o;
      o.x = pack2(v[i].x * rs * gv[i].x, v[i].y * rs * gv[i].y);
      o.y = pack2(v[i].z * rs * gv[i].z, v[i].w * rs * gv[i].w);
      hr[i * 64 + lane] = o;
    }
  }
}

DI void post_z(const Params& p, int layer) {
  const int tid_ = TID();
  const int lane = tid_ & 63;
  const int gw = (VBID * 256 + tid_) >> 6;
  const int nw = NVB * 4;
  bf16_t* z = (bf16_t*)(p.ws + O_Z);
  bf16_t* vsT = (bf16_t*)(p.ws + O_VST);
  bf16_t* vwT = (bf16_t*)(p.ws + O_VWT);
  bf16_t* rvT = (bf16_t*)(p.ws + O_RVT);
  bf16_t* kzT = (bf16_t*)(p.ws + O_KZT);
  const float2* rope = (const float2*)(p.ws + O_ROPE);
  const float* qn = p.nsa_q_norm + layer * 64;
  const float* kn = p.nsa_k_norm + layer * 64;
  {
    const float* part = (const float*)(p.ws + O_HID);
    float* bias = (float*)(p.ws + O_BIAS);
    const int idx = VBID * 256 + tid_;
    if (idx < 512) {
      const int kv = idx >> 8, n = idx & 255;
      float a = 0.f;
      for (int kc = 0; kc < 64; ++kc) a += part[(kv * 64 + kc) * 256 + n];
      bias[idx] = a;
    }
  }
  for (int item = gw; item < 1024 * 36; item += nw) {
    const int tc = item / 36, slab = item - tc * 36;
    const int tok0 = tc * 32;
    const int b = tok0 >> 13, spos = tok0 & 8191;
    bf16_t* zr = z + (size_t)tok0 * ZS;
    if (slab >= 32) {
      const int s4 = slab - 32, kv = s4 >> 1, gi = s4 & 1;
      const int colbase = (kv ? C_VC : C_KC) + gi * 64;
      bf16_t* dst = (bf16_t*)(p.ws + O_KVD) + ((size_t)((kv * 8 + b * 2 + gi) * SEQ + spos)) * 64 + lane;
      bf16_t u[32];
#pragma unroll
      for (int i = 0; i < 32; ++i) u[i] = zr[(size_t)i * ZS + colbase + lane];
#pragma unroll
      for (int i = 0; i < 32; ++i) dst[i * 64] = u[i];
    } else if (slab < 12) {
      int colbase; const float* g; float sc;
      if (slab < 8) { colbase = C_Q + slab * 64; g = qn; sc = 0.125f; }
      else if (slab < 10) { colbase = C_KS + (slab - 8) * 64; g = kn; sc = 1.f; }
      else { colbase = C_KW + (slab - 10) * 64; g = kn; sc = 1.f; }
      const float gv = g[lane] * sc;
      float v[32];
#pragma unroll
      for (int i = 0; i < 32; ++i) v[i] = bf2f(zr[(size_t)i * ZS + colbase + lane]);
#pragma unroll
      for (int i = 0; i < 32; ++i) {
        float ss = wave_sum(v[i] * v[i], lane);
        float rs = rsqrtf(ss * (1.f / 64.f) + 1e-6f);
        zr[(size_t)i * ZS + colbase + lane] = f2bf(v[i] * rs * gv);
      }
    } else if (slab < 16 || slab >= 24) {
      int colbase; bf16_t* dst;
      if (slab < 16) {
        const int gi = slab & 1;
        const bool isw = slab >= 14;
        colbase = (isw ? C_VW : C_VS) + gi * 64;
        dst = (isw ? vwT : vsT) + ((size_t)((b * 2 + gi) * 64 + lane)) * TS + spos;
      } else {
        const int s8 = slab - 24;
        const int h = s8 >> 1, half = s8 & 1;
        colbase = C_RV + s8 * 64;
        dst = rvT + ((size_t)((b * 4 + h) * 128 + half * 64 + lane)) * TS + spos;
      }
      unsigned u[32];
#pragma unroll
      for (int i = 0; i < 32; ++i) u[i] = zr[(size_t)i * ZS + colbase + lane];
#pragma unroll
      for (int q4 = 0; q4 < 4; ++q4)
        *(uint4*)(dst + q4 * 8) = make_uint4(u[q4 * 8 + 0] | (u[q4 * 8 + 1] << 16), u[q4 * 8 + 2] | (u[q4 * 8 + 3] << 16),
                                             u[q4 * 8 + 4] | (u[q4 * 8 + 5] << 16), u[q4 * 8 + 6] | (u[q4 * 8 + 7] << 16));
    } else if (slab < 20) {
      const int h = slab - 16;
      const int colbase = C_RQ + h * 128;
      float x1[32], x2[32];
#pragma unroll
      for (int i = 0; i < 32; ++i) {
        const bf16_t* p1 = zr + (size_t)i * ZS + colbase + lane;
        x1[i] = bf2f(p1[0]);
        x2[i] = bf2f(p1[64]);
      }
#pragma unroll
      for (int i = 0; i < 32; ++i) {
        bf16_t* p1 = zr + (size_t)i * ZS + colbase + lane;
        float2 cs = rope[(spos + i) * 64 + lane];
        p1[0] = f2bf(x1[i] * cs.x - x2[i] * cs.y);
        p1[64] = f2bf(x1[i] * cs.y + x2[i] * cs.x);
      }
    } else {
      const int h = slab - 20;
      const int colbase = C_RK + h * 128;
      const float lg2 = log2f(1.f - exp2f(-5.f - (float)h));
      float x1[32], x2[32];
#pragma unroll
      for (int i = 0; i < 32; ++i) {
        const bf16_t* p1 = zr + (size_t)i * ZS + colbase + lane;
        x1[i] = bf2f(p1[0]);
        x2[i] = bf2f(p1[64]);
      }
      unsigned u1[32], u2[32];
#pragma unroll
      for (int i = 0; i < 32; ++i) {
        bf16_t* p1 = zr + (size_t)i * ZS + colbase + lane;
        float2 cs = rope[(spos + i) * 64 + lane];
        float o1 = (x1[i] * cs.x - x2[i] * cs.y) * 0.08838834764831845f;
        float o2 = (x1[i] * cs.y + x2[i] * cs.x) * 0.08838834764831845f;
        p1[0] = f2bf(o1);
        p1[64] = f2bf(o2);
        float zeta = __builtin_amdgcn_exp2f(lg2 * (float)(127 - ((spos + i) & 127)));
        u1[i] = f2bf(o1 * zeta);
        u2[i] = f2bf(o2 * zeta);
      }
      bf16_t* d1 = kzT + ((size_t)((b * 4 + h) * 128 + lane)) * TS + spos;
#pragma unroll
      for (int q4 = 0; q4 < 4; ++q4) {
        *(uint4*)(d1 + q4 * 8) = make_uint4(u1[q4 * 8 + 0] | (u1[q4 * 8 + 1] << 16), u1[q4 * 8 + 2] | (u1[q4 * 8 + 3] << 16),
                                            u1[q4 * 8 + 4] | (u1[q4 * 8 + 5] << 16), u1[q4 * 8 + 6] | (u1[q4 * 8 + 7] << 16));
        *(uint4*)(d1 + (size_t)64 * TS + q4 * 8) = make_uint4(u2[q4 * 8 + 0] | (u2[q4 * 8 + 1] << 16), u2[q4 * 8 + 2] | (u2[q4 * 8 + 3] << 16),
                                                              u2[q4 * 8 + 4] | (u2[q4 * 8 + 5] << 16), u2[q4 * 8 + 6] | (u2[q4 * 8 + 7] << 16));
      }
    }
  }
}

DI void phase4b(const Params& p, int layer) {
  const int tid_ = TID();
  const int lane = tid_ & 63;
  const int gw = (VBID * 256 + tid_) >> 6;
  const int nw = NVB * 4;
  bf16_t* z = (bf16_t*)(p.ws + O_Z);
  const bf16_t* hid = (const bf16_t*)(p.ws + O_HID);
  bf16_t* kcmp = (bf16_t*)(p.ws + O_KCMP);
  bf16_t* vcmpT = (bf16_t*)(p.ws + O_VCMPT);
  const float* kn = p.nsa_k_norm + layer * 64;
  for (int item = gw; item < 8192; item += nw) {
    const int kv = item >> 12, row = item & 4095;
    const bf16_t* hrow = hid + ((size_t)kv * 4096 + row) * 256;
    const float* w2 = (kv ? p.cmp_w2_v : p.cmp_w2_k) + (size_t)layer * 256 * 64;
    float acc = 0.f;
    for (int k8 = 0; k8 < 32; ++k8) {
      uint4 hv = *(const uint4*)(hrow + k8 * 8);
      const float* wr = w2 + (size_t)(k8 * 8) * 64 + lane;
      acc += bflo(hv.x) * wr[0];
      acc += bfhi(hv.x) * wr[64];
      acc += bflo(hv.y) * wr[128];
      acc += bfhi(hv.y) * wr[192];
      acc += bflo(hv.z) * wr[256];
      acc += bfhi(hv.z) * wr[320];
      acc += bflo(hv.w) * wr[384];
      acc += bfhi(hv.w) * wr[448];
    }
    if (kv == 0) {
      float ss = wave_sum(acc * acc, lane);
      float rs = rsqrtf(ss * (1.f / 64.f) + 1e-6f);
      kcmp[(size_t)row * 64 + lane] = f2bf(acc * rs * kn[lane]);
    } else {
      const int bg = row >> 9, c = row & 511;
      vcmpT[((size_t)(bg * 64 + lane)) * 512 + c] = f2bf(acc);
    }
  }
  const int gtid = VBID * 256 + tid_;
  const int gthreads = NVB * 256;
  for (int idx = gtid; idx < 65536; idx += gthreads) {
    const int d4 = idx & 31, e = (idx >> 5) & 127, h = (idx >> 12) & 3, b = idx >> 14;
    const float lg2 = log2f(1.f - exp2f(-5.f - (float)h));
    const float gch = exp2f(lg2 * 128.f);
    float r0 = 0.f, r1 = 0.f, r2 = 0.f, r3 = 0.f;
    bf16_t* ptr = z + ((size_t)(b * SEQ + e)) * ZS + C_RV + h * 128 + d4 * 4;
    for (int c0 = 0; c0 < 64; c0 += 16) {
      typedef __attribute__((ext_vector_type(2))) unsigned u32x2;
      u32x2 v[16];
#pragma unroll
      for (int i = 0; i < 16; ++i) v[i] = *(const u32x2*)(ptr + (size_t)(c0 + i) * 128 * ZS);
#pragma unroll
      for (int i = 0; i < 16; ++i) {
        u32x2 o;
        o.x = pack2(r0, r1);
        o.y = pack2(r2, r3);
        *(u32x2*)(ptr + (size_t)(c0 + i) * 128 * ZS) = o;
        r0 = gch * r0 + bflo(v[i].x);
        r1 = gch * r1 + bfhi(v[i].x);
        r2 = gch * r2 + bflo(v[i].y);
        r3 = gch * r3 + bfhi(v[i].y);
      }
    }
  }
}


DI void tile64_gload(int tid, u32x4& r0, u32x4& r1, const bf16_t* base, size_t stride) {
  {
    int idx = tid;
    int row = idx >> 3, ch = idx & 7;
    r0 = *(const u32x4*)(base + (size_t)row * stride + ch * 8);
  }
  {
    int idx = tid + 256;
    int row = idx >> 3, ch = idx & 7;
    r1 = *(const u32x4*)(base + (size_t)row * stride + ch * 8);
  }
}
DI void tile64_sstore(int tid, bf16_t* dst, const u32x4& r0, const u32x4& r1) {
  {
    int idx = tid;
    int row = idx >> 3, ch = idx & 7;
    *(u32x4*)(dst + row * 64 + ((ch ^ ((row >> 1) & 7)) << 3)) = r0;
  }
  {
    int idx = tid + 256;
    int row = idx >> 3, ch = idx & 7;
    *(u32x4*)(dst + row * 64 + ((ch ^ ((row >> 1) & 7)) << 3)) = r1;
  }
}

struct AttnSt { f32x4 O[2][4]; f32x4 L[2]; float m[2]; float l[2]; };

template <int MODE, bool FX>
DI void attn_compute(const int lane, const bf16_t* Ks, const bf16_t* Vs, const bf16x8 (&qf)[2][2], AttnSt& st, const float (&invl)[2],
                     int lo, int hi, float (&impA)[4], float (&impE)[4], const float CL) {
  const int quad = lane >> 4, col = lane & 15;
  f32x4 S[4][2];
#pragma unroll
  for (int kt = 0; kt < 4; ++kt)
#pragma unroll
    for (int hh = 0; hh < 2; ++hh) S[kt][hh] = f32x4{0.f, 0.f, 0.f, 0.f};
#pragma unroll
  for (int ks = 0; ks < 2; ++ks) {
#pragma unroll
    for (int kt = 0; kt < 4; ++kt) {
      int row = kt * 16 + col;
      bf16x8 kf = *(const bf16x8*)(Ks + row * 64 + (((ks * 4 + quad) ^ ((row >> 1) & 7)) << 3));
#pragma unroll
      for (int hh = 0; hh < 2; ++hh) S[kt][hh] = mfma16(kf, qf[hh][ks], S[kt][hh]);
    }
  }
  bf16x8 pf[2][2];
  const bool full = (lo <= 0) && (hi >= 63);
  const bool none = (hi < 0) || (lo > 63) || (hi < lo);
  if (__all(full || none)) {
    constexpr float L2E = 1.4426950408889634f;
#pragma unroll
    for (int hh = 0; hh < 2; ++hh) {
      float mL;
      float il = 1.f;
      if (FX) {
        mL = full ? CL : 1e30f;
        if (MODE == 1) il = invl[hh];
      } else if (MODE != 1) {
        float mx = -1e30f;
#pragma unroll
        for (int kt = 0; kt < 4; ++kt)
#pragma unroll
          for (int j = 0; j < 4; ++j) mx = fmaxf(mx, S[kt][hh][j]);
        mx = full ? mx : -1e30f;
        mx = fmaxf(mx, shx(mx, 16, lane));
        mx = fmaxf(mx, shx(mx, 32, lane));
        const float m_new = fmaxf(st.m[hh], mx);
        const float alpha = __expf(st.m[hh] - m_new);
        st.m[hh] = m_new;
        st.l[hh] *= alpha;
        if (MODE == 2) {
#pragma unroll
          for (int dt = 0; dt < 4; ++dt) st.O[hh][dt] *= alpha;
        }
        mL = full ? m_new * L2E : 1e30f;
      } else {
        mL = full ? st.m[hh] * L2E : 1e30f;
        il = invl[hh];
      }
      float rs = 0.f;
#pragma unroll
      for (int kt = 0; kt < 4; ++kt) {
        float a = 0.f;
#pragma unroll
        for (int j = 0; j < 4; ++j) {
          float pv = __builtin_amdgcn_exp2f(fmaf(S[kt][hh][j], L2E, -mL));
          if (MODE == 1) pv *= il;
          S[kt][hh][j] = pv;
          a += pv;
        }
        rs += a;
        if (MODE == 1) {
          impA[kt] += a;
          impE[kt] += S[kt][hh][3];
        }
      }
      if (MODE != 1 && !(FX && MODE == 2)) st.l[hh] += rs;
      if (MODE != 0) {
#pragma unroll
        for (int c = 0; c < 2; ++c)
          pf[hh][c] = mk8(pack2(S[2 * c][hh][0], S[2 * c][hh][1]), pack2(S[2 * c][hh][2], S[2 * c][hh][3]),
                          pack2(S[2 * c + 1][hh][0], S[2 * c + 1][hh][1]), pack2(S[2 * c + 1][hh][2], S[2 * c + 1][hh][3]));
      }
    }
  } else {
#pragma unroll
  for (int hh = 0; hh < 2; ++hh) {
    if (FX) {
      constexpr float L2E = 1.4426950408889634f;
      const float il = (MODE == 1) ? invl[hh] : 1.f;
      float rs = 0.f;
#pragma unroll
      for (int kt = 0; kt < 4; ++kt) {
        float a = 0.f;
#pragma unroll
        for (int j = 0; j < 4; ++j) {
          const int kl = kt * 16 + quad * 4 + j;
          const bool v = (kl >= lo) && (kl <= hi);
          float pv = v ? __builtin_amdgcn_exp2f(fmaf(S[kt][hh][j], L2E, -CL)) : 0.f;
          if (MODE == 1) pv *= il;
          S[kt][hh][j] = pv;
          a += pv;
        }
        rs += a;
        if (MODE == 1) {
          impA[kt] += a;
          impE[kt] += S[kt][hh][3];
        }
      }
      if (MODE != 1 && !(FX && MODE == 2)) st.l[hh] += rs;
      if (MODE != 0) {
#pragma unroll
        for (int c = 0; c < 2; ++c)
          pf[hh][c] = mk8(pack2(S[2 * c][hh][0], S[2 * c][hh][1]), pack2(S[2 * c][hh][2], S[2 * c][hh][3]),
                          pack2(S[2 * c + 1][hh][0], S[2 * c + 1][hh][1]), pack2(S[2 * c + 1][hh][2], S[2 * c + 1][hh][3]));
      }
      continue;
    }
    float mx = -1e30f;
#pragma unroll
    for (int kt = 0; kt < 4; ++kt)
#pragma unroll
      for (int j = 0; j < 4; ++j) {
        int kl = kt * 16 + quad * 4 + j;
        bool v = (kl >= lo) && (kl <= hi);
        float sv = v ? S[kt][hh][j] : -1e30f;
        S[kt][hh][j] = sv;
        mx = fmaxf(mx, sv);
      }
    if (MODE != 1) {
      mx = fmaxf(mx, shx(mx, 16, lane));
      mx = fmaxf(mx, shx(mx, 32, lane));
      float m_new = fmaxf(st.m[hh], mx);
      float alpha = __expf(st.m[hh] - m_new);
      st.m[hh] = m_new;
      float rs = 0.f;
#pragma unroll
      for (int kt = 0; kt < 4; ++kt)
#pragma unroll
        for (int j = 0; j < 4; ++j) {
          float sv = S[kt][hh][j];
          float pv = (sv > -1e29f) ? __expf(sv - m_new) : 0.f;
          rs += pv;
          S[kt][hh][j] = pv;
        }
      st.l[hh] = st.l[hh] * alpha + rs;
      if (MODE == 2) {
#pragma unroll
        for (int dt = 0; dt < 4; ++dt) st.O[hh][dt] *= alpha;
      }
    } else {
      const float mh = st.m[hh], il = invl[hh];
#pragma unroll
      for (int kt = 0; kt < 4; ++kt) {
        float a = 0.f;
#pragma unroll
        for (int j = 0; j < 4; ++j) {
          float sv = S[kt][hh][j];
          float pv = (sv > -1e29f) ? __expf(sv - mh) * il : 0.f;
          S[kt][hh][j] = pv;
          a += pv;
        }
        impA[kt] += a;
        impE[kt] += S[kt][hh][3];
      }
    }
    if (MODE != 0) {
#pragma unroll
      for (int c = 0; c < 2; ++c)
        pf[hh][c] = mk8(pack2(S[2 * c][hh][0], S[2 * c][hh][1]), pack2(S[2 * c][hh][2], S[2 * c][hh][3]),
                        pack2(S[2 * c + 1][hh][0], S[2 * c + 1][hh][1]), pack2(S[2 * c + 1][hh][2], S[2 * c + 1][hh][3]));
    }
  }
  }
  if (MODE != 0) {
#pragma unroll
    for (int dt = 0; dt < 4; ++dt) {
      const int row = dt * 16 + col;
      const int sw = (row >> 1) & 7;
#pragma unroll
      for (int c = 0; c < 2; ++c) {
        uint2 a = *(const uint2*)(Vs + row * 64 + (((4 * c + (quad >> 1)) ^ sw) << 3) + (quad & 1) * 4);
        uint2 b = *(const uint2*)(Vs + row * 64 + (((4 * c + 2 + (quad >> 1)) ^ sw) << 3) + (quad & 1) * 4);
        bf16x8 vf = mk8(a.x, a.y, b.x, b.y);
#pragma unroll
        for (int hh = 0; hh < 2; ++hh) st.O[hh][dt] = mfma16(vf, pf[hh][c], st.O[hh][dt]);
      }
    }
    if (FX && MODE == 2) {
      const bf16x8 ones = mk8(0x3F803F80u, 0x3F803F80u, 0x3F803F80u, 0x3F803F80u);
#pragma unroll
      for (int c = 0; c < 2; ++c)
#pragma unroll
        for (int hh = 0; hh < 2; ++hh) st.L[hh] = mfma16(ones, pf[hh][c], st.L[hh]);
    }
  }
}

DI void st_reset(AttnSt& st) {
#pragma unroll
  for (int h = 0; h < 2; ++h) {
    st.m[h] = -1e30f;
    st.l[h] = 0.f;
    st.L[h] = f32x4{0.f, 0.f, 0.f, 0.f};
#pragma unroll
    for (int dt = 0; dt < 4; ++dt) st.O[h][dt] = f32x4{0.f, 0.f, 0.f, 0.f};
  }
}

template <bool FIRST>
DI void nsa_flush(const int quad, bf16_t* optr, const AttnSt& st, const float (&sc)[2]) {
#pragma unroll
  for (int h = 0; h < 2; ++h)
#pragma unroll
    for (int dt = 0; dt < 4; ++dt) {
      uint2* q = (uint2*)(optr + h * 64 + dt * 16 + quad * 4);
      f32x4 o = st.O[h][dt] * sc[h];
      if (!FIRST) {
        uint2 pv = *q;
        o[0] += bflo(pv.x); o[1] += bfhi(pv.x); o[2] += bflo(pv.y); o[3] += bfhi(pv.y);
      }
      uint2 u;
      u.x = pack2(o[0], o[1]);
      u.y = pack2(o[2], o[3]);
      *q = u;
    }
}

template <bool FX>
DI void nsa_tile(const Params& p, int b, int g, int tile, bf16_t* lds, const float CL) {
  const int tid = TID(), lane = tid & 63, w = tid >> 6, quad = lane >> 4, col = lane & 15;
  const int cur = tile;
  const int tok = tile * 64 + w * 16 + col;
  bf16_t* z = (bf16_t*)(p.ws + O_Z);
  const bf16_t* kcmp = (const bf16_t*)(p.ws + O_KCMP) + (size_t)(b * 2 + g) * 512 * 64;
  const bf16_t* vcmpT = (const bf16_t*)(p.ws + O_VCMPT) + (size_t)(b * 2 + g) * 64 * 512;
  const bf16_t* vsT = (const bf16_t*)(p.ws + O_VST) + (size_t)(b * 2 + g) * 64 * TS;
  const bf16_t* vwT = (const bf16_t*)(p.ws + O_VWT) + (size_t)(b * 2 + g) * 64 * TS;
  const bf16_t* zb = z + (size_t)b * SEQ * ZS;
  const bf16_t* ztok = z + ((size_t)(b * SEQ + tok)) * ZS;
  bf16_t* otok = (bf16_t*)(p.ws + O_ONSA) + ((size_t)(b * SEQ + tok)) * 512 + g * 256;
  bf16_t* Ks = lds;
  bf16_t* Vs = lds + 4096;
  float* impl = (float*)(lds + 8192);

  AttnSt st;
  float invl[2] = {0.f, 0.f};
  float dA[4] = {0.f, 0.f, 0.f, 0.f}, dE[4] = {0.f, 0.f, 0.f, 0.f};
  u32x4 rk0, rk1, rv0, rv1;
  bf16x8 qf[2][2];

  const int ncs = (cur < 16) ? 1 : (cur >> 4) + 1;
  const int chi = (tok >= 31) ? ((tok - 31) >> 4) : -1;

  for (int hp = 0; hp < 2; ++hp) {
#pragma unroll
    for (int hh = 0; hh < 2; ++hh)
#pragma unroll
      for (int ks = 0; ks < 2; ++ks) qf[hh][ks] = *(const bf16x8*)(ztok + C_Q + g * 256 + (hp * 2 + hh) * 64 + ks * 32 + quad * 8);
    st_reset(st);
    tile64_gload(tid, rk0, rk1, kcmp, 64);
    for (int s = 0; s < ncs; ++s) {
      __syncthreads();
      tile64_sstore(tid, Ks, rk0, rk1);
      __syncthreads();
      if (s + 1 < ncs) tile64_gload(tid, rk0, rk1, kcmp + (size_t)(s + 1) * 4096, 64);
      attn_compute<0, FX>(lane, Ks, Vs, qf, st, invl, 0, chi - s * 64, dA, dE, CL);
    }
#pragma unroll
    for (int h = 0; h < 2; ++h) {
      float l = st.l[h];
      l += shx(l, 16, lane);
      l += shx(l, 32, lane);
      invl[h] = (l > 0.f) ? 1.f / l : 0.f;
    }
    {
      float carry = 0.f;
      tile64_gload(tid, rk0, rk1, kcmp, 64);
      tile64_gload(tid, rv0, rv1, vcmpT, 512);
      for (int s = 0; s < ncs; ++s) {
        float iA[4] = {0.f, 0.f, 0.f, 0.f}, iE[4] = {0.f, 0.f, 0.f, 0.f};
        __syncthreads();
        tile64_sstore(tid, Ks, rk0, rk1);
        tile64_sstore(tid, Vs, rv0, rv1);
        __syncthreads();
        if (s + 1 < ncs) {
          tile64_gload(tid, rk0, rk1, kcmp + (size_t)(s + 1) * 4096, 64);
          tile64_gload(tid, rv0, rv1, vcmpT + (s + 1) * 64, 512);
        }
        attn_compute<1, FX>(lane, Ks, Vs, qf, st, invl, 0, chi - s * 64, iA, iE, CL);
#pragma unroll
        for (int kt = 0; kt < 4; ++kt) {
          float recv = shfrom(iE[kt], (lane + 48) & 63);
          float val = iA[kt] + ((quad == 0) ? carry : recv);
          carry = recv;
          float* slot = impl + (s * 4 + kt) * 256 + tid;
          if (hp == 0) *slot = val; else *slot += val;
        }
      }
    }
    {
      float sc[2];
#pragma unroll
      for (int h = 0; h < 2; ++h) sc[h] = sigmoidf(bf2f(ztok[C_GT + 0 * 8 + g * 4 + hp * 2 + h]));
      nsa_flush<true>(quad, otok + hp * 128, st, sc);
    }
  }

  uint32_t sw0, sw1, sw2, sw3;
  {
    uint32_t key[32];
#pragma unroll
    for (int i = 0; i < 32; ++i) {
      int j = i * 4 + quad;
      float sc = (i < ncs * 4) ? impl[i * 256 + tid] : 0.f;
      if (j == 0 || j == cur || j == cur - 1) sc = 1e4f;
      uint32_t k = (__float_as_uint(sc) & ~127u) | (uint32_t)(127 - j);
      key[i] = (j > cur) ? 0u : k;
    }
    uint32_t prev = 0xFFFFFFFFu;
    for (int r = 0; r < 16; ++r) {
      uint32_t mx = 0u;
#pragma unroll
      for (int i = 0; i < 32; ++i) {
        uint32_t k = key[i];
        k = (k < prev) ? k : 0u;
        mx = (k > mx) ? k : mx;
      }
      uint32_t o = shxu(mx, 16, lane);
      mx = (o > mx) ? o : mx;
      o = shxu(mx, 32, lane);
      mx = (o > mx) ? o : mx;
      prev = mx;
    }
    sw0 = 0u; sw1 = 0u; sw2 = 0u; sw3 = 0u;
#pragma unroll
    for (int i = 0; i < 32; ++i) {
      bool sel = (key[i] != 0u) && (key[i] >= prev);
      uint32_t bit = sel ? (1u << ((i & 7) * 4 + quad)) : 0u;
      if ((i >> 3) == 0) sw0 |= bit;
      else if ((i >> 3) == 1) sw1 |= bit;
      else if ((i >> 3) == 2) sw2 |= bit;
      else sw3 |= bit;
    }
    sw0 |= shxu(sw0, 16, lane); sw0 |= shxu(sw0, 32, lane);
    sw1 |= shxu(sw1, 16, lane); sw1 |= shxu(sw1, 32, lane);
    sw2 |= shxu(sw2, 16, lane); sw2 |= shxu(sw2, 32, lane);
    sw3 |= shxu(sw3, 16, lane); sw3 |= shxu(sw3, 32, lane);
  }

  for (int hp = 0; hp < 2; ++hp) {
#pragma unroll
    for (int hh = 0; hh < 2; ++hh)
#pragma unroll
      for (int ks = 0; ks < 2; ++ks) qf[hh][ks] = *(const bf16x8*)(ztok + C_Q + g * 256 + (hp * 2 + hh) * 64 + ks * 32 + quad * 8);
    st_reset(st);
    {
      const bf16_t* kb = zb + C_KS + g * 64;
      tile64_gload(tid, rk0, rk1, kb, ZS);
      tile64_gload(tid, rv0, rv1, vsT, TS);
      for (int s = 0; s <= cur; ++s) {
        __syncthreads();
        tile64_sstore(tid, Ks, rk0, rk1);
        tile64_sstore(tid, Vs, rv0, rv1);
        __syncthreads();
        if (s < cur) {
          tile64_gload(tid, rk0, rk1, kb + (size_t)(s + 1) * 64 * ZS, ZS);
          tile64_gload(tid, rv0, rv1, vsT + (s + 1) * 64, TS);
        }
        uint32_t wsel = (s < 32) ? sw0 : (s < 64) ? sw1 : (s < 96) ? sw2 : sw3;
        bool sel = (wsel >> (s & 31)) & 1u;
        int hi = sel ? (tok - s * 64) : -1;
        if (__any(hi >= 0)) attn_compute<2, FX>(lane, Ks, Vs, qf, st, invl, 0, hi, dA, dE, CL);
      }
    }
    {
      float sc[2];
#pragma unroll
      for (int h = 0; h < 2; ++h) {
        float l;
        if (FX) {
          l = st.L[h][0];
        } else {
          l = st.l[h];
          l += shx(l, 16, lane);
          l += shx(l, 32, lane);
        }
        sc[h] = (l > 0.f) ? sigmoidf(bf2f(ztok[C_GT + 1 * 8 + g * 4 + hp * 2 + h])) / l : 0.f;
      }
      nsa_flush<false>(quad, otok + hp * 128, st, sc);
    }
    st_reset(st);
    {
      const bf16_t* kb = zb + C_KW + g * 64;
      const int s0 = (cur >= 8) ? cur - 8 : 0;
      tile64_gload(tid, rk0, rk1, kb + (size_t)s0 * 64 * ZS, ZS);
      tile64_gload(tid, rv0, rv1, vwT + s0 * 64, TS);
      for (int s = s0; s <= cur; ++s) {
        __syncthreads();
        tile64_sstore(tid, Ks, rk0, rk1);
        tile64_sstore(tid, Vs, rv0, rv1);
        __syncthreads();
        if (s < cur) {
          tile64_gload(tid, rk0, rk1, kb + (size_t)(s + 1) * 64 * ZS, ZS);
          tile64_gload(tid, rv0, rv1, vwT + (s + 1) * 64, TS);
        }
        attn_compute<2, FX>(lane, Ks, Vs, qf, st, invl, tok - 511 - s * 64, tok - s * 64, dA, dE, CL);
      }
    }
    {
      float sc[2];
#pragma unroll
      for (int h = 0; h < 2; ++h) {
        float l;
        if (FX) {
          l = st.L[h][0];
        } else {
          l = st.l[h];
          l += shx(l, 16, lane);
          l += shx(l, 32, lane);
        }
        sc[h] = (l > 0.f) ? sigmoidf(bf2f(ztok[C_GT + 2 * 8 + g * 4 + hp * 2 + h])) / l : 0.f;
      }
      nsa_flush<false>(quad, otok + hp * 128, st, sc);
    }
  }
}

DI void load128(int tid, bf16_t* lds, const bf16_t* base, size_t stride) {
  u32x4 r[8];
#pragma unroll
  for (int i = 0; i < 8; ++i) {
    int idx = tid + 256 * i;
    int row = idx >> 4, ch = idx & 15;
    r[i] = *(const u32x4*)(base + (size_t)row * stride + ch * 8);
  }
#pragma unroll
  for (int i = 0; i < 8; ++i) {
    int idx = tid + 256 * i;
    int row = idx >> 4, ch = idx & 15;
    *(u32x4*)(lds + row * 128 + ((ch ^ (row & 15)) << 3)) = r[i];
  }
}

DI void ret_tile(const Params& p, int b, int h, int c, bf16_t* lds) {
  const int tid = TID(), lane = tid & 63, w = tid >> 6, quad = lane >> 4, col = lane & 15;
  const float lg2 = log2f(1.f - exp2f(-5.f - (float)h));
  bf16_t* z = (bf16_t*)(p.ws + O_Z);
  const bf16_t* rvT = (const bf16_t*)(p.ws + O_RVT);
  bf16_t* zc = z + ((size_t)(b * SEQ + c * 128)) * ZS;
  bf16x8 qf[2][4];
#pragma unroll
  for (int nt = 0; nt < 2; ++nt)
#pragma unroll
    for (int ks = 0; ks < 4; ++ks) {
      int n = 32 * w + nt * 16 + col;
      qf[nt][ks] = *(const bf16x8*)(zc + (size_t)n * ZS + C_RQ + h * 128 + ks * 32 + quad * 8);
    }
  f32x4 acc[8][2];
#pragma unroll
  for (int et = 0; et < 8; ++et)
#pragma unroll
    for (int nt = 0; nt < 2; ++nt) acc[et][nt] = f32x4{0.f, 0.f, 0.f, 0.f};
  __syncthreads();
  load128(tid, lds, zc + C_RV + h * 128, ZS);
  __syncthreads();
#pragma unroll
  for (int ks = 0; ks < 4; ++ks)
#pragma unroll
    for (int et = 0; et < 8; ++et) {
      int row = et * 16 + col;
      bf16x8 af = *(const bf16x8*)(lds + row * 128 + (((ks * 4 + quad) ^ (row & 15)) << 3));
#pragma unroll
      for (int nt = 0; nt < 2; ++nt) acc[et][nt] = mfma16(af, qf[nt][ks], acc[et][nt]);
    }
#pragma unroll
  for (int nt = 0; nt < 2; ++nt) {
    int n = 32 * w + nt * 16 + col;
    float xi = __builtin_amdgcn_exp2f(lg2 * (float)(n + 1));
#pragma unroll
    for (int et = 0; et < 8; ++et) acc[et][nt] *= xi;
  }
  __syncthreads();
  load128(tid, lds, zc + C_RK + h * 128, ZS);
  __syncthreads();
  bf16x8 pf[2][4];
#pragma unroll
  for (int nt = 0; nt < 2; ++nt) {
    f32x4 s[8];
#pragma unroll
    for (int mt = 0; mt < 8; ++mt) s[mt] = f32x4{0.f, 0.f, 0.f, 0.f};
#pragma unroll
    for (int ks = 0; ks < 4; ++ks)
#pragma unroll
      for (int mt = 0; mt < 8; ++mt) {
        if (mt <= 2 * w + 1) {
          int row = mt * 16 + col;
          bf16x8 af = *(const bf16x8*)(lds + row * 128 + (((ks * 4 + quad) ^ (row & 15)) << 3));
          s[mt] = mfma16(af, qf[nt][ks], s[mt]);
        }
      }
    const int n = 32 * w + nt * 16 + col;
#pragma unroll
    for (int c2 = 0; c2 < 4; ++c2) {
      float v[8];
#pragma unroll
      for (int i = 0; i < 8; ++i) {
        const int mt = 2 * c2 + (i >> 2), j = i & 3;
        const int m = mt * 16 + quad * 4 + j;
        v[i] = (n >= m) ? s[mt][j] * __builtin_amdgcn_exp2f(lg2 * (float)(n - m)) : 0.f;
      }
      pf[nt][c2] = mk8(pack2(v[0], v[1]), pack2(v[2], v[3]), pack2(v[4], v[5]), pack2(v[6], v[7]));
    }
  }
  __syncthreads();
  load128(tid, lds, rvT + ((size_t)((b * 4 + h) * 128)) * TS + c * 128, TS);
  __syncthreads();
#pragma unroll
  for (int c2 = 0; c2 < 4; ++c2) {
    if (2 * c2 <= 2 * w + 1) {
#pragma unroll
      for (int et = 0; et < 8; ++et) {
        int row = et * 16 + col;
        int sw = row & 15;
        uint2 a = *(const uint2*)(lds + row * 128 + (((4 * c2 + (quad >> 1)) ^ sw) << 3) + (quad & 1) * 4);
        uint2 bb = *(const uint2*)(lds + row * 128 + (((4 * c2 + 2 + (quad >> 1)) ^ sw) << 3) + (quad & 1) * 4);
        bf16x8 vf = mk8(a.x, a.y, bb.x, bb.y);
#pragma unroll
        for (int nt = 0; nt < 2; ++nt) acc[et][nt] = mfma16(vf, pf[nt][c2], acc[et][nt]);
      }
    }
  }
#pragma unroll
  for (int nt = 0; nt < 2; ++nt) {
    float ss = 0.f;
#pragma unroll
    for (int et = 0; et < 8; ++et)
#pragma unroll
      for (int j = 0; j < 4; ++j) ss += acc[et][nt][j] * acc[et][nt][j];
    ss += shx(ss, 16, lane);
    ss += shx(ss, 32, lane);
    const float rs = rsqrtf(ss * (1.f / 128.f) + 1e-6f);
    const int n = 32 * w + nt * 16 + col;
    bf16_t* zr = zc + (size_t)n * ZS;
#pragma unroll
    for (int et = 0; et < 8; ++et) {
      const int e0 = et * 16 + quad * 4;
      uint2 gv = *(const uint2*)(zr + C_RG + h * 128 + e0);
      float g0 = bflo(gv.x), g1 = bfhi(gv.x), g2 = bflo(gv.y), g3 = bfhi(gv.y);
      uint2 o;
      o.x = pack2(acc[et][nt][0] * rs * g0 * sigmoidf(g0), acc[et][nt][1] * rs * g1 * sigmoidf(g1));
      o.y = pack2(acc[et][nt][2] * rs * g2 * sigmoidf(g2), acc[et][nt][3] * rs * g3 * sigmoidf(g3));
      *(uint2*)(zr + C_RQ + h * 128 + e0) = o;
    }
  }
}

#define GEMM_TILE_LOOP(NT)                                                             \
  for (int qp_ = (int)(blockIdx.x >> 3), per_ = (int)(gridDim.x >> 3), xcd_ = (int)(blockIdx.x & 7), q_ = 0, mt = 0, ntile = 0; \
       2 * qp_ < 32 * (NT) && ((q_ = 2 * qp_ + HALF()), (mt = (((xcd_ + 8 * (q_ / (8 * (NT)))) << 3) + ((q_ % (8 * (NT))) & 7)), ntile = ((q_ % (8 * (NT))) >> 3)), true); \
       qp_ += per_)


DI int TID8() { int t = threadIdx.x; asm volatile("" : "+v"(t)); return t; }
DI void g8_load(u32x4 (&ra)[4], u32x4 (&rb)[4], const bf16_t* a, size_t lda, const bf16_t* b, size_t ldb, int kb, int lrow, int lch) {
#pragma unroll
  for (int i = 0; i < 4; ++i) {
    ra[i] = *(const u32x4*)(a + (size_t)(lrow + 64 * i) * lda + kb * 64 + lch * 8);
    rb[i] = *(const u32x4*)(b + (size_t)(lrow + 64 * i) * ldb + kb * 64 + lch * 8);
  }
}
DI void g8_store(bf16_t* S, const u32x4 (&ra)[4], const u32x4 (&rb)[4], int lrow, int lch) {
#pragma unroll
  for (int i = 0; i < 4; ++i) {
    const int r = lrow + 64 * i;
    const int off = r * 64 + ((lch ^ ((r >> 1) & 7)) << 3);
    *(u32x4*)(S + off) = ra[i];
    *(u32x4*)(S + 16384 + off) = rb[i];
  }
}
DI void g8_load1(u32x4 (&r4)[4], const bf16_t* a, size_t lda, int kb, int lrow, int lch) {
  const bf16_t* base = a + kb * 64;
  const unsigned ld32 = (unsigned)lda;
#pragma unroll
  for (int i = 0; i < 4; ++i) {
    const unsigned off = (unsigned)(lrow + 64 * i) * ld32 + (unsigned)(lch * 8);
    r4[i] = *(const u32x4*)(base + off);
  }
}
DI void g8_store1(bf16_t* S, const u32x4 (&r4)[4], int lrow, int lch) {
#pragma unroll
  for (int i = 0; i < 4; ++i) {
    const int r = lrow + 64 * i;
    *(u32x4*)(S + r * 64 + ((lch ^ ((r >> 1) & 7)) << 3)) = r4[i];
  }
}
template <int KS0 = 0, int KS1 = 2>
DI void g8_compute(f32x4 (&acc)[8][4], const bf16_t* S, int wm, int wn, int lane) {
#pragma unroll
  for (int ks = KS0; ks < KS1; ++ks) {
    bf16x8 af[8], bfr[4];
#pragma unroll
    for (int i = 0; i < 8; ++i) {
      const int r = wm * 128 + i * 16 + (lane & 15);
      af[i] = *(const bf16x8*)(S + r * 64 + (((ks * 4 + (lane >> 4)) ^ ((r >> 1) & 7)) << 3));
    }
#pragma unroll
    for (int j = 0; j < 4; ++j) {
      const int r = wn * 64 + j * 16 + (lane & 15);
      bfr[j] = *(const bf16x8*)(S + 16384 + r * 64 + (((ks * 4 + (lane >> 4)) ^ ((r >> 1) & 7)) << 3));
    }
    __builtin_amdgcn_s_setprio(1);
#pragma unroll
    for (int i = 0; i < 8; ++i)
#pragma unroll
      for (int j = 0; j < 4; ++j) acc[i][j] = mfma16(bfr[j], af[i], acc[i][j]);
    __builtin_amdgcn_s_setprio(0);
  }
}
DI void g8_load1o(u32x4 (&r4)[4], const bf16_t* base, const unsigned (&off)[4]) {
#pragma unroll
  for (int i = 0; i < 4; ++i) r4[i] = *(const u32x4*)(base + off[i]);
}
DI void gemm8_accum(f32x4 (&acc)[8][4], const bf16_t* a, size_t lda, const bf16_t* b, size_t ldb, int nkb, bf16_t* L,
                    const bool pre, const bf16_t* an, size_t ldan, const bf16_t* bn, size_t ldbn) {
  const int tid = TID8(), lane = tid & 63, w = tid >> 6;
  const int wm = w >> 2, wn = w & 3;
  const int lrow = tid >> 3, lch = tid & 7;
  u32x4 ra[4], rb[4];
  unsigned offa[4], offb[4];
#pragma unroll
  for (int i = 0; i < 4; ++i) {
    offa[i] = (unsigned)(lrow + 64 * i) * (unsigned)lda + (unsigned)(lch * 8);
    offb[i] = (unsigned)(lrow + 64 * i) * (unsigned)ldb + (unsigned)(lch * 8);
  }
  if (!pre) {
    g8_load1o(ra, a, offa);
    g8_load1o(rb, b, offb);
    __syncthreads();
    g8_store(L, ra, rb, lrow, lch);
  }
  g8_load1o(ra, a + 64, offa);
  g8_load1o(rb, b + 64, offb);
  for (int kb = 0; kb + 2 < nkb; ++kb) {
    __syncthreads();
    g8_store1(L + ((kb + 1) & 1) * 32768, ra, lrow, lch);
    g8_load1o(ra, a + (kb + 2) * 64, offa);
    __builtin_amdgcn_sched_barrier(0);
    g8_compute<0, 1>(acc, L + (kb & 1) * 32768, wm, wn, lane);
    __builtin_amdgcn_sched_barrier(0);
    g8_store1(L + ((kb + 1) & 1) * 32768 + 16384, rb, lrow, lch);
    g8_load1o(rb, b + (kb + 2) * 64, offb);
    __builtin_amdgcn_sched_barrier(0);
    g8_compute<1, 2>(acc, L + (kb & 1) * 32768, wm, wn, lane);
  }
  __syncthreads();
  g8_store1(L + 32768, ra, lrow, lch);
  g8_load1(ra, an, ldan, 0, lrow, lch);
  __builtin_amdgcn_sched_barrier(0);
  g8_compute<0, 1>(acc, L, wm, wn, lane);
  __builtin_amdgcn_sched_barrier(0);
  g8_store1(L + 32768 + 16384, rb, lrow, lch);
  g8_load1(rb, bn, ldbn, 0, lrow, lch);
  __builtin_amdgcn_sched_barrier(0);
  g8_compute<1, 2>(acc, L, wm, wn, lane);
  __syncthreads();
  g8_store1(L, ra, lrow, lch);
  __builtin_amdgcn_sched_barrier(0);
  g8_compute<0, 1>(acc, L + 32768, wm, wn, lane);
  __builtin_amdgcn_sched_barrier(0);
  g8_store1(L + 16384, rb, lrow, lch);
  __builtin_amdgcn_sched_barrier(0);
  g8_compute<1, 2>(acc, L + 32768, wm, wn, lane);
  __syncthreads();
}
DI void zero_acc8(f32x4 (&acc)[8][4]) {
#pragma unroll
  for (int i = 0; i < 8; ++i)
#pragma unroll
    for (int j = 0; j < 4; ++j) acc[i][j] = f32x4{0.f, 0.f, 0.f, 0.f};
}
template <class F>
DI void gemm8_epi_staged(f32x4 (&acc)[8][4], int m0, int n0, bf16_t* L0, F f, bf16_t* dst, size_t ld, int nmax) {
  bf16_t* L = L0 + 32768;
  const int tid = TID8(), lane = tid & 63, w = tid >> 6;
  const int wm = w >> 2, wn = w & 3;
#pragma unroll
  for (int half = 0; half < 2; ++half) {
    if (wm == half) {
#pragma unroll
      for (int i = 0; i < 8; ++i)
#pragma unroll
        for (int j = 0; j < 4; ++j) {
          const int ml = i * 16 + (lane & 15);
          const int nl = wn * 64 + j * 16 + (lane >> 4) * 4;
          f32x4 a = acc[i][j];
          f(m0 + half * 128 + ml, n0 + nl, a);
          uint2 u;
          u.x = pack2(a[0], a[1]);
          u.y = pack2(a[2], a[3]);
          *(uint2*)(L + ml * 264 + nl) = u;
        }
    }
    __syncthreads();
#pragma unroll
    for (int it = 0; it < 8; ++it) {
      const int idx = tid + 512 * it;
      const int row = idx >> 5, ch = idx & 31;
      const u32x4 v = *(const u32x4*)(L + row * 264 + ch * 8);
      const int n = n0 + ch * 8;
      if (n < nmax) *(u32x4*)(dst + (size_t)(m0 + half * 128 + row) * ld + n) = v;
    }
    __syncthreads();
  }
}
DI void gemm8_epi_resid(f32x4 (&acc)[8][4], int m0, int n0, int ntile8, bf16_t* L, const float* xin, float* out, bf16_t* xb, float* rowpart) {
  const int tid = TID8(), lane = tid & 63, w = tid >> 6;
  const int wm = w >> 2, wn = w & 3;
  float* red = (float*)(L + 32768);
#pragma unroll
  for (int i = 0; i < 8; ++i) {
    const int ml = wm * 128 + i * 16 + (lane & 15);
    const size_t rowoff = (size_t)(m0 + ml) * DM;
    float ss = 0.f;
#pragma unroll
    for (int j = 0; j < 4; ++j) {
      const int n = n0 + wn * 64 + j * 16 + (lane >> 4) * 4;
      const float4 xv = *(const float4*)(xin + rowoff + n);
      const float o0 = xv.x + acc[i][j][0], o1 = xv.y + acc[i][j][1], o2 = xv.z + acc[i][j][2], o3 = xv.w + acc[i][j][3];
      *(float4*)(out + rowoff + n) = make_float4(o0, o1, o2, o3);
      ss += o0 * o0 + o1 * o1 + o2 * o2 + o3 * o3;
      uint2 u;
      u.x = pack2(o0, o1);
      u.y = pack2(o2, o3);
      *(uint2*)(xb + rowoff + n) = u;
    }
    ss += shx(ss, 16, lane);
    ss += shx(ss, 32, lane);
    if ((lane >> 4) == 0) red[wn * 256 + ml] = ss;
  }
  __syncthreads();
  {
    const int row = tid & 255, h = tid >> 8;
    rowpart[(size_t)(ntile8 * 2 + h) * T_TOK + m0 + row] = red[(2 * h) * 256 + row] + red[(2 * h + 1) * 256 + row];
  }
}
template <class E>
DI void gemm8_epi(f32x4 (&acc)[8][4], int m0, int n0, E e) {
  const int tid = TID8(), lane = tid & 63, w = tid >> 6;
  const int wm = w >> 2, wn = w & 3;
#pragma unroll
  for (int i = 0; i < 8; ++i)
#pragma unroll
    for (int j = 0; j < 4; ++j) {
      const int m = m0 + wm * 128 + i * 16 + (lane & 15);
      const int n = n0 + wn * 64 + j * 16 + (lane >> 4) * 4;
      e(m, n, acc[i][j]);
    }
}
DI void row_rs8(float (&rsv)[8], const float* rowpart, int m0) {
  const int tid = TID8(), lane = tid & 63, wm = tid >> 8;
#pragma unroll
  for (int i = 0; i < 8; ++i) {
    const int m = m0 + wm * 128 + i * 16 + (lane & 15);
    float s = 0.f;
#pragma unroll
    for (int t = 0; t < 8; ++t) s += rowpart[(size_t)t * T_TOK + m];
    rsv[i] = rsqrtf(s * (1.f / 1024.f) + 1e-6f);
  }
}
DI void scale_rows8(f32x4 (&acc)[8][4], const float (&rsv)[8]) {
#pragma unroll
  for (int i = 0; i < 8; ++i)
#pragma unroll
    for (int j = 0; j < 4; ++j) acc[i][j] *= rsv[i];
}
#define G8_TILE(q, NT8, MT, NTL) \
  MT = (((xcd_ + 8 * ((q) / (4 * (NT8)))) << 2) + (((q) % (4 * (NT8))) & 3)); NTL = (((q) % (4 * (NT8))) >> 2);
#define GEMM8_TILE_LOOP(NT8)                                                            \
  for (int q_ = (int)(blockIdx.x >> 3), per_ = (int)(gridDim.x >> 3), xcd_ = (int)(blockIdx.x & 7), first_ = 1, mt = 0, ntile = 0, mtn = 0, ntilen = 0; \
       q_ < 16 * (NT8) && ([&] { G8_TILE(q_, NT8, mt, ntile) const int qn_ = (q_ + per_ < 16 * (NT8)) ? q_ + per_ : q_; G8_TILE(qn_, NT8, mtn, ntilen) }(), true); \
       q_ += per_, first_ = 0)

#define XB_TMO      128
#define XB_XCNT(j)  (256  + 64 * (j))
#define XB_XSUB(j)  (1280 + 64 * (j))
#define XB_XGEN(j)  (2304 + 64 * (j))
#define XB_TOP      3328
#define XB_TOPGEN   3392
#define XB_SPIN_CAP (1u << 20)
DI unsigned xb_ld(unsigned* p) { return __hip_atomic_load(p, __ATOMIC_RELAXED, __HIP_MEMORY_SCOPE_AGENT); }
DI unsigned xb_add(unsigned* p, unsigned v) { return __hip_atomic_fetch_add(p, v, __ATOMIC_RELAXED, __HIP_MEMORY_SCOPE_AGENT); }
DI unsigned xb_xcc_id() { return (unsigned)__builtin_amdgcn_s_getreg((3 << 11) | 20) & 0xFu; }
#define XB_SPIN(cond, bar) do { unsigned _sp = 0; while (cond) { __builtin_amdgcn_s_sleep(1); \
    if ((++_sp & 255u) == 0u) { if (xb_ld(&(bar)[XB_TMO])) break; if (_sp > XB_SPIN_CAP) { atomicAdd(&(bar)[XB_TMO], 1u); break; } } } } while (0)

DI void xcd_barrier(unsigned* bar, const unsigned x, const unsigned nloc, const unsigned nx) {
  asm volatile("s_waitcnt vmcnt(0)" ::: "memory");
  __syncthreads();
  if (threadIdx.x == 0) {
    __builtin_amdgcn_s_waitcnt(0);
    const unsigned old = xb_add(&bar[XB_XSUB(x)], 1u);
    const unsigned gen = old / nloc;
    if (old + 1u == (gen + 1u) * nloc) {
      __builtin_amdgcn_fence(__ATOMIC_RELEASE, "agent");
      asm volatile("s_waitcnt vmcnt(0)" ::: "memory");
      const unsigned og = xb_add(&bar[XB_TOP], 1u);
      const unsigned tg = og / nx;
      if (og + 1u == (tg + 1u) * nx) xb_add(&bar[XB_TOPGEN], 1u);
      else XB_SPIN(xb_ld(&bar[XB_TOPGEN]) == tg, bar);
      __builtin_amdgcn_fence(__ATOMIC_ACQUIRE, "agent");
      xb_add(&bar[XB_XGEN(x)], 1u);
      asm volatile("s_waitcnt vmcnt(0)" ::: "memory");
    } else {
      XB_SPIN(xb_ld(&bar[XB_XGEN(x)]) == gen, bar);
      __builtin_amdgcn_fence(__ATOMIC_ACQUIRE, "agent");
      asm volatile("s_waitcnt vmcnt(0)" ::: "memory");
    }
  }
  __syncthreads();
}

__global__ void __launch_bounds__(512, 2) mega(Params p) {
  extern __shared__ __attribute__((aligned(16))) bf16_t lds_all[];
  bf16_t* lds = lds_all + HALF() * 32768;
  cg::grid_group grid = cg::this_grid();
  const int nb = NVB;
  bf16_t* wt = (bf16_t*)(p.ws + O_WT);
  bf16_t* z = (bf16_t*)(p.ws + O_Z);
  bf16_t* hbuf = (bf16_t*)(p.ws + O_VST);
  bf16_t* ubuf = z;
  bf16_t* p16 = (bf16_t*)(p.ws + O_KVD);
  float* rowpart = (float*)(p.ws + O_RP);
  bf16_t* hid = (bf16_t*)(p.ws + O_HID);
  const float* bias = (const float*)(p.ws + O_BIAS);

  unsigned* bar = (unsigned*)(p.ws + O_BAR);
  const unsigned xb_x = xb_xcc_id();
  if (threadIdx.x == 0) (void)xb_add(&bar[XB_XCNT(xb_x)], 1u);
  unsigned xb_nloc = 1u, xb_nx = 1u;

  for (int layer = 0; layer < 2; ++layer) {
    const bf16_t* wl = wt;
    const float* xin = (layer == 0) ? p.x : p.out;

    phase0(p, layer, lds);
    norm_phase(xin, p.norm_mix + layer * DM, hbuf);
    if (layer == 0) {
      grid.sync();
      unsigned mine = 0u, cnt = 0u;
#pragma unroll
      for (unsigned j = 0; j < 16; ++j) {
        const unsigned c = xb_ld(&bar[XB_XCNT(j)]);
        cnt += (c > 0u) ? 1u : 0u;
        mine = (j == xb_x) ? c : mine;
      }
      xb_nloc = __builtin_amdgcn_readfirstlane(mine > 0u ? mine : 1u);
      xb_nx = __builtin_amdgcn_readfirstlane(cnt > 0u ? cnt : 1u);
    } else {
      xcd_barrier(bar, xb_x, xb_nloc, xb_nx);
    }

    GEMM8_TILE_LOOP(22) {
      const int m0 = mt * 256, n0 = ntile * 256;
      f32x4 acc8[8][4];
      zero_acc8(acc8);
      gemm8_accum(acc8, hbuf + (size_t)m0 * DM, DM, wl + W_IN + (size_t)n0 * 1024, 1024, 16, lds_all, !first_,
                  hbuf + (size_t)mtn * 256 * DM, DM, wl + W_IN + (size_t)ntilen * 256 * 1024, 1024);
      gemm8_epi_staged(acc8, m0, n0, lds_all, [&](int, int, f32x4&) {}, z, ZS, ZS);
    }
    xcd_barrier(bar, xb_x, xb_nloc, xb_nx);

    post_z(p, layer);
    xcd_barrier(bar, xb_x, xb_nloc, xb_nx);

    for (int u_ = (int)blockIdx.x, t = 0; (u_ < 64 || u_ - 64 < 512) && ((t = (u_ < 64) ? 2 * u_ + HALF() : 128 + 2 * (u_ - 64) + HALF()), true); u_ = (u_ < 64) ? 1 << 20 : u_ + (int)gridDim.x - 64) {
      f32x4 acc[4][4];
      zero_acc(acc);
      if (t < 128) {
        const int kv = t >> 6, mt = (t >> 1) & 31, ntile = t & 1;
        const int m0 = mt * 128, n0 = ntile * 128;
        const bf16_t* kvd = (const bf16_t*)(p.ws + O_KVD) + (size_t)kv * 8 * SEQ * 64;
        auto ap = [&](int r, int kb) -> const bf16_t* {
          int row = m0 + r;
          int bg = row >> 9, c = row & 511;
          int tk = 16 * c + kb;
          tk = tk > (SEQ - 1) ? (SEQ - 1) : tk;
          return kvd + ((size_t)(bg * SEQ + tk)) * 64;
        };
        gemm_accum(acc, ap, RowPtr{wl + (kv ? W_C1V : W_C1K) + (size_t)n0 * 2048, 2048}, 32, lds);
        const float* bs = bias + kv * 256;
        bf16_t* hd = hid + (size_t)kv * 4096 * 256;
        gemm_epi(acc, m0, n0, [&](int m, int n, f32x4& a) {
          float o[4];
#pragma unroll
          for (int j = 0; j < 4; ++j) {
            float xv = a[j] + bs[n + j];
            float y = 0.7978845608028654f * (xv + 0.044715f * xv * xv * xv);
            float th = 1.f - 2.f * __builtin_amdgcn_rcpf(__expf(2.f * y) + 1.f);
            o[j] = 0.5f * xv * (1.f + th);
          }
          uint2 u;
          u.x = pack2(o[0], o[1]);
          u.y = pack2(o[2], o[3]);
          *(uint2*)(hd + (size_t)m * 256 + n) = u;
        });
      } else {
        const int idx = t - 128;
        const int c = idx & 63, bh = idx >> 6;
        const bf16_t* rvT = (const bf16_t*)(p.ws + O_RVT) + ((size_t)bh * 128) * TS + c * 128;
        const bf16_t* kzT = (const bf16_t*)(p.ws + O_KZT) + ((size_t)bh * 128) * TS + c * 128;
        gemm_accum(acc, RowPtr{rvT, TS}, RowPtr{kzT, TS}, 2, lds);
        bf16_t* dst = z + ((size_t)((bh >> 2) * SEQ + c * 128)) * ZS + C_RV + (bh & 3) * 128;
        gemm_epi_staged(acc, 0, 0, lds, [&](int, int, f32x4&) {}, dst, ZS, 128);
      }
    }
    xcd_barrier(bar, xb_x, xb_nloc, xb_nx);

    phase4b(p, layer);
    {
      const float* pl = p.p + (size_t)layer * T_TOK * 256;
      const int gtid = VBID * 256 + TID();
      const int gthreads = nb * 256;
      for (int i = gtid; i < T_TOK * 32; i += gthreads) {
        float4 a = ((const float4*)pl)[2 * i], b2 = ((const float4*)pl)[2 * i + 1];
        ((uint4*)p16)[i] = make_uint4(pack2(a.x, a.y), pack2(a.z, a.w), pack2(b2.x, b2.y), pack2(b2.z, b2.w));
      }
    }
    xcd_barrier(bar, xb_x, xb_nloc, xb_nx);

    float nsa_c;
    {
      const int ln = TID() & 63;
      float gq = fabsf(p.nsa_q_norm[layer * 64 + ln]), gk = fabsf(p.nsa_k_norm[layer * 64 + ln]);
#pragma unroll
      for (int o = 32; o > 0; o >>= 1) {
        gq = fmaxf(gq, shx(gq, o, ln));
        gk = fmaxf(gk, shx(gk, o, ln));
      }
      nsa_c = 8.f * gq * gk;
    }
    const bool nsa_fx = nsa_c < 30.f;
    const float nsa_cl = nsa_c * 1.4426950408889634f;
    for (int t = VBID; t < 2048; t += nb) {
      if (t < 1024) {
        const int tile = (t < 512) ? 127 - (t >> 3) : ((t - 512) >> 3), bg = t & 7;
        if (nsa_fx) nsa_tile<true>(p, bg >> 1, bg & 1, tile, lds, nsa_cl);
        else nsa_tile<false>(p, bg >> 1, bg & 1, tile, lds, 0.f);
      } else {
        const int idx = t - 1024;
        ret_tile(p, idx >> 8, (idx >> 6) & 3, idx & 63, lds);
      }
    }
    xcd_barrier(bar, xb_x, xb_nloc, xb_nx);

    GEMM8_TILE_LOOP(4) {
      const int m0 = mt * 256, n0 = ntile * 256;
      f32x4 acc8[8][4];
      zero_acc8(acc8);
      gemm8_accum(acc8, (const bf16_t*)(p.ws + O_ONSA) + (size_t)m0 * 512, 512, wl + W_UPA + (size_t)n0 * 512, 512, 8, lds_all, !first_,
                  z + (size_t)m0 * ZS + C_RQ, ZS, wl + W_UPR + (size_t)n0 * 512, 512);
      gemm8_epi(acc8, m0, n0, [&](int m, int n, f32x4& a) {
        uint2 ua = *(const uint2*)(z + (size_t)m * ZS + C_MA + n);
        uint2 ub = *(const uint2*)(z + (size_t)m * ZS + C_MB + n);
        a[0] *= sigmoidf(bflo(ua.x)) * inv_sigmoidf(bflo(ub.x));
        a[1] *= sigmoidf(bfhi(ua.x)) * inv_sigmoidf(bfhi(ub.x));
        a[2] *= sigmoidf(bflo(ua.y)) * inv_sigmoidf(bflo(ub.y));
        a[3] *= sigmoidf(bfhi(ua.y)) * inv_sigmoidf(bfhi(ub.y));
      });
      gemm8_accum(acc8, z + (size_t)m0 * ZS + C_RQ, ZS, wl + W_UPR + (size_t)n0 * 512, 512, 8, lds_all, true,
                  (const bf16_t*)(p.ws + O_ONSA) + (size_t)mtn * 256 * 512, 512, wl + W_UPA + (size_t)ntilen * 256 * 512, 512);
      gemm8_epi_staged(acc8, m0, n0, lds_all, [&](int m, int n, f32x4& a) {
        uint2 ub = *(const uint2*)(z + (size_t)m * ZS + C_MB + n);
        a[0] *= sigmoidf(bflo(ub.x)); a[1] *= sigmoidf(bfhi(ub.x));
        a[2] *= sigmoidf(bflo(ub.y)); a[3] *= sigmoidf(bfhi(ub.y));
      }, z + C_RK, ZS, 1024);
    }
    xcd_barrier(bar, xb_x, xb_nloc, xb_nx);

    GEMM8_TILE_LOOP(4) {
      const int m0 = mt * 256, n0 = ntile * 256;
      f32x4 acc8[8][4];
      zero_acc8(acc8);
      gemm8_accum(acc8, z + (size_t)m0 * ZS + C_RK, ZS, wl + W_OUT + (size_t)n0 * 1024, 1024, 16, lds_all, !first_,
                  z + (size_t)mtn * 256 * ZS + C_RK, ZS, wl + W_OUT + (size_t)ntilen * 256 * 1024, 1024);
      gemm8_epi_resid(acc8, m0, n0, ntile, lds_all, xin, p.out, hbuf, rowpart);
    }
    xcd_barrier(bar, xb_x, xb_nloc, xb_nx);

    GEMM8_TILE_LOOP(16) {
      const int m0 = mt * 256, n0 = ntile * 256;
      f32x4 acc8[8][4];
      zero_acc8(acc8);
      gemm8_accum(acc8, hbuf + (size_t)m0 * DM, DM, wl + W_FF1 + (size_t)n0 * 1024, 1024, 16, lds_all, !first_,
                  hbuf + (size_t)mtn * 256 * DM, DM, wl + W_FF1 + (size_t)ntilen * 256 * 1024, 1024);
      float rsv[8];
      row_rs8(rsv, rowpart, m0);
      scale_rows8(acc8, rsv);
      gemm8_epi_staged(acc8, m0, n0, lds_all, [&](int, int, f32x4& a) {
        float r0 = fmaxf(a[0], 0.f), r1 = fmaxf(a[1], 0.f), r2 = fmaxf(a[2], 0.f), r3 = fmaxf(a[3], 0.f);
        a[0] = r0 * r0; a[1] = r1 * r1; a[2] = r2 * r2; a[3] = r3 * r3;
      }, ubuf, 4096, 4096);
    }
    xcd_barrier(bar, xb_x, xb_nloc, xb_nx);

    GEMM8_TILE_LOOP(4) {
      const int m0 = mt * 256, n0 = ntile * 256;
      f32x4 acc8[8][4];
      zero_acc8(acc8);
      gemm8_accum(acc8, ubuf + (size_t)m0 * 4096, 4096, wl + W_FF2 + (size_t)n0 * 4096, 4096, 64, lds_all, !first_,
                  ubuf + (size_t)mtn * 256 * 4096, 4096, wl + W_FF2 + (size_t)ntilen * 256 * 4096, 4096);
      gemm8_epi_resid(acc8, m0, n0, ntile, lds_all, p.out, p.out, hbuf, rowpart);
    }
    xcd_barrier(bar, xb_x, xb_nloc, xb_nx);

    GEMM8_TILE_LOOP(4) {
      const int m0 = mt * 256, n0 = ntile * 256;
      f32x4 acc8[8][4];
      zero_acc8(acc8);
      gemm8_accum(acc8, p16 + (size_t)m0 * 256, 256, wl + W_PLE + (size_t)n0 * 256, 256, 4, lds_all, !first_,
                  hbuf + (size_t)m0 * DM, DM, wl + W_PG + (size_t)n0 * 1024, 1024);
      bf16_t* ppb = z + (size_t)T_TOK * 256;
      gemm8_epi_staged(acc8, m0, n0, lds_all, [&](int, int, f32x4&) {}, ppb, DM, 1024);
      zero_acc8(acc8);
      gemm8_accum(acc8, hbuf + (size_t)m0 * DM, DM, wl + W_PG + (size_t)n0 * 1024, 1024, 16, lds_all, true,
                  p16 + (size_t)mtn * 256 * 256, 256, wl + W_PLE + (size_t)ntilen * 256 * 256, 256);
      float rsv[8];
      row_rs8(rsv, rowpart, m0);
      scale_rows8(acc8, rsv);
      gemm8_epi(acc8, m0, n0, [&](int m, int n, f32x4& a) {
        uint2 pv = *(const uint2*)(ppb + (size_t)m * DM + n);
        float4* o = (float4*)(p.out + (size_t)m * DM + n);
        float4 xv = *o;
        *o = make_float4(xv.x + sigmoidf(a[0]) * bflo(pv.x), xv.y + sigmoidf(a[1]) * bfhi(pv.x),
                         xv.z + sigmoidf(a[2]) * bflo(pv.y), xv.w + sigmoidf(a[3]) * bfhi(pv.y));
      });
    }
    xcd_barrier(bar, xb_x, xb_nloc, xb_nx);
  }
}

extern "C" void kernel_launch(void* const* d_in, const int* in_sizes, int n_in,
                              void* d_out, int out_size, void* d_ws, size_t ws_size,
                              hipStream_t stream) {
  static int grid_blocks = 0;
  if (!grid_blocks) {
    int dev = 0, cus = 0, per_cu = 0;
    hipGetDevice(&dev);
    hipDeviceGetAttribute(&cus, hipDeviceAttributeMultiprocessorCount, dev);
    hipFuncSetAttribute((const void*)mega, hipFuncAttributeMaxDynamicSharedMemorySize, DYN_LDS);
    hipOccupancyMaxActiveBlocksPerMultiprocessor(&per_cu, mega, 512, DYN_LDS);
    if (per_cu > 1) per_cu = 1;
    if (per_cu < 1) per_cu = 1;
    grid_blocks = cus * per_cu;
  }
  if (ws_size < WS_NEED) {
    fprintf(stderr, "workspace too small: %zu < %llu\n", ws_size, (unsigned long long)WS_NEED);
    return;
  }
  Params p{};
  p.x = (const float*)d_in[0]; p.p = (const float*)d_in[1]; p.norm_mix = (const float*)d_in[2]; p.w_in = (const float*)d_in[3];
  p.nsa_q_norm = (const float*)d_in[4]; p.nsa_k_norm = (const float*)d_in[5]; p.cmp_pos_k = (const float*)d_in[6];
  p.cmp_pos_v = (const float*)d_in[7]; p.cmp_w1_k = (const float*)d_in[8]; p.cmp_w2_k = (const float*)d_in[9];
  p.cmp_w1_v = (const float*)d_in[10]; p.cmp_w2_v = (const float*)d_in[11]; p.w_up_nsa = (const float*)d_in[12];
  p.w_up_ret = (const float*)d_in[13]; p.w_out = (const float*)d_in[14]; p.norm_mlp = (const float*)d_in[15];
  p.w_ff1 = (const float*)d_in[16]; p.w_ff2 = (const float*)d_in[17]; p.norm_ple = (const float*)d_in[18];
  p.w_ple = (const float*)d_in[19]; p.w_ple_gate = (const float*)d_in[20];
  p.out = (float*)d_out; p.ws = (char*)d_ws;
  hipMemsetAsync((char*)d_ws + O_BAR, 0, BAR_BYTES, stream);
  void* args[] = {&p};
  hipError_t e = hipLaunchCooperativeKernel((void*)mega, dim3(grid_blocks), dim3(512), args, DYN_LDS, stream);
  if (e != hipSuccess) fprintf(stderr, "cooperative launch failed: %s (grid %d)\n", hipGetErrorString(e), grid_blocks);
}
```
